# Optimizing an MI355X kernel written in HIP

```python
import jax, jax.numpy as jnp
from jax import lax
import numpy as np

D_MODEL = 4096
BATCH = 4
SEQ = 2048
DEPTH = 1

N_HEADS = 16
HEAD_DIM = 128
N_KV_HEADS = 4
ATT_WIDTH = N_HEADS * HEAD_DIM
KV_WIDTH = N_KV_HEADS * HEAD_DIM
IDX_HEADS = 32
IDX_DIM = 64
TOPK_MAX = 256
Q_BLOCK = 128
GM_WIDTH = 2048
GM_GROUPS = 8
GM_GROUP_W = GM_WIDTH // GM_GROUPS
GM_CHUNK = 128
D_FF = 11008
CONV_W = 3
EPS = 1e-6
NEG_BIG = -1e30
IN_SIZES = (ATT_WIDTH, KV_WIDTH, KV_WIDTH, IDX_HEADS * IDX_DIM, IDX_DIM, IDX_HEADS,
            GM_WIDTH, GM_WIDTH, D_MODEL, D_MODEL)
IN_WIDTH = (ATT_WIDTH + 2 * KV_WIDTH + IDX_HEADS * IDX_DIM + IDX_DIM + IDX_HEADS
            + 2 * GM_WIDTH + 2 * D_MODEL)

kernel_name = 'hybrid_dsa_gmlp_convffn_adaln'


def _split_points():
    return np.cumsum(np.array(IN_SIZES))[:-1].tolist()


def _rmsnorm(x, g):
    xf = x.astype(jnp.float32)
    y = xf * lax.rsqrt(jnp.mean(xf * xf, axis=-1, keepdims=True) + EPS)
    return (y * g.astype(jnp.float32)).astype(x.dtype)


def _alibi_slopes(n):
    return jnp.asarray([2.0 ** (-8.0 * (i + 1) / n) for i in range(n)], dtype=jnp.float32)


def _dsa_attention(q, k, v, q_idx, k_idx, w_idx):
    B, S = q.shape[0], q.shape[1]
    topk = min(TOPK_MAX, S // 4)
    n_blk = S // Q_BLOCK
    rep = N_HEADS // N_KV_HEADS
    slopes = _alibi_slopes(N_HEADS).reshape(N_KV_HEADS, rep)
    key_pos = jnp.arange(S, dtype=jnp.int32)
    scale = HEAD_DIM ** -0.5
    idx_scale = IDX_DIM ** -0.5
    w_scale = IDX_HEADS ** -0.5

    def block(i):
        t0 = i * Q_BLOCK
        qb = lax.dynamic_slice_in_dim(q, t0, Q_BLOCK, axis=1).reshape(B, Q_BLOCK, N_KV_HEADS, rep, HEAD_DIM)
        qib = lax.dynamic_slice_in_dim(q_idx, t0, Q_BLOCK, axis=1)
        wb = lax.dynamic_slice_in_dim(w_idx, t0, Q_BLOCK, axis=1)
        q_pos = t0 + jnp.arange(Q_BLOCK, dtype=jnp.int32)
        causal = key_pos[None, :] <= q_pos[:, None]
        logits = jnp.einsum('bthd,bsd->btsh', qib, k_idx).astype(jnp.float32) * idx_scale
        iscore = jnp.einsum('btsh,bth->bts', jax.nn.relu(logits), wb.astype(jnp.float32) * w_scale)
        iscore = jnp.where(causal[None], iscore, -jnp.inf)
        _, sel = lax.top_k(iscore, topk)
        valid = sel <= q_pos[None, :, None]
        k_sel = jax.vmap(lambda kk, ii: kk[ii])(k, sel)
        v_sel = jax.vmap(lambda vv, ii: vv[ii])(v, sel)
        s = jnp.einsum('btgrd,btkgd->btgrk', qb, k_sel).astype(jnp.float32) * scale
        dist = (q_pos[None, :, None] - sel).astype(jnp.float32)
        s = s - slopes[None, None, :, :, None] * dist[:, :, None, None, :]
        s = jnp.where(valid[:, :, None, None, :], s, NEG_BIG)
        p = jax.nn.softmax(s, axis=-1).astype(v.dtype)
        o = jnp.einsum('btgrk,btkgd->btgrd', p, v_sel)
        return o.reshape(B, Q_BLOCK, ATT_WIDTH)

    out = lax.map(block, jnp.arange(n_blk, dtype=jnp.int32))
    return out.transpose(1, 0, 2, 3).reshape(B, S, ATT_WIDTH)


def _chunked_sgu(u, v, g, w_s, b_s):
    B, S = u.shape[0], u.shape[1]
    n = S // GM_CHUNK
    vn = _rmsnorm(v, g).reshape(B, n, GM_CHUNK, GM_GROUPS, GM_GROUP_W)
    mask = jnp.tril(jnp.ones((GM_CHUNK, GM_CHUNK), dtype=bool))
    w = jnp.where(mask[None], w_s, jnp.zeros_like(w_s))
    f = jnp.einsum('gts,bnsgc->bntgc', w, vn) + b_s.T[None, None, :, :, None]
    return u * f.reshape(B, S, GM_WIDTH)


def _conv_ffn(h, w_up, conv_w, conv_b, w_down):
    S = h.shape[1]
    a = h @ w_up
    ap = jnp.pad(a, ((0, 0), (CONV_W - 1, 0), (0, 0)))
    acc = conv_b
    for j in range(CONV_W):
        acc = acc + ap[:, j:j + S] * conv_w[j]
    gate, val = jnp.split(acc, 2, axis=-1)
    return (jax.nn.silu(gate) * val) @ w_down


def setup_inputs(seed: int = 0) -> dict:
    key = jax.random.key(seed)
    ks = jax.random.split(key, 20)
    f32 = jnp.float32
    nrm = lambda k, shape, s: jax.random.normal(k, shape, f32) * s
    L = DEPTH
    return {
        'x': nrm(ks[0], (BATCH, SEQ, D_MODEL), 1.0),
        'c': nrm(ks[1], (BATCH, D_MODEL), 1.0),
        'ada_w': nrm(ks[2], (L, D_MODEL, 6 * D_MODEL), 0.5 * D_MODEL ** -0.5),
        'ada_b': nrm(ks[3], (L, 6 * D_MODEL), 0.01),
        'norm1_g': 1.0 + nrm(ks[4], (L, D_MODEL), 0.02),
        'w_in': nrm(ks[5], (L, D_MODEL, IN_WIDTH), D_MODEL ** -0.5),
        'q_norm_g': 1.0 + nrm(ks[6], (L, HEAD_DIM), 0.02),
        'k_norm_g': 1.0 + nrm(ks[7], (L, HEAD_DIM), 0.02),
        'sgu_norm_g': 1.0 + nrm(ks[8], (L, GM_WIDTH), 0.02),
        'sgu_w': nrm(ks[9], (L, GM_GROUPS, GM_CHUNK, GM_CHUNK), GM_CHUNK ** -0.5),
        'sgu_b': 1.0 + nrm(ks[10], (L, GM_GROUPS, GM_CHUNK), 0.1),
        'w_branch_a': nrm(ks[11], (L, ATT_WIDTH, D_MODEL), ATT_WIDTH ** -0.5),
        'w_branch_b': nrm(ks[12], (L, GM_WIDTH, D_MODEL), GM_WIDTH ** -0.5),
        'w_out': nrm(ks[13], (L, D_MODEL, D_MODEL), D_MODEL ** -0.5),
        'norm2_g': 1.0 + nrm(ks[14], (L, D_MODEL), 0.02),
        'w_up': nrm(ks[15], (L, D_MODEL, 2 * D_FF), D_MODEL ** -0.5),
        'conv_w': nrm(ks[16], (L, CONV_W, 2 * D_FF), CONV_W ** -0.5),
        'conv_b': nrm(ks[17], (L, 2 * D_FF), 0.01),
        'w_down': nrm(ks[18], (L, D_FF, D_MODEL), D_FF ** -0.5),
    }


def reference(x, c, ada_w, ada_b, norm1_g, w_in, q_norm_g, k_norm_g, sgu_norm_g, sgu_w, sgu_b,
              w_branch_a, w_branch_b, w_out, norm2_g, w_up, conv_w, conv_b, w_down):
    B, S = x.shape[0], x.shape[1]
    cs = jax.nn.silu(c)
    splits = _split_points()
    for l in range(DEPTH):
        mod = cs @ ada_w[l] + ada_b[l]
        sh1, sc1, g1, sh2, sc2, g2 = [m[:, None, :] for m in jnp.split(mod, 6, axis=-1)]
        h = _rmsnorm(x, norm1_g[l]) * (1 + sc1) + sh1
        proj = h @ w_in[l]
        q, k, v, qi, ki, wi, gu, gv, ga, gb = jnp.split(proj, splits, axis=-1)
        q = _rmsnorm(q.reshape(B, S, N_HEADS, HEAD_DIM), q_norm_g[l])
        k = _rmsnorm(k.reshape(B, S, N_KV_HEADS, HEAD_DIM), k_norm_g[l])
        v = v.reshape(B, S, N_KV_HEADS, HEAD_DIM)
        qi = qi.reshape(B, S, IDX_HEADS, IDX_DIM)
        y_a = _dsa_attention(q, k, v, qi, ki, wi)
        y_b = _chunked_sgu(jax.nn.gelu(gu, approximate=False), jax.nn.gelu(gv, approximate=False),
                           sgu_norm_g[l], sgu_w[l], sgu_b[l])
        merged = jax.nn.sigmoid(ga) * (y_a @ w_branch_a[l]) + jax.nn.sigmoid(gb) * (y_b @ w_branch_b[l])
        x = x + g1 * (merged @ w_out[l])
        h2 = _rmsnorm(x, norm2_g[l]) * (1 + sc2) + sh2
        x = x + g2 * _conv_ffn(h2, w_up[l], conv_w[l], conv_b[l], w_down[l])
    return x
```

```cpp
#include <hip/hip_runtime.h>
#include <cstdio>
#include <cstdint>

#ifndef MK_N_LAUNCHES
#define MK_N_LAUNCHES 1
#endif

namespace pg8 {
#define PG8_LAS __attribute__((address_space(3)))
typedef unsigned short bf16_t;
typedef short bf16x8 __attribute__((ext_vector_type(8)));
typedef float f32x4 __attribute__((ext_vector_type(4)));
typedef float f32x2 __attribute__((ext_vector_type(2)));
typedef unsigned u32x4 __attribute__((ext_vector_type(4)));
typedef unsigned u32x2 __attribute__((ext_vector_type(2)));
constexpr int BM = 256, BK = 64, HALF = 128, HTB = HALF * BK * 2, STAGE_BYTES = 8 * HTB, NXCD = 8, WGM = 8;

__host__ __device__ __forceinline__ int lds_byte(int r, int c) { const int st = (r >> 4) * 2 + (c >> 5), rr = r & 15, cc = c & 31, ob = rr * 64 + cc * 2; return st * 1024 + (ob ^ (((ob >> 9) & 1) << 5)); }
__host__ __device__ __forceinline__ void stage_rc(int b, int& R, int& C) { const int st = b / 1024, sb = b % 1024, swz = sb ^ (((sb >> 9) & 1) << 5); R = (st >> 1) * 16 + swz / 64; C = (st & 1) * 32 + (swz % 64) / 2; }
__host__ __device__ __forceinline__ int perm32(int rho) { const int n = rho >> 4, i = rho & 15; return 8 * (i >> 2) + 4 * n + (i & 3); }

struct Unit { int pm, pn; };
struct Gemm { const bf16_t* A; const bf16_t* Bt; int M, N, K, lda, ldb; };

struct StaticOrder {
    int nM, nN, nwg, G, c;
    __host__ __device__ void init(int M, int N, int G_, int c_) { nM = M / BM; nN = N / BM; nwg = nM * nN; G = G_; c = c_; }
    __host__ __device__ bool next(int i, Unit& u) const {
        const long L = (long)i * G + c; if (L >= nwg) return false;
        int wgid = (int)L; { const int q = nwg / NXCD, r = nwg % NXCD, xcd = wgid % NXCD, off = wgid / NXCD; wgid = (xcd < r ? xcd * (q + 1) : r * (q + 1) + (xcd - r) * q) + off; }
        const int nig = WGM * nN, gid = wgid / nig, fm = gid * WGM, gsz = (nM - fm) < WGM ? (nM - fm) : WGM;
        u.pm = fm + ((wgid % nig) % gsz); u.pn = (wgid % nig) / gsz; return true;
    }
    __device__ __forceinline__ void a_ready(const Unit&) const {}
    __device__ __forceinline__ void done(const Unit&) const {}
};

__device__ __forceinline__ unsigned cvt_pk_bf16(float lo, float hi) { unsigned r; asm volatile("v_cvt_pk_bf16_f32 %0, %1, %2" : "=v"(r) : "v"(lo), "v"(hi)); return r; }
__device__ __forceinline__ f32x2 gelu_pk(f32x2 v) {
    const f32x2 av = __builtin_elementwise_abs(v), d = av * 0.2316418882f + 1.0f;
    f32x2 t; t.x = __builtin_amdgcn_rcpf(d.x); t.y = __builtin_amdgcn_rcpf(d.y);
    f32x2 q = t * 0.5307027145f + (-0.7265760135f); q = q * t + 0.7107068705f; q = q * t + (-0.142248368f); q = q * t + 0.127414796f; q = q * t;
    const f32x2 s = (v * v) * (-0.72134752044f);
    f32x2 e; e.x = __builtin_amdgcn_exp2f(s.x); e.y = __builtin_amdgcn_exp2f(s.y);
    const f32x2 m = v * (q * e), r = v - m;
    f32x2 o; o.x = v.x < 0.f ? m.x : r.x; o.y = v.y < 0.f ? m.y : r.y; return o;
}
__device__ __forceinline__ float sigmoidf_(float x) { return __builtin_amdgcn_rcpf(1.0f + __builtin_amdgcn_exp2f(-1.4426950408889634f * x)); }
__device__ __forceinline__ float bflo(unsigned w) { return __builtin_bit_cast(float, w << 16); }
__device__ __forceinline__ float bfhi(unsigned w) { return __builtin_bit_cast(float, w & 0xffff0000u); }

template <class Epi, class Sched, bool ALIGN_EPI>
__device__ __forceinline__ void gemm_phase(PG8_LAS unsigned char* lds, const Gemm g, const Sched& S, const Epi& E) {
    const int tid = threadIdx.x, wid = __builtin_amdgcn_readfirstlane(tid >> 6), lane = tid & 63, wr = wid >> 2, wc = wid & 3, fr = lane & 15, fq = lane >> 4;
    const int K = g.K, nt = K / BK;
    unsigned voffA[2], voffB[2];
#pragma unroll
    for (int i = 0; i < 2; ++i) { int R, C; stage_rc(tid * 16 + i * 8192, R, C); const int Rb = Epi::PERM ? ((R & ~31) + perm32(R & 31)) : R;
        voffA[i] = (unsigned)(R * g.lda + C) * 2u; voffB[i] = (unsigned)(Rb * g.ldb + C) * 2u; }
    const size_t kstep = (size_t)(BK * 2);
    const size_t hstepA = (size_t)HALF * g.lda * 2, hstepB = (size_t)HALF * g.ldb * 2;
    const size_t tstepA = 2 * hstepA, tstepB = 2 * hstepB;
    const unsigned ldsw = (unsigned)wid * 1024u;
    const int aoff = lds_byte(wr * 64 + fr, fq * 8), boff = lds_byte(wc * 32 + fr, fq * 8);
#define PG8_SA(b, h) (((b) * 2 + (h)) * HTB)
#define PG8_SB(b, h) ((4 + (b) * 2 + (h)) * HTB)
#define PG8_STAGE(bufoff, gbase, voff) do { _Pragma("unroll") for (int _i = 0; _i < 2; ++_i) \
        __builtin_amdgcn_global_load_lds((const unsigned*)((const char*)(gbase) + (voff)[_i]), (PG8_LAS unsigned*)(lds + (bufoff) + ldsw + _i * 8192), 16, 0, 0); } while (0)
#define PG8_LDA(dst, b, h) do { _Pragma("unroll") for (int m = 0; m < 4; ++m) _Pragma("unroll") for (int k = 0; k < 2; ++k) dst[m][k] = *(const PG8_LAS bf16x8*)(lds + PG8_SA(b, h) + aoff + m * 2048 + k * 1024); } while (0)
#define PG8_LDB(dst, b, h) do { _Pragma("unroll") for (int n = 0; n < 2; ++n) _Pragma("unroll") for (int k = 0; k < 2; ++k) dst[n][k] = *(const PG8_LAS bf16x8*)(lds + PG8_SB(b, h) + boff + n * 2048 + k * 1024); } while (0)
#define PG8_MMA(ai, bj, At, Bt) do { __builtin_amdgcn_s_setprio(1); _Pragma("unroll") for (int m = 0; m < 4; ++m) _Pragma("unroll") for (int n = 0; n < 2; ++n) _Pragma("unroll") for (int k = 0; k < 2; ++k) \
        acc[ai][bj][m][n] = __builtin_amdgcn_mfma_f32_16x16x32_bf16(Bt[n][k], At[m][k], acc[ai][bj][m][n], 0, 0, 0); __builtin_amdgcn_s_setprio(0); } while (0)
#define PG8_WAIT_V(n) asm volatile("s_waitcnt vmcnt(" #n ")" ::: "memory")
#define PG8_WAIT_L(n) asm volatile("s_waitcnt lgkmcnt(" #n ")" ::: "memory")
#define PG8_BAR __builtin_amdgcn_s_barrier()
#define PG8_SCHED __builtin_amdgcn_sched_barrier(0)
    Unit cur, nxt; int ui = 0;
    if (!S.next(0, cur)) return;
    f32x4 acc[2][2][4][2];
#pragma unroll
    for (int a = 0; a < 2; ++a)
#pragma unroll
        for (int b = 0; b < 2; ++b)
#pragma unroll
            for (int m = 0; m < 4; ++m)
#pragma unroll
                for (int n = 0; n < 2; ++n) acc[a][b][m][n] = (f32x4){0.f, 0.f, 0.f, 0.f};
    bf16x8 At[4][2], B0[2][2], B1[2][2];
    const char* cA = (const char*)g.A + (size_t)cur.pm * tstepA; const char* cB = (const char*)g.Bt + (size_t)cur.pn * tstepB;
    S.a_ready(cur);
    PG8_STAGE(PG8_SB(0, 0), cB, voffB); PG8_STAGE(PG8_SB(0, 1), cB + hstepB, voffB); PG8_STAGE(PG8_SA(0, 0), cA, voffA); PG8_STAGE(PG8_SA(0, 1), cA + hstepA, voffA);
    if (wr == 1) PG8_BAR;
    PG8_WAIT_V(2); PG8_BAR;
    PG8_STAGE(PG8_SB(1, 0), cB + kstep, voffB); PG8_STAGE(PG8_SA(1, 0), cA + kstep, voffA); PG8_STAGE(PG8_SB(1, 1), cB + hstepB + kstep, voffB);
    PG8_WAIT_V(6); PG8_BAR;
    for (;;) {
        const bool has_next = S.next(ui + 1, nxt);
        const char* nA = has_next ? (const char*)g.A + (size_t)nxt.pm * tstepA : cA; const char* nB = has_next ? (const char*)g.Bt + (size_t)nxt.pn * tstepB : cB;
        for (int t = 0; t < nt; t += 2) {
            const bool last = (t == nt - 2);
            const char* a1 = cA + (size_t)(t + 1) * kstep;
            const char* a2 = last ? nA : cA + (size_t)(t + 2) * kstep; const char* b2 = last ? nB : cB + (size_t)(t + 2) * kstep;
            const char* a3 = a2 + kstep; const char* b3 = b2 + kstep;
            if (last && has_next) S.a_ready(nxt);
            PG8_LDB(B0, 0, 0); PG8_LDB(B1, 0, 1); PG8_SCHED; PG8_LDA(At, 0, 0); PG8_STAGE(PG8_SA(1, 1), a1 + hstepA, voffA);
            PG8_WAIT_V(8); PG8_WAIT_L(0); PG8_BAR; PG8_MMA(0, 0, At, B0); PG8_MMA(0, 1, At, B1); PG8_BAR; PG8_SCHED;
            PG8_LDA(At, 0, 1); PG8_STAGE(PG8_SB(0, 0), b2, voffB); PG8_STAGE(PG8_SB(0, 1), b2 + hstepB, voffB); PG8_STAGE(PG8_SA(0, 0), a2, voffA);
            PG8_WAIT_V(8); PG8_WAIT_L(0); PG8_BAR; PG8_MMA(1, 0, At, B0); PG8_MMA(1, 1, At, B1); PG8_BAR; PG8_SCHED;
            PG8_LDB(B0, 1, 0); PG8_LDB(B1, 1, 1); PG8_SCHED; PG8_LDA(At, 1, 0); PG8_STAGE(PG8_SA(0, 1), a2 + hstepA, voffA);
            PG8_WAIT_V(8); PG8_WAIT_L(0); PG8_BAR; PG8_MMA(0, 0, At, B0); PG8_MMA(0, 1, At, B1); PG8_BAR; PG8_SCHED;
            PG8_LDA(At, 1, 1); PG8_STAGE(PG8_SB(1, 0), b3, voffB); PG8_STAGE(PG8_SB(1, 1), b3 + hstepB, voffB); PG8_STAGE(PG8_SA(1, 0), a3, voffA);
            PG8_WAIT_V(8); PG8_WAIT_L(0); PG8_BAR; PG8_MMA(1, 0, At, B0); PG8_MMA(1, 1, At, B1); PG8_BAR; PG8_SCHED;
        }
        if constexpr (ALIGN_EPI) { if (wr == 0) PG8_BAR; }
        E(acc, cur, wr, wc, fr, fq); S.done(cur);
        if (!has_next) break;
#pragma unroll
        for (int a = 0; a < 2; ++a)
#pragma unroll
            for (int b = 0; b < 2; ++b)
#pragma unroll
                for (int m = 0; m < 4; ++m)
#pragma unroll
                    for (int n = 0; n < 2; ++n) acc[a][b][m][n] = (f32x4){0.f, 0.f, 0.f, 0.f};
        cur = nxt; cA = nA; cB = nB; ++ui;
        if constexpr (ALIGN_EPI) { if (wr == 1) PG8_BAR; }
    }
    PG8_WAIT_V(0);
    if constexpr (!ALIGN_EPI) { if (wr == 0) PG8_BAR; }
    PG8_BAR;
#undef PG8_SA
#undef PG8_SB
#undef PG8_STAGE
#undef PG8_LDA
#undef PG8_LDB
#undef PG8_MMA
#undef PG8_WAIT_V
#undef PG8_WAIT_L
#undef PG8_BAR
#undef PG8_SCHED
}
}

constexpr int NWAVES = 8;
constexpr int BATCH = 4, SEQ = 2048, DM = 4096, M = BATCH * SEQ;
constexpr int NH = 16, HD = 128, NKV = 4, ATTW = 2048, KVW = 512, IH = 32, IDIM = 64, TOPK = 256;
constexpr int GMW = 2048, GMG = 8, GMGW = 256, GMC = 128, DFF = 11008, F2 = 2 * DFF;
constexpr int IN_W = 17504, MODW = 6 * DM;
constexpr float EPS = 1e-6f;
constexpr int PQ = 0, PK = 2048, PV = 2560, PQI = 3072, PGU = 5120, PGV = 7168, PGA = 9216, PGB = 13312, PKI = 17408, PWI = 17472, PNP = 17664;
constexpr int SQ = 0, SK = 2048, SV = 2560, SQI = 3072, SKI = 5120, SWI = 5184, SGU = 5216, SGV = 7264, SGA = 9312, SGB = 13408;

constexpr size_t MiB = 1u << 20;
constexpr size_t WS_CTL = 0, CTL_ZERO_BYTES = 2 * MiB;
constexpr size_t WS_MOD = 1 * MiB;
constexpr size_t WS_WIN = 2 * MiB;
constexpr size_t WS_WA = 140 * MiB, WS_WB = 156 * MiB;
constexpr size_t WS_WOUT = 172 * MiB;
constexpr size_t WS_WUP = 204 * MiB;
constexpr size_t WS_WDN = 376 * MiB;
constexpr size_t WS_H = 462 * MiB;
constexpr size_t WS_X1 = 526 * MiB;
constexpr size_t WS_PROJ = 654 * MiB;
constexpr size_t WS_MASK = 930 * MiB;
constexpr size_t WS_RS = 932 * MiB;
constexpr size_t WS_SWT = 932 * MiB + 65536;
constexpr size_t WS_VT = 933 * MiB;
constexpr size_t WS_YA = 941 * MiB, WS_YB = 973 * MiB;
constexpr size_t WS_MRG = 1005 * MiB;
constexpr size_t WS_TMP = 1069 * MiB;
constexpr size_t WS_A = 654 * MiB;
constexpr size_t WS_ACT = 998 * MiB;
constexpr size_t WS_END = 1197 * MiB;
static_assert(WS_WIN + (size_t)PNP * DM * 2 <= WS_WA && WS_WUP + (size_t)F2 * DM * 2 <= WS_WDN && WS_WDN + (size_t)DM * DFF * 2 <= WS_H, "ws map 1");
static_assert(WS_PROJ + (size_t)M * PNP * 2 <= WS_MASK && WS_A + (size_t)M * F2 * 2 <= WS_ACT && WS_ACT + (size_t)M * DFF * 2 <= WS_END && WS_TMP + (size_t)M * DM * 4 <= WS_END, "ws map 2");
constexpr int CW_TMO = 0, CW_CODE = 1, CW_BAR = 4096;

constexpr int RING_OFF = 0, RING_BYTES = 131072;
constexpr int LDSCTL_OFF = RING_BYTES + 8192, MISC_OFF = LDSCTL_OFF + 320;
constexpr int LDS_BYTES = 147456;
static_assert(MISC_OFF + 128 <= LDS_BYTES, "LDS map");

#define GAS __attribute__((address_space(1)))
#define LAS __attribute__((address_space(3)))
typedef unsigned short bf16;
typedef unsigned v4u __attribute__((ext_vector_type(4)));
typedef unsigned v2u __attribute__((ext_vector_type(2)));
typedef float f32x4 __attribute__((ext_vector_type(4)));
typedef float f32x16 __attribute__((ext_vector_type(16)));
typedef short bf16x8 __attribute__((ext_vector_type(8)));
typedef short bf16x4 __attribute__((ext_vector_type(4)));
typedef GAS unsigned gu32;
#define RLX_AGENT __ATOMIC_RELAXED, __HIP_MEMORY_SCOPE_AGENT
#define LDS_WAIT() asm volatile("s_waitcnt lgkmcnt(0)" ::: "memory")
#define VM_WAIT() asm volatile("s_waitcnt vmcnt(0)" ::: "memory")
__device__ __forceinline__ unsigned f2bf(float f) { unsigned u = __builtin_bit_cast(unsigned, f); return (u + 0x7fffu + ((u >> 16) & 1u)) >> 16; }
__device__ __forceinline__ unsigned pk2(float lo, float hi) { return f2bf(lo) | (f2bf(hi) << 16); }
__device__ __forceinline__ float bf2f(bf16 h) { return __builtin_bit_cast(float, (unsigned)h << 16); }
using pg8::bflo; using pg8::bfhi;

#define XB_TMO      128
#define XB_XCNT(j)  (256  + 64 * (j))
#define XB_XSUB(j)  (1280 + 64 * (j))
#define XB_XGEN(j)  (2304 + 64 * (j))
#define XB_TOP      3328
#define XB_TOPGEN   3392
#define XCD_BAR_WORDS 3456
#define XB_SPIN_CAP (1u << 18)
__device__ __forceinline__ unsigned xb_ld(unsigned* p)              { return __hip_atomic_load(p, __ATOMIC_RELAXED, __HIP_MEMORY_SCOPE_AGENT); }
__device__ __forceinline__ unsigned xb_add(unsigned* p, unsigned v) { return __hip_atomic_fetch_add(p, v, __ATOMIC_RELAXED, __HIP_MEMORY_SCOPE_AGENT); }
__device__ __forceinline__ unsigned xb_xcc_id() { return (unsigned)__builtin_amdgcn_s_getreg((3 << 11) | 20) & 0xFu; }
#define XB_SPIN(cond, bar) do { unsigned _sp = 0; while (cond) { __builtin_amdgcn_s_sleep(1); \
    if ((++_sp & 255u) == 0u) { if (xb_ld(&(bar)[XB_TMO])) break; if (_sp > XB_SPIN_CAP) { atomicAdd(&(bar)[XB_TMO], 1u); break; } } } } while (0)
struct XcdBarrier { unsigned* bar; unsigned x; volatile LAS unsigned* st; };
__device__ __forceinline__ XcdBarrier xcd_barrier_post(unsigned* bar, volatile LAS unsigned* st) {
    XcdBarrier b; b.bar = bar; b.x = xb_xcc_id(); b.st = st;
    if (threadIdx.x == 0) (void)xb_add(&bar[XB_XCNT(b.x)], 1u);
    return b;
}
__device__ __forceinline__ void xcd_barrier_complete(unsigned* bar, unsigned x, unsigned& nloc, unsigned& nx) {
    const unsigned G = gridDim.x * gridDim.y * gridDim.z;
    unsigned sum, cnt, mine, sp = 0u;
    for (;;) {
        sum = 0u; cnt = 0u; mine = 0u;
#pragma unroll
        for (unsigned j = 0; j < 16; ++j) { const unsigned c = xb_ld(&bar[XB_XCNT(j)]); sum += c; cnt += (c > 0u) ? 1u : 0u; mine = (j == x) ? c : mine; }
        if (sum == G) break;
        __builtin_amdgcn_s_sleep(1);
        if ((++sp & 255u) == 0u) { if (xb_ld(&bar[XB_TMO])) break; if (sp > XB_SPIN_CAP) { atomicAdd(&bar[XB_TMO], 1u); break; } }
    }
    nloc = mine > 0u ? mine : 1u; nx = cnt > 0u ? cnt : 1u;
}
__device__ __forceinline__ void xcd_barrier(const XcdBarrier& b) {
    asm volatile("s_waitcnt vmcnt(0)" ::: "memory");
    __syncthreads();
    if (threadIdx.x == 0) {
        unsigned* bar = b.bar;
        __builtin_amdgcn_s_waitcnt(0);
        unsigned nloc = b.st[0], nx = b.st[1];
        if (nloc == 0u) { xcd_barrier_complete(bar, b.x, nloc, nx); b.st[0] = nloc; b.st[1] = nx; }
        const unsigned old = xb_add(&bar[XB_XSUB(b.x)], 1u);
        const unsigned gen = old / nloc;
        if (old + 1u == (gen + 1u) * nloc) {
            __builtin_amdgcn_fence(__ATOMIC_RELEASE, "agent");
            asm volatile("s_waitcnt vmcnt(0)" ::: "memory");
            const unsigned og = xb_add(&bar[XB_TOP], 1u);
            const unsigned tg = og / nx;
            if (og + 1u == (tg + 1u) * nx) xb_add(&bar[XB_TOPGEN], 1u);
            else XB_SPIN(xb_ld(&bar[XB_TOPGEN]) == tg, bar);
            __builtin_amdgcn_fence(__ATOMIC_ACQUIRE, "agent");
            xb_add(&bar[XB_XGEN(b.x)], 1u);
            asm volatile("s_waitcnt vmcnt(0)" ::: "memory");
        } else {
            XB_SPIN(xb_ld(&bar[XB_XGEN(b.x)]) == gen, bar);
            __builtin_amdgcn_fence(__ATOMIC_ACQUIRE, "agent");
            asm volatile("s_waitcnt vmcnt(0)" ::: "memory");
        }
    }
    __syncthreads();
}

struct Frame {
    LAS unsigned char* lds;
    volatile LAS unsigned* MISC;
    gu32* ctl;
    int tid, lane, wave, G, gw, NGW;
    const float *x, *c, *ada_w, *ada_b, *n1g, *w_in, *qng, *kng, *sgg, *sgw, *sgb, *w_a, *w_b, *w_out, *n2g, *w_up, *cvw, *cvb, *w_dn;
    float* out;
    float* MOD; bf16 *WIN, *WA, *WB, *WOUT, *WUP, *WDN, *H, *PROJ, *VT, *YA, *YB, *MRG, *A, *ACT; float *X1, *TMP, *RS, *SWT; unsigned* MASK;
};
__device__ __forceinline__ float wave_sum(float v) {
#pragma unroll
    for (int o = 1; o < 64; o <<= 1) v += __shfl_xor(v, o);
    return v;
}

__device__ __forceinline__ void transpose_item(const float* W, int Nsrc, int k0, int n0, bf16* dst, size_t ldk, int drow0, LAS float* scr, int lane) {
#pragma unroll
    for (int i = 0; i < 8; ++i) { const int kk = 8 * i + (lane >> 3); const f32x4 v = *(const GAS f32x4*)(W + (size_t)(k0 + kk) * Nsrc + n0 + 4 * (lane & 7));
        LAS float* s = scr + kk * 33 + 4 * (lane & 7); s[0] = v.x; s[1] = v.y; s[2] = v.z; s[3] = v.w; }
    LDS_WAIT(); asm volatile("" ::: "memory");
    const int c = lane & 7;
#pragma unroll
    for (int j = 0; j < 4; ++j) { const int n = (lane >> 3) + 8 * j; const LAS float* s = scr + (8 * c) * 33 + n;
        v4u o; o.x = pk2(s[0 * 33], s[1 * 33]); o.y = pk2(s[2 * 33], s[3 * 33]); o.z = pk2(s[4 * 33], s[5 * 33]); o.w = pk2(s[6 * 33], s[7 * 33]);
        *(GAS v4u*)(dst + (size_t)(drow0 + n) * ldk + k0 + 8 * c) = o; }
    LDS_WAIT(); asm volatile("" ::: "memory");
}
__device__ __forceinline__ int win_dst_row(int n) {
    if (n < SKI) return n;
    if (n < SWI) return PKI + (n - SKI);
    if (n < SGU) return PWI + (n - SWI);
    return PGU + (n - SGU);
}
__device__ __forceinline__ void gemv_item(Frame& F, int item) {
    const int nb = item % 96, ks = item / 96, n0 = nb * 256 + 4 * F.lane, k0 = ks * 64;
    float cs[4];
#pragma unroll
    for (int b = 0; b < 4; ++b) { const float cv = F.c[b * DM + k0 + F.lane]; cs[b] = cv * pg8::sigmoidf_(cv); }
    f32x4 acc[4];
#pragma unroll
    for (int b = 0; b < 4; ++b) acc[b] = (ks == 0) ? *(const GAS f32x4*)(F.ada_b + n0) : (f32x4){0.f, 0.f, 0.f, 0.f};
    const float* wp = F.ada_w + (size_t)k0 * MODW + n0;
#pragma unroll 16
    for (int k = 0; k < 64; ++k) { const f32x4 w = *(const GAS f32x4*)(wp + (size_t)k * MODW);
#pragma unroll
        for (int b = 0; b < 4; ++b) { const float s = __builtin_bit_cast(float, __builtin_amdgcn_readlane(__builtin_bit_cast(int, cs[b]), k)); acc[b] += w * s; } }
#pragma unroll
    for (int b = 0; b < 4; ++b) { float* o = F.MOD + b * MODW + n0; unsafeAtomicAdd(o + 0, acc[b].x); unsafeAtomicAdd(o + 1, acc[b].y); unsafeAtomicAdd(o + 2, acc[b].z); unsafeAtomicAdd(o + 3, acc[b].w); }
}
__device__ __forceinline__ void p0_prologue(Frame& F) {
    LAS float* scr = (LAS float*)(F.lds + RING_OFF + F.wave * 16384);
    constexpr int I_GV = 96 * 64;
    constexpr int I_IN = (DM / 64) * (IN_W / 32), I_A = (ATTW / 64) * (DM / 32), I_B = (GMW / 64) * (DM / 32), I_O = (DM / 64) * (DM / 32), I_UP = (DM / 64) * (F2 / 32), I_DN = (DFF / 64) * (DM / 32);
    constexpr int NITEMS = I_GV + I_IN + I_A + I_B + I_O + I_UP + I_DN;
    for (int it = F.gw; it < NITEMS; it += F.NGW) {
        int r = it;
        if (r < I_GV) { gemv_item(F, r); continue; } r -= I_GV;
        if (r < I_IN) { const int nblk = IN_W / 32, kb = r / nblk, nb = r % nblk; transpose_item(F.w_in, IN_W, 64 * kb, 32 * nb, F.WIN, DM, win_dst_row(32 * nb), scr, F.lane); continue; } r -= I_IN;
        if (r < I_A) { const int nblk = DM / 32, kb = r / nblk, nb = r % nblk; transpose_item(F.w_a, DM, 64 * kb, 32 * nb, F.WA, ATTW, 32 * nb, scr, F.lane); continue; } r -= I_A;
        if (r < I_B) { const int nblk = DM / 32, kb = r / nblk, nb = r % nblk; transpose_item(F.w_b, DM, 64 * kb, 32 * nb, F.WB, GMW, 32 * nb, scr, F.lane); continue; } r -= I_B;
        if (r < I_O) { const int nblk = DM / 32, kb = r / nblk, nb = r % nblk; transpose_item(F.w_out, DM, 64 * kb, 32 * nb, F.WOUT, DM, 32 * nb, scr, F.lane); continue; } r -= I_O;
        if (r < I_UP) { const int nblk = F2 / 32, kb = r / nblk, nb = r % nblk; const int n = 32 * nb; const int ch = n < DFF ? n : n - DFF;
            const int drow = (ch >> 7) * 256 + (ch & 127) + (n < DFF ? 0 : 128);
            transpose_item(F.w_up, F2, 64 * kb, n, F.WUP, DM, drow, scr, F.lane); continue; } r -= I_UP;
        { const int nblk = DM / 32, kb = r / nblk, nb = r % nblk; transpose_item(F.w_dn, DM, 64 * kb, 32 * nb, F.WDN, DFF, 32 * nb, scr, F.lane); }
    }
    { const size_t n16 = (size_t)(PNP - IN_W) * DM * 2 / 16; GAS v4u* p = (GAS v4u*)(F.WIN + (size_t)IN_W * DM);
      for (size_t i = (size_t)F.gw * 64 + F.lane; i < n16; i += (size_t)F.NGW * 64) p[i] = (v4u){0u, 0u, 0u, 0u}; }
    for (int i = F.gw * 64 + F.lane; i < GMG * GMC * GMC; i += F.NGW * 64) { const int g = i >> 14, s = (i >> 7) & 127, t = i & 127; F.SWT[i] = F.sgw[(g * GMC + t) * GMC + s]; }
}

__device__ __forceinline__ void norm_rows(Frame& F, const float* X, const float* gain, int sh_off, int sc_off, bf16* O) {
    for (int m = F.gw; m < M; m += F.NGW) {
        const int b = m >> 11;
        const GAS f32x4* xr = (const GAS f32x4*)(X + (size_t)m * DM) + F.lane;
        f32x4 v[16]; float s = 0.f;
#pragma unroll
        for (int j = 0; j < 16; ++j) { v[j] = xr[64 * j]; s += (v[j].x * v[j].x + v[j].y * v[j].y) + (v[j].z * v[j].z + v[j].w * v[j].w); }
        const float rstd = 1.0f / sqrtf(wave_sum(s) * (1.f / DM) + EPS);
        const GAS f32x4* gp = (const GAS f32x4*)gain + F.lane;
        const GAS f32x4* shp = (const GAS f32x4*)(F.MOD + b * MODW + sh_off) + F.lane;
        const GAS f32x4* scp = (const GAS f32x4*)(F.MOD + b * MODW + sc_off) + F.lane;
        GAS v2u* o8 = (GAS v2u*)(O + (size_t)m * DM) + F.lane;
#pragma unroll
        for (int j = 0; j < 16; ++j) { const f32x4 g = gp[64 * j], sh = shp[64 * j], sc = scp[64 * j];
            const f32x4 y = (v[j] * rstd) * g * (sc + 1.0f) + sh;
            v2u w; w.x = pk2(y.x, y.y); w.y = pk2(y.z, y.w); o8[64 * j] = w; }
    }
}

__device__ __forceinline__ unsigned sortable(float f) { const unsigned u = __builtin_bit_cast(unsigned, f); return u ^ ((unsigned)((int)u >> 31) | 0x80000000u); }
__device__ __forceinline__ void idx_row(Frame& F, int row) {
    const int lane = F.lane, b = row >> 11, t = row & 2047, hi = lane >> 5, l31 = lane & 31;
    GAS v2u* mrow = (GAS v2u*)(F.MASK + (size_t)row * 64);
    if (t < TOPK) {
        if (lane < 32) { const int k0 = 64 * lane; v2u w;
            w.x = (t >= k0 + 31) ? 0xffffffffu : (t < k0 ? 0u : ((2u << (t - k0)) - 1u));
            w.y = (t >= k0 + 63) ? 0xffffffffu : (t < k0 + 32 ? 0u : ((2u << (t - k0 - 32)) - 1u));
            mrow[lane] = w; }
        return;
    }
    const bf16* prow = F.PROJ + (size_t)row * PNP;
    bf16x8 qa[4];
#pragma unroll
    for (int ks = 0; ks < 4; ++ks) qa[ks] = *(const GAS bf16x8*)(prow + PQI + l31 * 64 + 16 * ks + 8 * hi);
    float wv[16];
#pragma unroll
    for (int r = 0; r < 16; ++r) wv[r] = bf2f(prow[PWI + (r & 3) + 8 * (r >> 2) + 4 * hi]);
    const bf16* kib = F.PROJ + (size_t)(b * SEQ) * PNP + PKI + 8 * hi;
    unsigned sc[32];
#pragma unroll
    for (int jp = 0; jp < 32; ++jp) {
        if (64 * jp <= t) {
            float s01[2];
#pragma unroll
            for (int h = 0; h < 2; ++h) {
                const bf16* kp = kib + (size_t)(64 * jp + 32 * h + l31) * PNP;
                f32x16 acc;
#pragma unroll
                for (int r = 0; r < 16; ++r) acc[r] = 0.f;
#pragma unroll
                for (int ks = 0; ks < 4; ++ks) { const bf16x8 kb = *(const GAS bf16x8*)(kp + 16 * ks); acc = __builtin_amdgcn_mfma_f32_32x32x16_bf16(qa[ks], kb, acc, 0, 0, 0); }
                float s = 0.f;
#pragma unroll
                for (int r = 0; r < 16; ++r) s += wv[r] * fmaxf(acc[r], 0.f);
                s += __shfl_xor(s, 32);
                s01[h] = s;
            }
            const float mine = (lane < 32 ? s01[0] : s01[1]) + 0.0f;
            sc[jp] = (64 * jp + lane <= t) ? sortable(mine) : 0u;
        } else sc[jp] = 0u;
    }
    unsigned thr = 0u;
    for (int bit = 31; bit >= 0; --bit) {
        const unsigned cand = thr | (1u << bit); int cnt = 0;
#pragma unroll
        for (int jp = 0; jp < 32; ++jp) cnt += __popcll(__ballot(sc[jp] >= cand));
        if (cnt >= TOPK) thr = cand;
    }
    int cgt = 0;
#pragma unroll
    for (int jp = 0; jp < 32; ++jp) cgt += __popcll(__ballot(sc[jp] > thr));
    const int need = TOPK - cgt; int seen = 0;
    unsigned mylo = 0u, myhi = 0u;
    const unsigned long long lt = (lane == 0) ? 0ull : (~0ull >> (64 - lane));
#pragma unroll
    for (int jp = 0; jp < 32; ++jp) {
        unsigned long long sel = __ballot(sc[jp] > thr);
        const unsigned long long eq = __ballot(sc[jp] == thr);
        if (eq) { const bool take = (sc[jp] == thr) && (seen + __popcll(eq & lt) < need); sel |= __ballot(take); seen += __popcll(eq); }
        if (lane == jp) { mylo = (unsigned)sel; myhi = (unsigned)(sel >> 32); }
    }
    if (lane < 32) { v2u w; w.x = mylo; w.y = myhi; mrow[lane] = w; }
}
constexpr float QSCALE = 0.08838834764831845f * 1.4426950408889634f;
__device__ __forceinline__ void qknorm_row(Frame& F, int row) {
    bf16* prow = F.PROJ + (size_t)row * PNP; const int lane = F.lane;
    {
        GAS v4u* p = (GAS v4u*)(prow + PQ + 32 * lane); v4u w[4]; float ss = 0.f;
#pragma unroll
        for (int i = 0; i < 4; ++i) { w[i] = p[i];
#pragma unroll
            for (int j = 0; j < 4; ++j) { const float a = bflo(w[i][j]), c = bfhi(w[i][j]); ss += a * a + c * c; } }
        ss += __shfl_xor(ss, 1); ss += __shfl_xor(ss, 2);
        const float r = QSCALE / sqrtf(ss * (1.f / HD) + EPS); const float* g = F.qng + 32 * (lane & 3);
#pragma unroll
        for (int i = 0; i < 4; ++i) { v4u o;
#pragma unroll
            for (int j = 0; j < 4; ++j) o[j] = pk2(bflo(w[i][j]) * r * g[8 * i + 2 * j], bfhi(w[i][j]) * r * g[8 * i + 2 * j + 1]);
            p[i] = o; }
    }
    {
        GAS v4u* p = (GAS v4u*)(prow + PK + 8 * lane); const v4u w = *p; float ss = 0.f;
#pragma unroll
        for (int j = 0; j < 4; ++j) { const float a = bflo(w[j]), c = bfhi(w[j]); ss += a * a + c * c; }
        ss += __shfl_xor(ss, 1); ss += __shfl_xor(ss, 2); ss += __shfl_xor(ss, 4); ss += __shfl_xor(ss, 8);
        const float r = 1.0f / sqrtf(ss * (1.f / HD) + EPS); const float* g = F.kng + 8 * (lane & 15); v4u o;
#pragma unroll
        for (int j = 0; j < 4; ++j) o[j] = pk2(bflo(w[j]) * r * g[2 * j], bfhi(w[j]) * r * g[2 * j + 1]);
        *p = o;
    }
    {
        const GAS v4u* p = (const GAS v4u*)(prow + PGV + 32 * lane); float ss = 0.f;
#pragma unroll
        for (int i = 0; i < 4; ++i) { const v4u w = p[i];
#pragma unroll
            for (int j = 0; j < 4; ++j) { const float a = bflo(w[j]), c = bfhi(w[j]); ss += a * a + c * c; } }
        ss = wave_sum(ss);
        if (lane == 0) F.RS[row] = 1.0f / sqrtf(ss * (1.f / GMW) + EPS);
    }
}
__device__ __forceinline__ void vt_item(Frame& F, int item) {
    const int s8 = item & 255, dh = (item >> 8) & 1, g = (item >> 9) & 3, b = item >> 11, d = 64 * dh + F.lane;
    const bf16* src = F.PROJ + (size_t)(b * SEQ + 8 * s8) * PNP + PV + g * HD + d;
    unsigned e[8];
#pragma unroll
    for (int j = 0; j < 8; ++j) e[j] = src[(size_t)j * PNP];
    v4u o; o.x = e[0] | (e[1] << 16); o.y = e[2] | (e[3] << 16); o.z = e[4] | (e[5] << 16); o.w = e[6] | (e[7] << 16);
    *(GAS v4u*)(F.VT + ((size_t)((b * NKV + g) * HD + d)) * SEQ + 8 * s8) = o;
}

__device__ __forceinline__ void attn_block(Frame& F, int b, int g, int qb) {
    const int lane = F.lane, w = F.wave, hi = lane >> 5, l31 = lane & 31;
    const int hh = 4 * g + (w >> 1), t = qb * 64 + 32 * (w & 1) + l31;
    const size_t row = (size_t)b * SEQ + t;
    const float slope2 = exp2f(-0.5f * (float)(hh + 1)) * 1.4426950408889634f;
    bf16x8 qf[8];
#pragma unroll
    for (int ks = 0; ks < 8; ++ks) qf[ks] = *(const GAS bf16x8*)(F.PROJ + row * PNP + PQ + hh * HD + 16 * ks + 8 * hi);
    f32x16 o[4];
#pragma unroll
    for (int db = 0; db < 4; ++db)
#pragma unroll
        for (int r = 0; r < 16; ++r) o[db][r] = 0.f;
    float m = -1e30f, lsum = 0.f;
    const bf16* kbase = F.PROJ + (size_t)(b * SEQ + l31) * PNP + PK + g * HD + 8 * hi;
    const bf16* vbase = F.VT + ((size_t)((b * NKV + g) * HD + l31)) * SEQ + 4 * hi;
    const unsigned* mbase = F.MASK + row * 64;
    for (int kt = 0; kt <= qb; ++kt) {
        const v2u mw = *(const GAS v2u*)(mbase + 2 * kt);
        f32x16 p[2];
#pragma unroll
        for (int kb = 0; kb < 2; ++kb) {
#pragma unroll
            for (int r = 0; r < 16; ++r) p[kb][r] = 0.f;
            const bf16* kp = kbase + (size_t)(64 * kt + 32 * kb) * PNP;
#pragma unroll
            for (int ks = 0; ks < 8; ++ks) { const bf16x8 kf = *(const GAS bf16x8*)(kp + 16 * ks); p[kb] = __builtin_amdgcn_mfma_f32_32x32x16_bf16(kf, qf[ks], p[kb], 0, 0, 0); }
        }
        const float base = -slope2 * (float)(t - 64 * kt - 4 * hi);
        float rmax = -3e30f;
#pragma unroll
        for (int kb = 0; kb < 2; ++kb) { const unsigned mword = (kb ? mw.y : mw.x) >> (4 * hi);
#pragma unroll
            for (int r = 0; r < 16; ++r) { const int ko = (r & 3) + 8 * (r >> 2);
                float s = p[kb][r] + (base + slope2 * (float)(32 * kb + ko));
                s = ((mword >> ko) & 1u) ? s : -2e30f; p[kb][r] = s; rmax = fmaxf(rmax, s); } }
        rmax = fmaxf(rmax, __shfl_xor(rmax, 32));
        const float mn = fmaxf(m, rmax), alpha = exp2f(m - mn); m = mn;
        float ps = 0.f;
#pragma unroll
        for (int kb = 0; kb < 2; ++kb)
#pragma unroll
            for (int r = 0; r < 16; ++r) { const float e = exp2f(p[kb][r] - mn); p[kb][r] = e; ps += e; }
        lsum = lsum * alpha + ps;
#pragma unroll
        for (int db = 0; db < 4; ++db)
#pragma unroll
            for (int r = 0; r < 16; ++r) o[db][r] *= alpha;
#pragma unroll
        for (int kb = 0; kb < 2; ++kb)
#pragma unroll
            for (int s2 = 0; s2 < 2; ++s2) {
                v4u pw; pw.x = pk2(p[kb][8 * s2 + 0], p[kb][8 * s2 + 1]); pw.y = pk2(p[kb][8 * s2 + 2], p[kb][8 * s2 + 3]); pw.z = pk2(p[kb][8 * s2 + 4], p[kb][8 * s2 + 5]); pw.w = pk2(p[kb][8 * s2 + 6], p[kb][8 * s2 + 7]);
                const bf16x8 pb = __builtin_bit_cast(bf16x8, pw);
                const bf16* vp = vbase + 64 * kt + 32 * kb + 16 * s2;
#pragma unroll
                for (int db = 0; db < 4; ++db) { const v2u v0 = *(const GAS v2u*)(vp + (size_t)(32 * db) * SEQ), v1 = *(const GAS v2u*)(vp + (size_t)(32 * db) * SEQ + 8);
                    v4u vw; vw.x = v0.x; vw.y = v0.y; vw.z = v1.x; vw.w = v1.y;
                    o[db] = __builtin_amdgcn_mfma_f32_32x32x16_bf16(__builtin_bit_cast(bf16x8, vw), pb, o[db], 0, 0, 0); }
            }
    }
    lsum += __shfl_xor(lsum, 32);
    const float inv = 1.0f / lsum;
    bf16* yrow = F.YA + row * ATTW + hh * HD + 4 * hi;
#pragma unroll
    for (int db = 0; db < 4; ++db)
#pragma unroll
        for (int rq = 0; rq < 4; ++rq) { v2u wv; wv.x = pk2(o[db][4 * rq] * inv, o[db][4 * rq + 1] * inv); wv.y = pk2(o[db][4 * rq + 2] * inv, o[db][4 * rq + 3] * inv);
            *(GAS v2u*)(yrow + 32 * db + 8 * rq) = wv; }
}

__device__ __forceinline__ void sgu_unit(Frame& F, int unit) {
    const int ck = unit >> 3, g = unit & 7, r0 = ck * GMC, c0 = g * GMGW, tid = F.tid;
    LAS unsigned* XB = (LAS unsigned*)(F.lds);
    LAS float* WT = (LAS float*)(F.lds + 65536);
    __syncthreads();
#pragma unroll
    for (int i = 0; i < 8; ++i) { const int c = tid + 512 * i, s = c >> 5, q = c & 31;
        *(LAS v4u*)(F.lds + s * 512 + q * 16) = *(const GAS v4u*)(F.PROJ + (size_t)(r0 + s) * PNP + PGV + c0 + 8 * q); }
#pragma unroll 4
    for (int i = 0; i < 32; ++i) { const int e = tid + 512 * i, s = e >> 7, t = e & 127;
        WT[e] = (s <= t) ? F.SWT[(g * GMC + s) * GMC + t] * F.RS[r0 + s] : 0.f; }
    __syncthreads();
    const int cp = tid & 127, tq = tid >> 7;
    const float sg0 = F.sgg[c0 + 2 * cp], sg1 = F.sgg[c0 + 2 * cp + 1];
    for (int pass = 0; pass < 4; ++pass) {
        const int t0 = 8 * (4 * pass + tq);
        float a0[8], a1[8];
#pragma unroll
        for (int j = 0; j < 8; ++j) { a0[j] = 0.f; a1[j] = 0.f; }
        for (int s = 0; s < t0 + 8; ++s) {
            const unsigned xw = XB[s * 128 + cp]; const float x0 = bflo(xw), x1 = bfhi(xw);
            const f32x4 w0 = *(const LAS f32x4*)(WT + s * 128 + t0), w1 = *(const LAS f32x4*)(WT + s * 128 + t0 + 4);
#pragma unroll
            for (int j = 0; j < 4; ++j) { a0[j] += w0[j] * x0; a1[j] += w0[j] * x1; a0[4 + j] += w1[j] * x0; a1[4 + j] += w1[j] * x1; }
        }
#pragma unroll
        for (int j = 0; j < 8; ++j) { const int t = t0 + j; const float bb = F.sgb[g * GMC + t];
            const unsigned uw = *(const GAS unsigned*)(F.PROJ + (size_t)(r0 + t) * PNP + PGU + c0 + 2 * cp);
            *(GAS unsigned*)(F.YB + (size_t)(r0 + t) * GMW + c0 + 2 * cp) = pk2(bflo(uw) * (a0[j] * sg0 + bb), bfhi(uw) * (a1[j] * sg1 + bb)); }
    }
}

using pg8::Unit; using pg8::cvt_pk_bf16;
struct EpiProj {
    static constexpr bool PERM = true; bf16* O;
    __device__ __forceinline__ void operator()(const f32x4 (&acc)[2][2][4][2], const Unit& u, int wr, int wc, int fr, int fq) const {
        const int act = (u.pn >= PGU / 256 && u.pn < PGA / 256) ? 1 : ((u.pn >= PGA / 256 && u.pn < PKI / 256) ? 2 : 0);
        const int row0 = u.pm * 256 + wr * 64 + fr, col0 = u.pn * 256 + wc * 32 + 8 * fq;
#pragma unroll
        for (int ai = 0; ai < 2; ++ai)
#pragma unroll
            for (int m = 0; m < 4; ++m) { bf16* rowp = O + (size_t)(row0 + ai * 128 + m * 16) * PNP + col0;
#pragma unroll
                for (int bj = 0; bj < 2; ++bj) { f32x4 v0 = acc[ai][bj][m][0], v1 = acc[ai][bj][m][1];
                    if (act == 1) { const pg8::f32x2 a = pg8::gelu_pk((pg8::f32x2){v0[0], v0[1]}), b = pg8::gelu_pk((pg8::f32x2){v0[2], v0[3]}), c = pg8::gelu_pk((pg8::f32x2){v1[0], v1[1]}), d = pg8::gelu_pk((pg8::f32x2){v1[2], v1[3]});
                        v0 = (f32x4){a.x, a.y, b.x, b.y}; v1 = (f32x4){c.x, c.y, d.x, d.y}; }
                    else if (act == 2) {
#pragma unroll
                        for (int j = 0; j < 4; ++j) { v0[j] = pg8::sigmoidf_(v0[j]); v1[j] = pg8::sigmoidf_(v1[j]); } }
                    v4u w; w.x = cvt_pk_bf16(v0[0], v0[1]); w.y = cvt_pk_bf16(v0[2], v0[3]); w.z = cvt_pk_bf16(v1[0], v1[1]); w.w = cvt_pk_bf16(v1[2], v1[3]);
                    *(GAS v4u*)(rowp + bj * 128) = w; } }
    }
};
struct EpiGateA {
    static constexpr bool PERM = true; const bf16* P; float* T;
    __device__ __forceinline__ void operator()(const f32x4 (&acc)[2][2][4][2], const Unit& u, int wr, int wc, int fr, int fq) const {
        const int row0 = u.pm * 256 + wr * 64 + fr, col0 = u.pn * 256 + wc * 32 + 8 * fq;
#pragma unroll
        for (int ai = 0; ai < 2; ++ai)
#pragma unroll
            for (int m = 0; m < 4; ++m) { const size_t r = (size_t)(row0 + ai * 128 + m * 16);
#pragma unroll
                for (int bj = 0; bj < 2; ++bj) { const v4u gw = *(const GAS v4u*)(P + r * PNP + PGA + col0 + bj * 128);
                    f32x4 v0 = acc[ai][bj][m][0], v1 = acc[ai][bj][m][1];
                    v0 = v0 * (f32x4){bflo(gw.x), bfhi(gw.x), bflo(gw.y), bfhi(gw.y)}; v1 = v1 * (f32x4){bflo(gw.z), bfhi(gw.z), bflo(gw.w), bfhi(gw.w)};
                    GAS f32x4* tp = (GAS f32x4*)(T + r * DM + col0 + bj * 128); tp[0] = v0; tp[1] = v1; } }
    }
};
struct EpiGateB {
    static constexpr bool PERM = true; const bf16* P; const float* T; bf16* O;
    __device__ __forceinline__ void operator()(const f32x4 (&acc)[2][2][4][2], const Unit& u, int wr, int wc, int fr, int fq) const {
        const int row0 = u.pm * 256 + wr * 64 + fr, col0 = u.pn * 256 + wc * 32 + 8 * fq;
#pragma unroll
        for (int ai = 0; ai < 2; ++ai)
#pragma unroll
            for (int m = 0; m < 4; ++m) { const size_t r = (size_t)(row0 + ai * 128 + m * 16);
#pragma unroll
                for (int bj = 0; bj < 2; ++bj) { const v4u gw = *(const GAS v4u*)(P + r * PNP + PGB + col0 + bj * 128);
                    const GAS f32x4* tp = (const GAS f32x4*)(T + r * DM + col0 + bj * 128);
                    const f32x4 v0 = tp[0] + acc[ai][bj][m][0] * (f32x4){bflo(gw.x), bfhi(gw.x), bflo(gw.y), bfhi(gw.y)};
                    const f32x4 v1 = tp[1] + acc[ai][bj][m][1] * (f32x4){bflo(gw.z), bfhi(gw.z), bflo(gw.w), bfhi(gw.w)};
                    v4u w; w.x = cvt_pk_bf16(v0[0], v0[1]); w.y = cvt_pk_bf16(v0[2], v0[3]); w.z = cvt_pk_bf16(v1[0], v1[1]); w.w = cvt_pk_bf16(v1[2], v1[3]);
                    *(GAS v4u*)(O + r * DM + col0 + bj * 128) = w; } }
    }
};
struct EpiResid {
    static constexpr bool PERM = false; const float* base; const float* gate; float* C;
    __device__ __forceinline__ void operator()(const f32x4 (&acc)[2][2][4][2], const Unit& u, int wr, int wc, int fr, int fq) const {
        const int row0 = u.pm * 256 + wr * 64 + fr, col0 = u.pn * 256 + wc * 32 + 4 * fq; const float* gp = gate + (u.pm >> 3) * MODW + col0;
        f32x4 gv[2][2];
#pragma unroll
        for (int bj = 0; bj < 2; ++bj)
#pragma unroll
            for (int n = 0; n < 2; ++n) gv[bj][n] = *(const GAS f32x4*)(gp + bj * 128 + n * 16);
#pragma unroll
        for (int ai = 0; ai < 2; ++ai)
#pragma unroll
            for (int m = 0; m < 4; ++m) { const size_t off = (size_t)(row0 + ai * 128 + m * 16) * DM + col0;
#pragma unroll
                for (int bj = 0; bj < 2; ++bj)
#pragma unroll
                    for (int n = 0; n < 2; ++n) { const f32x4 bs = *(const GAS f32x4*)(base + off + bj * 128 + n * 16);
                        *(GAS f32x4*)(C + off + bj * 128 + n * 16) = bs + gv[bj][n] * acc[ai][bj][m][n]; } }
    }
};
struct EpiPlain {
    static constexpr bool PERM = true; bf16* O; int ldc;
    __device__ __forceinline__ void operator()(const f32x4 (&acc)[2][2][4][2], const Unit& u, int wr, int wc, int fr, int fq) const {
        const int row0 = u.pm * 256 + wr * 64 + fr, col0 = u.pn * 256 + wc * 32 + 8 * fq;
#pragma unroll
        for (int ai = 0; ai < 2; ++ai)
#pragma unroll
            for (int m = 0; m < 4; ++m) { bf16* rowp = O + (size_t)(row0 + ai * 128 + m * 16) * ldc + col0;
#pragma unroll
                for (int bj = 0; bj < 2; ++bj) { const f32x4 v0 = acc[ai][bj][m][0], v1 = acc[ai][bj][m][1];
                    v4u w; w.x = cvt_pk_bf16(v0[0], v0[1]); w.y = cvt_pk_bf16(v0[2], v0[3]); w.z = cvt_pk_bf16(v1[0], v1[1]); w.w = cvt_pk_bf16(v1[2], v1[3]);
                    *(GAS v4u*)(rowp + bj * 128) = w; } }
    }
};

__device__ __forceinline__ void conv_phase(Frame& F) {
    constexpr int C8 = DFF / 8, TB = 16, NTB = M / TB;
    const size_t total = (size_t)C8 * NTB;
    for (size_t idx = (size_t)F.gw * 64 + F.lane; idx < total; idx += (size_t)F.NGW * 64) {
        const int c8 = (int)(idx % C8), tb = (int)(idx / C8), ch = 8 * c8, t0 = tb * TB;
        const int acol = (ch >> 7) * 256 + (ch & 127);
        float wg[3][8], wv[3][8], bg[8], bv[8];
#pragma unroll
        for (int j = 0; j < 3; ++j) { const f32x4 a = *(const GAS f32x4*)(F.cvw + (size_t)j * F2 + ch), b = *(const GAS f32x4*)(F.cvw + (size_t)j * F2 + ch + 4);
            const f32x4 c = *(const GAS f32x4*)(F.cvw + (size_t)j * F2 + DFF + ch), d = *(const GAS f32x4*)(F.cvw + (size_t)j * F2 + DFF + ch + 4);
#pragma unroll
            for (int e = 0; e < 4; ++e) { wg[j][e] = a[e]; wg[j][4 + e] = b[e]; wv[j][e] = c[e]; wv[j][4 + e] = d[e]; } }
        { const f32x4 a = *(const GAS f32x4*)(F.cvb + ch), b = *(const GAS f32x4*)(F.cvb + ch + 4), c = *(const GAS f32x4*)(F.cvb + DFF + ch), d = *(const GAS f32x4*)(F.cvb + DFF + ch + 4);
#pragma unroll
          for (int e = 0; e < 4; ++e) { bg[e] = a[e]; bg[4 + e] = b[e]; bv[e] = c[e]; bv[4 + e] = d[e]; } }
        float g1[8], g2[8], v1[8], v2[8];
        const bool first = (t0 & (SEQ - 1)) == 0;
        const bf16* ap = F.A + (size_t)t0 * F2 + acol;
        if (first) {
#pragma unroll
            for (int e = 0; e < 8; ++e) { g1[e] = g2[e] = v1[e] = v2[e] = 0.f; }
        } else {
            const v4u ga = *(const GAS v4u*)(ap - F2), gb = *(const GAS v4u*)(ap - 2 * (size_t)F2), va = *(const GAS v4u*)(ap - F2 + 128), vb = *(const GAS v4u*)(ap - 2 * (size_t)F2 + 128);
#pragma unroll
            for (int e = 0; e < 4; ++e) { g1[2 * e] = bflo(ga[e]); g1[2 * e + 1] = bfhi(ga[e]); g2[2 * e] = bflo(gb[e]); g2[2 * e + 1] = bfhi(gb[e]);
                v1[2 * e] = bflo(va[e]); v1[2 * e + 1] = bfhi(va[e]); v2[2 * e] = bflo(vb[e]); v2[2 * e + 1] = bfhi(vb[e]); }
        }
#pragma unroll 4
        for (int i = 0; i < TB; ++i) {
            const v4u gw = *(const GAS v4u*)(ap + (size_t)i * F2), vw = *(const GAS v4u*)(ap + (size_t)i * F2 + 128);
            float g0[8], v0[8], y[8];
#pragma unroll
            for (int e = 0; e < 4; ++e) { g0[2 * e] = bflo(gw[e]); g0[2 * e + 1] = bfhi(gw[e]); v0[2 * e] = bflo(vw[e]); v0[2 * e + 1] = bfhi(vw[e]); }
#pragma unroll
            for (int e = 0; e < 8; ++e) { const float gt = bg[e] + wg[0][e] * g2[e] + wg[1][e] * g1[e] + wg[2][e] * g0[e];
                const float vl = bv[e] + wv[0][e] * v2[e] + wv[1][e] * v1[e] + wv[2][e] * v0[e];
                y[e] = gt * pg8::sigmoidf_(gt) * vl; g2[e] = g1[e]; g1[e] = g0[e]; v2[e] = v1[e]; v1[e] = v0[e]; }
            v4u o; o.x = pk2(y[0], y[1]); o.y = pk2(y[2], y[3]); o.z = pk2(y[4], y[5]); o.w = pk2(y[6], y[7]);
            *(GAS v4u*)(F.ACT + (size_t)(t0 + i) * DFF + ch) = o;
        }
    }
}

constexpr int N_PHASES = 11;
struct Args { const float* in[19]; float* out; unsigned char* ws; int ph_lo, ph_hi, li, pad; };
__global__ void __launch_bounds__(NWAVES * 64, 2) mega_fwd(Args args) {
    extern __shared__ __attribute__((aligned(16))) unsigned char lds[];
    Frame F;
    F.lds = (LAS unsigned char*)lds;
    F.MISC = (volatile LAS unsigned*)(F.lds + MISC_OFF);
    F.tid = threadIdx.x; F.lane = F.tid & 63; F.wave = __builtin_amdgcn_readfirstlane(F.tid >> 6);
    F.G = gridDim.x; F.gw = blockIdx.x * NWAVES + F.wave; F.NGW = F.G * NWAVES;
    unsigned char* ws = args.ws;
    F.ctl = (gu32*)(ws + WS_CTL);
    F.x = args.in[0]; F.c = args.in[1]; F.ada_w = args.in[2]; F.ada_b = args.in[3]; F.n1g = args.in[4]; F.w_in = args.in[5]; F.qng = args.in[6]; F.kng = args.in[7];
    F.sgg = args.in[8]; F.sgw = args.in[9]; F.sgb = args.in[10]; F.w_a = args.in[11]; F.w_b = args.in[12]; F.w_out = args.in[13]; F.n2g = args.in[14]; F.w_up = args.in[15];
    F.cvw = args.in[16]; F.cvb = args.in[17]; F.w_dn = args.in[18]; F.out = args.out;
    F.MOD = (float*)(ws + WS_MOD); F.WIN = (bf16*)(ws + WS_WIN); F.WA = (bf16*)(ws + WS_WA); F.WB = (bf16*)(ws + WS_WB); F.WOUT = (bf16*)(ws + WS_WOUT); F.WUP = (bf16*)(ws + WS_WUP); F.WDN = (bf16*)(ws + WS_WDN);
    F.H = (bf16*)(ws + WS_H); F.X1 = (float*)(ws + WS_X1); F.PROJ = (bf16*)(ws + WS_PROJ); F.MASK = (unsigned*)(ws + WS_MASK); F.RS = (float*)(ws + WS_RS); F.SWT = (float*)(ws + WS_SWT);
    F.VT = (bf16*)(ws + WS_VT); F.YA = (bf16*)(ws + WS_YA); F.YB = (bf16*)(ws + WS_YB); F.MRG = (bf16*)(ws + WS_MRG); F.TMP = (float*)(ws + WS_TMP); F.A = (bf16*)(ws + WS_A); F.ACT = (bf16*)(ws + WS_ACT);
    for (int u = F.tid; u < (LDS_BYTES - LDSCTL_OFF) / 4; u += NWAVES * 64) ((LAS unsigned*)(F.lds + LDSCTL_OFF))[u] = 0u;
    __syncthreads();
    XcdBarrier bar; bar.bar = (unsigned*)(F.ctl + CW_BAR); bar.x = 0; bar.st = nullptr;
    if (MK_N_LAUNCHES == 1) bar = xcd_barrier_post((unsigned*)(F.ctl + CW_BAR), F.MISC + 8);
    const int lo = args.ph_lo, hi = args.ph_hi;
#define IN(k) (lo <= (k) && (k) < hi)
#define SEAM(k) do { if (IN(k) && IN((k) + 1)) xcd_barrier(bar); } while (0)

    if (IN(0)) { p0_prologue(F); } SEAM(0);
    if (IN(1)) { norm_rows(F, F.x, F.n1g, 0, DM, F.H); } SEAM(1);
    if (IN(2)) { pg8::Gemm g{F.H, F.WIN, M, PNP, DM, DM, DM}; pg8::StaticOrder S; S.init(M, PNP, F.G, (int)blockIdx.x); EpiProj E{F.PROJ};
        pg8::gemm_phase<EpiProj, pg8::StaticOrder, true>(F.lds + RING_OFF, g, S, E); } SEAM(2);
    if (IN(3)) {
        for (int row = F.gw; row < M; row += F.NGW) { idx_row(F, row); qknorm_row(F, row); }
        for (int it = F.gw; it < BATCH * NKV * 2 * 256; it += F.NGW) vt_item(F, it);
    } SEAM(3);
    if (IN(4)) {
        for (int p = blockIdx.x; p < 256; p += F.G) { const int bg = p >> 4, j = p & 15; attn_block(F, bg >> 2, bg & 3, j); attn_block(F, bg >> 2, bg & 3, 31 - j); }
        for (int u = blockIdx.x; u < 512; u += F.G) sgu_unit(F, u);
        __syncthreads();
    } SEAM(4);
    if (IN(5)) {
        { pg8::Gemm g{F.YA, F.WA, M, DM, ATTW, ATTW, ATTW}; pg8::StaticOrder S; S.init(M, DM, F.G, (int)blockIdx.x); EpiGateA E{F.PROJ, F.TMP};
          pg8::gemm_phase<EpiGateA, pg8::StaticOrder, true>(F.lds + RING_OFF, g, S, E); }
        VM_WAIT(); __syncthreads();
        { pg8::Gemm g{F.YB, F.WB, M, DM, GMW, GMW, GMW}; pg8::StaticOrder S; S.init(M, DM, F.G, (int)blockIdx.x); EpiGateB E{F.PROJ, F.TMP, F.MRG};
          pg8::gemm_phase<EpiGateB, pg8::StaticOrder, true>(F.lds + RING_OFF, g, S, E); }
    } SEAM(5);
    if (IN(6)) { pg8::Gemm g{F.MRG, F.WOUT, M, DM, DM, DM, DM}; pg8::StaticOrder S; S.init(M, DM, F.G, (int)blockIdx.x); EpiResid E{F.x, F.MOD + 2 * DM, F.X1};
        pg8::gemm_phase<EpiResid, pg8::StaticOrder, true>(F.lds + RING_OFF, g, S, E); } SEAM(6);
    if (IN(7)) { norm_rows(F, F.X1, F.n2g, 3 * DM, 4 * DM, F.H); } SEAM(7);
    if (IN(8)) { pg8::Gemm g{F.H, F.WUP, M, F2, DM, DM, DM}; pg8::StaticOrder S; S.init(M, F2, F.G, (int)blockIdx.x); EpiPlain E{F.A, F2};
        pg8::gemm_phase<EpiPlain, pg8::StaticOrder, true>(F.lds + RING_OFF, g, S, E); } SEAM(8);
    if (IN(9)) { conv_phase(F); } SEAM(9);
    if (IN(10)) { pg8::Gemm g{F.ACT, F.WDN, M, DM, DFF, DFF, DFF}; pg8::StaticOrder S; S.init(M, DM, F.G, (int)blockIdx.x); EpiResid E{F.X1, F.MOD + 5 * DM, F.out};
        pg8::gemm_phase<EpiResid, pg8::StaticOrder, true>(F.lds + RING_OFF, g, S, E); }
#undef IN
#undef SEAM
}

extern "C" void kernel_launch(void* const* d_in, const int* in_sizes, int n_in, void* d_out, int out_size, void* d_ws, size_t ws_size, hipStream_t stream) {
    static int grid = 0;
    if (grid == 0) {
        if (n_in != 19 || in_sizes[0] != M * DM || out_size != M * DM || ws_size < WS_END) { fprintf(stderr, "kernel_launch: unexpected shapes (n_in %d, in0 %d, out %d, ws %zu < %zu); nothing launched\n", n_in, n_in > 0 ? in_sizes[0] : -1, out_size, ws_size, (size_t)WS_END); grid = -1; return; }
        int dev = 0, cus = 0, per_cu = 0;
        if (hipGetDevice(&dev) != hipSuccess || hipDeviceGetAttribute(&cus, hipDeviceAttributeMultiprocessorCount, dev) != hipSuccess) { fprintf(stderr, "kernel_launch: device query failed\n"); grid = -1; return; }
        if (hipFuncSetAttribute((const void*)mega_fwd, hipFuncAttributeMaxDynamicSharedMemorySize, LDS_BYTES) != hipSuccess) { fprintf(stderr, "kernel_launch: hipFuncSetAttribute failed\n"); grid = -1; return; }
        if (hipOccupancyMaxActiveBlocksPerMultiprocessor(&per_cu, (const void*)mega_fwd, NWAVES * 64, LDS_BYTES) != hipSuccess || per_cu < 1) { fprintf(stderr, "kernel_launch: occupancy query reports %d blocks per CU\n", per_cu); }
        (void)hipGetLastError();
        grid = cus;
    }
    if (grid < 0) return;
    if (hipMemsetAsync((char*)d_ws + WS_CTL, 0, CTL_ZERO_BYTES, stream) != hipSuccess) { fprintf(stderr, "kernel_launch: memset failed\n"); return; }
    Args a{};
    for (int i = 0; i < 19; ++i) a.in[i] = (const float*)d_in[i];
    a.out = (float*)d_out; a.ws = (unsigned char*)d_ws; a.pad = 0;
    for (int li = 0; li < MK_N_LAUNCHES; ++li) {
        if (MK_N_LAUNCHES == 1) { a.ph_lo = 0; a.ph_hi = N_PHASES; } else { a.ph_lo = li; a.ph_hi = li + 1; }
        a.li = li;
        hipLaunchKernelGGL(mega_fwd, dim3(grid), dim3(NWAVES * 64), LDS_BYTES, stream, a);
        const hipError_t le = hipPeekAtLastError();
        if (le != hipSuccess) { fprintf(stderr, "kernel_launch: launch %d failed: %s\n", li, hipGetErrorName(le)); break; }
    }
}
```

```cpp
#include <hip/hip_runtime.h>
#include <cstdio>
#include <cstdint>

#ifndef MK_N_LAUNCHES
#define MK_N_LAUNCHES 1
#endif
#ifndef PROBE_MASK
#define PROBE_MASK 0x0
#endif

namespace pg8 {
#define PG8_LAS __attribute__((address_space(3)))
typedef unsigned short bf16_t;
typedef short bf16x8 __attribute__((ext_vector_type(8)));
typedef float f32x4 __attribute__((ext_vector_type(4)));
typedef float f32x2 __attribute__((ext_vector_type(2)));
typedef unsigned u32x4 __attribute__((ext_vector_type(4)));
typedef unsigned u32x2 __attribute__((ext_vector_type(2)));
constexpr int BM = 256, BK = 64, HALF = 128, HTB = HALF * BK * 2, STAGE_BYTES = 8 * HTB, NXCD = 8, WGM = 8;

__host__ __device__ __forceinline__ int lds_byte(int r, int c) { const int st = (r >> 4) * 2 + (c >> 5), rr = r & 15, cc = c & 31, ob = rr * 64 + cc * 2; return st * 1024 + (ob ^ (((ob >> 9) & 1) << 5)); }
__host__ __device__ __forceinline__ void stage_rc(int b, int& R, int& C) { const int st = b / 1024, sb = b % 1024, swz = sb ^ (((sb >> 9) & 1) << 5); R = (st >> 1) * 16 + swz / 64; C = (st & 1) * 32 + (swz % 64) / 2; }
__host__ __device__ __forceinline__ int perm32(int rho) { const int n = rho >> 4, i = rho & 15; return 8 * (i >> 2) + 4 * n + (i & 3); }

struct Unit { int pm, pn; };
struct Gemm { const bf16_t* A; const bf16_t* Bt; int M, N, K, lda, ldb; };

struct StaticOrder {
    int nM, nN, nwg, G, c;
    __host__ __device__ void init(int M, int N, int G_, int c_) { nM = M / BM; nN = N / BM; nwg = nM * nN; G = G_; c = c_; }
    __host__ __device__ bool next(int i, Unit& u) const {
        const long L = (long)i * G + c; if (L >= nwg) return false;
        int wgid = (int)L; { const int q = nwg / NXCD, r = nwg % NXCD, xcd = wgid % NXCD, off = wgid / NXCD; wgid = (xcd < r ? xcd * (q + 1) : r * (q + 1) + (xcd - r) * q) + off; }
        const int nig = WGM * nN, gid = wgid / nig, fm = gid * WGM, gsz = (nM - fm) < WGM ? (nM - fm) : WGM;
        u.pm = fm + ((wgid % nig) % gsz); u.pn = (wgid % nig) / gsz; return true;
    }
    __device__ __forceinline__ void a_ready(const Unit&) const {}
    __device__ __forceinline__ void done(const Unit&) const {}
};

__device__ __forceinline__ unsigned cvt_pk_bf16(float lo, float hi) { unsigned r; asm volatile("v_cvt_pk_bf16_f32 %0, %1, %2" : "=v"(r) : "v"(lo), "v"(hi)); return r; }
__device__ __forceinline__ f32x2 gelu_pk(f32x2 v) {
    const f32x2 av = __builtin_elementwise_abs(v), d = av * 0.2316418882f + 1.0f;
    f32x2 t; t.x = __builtin_amdgcn_rcpf(d.x); t.y = __builtin_amdgcn_rcpf(d.y);
    f32x2 q = t * 0.5307027145f + (-0.7265760135f); q = q * t + 0.7107068705f; q = q * t + (-0.142248368f); q = q * t + 0.127414796f; q = q * t;
    const f32x2 s = (v * v) * (-0.72134752044f);
    f32x2 e; e.x = __builtin_amdgcn_exp2f(s.x); e.y = __builtin_amdgcn_exp2f(s.y);
    const f32x2 m = v * (q * e), r = v - m;
    f32x2 o; o.x = v.x < 0.f ? m.x : r.x; o.y = v.y < 0.f ? m.y : r.y; return o;
}
__device__ __forceinline__ float sigmoidf_(float x) { return __builtin_amdgcn_rcpf(1.0f + __builtin_amdgcn_exp2f(-1.4426950408889634f * x)); }
__device__ __forceinline__ float bflo(unsigned w) { return __builtin_bit_cast(float, w << 16); }
__device__ __forceinline__ float bfhi(unsigned w) { return __builtin_bit_cast(float, w & 0xffff0000u); }

typedef int i32x8 __attribute__((ext_vector_type(8)));
typedef int i32x4 __attribute__((ext_vector_type(4)));
template <class Epi, class Sched, bool ALIGN_EPI, int ES = 2>
__device__ __forceinline__ void gemm_phase(PG8_LAS unsigned char* lds, const Gemm g, const Sched& S, const Epi& E) {
    const int tid = threadIdx.x, wid = __builtin_amdgcn_readfirstlane(tid >> 6), lane = tid & 63, wr = wid >> 2, wc = wid & 3, fr = lane & 15, fq = lane >> 4;
    const int K = g.K, nt = K * ES / (BK * 2);
    unsigned voffA[2], voffB[2];
#pragma unroll
    for (int i = 0; i < 2; ++i) { int R, C; stage_rc(tid * 16 + i * 8192, R, C); const int Rb = Epi::PERM ? ((R & ~31) + perm32(R & 31)) : R;
        voffA[i] = (unsigned)(R * g.lda) * (unsigned)ES + (unsigned)C * 2u; voffB[i] = (unsigned)(Rb * g.ldb) * (unsigned)ES + (unsigned)C * 2u; }
    const size_t kstep = (size_t)(BK * 2);
    const size_t hstepA = (size_t)HALF * g.lda * ES, hstepB = (size_t)HALF * g.ldb * ES;
    const size_t tstepA = 2 * hstepA, tstepB = 2 * hstepB;
    const unsigned ldsw = (unsigned)wid * 1024u;
    const int aoff = lds_byte(wr * 64 + fr, fq * 8), boff = lds_byte(wc * 32 + fr, fq * 8);
#define PG8_SA(b, h) (((b) * 2 + (h)) * HTB)
#define PG8_SB(b, h) ((4 + (b) * 2 + (h)) * HTB)
#define PG8_STAGE(bufoff, gbase, voff) do { _Pragma("unroll") for (int _i = 0; _i < 2; ++_i) \
        __builtin_amdgcn_global_load_lds((const unsigned*)((const char*)(gbase) + (voff)[_i]), (PG8_LAS unsigned*)(lds + (bufoff) + ldsw + _i * 8192), 16, 0, 0); } while (0)
#define PG8_CAT(x, y) __builtin_shufflevector(x, y, 0, 1, 2, 3, 4, 5, 6, 7)
#define PG8_LO(v) __builtin_bit_cast(bf16x8, __builtin_shufflevector(v, v, 0, 1, 2, 3))
#define PG8_HI(v) __builtin_bit_cast(bf16x8, __builtin_shufflevector(v, v, 4, 5, 6, 7))
#define PG8_LDA(dst, b, h) do { _Pragma("unroll") for (int m = 0; m < 4; ++m) { const i32x4 _l = *(const PG8_LAS i32x4*)(lds + PG8_SA(b, h) + aoff + m * 2048), _h = *(const PG8_LAS i32x4*)(lds + PG8_SA(b, h) + aoff + m * 2048 + 1024); dst[m] = PG8_CAT(_l, _h); } } while (0)
#define PG8_LDB(dst, b, h) do { _Pragma("unroll") for (int n = 0; n < 2; ++n) { const i32x4 _l = *(const PG8_LAS i32x4*)(lds + PG8_SB(b, h) + boff + n * 2048), _h = *(const PG8_LAS i32x4*)(lds + PG8_SB(b, h) + boff + n * 2048 + 1024); dst[n] = PG8_CAT(_l, _h); } } while (0)
#define PG8_MMA(ai, bj, At, Bt) do { __builtin_amdgcn_s_setprio(1); _Pragma("unroll") for (int m = 0; m < 4; ++m) _Pragma("unroll") for (int n = 0; n < 2; ++n) { \
        if constexpr (ES == 2) { acc[ai][bj][m][n] = __builtin_amdgcn_mfma_f32_16x16x32_bf16(PG8_LO(Bt[n]), PG8_LO(At[m]), acc[ai][bj][m][n], 0, 0, 0); \
                                 acc[ai][bj][m][n] = __builtin_amdgcn_mfma_f32_16x16x32_bf16(PG8_HI(Bt[n]), PG8_HI(At[m]), acc[ai][bj][m][n], 0, 0, 0); } \
        else asm volatile("v_mfma_f32_16x16x128_f8f6f4 %0, %1, %2, %0" : "+v"(acc[ai][bj][m][n]) : "v"(Bt[n]), "v"(At[m])); } __builtin_amdgcn_s_setprio(0); } while (0)
#define PG8_WAIT_V(n) asm volatile("s_waitcnt vmcnt(" #n ")" ::: "memory")
#define PG8_WAIT_L(n) asm volatile("s_waitcnt lgkmcnt(" #n ")" ::: "memory")
#define PG8_BAR __builtin_amdgcn_s_barrier()
#define PG8_SCHED __builtin_amdgcn_sched_barrier(0)
    Unit cur, nxt; int ui = 0;
    if (!S.next(0, cur)) return;
    f32x4 acc[2][2][4][2];
#pragma unroll
    for (int a = 0; a < 2; ++a)
#pragma unroll
        for (int b = 0; b < 2; ++b)
#pragma unroll
            for (int m = 0; m < 4; ++m)
#pragma unroll
                for (int n = 0; n < 2; ++n) acc[a][b][m][n] = (f32x4){0.f, 0.f, 0.f, 0.f};
    i32x8 At[4], B0[2], B1[2];
    const char* cA = (const char*)g.A + (size_t)cur.pm * tstepA; const char* cB = (const char*)g.Bt + (size_t)cur.pn * tstepB;
    S.a_ready(cur);
    PG8_STAGE(PG8_SB(0, 0), cB, voffB); PG8_STAGE(PG8_SB(0, 1), cB + hstepB, voffB); PG8_STAGE(PG8_SA(0, 0), cA, voffA); PG8_STAGE(PG8_SA(0, 1), cA + hstepA, voffA);
    if (wr == 1) PG8_BAR;
    PG8_WAIT_V(2); PG8_BAR;
    PG8_STAGE(PG8_SB(1, 0), cB + kstep, voffB); PG8_STAGE(PG8_SA(1, 0), cA + kstep, voffA); PG8_STAGE(PG8_SB(1, 1), cB + hstepB + kstep, voffB);
    PG8_WAIT_V(6); PG8_BAR;
    for (;;) {
        const bool has_next = S.next(ui + 1, nxt);
        const char* nA = has_next ? (const char*)g.A + (size_t)nxt.pm * tstepA : cA; const char* nB = has_next ? (const char*)g.Bt + (size_t)nxt.pn * tstepB : cB;
        for (int t = 0; t < nt; t += 2) {
            const bool last = (t == nt - 2);
            const char* a1 = cA + (size_t)(t + 1) * kstep;
            const char* a2 = last ? nA : cA + (size_t)(t + 2) * kstep; const char* b2 = last ? nB : cB + (size_t)(t + 2) * kstep;
            const char* a3 = a2 + kstep; const char* b3 = b2 + kstep;
            if (last && has_next) S.a_ready(nxt);
            PG8_LDB(B0, 0, 0); PG8_LDB(B1, 0, 1); PG8_SCHED; PG8_LDA(At, 0, 0); PG8_STAGE(PG8_SA(1, 1), a1 + hstepA, voffA);
            PG8_WAIT_V(8); PG8_WAIT_L(0); PG8_BAR; PG8_MMA(0, 0, At, B0); PG8_MMA(0, 1, At, B1); PG8_BAR; PG8_SCHED;
            PG8_LDA(At, 0, 1); PG8_STAGE(PG8_SB(0, 0), b2, voffB); PG8_STAGE(PG8_SB(0, 1), b2 + hstepB, voffB); PG8_STAGE(PG8_SA(0, 0), a2, voffA);
            PG8_WAIT_V(8); PG8_WAIT_L(0); PG8_BAR; PG8_MMA(1, 0, At, B0); PG8_MMA(1, 1, At, B1); PG8_BAR; PG8_SCHED;
            PG8_LDB(B0, 1, 0); PG8_LDB(B1, 1, 1); PG8_SCHED; PG8_LDA(At, 1, 0); PG8_STAGE(PG8_SA(0, 1), a2 + hstepA, voffA);
            PG8_WAIT_V(8); PG8_WAIT_L(0); PG8_BAR; PG8_MMA(0, 0, At, B0); PG8_MMA(0, 1, At, B1); PG8_BAR; PG8_SCHED;
            PG8_LDA(At, 1, 1); PG8_STAGE(PG8_SB(1, 0), b3, voffB); PG8_STAGE(PG8_SB(1, 1), b3 + hstepB, voffB); PG8_STAGE(PG8_SA(1, 0), a3, voffA);
            PG8_WAIT_V(8); PG8_WAIT_L(0); PG8_BAR; PG8_MMA(1, 0, At, B0); PG8_MMA(1, 1, At, B1); PG8_BAR; PG8_SCHED;
        }
        if constexpr (ALIGN_EPI) { if (wr == 0) PG8_BAR; }
        if constexpr (ES == 1) asm volatile("s_nop 15\n\ts_nop 15" ::: "memory");
        E(acc, cur, wr, wc, fr, fq); S.done(cur);
        if (!has_next) break;
#pragma unroll
        for (int a = 0; a < 2; ++a)
#pragma unroll
            for (int b = 0; b < 2; ++b)
#pragma unroll
                for (int m = 0; m < 4; ++m)
#pragma unroll
                    for (int n = 0; n < 2; ++n) acc[a][b][m][n] = (f32x4){0.f, 0.f, 0.f, 0.f};
        cur = nxt; cA = nA; cB = nB; ++ui;
        if constexpr (ALIGN_EPI) { if (wr == 1) PG8_BAR; }
    }
    PG8_WAIT_V(0);
    if constexpr (!ALIGN_EPI) { if (wr == 0) PG8_BAR; }
    PG8_BAR;
#undef PG8_SA
#undef PG8_SB
#undef PG8_STAGE
#undef PG8_LDA
#undef PG8_CAT
#undef PG8_LO
#undef PG8_HI
#undef PG8_LDB
#undef PG8_MMA
#undef PG8_WAIT_V
#undef PG8_WAIT_L
#undef PG8_BAR
#undef PG8_SCHED
}
}

constexpr int NWAVES = 8;
constexpr int BATCH = 4, SEQ = 2048, DM = 4096, M = BATCH * SEQ;
constexpr int NH = 16, HD = 128, NKV = 4, ATTW = 2048, KVW = 512, IH = 32, IDIM = 64, TOPK = 256;
constexpr int GMW = 2048, GMG = 8, GMGW = 256, GMC = 128, DFF = 11008, F2 = 2 * DFF;
constexpr int IN_W = 17504, MODW = 6 * DM;
constexpr float EPS = 1e-6f;
constexpr int PQ = 0, PK = 2048, PV = 2560, PQI = 3072, PGU = 5120, PGV = 7168, PGA = 9216, PGB = 13312, PKI = 17408, PWI = 17472, PNP = 17664;
constexpr int SQ = 0, SK = 2048, SV = 2560, SQI = 3072, SKI = 5120, SWI = 5184, SGU = 5216, SGV = 7264, SGA = 9312, SGB = 13408;

constexpr size_t MiB = 1u << 20;
constexpr size_t WS_CTL = 0, CTL_ZERO_BYTES = 2 * MiB;
constexpr size_t WS_MOD = 1 * MiB;
constexpr size_t WS_WIN = 2 * MiB;
constexpr size_t WS_WA = 140 * MiB, WS_WB = 156 * MiB;
constexpr size_t WS_WOUT = 172 * MiB;
constexpr size_t WS_WUP = 204 * MiB;
constexpr size_t WS_WDN = 376 * MiB;
constexpr size_t WS_H = 462 * MiB;
constexpr size_t WS_X1 = 526 * MiB;
constexpr size_t WS_PROJ = 654 * MiB;
constexpr size_t WS_MASK = 930 * MiB;
constexpr size_t WS_RS = 932 * MiB;
constexpr size_t WS_SWT = 932 * MiB + 65536;
constexpr size_t WS_VT = 933 * MiB;
constexpr size_t WS_YA = 941 * MiB, WS_YB = 973 * MiB;
constexpr size_t WS_MRG = 1005 * MiB;
constexpr size_t WS_TMP = 1069 * MiB;
constexpr size_t WS_A = 654 * MiB;
constexpr size_t WS_ACT = 998 * MiB;
constexpr size_t WS_END = 1197 * MiB;
static_assert(WS_WIN + (size_t)PNP * DM * 2 <= WS_WA && WS_WUP + (size_t)F2 * DM * 2 <= WS_WDN && WS_WDN + (size_t)DM * DFF * 2 <= WS_H, "ws map 1");
static_assert(WS_PROJ + (size_t)M * PNP * 2 <= WS_MASK && WS_A + (size_t)M * F2 * 2 <= WS_ACT && WS_ACT + (size_t)M * DFF * 2 <= WS_END && WS_TMP + (size_t)M * DM * 4 <= WS_END, "ws map 2");
constexpr int CW_TMO = 0, CW_CODE = 1, CW_BAR = 4096;

constexpr int RING_OFF = 0, RING_BYTES = 131072;
constexpr int LDSCTL_OFF = RING_BYTES + 8192, MISC_OFF = LDSCTL_OFF + 320;
constexpr int LDS_BYTES = 147456;
static_assert(MISC_OFF + 128 <= LDS_BYTES, "LDS map");

#define GAS __attribute__((address_space(1)))
#define LAS __attribute__((address_space(3)))
typedef unsigned short bf16;
typedef unsigned v4u __attribute__((ext_vector_type(4)));
typedef unsigned v2u __attribute__((ext_vector_type(2)));
typedef float f32x4 __attribute__((ext_vector_type(4)));
typedef float f32x16 __attribute__((ext_vector_type(16)));
typedef short bf16x8 __attribute__((ext_vector_type(8)));
typedef short bf16x4 __attribute__((ext_vector_type(4)));
typedef GAS unsigned gu32;
#define RLX_AGENT __ATOMIC_RELAXED, __HIP_MEMORY_SCOPE_AGENT
#define LDS_WAIT() asm volatile("s_waitcnt lgkmcnt(0)" ::: "memory")
#define VM_WAIT() asm volatile("s_waitcnt vmcnt(0)" ::: "memory")
__device__ __forceinline__ unsigned f2bf(float f) { unsigned u = __builtin_bit_cast(unsigned, f); return (u + 0x7fffu + ((u >> 16) & 1u)) >> 16; }
__device__ __forceinline__ unsigned pk2(float lo, float hi) { return f2bf(lo) | (f2bf(hi) << 16); }
__device__ __forceinline__ float bf2f(bf16 h) { return __builtin_bit_cast(float, (unsigned)h << 16); }
using pg8::bflo; using pg8::bfhi;
constexpr float S_H2 = 16.f, S_WUP = 1024.f, S_ACT = 4.f, S_WDN = 1024.f;
__device__ __forceinline__ float clamp448(float x) { return __builtin_amdgcn_fmed3f(x, -448.f, 448.f); }
__device__ __forceinline__ unsigned pk4_fp8(float a, float b, float c, float d) {
    int w = __builtin_amdgcn_cvt_pk_fp8_f32(clamp448(a), clamp448(b), 0, false);
    w = __builtin_amdgcn_cvt_pk_fp8_f32(clamp448(c), clamp448(d), w, true);
    return (unsigned)w;
}

#define XB_TMO      128
#define XB_XCNT(j)  (256  + 64 * (j))
#define XB_XSUB(j)  (1280 + 64 * (j))
#define XB_XGEN(j)  (2304 + 64 * (j))
#define XB_TOP      3328
#define XB_TOPGEN   3392
#define XCD_BAR_WORDS 3456
#define XB_SPIN_CAP (1u << 18)
__device__ __forceinline__ unsigned xb_ld(unsigned* p)              { return __hip_atomic_load(p, __ATOMIC_RELAXED, __HIP_MEMORY_SCOPE_AGENT); }
__device__ __forceinline__ unsigned xb_add(unsigned* p, unsigned v) { return __hip_atomic_fetch_add(p, v, __ATOMIC_RELAXED, __HIP_MEMORY_SCOPE_AGENT); }
__device__ __forceinline__ unsigned xb_xcc_id() { return (unsigned)__builtin_amdgcn_s_getreg((3 << 11) | 20) & 0xFu; }
#define XB_SPIN(cond, bar) do { unsigned _sp = 0; while (cond) { __builtin_amdgcn_s_sleep(1); \
    if ((++_sp & 255u) == 0u) { if (xb_ld(&(bar)[XB_TMO])) break; if (_sp > XB_SPIN_CAP) { atomicAdd(&(bar)[XB_TMO], 1u); break; } } } } while (0)
struct XcdBarrier { unsigned* bar; unsigned x; volatile LAS unsigned* st; };
__device__ __forceinline__ XcdBarrier xcd_barrier_post(unsigned* bar, volatile LAS unsigned* st) {
    XcdBarrier b; b.bar = bar; b.x = xb_xcc_id(); b.st = st;
    if (threadIdx.x == 0) (void)xb_add(&bar[XB_XCNT(b.x)], 1u);
    return b;
}
__device__ __forceinline__ void xcd_barrier_complete(unsigned* bar, unsigned x, unsigned& nloc, unsigned& nx) {
    const unsigned G = gridDim.x * gridDim.y * gridDim.z;
    unsigned sum, cnt, mine, sp = 0u;
    for (;;) {
        sum = 0u; cnt = 0u; mine = 0u;
#pragma unroll
        for (unsigned j = 0; j < 16; ++j) { const unsigned c = xb_ld(&bar[XB_XCNT(j)]); sum += c; cnt += (c > 0u) ? 1u : 0u; mine = (j == x) ? c : mine; }
        if (sum == G) break;
        __builtin_amdgcn_s_sleep(1);
        if ((++sp & 255u) == 0u) { if (xb_ld(&bar[XB_TMO])) break; if (sp > XB_SPIN_CAP) { atomicAdd(&bar[XB_TMO], 1u); break; } }
    }
    nloc = mine > 0u ? mine : 1u; nx = cnt > 0u ? cnt : 1u;
}
__device__ __forceinline__ void xcd_barrier(const XcdBarrier& b) {
    asm volatile("s_waitcnt vmcnt(0)" ::: "memory");
    __syncthreads();
    if (threadIdx.x == 0) {
        unsigned* bar = b.bar;
        __builtin_amdgcn_s_waitcnt(0);
        unsigned nloc = b.st[0], nx = b.st[1];
        if (nloc == 0u) { xcd_barrier_complete(bar, b.x, nloc, nx); b.st[0] = nloc; b.st[1] = nx; }
        const unsigned old = xb_add(&bar[XB_XSUB(b.x)], 1u);
        const unsigned gen = old / nloc;
        if (old + 1u == (gen + 1u) * nloc) {
            __builtin_amdgcn_fence(__ATOMIC_RELEASE, "agent");
            asm volatile("s_waitcnt vmcnt(0)" ::: "memory");
            const unsigned og = xb_add(&bar[XB_TOP], 1u);
            const unsigned tg = og / nx;
            if (og + 1u == (tg + 1u) * nx) xb_add(&bar[XB_TOPGEN], 1u);
            else XB_SPIN(xb_ld(&bar[XB_TOPGEN]) == tg, bar);
            __builtin_amdgcn_fence(__ATOMIC_ACQUIRE, "agent");
            xb_add(&bar[XB_XGEN(b.x)], 1u);
            asm volatile("s_waitcnt vmcnt(0)" ::: "memory");
        } else {
            XB_SPIN(xb_ld(&bar[XB_XGEN(b.x)]) == gen, bar);
            __builtin_amdgcn_fence(__ATOMIC_ACQUIRE, "agent");
            asm volatile("s_waitcnt vmcnt(0)" ::: "memory");
        }
    }
    __syncthreads();
}

struct Frame {
    LAS unsigned char* lds;
    volatile LAS unsigned* MISC;
    gu32* ctl;
    int tid, lane, wave, G, gw, NGW;
    const float *x, *c, *ada_w, *ada_b, *n1g, *w_in, *qng, *kng, *sgg, *sgw, *sgb, *w_a, *w_b, *w_out, *n2g, *w_up, *cvw, *cvb, *w_dn;
    float* out;
    float *MOD, *PART; bf16 *WIN, *WA, *WB, *WOUT, *WUP, *WDN, *H, *PROJ, *VT, *YA, *YB, *MRG, *A, *ACT; float *X1, *TMP, *RS, *SWT; unsigned* MASK;
};
__device__ __forceinline__ float wave_sum(float v) {
#pragma unroll
    for (int o = 1; o < 64; o <<= 1) v += __shfl_xor(v, o);
    return v;
}

template <bool FP8 = false>
__device__ __forceinline__ void transpose_item(const float* W, int Nsrc, int k0, int n0, void* dstv, size_t ldk, int drow0, LAS float* scr, int lane, float scale = 1.f) {
#pragma unroll
    for (int i = 0; i < 8; ++i) { const int kk = 8 * i + (lane >> 3); const f32x4 v = *(const GAS f32x4*)(W + (size_t)(k0 + kk) * Nsrc + n0 + 4 * (lane & 7));
        LAS float* s = scr + kk * 33 + 4 * (lane & 7); s[0] = v.x; s[1] = v.y; s[2] = v.z; s[3] = v.w; }
    LDS_WAIT(); asm volatile("" ::: "memory");
    const int c = lane & 7;
#pragma unroll
    for (int j = 0; j < 4; ++j) { const int n = (lane >> 3) + 8 * j; const LAS float* s = scr + (8 * c) * 33 + n;
        if constexpr (FP8) { v2u o; o.x = pk4_fp8(s[0 * 33] * scale, s[1 * 33] * scale, s[2 * 33] * scale, s[3 * 33] * scale); o.y = pk4_fp8(s[4 * 33] * scale, s[5 * 33] * scale, s[6 * 33] * scale, s[7 * 33] * scale);
            *(GAS v2u*)((unsigned char*)dstv + (size_t)(drow0 + n) * ldk + k0 + 8 * c) = o; }
        else { v4u o; o.x = pk2(s[0 * 33], s[1 * 33]); o.y = pk2(s[2 * 33], s[3 * 33]); o.z = pk2(s[4 * 33], s[5 * 33]); o.w = pk2(s[6 * 33], s[7 * 33]);
            *(GAS v4u*)((bf16*)dstv + (size_t)(drow0 + n) * ldk + k0 + 8 * c) = o; } }
    LDS_WAIT(); asm volatile("" ::: "memory");
}
__device__ __forceinline__ int win_dst_row(int n) {
    if (n < SKI) return n;
    if (n < SWI) return PKI + (n - SKI);
    if (n < SGU) return PWI + (n - SWI);
    return PGU + (n - SGU);
}
__device__ __forceinline__ void gemv_item(Frame& F, int item) {
    const int nb = item % 96, ks = item / 96, n0 = nb * 256 + 4 * F.lane, k0 = ks * 64;
    float cs[4];
#pragma unroll
    for (int b = 0; b < 4; ++b) { const float cv = F.c[b * DM + k0 + F.lane]; cs[b] = cv * pg8::sigmoidf_(cv); }
    f32x4 acc[4];
#pragma unroll
    for (int b = 0; b < 4; ++b) acc[b] = (f32x4){0.f, 0.f, 0.f, 0.f};
    const float* wp = F.ada_w + (size_t)k0 * MODW + n0;
#pragma unroll 16
    for (int k = 0; k < 64; ++k) { const f32x4 w = *(const GAS f32x4*)(wp + (size_t)k * MODW);
#pragma unroll
        for (int b = 0; b < 4; ++b) { const float s = __builtin_bit_cast(float, __builtin_amdgcn_readlane(__builtin_bit_cast(int, cs[b]), k)); acc[b] += w * s; } }
#pragma unroll
    for (int b = 0; b < 4; ++b) *(GAS f32x4*)(F.PART + (size_t)(ks * 4 + b) * MODW + n0) = acc[b];
}
__device__ __forceinline__ void mod_reduce(Frame& F) {
    for (int i = F.gw * 64 + F.lane; i < 4 * (MODW / 4); i += F.NGW * 64) { const int b = i / (MODW / 4), n0 = 4 * (i % (MODW / 4));
        f32x4 a = *(const GAS f32x4*)(F.ada_b + n0);
#pragma unroll 16
        for (int ks = 0; ks < 64; ++ks) a += *(const GAS f32x4*)(F.PART + (size_t)(ks * 4 + b) * MODW + n0);
        *(GAS f32x4*)(F.MOD + b * MODW + n0) = a; }
}
__device__ __forceinline__ void p0_prologue(Frame& F, bool with_gemv = true) {
    LAS float* scr = (LAS float*)(F.lds + RING_OFF + F.wave * 16384);
    constexpr int I_GV = 96 * 64;
    constexpr int I_IN = (DM / 64) * (IN_W / 32), I_A = (ATTW / 64) * (DM / 32), I_B = (GMW / 64) * (DM / 32), I_O = (DM / 64) * (DM / 32), I_UP = (DM / 128) * (F2 / 32), I_DN = (DFF / 128) * (DM / 32);
    constexpr int NITEMS = I_GV + I_IN + I_A + I_B + I_O + I_UP + I_DN;
    for (int it = F.gw; it < NITEMS; it += F.NGW) {
        int r = it;
        if (r < I_GV) { if (with_gemv) gemv_item(F, r); continue; } r -= I_GV;
        if (r < I_IN) { const int nblk = IN_W / 32, kb = r / nblk, nb = r % nblk; transpose_item(F.w_in, IN_W, 64 * kb, 32 * nb, F.WIN, DM, win_dst_row(32 * nb), scr, F.lane); continue; } r -= I_IN;
        if (r < I_A) { const int nblk = DM / 32, kb = r / nblk, nb = r % nblk; transpose_item(F.w_a, DM, 64 * kb, 32 * nb, F.WA, ATTW, 32 * nb, scr, F.lane); continue; } r -= I_A;
        if (r < I_B) { const int nblk = DM / 32, kb = r / nblk, nb = r % nblk; transpose_item(F.w_b, DM, 64 * kb, 32 * nb, F.WB, GMW, 32 * nb, scr, F.lane); continue; } r -= I_B;
        if (r < I_O) { const int nblk = DM / 32, kb = r / nblk, nb = r % nblk; transpose_item(F.w_out, DM, 64 * kb, 32 * nb, F.WOUT, DM, 32 * nb, scr, F.lane); continue; } r -= I_O;
        if (r < I_UP) { const int nblk = F2 / 32, kb = r / nblk, nb = r % nblk; const int n = 32 * nb; const int ch = n < DFF ? n : n - DFF;
            const int drow = (ch >> 7) * 256 + (ch & 127) + (n < DFF ? 0 : 128);
            transpose_item<true>(F.w_up, F2, 128 * kb, n, F.WUP, DM, drow, scr, F.lane, S_WUP); transpose_item<true>(F.w_up, F2, 128 * kb + 64, n, F.WUP, DM, drow, scr, F.lane, S_WUP); continue; } r -= I_UP;
        { const int nblk = DM / 32, kb = r / nblk, nb = r % nblk; transpose_item<true>(F.w_dn, DM, 128 * kb, 32 * nb, F.WDN, DFF, 32 * nb, scr, F.lane, S_WDN); transpose_item<true>(F.w_dn, DM, 128 * kb + 64, 32 * nb, F.WDN, DFF, 32 * nb, scr, F.lane, S_WDN); }
    }
    { const size_t n16 = (size_t)(PNP - IN_W) * DM * 2 / 16; GAS v4u* p = (GAS v4u*)(F.WIN + (size_t)IN_W * DM);
      for (size_t i = (size_t)F.gw * 64 + F.lane; i < n16; i += (size_t)F.NGW * 64) p[i] = (v4u){0u, 0u, 0u, 0u}; }
    for (int i = F.gw * 64 + F.lane; i < GMG * GMC * GMC; i += F.NGW * 64) { const int g = i >> 14, s = (i >> 7) & 127, t = i & 127; F.SWT[i] = F.sgw[(g * GMC + t) * GMC + s]; }
}

template <bool FP8 = false>
__device__ __forceinline__ void norm_rows(Frame& F, const float* X, const float* gain, int sh_off, int sc_off, void* Ov) {
    for (int m = F.gw; m < M; m += F.NGW) {
        const int b = m >> 11;
        const GAS f32x4* xr = (const GAS f32x4*)(X + (size_t)m * DM) + F.lane;
        f32x4 v[16]; float s = 0.f;
#pragma unroll
        for (int j = 0; j < 16; ++j) { v[j] = xr[64 * j]; s += (v[j].x * v[j].x + v[j].y * v[j].y) + (v[j].z * v[j].z + v[j].w * v[j].w); }
        const float rstd = 1.0f / sqrtf(wave_sum(s) * (1.f / DM) + EPS);
        const GAS f32x4* gp = (const GAS f32x4*)gain + F.lane;
        const GAS f32x4* shp = (const GAS f32x4*)(F.MOD + b * MODW + sh_off) + F.lane;
        const GAS f32x4* scp = (const GAS f32x4*)(F.MOD + b * MODW + sc_off) + F.lane;
        GAS v2u* o8 = (GAS v2u*)((bf16*)Ov + (size_t)m * DM) + F.lane; GAS unsigned* o4 = (GAS unsigned*)((unsigned char*)Ov + (size_t)m * DM) + F.lane;
#pragma unroll
        for (int j = 0; j < 16; ++j) { const f32x4 g = gp[64 * j], sh = shp[64 * j], sc = scp[64 * j];
            const f32x4 y = (v[j] * rstd) * g * (sc + 1.0f) + sh;
            if constexpr (FP8) o4[64 * j] = pk4_fp8(y.x * S_H2, y.y * S_H2, y.z * S_H2, y.w * S_H2);
            else { v2u w; w.x = pk2(y.x, y.y); w.y = pk2(y.z, y.w); o8[64 * j] = w; } }
    }
}

__device__ __forceinline__ unsigned sortable(float f) { const unsigned u = __builtin_bit_cast(unsigned, f); return u ^ ((unsigned)((int)u >> 31) | 0x80000000u); }
__device__ __forceinline__ void idx_row(Frame& F, int row) {
    const int lane = F.lane, b = row >> 11, t = row & 2047, hi = lane >> 5, l31 = lane & 31;
    GAS v2u* mrow = (GAS v2u*)(F.MASK + (size_t)row * 64);
    if (t < TOPK) {
        if (lane < 32) { const int k0 = 64 * lane; v2u w;
            w.x = (t >= k0 + 31) ? 0xffffffffu : (t < k0 ? 0u : ((2u << (t - k0)) - 1u));
            w.y = (t >= k0 + 63) ? 0xffffffffu : (t < k0 + 32 ? 0u : ((2u << (t - k0 - 32)) - 1u));
            mrow[lane] = w; }
        return;
    }
    const bf16* prow = F.PROJ + (size_t)row * PNP;
    bf16x8 qa[4];
#pragma unroll
    for (int ks = 0; ks < 4; ++ks) qa[ks] = *(const GAS bf16x8*)(prow + PQI + l31 * 64 + 16 * ks + 8 * hi);
    float wv[16];
#pragma unroll
    for (int r = 0; r < 16; ++r) wv[r] = bf2f(prow[PWI + (r & 3) + 8 * (r >> 2) + 4 * hi]);
    const bf16* kib = F.PROJ + (size_t)(b * SEQ) * PNP + PKI + 8 * hi;
    unsigned sc[32];
#pragma unroll
    for (int jp = 0; jp < 32; ++jp) {
        if (64 * jp <= t) {
            float s01[2];
#pragma unroll
            for (int h = 0; h < 2; ++h) {
                const bf16* kp = kib + (size_t)(64 * jp + 32 * h + l31) * PNP;
                f32x16 acc;
#pragma unroll
                for (int r = 0; r < 16; ++r) acc[r] = 0.f;
#pragma unroll
                for (int ks = 0; ks < 4; ++ks) { const bf16x8 kb = *(const GAS bf16x8*)(kp + 16 * ks); acc = __builtin_amdgcn_mfma_f32_32x32x16_bf16(qa[ks], kb, acc, 0, 0, 0); }
                float s = 0.f;
#pragma unroll
                for (int r = 0; r < 16; ++r) s += wv[r] * fmaxf(acc[r], 0.f);
                s += __shfl_xor(s, 32);
                s01[h] = s;
            }
            const float mine = (lane < 32 ? s01[0] : s01[1]) + 0.0f;
            sc[jp] = (64 * jp + lane <= t) ? sortable(mine) : 0u;
        } else sc[jp] = 0u;
    }
    unsigned thr = 0u;
    for (int bit = 31; bit >= 0; --bit) {
        const unsigned cand = thr | (1u << bit); int cnt = 0;
#pragma unroll
        for (int jp = 0; jp < 32; ++jp) cnt += __popcll(__ballot(sc[jp] >= cand));
        if (cnt >= TOPK) thr = cand;
    }
    int cgt = 0;
#pragma unroll
    for (int jp = 0; jp < 32; ++jp) cgt += __popcll(__ballot(sc[jp] > thr));
    const int need = TOPK - cgt; int seen = 0;
    unsigned mylo = 0u, myhi = 0u;
    const unsigned long long lt = (lane == 0) ? 0ull : (~0ull >> (64 - lane));
#pragma unroll
    for (int jp = 0; jp < 32; ++jp) {
        unsigned long long sel = __ballot(sc[jp] > thr);
        const unsigned long long eq = __ballot(sc[jp] == thr);
        if (eq) { const bool take = (sc[jp] == thr) && (seen + __popcll(eq & lt) < need); sel |= __ballot(take); seen += __popcll(eq); }
        if (lane == jp) { mylo = (unsigned)sel; myhi = (unsigned)(sel >> 32); }
    }
    if (lane < 32) { v2u w; w.x = mylo; w.y = myhi; mrow[lane] = w; }
}
constexpr float QSCALE = 0.08838834764831845f * 1.4426950408889634f;
__device__ __forceinline__ void qknorm_row(Frame& F, int row) {
    bf16* prow = F.PROJ + (size_t)row * PNP; const int lane = F.lane;
    {
        GAS v4u* p = (GAS v4u*)(prow + PQ + 32 * lane); v4u w[4]; float ss = 0.f;
#pragma unroll
        for (int i = 0; i < 4; ++i) { w[i] = p[i];
#pragma unroll
            for (int j = 0; j < 4; ++j) { const float a = bflo(w[i][j]), c = bfhi(w[i][j]); ss += a * a + c * c; } }
        ss += __shfl_xor(ss, 1); ss += __shfl_xor(ss, 2);
        const float r = QSCALE / sqrtf(ss * (1.f / HD) + EPS); const float* g = F.qng + 32 * (lane & 3);
#pragma unroll
        for (int i = 0; i < 4; ++i) { v4u o;
#pragma unroll
            for (int j = 0; j < 4; ++j) o[j] = pk2(bflo(w[i][j]) * r * g[8 * i + 2 * j], bfhi(w[i][j]) * r * g[8 * i + 2 * j + 1]);
            p[i] = o; }
    }
    {
        GAS v4u* p = (GAS v4u*)(prow + PK + 8 * lane); const v4u w = *p; float ss = 0.f;
#pragma unroll
        for (int j = 0; j < 4; ++j) { const float a = bflo(w[j]), c = bfhi(w[j]); ss += a * a + c * c; }
        ss += __shfl_xor(ss, 1); ss += __shfl_xor(ss, 2); ss += __shfl_xor(ss, 4); ss += __shfl_xor(ss, 8);
        const float r = 1.0f / sqrtf(ss * (1.f / HD) + EPS); const float* g = F.kng + 8 * (lane & 15); v4u o;
#pragma unroll
        for (int j = 0; j < 4; ++j) o[j] = pk2(bflo(w[j]) * r * g[2 * j], bfhi(w[j]) * r * g[2 * j + 1]);
        *p = o;
    }
    {
        const GAS v4u* p = (const GAS v4u*)(prow + PGV + 32 * lane); float ss = 0.f;
#pragma unroll
        for (int i = 0; i < 4; ++i) { const v4u w = p[i];
#pragma unroll
            for (int j = 0; j < 4; ++j) { const float a = bflo(w[j]), c = bfhi(w[j]); ss += a * a + c * c; } }
        ss = wave_sum(ss);
        if (lane == 0) F.RS[row] = 1.0f / sqrtf(ss * (1.f / GMW) + EPS);
    }
}
__device__ __forceinline__ void vt_item(Frame& F, int item) {
    const int s8 = item & 255, dh = (item >> 8) & 1, g = (item >> 9) & 3, b = item >> 11, d = 64 * dh + F.lane;
    const bf16* src = F.PROJ + (size_t)(b * SEQ + 8 * s8) * PNP + PV + g * HD + d;
    unsigned e[8];
#pragma unroll
    for (int j = 0; j < 8; ++j) e[j] = src[(size_t)j * PNP];
    v4u o; o.x = e[0] | (e[1] << 16); o.y = e[2] | (e[3] << 16); o.z = e[4] | (e[5] << 16); o.w = e[6] | (e[7] << 16);
    *(GAS v4u*)(F.VT + ((size_t)((b * NKV + g) * HD + d)) * SEQ + 8 * s8) = o;
}

__device__ __forceinline__ void attn_block(Frame& F, int b, int g, int qb) {
    const int lane = F.lane, w = F.wave, hi = lane >> 5, l31 = lane & 31;
    const int hh = 4 * g + (w >> 1), t = qb * 64 + 32 * (w & 1) + l31;
    const size_t row = (size_t)b * SEQ + t;
    const float slope2 = exp2f(-0.5f * (float)(hh + 1)) * 1.4426950408889634f;
    bf16x8 qf[8];
#pragma unroll
    for (int ks = 0; ks < 8; ++ks) qf[ks] = *(const GAS bf16x8*)(F.PROJ + row * PNP + PQ + hh * HD + 16 * ks + 8 * hi);
    f32x16 o[4];
#pragma unroll
    for (int db = 0; db < 4; ++db)
#pragma unroll
        for (int r = 0; r < 16; ++r) o[db][r] = 0.f;
    float m = -1e30f, lsum = 0.f;
    const bf16* kbase = F.PROJ + (size_t)(b * SEQ + l31) * PNP + PK + g * HD + 8 * hi;
    const bf16* vbase = F.VT + ((size_t)((b * NKV + g) * HD + l31)) * SEQ + 4 * hi;
    const unsigned* mbase = F.MASK + row * 64;
    for (int kt = 0; kt <= qb; ++kt) {
        const v2u mw = *(const GAS v2u*)(mbase + 2 * kt);
        f32x16 p[2];
#pragma unroll
        for (int kb = 0; kb < 2; ++kb) {
#pragma unroll
            for (int r = 0; r < 16; ++r) p[kb][r] = 0.f;
            const bf16* kp = kbase + (size_t)(64 * kt + 32 * kb) * PNP;
#pragma unroll
            for (int ks = 0; ks < 8; ++ks) { const bf16x8 kf = *(const GAS bf16x8*)(kp + 16 * ks); p[kb] = __builtin_amdgcn_mfma_f32_32x32x16_bf16(kf, qf[ks], p[kb], 0, 0, 0); }
        }
        const float base = -slope2 * (float)(t - 64 * kt - 4 * hi);
        float rmax = -3e30f;
#pragma unroll
        for (int kb = 0; kb < 2; ++kb) { const unsigned mword = (kb ? mw.y : mw.x) >> (4 * hi);
#pragma unroll
            for (int r = 0; r < 16; ++r) { const int ko = (r & 3) + 8 * (r >> 2);
                float s = p[kb][r] + (base + slope2 * (float)(32 * kb + ko));
                s = ((mword >> ko) & 1u) ? s : -2e30f; p[kb][r] = s; rmax = fmaxf(rmax, s); } }
        rmax = fmaxf(rmax, __shfl_xor(rmax, 32));
        const float mn = fmaxf(m, rmax), alpha = exp2f(m - mn); m = mn;
        float ps = 0.f;
#pragma unroll
        for (int kb = 0; kb < 2; ++kb)
#pragma unroll
            for (int r = 0; r < 16; ++r) { const float e = exp2f(p[kb][r] - mn); p[kb][r] = e; ps += e; }
        lsum = lsum * alpha + ps;
#pragma unroll
        for (int db = 0; db < 4; ++db)
#pragma unroll
            for (int r = 0; r < 16; ++r) o[db][r] *= alpha;
#pragma unroll
        for (int kb = 0; kb < 2; ++kb)
#pragma unroll
            for (int s2 = 0; s2 < 2; ++s2) {
                v4u pw; pw.x = pk2(p[kb][8 * s2 + 0], p[kb][8 * s2 + 1]); pw.y = pk2(p[kb][8 * s2 + 2], p[kb][8 * s2 + 3]); pw.z = pk2(p[kb][8 * s2 + 4], p[kb][8 * s2 + 5]); pw.w = pk2(p[kb][8 * s2 + 6], p[kb][8 * s2 + 7]);
                const bf16x8 pb = __builtin_bit_cast(bf16x8, pw);
                const bf16* vp = vbase + 64 * kt + 32 * kb + 16 * s2;
#pragma unroll
                for (int db = 0; db < 4; ++db) { const v2u v0 = *(const GAS v2u*)(vp + (size_t)(32 * db) * SEQ), v1 = *(const GAS v2u*)(vp + (size_t)(32 * db) * SEQ + 8);
                    v4u vw; vw.x = v0.x; vw.y = v0.y; vw.z = v1.x; vw.w = v1.y;
                    o[db] = __builtin_amdgcn_mfma_f32_32x32x16_bf16(__builtin_bit_cast(bf16x8, vw), pb, o[db], 0, 0, 0); }
            }
    }
    lsum += __shfl_xor(lsum, 32);
    const float inv = 1.0f / lsum;
    bf16* yrow = F.YA + row * ATTW + hh * HD + 4 * hi;
#pragma unroll
    for (int db = 0; db < 4; ++db)
#pragma unroll
        for (int rq = 0; rq < 4; ++rq) { v2u wv; wv.x = pk2(o[db][4 * rq] * inv, o[db][4 * rq + 1] * inv); wv.y = pk2(o[db][4 * rq + 2] * inv, o[db][4 * rq + 3] * inv);
            *(GAS v2u*)(yrow + 32 * db + 8 * rq) = wv; }
}

__device__ __forceinline__ void sgu_unit(Frame& F, int unit) {
    const int ck = unit >> 3, g = unit & 7, r0 = ck * GMC, c0 = g * GMGW, tid = F.tid;
    LAS unsigned* XB = (LAS unsigned*)(F.lds);
    LAS float* WT = (LAS float*)(F.lds + 65536);
    __syncthreads();
#pragma unroll
    for (int i = 0; i < 8; ++i) { const int c = tid + 512 * i, s = c >> 5, q = c & 31;
        *(LAS v4u*)(F.lds + s * 512 + q * 16) = *(const GAS v4u*)(F.PROJ + (size_t)(r0 + s) * PNP + PGV + c0 + 8 * q); }
#pragma unroll 4
    for (int i = 0; i < 32; ++i) { const int e = tid + 512 * i, s = e >> 7, t = e & 127;
        WT[e] = (s <= t) ? F.SWT[(g * GMC + s) * GMC + t] * F.RS[r0 + s] : 0.f; }
    __syncthreads();
    const int cp = tid & 127, tq = tid >> 7;
    const float sg0 = F.sgg[c0 + 2 * cp], sg1 = F.sgg[c0 + 2 * cp + 1];
    for (int pass = 0; pass < 4; ++pass) {
        const int t0 = 8 * (4 * pass + tq);
        float a0[8], a1[8];
#pragma unroll
        for (int j = 0; j < 8; ++j) { a0[j] = 0.f; a1[j] = 0.f; }
        for (int s = 0; s < t0 + 8; ++s) {
            const unsigned xw = XB[s * 128 + cp]; const float x0 = bflo(xw), x1 = bfhi(xw);
            const f32x4 w0 = *(const LAS f32x4*)(WT + s * 128 + t0), w1 = *(const LAS f32x4*)(WT + s * 128 + t0 + 4);
#pragma unroll
            for (int j = 0; j < 4; ++j) { a0[j] += w0[j] * x0; a1[j] += w0[j] * x1; a0[4 + j] += w1[j] * x0; a1[4 + j] += w1[j] * x1; }
        }
#pragma unroll
        for (int j = 0; j < 8; ++j) { const int t = t0 + j; const float bb = F.sgb[g * GMC + t];
            const unsigned uw = *(const GAS unsigned*)(F.PROJ + (size_t)(r0 + t) * PNP + PGU + c0 + 2 * cp);
            *(GAS unsigned*)(F.YB + (size_t)(r0 + t) * GMW + c0 + 2 * cp) = pk2(bflo(uw) * (a0[j] * sg0 + bb), bfhi(uw) * (a1[j] * sg1 + bb)); }
    }
}

using pg8::Unit; using pg8::cvt_pk_bf16;
struct EpiProj {
    static constexpr bool PERM = true; bf16* O;
    __device__ __forceinline__ void operator()(const f32x4 (&acc)[2][2][4][2], const Unit& u, int wr, int wc, int fr, int fq) const {
        const int act = (u.pn >= PGU / 256 && u.pn < PGA / 256) ? 1 : ((u.pn >= PGA / 256 && u.pn < PKI / 256) ? 2 : 0);
        const int row0 = u.pm * 256 + wr * 64 + fr, col0 = u.pn * 256 + wc * 32 + 8 * fq;
#pragma unroll
        for (int ai = 0; ai < 2; ++ai)
#pragma unroll
            for (int m = 0; m < 4; ++m) { bf16* rowp = O + (size_t)(row0 + ai * 128 + m * 16) * PNP + col0;
#pragma unroll
                for (int bj = 0; bj < 2; ++bj) { f32x4 v0 = acc[ai][bj][m][0], v1 = acc[ai][bj][m][1];
                    if (act == 1) { const pg8::f32x2 a = pg8::gelu_pk((pg8::f32x2){v0[0], v0[1]}), b = pg8::gelu_pk((pg8::f32x2){v0[2], v0[3]}), c = pg8::gelu_pk((pg8::f32x2){v1[0], v1[1]}), d = pg8::gelu_pk((pg8::f32x2){v1[2], v1[3]});
                        v0 = (f32x4){a.x, a.y, b.x, b.y}; v1 = (f32x4){c.x, c.y, d.x, d.y}; }
                    else if (act == 2) {
#pragma unroll
                        for (int j = 0; j < 4; ++j) { v0[j] = pg8::sigmoidf_(v0[j]); v1[j] = pg8::sigmoidf_(v1[j]); } }
                    v4u w; w.x = cvt_pk_bf16(v0[0], v0[1]); w.y = cvt_pk_bf16(v0[2], v0[3]); w.z = cvt_pk_bf16(v1[0], v1[1]); w.w = cvt_pk_bf16(v1[2], v1[3]);
                    *(GAS v4u*)(rowp + bj * 128) = w; } }
    }
};
struct EpiGateA {
    static constexpr bool PERM = true; const bf16* P; float* T;
    __device__ __forceinline__ void operator()(const f32x4 (&acc)[2][2][4][2], const Unit& u, int wr, int wc, int fr, int fq) const {
        const int row0 = u.pm * 256 + wr * 64 + fr, col0 = u.pn * 256 + wc * 32 + 8 * fq;
#pragma unroll
        for (int ai = 0; ai < 2; ++ai)
#pragma unroll
            for (int m = 0; m < 4; ++m) { const size_t r = (size_t)(row0 + ai * 128 + m * 16);
#pragma unroll
                for (int bj = 0; bj < 2; ++bj) { const v4u gw = *(const GAS v4u*)(P + r * PNP + PGA + col0 + bj * 128);
                    f32x4 v0 = acc[ai][bj][m][0], v1 = acc[ai][bj][m][1];
                    v0 = v0 * (f32x4){bflo(gw.x), bfhi(gw.x), bflo(gw.y), bfhi(gw.y)}; v1 = v1 * (f32x4){bflo(gw.z), bfhi(gw.z), bflo(gw.w), bfhi(gw.w)};
                    GAS f32x4* tp = (GAS f32x4*)(T + r * DM + col0 + bj * 128); tp[0] = v0; tp[1] = v1; } }
    }
};
struct EpiGateB {
    static constexpr bool PERM = true; const bf16* P; const float* T; bf16* O;
    __device__ __forceinline__ void operator()(const f32x4 (&acc)[2][2][4][2], const Unit& u, int wr, int wc, int fr, int fq) const {
        const int row0 = u.pm * 256 + wr * 64 + fr, col0 = u.pn * 256 + wc * 32 + 8 * fq;
#pragma unroll
        for (int ai = 0; ai < 2; ++ai)
#pragma unroll
            for (int m = 0; m < 4; ++m) { const size_t r = (size_t)(row0 + ai * 128 + m * 16);
#pragma unroll
                for (int bj = 0; bj < 2; ++bj) { const v4u gw = *(const GAS v4u*)(P + r * PNP + PGB + col0 + bj * 128);
                    const GAS f32x4* tp = (const GAS f32x4*)(T + r * DM + col0 + bj * 128);
                    const f32x4 v0 = tp[0] + acc[ai][bj][m][0] * (f32x4){bflo(gw.x), bfhi(gw.x), bflo(gw.y), bfhi(gw.y)};
                    const f32x4 v1 = tp[1] + acc[ai][bj][m][1] * (f32x4){bflo(gw.z), bfhi(gw.z), bflo(gw.w), bfhi(gw.w)};
                    v4u w; w.x = cvt_pk_bf16(v0[0], v0[1]); w.y = cvt_pk_bf16(v0[2], v0[3]); w.z = cvt_pk_bf16(v1[0], v1[1]); w.w = cvt_pk_bf16(v1[2], v1[3]);
                    *(GAS v4u*)(O + r * DM + col0 + bj * 128) = w; } }
    }
};
struct EpiResid {
    static constexpr bool PERM = false; const float* base; const float* gate; float* C; float scale;
    __device__ __forceinline__ void operator()(const f32x4 (&acc)[2][2][4][2], const Unit& u, int wr, int wc, int fr, int fq) const {
        const int row0 = u.pm * 256 + wr * 64 + fr, col0 = u.pn * 256 + wc * 32 + 4 * fq; const float* gp = gate + (u.pm >> 3) * MODW + col0;
        f32x4 gv[2][2];
#pragma unroll
        for (int bj = 0; bj < 2; ++bj)
#pragma unroll
            for (int n = 0; n < 2; ++n) gv[bj][n] = *(const GAS f32x4*)(gp + bj * 128 + n * 16) * scale;
#pragma unroll
        for (int ai = 0; ai < 2; ++ai)
#pragma unroll
            for (int m = 0; m < 4; ++m) { const size_t off = (size_t)(row0 + ai * 128 + m * 16) * DM + col0;
#pragma unroll
                for (int bj = 0; bj < 2; ++bj)
#pragma unroll
                    for (int n = 0; n < 2; ++n) { const f32x4 bs = *(const GAS f32x4*)(base + off + bj * 128 + n * 16);
                        *(GAS f32x4*)(C + off + bj * 128 + n * 16) = bs + gv[bj][n] * acc[ai][bj][m][n]; } }
    }
};
struct EpiPlain {
    static constexpr bool PERM = true; bf16* O; int ldc; float scale;
    __device__ __forceinline__ void operator()(const f32x4 (&acc)[2][2][4][2], const Unit& u, int wr, int wc, int fr, int fq) const {
        const int row0 = u.pm * 256 + wr * 64 + fr, col0 = u.pn * 256 + wc * 32 + 8 * fq;
#pragma unroll
        for (int ai = 0; ai < 2; ++ai)
#pragma unroll
            for (int m = 0; m < 4; ++m) { bf16* rowp = O + (size_t)(row0 + ai * 128 + m * 16) * ldc + col0;
#pragma unroll
                for (int bj = 0; bj < 2; ++bj) { const f32x4 v0 = acc[ai][bj][m][0] * scale, v1 = acc[ai][bj][m][1] * scale;
                    v4u w; w.x = cvt_pk_bf16(v0[0], v0[1]); w.y = cvt_pk_bf16(v0[2], v0[3]); w.z = cvt_pk_bf16(v1[0], v1[1]); w.w = cvt_pk_bf16(v1[2], v1[3]);
                    *(GAS v4u*)(rowp + bj * 128) = w; } }
    }
};

__device__ __forceinline__ void conv_phase(Frame& F) {
    constexpr int C8 = DFF / 8, TB = 16, NTB = M / TB;
    const size_t total = (size_t)C8 * NTB;
    for (size_t idx = (size_t)F.gw * 64 + F.lane; idx < total; idx += (size_t)F.NGW * 64) {
        const int c8 = (int)(idx % C8), tb = (int)(idx / C8), ch = 8 * c8, t0 = tb * TB;
        const int acol = (ch >> 7) * 256 + (ch & 127);
        float wg[3][8], wv[3][8], bg[8], bv[8];
#pragma unroll
        for (int j = 0; j < 3; ++j) { const f32x4 a = *(const GAS f32x4*)(F.cvw + (size_t)j * F2 + ch), b = *(const GAS f32x4*)(F.cvw + (size_t)j * F2 + ch + 4);
            const f32x4 c = *(const GAS f32x4*)(F.cvw + (size_t)j * F2 + DFF + ch), d = *(const GAS f32x4*)(F.cvw + (size_t)j * F2 + DFF + ch + 4);
#pragma unroll
            for (int e = 0; e < 4; ++e) { wg[j][e] = a[e]; wg[j][4 + e] = b[e]; wv[j][e] = c[e]; wv[j][4 + e] = d[e]; } }
        { const f32x4 a = *(const GAS f32x4*)(F.cvb + ch), b = *(const GAS f32x4*)(F.cvb + ch + 4), c = *(const GAS f32x4*)(F.cvb + DFF + ch), d = *(const GAS f32x4*)(F.cvb + DFF + ch + 4);
#pragma unroll
          for (int e = 0; e < 4; ++e) { bg[e] = a[e]; bg[4 + e] = b[e]; bv[e] = c[e]; bv[4 + e] = d[e]; } }
        float g1[8], g2[8], v1[8], v2[8];
        const bool first = (t0 & (SEQ - 1)) == 0;
        const bf16* ap = F.A + (size_t)t0 * F2 + acol;
        if (first) {
#pragma unroll
            for (int e = 0; e < 8; ++e) { g1[e] = g2[e] = v1[e] = v2[e] = 0.f; }
        } else {
            const v4u ga = *(const GAS v4u*)(ap - F2), gb = *(const GAS v4u*)(ap - 2 * (size_t)F2), va = *(const GAS v4u*)(ap - F2 + 128), vb = *(const GAS v4u*)(ap - 2 * (size_t)F2 + 128);
#pragma unroll
            for (int e = 0; e < 4; ++e) { g1[2 * e] = bflo(ga[e]); g1[2 * e + 1] = bfhi(ga[e]); g2[2 * e] = bflo(gb[e]); g2[2 * e + 1] = bfhi(gb[e]);
                v1[2 * e] = bflo(va[e]); v1[2 * e + 1] = bfhi(va[e]); v2[2 * e] = bflo(vb[e]); v2[2 * e + 1] = bfhi(vb[e]); }
        }
#pragma unroll 4
        for (int i = 0; i < TB; ++i) {
            const v4u gw = *(const GAS v4u*)(ap + (size_t)i * F2), vw = *(const GAS v4u*)(ap + (size_t)i * F2 + 128);
            float g0[8], v0[8], y[8];
#pragma unroll
            for (int e = 0; e < 4; ++e) { g0[2 * e] = bflo(gw[e]); g0[2 * e + 1] = bfhi(gw[e]); v0[2 * e] = bflo(vw[e]); v0[2 * e + 1] = bfhi(vw[e]); }
#pragma unroll
            for (int e = 0; e < 8; ++e) { const float gt = bg[e] + wg[0][e] * g2[e] + wg[1][e] * g1[e] + wg[2][e] * g0[e];
                const float vl = bv[e] + wv[0][e] * v2[e] + wv[1][e] * v1[e] + wv[2][e] * v0[e];
                y[e] = gt * pg8::sigmoidf_(gt) * vl; g2[e] = g1[e]; g1[e] = g0[e]; v2[e] = v1[e]; v1[e] = v0[e]; }
            v2u o; o.x = pk4_fp8(y[0] * S_ACT, y[1] * S_ACT, y[2] * S_ACT, y[3] * S_ACT); o.y = pk4_fp8(y[4] * S_ACT, y[5] * S_ACT, y[6] * S_ACT, y[7] * S_ACT);
            *(GAS v2u*)((unsigned char*)F.ACT + (size_t)(t0 + i) * DFF + ch) = o;
        }
    }
}

constexpr int N_PHASES = 12;
struct Args { const float* in[19]; float* out; unsigned char* ws; int ph_lo, ph_hi, li, pad; };
__global__ void __launch_bounds__(NWAVES * 64, 2) mega_fwd(Args args) {
    extern __shared__ __attribute__((aligned(16))) unsigned char lds[];
    Frame F;
    F.lds = (LAS unsigned char*)lds;
    F.MISC = (volatile LAS unsigned*)(F.lds + MISC_OFF);
    F.tid = threadIdx.x; F.lane = F.tid & 63; F.wave = __builtin_amdgcn_readfirstlane(F.tid >> 6);
    F.G = gridDim.x; F.gw = blockIdx.x * NWAVES + F.wave; F.NGW = F.G * NWAVES;
    unsigned char* ws = args.ws;
    F.ctl = (gu32*)(ws + WS_CTL);
    F.x = args.in[0]; F.c = args.in[1]; F.ada_w = args.in[2]; F.ada_b = args.in[3]; F.n1g = args.in[4]; F.w_in = args.in[5]; F.qng = args.in[6]; F.kng = args.in[7];
    F.sgg = args.in[8]; F.sgw = args.in[9]; F.sgb = args.in[10]; F.w_a = args.in[11]; F.w_b = args.in[12]; F.w_out = args.in[13]; F.n2g = args.in[14]; F.w_up = args.in[15];
    F.cvw = args.in[16]; F.cvb = args.in[17]; F.w_dn = args.in[18]; F.out = args.out;
    F.MOD = (float*)(ws + WS_MOD); F.PART = (float*)(ws + WS_TMP);   F.WIN = (bf16*)(ws + WS_WIN); F.WA = (bf16*)(ws + WS_WA); F.WB = (bf16*)(ws + WS_WB); F.WOUT = (bf16*)(ws + WS_WOUT); F.WUP = (bf16*)(ws + WS_WUP); F.WDN = (bf16*)(ws + WS_WDN);
    F.H = (bf16*)(ws + WS_H); F.X1 = (float*)(ws + WS_X1); F.PROJ = (bf16*)(ws + WS_PROJ); F.MASK = (unsigned*)(ws + WS_MASK); F.RS = (float*)(ws + WS_RS); F.SWT = (float*)(ws + WS_SWT);
    F.VT = (bf16*)(ws + WS_VT); F.YA = (bf16*)(ws + WS_YA); F.YB = (bf16*)(ws + WS_YB); F.MRG = (bf16*)(ws + WS_MRG); F.TMP = (float*)(ws + WS_TMP); F.A = (bf16*)(ws + WS_A); F.ACT = (bf16*)(ws + WS_ACT);
    for (int u = F.tid; u < (LDS_BYTES - LDSCTL_OFF) / 4; u += NWAVES * 64) ((LAS unsigned*)(F.lds + LDSCTL_OFF))[u] = 0u;
    __syncthreads();
    XcdBarrier bar; bar.bar = (unsigned*)(F.ctl + CW_BAR); bar.x = 0; bar.st = nullptr;
    if (MK_N_LAUNCHES == 1) bar = xcd_barrier_post((unsigned*)(F.ctl + CW_BAR), F.MISC + 8);
    const int lo = args.ph_lo, hi = args.ph_hi;
#define IN(k) (lo <= (k) && (k) < hi)
#define SEAM(k) do { if (IN(k) && IN((k) + 1)) xcd_barrier(bar); } while (0)

#define REP(k) if ((PROBE_MASK >> (k)) & 1) for (int _rep = 0; _rep < 1; ++_rep)
    if (IN(0)) { p0_prologue(F); REP(0) { xcd_barrier(bar); p0_prologue(F, false); } } SEAM(0);
    if (IN(1)) { mod_reduce(F); } SEAM(1);
    if (IN(2)) { norm_rows(F, F.x, F.n1g, 0, DM, F.H); REP(2) { xcd_barrier(bar); norm_rows(F, F.x, F.n1g, 0, DM, F.H); } } SEAM(2);
    if (IN(3)) { pg8::Gemm g{F.H, F.WIN, M, PNP, DM, DM, DM}; pg8::StaticOrder S; S.init(M, PNP, F.G, (int)blockIdx.x); EpiProj E{F.PROJ};
        pg8::gemm_phase<EpiProj, pg8::StaticOrder, true>(F.lds + RING_OFF, g, S, E);
        REP(3) { xcd_barrier(bar); pg8::gemm_phase<EpiProj, pg8::StaticOrder, true>(F.lds + RING_OFF, g, S, E); } } SEAM(3);
    if (IN(4)) {
        for (int row = F.gw; row < M; row += F.NGW) { idx_row(F, row); qknorm_row(F, row); }
        for (int it = F.gw; it < BATCH * NKV * 2 * 256; it += F.NGW) vt_item(F, it);
        REP(4) { xcd_barrier(bar); for (int row = F.gw; row < M; row += F.NGW) { idx_row(F, row); } }
        REP(13) { xcd_barrier(bar); for (int it = F.gw; it < BATCH * NKV * 2 * 256; it += F.NGW) vt_item(F, it); }
    } SEAM(4);
    if (IN(5)) {
        for (int p = blockIdx.x; p < 256; p += F.G) { const int bg = p >> 4, j = p & 15; attn_block(F, bg >> 2, bg & 3, j); attn_block(F, bg >> 2, bg & 3, 31 - j); }
        REP(5) { xcd_barrier(bar); for (int p = blockIdx.x; p < 256; p += F.G) { const int bg = p >> 4, j = p & 15; attn_block(F, bg >> 2, bg & 3, j); attn_block(F, bg >> 2, bg & 3, 31 - j); } }
        for (int u = blockIdx.x; u < 512; u += F.G) sgu_unit(F, u);
        __syncthreads();
        REP(14) { xcd_barrier(bar); for (int u = blockIdx.x; u < 512; u += F.G) sgu_unit(F, u); __syncthreads(); }
    } SEAM(5);
    if (IN(6)) {
        { pg8::Gemm g{F.YA, F.WA, M, DM, ATTW, ATTW, ATTW}; pg8::StaticOrder S; S.init(M, DM, F.G, (int)blockIdx.x); EpiGateA E{F.PROJ, F.TMP};
          pg8::gemm_phase<EpiGateA, pg8::StaticOrder, true>(F.lds + RING_OFF, g, S, E); }
        VM_WAIT(); __syncthreads();
        { pg8::Gemm g{F.YB, F.WB, M, DM, GMW, GMW, GMW}; pg8::StaticOrder S; S.init(M, DM, F.G, (int)blockIdx.x); EpiGateB E{F.PROJ, F.TMP, F.MRG};
          pg8::gemm_phase<EpiGateB, pg8::StaticOrder, true>(F.lds + RING_OFF, g, S, E); }
        REP(6) { xcd_barrier(bar);
          { pg8::Gemm g{F.YA, F.WA, M, DM, ATTW, ATTW, ATTW}; pg8::StaticOrder S; S.init(M, DM, F.G, (int)blockIdx.x); EpiGateA E{F.PROJ, F.TMP};
            pg8::gemm_phase<EpiGateA, pg8::StaticOrder, true>(F.lds + RING_OFF, g, S, E); }
          VM_WAIT(); __syncthreads();
          { pg8::Gemm g{F.YB, F.WB, M, DM, GMW, GMW, GMW}; pg8::StaticOrder S; S.init(M, DM, F.G, (int)blockIdx.x); EpiGateB E{F.PROJ, F.TMP, F.MRG};
            pg8::gemm_phase<EpiGateB, pg8::StaticOrder, true>(F.lds + RING_OFF, g, S, E); } }
    } SEAM(6);
    if (IN(7)) { pg8::Gemm g{F.MRG, F.WOUT, M, DM, DM, DM, DM}; pg8::StaticOrder S; S.init(M, DM, F.G, (int)blockIdx.x); EpiResid E{F.x, F.MOD + 2 * DM, F.X1, 1.0f};
        pg8::gemm_phase<EpiResid, pg8::StaticOrder, true>(F.lds + RING_OFF, g, S, E);
        REP(7) { xcd_barrier(bar); pg8::gemm_phase<EpiResid, pg8::StaticOrder, true>(F.lds + RING_OFF, g, S, E); } } SEAM(7);
    if (IN(8)) { norm_rows<true>(F, F.X1, F.n2g, 3 * DM, 4 * DM, F.H); REP(8) { xcd_barrier(bar); norm_rows<true>(F, F.X1, F.n2g, 3 * DM, 4 * DM, F.H); } } SEAM(8);
    if (IN(9)) { pg8::Gemm g{F.H, F.WUP, M, F2, DM, DM, DM}; pg8::StaticOrder S; S.init(M, F2, F.G, (int)blockIdx.x); EpiPlain E{F.A, F2, 1.0f / (S_H2 * S_WUP)};
        pg8::gemm_phase<EpiPlain, pg8::StaticOrder, true, 1>(F.lds + RING_OFF, g, S, E);
        REP(9) { xcd_barrier(bar); pg8::gemm_phase<EpiPlain, pg8::StaticOrder, true, 1>(F.lds + RING_OFF, g, S, E); } } SEAM(9);
    if (IN(10)) { conv_phase(F); REP(10) { xcd_barrier(bar); conv_phase(F); } } SEAM(10);
    if (IN(11)) { pg8::Gemm g{F.ACT, F.WDN, M, DM, DFF, DFF, DFF}; pg8::StaticOrder S; S.init(M, DM, F.G, (int)blockIdx.x); EpiResid E{F.X1, F.MOD + 5 * DM, F.out, 1.0f / (S_ACT * S_WDN)};
        pg8::gemm_phase<EpiResid, pg8::StaticOrder, true, 1>(F.lds + RING_OFF, g, S, E);
        REP(11) { xcd_barrier(bar); pg8::gemm_phase<EpiResid, pg8::StaticOrder, true, 1>(F.lds + RING_OFF, g, S, E); } }
#undef REP
#undef IN
#undef SEAM
}

extern "C" void kernel_launch(void* const* d_in, const int* in_sizes, int n_in, void* d_out, int out_size, void* d_ws, size_t ws_size, hipStream_t stream) {
    static int grid = 0;
    if (grid == 0) {
        if (n_in != 19 || in_sizes[0] != M * DM || out_size != M * DM || ws_size < WS_END) { fprintf(stderr, "kernel_launch: unexpected shapes (n_in %d, in0 %d, out %d, ws %zu < %zu); nothing launched\n", n_in, n_in > 0 ? in_sizes[0] : -1, out_size, ws_size, (size_t)WS_END); grid = -1; return; }
        int dev = 0, cus = 0, per_cu = 0;
        if (hipGetDevice(&dev) != hipSuccess || hipDeviceGetAttribute(&cus, hipDeviceAttributeMultiprocessorCount, dev) != hipSuccess) { fprintf(stderr, "kernel_launch: device query failed\n"); grid = -1; return; }
        if (hipFuncSetAttribute((const void*)mega_fwd, hipFuncAttributeMaxDynamicSharedMemorySize, LDS_BYTES) != hipSuccess) { fprintf(stderr, "kernel_launch: hipFuncSetAttribute failed\n"); grid = -1; return; }
        if (hipOccupancyMaxActiveBlocksPerMultiprocessor(&per_cu, (const void*)mega_fwd, NWAVES * 64, LDS_BYTES) != hipSuccess || per_cu < 1) { fprintf(stderr, "kernel_launch: occupancy query reports %d blocks per CU\n", per_cu); }
        (void)hipGetLastError();
        grid = cus;
    }
    if (grid < 0) return;
    if (hipMemsetAsync((char*)d_ws + WS_CTL, 0, CTL_ZERO_BYTES, stream) != hipSuccess) { fprintf(stderr, "kernel_launch: memset failed\n"); return; }
    Args a{};
    for (int i = 0; i < 19; ++i) a.in[i] = (const float*)d_in[i];
    a.out = (float*)d_out; a.ws = (unsigned char*)d_ws; a.pad = 0;
    for (int li = 0; li < MK_N_LAUNCHES; ++li) {
        if (MK_N_LAUNCHES == 1) { a.ph_lo = 0; a.ph_hi = N_PHASES; } else { a.ph_lo = li; a.ph_hi = li + 1; }
        a.li = li;
        hipLaunchKernelGGL(mega_fwd, dim3(grid), dim3(NWAVES * 64), LDS_BYTES, stream, a);
        const hipError_t le = hipPeekAtLastError();
        if (le != hipSuccess) { fprintf(stderr, "kernel_launch: launch %d failed: %s\n", li, hipGetErrorName(le)); break; }
    }
}
```

```cpp
#include <hip/hip_runtime.h>
#include <cstdio>
#include <cstdint>

#ifndef MK_N_LAUNCHES
#define MK_N_LAUNCHES 1
#endif
#ifndef PROBE_MASK
#define PROBE_MASK 0x0
#endif

namespace pg8 {
#define PG8_LAS __attribute__((address_space(3)))
typedef unsigned short bf16_t;
typedef short bf16x8 __attribute__((ext_vector_type(8)));
typedef float f32x4 __attribute__((ext_vector_type(4)));
typedef float f32x2 __attribute__((ext_vector_type(2)));
typedef unsigned u32x4 __attribute__((ext_vector_type(4)));
typedef unsigned u32x2 __attribute__((ext_vector_type(2)));
constexpr int BM = 256, BK = 64, HALF = 128, HTB = HALF * BK * 2, STAGE_BYTES = 8 * HTB, NXCD = 8, WGM = 8;

__host__ __device__ __forceinline__ int lds_byte(int r, int c) { const int st = (r >> 4) * 2 + (c >> 5), rr = r & 15, cc = c & 31, ob = rr * 64 + cc * 2; return st * 1024 + (ob ^ (((ob >> 9) & 1) << 5)); }
__host__ __device__ __forceinline__ void stage_rc(int b, int& R, int& C) { const int st = b / 1024, sb = b % 1024, swz = sb ^ (((sb >> 9) & 1) << 5); R = (st >> 1) * 16 + swz / 64; C = (st & 1) * 32 + (swz % 64) / 2; }
__host__ __device__ __forceinline__ int perm32(int rho) { const int n = rho >> 4, i = rho & 15; return 8 * (i >> 2) + 4 * n + (i & 3); }

struct Unit { int pm, pn; };
struct Gemm { const bf16_t* A; const bf16_t* Bt; int M, N, K, lda, ldb; };

struct StaticOrder {
    int nM, nN, nwg, G, c;
    __host__ __device__ void init(int M, int N, int G_, int c_) { nM = M / BM; nN = N / BM; nwg = nM * nN; G = G_; c = c_; }
    __host__ __device__ bool next(int i, Unit& u) const {
        const long L = (long)i * G + c; if (L >= nwg) return false;
        int wgid = (int)L; { const int q = nwg / NXCD, r = nwg % NXCD, xcd = wgid % NXCD, off = wgid / NXCD; wgid = (xcd < r ? xcd * (q + 1) : r * (q + 1) + (xcd - r) * q) + off; }
        const int nig = WGM * nN, gid = wgid / nig, fm = gid * WGM, gsz = (nM - fm) < WGM ? (nM - fm) : WGM;
        u.pm = fm + ((wgid % nig) % gsz); u.pn = (wgid % nig) / gsz; return true;
    }
    __device__ __forceinline__ void a_ready(const Unit&) const {}
    __device__ __forceinline__ void done(const Unit&) const {}
};

__device__ __forceinline__ unsigned cvt_pk_bf16(float lo, float hi) { unsigned r; asm volatile("v_cvt_pk_bf16_f32 %0, %1, %2" : "=v"(r) : "v"(lo), "v"(hi)); return r; }
__device__ __forceinline__ f32x2 gelu_pk(f32x2 v) {
    const f32x2 av = __builtin_elementwise_abs(v), d = av * 0.2316418882f + 1.0f;
    f32x2 t; t.x = __builtin_amdgcn_rcpf(d.x); t.y = __builtin_amdgcn_rcpf(d.y);
    f32x2 q = t * 0.5307027145f + (-0.7265760135f); q = q * t + 0.7107068705f; q = q * t + (-0.142248368f); q = q * t + 0.127414796f; q = q * t;
    const f32x2 s = (v * v) * (-0.72134752044f);
    f32x2 e; e.x = __builtin_amdgcn_exp2f(s.x); e.y = __builtin_amdgcn_exp2f(s.y);
    const f32x2 m = v * (q * e), r = v - m;
    f32x2 o; o.x = v.x < 0.f ? m.x : r.x; o.y = v.y < 0.f ? m.y : r.y; return o;
}
__device__ __forceinline__ float sigmoidf_(float x) { return __builtin_amdgcn_rcpf(1.0f + __builtin_amdgcn_exp2f(-1.4426950408889634f * x)); }
__device__ __forceinline__ float bflo(unsigned w) { return __builtin_bit_cast(float, w << 16); }
__device__ __forceinline__ float bfhi(unsigned w) { return __builtin_bit_cast(float, w & 0xffff0000u); }

typedef int i32x8 __attribute__((ext_vector_type(8)));
typedef int i32x4 __attribute__((ext_vector_type(4)));
template <class Epi, class Sched, bool ALIGN_EPI, int ES = 2>
__device__ __forceinline__ void gemm_phase(PG8_LAS unsigned char* lds, const Gemm g, const Sched& S, const Epi& E) {
    const int tid = threadIdx.x, wid = __builtin_amdgcn_readfirstlane(tid >> 6), lane = tid & 63, wr = wid >> 2, wc = wid & 3, fr = lane & 15, fq = lane >> 4;
    const int K = g.K, nt = K * ES / (BK * 2);
    unsigned voffA[2], voffB[2];
#pragma unroll
    for (int i = 0; i < 2; ++i) { int R, C; stage_rc(tid * 16 + i * 8192, R, C); const int Rb = Epi::PERM ? ((R & ~31) + perm32(R & 31)) : R;
        voffA[i] = (unsigned)(R * g.lda) * (unsigned)ES + (unsigned)C * 2u; voffB[i] = (unsigned)(Rb * g.ldb) * (unsigned)ES + (unsigned)C * 2u; }
    const size_t kstep = (size_t)(BK * 2);
    const size_t hstepA = (size_t)HALF * g.lda * ES, hstepB = (size_t)HALF * g.ldb * ES;
    const size_t tstepA = 2 * hstepA, tstepB = 2 * hstepB;
    const unsigned ldsw = (unsigned)wid * 1024u;
    const int aoff = lds_byte(wr * 64 + fr, fq * 8), boff = lds_byte(wc * 32 + fr, fq * 8);
#define PG8_SA(b, h) (((b) * 2 + (h)) * HTB)
#define PG8_SB(b, h) ((4 + (b) * 2 + (h)) * HTB)
#define PG8_STAGE(bufoff, gbase, voff) do { _Pragma("unroll") for (int _i = 0; _i < 2; ++_i) \
        __builtin_amdgcn_global_load_lds((const unsigned*)((const char*)(gbase) + (voff)[_i]), (PG8_LAS unsigned*)(lds + (bufoff) + ldsw + _i * 8192), 16, 0, 0); } while (0)
#define PG8_CAT(x, y) __builtin_shufflevector(x, y, 0, 1, 2, 3, 4, 5, 6, 7)
#define PG8_LO(v) __builtin_bit_cast(bf16x8, __builtin_shufflevector(v, v, 0, 1, 2, 3))
#define PG8_HI(v) __builtin_bit_cast(bf16x8, __builtin_shufflevector(v, v, 4, 5, 6, 7))
#define PG8_LDA(dst, b, h) do { _Pragma("unroll") for (int m = 0; m < 4; ++m) { const i32x4 _l = *(const PG8_LAS i32x4*)(lds + PG8_SA(b, h) + aoff + m * 2048), _h = *(const PG8_LAS i32x4*)(lds + PG8_SA(b, h) + aoff + m * 2048 + 1024); dst[m] = PG8_CAT(_l, _h); } } while (0)
#define PG8_LDB(dst, b, h) do { _Pragma("unroll") for (int n = 0; n < 2; ++n) { const i32x4 _l = *(const PG8_LAS i32x4*)(lds + PG8_SB(b, h) + boff + n * 2048), _h = *(const PG8_LAS i32x4*)(lds + PG8_SB(b, h) + boff + n * 2048 + 1024); dst[n] = PG8_CAT(_l, _h); } } while (0)
#define PG8_MMA(ai, bj, At, Bt) do { __builtin_amdgcn_s_setprio(1); _Pragma("unroll") for (int m = 0; m < 4; ++m) _Pragma("unroll") for (int n = 0; n < 2; ++n) { \
        if constexpr (ES == 2) { acc[ai][bj][m][n] = __builtin_amdgcn_mfma_f32_16x16x32_bf16(PG8_LO(Bt[n]), PG8_LO(At[m]), acc[ai][bj][m][n], 0, 0, 0); \
                                 acc[ai][bj][m][n] = __builtin_amdgcn_mfma_f32_16x16x32_bf16(PG8_HI(Bt[n]), PG8_HI(At[m]), acc[ai][bj][m][n], 0, 0, 0); } \
        else asm volatile("v_mfma_f32_16x16x128_f8f6f4 %0, %1, %2, %0" : "+v"(acc[ai][bj][m][n]) : "v"(Bt[n]), "v"(At[m])); } __builtin_amdgcn_s_setprio(0); } while (0)
#define PG8_WAIT_V(n) asm volatile("s_waitcnt vmcnt(" #n ")" ::: "memory")
#define PG8_WAIT_L(n) asm volatile("s_waitcnt lgkmcnt(" #n ")" ::: "memory")
#define PG8_BAR __builtin_amdgcn_s_barrier()
#define PG8_SCHED __builtin_amdgcn_sched_barrier(0)
    Unit cur, nxt; int ui = 0;
    if (!S.next(0, cur)) return;
    f32x4 acc[2][2][4][2];
#pragma unroll
    for (int a = 0; a < 2; ++a)
#pragma unroll
        for (int b = 0; b < 2; ++b)
#pragma unroll
            for (int m = 0; m < 4; ++m)
#pragma unroll
                for (int n = 0; n < 2; ++n) acc[a][b][m][n] = (f32x4){0.f, 0.f, 0.f, 0.f};
    i32x8 At[4], B0[2], B1[2];
    const char* cA = (const char*)g.A + (size_t)cur.pm * tstepA; const char* cB = (const char*)g.Bt + (size_t)cur.pn * tstepB;
    S.a_ready(cur);
    PG8_STAGE(PG8_SB(0, 0), cB, voffB); PG8_STAGE(PG8_SB(0, 1), cB + hstepB, voffB); PG8_STAGE(PG8_SA(0, 0), cA, voffA); PG8_STAGE(PG8_SA(0, 1), cA + hstepA, voffA);
    if (wr == 1) PG8_BAR;
    PG8_WAIT_V(2); PG8_BAR;
    PG8_STAGE(PG8_SB(1, 0), cB + kstep, voffB); PG8_STAGE(PG8_SA(1, 0), cA + kstep, voffA); PG8_STAGE(PG8_SB(1, 1), cB + hstepB + kstep, voffB);
    PG8_WAIT_V(6); PG8_BAR;
    for (;;) {
        const bool has_next = S.next(ui + 1, nxt);
        const char* nA = has_next ? (const char*)g.A + (size_t)nxt.pm * tstepA : cA; const char* nB = has_next ? (const char*)g.Bt + (size_t)nxt.pn * tstepB : cB;
        for (int t = 0; t < nt; t += 2) {
            const bool last = (t == nt - 2);
            const char* a1 = cA + (size_t)(t + 1) * kstep;
            const char* a2 = last ? nA : cA + (size_t)(t + 2) * kstep; const char* b2 = last ? nB : cB + (size_t)(t + 2) * kstep;
            const char* a3 = a2 + kstep; const char* b3 = b2 + kstep;
            if (last && has_next) S.a_ready(nxt);
            PG8_LDB(B0, 0, 0); PG8_LDB(B1, 0, 1); PG8_SCHED; PG8_LDA(At, 0, 0); PG8_STAGE(PG8_SA(1, 1), a1 + hstepA, voffA);
            PG8_WAIT_V(8); PG8_WAIT_L(0); PG8_BAR; PG8_MMA(0, 0, At, B0); PG8_MMA(0, 1, At, B1); PG8_BAR; PG8_SCHED;
            PG8_LDA(At, 0, 1); PG8_STAGE(PG8_SB(0, 0), b2, voffB); PG8_STAGE(PG8_SB(0, 1), b2 + hstepB, voffB); PG8_STAGE(PG8_SA(0, 0), a2, voffA);
            PG8_WAIT_V(8); PG8_WAIT_L(0); PG8_BAR; PG8_MMA(1, 0, At, B0); PG8_MMA(1, 1, At, B1); PG8_BAR; PG8_SCHED;
            PG8_LDB(B0, 1, 0); PG8_LDB(B1, 1, 1); PG8_SCHED; PG8_LDA(At, 1, 0); PG8_STAGE(PG8_SA(0, 1), a2 + hstepA, voffA);
            PG8_WAIT_V(8); PG8_WAIT_L(0); PG8_BAR; PG8_MMA(0, 0, At, B0); PG8_MMA(0, 1, At, B1); PG8_BAR; PG8_SCHED;
            PG8_LDA(At, 1, 1); PG8_STAGE(PG8_SB(1, 0), b3, voffB); PG8_STAGE(PG8_SB(1, 1), b3 + hstepB, voffB); PG8_STAGE(PG8_SA(1, 0), a3, voffA);
            PG8_WAIT_V(8); PG8_WAIT_L(0); PG8_BAR; PG8_MMA(1, 0, At, B0); PG8_MMA(1, 1, At, B1); PG8_BAR; PG8_SCHED;
        }
        if constexpr (ALIGN_EPI) { if (wr == 0) PG8_BAR; }
        if constexpr (ES == 1) asm volatile("s_nop 15\n\ts_nop 15" ::: "memory");
        E(acc, cur, wr, wc, fr, fq); S.done(cur);
        if (!has_next) break;
#pragma unroll
        for (int a = 0; a < 2; ++a)
#pragma unroll
            for (int b = 0; b < 2; ++b)
#pragma unroll
                for (int m = 0; m < 4; ++m)
#pragma unroll
                    for (int n = 0; n < 2; ++n) acc[a][b][m][n] = (f32x4){0.f, 0.f, 0.f, 0.f};
        cur = nxt; cA = nA; cB = nB; ++ui;
        if constexpr (ALIGN_EPI) { if (wr == 1) PG8_BAR; }
    }
    PG8_WAIT_V(0);
    if constexpr (!ALIGN_EPI) { if (wr == 0) PG8_BAR; }
    PG8_BAR;
#undef PG8_SA
#undef PG8_SB
#undef PG8_STAGE
#undef PG8_LDA
#undef PG8_CAT
#undef PG8_LO
#undef PG8_HI
#undef PG8_LDB
#undef PG8_MMA
#undef PG8_WAIT_V
#undef PG8_WAIT_L
#undef PG8_BAR
#undef PG8_SCHED
}
}

constexpr int NWAVES = 8;
constexpr int BATCH = 4, SEQ = 2048, DM = 4096, M = BATCH * SEQ;
constexpr int NH = 16, HD = 128, NKV = 4, ATTW = 2048, KVW = 512, IH = 32, IDIM = 64, TOPK = 256;
constexpr int GMW = 2048, GMG = 8, GMGW = 256, GMC = 128, DFF = 11008, F2 = 2 * DFF;
constexpr int IN_W = 17504, MODW = 6 * DM;
constexpr float EPS = 1e-6f;
constexpr int PQ = 0, PK = 2048, PV = 2560, PQI = 3072, PGU = 5120, PGV = 7168, PGA = 9216, PGB = 13312, PKI = 17408, PWI = 17472, PNP = 17664;
constexpr int SQ = 0, SK = 2048, SV = 2560, SQI = 3072, SKI = 5120, SWI = 5184, SGU = 5216, SGV = 7264, SGA = 9312, SGB = 13408;

constexpr size_t MiB = 1u << 20;
constexpr size_t WS_CTL = 0, CTL_ZERO_BYTES = 2 * MiB;
constexpr size_t WS_MOD = 1 * MiB;
constexpr size_t WS_WIN = 2 * MiB;
constexpr size_t WS_WA = 140 * MiB, WS_WB = 156 * MiB;
constexpr size_t WS_WOUT = 172 * MiB;
constexpr size_t WS_WUP = 204 * MiB;
constexpr size_t WS_WDN = 376 * MiB;
constexpr size_t WS_H = 462 * MiB;
constexpr size_t WS_X1 = 526 * MiB;
constexpr size_t WS_PROJ = 654 * MiB;
constexpr size_t WS_MASK = 930 * MiB;
constexpr size_t WS_RS = 932 * MiB;
constexpr size_t WS_SWT = 932 * MiB + 65536;
constexpr size_t WS_VT = 933 * MiB;
constexpr size_t WS_YA = 941 * MiB, WS_YB = 973 * MiB;
constexpr size_t WS_MRG = 1005 * MiB;
constexpr size_t WS_TMP = 1069 * MiB;
constexpr size_t WS_A = 654 * MiB;
constexpr size_t WS_ACT = 998 * MiB;
constexpr size_t WS_END = 1197 * MiB;
static_assert(WS_WIN + (size_t)PNP * DM * 2 <= WS_WA && WS_WUP + (size_t)F2 * DM * 2 <= WS_WDN && WS_WDN + (size_t)DM * DFF * 2 <= WS_H, "ws map 1");
static_assert(WS_PROJ + (size_t)M * PNP * 2 <= WS_MASK && WS_A + (size_t)M * F2 * 2 <= WS_ACT && WS_ACT + (size_t)M * DFF * 2 <= WS_END && WS_TMP + (size_t)M * DM * 4 <= WS_END, "ws map 2");
constexpr int CW_TMO = 0, CW_CODE = 1, CW_BAR = 4096;

constexpr int RING_OFF = 0, RING_BYTES = 131072;
constexpr int LDSCTL_OFF = RING_BYTES + 8192, MISC_OFF = LDSCTL_OFF + 320;
constexpr int LDS_BYTES = 147456;
static_assert(MISC_OFF + 128 <= LDS_BYTES, "LDS map");

#define GAS __attribute__((address_space(1)))
#define LAS __attribute__((address_space(3)))
typedef unsigned short bf16;
typedef unsigned v4u __attribute__((ext_vector_type(4)));
typedef unsigned v2u __attribute__((ext_vector_type(2)));
typedef float f32x4 __attribute__((ext_vector_type(4)));
typedef float f32x16 __attribute__((ext_vector_type(16)));
typedef short bf16x8 __attribute__((ext_vector_type(8)));
typedef short bf16x4 __attribute__((ext_vector_type(4)));
typedef GAS unsigned gu32;
#define RLX_AGENT __ATOMIC_RELAXED, __HIP_MEMORY_SCOPE_AGENT
#define LDS_WAIT() asm volatile("s_waitcnt lgkmcnt(0)" ::: "memory")
#define VM_WAIT() asm volatile("s_waitcnt vmcnt(0)" ::: "memory")
__device__ __forceinline__ unsigned f2bf(float f) { unsigned u = __builtin_bit_cast(unsigned, f); return (u + 0x7fffu + ((u >> 16) & 1u)) >> 16; }
__device__ __forceinline__ unsigned pk2(float lo, float hi) { return f2bf(lo) | (f2bf(hi) << 16); }
__device__ __forceinline__ float bf2f(bf16 h) { return __builtin_bit_cast(float, (unsigned)h << 16); }
using pg8::bflo; using pg8::bfhi;
constexpr float S_H2 = 16.f, S_WUP = 1024.f, S_ACT = 4.f, S_WDN = 1024.f, S_YA = 16.f, S_YB = 8.f, S_MRG = 16.f, S_WA = 1024.f, S_WB = 1024.f, S_WOUT = 1024.f;
__device__ __forceinline__ float clamp448(float x) { return __builtin_amdgcn_fmed3f(x, -448.f, 448.f); }
__device__ __forceinline__ unsigned pk4_fp8(float a, float b, float c, float d) {
    int w = __builtin_amdgcn_cvt_pk_fp8_f32(clamp448(a), clamp448(b), 0, false);
    w = __builtin_amdgcn_cvt_pk_fp8_f32(clamp448(c), clamp448(d), w, true);
    return (unsigned)w;
}

#define XB_TMO      128
#define XB_XCNT(j)  (256  + 64 * (j))
#define XB_XSUB(j)  (1280 + 64 * (j))
#define XB_XGEN(j)  (2304 + 64 * (j))
#define XB_TOP      3328
#define XB_TOPGEN   3392
#define XCD_BAR_WORDS 3456
#define XB_SPIN_CAP (1u << 18)
__device__ __forceinline__ unsigned xb_ld(unsigned* p)              { return __hip_atomic_load(p, __ATOMIC_RELAXED, __HIP_MEMORY_SCOPE_AGENT); }
__device__ __forceinline__ unsigned xb_add(unsigned* p, unsigned v) { return __hip_atomic_fetch_add(p, v, __ATOMIC_RELAXED, __HIP_MEMORY_SCOPE_AGENT); }
__device__ __forceinline__ unsigned xb_xcc_id() { return (unsigned)__builtin_amdgcn_s_getreg((3 << 11) | 20) & 0xFu; }
#define XB_SPIN(cond, bar) do { unsigned _sp = 0; while (cond) { __builtin_amdgcn_s_sleep(1); \
    if ((++_sp & 255u) == 0u) { if (xb_ld(&(bar)[XB_TMO])) break; if (_sp > XB_SPIN_CAP) { atomicAdd(&(bar)[XB_TMO], 1u); break; } } } } while (0)
struct XcdBarrier { unsigned* bar; unsigned x; volatile LAS unsigned* st; };
__device__ __forceinline__ XcdBarrier xcd_barrier_post(unsigned* bar, volatile LAS unsigned* st) {
    XcdBarrier b; b.bar = bar; b.x = xb_xcc_id(); b.st = st;
    if (threadIdx.x == 0) (void)xb_add(&bar[XB_XCNT(b.x)], 1u);
    return b;
}
__device__ __forceinline__ void xcd_barrier_complete(unsigned* bar, unsigned x, unsigned& nloc, unsigned& nx) {
    const unsigned G = gridDim.x * gridDim.y * gridDim.z;
    unsigned sum, cnt, mine, sp = 0u;
    for (;;) {
        sum = 0u; cnt = 0u; mine = 0u;
#pragma unroll
        for (unsigned j = 0; j < 16; ++j) { const unsigned c = xb_ld(&bar[XB_XCNT(j)]); sum += c; cnt += (c > 0u) ? 1u : 0u; mine = (j == x) ? c : mine; }
        if (sum == G) break;
        __builtin_amdgcn_s_sleep(1);
        if ((++sp & 255u) == 0u) { if (xb_ld(&bar[XB_TMO])) break; if (sp > XB_SPIN_CAP) { atomicAdd(&bar[XB_TMO], 1u); break; } }
    }
    nloc = mine > 0u ? mine : 1u; nx = cnt > 0u ? cnt : 1u;
}
__device__ __forceinline__ void xcd_barrier(const XcdBarrier& b) {
    asm volatile("s_waitcnt vmcnt(0)" ::: "memory");
    __syncthreads();
    if (threadIdx.x == 0) {
        unsigned* bar = b.bar;
        __builtin_amdgcn_s_waitcnt(0);
        unsigned nloc = b.st[0], nx = b.st[1];
        if (nloc == 0u) { xcd_barrier_complete(bar, b.x, nloc, nx); b.st[0] = nloc; b.st[1] = nx; }
        const unsigned old = xb_add(&bar[XB_XSUB(b.x)], 1u);
        const unsigned gen = old / nloc;
        if (old + 1u == (gen + 1u) * nloc) {
            __builtin_amdgcn_fence(__ATOMIC_RELEASE, "agent");
            asm volatile("s_waitcnt vmcnt(0)" ::: "memory");
            const unsigned og = xb_add(&bar[XB_TOP], 1u);
            const unsigned tg = og / nx;
            if (og + 1u == (tg + 1u) * nx) xb_add(&bar[XB_TOPGEN], 1u);
            else XB_SPIN(xb_ld(&bar[XB_TOPGEN]) == tg, bar);
            __builtin_amdgcn_fence(__ATOMIC_ACQUIRE, "agent");
            xb_add(&bar[XB_XGEN(b.x)], 1u);
            asm volatile("s_waitcnt vmcnt(0)" ::: "memory");
        } else {
            XB_SPIN(xb_ld(&bar[XB_XGEN(b.x)]) == gen, bar);
            __builtin_amdgcn_fence(__ATOMIC_ACQUIRE, "agent");
            asm volatile("s_waitcnt vmcnt(0)" ::: "memory");
        }
    }
    __syncthreads();
}

struct Frame {
    LAS unsigned char* lds;
    volatile LAS unsigned* MISC;
    gu32* ctl;
    int tid, lane, wave, G, gw, NGW;
    const float *x, *c, *ada_w, *ada_b, *n1g, *w_in, *qng, *kng, *sgg, *sgw, *sgb, *w_a, *w_b, *w_out, *n2g, *w_up, *cvw, *cvb, *w_dn;
    float* out;
    float *MOD, *PART; bf16 *WIN, *WA, *WB, *WOUT, *WUP, *WDN, *H, *PROJ, *VT, *YA, *YB, *MRG, *A, *ACT; float *X1, *TMP, *RS, *SWT; unsigned* MASK;
};
__device__ __forceinline__ float wave_sum(float v) {
#pragma unroll
    for (int o = 1; o < 64; o <<= 1) v += __shfl_xor(v, o);
    return v;
}

template <bool FP8 = false>
__device__ __forceinline__ void transpose_item(const float* W, int Nsrc, int k0, int n0, void* dstv, size_t ldk, int drow0, LAS float* scr, int lane, float scale = 1.f) {
#pragma unroll
    for (int i = 0; i < 8; ++i) { const int kk = 8 * i + (lane >> 3); const f32x4 v = *(const GAS f32x4*)(W + (size_t)(k0 + kk) * Nsrc + n0 + 4 * (lane & 7));
        LAS float* s = scr + kk * 33 + 4 * (lane & 7); s[0] = v.x; s[1] = v.y; s[2] = v.z; s[3] = v.w; }
    LDS_WAIT(); asm volatile("" ::: "memory");
    const int c = lane & 7;
#pragma unroll
    for (int j = 0; j < 4; ++j) { const int n = (lane >> 3) + 8 * j; const LAS float* s = scr + (8 * c) * 33 + n;
        if constexpr (FP8) { v2u o; o.x = pk4_fp8(s[0 * 33] * scale, s[1 * 33] * scale, s[2 * 33] * scale, s[3 * 33] * scale); o.y = pk4_fp8(s[4 * 33] * scale, s[5 * 33] * scale, s[6 * 33] * scale, s[7 * 33] * scale);
            *(GAS v2u*)((unsigned char*)dstv + (size_t)(drow0 + n) * ldk + k0 + 8 * c) = o; }
        else { v4u o; o.x = pk2(s[0 * 33], s[1 * 33]); o.y = pk2(s[2 * 33], s[3 * 33]); o.z = pk2(s[4 * 33], s[5 * 33]); o.w = pk2(s[6 * 33], s[7 * 33]);
            *(GAS v4u*)((bf16*)dstv + (size_t)(drow0 + n) * ldk + k0 + 8 * c) = o; } }
    LDS_WAIT(); asm volatile("" ::: "memory");
}
__device__ __forceinline__ int win_dst_row(int n) {
    if (n < SKI) return n;
    if (n < SWI) return PKI + (n - SKI);
    if (n < SGU) return PWI + (n - SWI);
    return PGU + (n - SGU);
}
__device__ __forceinline__ void gemv_item(Frame& F, int item) {
    const int nb = item % 96, ks = item / 96, n0 = nb * 256 + 4 * F.lane, k0 = ks * 64;
    float cs[4];
#pragma unroll
    for (int b = 0; b < 4; ++b) { const float cv = F.c[b * DM + k0 + F.lane]; cs[b] = cv * pg8::sigmoidf_(cv); }
    f32x4 acc[4];
#pragma unroll
    for (int b = 0; b < 4; ++b) acc[b] = (f32x4){0.f, 0.f, 0.f, 0.f};
    const float* wp = F.ada_w + (size_t)k0 * MODW + n0;
#pragma unroll 16
    for (int k = 0; k < 64; ++k) { const f32x4 w = *(const GAS f32x4*)(wp + (size_t)k * MODW);
#pragma unroll
        for (int b = 0; b < 4; ++b) { const float s = __builtin_bit_cast(float, __builtin_amdgcn_readlane(__builtin_bit_cast(int, cs[b]), k)); acc[b] += w * s; } }
#pragma unroll
    for (int b = 0; b < 4; ++b) *(GAS f32x4*)(F.PART + (size_t)(ks * 4 + b) * MODW + n0) = acc[b];
}
__device__ __forceinline__ void mod_reduce(Frame& F) {
    for (int i = F.gw * 64 + F.lane; i < 4 * (MODW / 4); i += F.NGW * 64) { const int b = i / (MODW / 4), n0 = 4 * (i % (MODW / 4));
        f32x4 a = *(const GAS f32x4*)(F.ada_b + n0);
#pragma unroll 16
        for (int ks = 0; ks < 64; ++ks) a += *(const GAS f32x4*)(F.PART + (size_t)(ks * 4 + b) * MODW + n0);
        *(GAS f32x4*)(F.MOD + b * MODW + n0) = a; }
}
__device__ __forceinline__ void p0_prologue(Frame& F, bool with_gemv = true) {
    LAS float* scr = (LAS float*)(F.lds + RING_OFF + F.wave * 16384);
    constexpr int I_GV = 96 * 64;
    constexpr int I_IN = (DM / 64) * (IN_W / 32), I_A = (ATTW / 128) * (DM / 32), I_B = (GMW / 128) * (DM / 32), I_O = (DM / 128) * (DM / 32), I_UP = (DM / 128) * (F2 / 32), I_DN = (DFF / 128) * (DM / 32);
    constexpr int NITEMS = I_GV + I_IN + I_A + I_B + I_O + I_UP + I_DN;
    for (int it = F.gw; it < NITEMS; it += F.NGW) {
        int r = it;
        if (r < I_GV) { if (with_gemv) gemv_item(F, r); continue; } r -= I_GV;
        if (r < I_IN) { const int nblk = IN_W / 32, kb = r / nblk, nb = r % nblk; transpose_item(F.w_in, IN_W, 64 * kb, 32 * nb, F.WIN, DM, win_dst_row(32 * nb), scr, F.lane); continue; } r -= I_IN;
        if (r < I_A) { const int nblk = DM / 32, kb = r / nblk, nb = r % nblk; transpose_item<true>(F.w_a, DM, 128 * kb, 32 * nb, F.WA, ATTW, 32 * nb, scr, F.lane, S_WA); transpose_item<true>(F.w_a, DM, 128 * kb + 64, 32 * nb, F.WA, ATTW, 32 * nb, scr, F.lane, S_WA); continue; } r -= I_A;
        if (r < I_B) { const int nblk = DM / 32, kb = r / nblk, nb = r % nblk; transpose_item<true>(F.w_b, DM, 128 * kb, 32 * nb, F.WB, GMW, 32 * nb, scr, F.lane, S_WB); transpose_item<true>(F.w_b, DM, 128 * kb + 64, 32 * nb, F.WB, GMW, 32 * nb, scr, F.lane, S_WB); continue; } r -= I_B;
        if (r < I_O) { const int nblk = DM / 32, kb = r / nblk, nb = r % nblk; transpose_item<true>(F.w_out, DM, 128 * kb, 32 * nb, F.WOUT, DM, 32 * nb, scr, F.lane, S_WOUT); transpose_item<true>(F.w_out, DM, 128 * kb + 64, 32 * nb, F.WOUT, DM, 32 * nb, scr, F.lane, S_WOUT); continue; } r -= I_O;
        if (r < I_UP) { const int nblk = F2 / 32, kb = r / nblk, nb = r % nblk; const int n = 32 * nb; const int ch = n < DFF ? n : n - DFF;
            const int drow = (ch >> 7) * 256 + (ch & 127) + (n < DFF ? 0 : 128);
            transpose_item<true>(F.w_up, F2, 128 * kb, n, F.WUP, DM, drow, scr, F.lane, S_WUP); transpose_item<true>(F.w_up, F2, 128 * kb + 64, n, F.WUP, DM, drow, scr, F.lane, S_WUP); continue; } r -= I_UP;
        { const int nblk = DM / 32, kb = r / nblk, nb = r % nblk; transpose_item<true>(F.w_dn, DM, 128 * kb, 32 * nb, F.WDN, DFF, 32 * nb, scr, F.lane, S_WDN); transpose_item<true>(F.w_dn, DM, 128 * kb + 64, 32 * nb, F.WDN, DFF, 32 * nb, scr, F.lane, S_WDN); }
    }
    { const size_t n16 = (size_t)(PNP - IN_W) * DM * 2 / 16; GAS v4u* p = (GAS v4u*)(F.WIN + (size_t)IN_W * DM);
      for (size_t i = (size_t)F.gw * 64 + F.lane; i < n16; i += (size_t)F.NGW * 64) p[i] = (v4u){0u, 0u, 0u, 0u}; }
    for (int i = F.gw * 64 + F.lane; i < GMG * GMC * GMC; i += F.NGW * 64) { const int g = i >> 14, s = (i >> 7) & 127, t = i & 127; F.SWT[i] = F.sgw[(g * GMC + t) * GMC + s]; }
}

template <bool FP8 = false>
__device__ __forceinline__ void norm_rows(Frame& F, const float* X, const float* gain, int sh_off, int sc_off, void* Ov) {
    for (int m = F.gw; m < M; m += F.NGW) {
        const int b = m >> 11;
        const GAS f32x4* xr = (const GAS f32x4*)(X + (size_t)m * DM) + F.lane;
        f32x4 v[16]; float s = 0.f;
#pragma unroll
        for (int j = 0; j < 16; ++j) { v[j] = xr[64 * j]; s += (v[j].x * v[j].x + v[j].y * v[j].y) + (v[j].z * v[j].z + v[j].w * v[j].w); }
        const float rstd = 1.0f / sqrtf(wave_sum(s) * (1.f / DM) + EPS);
        const GAS f32x4* gp = (const GAS f32x4*)gain + F.lane;
        const GAS f32x4* shp = (const GAS f32x4*)(F.MOD + b * MODW + sh_off) + F.lane;
        const GAS f32x4* scp = (const GAS f32x4*)(F.MOD + b * MODW + sc_off) + F.lane;
        GAS v2u* o8 = (GAS v2u*)((bf16*)Ov + (size_t)m * DM) + F.lane; GAS unsigned* o4 = (GAS unsigned*)((unsigned char*)Ov + (size_t)m * DM) + F.lane;
#pragma unroll
        for (int j = 0; j < 16; ++j) { const f32x4 g = gp[64 * j], sh = shp[64 * j], sc = scp[64 * j];
            const f32x4 y = (v[j] * rstd) * g * (sc + 1.0f) + sh;
            if constexpr (FP8) o4[64 * j] = pk4_fp8(y.x * S_H2, y.y * S_H2, y.z * S_H2, y.w * S_H2);
            else { v2u w; w.x = pk2(y.x, y.y); w.y = pk2(y.z, y.w); o8[64 * j] = w; } }
    }
}

__device__ __forceinline__ unsigned sortable(float f) { const unsigned u = __builtin_bit_cast(unsigned, f); return u ^ ((unsigned)((int)u >> 31) | 0x80000000u); }
__device__ __forceinline__ void idx_row(Frame& F, int row) {
    const int lane = F.lane, b = row >> 11, t = row & 2047, hi = lane >> 5, l31 = lane & 31;
    GAS v2u* mrow = (GAS v2u*)(F.MASK + (size_t)row * 64);
    if (t < TOPK) {
        if (lane < 32) { const int k0 = 64 * lane; v2u w;
            w.x = (t >= k0 + 31) ? 0xffffffffu : (t < k0 ? 0u : ((2u << (t - k0)) - 1u));
            w.y = (t >= k0 + 63) ? 0xffffffffu : (t < k0 + 32 ? 0u : ((2u << (t - k0 - 32)) - 1u));
            mrow[lane] = w; }
        return;
    }
    const bf16* prow = F.PROJ + (size_t)row * PNP;
    bf16x8 qa[4];
#pragma unroll
    for (int ks = 0; ks < 4; ++ks) qa[ks] = *(const GAS bf16x8*)(prow + PQI + l31 * 64 + 16 * ks + 8 * hi);
    float wv[16];
#pragma unroll
    for (int r = 0; r < 16; ++r) wv[r] = bf2f(prow[PWI + (r & 3) + 8 * (r >> 2) + 4 * hi]);
    const bf16* kib = F.PROJ + (size_t)(b * SEQ) * PNP + PKI + 8 * hi;
    unsigned sc[32];
#pragma unroll
    for (int jp = 0; jp < 32; ++jp) {
        if (64 * jp <= t) {
            float s01[2];
#pragma unroll
            for (int h = 0; h < 2; ++h) {
                const bf16* kp = kib + (size_t)(64 * jp + 32 * h + l31) * PNP;
                f32x16 acc;
#pragma unroll
                for (int r = 0; r < 16; ++r) acc[r] = 0.f;
#pragma unroll
                for (int ks = 0; ks < 4; ++ks) { const bf16x8 kb = *(const GAS bf16x8*)(kp + 16 * ks); acc = __builtin_amdgcn_mfma_f32_32x32x16_bf16(qa[ks], kb, acc, 0, 0, 0); }
                float s = 0.f;
#pragma unroll
                for (int r = 0; r < 16; ++r) s += wv[r] * fmaxf(acc[r], 0.f);
                s += __shfl_xor(s, 32);
                s01[h] = s;
            }
            const float mine = (lane < 32 ? s01[0] : s01[1]) + 0.0f;
            sc[jp] = (64 * jp + lane <= t) ? sortable(mine) : 0u;
        } else sc[jp] = 0u;
    }
    unsigned thr = 0u;
    for (int bit = 31; bit >= 0; --bit) {
        const unsigned cand = thr | (1u << bit); int cnt = 0;
#pragma unroll
        for (int jp = 0; jp < 32; ++jp) cnt += __popcll(__ballot(sc[jp] >= cand));
        if (cnt >= TOPK) thr = cand;
    }
    int cgt = 0;
#pragma unroll
    for (int jp = 0; jp < 32; ++jp) cgt += __popcll(__ballot(sc[jp] > thr));
    const int need = TOPK - cgt; int seen = 0;
    unsigned mylo = 0u, myhi = 0u;
    const unsigned long long lt = (lane == 0) ? 0ull : (~0ull >> (64 - lane));
#pragma unroll
    for (int jp = 0; jp < 32; ++jp) {
        unsigned long long sel = __ballot(sc[jp] > thr);
        const unsigned long long eq = __ballot(sc[jp] == thr);
        if (eq) { const bool take = (sc[jp] == thr) && (seen + __popcll(eq & lt) < need); sel |= __ballot(take); seen += __popcll(eq); }
        if (lane == jp) { mylo = (unsigned)sel; myhi = (unsigned)(sel >> 32); }
    }
    if (lane < 32) { v2u w; w.x = mylo; w.y = myhi; mrow[lane] = w; }
}
constexpr float QSCALE = 0.08838834764831845f * 1.4426950408889634f;
__device__ __forceinline__ void qknorm_row(Frame& F, int row) {
    bf16* prow = F.PROJ + (size_t)row * PNP; const int lane = F.lane;
    {
        GAS v4u* p = (GAS v4u*)(prow + PQ + 32 * lane); v4u w[4]; float ss = 0.f;
#pragma unroll
        for (int i = 0; i < 4; ++i) { w[i] = p[i];
#pragma unroll
            for (int j = 0; j < 4; ++j) { const float a = bflo(w[i][j]), c = bfhi(w[i][j]); ss += a * a + c * c; } }
        ss += __shfl_xor(ss, 1); ss += __shfl_xor(ss, 2);
        const float r = QSCALE / sqrtf(ss * (1.f / HD) + EPS); const float* g = F.qng + 32 * (lane & 3);
#pragma unroll
        for (int i = 0; i < 4; ++i) { v4u o;
#pragma unroll
            for (int j = 0; j < 4; ++j) o[j] = pk2(bflo(w[i][j]) * r * g[8 * i + 2 * j], bfhi(w[i][j]) * r * g[8 * i + 2 * j + 1]);
            p[i] = o; }
    }
    {
        GAS v4u* p = (GAS v4u*)(prow + PK + 8 * lane); const v4u w = *p; float ss = 0.f;
#pragma unroll
        for (int j = 0; j < 4; ++j) { const float a = bflo(w[j]), c = bfhi(w[j]); ss += a * a + c * c; }
        ss += __shfl_xor(ss, 1); ss += __shfl_xor(ss, 2); ss += __shfl_xor(ss, 4); ss += __shfl_xor(ss, 8);
        const float r = 1.0f / sqrtf(ss * (1.f / HD) + EPS); const float* g = F.kng + 8 * (lane & 15); v4u o;
#pragma unroll
        for (int j = 0; j < 4; ++j) o[j] = pk2(bflo(w[j]) * r * g[2 * j], bfhi(w[j]) * r * g[2 * j + 1]);
        *p = o;
    }
    {
        const GAS v4u* p = (const GAS v4u*)(prow + PGV + 32 * lane); float ss = 0.f;
#pragma unroll
        for (int i = 0; i < 4; ++i) { const v4u w = p[i];
#pragma unroll
            for (int j = 0; j < 4; ++j) { const float a = bflo(w[j]), c = bfhi(w[j]); ss += a * a + c * c; } }
        ss = wave_sum(ss);
        if (lane == 0) F.RS[row] = 1.0f / sqrtf(ss * (1.f / GMW) + EPS);
    }
}
__device__ __forceinline__ void vt_item(Frame& F, int item) {
    const int s8 = item & 255, dh = (item >> 8) & 1, g = (item >> 9) & 3, b = item >> 11, d = 64 * dh + F.lane;
    const bf16* src = F.PROJ + (size_t)(b * SEQ + 8 * s8) * PNP + PV + g * HD + d;
    unsigned e[8];
#pragma unroll
    for (int j = 0; j < 8; ++j) e[j] = src[(size_t)j * PNP];
    v4u o; o.x = e[0] | (e[1] << 16); o.y = e[2] | (e[3] << 16); o.z = e[4] | (e[5] << 16); o.w = e[6] | (e[7] << 16);
    *(GAS v4u*)(F.VT + ((size_t)((b * NKV + g) * HD + d)) * SEQ + 8 * s8) = o;
}

__device__ __forceinline__ void attn_block(Frame& F, int b, int g, int qb) {
    const int lane = F.lane, w = F.wave, hi = lane >> 5, l31 = lane & 31;
    const int hh = 4 * g + (w >> 1), t = qb * 64 + 32 * (w & 1) + l31;
    const size_t row = (size_t)b * SEQ + t;
    const float slope2 = exp2f(-0.5f * (float)(hh + 1)) * 1.4426950408889634f;
    bf16x8 qf[8];
#pragma unroll
    for (int ks = 0; ks < 8; ++ks) qf[ks] = *(const GAS bf16x8*)(F.PROJ + row * PNP + PQ + hh * HD + 16 * ks + 8 * hi);
    f32x16 o[4];
#pragma unroll
    for (int db = 0; db < 4; ++db)
#pragma unroll
        for (int r = 0; r < 16; ++r) o[db][r] = 0.f;
    float m = -1e30f, lsum = 0.f;
    const bf16* kbase = F.PROJ + (size_t)(b * SEQ + l31) * PNP + PK + g * HD + 8 * hi;
    const bf16* vbase = F.VT + ((size_t)((b * NKV + g) * HD + l31)) * SEQ + 4 * hi;
    const unsigned* mbase = F.MASK + row * 64;
    for (int kt = 0; kt <= qb; ++kt) {
        const v2u mw = *(const GAS v2u*)(mbase + 2 * kt);
        f32x16 p[2];
#pragma unroll
        for (int kb = 0; kb < 2; ++kb) {
#pragma unroll
            for (int r = 0; r < 16; ++r) p[kb][r] = 0.f;
            const bf16* kp = kbase + (size_t)(64 * kt + 32 * kb) * PNP;
#pragma unroll
            for (int ks = 0; ks < 8; ++ks) { const bf16x8 kf = *(const GAS bf16x8*)(kp + 16 * ks); p[kb] = __builtin_amdgcn_mfma_f32_32x32x16_bf16(kf, qf[ks], p[kb], 0, 0, 0); }
        }
        const float base = -slope2 * (float)(t - 64 * kt - 4 * hi);
        float rmax = -3e30f;
#pragma unroll
        for (int kb = 0; kb < 2; ++kb) { const unsigned mword = (kb ? mw.y : mw.x) >> (4 * hi);
#pragma unroll
            for (int r = 0; r < 16; ++r) { const int ko = (r & 3) + 8 * (r >> 2);
                float s = p[kb][r] + (base + slope2 * (float)(32 * kb + ko));
                s = ((mword >> ko) & 1u) ? s : -2e30f; p[kb][r] = s; rmax = fmaxf(rmax, s); } }
        rmax = fmaxf(rmax, __shfl_xor(rmax, 32));
        const float mn = fmaxf(m, rmax), alpha = exp2f(m - mn); m = mn;
        float ps = 0.f;
#pragma unroll
        for (int kb = 0; kb < 2; ++kb)
#pragma unroll
            for (int r = 0; r < 16; ++r) { const float e = exp2f(p[kb][r] - mn); p[kb][r] = e; ps += e; }
        lsum = lsum * alpha + ps;
#pragma unroll
        for (int db = 0; db < 4; ++db)
#pragma unroll
            for (int r = 0; r < 16; ++r) o[db][r] *= alpha;
#pragma unroll
        for (int kb = 0; kb < 2; ++kb)
#pragma unroll
            for (int s2 = 0; s2 < 2; ++s2) {
                v4u pw; pw.x = pk2(p[kb][8 * s2 + 0], p[kb][8 * s2 + 1]); pw.y = pk2(p[kb][8 * s2 + 2], p[kb][8 * s2 + 3]); pw.z = pk2(p[kb][8 * s2 + 4], p[kb][8 * s2 + 5]); pw.w = pk2(p[kb][8 * s2 + 6], p[kb][8 * s2 + 7]);
                const bf16x8 pb = __builtin_bit_cast(bf16x8, pw);
                const bf16* vp = vbase + 64 * kt + 32 * kb + 16 * s2;
#pragma unroll
                for (int db = 0; db < 4; ++db) { const v2u v0 = *(const GAS v2u*)(vp + (size_t)(32 * db) * SEQ), v1 = *(const GAS v2u*)(vp + (size_t)(32 * db) * SEQ + 8);
                    v4u vw; vw.x = v0.x; vw.y = v0.y; vw.z = v1.x; vw.w = v1.y;
                    o[db] = __builtin_amdgcn_mfma_f32_32x32x16_bf16(__builtin_bit_cast(bf16x8, vw), pb, o[db], 0, 0, 0); }
            }
    }
    lsum += __shfl_xor(lsum, 32);
    const float inv = S_YA / lsum;
    unsigned char* yrow = (unsigned char*)F.YA + row * ATTW + hh * HD + 4 * hi;
#pragma unroll
    for (int db = 0; db < 4; ++db)
#pragma unroll
        for (int rq = 0; rq < 4; ++rq) *(GAS unsigned*)(yrow + 32 * db + 8 * rq) = pk4_fp8(o[db][4 * rq] * inv, o[db][4 * rq + 1] * inv, o[db][4 * rq + 2] * inv, o[db][4 * rq + 3] * inv);
}

__device__ __forceinline__ void sgu_unit(Frame& F, int unit) {
    const int ck = unit >> 3, g = unit & 7, r0 = ck * GMC, c0 = g * GMGW, tid = F.tid;
    LAS unsigned* XB = (LAS unsigned*)(F.lds);
    LAS float* WT = (LAS float*)(F.lds + 65536);
    __syncthreads();
#pragma unroll
    for (int i = 0; i < 8; ++i) { const int c = tid + 512 * i, s = c >> 5, q = c & 31;
        *(LAS v4u*)(F.lds + s * 512 + q * 16) = *(const GAS v4u*)(F.PROJ + (size_t)(r0 + s) * PNP + PGV + c0 + 8 * q); }
#pragma unroll 4
    for (int i = 0; i < 32; ++i) { const int e = tid + 512 * i, s = e >> 7, t = e & 127;
        WT[e] = (s <= t) ? F.SWT[(g * GMC + s) * GMC + t] * F.RS[r0 + s] : 0.f; }
    __syncthreads();
    const int cp = tid & 127, tq = tid >> 7;
    const float sg0 = F.sgg[c0 + 2 * cp], sg1 = F.sgg[c0 + 2 * cp + 1];
    for (int pass = 0; pass < 4; ++pass) {
        const int t0 = 8 * (4 * pass + tq);
        float a0[8], a1[8];
#pragma unroll
        for (int j = 0; j < 8; ++j) { a0[j] = 0.f; a1[j] = 0.f; }
        for (int s = 0; s < t0 + 8; ++s) {
            const unsigned xw = XB[s * 128 + cp]; const float x0 = bflo(xw), x1 = bfhi(xw);
            const f32x4 w0 = *(const LAS f32x4*)(WT + s * 128 + t0), w1 = *(const LAS f32x4*)(WT + s * 128 + t0 + 4);
#pragma unroll
            for (int j = 0; j < 4; ++j) { a0[j] += w0[j] * x0; a1[j] += w0[j] * x1; a0[4 + j] += w1[j] * x0; a1[4 + j] += w1[j] * x1; }
        }
#pragma unroll
        for (int j = 0; j < 8; ++j) { const int t = t0 + j; const float bb = F.sgb[g * GMC + t];
            const unsigned uw = *(const GAS unsigned*)(F.PROJ + (size_t)(r0 + t) * PNP + PGU + c0 + 2 * cp);
            *(GAS unsigned short*)((unsigned char*)F.YB + (size_t)(r0 + t) * GMW + c0 + 2 * cp) = (unsigned short)__builtin_amdgcn_cvt_pk_fp8_f32(clamp448(S_YB * bflo(uw) * (a0[j] * sg0 + bb)), clamp448(S_YB * bfhi(uw) * (a1[j] * sg1 + bb)), 0, false); }
    }
}

using pg8::Unit; using pg8::cvt_pk_bf16;
struct EpiProj {
    static constexpr bool PERM = true; bf16* O;
    __device__ __forceinline__ void operator()(const f32x4 (&acc)[2][2][4][2], const Unit& u, int wr, int wc, int fr, int fq) const {
        const int act = (u.pn >= PGU / 256 && u.pn < PGA / 256) ? 1 : ((u.pn >= PGA / 256 && u.pn < PKI / 256) ? 2 : 0);
        const int row0 = u.pm * 256 + wr * 64 + fr, col0 = u.pn * 256 + wc * 32 + 8 * fq;
#pragma unroll
        for (int ai = 0; ai < 2; ++ai)
#pragma unroll
            for (int m = 0; m < 4; ++m) { bf16* rowp = O + (size_t)(row0 + ai * 128 + m * 16) * PNP + col0;
#pragma unroll
                for (int bj = 0; bj < 2; ++bj) { f32x4 v0 = acc[ai][bj][m][0], v1 = acc[ai][bj][m][1];
                    if (act == 1) { const pg8::f32x2 a = pg8::gelu_pk((pg8::f32x2){v0[0], v0[1]}), b = pg8::gelu_pk((pg8::f32x2){v0[2], v0[3]}), c = pg8::gelu_pk((pg8::f32x2){v1[0], v1[1]}), d = pg8::gelu_pk((pg8::f32x2){v1[2], v1[3]});
                        v0 = (f32x4){a.x, a.y, b.x, b.y}; v1 = (f32x4){c.x, c.y, d.x, d.y}; }
                    else if (act == 2) {
#pragma unroll
                        for (int j = 0; j < 4; ++j) { v0[j] = pg8::sigmoidf_(v0[j]); v1[j] = pg8::sigmoidf_(v1[j]); } }
                    v4u w; w.x = cvt_pk_bf16(v0[0], v0[1]); w.y = cvt_pk_bf16(v0[2], v0[3]); w.z = cvt_pk_bf16(v1[0], v1[1]); w.w = cvt_pk_bf16(v1[2], v1[3]);
                    *(GAS v4u*)(rowp + bj * 128) = w; } }
    }
};
struct EpiGateA {
    static constexpr bool PERM = true; const bf16* P; float* T; float scale;
    __device__ __forceinline__ void operator()(const f32x4 (&acc)[2][2][4][2], const Unit& u, int wr, int wc, int fr, int fq) const {
        const int row0 = u.pm * 256 + wr * 64 + fr, col0 = u.pn * 256 + wc * 32 + 8 * fq;
#pragma unroll
        for (int ai = 0; ai < 2; ++ai)
#pragma unroll
            for (int m = 0; m < 4; ++m) { const size_t r = (size_t)(row0 + ai * 128 + m * 16);
#pragma unroll
                for (int bj = 0; bj < 2; ++bj) { const v4u gw = *(const GAS v4u*)(P + r * PNP + PGA + col0 + bj * 128);
                    f32x4 v0 = acc[ai][bj][m][0], v1 = acc[ai][bj][m][1];
                    v0 = v0 * ((f32x4){bflo(gw.x), bfhi(gw.x), bflo(gw.y), bfhi(gw.y)} * scale); v1 = v1 * ((f32x4){bflo(gw.z), bfhi(gw.z), bflo(gw.w), bfhi(gw.w)} * scale);
                    GAS f32x4* tp = (GAS f32x4*)(T + r * DM + col0 + bj * 128); tp[0] = v0; tp[1] = v1; } }
    }
};
struct EpiGateB {
    static constexpr bool PERM = true; const bf16* P; const float* T; unsigned char* O; float scale;
    __device__ __forceinline__ void operator()(const f32x4 (&acc)[2][2][4][2], const Unit& u, int wr, int wc, int fr, int fq) const {
        const int row0 = u.pm * 256 + wr * 64 + fr, col0 = u.pn * 256 + wc * 32 + 8 * fq;
#pragma unroll
        for (int ai = 0; ai < 2; ++ai)
#pragma unroll
            for (int m = 0; m < 4; ++m) { const size_t r = (size_t)(row0 + ai * 128 + m * 16);
#pragma unroll
                for (int bj = 0; bj < 2; ++bj) { const v4u gw = *(const GAS v4u*)(P + r * PNP + PGB + col0 + bj * 128);
                    const GAS f32x4* tp = (const GAS f32x4*)(T + r * DM + col0 + bj * 128);
                    const f32x4 v0 = (tp[0] + acc[ai][bj][m][0] * ((f32x4){bflo(gw.x), bfhi(gw.x), bflo(gw.y), bfhi(gw.y)} * scale)) * S_MRG;
                    const f32x4 v1 = (tp[1] + acc[ai][bj][m][1] * ((f32x4){bflo(gw.z), bfhi(gw.z), bflo(gw.w), bfhi(gw.w)} * scale)) * S_MRG;
                    v2u w; w.x = pk4_fp8(v0[0], v0[1], v0[2], v0[3]); w.y = pk4_fp8(v1[0], v1[1], v1[2], v1[3]);
                    *(GAS v2u*)(O + r * DM + col0 + bj * 128) = w; } }
    }
};
struct EpiResid {
    static constexpr bool PERM = false; const float* base; const float* gate; float* C; float scale;
    __device__ __forceinline__ void operator()(const f32x4 (&acc)[2][2][4][2], const Unit& u, int wr, int wc, int fr, int fq) const {
        const int row0 = u.pm * 256 + wr * 64 + fr, col0 = u.pn * 256 + wc * 32 + 4 * fq; const float* gp = gate + (u.pm >> 3) * MODW + col0;
        f32x4 gv[2][2];
#pragma unroll
        for (int bj = 0; bj < 2; ++bj)
#pragma unroll
            for (int n = 0; n < 2; ++n) gv[bj][n] = *(const GAS f32x4*)(gp + bj * 128 + n * 16) * scale;
#pragma unroll
        for (int ai = 0; ai < 2; ++ai)
#pragma unroll
            for (int m = 0; m < 4; ++m) { const size_t off = (size_t)(row0 + ai * 128 + m * 16) * DM + col0;
#pragma unroll
                for (int bj = 0; bj < 2; ++bj)
#pragma unroll
                    for (int n = 0; n < 2; ++n) { const f32x4 bs = *(const GAS f32x4*)(base + off + bj * 128 + n * 16);
                        *(GAS f32x4*)(C + off + bj * 128 + n * 16) = bs + gv[bj][n] * acc[ai][bj][m][n]; } }
    }
};
struct EpiPlain {
    static constexpr bool PERM = true; bf16* O; int ldc; float scale;
    __device__ __forceinline__ void operator()(const f32x4 (&acc)[2][2][4][2], const Unit& u, int wr, int wc, int fr, int fq) const {
        const int row0 = u.pm * 256 + wr * 64 + fr, col0 = u.pn * 256 + wc * 32 + 8 * fq;
#pragma unroll
        for (int ai = 0; ai < 2; ++ai)
#pragma unroll
            for (int m = 0; m < 4; ++m) { bf16* rowp = O + (size_t)(row0 + ai * 128 + m * 16) * ldc + col0;
#pragma unroll
                for (int bj = 0; bj < 2; ++bj) { const f32x4 v0 = acc[ai][bj][m][0] * scale, v1 = acc[ai][bj][m][1] * scale;
                    v4u w; w.x = cvt_pk_bf16(v0[0], v0[1]); w.y = cvt_pk_bf16(v0[2], v0[3]); w.z = cvt_pk_bf16(v1[0], v1[1]); w.w = cvt_pk_bf16(v1[2], v1[3]);
                    *(GAS v4u*)(rowp + bj * 128) = w; } }
    }
};

__device__ __forceinline__ void conv_phase(Frame& F) {
    constexpr int C8 = DFF / 8, TB = 16, NTB = M / TB;
    const size_t total = (size_t)C8 * NTB;
    for (size_t idx = (size_t)F.gw * 64 + F.lane; idx < total; idx += (size_t)F.NGW * 64) {
        const int c8 = (int)(idx % C8), tb = (int)(idx / C8), ch = 8 * c8, t0 = tb * TB;
        const int acol = (ch >> 7) * 256 + (ch & 127);
        float wg[3][8], wv[3][8], bg[8], bv[8];
#pragma unroll
        for (int j = 0; j < 3; ++j) { const f32x4 a = *(const GAS f32x4*)(F.cvw + (size_t)j * F2 + ch), b = *(const GAS f32x4*)(F.cvw + (size_t)j * F2 + ch + 4);
            const f32x4 c = *(const GAS f32x4*)(F.cvw + (size_t)j * F2 + DFF + ch), d = *(const GAS f32x4*)(F.cvw + (size_t)j * F2 + DFF + ch + 4);
#pragma unroll
            for (int e = 0; e < 4; ++e) { wg[j][e] = a[e]; wg[j][4 + e] = b[e]; wv[j][e] = c[e]; wv[j][4 + e] = d[e]; } }
        { const f32x4 a = *(const GAS f32x4*)(F.cvb + ch), b = *(const GAS f32x4*)(F.cvb + ch + 4), c = *(const GAS f32x4*)(F.cvb + DFF + ch), d = *(const GAS f32x4*)(F.cvb + DFF + ch + 4);
#pragma unroll
          for (int e = 0; e < 4; ++e) { bg[e] = a[e]; bg[4 + e] = b[e]; bv[e] = c[e]; bv[4 + e] = d[e]; } }
        float g1[8], g2[8], v1[8], v2[8];
        const bool first = (t0 & (SEQ - 1)) == 0;
        const bf16* ap = F.A + (size_t)t0 * F2 + acol;
        if (first) {
#pragma unroll
            for (int e = 0; e < 8; ++e) { g1[e] = g2[e] = v1[e] = v2[e] = 0.f; }
        } else {
            const v4u ga = *(const GAS v4u*)(ap - F2), gb = *(const GAS v4u*)(ap - 2 * (size_t)F2), va = *(const GAS v4u*)(ap - F2 + 128), vb = *(const GAS v4u*)(ap - 2 * (size_t)F2 + 128);
#pragma unroll
            for (int e = 0; e < 4; ++e) { g1[2 * e] = bflo(ga[e]); g1[2 * e + 1] = bfhi(ga[e]); g2[2 * e] = bflo(gb[e]); g2[2 * e + 1] = bfhi(gb[e]);
                v1[2 * e] = bflo(va[e]); v1[2 * e + 1] = bfhi(va[e]); v2[2 * e] = bflo(vb[e]); v2[2 * e + 1] = bfhi(vb[e]); }
        }
#pragma unroll 4
        for (int i = 0; i < TB; ++i) {
            const v4u gw = *(const GAS v4u*)(ap + (size_t)i * F2), vw = *(const GAS v4u*)(ap + (size_t)i * F2 + 128);
            float g0[8], v0[8], y[8];
#pragma unroll
            for (int e = 0; e < 4; ++e) { g0[2 * e] = bflo(gw[e]); g0[2 * e + 1] = bfhi(gw[e]); v0[2 * e] = bflo(vw[e]); v0[2 * e + 1] = bfhi(vw[e]); }
#pragma unroll
            for (int e = 0; e < 8; ++e) { const float gt = bg[e] + wg[0][e] * g2[e] + wg[1][e] * g1[e] + wg[2][e] * g0[e];
                const float vl = bv[e] + wv[0][e] * v2[e] + wv[1][e] * v1[e] + wv[2][e] * v0[e];
                y[e] = gt * pg8::sigmoidf_(gt) * vl; g2[e] = g1[e]; g1[e] = g0[e]; v2[e] = v1[e]; v1[e] = v0[e]; }
            v2u o; o.x = pk4_fp8(y[0] * S_ACT, y[1] * S_ACT, y[2] * S_ACT, y[3] * S_ACT); o.y = pk4_fp8(y[4] * S_ACT, y[5] * S_ACT, y[6] * S_ACT, y[7] * S_ACT);
            *(GAS v2u*)((unsigned char*)F.ACT + (size_t)(t0 + i) * DFF + ch) = o;
        }
    }
}

constexpr int N_PHASES = 12;
struct Args { const float* in[19]; float* out; unsigned char* ws; int ph_lo, ph_hi, li, pad; };
__global__ void __launch_bounds__(NWAVES * 64, 2) mega_fwd(Args args) {
    extern __shared__ __attribute__((aligned(16))) unsigned char lds[];
    Frame F;
    F.lds = (LAS unsigned char*)lds;
    F.MISC = (volatile LAS unsigned*)(F.lds + MISC_OFF);
    F.tid = threadIdx.x; F.lane = F.tid & 63; F.wave = __builtin_amdgcn_readfirstlane(F.tid >> 6);
    F.G = gridDim.x; F.gw = blockIdx.x * NWAVES + F.wave; F.NGW = F.G * NWAVES;
    unsigned char* ws = args.ws;
    F.ctl = (gu32*)(ws + WS_CTL);
    F.x = args.in[0]; F.c = args.in[1]; F.ada_w = args.in[2]; F.ada_b = args.in[3]; F.n1g = args.in[4]; F.w_in = args.in[5]; F.qng = args.in[6]; F.kng = args.in[7];
    F.sgg = args.in[8]; F.sgw = args.in[9]; F.sgb = args.in[10]; F.w_a = args.in[11]; F.w_b = args.in[12]; F.w_out = args.in[13]; F.n2g = args.in[14]; F.w_up = args.in[15];
    F.cvw = args.in[16]; F.cvb = args.in[17]; F.w_dn = args.in[18]; F.out = args.out;
    F.MOD = (float*)(ws + WS_MOD); F.PART = (float*)(ws + WS_TMP);   F.WIN = (bf16*)(ws + WS_WIN); F.WA = (bf16*)(ws + WS_WA); F.WB = (bf16*)(ws + WS_WB); F.WOUT = (bf16*)(ws + WS_WOUT); F.WUP = (bf16*)(ws + WS_WUP); F.WDN = (bf16*)(ws + WS_WDN);
    F.H = (bf16*)(ws + WS_H); F.X1 = (float*)(ws + WS_X1); F.PROJ = (bf16*)(ws + WS_PROJ); F.MASK = (unsigned*)(ws + WS_MASK); F.RS = (float*)(ws + WS_RS); F.SWT = (float*)(ws + WS_SWT);
    F.VT = (bf16*)(ws + WS_VT); F.YA = (bf16*)(ws + WS_YA); F.YB = (bf16*)(ws + WS_YB); F.MRG = (bf16*)(ws + WS_MRG); F.TMP = (float*)(ws + WS_TMP); F.A = (bf16*)(ws + WS_A); F.ACT = (bf16*)(ws + WS_ACT);
    for (int u = F.tid; u < (LDS_BYTES - LDSCTL_OFF) / 4; u += NWAVES * 64) ((LAS unsigned*)(F.lds + LDSCTL_OFF))[u] = 0u;
    __syncthreads();
    XcdBarrier bar; bar.bar = (unsigned*)(F.ctl + CW_BAR); bar.x = 0; bar.st = nullptr;
    if (MK_N_LAUNCHES == 1) bar = xcd_barrier_post((unsigned*)(F.ctl + CW_BAR), F.MISC + 8);
    const int lo = args.ph_lo, hi = args.ph_hi;
#define IN(k) (lo <= (k) && (k) < hi)
#define SEAM(k) do { if (IN(k) && IN((k) + 1)) xcd_barrier(bar); } while (0)

#define REP(k) if ((PROBE_MASK >> (k)) & 1) for (int _rep = 0; _rep < 1; ++_rep)
    if (IN(0)) { p0_prologue(F); REP(0) { xcd_barrier(bar); p0_prologue(F, false); } } SEAM(0);
    if (IN(1)) { mod_reduce(F); } SEAM(1);
    if (IN(2)) { norm_rows(F, F.x, F.n1g, 0, DM, F.H); REP(2) { xcd_barrier(bar); norm_rows(F, F.x, F.n1g, 0, DM, F.H); } } SEAM(2);
    if (IN(3)) { pg8::Gemm g{F.H, F.WIN, M, PNP, DM, DM, DM}; pg8::StaticOrder S; S.init(M, PNP, F.G, (int)blockIdx.x); EpiProj E{F.PROJ};
        pg8::gemm_phase<EpiProj, pg8::StaticOrder, true>(F.lds + RING_OFF, g, S, E);
        REP(3) { xcd_barrier(bar); pg8::gemm_phase<EpiProj, pg8::StaticOrder, true>(F.lds + RING_OFF, g, S, E); } } SEAM(3);
    if (IN(4)) {
        for (int row = F.gw; row < M; row += F.NGW) { idx_row(F, row); qknorm_row(F, row); }
        for (int it = F.gw; it < BATCH * NKV * 2 * 256; it += F.NGW) vt_item(F, it);
        REP(4) { xcd_barrier(bar); for (int row = F.gw; row < M; row += F.NGW) { idx_row(F, row); } }
        REP(13) { xcd_barrier(bar); for (int it = F.gw; it < BATCH * NKV * 2 * 256; it += F.NGW) vt_item(F, it); }
    } SEAM(4);
    if (IN(5)) {
        for (int p = blockIdx.x; p < 256; p += F.G) { const int bg = p >> 4, j = p & 15; attn_block(F, bg >> 2, bg & 3, j); attn_block(F, bg >> 2, bg & 3, 31 - j); }
        REP(5) { xcd_barrier(bar); for (int p = blockIdx.x; p < 256; p += F.G) { const int bg = p >> 4, j = p & 15; attn_block(F, bg >> 2, bg & 3, j); attn_block(F, bg >> 2, bg & 3, 31 - j); } }
        for (int u = blockIdx.x; u < 512; u += F.G) sgu_unit(F, u);
        __syncthreads();
        REP(14) { xcd_barrier(bar); for (int u = blockIdx.x; u < 512; u += F.G) sgu_unit(F, u); __syncthreads(); }
    } SEAM(5);
    if (IN(6)) {
        { pg8::Gemm g{F.YA, F.WA, M, DM, ATTW, ATTW, ATTW}; pg8::StaticOrder S; S.init(M, DM, F.G, (int)blockIdx.x); EpiGateA E{F.PROJ, F.TMP, 1.0f / (S_YA * S_WA)};
          pg8::gemm_phase<EpiGateA, pg8::StaticOrder, true, 1>(F.lds + RING_OFF, g, S, E); }
        VM_WAIT(); __syncthreads();
        { pg8::Gemm g{F.YB, F.WB, M, DM, GMW, GMW, GMW}; pg8::StaticOrder S; S.init(M, DM, F.G, (int)blockIdx.x); EpiGateB E{F.PROJ, F.TMP, (unsigned char*)F.MRG, 1.0f / (S_YB * S_WB)};
          pg8::gemm_phase<EpiGateB, pg8::StaticOrder, true, 1>(F.lds + RING_OFF, g, S, E); }
        REP(6) { xcd_barrier(bar);
          { pg8::Gemm g{F.YA, F.WA, M, DM, ATTW, ATTW, ATTW}; pg8::StaticOrder S; S.init(M, DM, F.G, (int)blockIdx.x); EpiGateA E{F.PROJ, F.TMP, 1.0f / (S_YA * S_WA)};
            pg8::gemm_phase<EpiGateA, pg8::StaticOrder, true, 1>(F.lds + RING_OFF, g, S, E); }
          VM_WAIT(); __syncthreads();
          { pg8::Gemm g{F.YB, F.WB, M, DM, GMW, GMW, GMW}; pg8::StaticOrder S; S.init(M, DM, F.G, (int)blockIdx.x); EpiGateB E{F.PROJ, F.TMP, (unsigned char*)F.MRG, 1.0f / (S_YB * S_WB)};
            pg8::gemm_phase<EpiGateB, pg8::StaticOrder, true, 1>(F.lds + RING_OFF, g, S, E); } }
    } SEAM(6);
    if (IN(7)) { pg8::Gemm g{F.MRG, F.WOUT, M, DM, DM, DM, DM}; pg8::StaticOrder S; S.init(M, DM, F.G, (int)blockIdx.x); EpiResid E{F.x, F.MOD + 2 * DM, F.X1, 1.0f / (S_MRG * S_WOUT)};
        pg8::gemm_phase<EpiResid, pg8::StaticOrder, true, 1>(F.lds + RING_OFF, g, S, E);
        REP(7) { xcd_barrier(bar); pg8::gemm_phase<EpiResid, pg8::StaticOrder, true, 1>(F.lds + RING_OFF, g, S, E); } } SEAM(7);
    if (IN(8)) { norm_rows<true>(F, F.X1, F.n2g, 3 * DM, 4 * DM, F.H); REP(8) { xcd_barrier(bar); norm_rows<true>(F, F.X1, F.n2g, 3 * DM, 4 * DM, F.H); } } SEAM(8);
    if (IN(9)) { pg8::Gemm g{F.H, F.WUP, M, F2, DM, DM, DM}; pg8::StaticOrder S; S.init(M, F2, F.G, (int)blockIdx.x); EpiPlain E{F.A, F2, 1.0f / (S_H2 * S_WUP)};
        pg8::gemm_phase<EpiPlain, pg8::StaticOrder, true, 1>(F.lds + RING_OFF, g, S, E);
        REP(9) { xcd_barrier(bar); pg8::gemm_phase<EpiPlain, pg8::StaticOrder, true, 1>(F.lds + RING_OFF, g, S, E); } } SEAM(9);
    if (IN(10)) { conv_phase(F); REP(10) { xcd_barrier(bar); conv_phase(F); } } SEAM(10);
    if (IN(11)) { pg8::Gemm g{F.ACT, F.WDN, M, DM, DFF, DFF, DFF}; pg8::StaticOrder S; S.init(M, DM, F.G, (int)blockIdx.x); EpiResid E{F.X1, F.MOD + 5 * DM, F.out, 1.0f / (S_ACT * S_WDN)};
        pg8::gemm_phase<EpiResid, pg8::StaticOrder, true, 1>(F.lds + RING_OFF, g, S, E);
        REP(11) { xcd_barrier(bar); pg8::gemm_phase<EpiResid, pg8::StaticOrder, true, 1>(F.lds + RING_OFF, g, S, E); } }
#undef REP
#undef IN
#undef SEAM
}

extern "C" void kernel_launch(void* const* d_in, const int* in_sizes, int n_in, void* d_out, int out_size, void* d_ws, size_t ws_size, hipStream_t stream) {
    static int grid = 0;
    if (grid == 0) {
        if (n_in != 19 || in_sizes[0] != M * DM || out_size != M * DM || ws_size < WS_END) { fprintf(stderr, "kernel_launch: unexpected shapes (n_in %d, in0 %d, out %d, ws %zu < %zu); nothing launched\n", n_in, n_in > 0 ? in_sizes[0] : -1, out_size, ws_size, (size_t)WS_END); grid = -1; return; }
        int dev = 0, cus = 0, per_cu = 0;
        if (hipGetDevice(&dev) != hipSuccess || hipDeviceGetAttribute(&cus, hipDeviceAttributeMultiprocessorCount, dev) != hipSuccess) { fprintf(stderr, "kernel_launch: device query failed\n"); grid = -1; return; }
        if (hipFuncSetAttribute((const void*)mega_fwd, hipFuncAttributeMaxDynamicSharedMemorySize, LDS_BYTES) != hipSuccess) { fprintf(stderr, "kernel_launch: hipFuncSetAttribute failed\n"); grid = -1; return; }
        if (hipOccupancyMaxActiveBlocksPerMultiprocessor(&per_cu, (const void*)mega_fwd, NWAVES * 64, LDS_BYTES) != hipSuccess || per_cu < 1) { fprintf(stderr, "kernel_launch: occupancy query reports %d blocks per CU\n", per_cu); }
        (void)hipGetLastError();
        grid = cus;
    }
    if (grid < 0) return;
    if (hipMemsetAsync((char*)d_ws + WS_CTL, 0, CTL_ZERO_BYTES, stream) != hipSuccess) { fprintf(stderr, "kernel_launch: memset failed\n"); return; }
    Args a{};
    for (int i = 0; i < 19; ++i) a.in[i] = (const float*)d_in[i];
    a.out = (float*)d_out; a.ws = (unsigned char*)d_ws; a.pad = 0;
    for (int li = 0; li < MK_N_LAUNCHES; ++li) {
        if (MK_N_LAUNCHES == 1) { a.ph_lo = 0; a.ph_hi = N_PHASES; } else { a.ph_lo = li; a.ph_hi = li + 1; }
        a.li = li;
        hipLaunchKernelGGL(mega_fwd, dim3(grid), dim3(NWAVES * 64), LDS_BYTES, stream, a);
        const hipError_t le = hipPeekAtLastError();
        if (le != hipSuccess) { fprintf(stderr, "kernel_launch: launch %d failed: %s\n", li, hipGetErrorName(le)); break; }
    }
}
```

```cpp
#include <hip/hip_runtime.h>
#include <cstdio>
#include <cstdint>

#ifndef MK_N_LAUNCHES
#define MK_N_LAUNCHES 1
#endif
#ifndef PROBE_MASK
#define PROBE_MASK 0x0
#endif

namespace pg8 {
#define PG8_LAS __attribute__((address_space(3)))
typedef unsigned short bf16_t;
typedef short bf16x8 __attribute__((ext_vector_type(8)));
typedef float f32x4 __attribute__((ext_vector_type(4)));
typedef float f32x2 __attribute__((ext_vector_type(2)));
typedef unsigned u32x4 __attribute__((ext_vector_type(4)));
typedef unsigned u32x2 __attribute__((ext_vector_type(2)));
constexpr int BM = 256, BK = 64, HALF = 128, HTB = HALF * BK * 2, STAGE_BYTES = 8 * HTB, NXCD = 8, WGM = 8;

__host__ __device__ __forceinline__ int lds_byte(int r, int c) { const int st = (r >> 4) * 2 + (c >> 5), rr = r & 15, cc = c & 31, ob = rr * 64 + cc * 2; return st * 1024 + (ob ^ (((ob >> 9) & 1) << 5)); }
__host__ __device__ __forceinline__ void stage_rc(int b, int& R, int& C) { const int st = b / 1024, sb = b % 1024, swz = sb ^ (((sb >> 9) & 1) << 5); R = (st >> 1) * 16 + swz / 64; C = (st & 1) * 32 + (swz % 64) / 2; }
__host__ __device__ __forceinline__ int perm32(int rho) { const int n = rho >> 4, i = rho & 15; return 8 * (i >> 2) + 4 * n + (i & 3); }

struct Unit { int pm, pn; };
struct Gemm { const bf16_t* A; const bf16_t* Bt; int M, N, K, lda, ldb; };

struct StaticOrder {
    int nM, nN, nwg, G, c;
    __host__ __device__ void init(int M, int N, int G_, int c_) { nM = M / BM; nN = N / BM; nwg = nM * nN; G = G_; c = c_; }
    __host__ __device__ bool next(int i, Unit& u) const {
        const long L = (long)i * G + c; if (L >= nwg) return false;
        int wgid = (int)L; { const int q = nwg / NXCD, r = nwg % NXCD, xcd = wgid % NXCD, off = wgid / NXCD; wgid = (xcd < r ? xcd * (q + 1) : r * (q + 1) + (xcd - r) * q) + off; }
        const int nig = WGM * nN, gid = wgid / nig, fm = gid * WGM, gsz = (nM - fm) < WGM ? (nM - fm) : WGM;
        u.pm = fm + ((wgid % nig) % gsz); u.pn = (wgid % nig) / gsz; return true;
    }
    __device__ __forceinline__ void a_ready(const Unit&) const {}
    __device__ __forceinline__ void done(const Unit&) const {}
};

__device__ __forceinline__ unsigned cvt_pk_bf16(float lo, float hi) { unsigned r; asm volatile("v_cvt_pk_bf16_f32 %0, %1, %2" : "=v"(r) : "v"(lo), "v"(hi)); return r; }
__device__ __forceinline__ f32x2 gelu_pk(f32x2 v) {
    const f32x2 av = __builtin_elementwise_abs(v), d = av * 0.2316418882f + 1.0f;
    f32x2 t; t.x = __builtin_amdgcn_rcpf(d.x); t.y = __builtin_amdgcn_rcpf(d.y);
    f32x2 q = t * 0.5307027145f + (-0.7265760135f); q = q * t + 0.7107068705f; q = q * t + (-0.142248368f); q = q * t + 0.127414796f; q = q * t;
    const f32x2 s = (v * v) * (-0.72134752044f);
    f32x2 e; e.x = __builtin_amdgcn_exp2f(s.x); e.y = __builtin_amdgcn_exp2f(s.y);
    const f32x2 m = v * (q * e), r = v - m;
    f32x2 o; o.x = v.x < 0.f ? m.x : r.x; o.y = v.y < 0.f ? m.y : r.y; return o;
}
__device__ __forceinline__ float sigmoidf_(float x) { return __builtin_amdgcn_rcpf(1.0f + __builtin_amdgcn_exp2f(-1.4426950408889634f * x)); }
__device__ __forceinline__ float bflo(unsigned w) { return __builtin_bit_cast(float, w << 16); }
__device__ __forceinline__ float bfhi(unsigned w) { return __builtin_bit_cast(float, w & 0xffff0000u); }

typedef int i32x8 __attribute__((ext_vector_type(8)));
typedef int i32x4 __attribute__((ext_vector_type(4)));
template <class Epi, class Sched, bool ALIGN_EPI, int ES = 2>
__device__ __forceinline__ void gemm_phase(PG8_LAS unsigned char* lds, const Gemm g, const Sched& S, const Epi& E) {
    const int tid = threadIdx.x, wid = __builtin_amdgcn_readfirstlane(tid >> 6), lane = tid & 63, wr = wid >> 2, wc = wid & 3, fr = lane & 15, fq = lane >> 4;
    const int K = g.K, nt = K * ES / (BK * 2);
    unsigned voffA[2], voffB[2];
#pragma unroll
    for (int i = 0; i < 2; ++i) { int R, C; stage_rc(tid * 16 + i * 8192, R, C); const int Rb = Epi::PERM ? ((R & ~31) + perm32(R & 31)) : R;
        voffA[i] = (unsigned)(R * g.lda) * (unsigned)ES + (unsigned)C * 2u; voffB[i] = (unsigned)(Rb * g.ldb) * (unsigned)ES + (unsigned)C * 2u; }
    const size_t kstep = (size_t)(BK * 2);
    const size_t hstepA = (size_t)HALF * g.lda * ES, hstepB = (size_t)HALF * g.ldb * ES;
    const size_t tstepA = 2 * hstepA, tstepB = 2 * hstepB;
    const unsigned ldsw = (unsigned)wid * 1024u;
    const int aoff = lds_byte(wr * 64 + fr, fq * 8), boff = lds_byte(wc * 32 + fr, fq * 8);
#define PG8_SA(b, h) (((b) * 2 + (h)) * HTB)
#define PG8_SB(b, h) ((4 + (b) * 2 + (h)) * HTB)
#define PG8_STAGE(bufoff, gbase, voff) do { _Pragma("unroll") for (int _i = 0; _i < 2; ++_i) \
        __builtin_amdgcn_global_load_lds((const unsigned*)((const char*)(gbase) + (voff)[_i]), (PG8_LAS unsigned*)(lds + (bufoff) + ldsw + _i * 8192), 16, 0, 0); } while (0)
#define PG8_CAT(x, y) __builtin_shufflevector(x, y, 0, 1, 2, 3, 4, 5, 6, 7)
#define PG8_LO(v) __builtin_bit_cast(bf16x8, __builtin_shufflevector(v, v, 0, 1, 2, 3))
#define PG8_HI(v) __builtin_bit_cast(bf16x8, __builtin_shufflevector(v, v, 4, 5, 6, 7))
#define PG8_LDA(dst, b, h) do { _Pragma("unroll") for (int m = 0; m < 4; ++m) { const i32x4 _l = *(const PG8_LAS i32x4*)(lds + PG8_SA(b, h) + aoff + m * 2048), _h = *(const PG8_LAS i32x4*)(lds + PG8_SA(b, h) + aoff + m * 2048 + 1024); dst[m] = PG8_CAT(_l, _h); } } while (0)
#define PG8_LDB(dst, b, h) do { _Pragma("unroll") for (int n = 0; n < 2; ++n) { const i32x4 _l = *(const PG8_LAS i32x4*)(lds + PG8_SB(b, h) + boff + n * 2048), _h = *(const PG8_LAS i32x4*)(lds + PG8_SB(b, h) + boff + n * 2048 + 1024); dst[n] = PG8_CAT(_l, _h); } } while (0)
#define PG8_MMA(ai, bj, At, Bt) do { __builtin_amdgcn_s_setprio(1); _Pragma("unroll") for (int m = 0; m < 4; ++m) _Pragma("unroll") for (int n = 0; n < 2; ++n) { \
        if constexpr (ES == 2) { acc[ai][bj][m][n] = __builtin_amdgcn_mfma_f32_16x16x32_bf16(PG8_LO(Bt[n]), PG8_LO(At[m]), acc[ai][bj][m][n], 0, 0, 0); \
                                 acc[ai][bj][m][n] = __builtin_amdgcn_mfma_f32_16x16x32_bf16(PG8_HI(Bt[n]), PG8_HI(At[m]), acc[ai][bj][m][n], 0, 0, 0); } \
        else asm volatile("v_mfma_f32_16x16x128_f8f6f4 %0, %1, %2, %0" : "+v"(acc[ai][bj][m][n]) : "v"(Bt[n]), "v"(At[m])); } __builtin_amdgcn_s_setprio(0); } while (0)
#define PG8_WAIT_V(n) asm volatile("s_waitcnt vmcnt(" #n ")" ::: "memory")
#define PG8_WAIT_L(n) asm volatile("s_waitcnt lgkmcnt(" #n ")" ::: "memory")
#define PG8_BAR __builtin_amdgcn_s_barrier()
#define PG8_SCHED __builtin_amdgcn_sched_barrier(0)
    Unit cur, nxt; int ui = 0;
    if (!S.next(0, cur)) return;
    f32x4 acc[2][2][4][2];
#pragma unroll
    for (int a = 0; a < 2; ++a)
#pragma unroll
        for (int b = 0; b < 2; ++b)
#pragma unroll
            for (int m = 0; m < 4; ++m)
#pragma unroll
                for (int n = 0; n < 2; ++n) acc[a][b][m][n] = (f32x4){0.f, 0.f, 0.f, 0.f};
    i32x8 At[4], B0[2], B1[2];
    const char* cA = (const char*)g.A + (size_t)cur.pm * tstepA; const char* cB = (const char*)g.Bt + (size_t)cur.pn * tstepB;
    S.a_ready(cur);
    PG8_STAGE(PG8_SB(0, 0), cB, voffB); PG8_STAGE(PG8_SB(0, 1), cB + hstepB, voffB); PG8_STAGE(PG8_SA(0, 0), cA, voffA); PG8_STAGE(PG8_SA(0, 1), cA + hstepA, voffA);
    if (wr == 1) PG8_BAR;
    PG8_WAIT_V(2); PG8_BAR;
    PG8_STAGE(PG8_SB(1, 0), cB + kstep, voffB); PG8_STAGE(PG8_SA(1, 0), cA + kstep, voffA); PG8_STAGE(PG8_SB(1, 1), cB + hstepB + kstep, voffB);
    PG8_WAIT_V(6); PG8_BAR;
    for (;;) {
        const bool has_next = S.next(ui + 1, nxt);
        const char* nA = has_next ? (const char*)g.A + (size_t)nxt.pm * tstepA : cA; const char* nB = has_next ? (const char*)g.Bt + (size_t)nxt.pn * tstepB : cB;
        for (int t = 0; t < nt; t += 2) {
            const bool last = (t == nt - 2);
            const char* a1 = cA + (size_t)(t + 1) * kstep;
            const char* a2 = last ? nA : cA + (size_t)(t + 2) * kstep; const char* b2 = last ? nB : cB + (size_t)(t + 2) * kstep;
            const char* a3 = a2 + kstep; const char* b3 = b2 + kstep;
            if (last && has_next) S.a_ready(nxt);
            PG8_LDB(B0, 0, 0); PG8_LDB(B1, 0, 1); PG8_SCHED; PG8_LDA(At, 0, 0); PG8_STAGE(PG8_SA(1, 1), a1 + hstepA, voffA);
            PG8_WAIT_V(8); PG8_WAIT_L(0); PG8_BAR; PG8_MMA(0, 0, At, B0); PG8_MMA(0, 1, At, B1); PG8_BAR; PG8_SCHED;
            PG8_LDA(At, 0, 1); PG8_STAGE(PG8_SB(0, 0), b2, voffB); PG8_STAGE(PG8_SB(0, 1), b2 + hstepB, voffB); PG8_STAGE(PG8_SA(0, 0), a2, voffA);
            PG8_WAIT_V(8); PG8_WAIT_L(0); PG8_BAR; PG8_MMA(1, 0, At, B0); PG8_MMA(1, 1, At, B1); PG8_BAR; PG8_SCHED;
            PG8_LDB(B0, 1, 0); PG8_LDB(B1, 1, 1); PG8_SCHED; PG8_LDA(At, 1, 0); PG8_STAGE(PG8_SA(0, 1), a2 + hstepA, voffA);
            PG8_WAIT_V(8); PG8_WAIT_L(0); PG8_BAR; PG8_MMA(0, 0, At, B0); PG8_MMA(0, 1, At, B1); PG8_BAR; PG8_SCHED;
            PG8_LDA(At, 1, 1); PG8_STAGE(PG8_SB(1, 0), b3, voffB); PG8_STAGE(PG8_SB(1, 1), b3 + hstepB, voffB); PG8_STAGE(PG8_SA(1, 0), a3, voffA);
            PG8_WAIT_V(8); PG8_WAIT_L(0); PG8_BAR; PG8_MMA(1, 0, At, B0); PG8_MMA(1, 1, At, B1); PG8_BAR; PG8_SCHED;
        }
        if constexpr (ALIGN_EPI) { if (wr == 0) PG8_BAR; }
        if constexpr (ES == 1) asm volatile("s_nop 15\n\ts_nop 15" ::: "memory");
        E(acc, cur, wr, wc, fr, fq); S.done(cur);
        if (!has_next) break;
#pragma unroll
        for (int a = 0; a < 2; ++a)
#pragma unroll
            for (int b = 0; b < 2; ++b)
#pragma unroll
                for (int m = 0; m < 4; ++m)
#pragma unroll
                    for (int n = 0; n < 2; ++n) acc[a][b][m][n] = (f32x4){0.f, 0.f, 0.f, 0.f};
        cur = nxt; cA = nA; cB = nB; ++ui;
        if constexpr (ALIGN_EPI) { if (wr == 1) PG8_BAR; }
    }
    PG8_WAIT_V(0);
    if constexpr (!ALIGN_EPI) { if (wr == 0) PG8_BAR; }
    PG8_BAR;
#undef PG8_SA
#undef PG8_SB
#undef PG8_STAGE
#undef PG8_LDA
#undef PG8_CAT
#undef PG8_LO
#undef PG8_HI
#undef PG8_LDB
#undef PG8_MMA
#undef PG8_WAIT_V
#undef PG8_WAIT_L
#undef PG8_BAR
#undef PG8_SCHED
}
}

constexpr int NWAVES = 8;
constexpr int BATCH = 4, SEQ = 2048, DM = 4096, M = BATCH * SEQ;
constexpr int NH = 16, HD = 128, NKV = 4, ATTW = 2048, KVW = 512, IH = 32, IDIM = 64, TOPK = 256;
constexpr int GMW = 2048, GMG = 8, GMGW = 256, GMC = 128, DFF = 11008, F2 = 2 * DFF;
constexpr int IN_W = 17504, MODW = 6 * DM;
constexpr float EPS = 1e-6f;
constexpr int PQ = 0, PK = 2048, PV = 2560, PQI = 3072, PGU = 5120, PGV = 7168, PGA = 9216, PGB = 13312, PKI = 17408, PWI = 17472, PNP = 17664;
constexpr int SQ = 0, SK = 2048, SV = 2560, SQI = 3072, SKI = 5120, SWI = 5184, SGU = 5216, SGV = 7264, SGA = 9312, SGB = 13408;

constexpr size_t MiB = 1u << 20;
constexpr size_t WS_CTL = 0, CTL_ZERO_BYTES = 2 * MiB;
constexpr size_t WS_MOD = 1 * MiB;
constexpr size_t WS_WIN = 2 * MiB;
constexpr size_t WS_WA = 140 * MiB, WS_WB = 156 * MiB;
constexpr size_t WS_WOUT = 172 * MiB;
constexpr size_t WS_WUP = 204 * MiB;
constexpr size_t WS_WDN = 376 * MiB;
constexpr size_t WS_H = 462 * MiB;
constexpr size_t WS_X1 = 526 * MiB;
constexpr size_t WS_PROJ = 654 * MiB;
constexpr size_t WS_MASK = 930 * MiB;
constexpr size_t WS_RS = 932 * MiB;
constexpr size_t WS_SWT = 932 * MiB + 65536;
constexpr size_t WS_VT = 933 * MiB;
constexpr size_t WS_YA = 941 * MiB, WS_YB = 973 * MiB;
constexpr size_t WS_MRG = 1005 * MiB;
constexpr size_t WS_TMP = 1069 * MiB;
constexpr size_t WS_A = 654 * MiB;
constexpr size_t WS_ACT = 998 * MiB;
constexpr size_t WS_END = 1197 * MiB;
static_assert(WS_WIN + (size_t)PNP * DM * 2 <= WS_WA && WS_WUP + (size_t)F2 * DM * 2 <= WS_WDN && WS_WDN + (size_t)DM * DFF * 2 <= WS_H, "ws map 1");
static_assert(WS_PROJ + (size_t)M * PNP * 2 <= WS_MASK && WS_A + (size_t)M * F2 * 2 <= WS_ACT && WS_ACT + (size_t)M * DFF * 2 <= WS_END && WS_TMP + (size_t)M * DM * 4 <= WS_END, "ws map 2");
constexpr int CW_TMO = 0, CW_CODE = 1, CW_BAR = 4096;

constexpr int RING_OFF = 0, RING_BYTES = 131072;
constexpr int LDSCTL_OFF = RING_BYTES + 8192, MISC_OFF = LDSCTL_OFF + 320;
constexpr int LDS_BYTES = 147456;
static_assert(MISC_OFF + 128 <= LDS_BYTES, "LDS map");

#define GAS __attribute__((address_space(1)))
#define LAS __attribute__((address_space(3)))
typedef unsigned short bf16;
typedef unsigned v4u __attribute__((ext_vector_type(4)));
typedef unsigned v2u __attribute__((ext_vector_type(2)));
typedef float f32x4 __attribute__((ext_vector_type(4)));
typedef float f32x16 __attribute__((ext_vector_type(16)));
typedef short bf16x8 __attribute__((ext_vector_type(8)));
typedef short bf16x4 __attribute__((ext_vector_type(4)));
typedef GAS unsigned gu32;
#define RLX_AGENT __ATOMIC_RELAXED, __HIP_MEMORY_SCOPE_AGENT
#define LDS_WAIT() asm volatile("s_waitcnt lgkmcnt(0)" ::: "memory")
#define VM_WAIT() asm volatile("s_waitcnt vmcnt(0)" ::: "memory")
__device__ __forceinline__ unsigned f2bf(float f) { unsigned u = __builtin_bit_cast(unsigned, f); return (u + 0x7fffu + ((u >> 16) & 1u)) >> 16; }
__device__ __forceinline__ unsigned pk2(float lo, float hi) { return f2bf(lo) | (f2bf(hi) << 16); }
__device__ __forceinline__ float bf2f(bf16 h) { return __builtin_bit_cast(float, (unsigned)h << 16); }
using pg8::bflo; using pg8::bfhi;
constexpr float S_H2 = 16.f, S_WUP = 1024.f, S_ACT = 4.f, S_WDN = 1024.f, S_YA = 16.f, S_YB = 8.f, S_MRG = 16.f, S_WA = 1024.f, S_WB = 1024.f, S_WOUT = 1024.f;
__device__ __forceinline__ float clamp448(float x) { return __builtin_amdgcn_fmed3f(x, -448.f, 448.f); }
__device__ __forceinline__ unsigned pk4_fp8(float a, float b, float c, float d) {
    int w = __builtin_amdgcn_cvt_pk_fp8_f32(clamp448(a), clamp448(b), 0, false);
    w = __builtin_amdgcn_cvt_pk_fp8_f32(clamp448(c), clamp448(d), w, true);
    return (unsigned)w;
}

#define XB_TMO      128
#define XB_XCNT(j)  (256  + 64 * (j))
#define XB_XSUB(j)  (1280 + 64 * (j))
#define XB_XGEN(j)  (2304 + 64 * (j))
#define XB_TOP      3328
#define XB_TOPGEN   3392
#define XCD_BAR_WORDS 3456
#define XB_SPIN_CAP (1u << 18)
__device__ __forceinline__ unsigned xb_ld(unsigned* p)              { return __hip_atomic_load(p, __ATOMIC_RELAXED, __HIP_MEMORY_SCOPE_AGENT); }
__device__ __forceinline__ unsigned xb_add(unsigned* p, unsigned v) { return __hip_atomic_fetch_add(p, v, __ATOMIC_RELAXED, __HIP_MEMORY_SCOPE_AGENT); }
__device__ __forceinline__ unsigned xb_xcc_id() { return (unsigned)__builtin_amdgcn_s_getreg((3 << 11) | 20) & 0xFu; }
#define XB_SPIN(cond, bar) do { unsigned _sp = 0; while (cond) { __builtin_amdgcn_s_sleep(1); \
    if ((++_sp & 255u) == 0u) { if (xb_ld(&(bar)[XB_TMO])) break; if (_sp > XB_SPIN_CAP) { atomicAdd(&(bar)[XB_TMO], 1u); break; } } } } while (0)
struct XcdBarrier { unsigned* bar; unsigned x; volatile LAS unsigned* st; };
__device__ __forceinline__ XcdBarrier xcd_barrier_post(unsigned* bar, volatile LAS unsigned* st) {
    XcdBarrier b; b.bar = bar; b.x = xb_xcc_id(); b.st = st;
    if (threadIdx.x == 0) (void)xb_add(&bar[XB_XCNT(b.x)], 1u);
    return b;
}
__device__ __forceinline__ void xcd_barrier_complete(unsigned* bar, unsigned x, unsigned& nloc, unsigned& nx) {
    const unsigned G = gridDim.x * gridDim.y * gridDim.z;
    unsigned sum, cnt, mine, sp = 0u;
    for (;;) {
        sum = 0u; cnt = 0u; mine = 0u;
#pragma unroll
        for (unsigned j = 0; j < 16; ++j) { const unsigned c = xb_ld(&bar[XB_XCNT(j)]); sum += c; cnt += (c > 0u) ? 1u : 0u; mine = (j == x) ? c : mine; }
        if (sum == G) break;
        __builtin_amdgcn_s_sleep(1);
        if ((++sp & 255u) == 0u) { if (xb_ld(&bar[XB_TMO])) break; if (sp > XB_SPIN_CAP) { atomicAdd(&bar[XB_TMO], 1u); break; } }
    }
    nloc = mine > 0u ? mine : 1u; nx = cnt > 0u ? cnt : 1u;
}
__device__ __forceinline__ void xcd_barrier(const XcdBarrier& b) {
    asm volatile("s_waitcnt vmcnt(0)" ::: "memory");
    __syncthreads();
    if (threadIdx.x == 0) {
        unsigned* bar = b.bar;
        __builtin_amdgcn_s_waitcnt(0);
        unsigned nloc = b.st[0], nx = b.st[1];
        if (nloc == 0u) { xcd_barrier_complete(bar, b.x, nloc, nx); b.st[0] = nloc; b.st[1] = nx; }
        const unsigned old = xb_add(&bar[XB_XSUB(b.x)], 1u);
        const unsigned gen = old / nloc;
        if (old + 1u == (gen + 1u) * nloc) {
            __builtin_amdgcn_fence(__ATOMIC_RELEASE, "agent");
            asm volatile("s_waitcnt vmcnt(0)" ::: "memory");
            const unsigned og = xb_add(&bar[XB_TOP], 1u);
            const unsigned tg = og / nx;
            if (og + 1u == (tg + 1u) * nx) xb_add(&bar[XB_TOPGEN], 1u);
            else XB_SPIN(xb_ld(&bar[XB_TOPGEN]) == tg, bar);
            __builtin_amdgcn_fence(__ATOMIC_ACQUIRE, "agent");
            xb_add(&bar[XB_XGEN(b.x)], 1u);
            asm volatile("s_waitcnt vmcnt(0)" ::: "memory");
        } else {
            XB_SPIN(xb_ld(&bar[XB_XGEN(b.x)]) == gen, bar);
            __builtin_amdgcn_fence(__ATOMIC_ACQUIRE, "agent");
            asm volatile("s_waitcnt vmcnt(0)" ::: "memory");
        }
    }
    __syncthreads();
}

struct Frame {
    LAS unsigned char* lds;
    volatile LAS unsigned* MISC;
    gu32* ctl;
    int tid, lane, wave, G, gw, NGW;
    const float *x, *c, *ada_w, *ada_b, *n1g, *w_in, *qng, *kng, *sgg, *sgw, *sgb, *w_a, *w_b, *w_out, *n2g, *w_up, *cvw, *cvb, *w_dn;
    float* out;
    float *MOD, *PART; bf16 *WIN, *WA, *WB, *WOUT, *WUP, *WDN, *H, *PROJ, *VT, *YA, *YB, *MRG, *A, *ACT; float *X1, *TMP, *RS, *SWT; unsigned* MASK;
};
__device__ __forceinline__ float wave_sum(float v) {
#pragma unroll
    for (int o = 1; o < 64; o <<= 1) v += __shfl_xor(v, o);
    return v;
}

template <bool FP8 = false>
__device__ __forceinline__ void transpose_item(const float* W, int Nsrc, int k0, int n0, void* dstv, size_t ldk, int drow0, LAS float* scr, int lane, float scale = 1.f) {
#pragma unroll
    for (int i = 0; i < 8; ++i) { const int kk = 8 * i + (lane >> 3); const f32x4 v = *(const GAS f32x4*)(W + (size_t)(k0 + kk) * Nsrc + n0 + 4 * (lane & 7));
        LAS float* s = scr + kk * 33 + 4 * (lane & 7); s[0] = v.x; s[1] = v.y; s[2] = v.z; s[3] = v.w; }
    LDS_WAIT(); asm volatile("" ::: "memory");
    const int c = lane & 7;
#pragma unroll
    for (int j = 0; j < 4; ++j) { const int n = (lane >> 3) + 8 * j; const LAS float* s = scr + (8 * c) * 33 + n;
        if constexpr (FP8) { v2u o; o.x = pk4_fp8(s[0 * 33] * scale, s[1 * 33] * scale, s[2 * 33] * scale, s[3 * 33] * scale); o.y = pk4_fp8(s[4 * 33] * scale, s[5 * 33] * scale, s[6 * 33] * scale, s[7 * 33] * scale);
            *(GAS v2u*)((unsigned char*)dstv + (size_t)(drow0 + n) * ldk + k0 + 8 * c) = o; }
        else { v4u o; o.x = pk2(s[0 * 33], s[1 * 33]); o.y = pk2(s[2 * 33], s[3 * 33]); o.z = pk2(s[4 * 33], s[5 * 33]); o.w = pk2(s[6 * 33], s[7 * 33]);
            *(GAS v4u*)((bf16*)dstv + (size_t)(drow0 + n) * ldk + k0 + 8 * c) = o; } }
    LDS_WAIT(); asm volatile("" ::: "memory");
}
__device__ __forceinline__ int win_dst_row(int n) {
    if (n < SKI) return n;
    if (n < SWI) return PKI + (n - SKI);
    if (n < SGU) return PWI + (n - SWI);
    return PGU + (n - SGU);
}
__device__ __forceinline__ void gemv_item(Frame& F, int item) {
    const int nb = item % 96, ks = item / 96, n0 = nb * 256 + 4 * F.lane, k0 = ks * 64;
    float cs[4];
#pragma unroll
    for (int b = 0; b < 4; ++b) { const float cv = F.c[b * DM + k0 + F.lane]; cs[b] = cv * pg8::sigmoidf_(cv); }
    f32x4 acc[4];
#pragma unroll
    for (int b = 0; b < 4; ++b) acc[b] = (f32x4){0.f, 0.f, 0.f, 0.f};
    const float* wp = F.ada_w + (size_t)k0 * MODW + n0;
#pragma unroll 16
    for (int k = 0; k < 64; ++k) { const f32x4 w = *(const GAS f32x4*)(wp + (size_t)k * MODW);
#pragma unroll
        for (int b = 0; b < 4; ++b) { const float s = __builtin_bit_cast(float, __builtin_amdgcn_readlane(__builtin_bit_cast(int, cs[b]), k)); acc[b] += w * s; } }
#pragma unroll
    for (int b = 0; b < 4; ++b) *(GAS f32x4*)(F.PART + (size_t)(ks * 4 + b) * MODW + n0) = acc[b];
}
__device__ __forceinline__ void mod_reduce(Frame& F) {
    for (int i = F.gw * 64 + F.lane; i < 4 * (MODW / 4); i += F.NGW * 64) { const int b = i / (MODW / 4), n0 = 4 * (i % (MODW / 4));
        f32x4 a = *(const GAS f32x4*)(F.ada_b + n0);
#pragma unroll 16
        for (int ks = 0; ks < 64; ++ks) a += *(const GAS f32x4*)(F.PART + (size_t)(ks * 4 + b) * MODW + n0);
        *(GAS f32x4*)(F.MOD + b * MODW + n0) = a; }
}
__device__ __forceinline__ void p0_prologue(Frame& F, bool with_gemv = true) {
    LAS float* scr = (LAS float*)(F.lds + RING_OFF + F.wave * 16384);
    constexpr int I_GV = 96 * 64;
    constexpr int I_IN = (DM / 64) * (IN_W / 32), I_A = (ATTW / 128) * (DM / 32), I_B = (GMW / 128) * (DM / 32), I_O = (DM / 128) * (DM / 32), I_UP = (DM / 128) * (F2 / 32), I_DN = (DFF / 128) * (DM / 32);
    constexpr int NITEMS = I_GV + I_IN + I_A + I_B + I_O + I_UP + I_DN;
    for (int it = F.gw; it < NITEMS; it += F.NGW) {
        int r = it;
        if (r < I_GV) { if (with_gemv) gemv_item(F, r); continue; } r -= I_GV;
        if (r < I_IN) { const int nblk = IN_W / 32, kb = r / nblk, nb = r % nblk; transpose_item(F.w_in, IN_W, 64 * kb, 32 * nb, F.WIN, DM, win_dst_row(32 * nb), scr, F.lane); continue; } r -= I_IN;
        if (r < I_A) { const int nblk = DM / 32, kb = r / nblk, nb = r % nblk; transpose_item<true>(F.w_a, DM, 128 * kb, 32 * nb, F.WA, ATTW, 32 * nb, scr, F.lane, S_WA); transpose_item<true>(F.w_a, DM, 128 * kb + 64, 32 * nb, F.WA, ATTW, 32 * nb, scr, F.lane, S_WA); continue; } r -= I_A;
        if (r < I_B) { const int nblk = DM / 32, kb = r / nblk, nb = r % nblk; transpose_item<true>(F.w_b, DM, 128 * kb, 32 * nb, F.WB, GMW, 32 * nb, scr, F.lane, S_WB); transpose_item<true>(F.w_b, DM, 128 * kb + 64, 32 * nb, F.WB, GMW, 32 * nb, scr, F.lane, S_WB); continue; } r -= I_B;
        if (r < I_O) { const int nblk = DM / 32, kb = r / nblk, nb = r % nblk; transpose_item<true>(F.w_out, DM, 128 * kb, 32 * nb, F.WOUT, DM, 32 * nb, scr, F.lane, S_WOUT); transpose_item<true>(F.w_out, DM, 128 * kb + 64, 32 * nb, F.WOUT, DM, 32 * nb, scr, F.lane, S_WOUT); continue; } r -= I_O;
        if (r < I_UP) { const int nblk = F2 / 32, kb = r / nblk, nb = r % nblk; const int n = 32 * nb; const int ch = n < DFF ? n : n - DFF;
            const int drow = (ch >> 7) * 256 + (ch & 127) + (n < DFF ? 0 : 128);
            transpose_item<true>(F.w_up, F2, 128 * kb, n, F.WUP, DM, drow, scr, F.lane, S_WUP); transpose_item<true>(F.w_up, F2, 128 * kb + 64, n, F.WUP, DM, drow, scr, F.lane, S_WUP); continue; } r -= I_UP;
        { const int nblk = DM / 32, kb = r / nblk, nb = r % nblk; transpose_item<true>(F.w_dn, DM, 128 * kb, 32 * nb, F.WDN, DFF, 32 * nb, scr, F.lane, S_WDN); transpose_item<true>(F.w_dn, DM, 128 * kb + 64, 32 * nb, F.WDN, DFF, 32 * nb, scr, F.lane, S_WDN); }
    }
    { const size_t n16 = (size_t)(PNP - IN_W) * DM * 2 / 16; GAS v4u* p = (GAS v4u*)(F.WIN + (size_t)IN_W * DM);
      for (size_t i = (size_t)F.gw * 64 + F.lane; i < n16; i += (size_t)F.NGW * 64) p[i] = (v4u){0u, 0u, 0u, 0u}; }
    for (int i = F.gw * 64 + F.lane; i < GMG * GMC * GMC; i += F.NGW * 64) { const int g = i >> 14, s = (i >> 7) & 127, t = i & 127; F.SWT[i] = F.sgw[(g * GMC + t) * GMC + s]; }
}

template <bool FP8 = false>
__device__ __forceinline__ void norm_rows(Frame& F, const float* X, const float* gain, int sh_off, int sc_off, void* Ov) {
    for (int m = F.gw; m < M; m += F.NGW) {
        const int b = m >> 11;
        const GAS f32x4* xr = (const GAS f32x4*)(X + (size_t)m * DM) + F.lane;
        f32x4 v[16]; float s = 0.f;
#pragma unroll
        for (int j = 0; j < 16; ++j) { v[j] = xr[64 * j]; s += (v[j].x * v[j].x + v[j].y * v[j].y) + (v[j].z * v[j].z + v[j].w * v[j].w); }
        const float rstd = 1.0f / sqrtf(wave_sum(s) * (1.f / DM) + EPS);
        const GAS f32x4* gp = (const GAS f32x4*)gain + F.lane;
        const GAS f32x4* shp = (const GAS f32x4*)(F.MOD + b * MODW + sh_off) + F.lane;
        const GAS f32x4* scp = (const GAS f32x4*)(F.MOD + b * MODW + sc_off) + F.lane;
        GAS v2u* o8 = (GAS v2u*)((bf16*)Ov + (size_t)m * DM) + F.lane; GAS unsigned* o4 = (GAS unsigned*)((unsigned char*)Ov + (size_t)m * DM) + F.lane;
#pragma unroll
        for (int j = 0; j < 16; ++j) { const f32x4 g = gp[64 * j], sh = shp[64 * j], sc = scp[64 * j];
            const f32x4 y = (v[j] * rstd) * g * (sc + 1.0f) + sh;
            if constexpr (FP8) o4[64 * j] = pk4_fp8(y.x * S_H2, y.y * S_H2, y.z * S_H2, y.w * S_H2);
            else { v2u w; w.x = pk2(y.x, y.y); w.y = pk2(y.z, y.w); o8[64 * j] = w; } }
    }
}

__device__ __forceinline__ unsigned sortable(float f) { const unsigned u = __builtin_bit_cast(unsigned, f); return u ^ ((unsigned)((int)u >> 31) | 0x80000000u); }
__device__ __forceinline__ void select_topk(const unsigned (&sc)[32], GAS v2u* mrow, int lane) {
    unsigned thr = 0u;
    for (int bit = 31; bit >= 0; --bit) {
        const unsigned cand = thr | (1u << bit); int cnt = 0;
#pragma unroll
        for (int jp = 0; jp < 32; ++jp) cnt += __popcll(__ballot(sc[jp] >= cand));
        if (cnt >= TOPK) thr = cand;
    }
    int cgt = 0;
#pragma unroll
    for (int jp = 0; jp < 32; ++jp) cgt += __popcll(__ballot(sc[jp] > thr));
    const int need = TOPK - cgt; int seen = 0;
    unsigned mylo = 0u, myhi = 0u;
    const unsigned long long lt = (lane == 0) ? 0ull : (~0ull >> (64 - lane));
#pragma unroll
    for (int jp = 0; jp < 32; ++jp) {
        unsigned long long sel = __ballot(sc[jp] > thr);
        const unsigned long long eq = __ballot(sc[jp] == thr);
        if (eq) { const bool take = (sc[jp] == thr) && (seen + __popcll(eq & lt) < need); sel |= __ballot(take); seen += __popcll(eq); }
        if (lane == jp) { mylo = (unsigned)sel; myhi = (unsigned)(sel >> 32); }
    }
    if (lane < 32) { v2u w; w.x = mylo; w.y = myhi; mrow[lane] = w; }
}
__device__ __forceinline__ void idx_block(Frame& F, int b, int blk) {
    const int lane = F.lane, w = F.wave, hi = lane >> 5, l31 = lane & 31, tid = F.tid;
    const int t0 = blk * 8, tq = t0 + w;
    const size_t row = (size_t)b * SEQ + tq;
    GAS v2u* mrow = (GAS v2u*)(F.MASK + row * 64);
    if (t0 < TOPK) {
        if (lane < 32) { const int k0 = 64 * lane; v2u mw;
            mw.x = (tq >= k0 + 31) ? 0xffffffffu : (tq < k0 ? 0u : ((2u << (tq - k0)) - 1u));
            mw.y = (tq >= k0 + 63) ? 0xffffffffu : (tq < k0 + 32 ? 0u : ((2u << (tq - k0 - 32)) - 1u));
            mrow[lane] = mw; }
        return;
    }
    const int nt = (t0 + 7) / 64 + 1;
    const bf16* prow = F.PROJ + row * PNP;
    bf16x8 qa[4]; float wv[16];
#pragma unroll
    for (int ks = 0; ks < 4; ++ks) qa[ks] = *(const GAS bf16x8*)(prow + PQI + l31 * 64 + 16 * ks + 8 * hi);
#pragma unroll
    for (int r = 0; r < 16; ++r) wv[r] = bf2f(prow[PWI + (r & 3) + 8 * (r >> 2) + 4 * hi]);
    const bf16* ksrc = F.PROJ + ((size_t)b * SEQ + (tid >> 3)) * PNP + PKI + 8 * (tid & 7);
    const int kdst = (tid >> 3) * 128 + (((tid & 7) ^ ((tid >> 3) & 7)) << 4);
    const int krd = l31 * 128;
    unsigned sc[32];
    __syncthreads();
    v4u stg = *(const GAS v4u*)ksrc;
#pragma unroll
    for (int kt = 0; kt < 32; ++kt) {
        if (kt < nt) {
            LAS unsigned char* kb_base = F.lds + (kt & 1) * 8192;
            *(LAS v4u*)(kb_base + kdst) = stg;
            if (kt + 1 < nt) stg = *(const GAS v4u*)(ksrc + (size_t)(kt + 1) * 64 * PNP);
            LDS_WAIT(); __builtin_amdgcn_s_barrier(); asm volatile("" ::: "memory");
            float s01[2];
#pragma unroll
            for (int h = 0; h < 2; ++h) {
                f32x16 acc;
#pragma unroll
                for (int r = 0; r < 16; ++r) acc[r] = 0.f;
#pragma unroll
                for (int ks = 0; ks < 4; ++ks) { const bf16x8 kf = *(const LAS bf16x8*)(kb_base + h * 4096 + krd + (((2 * ks + hi) ^ (l31 & 7)) << 4));
                    acc = __builtin_amdgcn_mfma_f32_32x32x16_bf16(qa[ks], kf, acc, 0, 0, 0); }
                float x = 0.f;
#pragma unroll
                for (int r = 0; r < 16; ++r) x += wv[r] * fmaxf(acc[r], 0.f);
                x += __shfl_xor(x, 32);
                s01[h] = x;
            }
            const float mine = (lane < 32 ? s01[0] : s01[1]) + 0.0f;
            sc[kt] = (64 * kt + lane <= tq) ? sortable(mine) : 0u;
        } else sc[kt] = 0u;
    }
    select_topk(sc, mrow, lane);
}
constexpr float QSCALE = 0.08838834764831845f * 1.4426950408889634f;
__device__ __forceinline__ void qknorm_row(Frame& F, int row) {
    bf16* prow = F.PROJ + (size_t)row * PNP; const int lane = F.lane;
    {
        GAS v4u* p = (GAS v4u*)(prow + PQ + 32 * lane); v4u w[4]; float ss = 0.f;
#pragma unroll
        for (int i = 0; i < 4; ++i) { w[i] = p[i];
#pragma unroll
            for (int j = 0; j < 4; ++j) { const float a = bflo(w[i][j]), c = bfhi(w[i][j]); ss += a * a + c * c; } }
        ss += __shfl_xor(ss, 1); ss += __shfl_xor(ss, 2);
        const float r = QSCALE / sqrtf(ss * (1.f / HD) + EPS); const float* g = F.qng + 32 * (lane & 3);
#pragma unroll
        for (int i = 0; i < 4; ++i) { v4u o;
#pragma unroll
            for (int j = 0; j < 4; ++j) o[j] = pk2(bflo(w[i][j]) * r * g[8 * i + 2 * j], bfhi(w[i][j]) * r * g[8 * i + 2 * j + 1]);
            p[i] = o; }
    }
    {
        GAS v4u* p = (GAS v4u*)(prow + PK + 8 * lane); const v4u w = *p; float ss = 0.f;
#pragma unroll
        for (int j = 0; j < 4; ++j) { const float a = bflo(w[j]), c = bfhi(w[j]); ss += a * a + c * c; }
        ss += __shfl_xor(ss, 1); ss += __shfl_xor(ss, 2); ss += __shfl_xor(ss, 4); ss += __shfl_xor(ss, 8);
        const float r = 1.0f / sqrtf(ss * (1.f / HD) + EPS); const float* g = F.kng + 8 * (lane & 15); v4u o;
#pragma unroll
        for (int j = 0; j < 4; ++j) o[j] = pk2(bflo(w[j]) * r * g[2 * j], bfhi(w[j]) * r * g[2 * j + 1]);
        *p = o;
    }
    {
        const GAS v4u* p = (const GAS v4u*)(prow + PGV + 32 * lane); float ss = 0.f;
#pragma unroll
        for (int i = 0; i < 4; ++i) { const v4u w = p[i];
#pragma unroll
            for (int j = 0; j < 4; ++j) { const float a = bflo(w[j]), c = bfhi(w[j]); ss += a * a + c * c; } }
        ss = wave_sum(ss);
        if (lane == 0) F.RS[row] = 1.0f / sqrtf(ss * (1.f / GMW) + EPS);
    }
}
__device__ __forceinline__ void vt_item(Frame& F, int item) {
    const int s8 = item & 255, dh = (item >> 8) & 1, g = (item >> 9) & 3, b = item >> 11, d = 64 * dh + F.lane;
    const bf16* src = F.PROJ + (size_t)(b * SEQ + 8 * s8) * PNP + PV + g * HD + d;
    unsigned e[8];
#pragma unroll
    for (int j = 0; j < 8; ++j) e[j] = src[(size_t)j * PNP];
    v4u o; o.x = e[0] | (e[1] << 16); o.y = e[2] | (e[3] << 16); o.z = e[4] | (e[5] << 16); o.w = e[6] | (e[7] << 16);
    *(GAS v4u*)(F.VT + ((size_t)((b * NKV + g) * HD + d)) * SEQ + 8 * s8) = o;
}

constexpr int AT_KSTR = 272, AT_VSTR = 136, AT_TILE = 17408;
#define RAW_BARRIER() do { LDS_WAIT(); __builtin_amdgcn_s_barrier(); asm volatile("" ::: "memory"); } while (0)
__device__ __forceinline__ void attn_block(Frame& F, int b, int g, int qb, float sbound) {
    const int lane = F.lane, w = F.wave, hi = lane >> 5, l31 = lane & 31, tid = F.tid;
    const int hh = 4 * g + (w >> 1), tw0 = qb * 64 + 32 * (w & 1), t = tw0 + l31;
    const size_t row = (size_t)b * SEQ + t;
    const float slope2 = exp2f(-0.5f * (float)(hh + 1)) * 1.4426950408889634f;
    bf16x8 qf[8];
#pragma unroll
    for (int ks = 0; ks < 8; ++ks) qf[ks] = *(const GAS bf16x8*)(F.PROJ + row * PNP + PQ + hh * HD + 16 * ks + 8 * hi);
    f32x16 o[4];
#pragma unroll
    for (int db = 0; db < 4; ++db)
#pragma unroll
        for (int r = 0; r < 16; ++r) o[db][r] = 0.f;
    float m = -1e30f, lsum = 0.f;
    const bf16* ksrc = F.PROJ + ((size_t)b * SEQ + (tid >> 4)) * PNP + PK + g * HD + 8 * (tid & 15);
    const int kdst = (tid >> 4) * AT_KSTR + (tid & 15) * 16;
    const bf16* vsrc = F.VT + ((size_t)((b * NKV + g) * HD + (tid >> 3))) * SEQ + 8 * (tid & 7);
    const int vdst = 2 * AT_TILE + (tid >> 3) * AT_VSTR + (tid & 7) * 16;
    const unsigned* mbase = F.MASK + row * 64;
    LAS unsigned char* L = F.lds;
    v4u sk0, sk1, sv0, sv1; v2u mw, mwn;
#define AT_LOAD(kt_) do { sk0 = *(const GAS v4u*)(ksrc + (size_t)(64 * (kt_)) * PNP); sk1 = *(const GAS v4u*)(ksrc + (size_t)(64 * (kt_) + 32) * PNP); \
        sv0 = *(const GAS v4u*)(vsrc + 64 * (kt_)); sv1 = *(const GAS v4u*)(vsrc + (size_t)64 * SEQ + 64 * (kt_)); mwn = *(const GAS v2u*)(mbase + 2 * (kt_)); } while (0)
#define AT_STORE(bf_) do { *(LAS v4u*)(L + (bf_) * AT_TILE + kdst) = sk0; *(LAS v4u*)(L + (bf_) * AT_TILE + kdst + 32 * AT_KSTR) = sk1; \
        LAS unsigned char* _v = L + (bf_) * AT_TILE + vdst; *(LAS v2u*)_v = (v2u){sv0.x, sv0.y}; *(LAS v2u*)(_v + 8) = (v2u){sv0.z, sv0.w}; \
        *(LAS v2u*)(_v + 64 * AT_VSTR) = (v2u){sv1.x, sv1.y}; *(LAS v2u*)(_v + 64 * AT_VSTR + 8) = (v2u){sv1.z, sv1.w}; } while (0)
    RAW_BARRIER();
    AT_LOAD(qb); AT_STORE(0); mw = mwn;
    int buf = 0; bool dead = false;
    for (int kt = qb; kt >= 0; --kt) {
        if (kt > 0) AT_LOAD(kt - 1);
        RAW_BARRIER();
        if (!dead) {
            const float dmin = (float)(tw0 - (64 * kt + 63));
            dead = __all((sbound - slope2 * dmin) < (m - 40.0f));
        }
        if (!dead) {
            const LAS unsigned char* kb_ = L + buf * AT_TILE + l31 * AT_KSTR + hi * 16;
            const LAS unsigned char* vb_ = L + buf * AT_TILE + 2 * AT_TILE + l31 * AT_VSTR + hi * 8;
            f32x16 p[2];
#pragma unroll
            for (int kb = 0; kb < 2; ++kb) {
#pragma unroll
                for (int r = 0; r < 16; ++r) p[kb][r] = 0.f;
#pragma unroll
                for (int ks = 0; ks < 8; ++ks) { const bf16x8 kf = *(const LAS bf16x8*)(kb_ + kb * 32 * AT_KSTR + ks * 32); p[kb] = __builtin_amdgcn_mfma_f32_32x32x16_bf16(kf, qf[ks], p[kb], 0, 0, 0); }
            }
            const float base = -slope2 * (float)(t - 64 * kt - 4 * hi);
            float rmax = -3e30f;
#pragma unroll
            for (int kb = 0; kb < 2; ++kb) { const unsigned mword = (kb ? mw.y : mw.x) >> (4 * hi);
#pragma unroll
                for (int r = 0; r < 16; ++r) { const int ko = (r & 3) + 8 * (r >> 2);
                    float sv = p[kb][r] + (base + slope2 * (float)(32 * kb + ko));
                    sv = ((mword >> ko) & 1u) ? sv : -2e30f; p[kb][r] = sv; rmax = fmaxf(rmax, sv); } }
            rmax = fmaxf(rmax, __shfl_xor(rmax, 32));
            const float mn = fmaxf(m, rmax), alpha = exp2f(m - mn);
            const bool moved = __any(mn != m);
            m = mn;
            float ps = 0.f;
#pragma unroll
            for (int kb = 0; kb < 2; ++kb)
#pragma unroll
                for (int r = 0; r < 16; ++r) { const float e = exp2f(p[kb][r] - mn); p[kb][r] = e; ps += e; }
            lsum = lsum * alpha + ps;
            if (moved) {
#pragma unroll
                for (int db = 0; db < 4; ++db)
#pragma unroll
                    for (int r = 0; r < 16; ++r) o[db][r] *= alpha;
            }
#pragma unroll
            for (int kb = 0; kb < 2; ++kb)
#pragma unroll
                for (int s2 = 0; s2 < 2; ++s2) {
                    v4u pw; pw.x = pk2(p[kb][8 * s2 + 0], p[kb][8 * s2 + 1]); pw.y = pk2(p[kb][8 * s2 + 2], p[kb][8 * s2 + 3]); pw.z = pk2(p[kb][8 * s2 + 4], p[kb][8 * s2 + 5]); pw.w = pk2(p[kb][8 * s2 + 6], p[kb][8 * s2 + 7]);
                    const bf16x8 pb = __builtin_bit_cast(bf16x8, pw);
#pragma unroll
                    for (int db = 0; db < 4; ++db) { const LAS unsigned char* vp = vb_ + db * 32 * AT_VSTR + kb * 64 + s2 * 32;
                        const v2u v0 = *(const LAS v2u*)vp, v1 = *(const LAS v2u*)(vp + 16);
                        v4u vw; vw.x = v0.x; vw.y = v0.y; vw.z = v1.x; vw.w = v1.y;
                        o[db] = __builtin_amdgcn_mfma_f32_32x32x16_bf16(__builtin_bit_cast(bf16x8, vw), pb, o[db], 0, 0, 0); }
                }
        }
        if (kt > 0) { AT_STORE(buf ^ 1); mw = mwn; }
        buf ^= 1;
    }
#undef AT_LOAD
#undef AT_STORE
    lsum += __shfl_xor(lsum, 32);
    const float inv = S_YA / lsum;
    unsigned char* yrow = (unsigned char*)F.YA + row * ATTW + hh * HD + 4 * hi;
#pragma unroll
    for (int db = 0; db < 4; ++db)
#pragma unroll
        for (int rq = 0; rq < 4; ++rq) *(GAS unsigned*)(yrow + 32 * db + 8 * rq) = pk4_fp8(o[db][4 * rq] * inv, o[db][4 * rq + 1] * inv, o[db][4 * rq + 2] * inv, o[db][4 * rq + 3] * inv);
}
__device__ __forceinline__ float attn_score_bound(Frame& F) {
    float gq = fmaxf(fabsf(F.qng[F.lane]), fabsf(F.qng[F.lane + 64])), gk = fmaxf(fabsf(F.kng[F.lane]), fabsf(F.kng[F.lane + 64]));
#pragma unroll
    for (int o = 1; o < 64; o <<= 1) { gq = fmaxf(gq, __shfl_xor(gq, o)); gk = fmaxf(gk, __shfl_xor(gk, o)); }
    return 1.02f * 128.0f * gq * gk * QSCALE;
}

__device__ __forceinline__ void sgu_unit(Frame& F, int unit) {
    const int ck = unit >> 3, g = unit & 7, r0 = ck * GMC, c0 = g * GMGW, tid = F.tid;
    LAS unsigned* XB = (LAS unsigned*)(F.lds);
    LAS float* WT = (LAS float*)(F.lds + 65536);
    __syncthreads();
#pragma unroll
    for (int i = 0; i < 8; ++i) { const int c = tid + 512 * i, s = c >> 5, q = c & 31;
        *(LAS v4u*)(F.lds + s * 512 + q * 16) = *(const GAS v4u*)(F.PROJ + (size_t)(r0 + s) * PNP + PGV + c0 + 8 * q); }
#pragma unroll 4
    for (int i = 0; i < 32; ++i) { const int e = tid + 512 * i, s = e >> 7, t = e & 127;
        WT[e] = (s <= t) ? F.SWT[(g * GMC + s) * GMC + t] * F.RS[r0 + s] : 0.f; }
    __syncthreads();
    const int cp = tid & 127, tq = tid >> 7;
    const float sg0 = F.sgg[c0 + 2 * cp], sg1 = F.sgg[c0 + 2 * cp + 1];
    for (int pass = 0; pass < 4; ++pass) {
        const int t0 = 8 * (4 * pass + tq);
        float a0[8], a1[8];
#pragma unroll
        for (int j = 0; j < 8; ++j) { a0[j] = 0.f; a1[j] = 0.f; }
        for (int s = 0; s < t0 + 8; ++s) {
            const unsigned xw = XB[s * 128 + cp]; const float x0 = bflo(xw), x1 = bfhi(xw);
            const f32x4 w0 = *(const LAS f32x4*)(WT + s * 128 + t0), w1 = *(const LAS f32x4*)(WT + s * 128 + t0 + 4);
#pragma unroll
            for (int j = 0; j < 4; ++j) { a0[j] += w0[j] * x0; a1[j] += w0[j] * x1; a0[4 + j] += w1[j] * x0; a1[4 + j] += w1[j] * x1; }
        }
#pragma unroll
        for (int j = 0; j < 8; ++j) { const int t = t0 + j; const float bb = F.sgb[g * GMC + t];
            const unsigned uw = *(const GAS unsigned*)(F.PROJ + (size_t)(r0 + t) * PNP + PGU + c0 + 2 * cp);
            *(GAS unsigned short*)((unsigned char*)F.YB + (size_t)(r0 + t) * GMW + c0 + 2 * cp) = (unsigned short)__builtin_amdgcn_cvt_pk_fp8_f32(clamp448(S_YB * bflo(uw) * (a0[j] * sg0 + bb)), clamp448(S_YB * bfhi(uw) * (a1[j] * sg1 + bb)), 0, false); }
    }
}

using pg8::Unit; using pg8::cvt_pk_bf16;
struct EpiProj {
    static constexpr bool PERM = true; bf16* O;
    __device__ __forceinline__ void operator()(const f32x4 (&acc)[2][2][4][2], const Unit& u, int wr, int wc, int fr, int fq) const {
        const int act = (u.pn >= PGU / 256 && u.pn < PGA / 256) ? 1 : ((u.pn >= PGA / 256 && u.pn < PKI / 256) ? 2 : 0);
        const int row0 = u.pm * 256 + wr * 64 + fr, col0 = u.pn * 256 + wc * 32 + 8 * fq;
#pragma unroll
        for (int ai = 0; ai < 2; ++ai)
#pragma unroll
            for (int m = 0; m < 4; ++m) { bf16* rowp = O + (size_t)(row0 + ai * 128 + m * 16) * PNP + col0;
#pragma unroll
                for (int bj = 0; bj < 2; ++bj) { f32x4 v0 = acc[ai][bj][m][0], v1 = acc[ai][bj][m][1];
                    if (act == 1) { const pg8::f32x2 a = pg8::gelu_pk((pg8::f32x2){v0[0], v0[1]}), b = pg8::gelu_pk((pg8::f32x2){v0[2], v0[3]}), c = pg8::gelu_pk((pg8::f32x2){v1[0], v1[1]}), d = pg8::gelu_pk((pg8::f32x2){v1[2], v1[3]});
                        v0 = (f32x4){a.x, a.y, b.x, b.y}; v1 = (f32x4){c.x, c.y, d.x, d.y}; }
                    else if (act == 2) {
#pragma unroll
                        for (int j = 0; j < 4; ++j) { v0[j] = pg8::sigmoidf_(v0[j]); v1[j] = pg8::sigmoidf_(v1[j]); } }
                    v4u w; w.x = cvt_pk_bf16(v0[0], v0[1]); w.y = cvt_pk_bf16(v0[2], v0[3]); w.z = cvt_pk_bf16(v1[0], v1[1]); w.w = cvt_pk_bf16(v1[2], v1[3]);
                    *(GAS v4u*)(rowp + bj * 128) = w; } }
    }
};
struct EpiGateA {
    static constexpr bool PERM = true; const bf16* P; float* T; float scale;
    __device__ __forceinline__ void operator()(const f32x4 (&acc)[2][2][4][2], const Unit& u, int wr, int wc, int fr, int fq) const {
        const int row0 = u.pm * 256 + wr * 64 + fr, col0 = u.pn * 256 + wc * 32 + 8 * fq;
#pragma unroll
        for (int ai = 0; ai < 2; ++ai)
#pragma unroll
            for (int m = 0; m < 4; ++m) { const size_t r = (size_t)(row0 + ai * 128 + m * 16);
#pragma unroll
                for (int bj = 0; bj < 2; ++bj) { const v4u gw = *(const GAS v4u*)(P + r * PNP + PGA + col0 + bj * 128);
                    f32x4 v0 = acc[ai][bj][m][0], v1 = acc[ai][bj][m][1];
                    v0 = v0 * ((f32x4){bflo(gw.x), bfhi(gw.x), bflo(gw.y), bfhi(gw.y)} * scale); v1 = v1 * ((f32x4){bflo(gw.z), bfhi(gw.z), bflo(gw.w), bfhi(gw.w)} * scale);
                    GAS f32x4* tp = (GAS f32x4*)(T + r * DM + col0 + bj * 128); tp[0] = v0; tp[1] = v1; } }
    }
};
struct EpiGateB {
    static constexpr bool PERM = true; const bf16* P; const float* T; unsigned char* O; float scale;
    __device__ __forceinline__ void operator()(const f32x4 (&acc)[2][2][4][2], const Unit& u, int wr, int wc, int fr, int fq) const {
        const int row0 = u.pm * 256 + wr * 64 + fr, col0 = u.pn * 256 + wc * 32 + 8 * fq;
#pragma unroll
        for (int ai = 0; ai < 2; ++ai)
#pragma unroll
            for (int m = 0; m < 4; ++m) { const size_t r = (size_t)(row0 + ai * 128 + m * 16);
#pragma unroll
                for (int bj = 0; bj < 2; ++bj) { const v4u gw = *(const GAS v4u*)(P + r * PNP + PGB + col0 + bj * 128);
                    const GAS f32x4* tp = (const GAS f32x4*)(T + r * DM + col0 + bj * 128);
                    const f32x4 v0 = (tp[0] + acc[ai][bj][m][0] * ((f32x4){bflo(gw.x), bfhi(gw.x), bflo(gw.y), bfhi(gw.y)} * scale)) * S_MRG;
                    const f32x4 v1 = (tp[1] + acc[ai][bj][m][1] * ((f32x4){bflo(gw.z), bfhi(gw.z), bflo(gw.w), bfhi(gw.w)} * scale)) * S_MRG;
                    v2u w; w.x = pk4_fp8(v0[0], v0[1], v0[2], v0[3]); w.y = pk4_fp8(v1[0], v1[1], v1[2], v1[3]);
                    *(GAS v2u*)(O + r * DM + col0 + bj * 128) = w; } }
    }
};
struct EpiResid {
    static constexpr bool PERM = false; const float* base; const float* gate; float* C; float scale;
    __device__ __forceinline__ void operator()(const f32x4 (&acc)[2][2][4][2], const Unit& u, int wr, int wc, int fr, int fq) const {
        const int row0 = u.pm * 256 + wr * 64 + fr, col0 = u.pn * 256 + wc * 32 + 4 * fq; const float* gp = gate + (u.pm >> 3) * MODW + col0;
        f32x4 gv[2][2];
#pragma unroll
        for (int bj = 0; bj < 2; ++bj)
#pragma unroll
            for (int n = 0; n < 2; ++n) gv[bj][n] = *(const GAS f32x4*)(gp + bj * 128 + n * 16) * scale;
#pragma unroll
        for (int ai = 0; ai < 2; ++ai)
#pragma unroll
            for (int m = 0; m < 4; ++m) { const size_t off = (size_t)(row0 + ai * 128 + m * 16) * DM + col0;
#pragma unroll
                for (int bj = 0; bj < 2; ++bj)
#pragma unroll
                    for (int n = 0; n < 2; ++n) { const f32x4 bs = *(const GAS f32x4*)(base + off + bj * 128 + n * 16);
                        *(GAS f32x4*)(C + off + bj * 128 + n * 16) = bs + gv[bj][n] * acc[ai][bj][m][n]; } }
    }
};
struct EpiPlain {
    static constexpr bool PERM = true; bf16* O; int ldc; float scale;
    __device__ __forceinline__ void operator()(const f32x4 (&acc)[2][2][4][2], const Unit& u, int wr, int wc, int fr, int fq) const {
        const int row0 = u.pm * 256 + wr * 64 + fr, col0 = u.pn * 256 + wc * 32 + 8 * fq;
#pragma unroll
        for (int ai = 0; ai < 2; ++ai)
#pragma unroll
            for (int m = 0; m < 4; ++m) { bf16* rowp = O + (size_t)(row0 + ai * 128 + m * 16) * ldc + col0;
#pragma unroll
                for (int bj = 0; bj < 2; ++bj) { const f32x4 v0 = acc[ai][bj][m][0] * scale, v1 = acc[ai][bj][m][1] * scale;
                    v4u w; w.x = cvt_pk_bf16(v0[0], v0[1]); w.y = cvt_pk_bf16(v0[2], v0[3]); w.z = cvt_pk_bf16(v1[0], v1[1]); w.w = cvt_pk_bf16(v1[2], v1[3]);
                    *(GAS v4u*)(rowp + bj * 128) = w; } }
    }
};

__device__ __forceinline__ void conv_phase(Frame& F) {
    constexpr int C8 = DFF / 8, TB = 16, NTB = M / TB;
    const size_t total = (size_t)C8 * NTB;
    for (size_t idx = (size_t)F.gw * 64 + F.lane; idx < total; idx += (size_t)F.NGW * 64) {
        const int c8 = (int)(idx % C8), tb = (int)(idx / C8), ch = 8 * c8, t0 = tb * TB;
        const int acol = (ch >> 7) * 256 + (ch & 127);
        float wg[3][8], wv[3][8], bg[8], bv[8];
#pragma unroll
        for (int j = 0; j < 3; ++j) { const f32x4 a = *(const GAS f32x4*)(F.cvw + (size_t)j * F2 + ch), b = *(const GAS f32x4*)(F.cvw + (size_t)j * F2 + ch + 4);
            const f32x4 c = *(const GAS f32x4*)(F.cvw + (size_t)j * F2 + DFF + ch), d = *(const GAS f32x4*)(F.cvw + (size_t)j * F2 + DFF + ch + 4);
#pragma unroll
            for (int e = 0; e < 4; ++e) { wg[j][e] = a[e]; wg[j][4 + e] = b[e]; wv[j][e] = c[e]; wv[j][4 + e] = d[e]; } }
        { const f32x4 a = *(const GAS f32x4*)(F.cvb + ch), b = *(const GAS f32x4*)(F.cvb + ch + 4), c = *(const GAS f32x4*)(F.cvb + DFF + ch), d = *(const GAS f32x4*)(F.cvb + DFF + ch + 4);
#pragma unroll
          for (int e = 0; e < 4; ++e) { bg[e] = a[e]; bg[4 + e] = b[e]; bv[e] = c[e]; bv[4 + e] = d[e]; } }
        float g1[8], g2[8], v1[8], v2[8];
        const bool first = (t0 & (SEQ - 1)) == 0;
        const bf16* ap = F.A + (size_t)t0 * F2 + acol;
        if (first) {
#pragma unroll
            for (int e = 0; e < 8; ++e) { g1[e] = g2[e] = v1[e] = v2[e] = 0.f; }
        } else {
            const v4u ga = *(const GAS v4u*)(ap - F2), gb = *(const GAS v4u*)(ap - 2 * (size_t)F2), va = *(const GAS v4u*)(ap - F2 + 128), vb = *(const GAS v4u*)(ap - 2 * (size_t)F2 + 128);
#pragma unroll
            for (int e = 0; e < 4; ++e) { g1[2 * e] = bflo(ga[e]); g1[2 * e + 1] = bfhi(ga[e]); g2[2 * e] = bflo(gb[e]); g2[2 * e + 1] = bfhi(gb[e]);
                v1[2 * e] = bflo(va[e]); v1[2 * e + 1] = bfhi(va[e]); v2[2 * e] = bflo(vb[e]); v2[2 * e + 1] = bfhi(vb[e]); }
        }
#pragma unroll 4
        for (int i = 0; i < TB; ++i) {
            const v4u gw = *(const GAS v4u*)(ap + (size_t)i * F2), vw = *(const GAS v4u*)(ap + (size_t)i * F2 + 128);
            float g0[8], v0[8], y[8];
#pragma unroll
            for (int e = 0; e < 4; ++e) { g0[2 * e] = bflo(gw[e]); g0[2 * e + 1] = bfhi(gw[e]); v0[2 * e] = bflo(vw[e]); v0[2 * e + 1] = bfhi(vw[e]); }
#pragma unroll
            for (int e = 0; e < 8; ++e) { const float gt = bg[e] + wg[0][e] * g2[e] + wg[1][e] * g1[e] + wg[2][e] * g0[e];
                const float vl = bv[e] + wv[0][e] * v2[e] + wv[1][e] * v1[e] + wv[2][e] * v0[e];
                y[e] = gt * pg8::sigmoidf_(gt) * vl; g2[e] = g1[e]; g1[e] = g0[e]; v2[e] = v1[e]; v1[e] = v0[e]; }
            v2u o; o.x = pk4_fp8(y[0] * S_ACT, y[1] * S_ACT, y[2] * S_ACT, y[3] * S_ACT); o.y = pk4_fp8(y[4] * S_ACT, y[5] * S_ACT, y[6] * S_ACT, y[7] * S_ACT);
            *(GAS v2u*)((unsigned char*)F.ACT + (size_t)(t0 + i) * DFF + ch) = o;
        }
    }
}

constexpr int N_PHASES = 12;
struct Args { const float* in[19]; float* out; unsigned char* ws; int ph_lo, ph_hi, li, pad; };
__global__ void __launch_bounds__(NWAVES * 64, 2) mega_fwd(Args args) {
    extern __shared__ __attribute__((aligned(16))) unsigned char lds[];
    Frame F;
    F.lds = (LAS unsigned char*)lds;
    F.MISC = (volatile LAS unsigned*)(F.lds + MISC_OFF);
    F.tid = threadIdx.x; F.lane = F.tid & 63; F.wave = __builtin_amdgcn_readfirstlane(F.tid >> 6);
    F.G = gridDim.x; F.gw = blockIdx.x * NWAVES + F.wave; F.NGW = F.G * NWAVES;
    unsigned char* ws = args.ws;
    F.ctl = (gu32*)(ws + WS_CTL);
    F.x = args.in[0]; F.c = args.in[1]; F.ada_w = args.in[2]; F.ada_b = args.in[3]; F.n1g = args.in[4]; F.w_in = args.in[5]; F.qng = args.in[6]; F.kng = args.in[7];
    F.sgg = args.in[8]; F.sgw = args.in[9]; F.sgb = args.in[10]; F.w_a = args.in[11]; F.w_b = args.in[12]; F.w_out = args.in[13]; F.n2g = args.in[14]; F.w_up = args.in[15];
    F.cvw = args.in[16]; F.cvb = args.in[17]; F.w_dn = args.in[18]; F.out = args.out;
    F.MOD = (float*)(ws + WS_MOD); F.PART = (float*)(ws + WS_TMP);   F.WIN = (bf16*)(ws + WS_WIN); F.WA = (bf16*)(ws + WS_WA); F.WB = (bf16*)(ws + WS_WB); F.WOUT = (bf16*)(ws + WS_WOUT); F.WUP = (bf16*)(ws + WS_WUP); F.WDN = (bf16*)(ws + WS_WDN);
    F.H = (bf16*)(ws + WS_H); F.X1 = (float*)(ws + WS_X1); F.PROJ = (bf16*)(ws + WS_PROJ); F.MASK = (unsigned*)(ws + WS_MASK); F.RS = (float*)(ws + WS_RS); F.SWT = (float*)(ws + WS_SWT);
    F.VT = (bf16*)(ws + WS_VT); F.YA = (bf16*)(ws + WS_YA); F.YB = (bf16*)(ws + WS_YB); F.MRG = (bf16*)(ws + WS_MRG); F.TMP = (float*)(ws + WS_TMP); F.A = (bf16*)(ws + WS_A); F.ACT = (bf16*)(ws + WS_ACT);
    for (int u = F.tid; u < (LDS_BYTES - LDSCTL_OFF) / 4; u += NWAVES * 64) ((LAS unsigned*)(F.lds + LDSCTL_OFF))[u] = 0u;
    __syncthreads();
    XcdBarrier bar; bar.bar = (unsigned*)(F.ctl + CW_BAR); bar.x = 0; bar.st = nullptr;
    if (MK_N_LAUNCHES == 1) bar = xcd_barrier_post((unsigned*)(F.ctl + CW_BAR), F.MISC + 8);
    const int lo = args.ph_lo, hi = args.ph_hi;
#define IN(k) (lo <= (k) && (k) < hi)
#define SEAM(k) do { if (IN(k) && IN((k) + 1)) xcd_barrier(bar); } while (0)

#define REP(k) if ((PROBE_MASK >> (k)) & 1) for (int _rep = 0; _rep < 1; ++_rep)
    if (IN(0)) { p0_prologue(F); REP(0) { xcd_barrier(bar); p0_prologue(F, false); } } SEAM(0);
    if (IN(1)) { mod_reduce(F); } SEAM(1);
    if (IN(2)) { norm_rows(F, F.x, F.n1g, 0, DM, F.H); REP(2) { xcd_barrier(bar); norm_rows(F, F.x, F.n1g, 0, DM, F.H); } } SEAM(2);
    if (IN(3)) { pg8::Gemm g{F.H, F.WIN, M, PNP, DM, DM, DM}; pg8::StaticOrder S; S.init(M, PNP, F.G, (int)blockIdx.x); EpiProj E{F.PROJ};
        pg8::gemm_phase<EpiProj, pg8::StaticOrder, true>(F.lds + RING_OFF, g, S, E);
        REP(3) { xcd_barrier(bar); pg8::gemm_phase<EpiProj, pg8::StaticOrder, true>(F.lds + RING_OFF, g, S, E); } } SEAM(3);
    if (IN(4)) {
        for (int it = blockIdx.x; it < 512; it += F.G) { const int b = it >> 7, j = it & 127; idx_block(F, b, j); idx_block(F, b, 255 - j); }
        for (int row = F.gw; row < M; row += F.NGW) qknorm_row(F, row);
        for (int it = F.gw; it < BATCH * NKV * 2 * 256; it += F.NGW) vt_item(F, it);
        REP(4) { xcd_barrier(bar); for (int it = blockIdx.x; it < 512; it += F.G) { const int b = it >> 7, j = it & 127; idx_block(F, b, j); idx_block(F, b, 255 - j); } }
        REP(13) { xcd_barrier(bar); for (int it = F.gw; it < BATCH * NKV * 2 * 256; it += F.NGW) vt_item(F, it); }
    } SEAM(4);
    if (IN(5)) {
        { const float sb = attn_score_bound(F); for (int p = blockIdx.x; p < 256; p += F.G) { const int bg = p >> 4, j = p & 15; attn_block(F, bg >> 2, bg & 3, j, sb); attn_block(F, bg >> 2, bg & 3, 31 - j, sb); } }
        REP(5) { xcd_barrier(bar); { const float sb = attn_score_bound(F); for (int p = blockIdx.x; p < 256; p += F.G) { const int bg = p >> 4, j = p & 15; attn_block(F, bg >> 2, bg & 3, j, sb); attn_block(F, bg >> 2, bg & 3, 31 - j, sb); } } }
        for (int u = blockIdx.x; u < 512; u += F.G) sgu_unit(F, u);
        __syncthreads();
        REP(14) { xcd_barrier(bar); for (int u = blockIdx.x; u < 512; u += F.G) sgu_unit(F, u); __syncthreads(); }
    } SEAM(5);
    if (IN(6)) {
        { pg8::Gemm g{F.YA, F.WA, M, DM, ATTW, ATTW, ATTW}; pg8::StaticOrder S; S.init(M, DM, F.G, (int)blockIdx.x); EpiGateA E{F.PROJ, F.TMP, 1.0f / (S_YA * S_WA)};
          pg8::gemm_phase<EpiGateA, pg8::StaticOrder, true, 1>(F.lds + RING_OFF, g, S, E); }
        VM_WAIT(); __syncthreads();
        { pg8::Gemm g{F.YB, F.WB, M, DM, GMW, GMW, GMW}; pg8::StaticOrder S; S.init(M, DM, F.G, (int)blockIdx.x); EpiGateB E{F.PROJ, F.TMP, (unsigned char*)F.MRG, 1.0f / (S_YB * S_WB)};
          pg8::gemm_phase<EpiGateB, pg8::StaticOrder, true, 1>(F.lds + RING_OFF, g, S, E); }
        REP(6) { xcd_barrier(bar);
          { pg8::Gemm g{F.YA, F.WA, M, DM, ATTW, ATTW, ATTW}; pg8::StaticOrder S; S.init(M, DM, F.G, (int)blockIdx.x); EpiGateA E{F.PROJ, F.TMP, 1.0f / (S_YA * S_WA)};
            pg8::gemm_phase<EpiGateA, pg8::StaticOrder, true, 1>(F.lds + RING_OFF, g, S, E); }
          VM_WAIT(); __syncthreads();
          { pg8::Gemm g{F.YB, F.WB, M, DM, GMW, GMW, GMW}; pg8::StaticOrder S; S.init(M, DM, F.G, (int)blockIdx.x); EpiGateB E{F.PROJ, F.TMP, (unsigned char*)F.MRG, 1.0f / (S_YB * S_WB)};
            pg8::gemm_phase<EpiGateB, pg8::StaticOrder, true, 1>(F.lds + RING_OFF, g, S, E); } }
    } SEAM(6);
    if (IN(7)) { pg8::Gemm g{F.MRG, F.WOUT, M, DM, DM, DM, DM}; pg8::StaticOrder S; S.init(M, DM, F.G, (int)blockIdx.x); EpiResid E{F.x, F.MOD + 2 * DM, F.X1, 1.0f / (S_MRG * S_WOUT)};
        pg8::gemm_phase<EpiResid, pg8::StaticOrder, true, 1>(F.lds + RING_OFF, g, S, E);
        REP(7) { xcd_barrier(bar); pg8::gemm_phase<EpiResid, pg8::StaticOrder, true, 1>(F.lds + RING_OFF, g, S, E); } } SEAM(7);
    if (IN(8)) { norm_rows<true>(F, F.X1, F.n2g, 3 * DM, 4 * DM, F.H); REP(8) { xcd_barrier(bar); norm_rows<true>(F, F.X1, F.n2g, 3 * DM, 4 * DM, F.H); } } SEAM(8);
    if (IN(9)) { pg8::Gemm g{F.H, F.WUP, M, F2, DM, DM, DM}; pg8::StaticOrder S; S.init(M, F2, F.G, (int)blockIdx.x); EpiPlain E{F.A, F2, 1.0f / (S_H2 * S_WUP)};
        pg8::gemm_phase<EpiPlain, pg8::StaticOrder, true, 1>(F.lds + RING_OFF, g, S, E);
        REP(9) { xcd_barrier(bar); pg8::gemm_phase<EpiPlain, pg8::StaticOrder, true, 1>(F.lds + RING_OFF, g, S, E); } } SEAM(9);
    if (IN(10)) { conv_phase(F); REP(10) { xcd_barrier(bar); conv_phase(F); } } SEAM(10);
    if (IN(11)) { pg8::Gemm g{F.ACT, F.WDN, M, DM, DFF, DFF, DFF}; pg8::StaticOrder S; S.init(M, DM, F.G, (int)blockIdx.x); EpiResid E{F.X1, F.MOD + 5 * DM, F.out, 1.0f / (S_ACT * S_WDN)};
        pg8::gemm_phase<EpiResid, pg8::StaticOrder, true, 1>(F.lds + RING_OFF, g, S, E);
        REP(11) { xcd_barrier(bar); pg8::gemm_phase<EpiResid, pg8::StaticOrder, true, 1>(F.lds + RING_OFF, g, S, E); } }
#undef REP
#undef IN
#undef SEAM
}

extern "C" void kernel_launch(void* const* d_in, const int* in_sizes, int n_in, void* d_out, int out_size, void* d_ws, size_t ws_size, hipStream_t stream) {
    static int grid = 0;
    if (grid == 0) {
        if (n_in != 19 || in_sizes[0] != M * DM || out_size != M * DM || ws_size < WS_END) { fprintf(stderr, "kernel_launch: unexpected shapes (n_in %d, in0 %d, out %d, ws %zu < %zu); nothing launched\n", n_in, n_in > 0 ? in_sizes[0] : -1, out_size, ws_size, (size_t)WS_END); grid = -1; return; }
        int dev = 0, cus = 0, per_cu = 0;
        if (hipGetDevice(&dev) != hipSuccess || hipDeviceGetAttribute(&cus, hipDeviceAttributeMultiprocessorCount, dev) != hipSuccess) { fprintf(stderr, "kernel_launch: device query failed\n"); grid = -1; return; }
        if (hipFuncSetAttribute((const void*)mega_fwd, hipFuncAttributeMaxDynamicSharedMemorySize, LDS_BYTES) != hipSuccess) { fprintf(stderr, "kernel_launch: hipFuncSetAttribute failed\n"); grid = -1; return; }
        if (hipOccupancyMaxActiveBlocksPerMultiprocessor(&per_cu, (const void*)mega_fwd, NWAVES * 64, LDS_BYTES) != hipSuccess || per_cu < 1) { fprintf(stderr, "kernel_launch: occupancy query reports %d blocks per CU\n", per_cu); }
        (void)hipGetLastError();
        grid = cus;
    }
    if (grid < 0) return;
    if (hipMemsetAsync((char*)d_ws + WS_CTL, 0, CTL_ZERO_BYTES, stream) != hipSuccess) { fprintf(stderr, "kernel_launch: memset failed\n"); return; }
    Args a{};
    for (int i = 0; i < 19; ++i) a.in[i] = (const float*)d_in[i];
    a.out = (float*)d_out; a.ws = (unsigned char*)d_ws; a.pad = 0;
    for (int li = 0; li < MK_N_LAUNCHES; ++li) {
        if (MK_N_LAUNCHES == 1) { a.ph_lo = 0; a.ph_hi = N_PHASES; } else { a.ph_lo = li; a.ph_hi = li + 1; }
        a.li = li;
        hipLaunchKernelGGL(mega_fwd, dim3(grid), dim3(NWAVES * 64), LDS_BYTES, stream, a);
        const hipError_t le = hipPeekAtLastError();
        if (le != hipSuccess) { fprintf(stderr, "kernel_launch: launch %d failed: %s\n", li, hipGetErrorName(le)); break; }
    }
}
```

```cpp
#include <hip/hip_runtime.h>
#include <cstdio>
#include <cstdint>

#ifndef MK_N_LAUNCHES
#define MK_N_LAUNCHES 1
#endif
#ifndef PROBE_MASK
#define PROBE_MASK 0x0
#endif

namespace pg8 {
#define PG8_LAS __attribute__((address_space(3)))
typedef unsigned short bf16_t;
typedef short bf16x8 __attribute__((ext_vector_type(8)));
typedef float f32x4 __attribute__((ext_vector_type(4)));
typedef float f32x2 __attribute__((ext_vector_type(2)));
typedef unsigned u32x4 __attribute__((ext_vector_type(4)));
typedef unsigned u32x2 __attribute__((ext_vector_type(2)));
constexpr int BM = 256, BK = 64, HALF = 128, HTB = HALF * BK * 2, STAGE_BYTES = 8 * HTB, NXCD = 8, WGM = 8;

__host__ __device__ __forceinline__ int lds_byte(int r, int c) { const int st = (r >> 4) * 2 + (c >> 5), rr = r & 15, cc = c & 31, ob = rr * 64 + cc * 2; return st * 1024 + (ob ^ (((ob >> 9) & 1) << 5)); }
__host__ __device__ __forceinline__ void stage_rc(int b, int& R, int& C) { const int st = b / 1024, sb = b % 1024, swz = sb ^ (((sb >> 9) & 1) << 5); R = (st >> 1) * 16 + swz / 64; C = (st & 1) * 32 + (swz % 64) / 2; }
__host__ __device__ __forceinline__ int perm32(int rho) { const int n = rho >> 4, i = rho & 15; return 8 * (i >> 2) + 4 * n + (i & 3); }

struct Unit { int pm, pn; };
struct Gemm { const bf16_t* A; const bf16_t* Bt; int M, N, K, lda, ldb; };

struct StaticOrder {
    int nM, nN, nwg, G, c;
    __host__ __device__ void init(int M, int N, int G_, int c_) { nM = M / BM; nN = N / BM; nwg = nM * nN; G = G_; c = c_; }
    __host__ __device__ bool next(int i, Unit& u) const {
        const long L = (long)i * G + c; if (L >= nwg) return false;
        int wgid = (int)L; { const int q = nwg / NXCD, r = nwg % NXCD, xcd = wgid % NXCD, off = wgid / NXCD; wgid = (xcd < r ? xcd * (q + 1) : r * (q + 1) + (xcd - r) * q) + off; }
        const int nig = WGM * nN, gid = wgid / nig, fm = gid * WGM, gsz = (nM - fm) < WGM ? (nM - fm) : WGM;
        u.pm = fm + ((wgid % nig) % gsz); u.pn = (wgid % nig) / gsz; return true;
    }
    __device__ __forceinline__ void a_ready(const Unit&) const {}
    __device__ __forceinline__ void done(const Unit&) const {}
};
struct MixOrder {
    int fp8, G, c;
    __host__ __device__ static void map(int L, int nwg, int nN, Unit& u) {
        int wgid = L; { const int q = nwg / NXCD, r = nwg % NXCD, xcd = wgid % NXCD, off = wgid / NXCD; wgid = (xcd < r ? xcd * (q + 1) : r * (q + 1) + (xcd - r) * q) + off; }
        const int nig = WGM * nN; u.pm = (wgid / nig) * WGM + ((wgid % nig) % WGM); u.pn = (wgid % nig) / WGM;
    }
    __host__ __device__ bool next(int i, Unit& u) const {
        int L;
        if (!fp8) { L = i * G + c; if (L >= 288) return false; map(L, 288, 9, u); u.pn = u.pn < 8 ? 12 + u.pn : 68; return true; }
        if (G == 256) { if (c >= 32) { if (i >= 8) return false; L = i * 224 + (c - 32); } else { if (i >= 4) return false; L = 1792 + 4 * c + i; } }
        else { L = i * G + c; if (L >= 1920) return false; }
        map(L, 1920, 60, u); u.pn = u.pn < 12 ? u.pn : u.pn + 8; return true;
    }
    __device__ __forceinline__ void a_ready(const Unit&) const {}
    __device__ __forceinline__ void done(const Unit&) const {}
};

__device__ __forceinline__ unsigned cvt_pk_bf16(float lo, float hi) { unsigned r; asm volatile("v_cvt_pk_bf16_f32 %0, %1, %2" : "=v"(r) : "v"(lo), "v"(hi)); return r; }
__device__ __forceinline__ f32x2 gelu_pk(f32x2 v) {
    const f32x2 av = __builtin_elementwise_abs(v), d = av * 0.2316418882f + 1.0f;
    f32x2 t; t.x = __builtin_amdgcn_rcpf(d.x); t.y = __builtin_amdgcn_rcpf(d.y);
    f32x2 q = t * 0.5307027145f + (-0.7265760135f); q = q * t + 0.7107068705f; q = q * t + (-0.142248368f); q = q * t + 0.127414796f; q = q * t;
    const f32x2 s = (v * v) * (-0.72134752044f);
    f32x2 e; e.x = __builtin_amdgcn_exp2f(s.x); e.y = __builtin_amdgcn_exp2f(s.y);
    const f32x2 m = v * (q * e), r = v - m;
    f32x2 o; o.x = v.x < 0.f ? m.x : r.x; o.y = v.y < 0.f ? m.y : r.y; return o;
}
__device__ __forceinline__ float sigmoidf_(float x) { return __builtin_amdgcn_rcpf(1.0f + __builtin_amdgcn_exp2f(-1.4426950408889634f * x)); }
__device__ __forceinline__ float bflo(unsigned w) { return __builtin_bit_cast(float, w << 16); }
__device__ __forceinline__ float bfhi(unsigned w) { return __builtin_bit_cast(float, w & 0xffff0000u); }

typedef int i32x8 __attribute__((ext_vector_type(8)));
typedef int i32x4 __attribute__((ext_vector_type(4)));
template <class Epi, class Sched, bool ALIGN_EPI, int ES = 2>
__device__ __forceinline__ void gemm_phase(PG8_LAS unsigned char* lds, const Gemm g, const Sched& S, const Epi& E) {
    const int tid = threadIdx.x, wid = __builtin_amdgcn_readfirstlane(tid >> 6), lane = tid & 63, wr = wid >> 2, wc = wid & 3, fr = lane & 15, fq = lane >> 4;
    const int K = g.K, nt = K * ES / (BK * 2);
    unsigned voffA[2], voffB[2];
#pragma unroll
    for (int i = 0; i < 2; ++i) { int R, C; stage_rc(tid * 16 + i * 8192, R, C); const int Rb = Epi::PERM ? ((R & ~31) + perm32(R & 31)) : R;
        voffA[i] = (unsigned)(R * g.lda) * (unsigned)ES + (unsigned)C * 2u; voffB[i] = (unsigned)(Rb * g.ldb) * (unsigned)ES + (unsigned)C * 2u; }
    const size_t kstep = (size_t)(BK * 2);
    const size_t hstepA = (size_t)HALF * g.lda * ES, hstepB = (size_t)HALF * g.ldb * ES;
    const size_t tstepA = 2 * hstepA, tstepB = 2 * hstepB;
    const unsigned ldsw = (unsigned)wid * 1024u;
    const int aoff = lds_byte(wr * 64 + fr, fq * 8), boff = lds_byte(wc * 32 + fr, fq * 8);
#define PG8_SA(b, h) (((b) * 2 + (h)) * HTB)
#define PG8_SB(b, h) ((4 + (b) * 2 + (h)) * HTB)
#define PG8_STAGE(bufoff, gbase, voff) do { _Pragma("unroll") for (int _i = 0; _i < 2; ++_i) \
        __builtin_amdgcn_global_load_lds((const unsigned*)((const char*)(gbase) + (voff)[_i]), (PG8_LAS unsigned*)(lds + (bufoff) + ldsw + _i * 8192), 16, 0, 0); } while (0)
#define PG8_CAT(x, y) __builtin_shufflevector(x, y, 0, 1, 2, 3, 4, 5, 6, 7)
#define PG8_LO(v) __builtin_bit_cast(bf16x8, __builtin_shufflevector(v, v, 0, 1, 2, 3))
#define PG8_HI(v) __builtin_bit_cast(bf16x8, __builtin_shufflevector(v, v, 4, 5, 6, 7))
#define PG8_LDA(dst, b, h) do { _Pragma("unroll") for (int m = 0; m < 4; ++m) { const i32x4 _l = *(const PG8_LAS i32x4*)(lds + PG8_SA(b, h) + aoff + m * 2048), _h = *(const PG8_LAS i32x4*)(lds + PG8_SA(b, h) + aoff + m * 2048 + 1024); dst[m] = PG8_CAT(_l, _h); } } while (0)
#define PG8_LDB(dst, b, h) do { _Pragma("unroll") for (int n = 0; n < 2; ++n) { const i32x4 _l = *(const PG8_LAS i32x4*)(lds + PG8_SB(b, h) + boff + n * 2048), _h = *(const PG8_LAS i32x4*)(lds + PG8_SB(b, h) + boff + n * 2048 + 1024); dst[n] = PG8_CAT(_l, _h); } } while (0)
#define PG8_MMA(ai, bj, At, Bt) do { __builtin_amdgcn_s_setprio(1); _Pragma("unroll") for (int m = 0; m < 4; ++m) _Pragma("unroll") for (int n = 0; n < 2; ++n) { \
        if constexpr (ES == 2) { acc[ai][bj][m][n] = __builtin_amdgcn_mfma_f32_16x16x32_bf16(PG8_LO(Bt[n]), PG8_LO(At[m]), acc[ai][bj][m][n], 0, 0, 0); \
                                 acc[ai][bj][m][n] = __builtin_amdgcn_mfma_f32_16x16x32_bf16(PG8_HI(Bt[n]), PG8_HI(At[m]), acc[ai][bj][m][n], 0, 0, 0); } \
        else asm volatile("v_mfma_f32_16x16x128_f8f6f4 %0, %1, %2, %0" : "+v"(acc[ai][bj][m][n]) : "v"(Bt[n]), "v"(At[m])); } __builtin_amdgcn_s_setprio(0); } while (0)
#define PG8_WAIT_V(n) asm volatile("s_waitcnt vmcnt(" #n ")" ::: "memory")
#define PG8_WAIT_L(n) asm volatile("s_waitcnt lgkmcnt(" #n ")" ::: "memory")
#define PG8_BAR __builtin_amdgcn_s_barrier()
#define PG8_SCHED __builtin_amdgcn_sched_barrier(0)
    Unit cur, nxt; int ui = 0;
    if (!S.next(0, cur)) return;
    f32x4 acc[2][2][4][2];
#pragma unroll
    for (int a = 0; a < 2; ++a)
#pragma unroll
        for (int b = 0; b < 2; ++b)
#pragma unroll
            for (int m = 0; m < 4; ++m)
#pragma unroll
                for (int n = 0; n < 2; ++n) acc[a][b][m][n] = (f32x4){0.f, 0.f, 0.f, 0.f};
    i32x8 At[4], B0[2], B1[2];
    const char* cA = (const char*)g.A + (size_t)cur.pm * tstepA; const char* cB = (const char*)g.Bt + (size_t)cur.pn * tstepB;
    S.a_ready(cur);
    PG8_STAGE(PG8_SB(0, 0), cB, voffB); PG8_STAGE(PG8_SB(0, 1), cB + hstepB, voffB); PG8_STAGE(PG8_SA(0, 0), cA, voffA); PG8_STAGE(PG8_SA(0, 1), cA + hstepA, voffA);
    if (wr == 1) PG8_BAR;
    PG8_WAIT_V(2); PG8_BAR;
    PG8_STAGE(PG8_SB(1, 0), cB + kstep, voffB); PG8_STAGE(PG8_SA(1, 0), cA + kstep, voffA); PG8_STAGE(PG8_SB(1, 1), cB + hstepB + kstep, voffB);
    PG8_WAIT_V(6); PG8_BAR;
    for (;;) {
        const bool has_next = S.next(ui + 1, nxt);
        const char* nA = has_next ? (const char*)g.A + (size_t)nxt.pm * tstepA : cA; const char* nB = has_next ? (const char*)g.Bt + (size_t)nxt.pn * tstepB : cB;
        for (int t = 0; t < nt; t += 2) {
            const bool last = (t == nt - 2);
            const char* a1 = cA + (size_t)(t + 1) * kstep;
            const char* a2 = last ? nA : cA + (size_t)(t + 2) * kstep; const char* b2 = last ? nB : cB + (size_t)(t + 2) * kstep;
            const char* a3 = a2 + kstep; const char* b3 = b2 + kstep;
            if (last && has_next) S.a_ready(nxt);
            PG8_LDB(B0, 0, 0); PG8_LDB(B1, 0, 1); PG8_SCHED; PG8_LDA(At, 0, 0); PG8_STAGE(PG8_SA(1, 1), a1 + hstepA, voffA);
            PG8_WAIT_V(8); PG8_WAIT_L(0); PG8_BAR; PG8_MMA(0, 0, At, B0); PG8_MMA(0, 1, At, B1); PG8_BAR; PG8_SCHED;
            PG8_LDA(At, 0, 1); PG8_STAGE(PG8_SB(0, 0), b2, voffB); PG8_STAGE(PG8_SB(0, 1), b2 + hstepB, voffB); PG8_STAGE(PG8_SA(0, 0), a2, voffA);
            PG8_WAIT_V(8); PG8_WAIT_L(0); PG8_BAR; PG8_MMA(1, 0, At, B0); PG8_MMA(1, 1, At, B1); PG8_BAR; PG8_SCHED;
            PG8_LDB(B0, 1, 0); PG8_LDB(B1, 1, 1); PG8_SCHED; PG8_LDA(At, 1, 0); PG8_STAGE(PG8_SA(0, 1), a2 + hstepA, voffA);
            PG8_WAIT_V(8); PG8_WAIT_L(0); PG8_BAR; PG8_MMA(0, 0, At, B0); PG8_MMA(0, 1, At, B1); PG8_BAR; PG8_SCHED;
            PG8_LDA(At, 1, 1); PG8_STAGE(PG8_SB(1, 0), b3, voffB); PG8_STAGE(PG8_SB(1, 1), b3 + hstepB, voffB); PG8_STAGE(PG8_SA(1, 0), a3, voffA);
            PG8_WAIT_V(8); PG8_WAIT_L(0); PG8_BAR; PG8_MMA(1, 0, At, B0); PG8_MMA(1, 1, At, B1); PG8_BAR; PG8_SCHED;
        }
        if constexpr (ALIGN_EPI) { if (wr == 0) PG8_BAR; }
        if constexpr (ES == 1) asm volatile("s_nop 15\n\ts_nop 15" ::: "memory");
        E(acc, cur, wr, wc, fr, fq); S.done(cur);
        if (!has_next) break;
#pragma unroll
        for (int a = 0; a < 2; ++a)
#pragma unroll
            for (int b = 0; b < 2; ++b)
#pragma unroll
                for (int m = 0; m < 4; ++m)
#pragma unroll
                    for (int n = 0; n < 2; ++n) acc[a][b][m][n] = (f32x4){0.f, 0.f, 0.f, 0.f};
        cur = nxt; cA = nA; cB = nB; ++ui;
        if constexpr (ALIGN_EPI) { if (wr == 1) PG8_BAR; }
    }
    PG8_WAIT_V(0);
    if constexpr (!ALIGN_EPI) { if (wr == 0) PG8_BAR; }
    PG8_BAR;
#undef PG8_SA
#undef PG8_SB
#undef PG8_STAGE
#undef PG8_LDA
#undef PG8_CAT
#undef PG8_LO
#undef PG8_HI
#undef PG8_LDB
#undef PG8_MMA
#undef PG8_WAIT_V
#undef PG8_WAIT_L
#undef PG8_BAR
#undef PG8_SCHED
}
}

constexpr int NWAVES = 8;
constexpr int BATCH = 4, SEQ = 2048, DM = 4096, M = BATCH * SEQ;
constexpr int NH = 16, HD = 128, NKV = 4, ATTW = 2048, KVW = 512, IH = 32, IDIM = 64, TOPK = 256;
constexpr int GMW = 2048, GMG = 8, GMGW = 256, GMC = 128, DFF = 11008, F2 = 2 * DFF;
constexpr int IN_W = 17504, MODW = 6 * DM;
constexpr float EPS = 1e-6f;
constexpr int PQ = 0, PK = 2048, PV = 2560, PQI = 3072, PGU = 5120, PGV = 7168, PGA = 9216, PGB = 13312, PKI = 17408, PWI = 17472, PNP = 17664;
constexpr int SQ = 0, SK = 2048, SV = 2560, SQI = 3072, SKI = 5120, SWI = 5184, SGU = 5216, SGV = 7264, SGA = 9312, SGB = 13408;

constexpr size_t MiB = 1u << 20;
constexpr size_t WS_CTL = 0, CTL_ZERO_BYTES = 2 * MiB;
constexpr size_t WS_MOD = 1 * MiB;
constexpr size_t WS_WIN = 2 * MiB;
constexpr size_t WS_WA = 140 * MiB, WS_WB = 156 * MiB;
constexpr size_t WS_WOUT = 172 * MiB;
constexpr size_t WS_WUP = 204 * MiB;
constexpr size_t WS_WDN = 376 * MiB;
constexpr size_t WS_H = 462 * MiB;
constexpr size_t WS_X1 = 526 * MiB;
constexpr size_t WS_PROJ = 654 * MiB;
constexpr size_t WS_MASK = 930 * MiB;
constexpr size_t WS_RS = 932 * MiB;
constexpr size_t WS_SWT = 932 * MiB + 65536;
constexpr size_t WS_VT = 933 * MiB;
constexpr size_t WS_YA = 941 * MiB, WS_YB = 973 * MiB;
constexpr size_t WS_MRG = 1005 * MiB;
constexpr size_t WS_TMP = 1069 * MiB;
constexpr size_t WS_A = 654 * MiB;
constexpr size_t WS_ACT = 998 * MiB;
constexpr size_t WS_WINB = 1197 * MiB;
constexpr size_t WS_END = 1336 * MiB;
static_assert(WS_WIN + (size_t)PNP * DM * 2 <= WS_WA && WS_WUP + (size_t)F2 * DM * 2 <= WS_WDN && WS_WDN + (size_t)DM * DFF * 2 <= WS_H, "ws map 1");
static_assert(WS_PROJ + (size_t)M * PNP * 2 <= WS_MASK && WS_A + (size_t)M * F2 * 2 <= WS_ACT && WS_ACT + (size_t)M * DFF * 2 <= WS_END && WS_TMP + (size_t)M * DM * 4 <= WS_END, "ws map 2");
constexpr int CW_TMO = 0, CW_CODE = 1, CW_BAR = 4096;

constexpr int RING_OFF = 0, RING_BYTES = 131072;
constexpr int LDSCTL_OFF = RING_BYTES + 8192, MISC_OFF = LDSCTL_OFF + 320;
constexpr int LDS_BYTES = 147456;
static_assert(MISC_OFF + 128 <= LDS_BYTES, "LDS map");

#define GAS __attribute__((address_space(1)))
#define LAS __attribute__((address_space(3)))
typedef unsigned short bf16;
typedef unsigned v4u __attribute__((ext_vector_type(4)));
typedef unsigned v2u __attribute__((ext_vector_type(2)));
typedef float f32x4 __attribute__((ext_vector_type(4)));
typedef float f32x16 __attribute__((ext_vector_type(16)));
typedef short bf16x8 __attribute__((ext_vector_type(8)));
typedef short bf16x4 __attribute__((ext_vector_type(4)));
typedef GAS unsigned gu32;
#define RLX_AGENT __ATOMIC_RELAXED, __HIP_MEMORY_SCOPE_AGENT
#define LDS_WAIT() asm volatile("s_waitcnt lgkmcnt(0)" ::: "memory")
#define VM_WAIT() asm volatile("s_waitcnt vmcnt(0)" ::: "memory")
__device__ __forceinline__ unsigned f2bf(float f) { unsigned u = __builtin_bit_cast(unsigned, f); return (u + 0x7fffu + ((u >> 16) & 1u)) >> 16; }
__device__ __forceinline__ unsigned pk2(float lo, float hi) { return f2bf(lo) | (f2bf(hi) << 16); }
__device__ __forceinline__ float bf2f(bf16 h) { return __builtin_bit_cast(float, (unsigned)h << 16); }
using pg8::bflo; using pg8::bfhi;
constexpr float S_H2 = 16.f, S_WUP = 1024.f, S_ACT = 4.f, S_WDN = 1024.f, S_YA = 16.f, S_YB = 8.f, S_MRG = 16.f, S_WA = 1024.f, S_WB = 1024.f, S_WOUT = 1024.f;
__device__ __forceinline__ float clamp448(float x) { return __builtin_amdgcn_fmed3f(x, -448.f, 448.f); }
__device__ __forceinline__ unsigned pk4_fp8(float a, float b, float c, float d) {
    int w = __builtin_amdgcn_cvt_pk_fp8_f32(clamp448(a), clamp448(b), 0, false);
    w = __builtin_amdgcn_cvt_pk_fp8_f32(clamp448(c), clamp448(d), w, true);
    return (unsigned)w;
}

#define XB_TMO      128
#define XB_XCNT(j)  (256  + 64 * (j))
#define XB_XSUB(j)  (1280 + 64 * (j))
#define XB_XGEN(j)  (2304 + 64 * (j))
#define XB_TOP      3328
#define XB_TOPGEN   3392
#define XCD_BAR_WORDS 3456
#define XB_SPIN_CAP (1u << 18)
__device__ __forceinline__ unsigned xb_ld(unsigned* p)              { return __hip_atomic_load(p, __ATOMIC_RELAXED, __HIP_MEMORY_SCOPE_AGENT); }
__device__ __forceinline__ unsigned xb_add(unsigned* p, unsigned v) { return __hip_atomic_fetch_add(p, v, __ATOMIC_RELAXED, __HIP_MEMORY_SCOPE_AGENT); }
__device__ __forceinline__ unsigned xb_xcc_id() { return (unsigned)__builtin_amdgcn_s_getreg((3 << 11) | 20) & 0xFu; }
#define XB_SPIN(cond, bar) do { unsigned _sp = 0; while (cond) { __builtin_amdgcn_s_sleep(1); \
    if ((++_sp & 255u) == 0u) { if (xb_ld(&(bar)[XB_TMO])) break; if (_sp > XB_SPIN_CAP) { atomicAdd(&(bar)[XB_TMO], 1u); break; } } } } while (0)
struct XcdBarrier { unsigned* bar; unsigned x; volatile LAS unsigned* st; };
__device__ __forceinline__ XcdBarrier xcd_barrier_post(unsigned* bar, volatile LAS unsigned* st) {
    XcdBarrier b; b.bar = bar; b.x = xb_xcc_id(); b.st = st;
    if (threadIdx.x == 0) (void)xb_add(&bar[XB_XCNT(b.x)], 1u);
    return b;
}
__device__ __forceinline__ void xcd_barrier_complete(unsigned* bar, unsigned x, unsigned& nloc, unsigned& nx) {
    const unsigned G = gridDim.x * gridDim.y * gridDim.z;
    unsigned sum, cnt, mine, sp = 0u;
    for (;;) {
        sum = 0u; cnt = 0u; mine = 0u;
#pragma unroll
        for (unsigned j = 0; j < 16; ++j) { const unsigned c = xb_ld(&bar[XB_XCNT(j)]); sum += c; cnt += (c > 0u) ? 1u : 0u; mine = (j == x) ? c : mine; }
        if (sum == G) break;
        __builtin_amdgcn_s_sleep(1);
        if ((++sp & 255u) == 0u) { if (xb_ld(&bar[XB_TMO])) break; if (sp > XB_SPIN_CAP) { atomicAdd(&bar[XB_TMO], 1u); break; } }
    }
    nloc = mine > 0u ? mine : 1u; nx = cnt > 0u ? cnt : 1u;
}
__device__ __forceinline__ void xcd_barrier(const XcdBarrier& b) {
    asm volatile("s_waitcnt vmcnt(0)" ::: "memory");
    __syncthreads();
    if (threadIdx.x == 0) {
        unsigned* bar = b.bar;
        __builtin_amdgcn_s_waitcnt(0);
        unsigned nloc = b.st[0], nx = b.st[1];
        if (nloc == 0u) { xcd_barrier_complete(bar, b.x, nloc, nx); b.st[0] = nloc; b.st[1] = nx; }
        const unsigned old = xb_add(&bar[XB_XSUB(b.x)], 1u);
        const unsigned gen = old / nloc;
        if (old + 1u == (gen + 1u) * nloc) {
            __builtin_amdgcn_fence(__ATOMIC_RELEASE, "agent");
            asm volatile("s_waitcnt vmcnt(0)" ::: "memory");
            const unsigned og = xb_add(&bar[XB_TOP], 1u);
            const unsigned tg = og / nx;
            if (og + 1u == (tg + 1u) * nx) xb_add(&bar[XB_TOPGEN], 1u);
            else XB_SPIN(xb_ld(&bar[XB_TOPGEN]) == tg, bar);
            __builtin_amdgcn_fence(__ATOMIC_ACQUIRE, "agent");
            xb_add(&bar[XB_XGEN(b.x)], 1u);
            asm volatile("s_waitcnt vmcnt(0)" ::: "memory");
        } else {
            XB_SPIN(xb_ld(&bar[XB_XGEN(b.x)]) == gen, bar);
            __builtin_amdgcn_fence(__ATOMIC_ACQUIRE, "agent");
            asm volatile("s_waitcnt vmcnt(0)" ::: "memory");
        }
    }
    __syncthreads();
}

struct Frame {
    LAS unsigned char* lds;
    volatile LAS unsigned* MISC;
    gu32* ctl;
    int tid, lane, wave, G, gw, NGW;
    const float *x, *c, *ada_w, *ada_b, *n1g, *w_in, *qng, *kng, *sgg, *sgw, *sgb, *w_a, *w_b, *w_out, *n2g, *w_up, *cvw, *cvb, *w_dn;
    float* out;
    float *MOD, *PART; bf16 *WINB; unsigned char* H8A; bf16 *WIN, *WA, *WB, *WOUT, *WUP, *WDN, *H, *PROJ, *VT, *YA, *YB, *MRG, *A, *ACT; float *X1, *TMP, *RS, *SWT; unsigned* MASK;
};
__device__ __forceinline__ float wave_sum(float v) {
#pragma unroll
    for (int o = 1; o < 64; o <<= 1) v += __shfl_xor(v, o);
    return v;
}

template <bool FP8 = false>
__device__ __forceinline__ void transpose_item(const float* W, int Nsrc, int k0, int n0, void* dstv, size_t ldk, int drow0, LAS float* scr, int lane, float scale = 1.f) {
#pragma unroll
    for (int i = 0; i < 8; ++i) { const int kk = 8 * i + (lane >> 3); const f32x4 v = *(const GAS f32x4*)(W + (size_t)(k0 + kk) * Nsrc + n0 + 4 * (lane & 7));
        LAS float* s = scr + kk * 33 + 4 * (lane & 7); s[0] = v.x; s[1] = v.y; s[2] = v.z; s[3] = v.w; }
    LDS_WAIT(); asm volatile("" ::: "memory");
    const int c = lane & 7;
#pragma unroll
    for (int j = 0; j < 4; ++j) { const int n = (lane >> 3) + 8 * j; const LAS float* s = scr + (8 * c) * 33 + n;
        if constexpr (FP8) { v2u o; o.x = pk4_fp8(s[0 * 33] * scale, s[1 * 33] * scale, s[2 * 33] * scale, s[3 * 33] * scale); o.y = pk4_fp8(s[4 * 33] * scale, s[5 * 33] * scale, s[6 * 33] * scale, s[7 * 33] * scale);
            *(GAS v2u*)((unsigned char*)dstv + (size_t)(drow0 + n) * ldk + k0 + 8 * c) = o; }
        else { v4u o; o.x = pk2(s[0 * 33], s[1 * 33]); o.y = pk2(s[2 * 33], s[3 * 33]); o.z = pk2(s[4 * 33], s[5 * 33]); o.w = pk2(s[6 * 33], s[7 * 33]);
            *(GAS v4u*)((bf16*)dstv + (size_t)(drow0 + n) * ldk + k0 + 8 * c) = o; } }
    LDS_WAIT(); asm volatile("" ::: "memory");
}
__device__ __forceinline__ int win_dst_row(int n) {
    if (n < SKI) return n;
    if (n < SWI) return PKI + (n - SKI);
    if (n < SGU) return PWI + (n - SWI);
    return PGU + (n - SGU);
}
__device__ __forceinline__ void gemv_item(Frame& F, int item) {
    const int nb = item % 96, ks = item / 96, n0 = nb * 256 + 4 * F.lane, k0 = ks * 64;
    float cs[4];
#pragma unroll
    for (int b = 0; b < 4; ++b) { const float cv = F.c[b * DM + k0 + F.lane]; cs[b] = cv * pg8::sigmoidf_(cv); }
    f32x4 acc[4];
#pragma unroll
    for (int b = 0; b < 4; ++b) acc[b] = (f32x4){0.f, 0.f, 0.f, 0.f};
    const float* wp = F.ada_w + (size_t)k0 * MODW + n0;
#pragma unroll 16
    for (int k = 0; k < 64; ++k) { const f32x4 w = *(const GAS f32x4*)(wp + (size_t)k * MODW);
#pragma unroll
        for (int b = 0; b < 4; ++b) { const float s = __builtin_bit_cast(float, __builtin_amdgcn_readlane(__builtin_bit_cast(int, cs[b]), k)); acc[b] += w * s; } }
#pragma unroll
    for (int b = 0; b < 4; ++b) *(GAS f32x4*)(F.PART + (size_t)(ks * 4 + b) * MODW + n0) = acc[b];
}
__device__ __forceinline__ void mod_reduce(Frame& F) {
    for (int i = F.gw * 64 + F.lane; i < 4 * (MODW / 4); i += F.NGW * 64) { const int b = i / (MODW / 4), n0 = 4 * (i % (MODW / 4));
        f32x4 a = *(const GAS f32x4*)(F.ada_b + n0);
#pragma unroll 16
        for (int ks = 0; ks < 64; ++ks) a += *(const GAS f32x4*)(F.PART + (size_t)(ks * 4 + b) * MODW + n0);
        *(GAS f32x4*)(F.MOD + b * MODW + n0) = a; }
}
__device__ __forceinline__ void p0_prologue(Frame& F, bool with_gemv = true) {
    LAS float* scr = (LAS float*)(F.lds + RING_OFF + F.wave * 16384);
    constexpr int I_GV = 96 * 64;
    constexpr int I_IN = (DM / 128) * (IN_W / 32), I_A = (ATTW / 128) * (DM / 32), I_B = (GMW / 128) * (DM / 32), I_O = (DM / 128) * (DM / 32), I_UP = (DM / 128) * (F2 / 32), I_DN = (DFF / 128) * (DM / 32);
    constexpr int NITEMS = I_GV + I_IN + I_A + I_B + I_O + I_UP + I_DN;
    for (int it = F.gw; it < NITEMS; it += F.NGW) {
        int r = it;
        if (r < I_GV) { if (with_gemv) gemv_item(F, r); continue; } r -= I_GV;
        if (r < I_IN) { const int nblk = IN_W / 32, kb = r / nblk, nb = r % nblk; transpose_item<true>(F.w_in, IN_W, 128 * kb, 32 * nb, F.WIN, DM, win_dst_row(32 * nb), scr, F.lane, 1024.f); transpose_item<true>(F.w_in, IN_W, 128 * kb + 64, 32 * nb, F.WIN, DM, win_dst_row(32 * nb), scr, F.lane, 1024.f);
            if (32 * nb >= SQI && 32 * nb < SGU) { transpose_item(F.w_in, IN_W, 128 * kb, 32 * nb, F.WINB, DM, win_dst_row(32 * nb), scr, F.lane); transpose_item(F.w_in, IN_W, 128 * kb + 64, 32 * nb, F.WINB, DM, win_dst_row(32 * nb), scr, F.lane); }
            continue; } r -= I_IN;
        if (r < I_A) { const int nblk = DM / 32, kb = r / nblk, nb = r % nblk; transpose_item<true>(F.w_a, DM, 128 * kb, 32 * nb, F.WA, ATTW, 32 * nb, scr, F.lane, S_WA); transpose_item<true>(F.w_a, DM, 128 * kb + 64, 32 * nb, F.WA, ATTW, 32 * nb, scr, F.lane, S_WA); continue; } r -= I_A;
        if (r < I_B) { const int nblk = DM / 32, kb = r / nblk, nb = r % nblk; transpose_item<true>(F.w_b, DM, 128 * kb, 32 * nb, F.WB, GMW, 32 * nb, scr, F.lane, S_WB); transpose_item<true>(F.w_b, DM, 128 * kb + 64, 32 * nb, F.WB, GMW, 32 * nb, scr, F.lane, S_WB); continue; } r -= I_B;
        if (r < I_O) { const int nblk = DM / 32, kb = r / nblk, nb = r % nblk; transpose_item<true>(F.w_out, DM, 128 * kb, 32 * nb, F.WOUT, DM, 32 * nb, scr, F.lane, S_WOUT); transpose_item<true>(F.w_out, DM, 128 * kb + 64, 32 * nb, F.WOUT, DM, 32 * nb, scr, F.lane, S_WOUT); continue; } r -= I_O;
        if (r < I_UP) { const int nblk = F2 / 32, kb = r / nblk, nb = r % nblk; const int n = 32 * nb; const int ch = n < DFF ? n : n - DFF;
            const int drow = (ch >> 7) * 256 + (ch & 127) + (n < DFF ? 0 : 128);
            transpose_item<true>(F.w_up, F2, 128 * kb, n, F.WUP, DM, drow, scr, F.lane, S_WUP); transpose_item<true>(F.w_up, F2, 128 * kb + 64, n, F.WUP, DM, drow, scr, F.lane, S_WUP); continue; } r -= I_UP;
        { const int nblk = DM / 32, kb = r / nblk, nb = r % nblk; transpose_item<true>(F.w_dn, DM, 128 * kb, 32 * nb, F.WDN, DFF, 32 * nb, scr, F.lane, S_WDN); transpose_item<true>(F.w_dn, DM, 128 * kb + 64, 32 * nb, F.WDN, DFF, 32 * nb, scr, F.lane, S_WDN); }
    }
    { const size_t n16 = (size_t)(PNP - IN_W) * DM / 16; GAS v4u* p = (GAS v4u*)((unsigned char*)F.WIN + (size_t)IN_W * DM);
      for (size_t i = (size_t)F.gw * 64 + F.lane; i < n16; i += (size_t)F.NGW * 64) p[i] = (v4u){0u, 0u, 0u, 0u};
      GAS v4u* pb = (GAS v4u*)(F.WINB + (size_t)IN_W * DM);
      for (size_t i = (size_t)F.gw * 64 + F.lane; i < 2 * n16; i += (size_t)F.NGW * 64) pb[i] = (v4u){0u, 0u, 0u, 0u}; }
    for (int i = F.gw * 64 + F.lane; i < GMG * GMC * GMC; i += F.NGW * 64) { const int g = i >> 14, s = (i >> 7) & 127, t = i & 127; F.SWT[i] = F.sgw[(g * GMC + t) * GMC + s]; }
}

template <int FP8 = 0>
__device__ __forceinline__ void norm_rows(Frame& F, const float* X, const float* gain, int sh_off, int sc_off, void* Ov, unsigned char* O8 = nullptr) {
    for (int m = F.gw; m < M; m += F.NGW) {
        const int b = m >> 11;
        const GAS f32x4* xr = (const GAS f32x4*)(X + (size_t)m * DM) + F.lane;
        f32x4 v[16]; float s = 0.f;
#pragma unroll
        for (int j = 0; j < 16; ++j) { v[j] = xr[64 * j]; s += (v[j].x * v[j].x + v[j].y * v[j].y) + (v[j].z * v[j].z + v[j].w * v[j].w); }
        const float rstd = 1.0f / sqrtf(wave_sum(s) * (1.f / DM) + EPS);
        const GAS f32x4* gp = (const GAS f32x4*)gain + F.lane;
        const GAS f32x4* shp = (const GAS f32x4*)(F.MOD + b * MODW + sh_off) + F.lane;
        const GAS f32x4* scp = (const GAS f32x4*)(F.MOD + b * MODW + sc_off) + F.lane;
        GAS v2u* o8 = (GAS v2u*)((bf16*)Ov + (size_t)m * DM) + F.lane; GAS unsigned* o4 = (GAS unsigned*)((FP8 == 2 ? O8 : (unsigned char*)Ov) + (size_t)m * DM) + F.lane;
#pragma unroll
        for (int j = 0; j < 16; ++j) { const f32x4 g = gp[64 * j], sh = shp[64 * j], sc = scp[64 * j];
            const f32x4 y = (v[j] * rstd) * g * (sc + 1.0f) + sh;
            if constexpr (FP8 != 0) o4[64 * j] = pk4_fp8(y.x * S_H2, y.y * S_H2, y.z * S_H2, y.w * S_H2);
            if constexpr (FP8 != 1) { v2u w; w.x = pk2(y.x, y.y); w.y = pk2(y.z, y.w); o8[64 * j] = w; } }
    }
}

__device__ __forceinline__ unsigned sortable(float f) { const unsigned u = __builtin_bit_cast(unsigned, f); return u ^ ((unsigned)((int)u >> 31) | 0x80000000u); }
__device__ __forceinline__ void select_topk(const unsigned (&sc)[32], GAS v2u* mrow, int lane) {
    unsigned thr = 0u;
    for (int bit = 31; bit >= 0; --bit) {
        const unsigned cand = thr | (1u << bit); int cnt = 0;
#pragma unroll
        for (int jp = 0; jp < 32; ++jp) cnt += __popcll(__ballot(sc[jp] >= cand));
        if (cnt >= TOPK) thr = cand;
    }
    int cgt = 0;
#pragma unroll
    for (int jp = 0; jp < 32; ++jp) cgt += __popcll(__ballot(sc[jp] > thr));
    const int need = TOPK - cgt; int seen = 0;
    unsigned mylo = 0u, myhi = 0u;
    const unsigned long long lt = (lane == 0) ? 0ull : (~0ull >> (64 - lane));
#pragma unroll
    for (int jp = 0; jp < 32; ++jp) {
        unsigned long long sel = __ballot(sc[jp] > thr);
        const unsigned long long eq = __ballot(sc[jp] == thr);
        if (eq) { const bool take = (sc[jp] == thr) && (seen + __popcll(eq & lt) < need); sel |= __ballot(take); seen += __popcll(eq); }
        if (lane == jp) { mylo = (unsigned)sel; myhi = (unsigned)(sel >> 32); }
    }
    if (lane < 32) { v2u w; w.x = mylo; w.y = myhi; mrow[lane] = w; }
}
__device__ __forceinline__ void idx_block(Frame& F, int b, int blk) {
    const int lane = F.lane, w = F.wave, hi = lane >> 5, l31 = lane & 31, tid = F.tid;
    const int t0 = blk * 8, tq = t0 + w;
    const size_t row = (size_t)b * SEQ + tq;
    GAS v2u* mrow = (GAS v2u*)(F.MASK + row * 64);
    if (t0 < TOPK) {
        if (lane < 32) { const int k0 = 64 * lane; v2u mw;
            mw.x = (tq >= k0 + 31) ? 0xffffffffu : (tq < k0 ? 0u : ((2u << (tq - k0)) - 1u));
            mw.y = (tq >= k0 + 63) ? 0xffffffffu : (tq < k0 + 32 ? 0u : ((2u << (tq - k0 - 32)) - 1u));
            mrow[lane] = mw; }
        return;
    }
    const int nt = (t0 + 7) / 64 + 1;
    const bf16* prow = F.PROJ + row * PNP;
    bf16x8 qa[4]; float wv[16];
#pragma unroll
    for (int ks = 0; ks < 4; ++ks) qa[ks] = *(const GAS bf16x8*)(prow + PQI + l31 * 64 + 16 * ks + 8 * hi);
#pragma unroll
    for (int r = 0; r < 16; ++r) wv[r] = bf2f(prow[PWI + (r & 3) + 8 * (r >> 2) + 4 * hi]);
    const bf16* ksrc = F.PROJ + ((size_t)b * SEQ + (tid >> 3)) * PNP + PKI + 8 * (tid & 7);
    const int kdst = (tid >> 3) * 128 + (((tid & 7) ^ ((tid >> 3) & 7)) << 4);
    const int krd = l31 * 128;
    unsigned sc[32];
    __syncthreads();
    v4u stg = *(const GAS v4u*)ksrc;
#pragma unroll
    for (int kt = 0; kt < 32; ++kt) {
        if (kt < nt) {
            LAS unsigned char* kb_base = F.lds + (kt & 1) * 8192;
            *(LAS v4u*)(kb_base + kdst) = stg;
            if (kt + 1 < nt) stg = *(const GAS v4u*)(ksrc + (size_t)(kt + 1) * 64 * PNP);
            LDS_WAIT(); __builtin_amdgcn_s_barrier(); asm volatile("" ::: "memory");
            float s01[2];
#pragma unroll
            for (int h = 0; h < 2; ++h) {
                f32x16 acc;
#pragma unroll
                for (int r = 0; r < 16; ++r) acc[r] = 0.f;
#pragma unroll
                for (int ks = 0; ks < 4; ++ks) { const bf16x8 kf = *(const LAS bf16x8*)(kb_base + h * 4096 + krd + (((2 * ks + hi) ^ (l31 & 7)) << 4));
                    acc = __builtin_amdgcn_mfma_f32_32x32x16_bf16(qa[ks], kf, acc, 0, 0, 0); }
                float x = 0.f;
#pragma unroll
                for (int r = 0; r < 16; ++r) x += wv[r] * fmaxf(acc[r], 0.f);
                x += __shfl_xor(x, 32);
                s01[h] = x;
            }
            const float mine = (lane < 32 ? s01[0] : s01[1]) + 0.0f;
            sc[kt] = (64 * kt + lane <= tq) ? sortable(mine) : 0u;
        } else sc[kt] = 0u;
    }
    select_topk(sc, mrow, lane);
}
constexpr float QSCALE = 0.08838834764831845f * 1.4426950408889634f;
__device__ __forceinline__ void qknorm_row(Frame& F, int row) {
    bf16* prow = F.PROJ + (size_t)row * PNP; const int lane = F.lane;
    {
        GAS v4u* p = (GAS v4u*)(prow + PQ + 32 * lane); v4u w[4]; float ss = 0.f;
#pragma unroll
        for (int i = 0; i < 4; ++i) { w[i] = p[i];
#pragma unroll
            for (int j = 0; j < 4; ++j) { const float a = bflo(w[i][j]), c = bfhi(w[i][j]); ss += a * a + c * c; } }
        ss += __shfl_xor(ss, 1); ss += __shfl_xor(ss, 2);
        const float r = QSCALE / sqrtf(ss * (1.f / HD) + EPS); const float* g = F.qng + 32 * (lane & 3);
#pragma unroll
        for (int i = 0; i < 4; ++i) { v4u o;
#pragma unroll
            for (int j = 0; j < 4; ++j) o[j] = pk2(bflo(w[i][j]) * r * g[8 * i + 2 * j], bfhi(w[i][j]) * r * g[8 * i + 2 * j + 1]);
            p[i] = o; }
    }
    {
        GAS v4u* p = (GAS v4u*)(prow + PK + 8 * lane); const v4u w = *p; float ss = 0.f;
#pragma unroll
        for (int j = 0; j < 4; ++j) { const float a = bflo(w[j]), c = bfhi(w[j]); ss += a * a + c * c; }
        ss += __shfl_xor(ss, 1); ss += __shfl_xor(ss, 2); ss += __shfl_xor(ss, 4); ss += __shfl_xor(ss, 8);
        const float r = 1.0f / sqrtf(ss * (1.f / HD) + EPS); const float* g = F.kng + 8 * (lane & 15); v4u o;
#pragma unroll
        for (int j = 0; j < 4; ++j) o[j] = pk2(bflo(w[j]) * r * g[2 * j], bfhi(w[j]) * r * g[2 * j + 1]);
        *p = o;
    }
    {
        const GAS v4u* p = (const GAS v4u*)(prow + PGV + 32 * lane); float ss = 0.f;
#pragma unroll
        for (int i = 0; i < 4; ++i) { const v4u w = p[i];
#pragma unroll
            for (int j = 0; j < 4; ++j) { const float a = bflo(w[j]), c = bfhi(w[j]); ss += a * a + c * c; } }
        ss = wave_sum(ss);
        if (lane == 0) F.RS[row] = 1.0f / sqrtf(ss * (1.f / GMW) + EPS);
    }
}
__device__ __forceinline__ void vt_item(Frame& F, int item) {
    const int s8 = item & 255, dh = (item >> 8) & 1, g = (item >> 9) & 3, b = item >> 11, d = 64 * dh + F.lane;
    const bf16* src = F.PROJ + (size_t)(b * SEQ + 8 * s8) * PNP + PV + g * HD + d;
    unsigned e[8];
#pragma unroll
    for (int j = 0; j < 8; ++j) e[j] = src[(size_t)j * PNP];
    v4u o; o.x = e[0] | (e[1] << 16); o.y = e[2] | (e[3] << 16); o.z = e[4] | (e[5] << 16); o.w = e[6] | (e[7] << 16);
    *(GAS v4u*)(F.VT + ((size_t)((b * NKV + g) * HD + d)) * SEQ + 8 * s8) = o;
}

constexpr int AT_KSTR = 272, AT_VSTR = 136, AT_TILE = 17408;
#define RAW_BARRIER() do { LDS_WAIT(); __builtin_amdgcn_s_barrier(); asm volatile("" ::: "memory"); } while (0)
__device__ __forceinline__ void attn_block(Frame& F, int b, int g, int qb, float sbound) {
    const int lane = F.lane, w = F.wave, hi = lane >> 5, l31 = lane & 31, tid = F.tid;
    const int hh = 4 * g + (w >> 1), tw0 = qb * 64 + 32 * (w & 1), t = tw0 + l31;
    const size_t row = (size_t)b * SEQ + t;
    const float slope2 = exp2f(-0.5f * (float)(hh + 1)) * 1.4426950408889634f;
    bf16x8 qf[8];
#pragma unroll
    for (int ks = 0; ks < 8; ++ks) qf[ks] = *(const GAS bf16x8*)(F.PROJ + row * PNP + PQ + hh * HD + 16 * ks + 8 * hi);
    f32x16 o[4];
#pragma unroll
    for (int db = 0; db < 4; ++db)
#pragma unroll
        for (int r = 0; r < 16; ++r) o[db][r] = 0.f;
    float m = -1e30f, lsum = 0.f;
    const bf16* ksrc = F.PROJ + ((size_t)b * SEQ + (tid >> 4)) * PNP + PK + g * HD + 8 * (tid & 15);
    const int kdst = (tid >> 4) * AT_KSTR + (tid & 15) * 16;
    const bf16* vsrc = F.VT + ((size_t)((b * NKV + g) * HD + (tid >> 3))) * SEQ + 8 * (tid & 7);
    const int vdst = 2 * AT_TILE + (tid >> 3) * AT_VSTR + (tid & 7) * 16;
    const unsigned* mbase = F.MASK + row * 64;
    LAS unsigned char* L = F.lds;
    v4u sk0, sk1, sv0, sv1; v2u mw, mwn;
#define AT_LOAD(kt_) do { sk0 = *(const GAS v4u*)(ksrc + (size_t)(64 * (kt_)) * PNP); sk1 = *(const GAS v4u*)(ksrc + (size_t)(64 * (kt_) + 32) * PNP); \
        sv0 = *(const GAS v4u*)(vsrc + 64 * (kt_)); sv1 = *(const GAS v4u*)(vsrc + (size_t)64 * SEQ + 64 * (kt_)); mwn = *(const GAS v2u*)(mbase + 2 * (kt_)); } while (0)
#define AT_STORE(bf_) do { *(LAS v4u*)(L + (bf_) * AT_TILE + kdst) = sk0; *(LAS v4u*)(L + (bf_) * AT_TILE + kdst + 32 * AT_KSTR) = sk1; \
        LAS unsigned char* _v = L + (bf_) * AT_TILE + vdst; *(LAS v2u*)_v = (v2u){sv0.x, sv0.y}; *(LAS v2u*)(_v + 8) = (v2u){sv0.z, sv0.w}; \
        *(LAS v2u*)(_v + 64 * AT_VSTR) = (v2u){sv1.x, sv1.y}; *(LAS v2u*)(_v + 64 * AT_VSTR + 8) = (v2u){sv1.z, sv1.w}; } while (0)
    RAW_BARRIER();
    AT_LOAD(qb); AT_STORE(0); mw = mwn;
    int buf = 0; bool dead = false;
    for (int kt = qb; kt >= 0; --kt) {
        if (kt > 0) AT_LOAD(kt - 1);
        RAW_BARRIER();
        if (!dead) {
            const float dmin = (float)(tw0 - (64 * kt + 63));
            dead = __all((sbound - slope2 * dmin) < (m - 40.0f));
        }
        if (!dead) {
            const LAS unsigned char* kb_ = L + buf * AT_TILE + l31 * AT_KSTR + hi * 16;
            const LAS unsigned char* vb_ = L + buf * AT_TILE + 2 * AT_TILE + l31 * AT_VSTR + hi * 8;
            f32x16 p[2];
#pragma unroll
            for (int kb = 0; kb < 2; ++kb) {
#pragma unroll
                for (int r = 0; r < 16; ++r) p[kb][r] = 0.f;
#pragma unroll
                for (int ks = 0; ks < 8; ++ks) { const bf16x8 kf = *(const LAS bf16x8*)(kb_ + kb * 32 * AT_KSTR + ks * 32); p[kb] = __builtin_amdgcn_mfma_f32_32x32x16_bf16(kf, qf[ks], p[kb], 0, 0, 0); }
            }
            const float base = -slope2 * (float)(t - 64 * kt - 4 * hi);
            float rmax = -3e30f;
#pragma unroll
            for (int kb = 0; kb < 2; ++kb) { const unsigned mword = (kb ? mw.y : mw.x) >> (4 * hi);
#pragma unroll
                for (int r = 0; r < 16; ++r) { const int ko = (r & 3) + 8 * (r >> 2);
                    float sv = p[kb][r] + (base + slope2 * (float)(32 * kb + ko));
                    sv = ((mword >> ko) & 1u) ? sv : -2e30f; p[kb][r] = sv; rmax = fmaxf(rmax, sv); } }
            rmax = fmaxf(rmax, __shfl_xor(rmax, 32));
            const float mn = fmaxf(m, rmax), alpha = exp2f(m - mn);
            const bool moved = __any(mn != m);
            m = mn;
            float ps = 0.f;
#pragma unroll
            for (int kb = 0; kb < 2; ++kb)
#pragma unroll
                for (int r = 0; r < 16; ++r) { const float e = exp2f(p[kb][r] - mn); p[kb][r] = e; ps += e; }
            lsum = lsum * alpha + ps;
            if (moved) {
#pragma unroll
                for (int db = 0; db < 4; ++db)
#pragma unroll
                    for (int r = 0; r < 16; ++r) o[db][r] *= alpha;
            }
#pragma unroll
            for (int kb = 0; kb < 2; ++kb)
#pragma unroll
                for (int s2 = 0; s2 < 2; ++s2) {
                    v4u pw; pw.x = pk2(p[kb][8 * s2 + 0], p[kb][8 * s2 + 1]); pw.y = pk2(p[kb][8 * s2 + 2], p[kb][8 * s2 + 3]); pw.z = pk2(p[kb][8 * s2 + 4], p[kb][8 * s2 + 5]); pw.w = pk2(p[kb][8 * s2 + 6], p[kb][8 * s2 + 7]);
                    const bf16x8 pb = __builtin_bit_cast(bf16x8, pw);
#pragma unroll
                    for (int db = 0; db < 4; ++db) { const LAS unsigned char* vp = vb_ + db * 32 * AT_VSTR + kb * 64 + s2 * 32;
                        const v2u v0 = *(const LAS v2u*)vp, v1 = *(const LAS v2u*)(vp + 16);
                        v4u vw; vw.x = v0.x; vw.y = v0.y; vw.z = v1.x; vw.w = v1.y;
                        o[db] = __builtin_amdgcn_mfma_f32_32x32x16_bf16(__builtin_bit_cast(bf16x8, vw), pb, o[db], 0, 0, 0); }
                }
        }
        if (kt > 0) { AT_STORE(buf ^ 1); mw = mwn; }
        buf ^= 1;
    }
#undef AT_LOAD
#undef AT_STORE
    lsum += __shfl_xor(lsum, 32);
    const float inv = S_YA / lsum;
    unsigned char* yrow = (unsigned char*)F.YA + row * ATTW + hh * HD + 4 * hi;
#pragma unroll
    for (int db = 0; db < 4; ++db)
#pragma unroll
        for (int rq = 0; rq < 4; ++rq) *(GAS unsigned*)(yrow + 32 * db + 8 * rq) = pk4_fp8(o[db][4 * rq] * inv, o[db][4 * rq + 1] * inv, o[db][4 * rq + 2] * inv, o[db][4 * rq + 3] * inv);
}
__device__ __forceinline__ float attn_score_bound(Frame& F) {
    float gq = fmaxf(fabsf(F.qng[F.lane]), fabsf(F.qng[F.lane + 64])), gk = fmaxf(fabsf(F.kng[F.lane]), fabsf(F.kng[F.lane + 64]));
#pragma unroll
    for (int o = 1; o < 64; o <<= 1) { gq = fmaxf(gq, __shfl_xor(gq, o)); gk = fmaxf(gk, __shfl_xor(gk, o)); }
    return 1.02f * 128.0f * gq * gk * QSCALE;
}

__device__ __forceinline__ void sgu_unit(Frame& F, int unit) {
    const int ck = unit >> 3, g = unit & 7, r0 = ck * GMC, c0 = g * GMGW, tid = F.tid;
    LAS unsigned* XB = (LAS unsigned*)(F.lds);
    LAS float* WT = (LAS float*)(F.lds + 65536);
    __syncthreads();
#pragma unroll
    for (int i = 0; i < 8; ++i) { const int c = tid + 512 * i, s = c >> 5, q = c & 31;
        *(LAS v4u*)(F.lds + s * 512 + q * 16) = *(const GAS v4u*)(F.PROJ + (size_t)(r0 + s) * PNP + PGV + c0 + 8 * q); }
#pragma unroll 4
    for (int i = 0; i < 32; ++i) { const int e = tid + 512 * i, s = e >> 7, t = e & 127;
        WT[e] = (s <= t) ? F.SWT[(g * GMC + s) * GMC + t] * F.RS[r0 + s] : 0.f; }
    __syncthreads();
    const int cp = tid & 127, tq = tid >> 7;
    const float sg0 = F.sgg[c0 + 2 * cp], sg1 = F.sgg[c0 + 2 * cp + 1];
    for (int pass = 0; pass < 4; ++pass) {
        const int t0 = 8 * (4 * pass + tq);
        float a0[8], a1[8];
#pragma unroll
        for (int j = 0; j < 8; ++j) { a0[j] = 0.f; a1[j] = 0.f; }
        for (int s = 0; s < t0 + 8; ++s) {
            const unsigned xw = XB[s * 128 + cp]; const float x0 = bflo(xw), x1 = bfhi(xw);
            const f32x4 w0 = *(const LAS f32x4*)(WT + s * 128 + t0), w1 = *(const LAS f32x4*)(WT + s * 128 + t0 + 4);
#pragma unroll
            for (int j = 0; j < 4; ++j) { a0[j] += w0[j] * x0; a1[j] += w0[j] * x1; a0[4 + j] += w1[j] * x0; a1[4 + j] += w1[j] * x1; }
        }
#pragma unroll
        for (int j = 0; j < 8; ++j) { const int t = t0 + j; const float bb = F.sgb[g * GMC + t];
            const unsigned uw = *(const GAS unsigned*)(F.PROJ + (size_t)(r0 + t) * PNP + PGU + c0 + 2 * cp);
            *(GAS unsigned short*)((unsigned char*)F.YB + (size_t)(r0 + t) * GMW + c0 + 2 * cp) = (unsigned short)__builtin_amdgcn_cvt_pk_fp8_f32(clamp448(S_YB * bflo(uw) * (a0[j] * sg0 + bb)), clamp448(S_YB * bfhi(uw) * (a1[j] * sg1 + bb)), 0, false); }
    }
}

using pg8::Unit; using pg8::cvt_pk_bf16;
struct EpiProj {
    static constexpr bool PERM = true; bf16* O; float scale;
    __device__ __forceinline__ void operator()(const f32x4 (&acc)[2][2][4][2], const Unit& u, int wr, int wc, int fr, int fq) const {
        const int act = (u.pn >= PGU / 256 && u.pn < PGA / 256) ? 1 : ((u.pn >= PGA / 256 && u.pn < PKI / 256) ? 2 : 0);
        const int row0 = u.pm * 256 + wr * 64 + fr, col0 = u.pn * 256 + wc * 32 + 8 * fq;
#pragma unroll
        for (int ai = 0; ai < 2; ++ai)
#pragma unroll
            for (int m = 0; m < 4; ++m) { bf16* rowp = O + (size_t)(row0 + ai * 128 + m * 16) * PNP + col0;
#pragma unroll
                for (int bj = 0; bj < 2; ++bj) { f32x4 v0 = acc[ai][bj][m][0] * scale, v1 = acc[ai][bj][m][1] * scale;
                    if (act == 1) { const pg8::f32x2 a = pg8::gelu_pk((pg8::f32x2){v0[0], v0[1]}), b = pg8::gelu_pk((pg8::f32x2){v0[2], v0[3]}), c = pg8::gelu_pk((pg8::f32x2){v1[0], v1[1]}), d = pg8::gelu_pk((pg8::f32x2){v1[2], v1[3]});
                        v0 = (f32x4){a.x, a.y, b.x, b.y}; v1 = (f32x4){c.x, c.y, d.x, d.y}; }
                    else if (act == 2) {
#pragma unroll
                        for (int j = 0; j < 4; ++j) { v0[j] = pg8::sigmoidf_(v0[j]); v1[j] = pg8::sigmoidf_(v1[j]); } }
                    v4u w; w.x = cvt_pk_bf16(v0[0], v0[1]); w.y = cvt_pk_bf16(v0[2], v0[3]); w.z = cvt_pk_bf16(v1[0], v1[1]); w.w = cvt_pk_bf16(v1[2], v1[3]);
                    *(GAS v4u*)(rowp + bj * 128) = w; } }
    }
};
struct EpiGateA {
    static constexpr bool PERM = true; const bf16* P; float* T; float scale;
    __device__ __forceinline__ void operator()(const f32x4 (&acc)[2][2][4][2], const Unit& u, int wr, int wc, int fr, int fq) const {
        const int row0 = u.pm * 256 + wr * 64 + fr, col0 = u.pn * 256 + wc * 32 + 8 * fq;
#pragma unroll
        for (int ai = 0; ai < 2; ++ai)
#pragma unroll
            for (int m = 0; m < 4; ++m) { const size_t r = (size_t)(row0 + ai * 128 + m * 16);
#pragma unroll
                for (int bj = 0; bj < 2; ++bj) { const v4u gw = *(const GAS v4u*)(P + r * PNP + PGA + col0 + bj * 128);
                    f32x4 v0 = acc[ai][bj][m][0], v1 = acc[ai][bj][m][1];
                    v0 = v0 * ((f32x4){bflo(gw.x), bfhi(gw.x), bflo(gw.y), bfhi(gw.y)} * scale); v1 = v1 * ((f32x4){bflo(gw.z), bfhi(gw.z), bflo(gw.w), bfhi(gw.w)} * scale);
                    GAS f32x4* tp = (GAS f32x4*)(T + r * DM + col0 + bj * 128); tp[0] = v0; tp[1] = v1; } }
    }
};
struct EpiGateB {
    static constexpr bool PERM = true; const bf16* P; const float* T; unsigned char* O; float scale;
    __device__ __forceinline__ void operator()(const f32x4 (&acc)[2][2][4][2], const Unit& u, int wr, int wc, int fr, int fq) const {
        const int row0 = u.pm * 256 + wr * 64 + fr, col0 = u.pn * 256 + wc * 32 + 8 * fq;
#pragma unroll
        for (int ai = 0; ai < 2; ++ai)
#pragma unroll
            for (int m = 0; m < 4; ++m) { const size_t r = (size_t)(row0 + ai * 128 + m * 16);
#pragma unroll
                for (int bj = 0; bj < 2; ++bj) { const v4u gw = *(const GAS v4u*)(P + r * PNP + PGB + col0 + bj * 128);
                    const GAS f32x4* tp = (const GAS f32x4*)(T + r * DM + col0 + bj * 128);
                    const f32x4 v0 = (tp[0] + acc[ai][bj][m][0] * ((f32x4){bflo(gw.x), bfhi(gw.x), bflo(gw.y), bfhi(gw.y)} * scale)) * S_MRG;
                    const f32x4 v1 = (tp[1] + acc[ai][bj][m][1] * ((f32x4){bflo(gw.z), bfhi(gw.z), bflo(gw.w), bfhi(gw.w)} * scale)) * S_MRG;
                    v2u w; w.x = pk4_fp8(v0[0], v0[1], v0[2], v0[3]); w.y = pk4_fp8(v1[0], v1[1], v1[2], v1[3]);
                    *(GAS v2u*)(O + r * DM + col0 + bj * 128) = w; } }
    }
};
struct EpiResid {
    static constexpr bool PERM = false; const float* base; const float* gate; float* C; float scale;
    __device__ __forceinline__ void operator()(const f32x4 (&acc)[2][2][4][2], const Unit& u, int wr, int wc, int fr, int fq) const {
        const int row0 = u.pm * 256 + wr * 64 + fr, col0 = u.pn * 256 + wc * 32 + 4 * fq; const float* gp = gate + (u.pm >> 3) * MODW + col0;
        f32x4 gv[2][2];
#pragma unroll
        for (int bj = 0; bj < 2; ++bj)
#pragma unroll
            for (int n = 0; n < 2; ++n) gv[bj][n] = *(const GAS f32x4*)(gp + bj * 128 + n * 16) * scale;
#pragma unroll
        for (int ai = 0; ai < 2; ++ai)
#pragma unroll
            for (int m = 0; m < 4; ++m) { const size_t off = (size_t)(row0 + ai * 128 + m * 16) * DM + col0;
#pragma unroll
                for (int bj = 0; bj < 2; ++bj)
#pragma unroll
                    for (int n = 0; n < 2; ++n) { const f32x4 bs = *(const GAS f32x4*)(base + off + bj * 128 + n * 16);
                        *(GAS f32x4*)(C + off + bj * 128 + n * 16) = bs + gv[bj][n] * acc[ai][bj][m][n]; } }
    }
};
struct EpiPlain {
    static constexpr bool PERM = true; bf16* O; int ldc; float scale;
    __device__ __forceinline__ void operator()(const f32x4 (&acc)[2][2][4][2], const Unit& u, int wr, int wc, int fr, int fq) const {
        const int row0 = u.pm * 256 + wr * 64 + fr, col0 = u.pn * 256 + wc * 32 + 8 * fq;
#pragma unroll
        for (int ai = 0; ai < 2; ++ai)
#pragma unroll
            for (int m = 0; m < 4; ++m) { bf16* rowp = O + (size_t)(row0 + ai * 128 + m * 16) * ldc + col0;
#pragma unroll
                for (int bj = 0; bj < 2; ++bj) { const f32x4 v0 = acc[ai][bj][m][0] * scale, v1 = acc[ai][bj][m][1] * scale;
                    v4u w; w.x = cvt_pk_bf16(v0[0], v0[1]); w.y = cvt_pk_bf16(v0[2], v0[3]); w.z = cvt_pk_bf16(v1[0], v1[1]); w.w = cvt_pk_bf16(v1[2], v1[3]);
                    *(GAS v4u*)(rowp + bj * 128) = w; } }
    }
};

__device__ __forceinline__ void conv_phase(Frame& F) {
    constexpr int C8 = DFF / 8, TB = 16, NTB = M / TB;
    const size_t total = (size_t)C8 * NTB;
    for (size_t idx = (size_t)F.gw * 64 + F.lane; idx < total; idx += (size_t)F.NGW * 64) {
        const int c8 = (int)(idx % C8), tb = (int)(idx / C8), ch = 8 * c8, t0 = tb * TB;
        const int acol = (ch >> 7) * 256 + (ch & 127);
        float wg[3][8], wv[3][8], bg[8], bv[8];
#pragma unroll
        for (int j = 0; j < 3; ++j) { const f32x4 a = *(const GAS f32x4*)(F.cvw + (size_t)j * F2 + ch), b = *(const GAS f32x4*)(F.cvw + (size_t)j * F2 + ch + 4);
            const f32x4 c = *(const GAS f32x4*)(F.cvw + (size_t)j * F2 + DFF + ch), d = *(const GAS f32x4*)(F.cvw + (size_t)j * F2 + DFF + ch + 4);
#pragma unroll
            for (int e = 0; e < 4; ++e) { wg[j][e] = a[e]; wg[j][4 + e] = b[e]; wv[j][e] = c[e]; wv[j][4 + e] = d[e]; } }
        { const f32x4 a = *(const GAS f32x4*)(F.cvb + ch), b = *(const GAS f32x4*)(F.cvb + ch + 4), c = *(const GAS f32x4*)(F.cvb + DFF + ch), d = *(const GAS f32x4*)(F.cvb + DFF + ch + 4);
#pragma unroll
          for (int e = 0; e < 4; ++e) { bg[e] = a[e]; bg[4 + e] = b[e]; bv[e] = c[e]; bv[4 + e] = d[e]; } }
        float g1[8], g2[8], v1[8], v2[8];
        const bool first = (t0 & (SEQ - 1)) == 0;
        const bf16* ap = F.A + (size_t)t0 * F2 + acol;
        if (first) {
#pragma unroll
            for (int e = 0; e < 8; ++e) { g1[e] = g2[e] = v1[e] = v2[e] = 0.f; }
        } else {
            const v4u ga = *(const GAS v4u*)(ap - F2), gb = *(const GAS v4u*)(ap - 2 * (size_t)F2), va = *(const GAS v4u*)(ap - F2 + 128), vb = *(const GAS v4u*)(ap - 2 * (size_t)F2 + 128);
#pragma unroll
            for (int e = 0; e < 4; ++e) { g1[2 * e] = bflo(ga[e]); g1[2 * e + 1] = bfhi(ga[e]); g2[2 * e] = bflo(gb[e]); g2[2 * e + 1] = bfhi(gb[e]);
                v1[2 * e] = bflo(va[e]); v1[2 * e + 1] = bfhi(va[e]); v2[2 * e] = bflo(vb[e]); v2[2 * e + 1] = bfhi(vb[e]); }
        }
#pragma unroll 4
        for (int i = 0; i < TB; ++i) {
            const v4u gw = *(const GAS v4u*)(ap + (size_t)i * F2), vw = *(const GAS v4u*)(ap + (size_t)i * F2 + 128);
            float g0[8], v0[8], y[8];
#pragma unroll
            for (int e = 0; e < 4; ++e) { g0[2 * e] = bflo(gw[e]); g0[2 * e + 1] = bfhi(gw[e]); v0[2 * e] = bflo(vw[e]); v0[2 * e + 1] = bfhi(vw[e]); }
#pragma unroll
            for (int e = 0; e < 8; ++e) { const float gt = bg[e] + wg[0][e] * g2[e] + wg[1][e] * g1[e] + wg[2][e] * g0[e];
                const float vl = bv[e] + wv[0][e] * v2[e] + wv[1][e] * v1[e] + wv[2][e] * v0[e];
                y[e] = gt * pg8::sigmoidf_(gt) * vl; g2[e] = g1[e]; g1[e] = g0[e]; v2[e] = v1[e]; v1[e] = v0[e]; }
            v2u o; o.x = pk4_fp8(y[0] * S_ACT, y[1] * S_ACT, y[2] * S_ACT, y[3] * S_ACT); o.y = pk4_fp8(y[4] * S_ACT, y[5] * S_ACT, y[6] * S_ACT, y[7] * S_ACT);
            *(GAS v2u*)((unsigned char*)F.ACT + (size_t)(t0 + i) * DFF + ch) = o;
        }
    }
}

constexpr int N_PHASES = 12;
struct Args { const float* in[19]; float* out; unsigned char* ws; int ph_lo, ph_hi, li, pad; };
__global__ void __launch_bounds__(NWAVES * 64, 2) mega_fwd(Args args) {
    extern __shared__ __attribute__((aligned(16))) unsigned char lds[];
    Frame F;
    F.lds = (LAS unsigned char*)lds;
    F.MISC = (volatile LAS unsigned*)(F.lds + MISC_OFF);
    F.tid = threadIdx.x; F.lane = F.tid & 63; F.wave = __builtin_amdgcn_readfirstlane(F.tid >> 6);
    F.G = gridDim.x; F.gw = blockIdx.x * NWAVES + F.wave; F.NGW = F.G * NWAVES;
    unsigned char* ws = args.ws;
    F.ctl = (gu32*)(ws + WS_CTL);
    F.x = args.in[0]; F.c = args.in[1]; F.ada_w = args.in[2]; F.ada_b = args.in[3]; F.n1g = args.in[4]; F.w_in = args.in[5]; F.qng = args.in[6]; F.kng = args.in[7];
    F.sgg = args.in[8]; F.sgw = args.in[9]; F.sgb = args.in[10]; F.w_a = args.in[11]; F.w_b = args.in[12]; F.w_out = args.in[13]; F.n2g = args.in[14]; F.w_up = args.in[15];
    F.cvw = args.in[16]; F.cvb = args.in[17]; F.w_dn = args.in[18]; F.out = args.out;
    F.MOD = (float*)(ws + WS_MOD); F.PART = (float*)(ws + WS_TMP);   F.WIN = (bf16*)(ws + WS_WIN); F.WINB = (bf16*)(ws + WS_WINB); F.H8A = ws + WS_X1;   F.WA = (bf16*)(ws + WS_WA); F.WB = (bf16*)(ws + WS_WB); F.WOUT = (bf16*)(ws + WS_WOUT); F.WUP = (bf16*)(ws + WS_WUP); F.WDN = (bf16*)(ws + WS_WDN);
    F.H = (bf16*)(ws + WS_H); F.X1 = (float*)(ws + WS_X1); F.PROJ = (bf16*)(ws + WS_PROJ); F.MASK = (unsigned*)(ws + WS_MASK); F.RS = (float*)(ws + WS_RS); F.SWT = (float*)(ws + WS_SWT);
    F.VT = (bf16*)(ws + WS_VT); F.YA = (bf16*)(ws + WS_YA); F.YB = (bf16*)(ws + WS_YB); F.MRG = (bf16*)(ws + WS_MRG); F.TMP = (float*)(ws + WS_TMP); F.A = (bf16*)(ws + WS_A); F.ACT = (bf16*)(ws + WS_ACT);
    for (int u = F.tid; u < (LDS_BYTES - LDSCTL_OFF) / 4; u += NWAVES * 64) ((LAS unsigned*)(F.lds + LDSCTL_OFF))[u] = 0u;
    __syncthreads();
    XcdBarrier bar; bar.bar = (unsigned*)(F.ctl + CW_BAR); bar.x = 0; bar.st = nullptr;
    if (MK_N_LAUNCHES == 1) bar = xcd_barrier_post((unsigned*)(F.ctl + CW_BAR), F.MISC + 8);
    const int lo = args.ph_lo, hi = args.ph_hi;
#define IN(k) (lo <= (k) && (k) < hi)
#define SEAM(k) do { if (IN(k) && IN((k) + 1)) xcd_barrier(bar); } while (0)

#define REP(k) if ((PROBE_MASK >> (k)) & 1) for (int _rep = 0; _rep < 1; ++_rep)
    if (IN(0)) { p0_prologue(F); REP(0) { xcd_barrier(bar); p0_prologue(F, false); } } SEAM(0);
    if (IN(1)) { mod_reduce(F); } SEAM(1);
    if (IN(2)) { norm_rows<2>(F, F.x, F.n1g, 0, DM, F.H, F.H8A); REP(2) { xcd_barrier(bar); norm_rows<2>(F, F.x, F.n1g, 0, DM, F.H, F.H8A); } } SEAM(2);
    if (IN(3)) {
        { pg8::Gemm g{F.H, F.WINB, M, PNP, DM, DM, DM}; pg8::MixOrder S{0, F.G, (int)blockIdx.x}; EpiProj E{F.PROJ, 1.0f};
          pg8::gemm_phase<EpiProj, pg8::MixOrder, true, 2>(F.lds + RING_OFF, g, S, E); }
        VM_WAIT(); __syncthreads();
        { pg8::Gemm g{(const bf16*)F.H8A, F.WIN, M, PNP, DM, DM, DM}; pg8::MixOrder S{1, F.G, (int)blockIdx.x}; EpiProj E{F.PROJ, 1.0f / (S_H2 * 1024.f)};
          pg8::gemm_phase<EpiProj, pg8::MixOrder, true, 1>(F.lds + RING_OFF, g, S, E); }
    } SEAM(3);
    if (IN(4)) {
        for (int it = blockIdx.x; it < 512; it += F.G) { const int b = it >> 7, j = it & 127; idx_block(F, b, j); idx_block(F, b, 255 - j); }
        for (int row = F.gw; row < M; row += F.NGW) qknorm_row(F, row);
        for (int it = F.gw; it < BATCH * NKV * 2 * 256; it += F.NGW) vt_item(F, it);
        REP(4) { xcd_barrier(bar); for (int it = blockIdx.x; it < 512; it += F.G) { const int b = it >> 7, j = it & 127; idx_block(F, b, j); idx_block(F, b, 255 - j); } }
        REP(13) { xcd_barrier(bar); for (int it = F.gw; it < BATCH * NKV * 2 * 256; it += F.NGW) vt_item(F, it); }
    } SEAM(4);
    if (IN(5)) {
        { const float sb = attn_score_bound(F); for (int p = blockIdx.x; p < 256; p += F.G) { const int bg = p >> 4, j = p & 15; attn_block(F, bg >> 2, bg & 3, j, sb); attn_block(F, bg >> 2, bg & 3, 31 - j, sb); } }
        REP(5) { xcd_barrier(bar); { const float sb = attn_score_bound(F); for (int p = blockIdx.x; p < 256; p += F.G) { const int bg = p >> 4, j = p & 15; attn_block(F, bg >> 2, bg & 3, j, sb); attn_block(F, bg >> 2, bg & 3, 31 - j, sb); } } }
        for (int u = blockIdx.x; u < 512; u += F.G) sgu_unit(F, u);
        __syncthreads();
        REP(14) { xcd_barrier(bar); for (int u = blockIdx.x; u < 512; u += F.G) sgu_unit(F, u); __syncthreads(); }
    } SEAM(5);
    if (IN(6)) {
        { pg8::Gemm g{F.YA, F.WA, M, DM, ATTW, ATTW, ATTW}; pg8::StaticOrder S; S.init(M, DM, F.G, (int)blockIdx.x); EpiGateA E{F.PROJ, F.TMP, 1.0f / (S_YA * S_WA)};
          pg8::gemm_phase<EpiGateA, pg8::StaticOrder, true, 1>(F.lds + RING_OFF, g, S, E); }
        VM_WAIT(); __syncthreads();
        { pg8::Gemm g{F.YB, F.WB, M, DM, GMW, GMW, GMW}; pg8::StaticOrder S; S.init(M, DM, F.G, (int)blockIdx.x); EpiGateB E{F.PROJ, F.TMP, (unsigned char*)F.MRG, 1.0f / (S_YB * S_WB)};
          pg8::gemm_phase<EpiGateB, pg8::StaticOrder, true, 1>(F.lds + RING_OFF, g, S, E); }
        REP(6) { xcd_barrier(bar);
          { pg8::Gemm g{F.YA, F.WA, M, DM, ATTW, ATTW, ATTW}; pg8::StaticOrder S; S.init(M, DM, F.G, (int)blockIdx.x); EpiGateA E{F.PROJ, F.TMP, 1.0f / (S_YA * S_WA)};
            pg8::gemm_phase<EpiGateA, pg8::StaticOrder, true, 1>(F.lds + RING_OFF, g, S, E); }
          VM_WAIT(); __syncthreads();
          { pg8::Gemm g{F.YB, F.WB, M, DM, GMW, GMW, GMW}; pg8::StaticOrder S; S.init(M, DM, F.G, (int)blockIdx.x); EpiGateB E{F.PROJ, F.TMP, (unsigned char*)F.MRG, 1.0f / (S_YB * S_WB)};
            pg8::gemm_phase<EpiGateB, pg8::StaticOrder, true, 1>(F.lds + RING_OFF, g, S, E); } }
    } SEAM(6);
    if (IN(7)) { pg8::Gemm g{F.MRG, F.WOUT, M, DM, DM, DM, DM}; pg8::StaticOrder S; S.init(M, DM, F.G, (int)blockIdx.x); EpiResid E{F.x, F.MOD + 2 * DM, F.X1, 1.0f / (S_MRG * S_WOUT)};
        pg8::gemm_phase<EpiResid, pg8::StaticOrder, true, 1>(F.lds + RING_OFF, g, S, E);
        REP(7) { xcd_barrier(bar); pg8::gemm_phase<EpiResid, pg8::StaticOrder, true, 1>(F.lds + RING_OFF, g, S, E); } } SEAM(7);
    if (IN(8)) { norm_rows<1>(F, F.X1, F.n2g, 3 * DM, 4 * DM, F.H); REP(8) { xcd_barrier(bar); norm_rows<1>(F, F.X1, F.n2g, 3 * DM, 4 * DM, F.H); } } SEAM(8);
    if (IN(9)) { pg8::Gemm g{F.H, F.WUP, M, F2, DM, DM, DM}; pg8::StaticOrder S; S.init(M, F2, F.G, (int)blockIdx.x); EpiPlain E{F.A, F2, 1.0f / (S_H2 * S_WUP)};
        pg8::gemm_phase<EpiPlain, pg8::StaticOrder, true, 1>(F.lds + RING_OFF, g, S, E);
        REP(9) { xcd_barrier(bar); pg8::gemm_phase<EpiPlain, pg8::StaticOrder, true, 1>(F.lds + RING_OFF, g, S, E); } } SEAM(9);
    if (IN(10)) { conv_phase(F); REP(10) { xcd_barrier(bar); conv_phase(F); } } SEAM(10);
    if (IN(11)) { pg8::Gemm g{F.ACT, F.WDN, M, DM, DFF, DFF, DFF}; pg8::StaticOrder S; S.init(M, DM, F.G, (int)blockIdx.x); EpiResid E{F.X1, F.MOD + 5 * DM, F.out, 1.0f / (S_ACT * S_WDN)};
        pg8::gemm_phase<EpiResid, pg8::StaticOrder, true, 1>(F.lds + RING_OFF, g, S, E);
        REP(11) { xcd_barrier(bar); pg8::gemm_phase<EpiResid, pg8::StaticOrder, true, 1>(F.lds + RING_OFF, g, S, E); } }
#undef REP
#undef IN
#undef SEAM
}

extern "C" void kernel_launch(void* const* d_in, const int* in_sizes, int n_in, void* d_out, int out_size, void* d_ws, size_t ws_size, hipStream_t stream) {
    static int grid = 0;
    if (grid == 0) {
        if (n_in != 19 || in_sizes[0] != M * DM || out_size != M * DM || ws_size < WS_END) { fprintf(stderr, "kernel_launch: unexpected shapes (n_in %d, in0 %d, out %d, ws %zu < %zu); nothing launched\n", n_in, n_in > 0 ? in_sizes[0] : -1, out_size, ws_size, (size_t)WS_END); grid = -1; return; }
        int dev = 0, cus = 0, per_cu = 0;
        if (hipGetDevice(&dev) != hipSuccess || hipDeviceGetAttribute(&cus, hipDeviceAttributeMultiprocessorCount, dev) != hipSuccess) { fprintf(stderr, "kernel_launch: device query failed\n"); grid = -1; return; }
        if (hipFuncSetAttribute((const void*)mega_fwd, hipFuncAttributeMaxDynamicSharedMemorySize, LDS_BYTES) != hipSuccess) { fprintf(stderr, "kernel_launch: hipFuncSetAttribute failed\n"); grid = -1; return; }
        if (hipOccupancyMaxActiveBlocksPerMultiprocessor(&per_cu, (const void*)mega_fwd, NWAVES * 64, LDS_BYTES) != hipSuccess || per_cu < 1) { fprintf(stderr, "kernel_launch: occupancy query reports %d blocks per CU\n", per_cu); }
        (void)hipGetLastError();
        grid = cus;
    }
    if (grid < 0) return;
    if (hipMemsetAsync((char*)d_ws + WS_CTL, 0, CTL_ZERO_BYTES, stream) != hipSuccess) { fprintf(stderr, "kernel_launch: memset failed\n"); return; }
    Args a{};
    for (int i = 0; i < 19; ++i) a.in[i] = (const float*)d_in[i];
    a.out = (float*)d_out; a.ws = (unsigned char*)d_ws; a.pad = 0;
    for (int li = 0; li < MK_N_LAUNCHES; ++li) {
        if (MK_N_LAUNCHES == 1) { a.ph_lo = 0; a.ph_hi = N_PHASES; } else { a.ph_lo = li; a.ph_hi = li + 1; }
        a.li = li;
        hipLaunchKernelGGL(mega_fwd, dim3(grid), dim3(NWAVES * 64), LDS_BYTES, stream, a);
        const hipError_t le = hipPeekAtLastError();
        if (le != hipSuccess) { fprintf(stderr, "kernel_launch: launch %d failed: %s\n", li, hipGetErrorName(le)); break; }
    }
}
```

```cpp
#include <hip/hip_runtime.h>
#include <cstdio>
#include <cstdint>

#ifndef MK_N_LAUNCHES
#define MK_N_LAUNCHES 1
#endif
#ifndef PROBE_MASK
#define PROBE_MASK 0x0
#endif

namespace pg8 {
#define PG8_LAS __attribute__((address_space(3)))
typedef unsigned short bf16_t;
typedef short bf16x8 __attribute__((ext_vector_type(8)));
typedef float f32x4 __attribute__((ext_vector_type(4)));
typedef float f32x2 __attribute__((ext_vector_type(2)));
typedef unsigned u32x4 __attribute__((ext_vector_type(4)));
typedef unsigned u32x2 __attribute__((ext_vector_type(2)));
constexpr int BM = 256, BK = 64, HALF = 128, HTB = HALF * BK * 2, STAGE_BYTES = 8 * HTB, NXCD = 8, WGM = 8;

__host__ __device__ __forceinline__ int lds_byte(int r, int c) { const int st = (r >> 4) * 2 + (c >> 5), rr = r & 15, cc = c & 31, ob = rr * 64 + cc * 2; return st * 1024 + (ob ^ (((ob >> 9) & 1) << 5)); }
__host__ __device__ __forceinline__ void stage_rc(int b, int& R, int& C) { const int st = b / 1024, sb = b % 1024, swz = sb ^ (((sb >> 9) & 1) << 5); R = (st >> 1) * 16 + swz / 64; C = (st & 1) * 32 + (swz % 64) / 2; }
__host__ __device__ __forceinline__ int perm32(int rho) { const int n = rho >> 4, i = rho & 15; return 8 * (i >> 2) + 4 * n + (i & 3); }

struct Unit { int pm, pn; };
struct Gemm { const bf16_t* A; const bf16_t* Bt; int M, N, K, lda, ldb; };

struct StaticOrder {
    int nM, nN, nwg, G, c;
    __host__ __device__ void init(int M, int N, int G_, int c_) { nM = M / BM; nN = N / BM; nwg = nM * nN; G = G_; c = c_; }
    __host__ __device__ bool next(int i, Unit& u) const {
        const long L = (long)i * G + c; if (L >= nwg) return false;
        int wgid = (int)L; { const int q = nwg / NXCD, r = nwg % NXCD, xcd = wgid % NXCD, off = wgid / NXCD; wgid = (xcd < r ? xcd * (q + 1) : r * (q + 1) + (xcd - r) * q) + off; }
        const int nig = WGM * nN, gid = wgid / nig, fm = gid * WGM, gsz = (nM - fm) < WGM ? (nM - fm) : WGM;
        u.pm = fm + ((wgid % nig) % gsz); u.pn = (wgid % nig) / gsz; return true;
    }
    __device__ __forceinline__ void a_ready(const Unit&) const {}
    __device__ __forceinline__ void done(const Unit&) const {}
};
struct MixOrder {
    int fp8, G, c;
    __host__ __device__ static void map(int L, int nwg, int nN, Unit& u) {
        int wgid = L; { const int q = nwg / NXCD, r = nwg % NXCD, xcd = wgid % NXCD, off = wgid / NXCD; wgid = (xcd < r ? xcd * (q + 1) : r * (q + 1) + (xcd - r) * q) + off; }
        const int nig = WGM * nN; u.pm = (wgid / nig) * WGM + ((wgid % nig) % WGM); u.pn = (wgid % nig) / WGM;
    }
    __host__ __device__ bool next(int i, Unit& u) const {
        int L;
        if (!fp8) { L = i * G + c; if (L >= 288) return false; map(L, 288, 9, u); u.pn = u.pn < 8 ? 12 + u.pn : 68; return true; }
        if (G == 256) { if (c >= 32) { if (i >= 8) return false; L = i * 224 + (c - 32); } else { if (i >= 4) return false; L = 1792 + 4 * c + i; } }
        else { L = i * G + c; if (L >= 1920) return false; }
        map(L, 1920, 60, u); u.pn = u.pn < 12 ? u.pn : u.pn + 8; return true;
    }
    __device__ __forceinline__ void a_ready(const Unit&) const {}
    __device__ __forceinline__ void done(const Unit&) const {}
};

__device__ __forceinline__ unsigned cvt_pk_bf16(float lo, float hi) { unsigned r; asm volatile("v_cvt_pk_bf16_f32 %0, %1, %2" : "=v"(r) : "v"(lo), "v"(hi)); return r; }
__device__ __forceinline__ f32x2 gelu_pk(f32x2 v) {
    const f32x2 av = __builtin_elementwise_abs(v), d = av * 0.2316418882f + 1.0f;
    f32x2 t; t.x = __builtin_amdgcn_rcpf(d.x); t.y = __builtin_amdgcn_rcpf(d.y);
    f32x2 q = t * 0.5307027145f + (-0.7265760135f); q = q * t + 0.7107068705f; q = q * t + (-0.142248368f); q = q * t + 0.127414796f; q = q * t;
    const f32x2 s = (v * v) * (-0.72134752044f);
    f32x2 e; e.x = __builtin_amdgcn_exp2f(s.x); e.y = __builtin_amdgcn_exp2f(s.y);
    const f32x2 m = v * (q * e), r = v - m;
    f32x2 o; o.x = v.x < 0.f ? m.x : r.x; o.y = v.y < 0.f ? m.y : r.y; return o;
}
__device__ __forceinline__ float sigmoidf_(float x) { return __builtin_amdgcn_rcpf(1.0f + __builtin_amdgcn_exp2f(-1.4426950408889634f * x)); }
__device__ __forceinline__ float bflo(unsigned w) { return __builtin_bit_cast(float, w << 16); }
__device__ __forceinline__ float bfhi(unsigned w) { return __builtin_bit_cast(float, w & 0xffff0000u); }

typedef int i32x8 __attribute__((ext_vector_type(8)));
typedef int i32x4 __attribute__((ext_vector_type(4)));
template <class Epi, class Sched, bool ALIGN_EPI, int ES = 2>
__device__ __forceinline__ void gemm_phase(PG8_LAS unsigned char* lds, const Gemm g, const Sched& S, const Epi& E) {
    const int tid = threadIdx.x, wid = __builtin_amdgcn_readfirstlane(tid >> 6), lane = tid & 63, wr = wid >> 2, wc = wid & 3, fr = lane & 15, fq = lane >> 4;
    const int K = g.K, nt = K * ES / (BK * 2);
    unsigned voffA[2], voffB[2];
#pragma unroll
    for (int i = 0; i < 2; ++i) { int R, C; stage_rc(tid * 16 + i * 8192, R, C); const int Rb = Epi::PERM ? ((R & ~31) + perm32(R & 31)) : R;
        voffA[i] = (unsigned)(R * g.lda) * (unsigned)ES + (unsigned)C * 2u; voffB[i] = (unsigned)(Rb * g.ldb) * (unsigned)ES + (unsigned)C * 2u; }
    const size_t kstep = (size_t)(BK * 2);
    const size_t hstepA = (size_t)HALF * g.lda * ES, hstepB = (size_t)HALF * g.ldb * ES;
    const size_t tstepA = 2 * hstepA, tstepB = 2 * hstepB;
    const unsigned ldsw = (unsigned)wid * 1024u;
    const int aoff = lds_byte(wr * 64 + fr, fq * 8), boff = lds_byte(wc * 32 + fr, fq * 8);
#define PG8_SA(b, h) (((b) * 2 + (h)) * HTB)
#define PG8_SB(b, h) ((4 + (b) * 2 + (h)) * HTB)
#define PG8_STAGE(bufoff, gbase, voff) do { _Pragma("unroll") for (int _i = 0; _i < 2; ++_i) \
        __builtin_amdgcn_global_load_lds((const unsigned*)((const char*)(gbase) + (voff)[_i]), (PG8_LAS unsigned*)(lds + (bufoff) + ldsw + _i * 8192), 16, 0, 0); } while (0)
#define PG8_CAT(x, y) __builtin_shufflevector(x, y, 0, 1, 2, 3, 4, 5, 6, 7)
#define PG8_LO(v) __builtin_bit_cast(bf16x8, __builtin_shufflevector(v, v, 0, 1, 2, 3))
#define PG8_HI(v) __builtin_bit_cast(bf16x8, __builtin_shufflevector(v, v, 4, 5, 6, 7))
#define PG8_LDA(dst, b, h) do { _Pragma("unroll") for (int m = 0; m < 4; ++m) { const i32x4 _l = *(const PG8_LAS i32x4*)(lds + PG8_SA(b, h) + aoff + m * 2048), _h = *(const PG8_LAS i32x4*)(lds + PG8_SA(b, h) + aoff + m * 2048 + 1024); dst[m] = PG8_CAT(_l, _h); } } while (0)
#define PG8_LDB(dst, b, h) do { _Pragma("unroll") for (int n = 0; n < 2; ++n) { const i32x4 _l = *(const PG8_LAS i32x4*)(lds + PG8_SB(b, h) + boff + n * 2048), _h = *(const PG8_LAS i32x4*)(lds + PG8_SB(b, h) + boff + n * 2048 + 1024); dst[n] = PG8_CAT(_l, _h); } } while (0)
#define PG8_MMA(ai, bj, At, Bt) do { __builtin_amdgcn_s_setprio(1); _Pragma("unroll") for (int m = 0; m < 4; ++m) _Pragma("unroll") for (int n = 0; n < 2; ++n) { \
        if constexpr (ES == 2) { acc[ai][bj][m][n] = __builtin_amdgcn_mfma_f32_16x16x32_bf16(PG8_LO(Bt[n]), PG8_LO(At[m]), acc[ai][bj][m][n], 0, 0, 0); \
                                 acc[ai][bj][m][n] = __builtin_amdgcn_mfma_f32_16x16x32_bf16(PG8_HI(Bt[n]), PG8_HI(At[m]), acc[ai][bj][m][n], 0, 0, 0); } \
        else asm volatile("v_mfma_f32_16x16x128_f8f6f4 %0, %1, %2, %0" : "+v"(acc[ai][bj][m][n]) : "v"(Bt[n]), "v"(At[m])); } __builtin_amdgcn_s_setprio(0); } while (0)
#define PG8_WAIT_V(n) asm volatile("s_waitcnt vmcnt(" #n ")" ::: "memory")
#define PG8_WAIT_L(n) asm volatile("s_waitcnt lgkmcnt(" #n ")" ::: "memory")
#define PG8_BAR __builtin_amdgcn_s_barrier()
#define PG8_SCHED __builtin_amdgcn_sched_barrier(0)
    Unit cur, nxt; int ui = 0;
    if (!S.next(0, cur)) return;
    f32x4 acc[2][2][4][2];
#pragma unroll
    for (int a = 0; a < 2; ++a)
#pragma unroll
        for (int b = 0; b < 2; ++b)
#pragma unroll
            for (int m = 0; m < 4; ++m)
#pragma unroll
                for (int n = 0; n < 2; ++n) acc[a][b][m][n] = (f32x4){0.f, 0.f, 0.f, 0.f};
    i32x8 At[4], B0[2], B1[2];
    const char* cA = (const char*)g.A + (size_t)cur.pm * tstepA; const char* cB = (const char*)g.Bt + (size_t)cur.pn * tstepB;
    S.a_ready(cur);
    PG8_STAGE(PG8_SB(0, 0), cB, voffB); PG8_STAGE(PG8_SB(0, 1), cB + hstepB, voffB); PG8_STAGE(PG8_SA(0, 0), cA, voffA); PG8_STAGE(PG8_SA(0, 1), cA + hstepA, voffA);
    if (wr == 1) PG8_BAR;
    PG8_WAIT_V(2); PG8_BAR;
    PG8_STAGE(PG8_SB(1, 0), cB + kstep, voffB); PG8_STAGE(PG8_SA(1, 0), cA + kstep, voffA); PG8_STAGE(PG8_SB(1, 1), cB + hstepB + kstep, voffB);
    PG8_WAIT_V(6); PG8_BAR;
    for (;;) {
        const bool has_next = S.next(ui + 1, nxt);
        const char* nA = has_next ? (const char*)g.A + (size_t)nxt.pm * tstepA : cA; const char* nB = has_next ? (const char*)g.Bt + (size_t)nxt.pn * tstepB : cB;
        for (int t = 0; t < nt; t += 2) {
            const bool last = (t == nt - 2);
            const char* a1 = cA + (size_t)(t + 1) * kstep;
            const char* a2 = last ? nA : cA + (size_t)(t + 2) * kstep; const char* b2 = last ? nB : cB + (size_t)(t + 2) * kstep;
            const char* a3 = a2 + kstep; const char* b3 = b2 + kstep;
            if (last && has_next) S.a_ready(nxt);
            PG8_LDB(B0, 0, 0); PG8_LDB(B1, 0, 1); PG8_SCHED; PG8_LDA(At, 0, 0); PG8_STAGE(PG8_SA(1, 1), a1 + hstepA, voffA);
            PG8_WAIT_V(8); PG8_WAIT_L(0); PG8_BAR; PG8_MMA(0, 0, At, B0); PG8_MMA(0, 1, At, B1); PG8_BAR; PG8_SCHED;
            PG8_LDA(At, 0, 1); PG8_STAGE(PG8_SB(0, 0), b2, voffB); PG8_STAGE(PG8_SB(0, 1), b2 + hstepB, voffB); PG8_STAGE(PG8_SA(0, 0), a2, voffA);
            PG8_WAIT_V(8); PG8_WAIT_L(0); PG8_BAR; PG8_MMA(1, 0, At, B0); PG8_MMA(1, 1, At, B1); PG8_BAR; PG8_SCHED;
            PG8_LDB(B0, 1, 0); PG8_LDB(B1, 1, 1); PG8_SCHED; PG8_LDA(At, 1, 0); PG8_STAGE(PG8_SA(0, 1), a2 + hstepA, voffA);
            PG8_WAIT_V(8); PG8_WAIT_L(0); PG8_BAR; PG8_MMA(0, 0, At, B0); PG8_MMA(0, 1, At, B1); PG8_BAR; PG8_SCHED;
            PG8_LDA(At, 1, 1); PG8_STAGE(PG8_SB(1, 0), b3, voffB); PG8_STAGE(PG8_SB(1, 1), b3 + hstepB, voffB); PG8_STAGE(PG8_SA(1, 0), a3, voffA);
            PG8_WAIT_V(8); PG8_WAIT_L(0); PG8_BAR; PG8_MMA(1, 0, At, B0); PG8_MMA(1, 1, At, B1); PG8_BAR; PG8_SCHED;
        }
        if constexpr (ALIGN_EPI) { if (wr == 0) PG8_BAR; }
        if constexpr (ES == 1) asm volatile("s_nop 15\n\ts_nop 15" ::: "memory");
        E(acc, cur, wr, wc, fr, fq); S.done(cur);
        if (!has_next) break;
#pragma unroll
        for (int a = 0; a < 2; ++a)
#pragma unroll
            for (int b = 0; b < 2; ++b)
#pragma unroll
                for (int m = 0; m < 4; ++m)
#pragma unroll
                    for (int n = 0; n < 2; ++n) acc[a][b][m][n] = (f32x4){0.f, 0.f, 0.f, 0.f};
        cur = nxt; cA = nA; cB = nB; ++ui;
        if constexpr (ALIGN_EPI) { if (wr == 1) PG8_BAR; }
    }
    PG8_WAIT_V(0);
    if constexpr (!ALIGN_EPI) { if (wr == 0) PG8_BAR; }
    PG8_BAR;
#undef PG8_SA
#undef PG8_SB
#undef PG8_STAGE
#undef PG8_LDA
#undef PG8_CAT
#undef PG8_LO
#undef PG8_HI
#undef PG8_LDB
#undef PG8_MMA
#undef PG8_WAIT_V
#undef PG8_WAIT_L
#undef PG8_BAR
#undef PG8_SCHED
}
}

constexpr int NWAVES = 8;
constexpr int BATCH = 4, SEQ = 2048, DM = 4096, M = BATCH * SEQ;
constexpr int NH = 16, HD = 128, NKV = 4, ATTW = 2048, KVW = 512, IH = 32, IDIM = 64, TOPK = 256;
constexpr int GMW = 2048, GMG = 8, GMGW = 256, GMC = 128, DFF = 11008, F2 = 2 * DFF;
constexpr int IN_W = 17504, MODW = 6 * DM;
constexpr float EPS = 1e-6f;
constexpr int PQ = 0, PK = 2048, PV = 2560, PQI = 3072, PGU = 5120, PGV = 7168, PGA = 9216, PGB = 13312, PKI = 17408, PWI = 17472, PNP = 17664;
constexpr int SQ = 0, SK = 2048, SV = 2560, SQI = 3072, SKI = 5120, SWI = 5184, SGU = 5216, SGV = 7264, SGA = 9312, SGB = 13408;

constexpr size_t MiB = 1u << 20;
constexpr size_t WS_CTL = 0, CTL_ZERO_BYTES = 2 * MiB;
constexpr size_t WS_MOD = 1 * MiB;
constexpr size_t WS_WIN = 2 * MiB;
constexpr size_t WS_WA = 140 * MiB, WS_WB = 156 * MiB;
constexpr size_t WS_WOUT = 172 * MiB;
constexpr size_t WS_WUP = 204 * MiB;
constexpr size_t WS_WDN = 376 * MiB;
constexpr size_t WS_H = 462 * MiB;
constexpr size_t WS_X1 = 526 * MiB;
constexpr size_t WS_PROJ = 654 * MiB;
constexpr size_t WS_MASK = 930 * MiB;
constexpr size_t WS_RS = 932 * MiB;
constexpr size_t WS_SWT = 932 * MiB + 65536;
constexpr size_t WS_VT = 933 * MiB;
constexpr size_t WS_YA = 941 * MiB, WS_YB = 973 * MiB;
constexpr size_t WS_MRG = 1005 * MiB;
constexpr size_t WS_TMP = 1069 * MiB;
constexpr size_t WS_A = 654 * MiB;
constexpr size_t WS_ACT = 998 * MiB;
constexpr size_t WS_WINB = 1197 * MiB;
constexpr size_t WS_END = 1336 * MiB;
static_assert(WS_WIN + (size_t)PNP * DM * 2 <= WS_WA && WS_WUP + (size_t)F2 * DM * 2 <= WS_WDN && WS_WDN + (size_t)DM * DFF * 2 <= WS_H, "ws map 1");
static_assert(WS_PROJ + (size_t)M * PNP * 2 <= WS_MASK && WS_A + (size_t)M * F2 * 2 <= WS_ACT && WS_ACT + (size_t)M * DFF * 2 <= WS_END && WS_TMP + (size_t)M * DM * 4 <= WS_END, "ws map 2");
constexpr int CW_TMO = 0, CW_CODE = 1, CW_BAR = 4096;

constexpr int RING_OFF = 0, RING_BYTES = 131072;
constexpr int LDSCTL_OFF = RING_BYTES + 8192, MISC_OFF = LDSCTL_OFF + 320;
constexpr int LDS_BYTES = 147456;
static_assert(MISC_OFF + 128 <= LDS_BYTES, "LDS map");

#define GAS __attribute__((address_space(1)))
#define LAS __attribute__((address_space(3)))
typedef unsigned short bf16;
typedef unsigned v4u __attribute__((ext_vector_type(4)));
typedef unsigned v2u __attribute__((ext_vector_type(2)));
typedef float f32x4 __attribute__((ext_vector_type(4)));
typedef float f32x16 __attribute__((ext_vector_type(16)));
typedef short bf16x8 __attribute__((ext_vector_type(8)));
typedef short bf16x4 __attribute__((ext_vector_type(4)));
typedef GAS unsigned gu32;
#define RLX_AGENT __ATOMIC_RELAXED, __HIP_MEMORY_SCOPE_AGENT
#define LDS_WAIT() asm volatile("s_waitcnt lgkmcnt(0)" ::: "memory")
#define VM_WAIT() asm volatile("s_waitcnt vmcnt(0)" ::: "memory")
__device__ __forceinline__ unsigned f2bf(float f) { unsigned u = __builtin_bit_cast(unsigned, f); return (u + 0x7fffu + ((u >> 16) & 1u)) >> 16; }
__device__ __forceinline__ unsigned pk2(float lo, float hi) { return f2bf(lo) | (f2bf(hi) << 16); }
__device__ __forceinline__ float bf2f(bf16 h) { return __builtin_bit_cast(float, (unsigned)h << 16); }
using pg8::bflo; using pg8::bfhi;
constexpr float S_H2 = 16.f, S_WUP = 1024.f, S_ACT = 4.f, S_WDN = 1024.f, S_YA = 16.f, S_YB = 8.f, S_MRG = 16.f, S_WA = 1024.f, S_WB = 1024.f, S_WOUT = 1024.f;
__device__ __forceinline__ float clamp448(float x) { return __builtin_amdgcn_fmed3f(x, -448.f, 448.f); }
__device__ __forceinline__ unsigned pk4_fp8(float a, float b, float c, float d) {
    int w = __builtin_amdgcn_cvt_pk_fp8_f32(clamp448(a), clamp448(b), 0, false);
    w = __builtin_amdgcn_cvt_pk_fp8_f32(clamp448(c), clamp448(d), w, true);
    return (unsigned)w;
}

#define XB_TMO      128
#define XB_XCNT(j)  (256  + 64 * (j))
#define XB_XSUB(j)  (1280 + 64 * (j))
#define XB_XGEN(j)  (2304 + 64 * (j))
#define XB_TOP      3328
#define XB_TOPGEN   3392
#define XCD_BAR_WORDS 3456
#define XB_SPIN_CAP (1u << 18)
__device__ __forceinline__ unsigned xb_ld(unsigned* p)              { return __hip_atomic_load(p, __ATOMIC_RELAXED, __HIP_MEMORY_SCOPE_AGENT); }
__device__ __forceinline__ unsigned xb_add(unsigned* p, unsigned v) { return __hip_atomic_fetch_add(p, v, __ATOMIC_RELAXED, __HIP_MEMORY_SCOPE_AGENT); }
__device__ __forceinline__ unsigned xb_xcc_id() { return (unsigned)__builtin_amdgcn_s_getreg((3 << 11) | 20) & 0xFu; }
#define XB_SPIN(cond, bar) do { unsigned _sp = 0; while (cond) { __builtin_amdgcn_s_sleep(1); \
    if ((++_sp & 255u) == 0u) { if (xb_ld(&(bar)[XB_TMO])) break; if (_sp > XB_SPIN_CAP) { atomicAdd(&(bar)[XB_TMO], 1u); break; } } } } while (0)
struct XcdBarrier { unsigned* bar; unsigned x; volatile LAS unsigned* st; };
__device__ __forceinline__ XcdBarrier xcd_barrier_post(unsigned* bar, volatile LAS unsigned* st) {
    XcdBarrier b; b.bar = bar; b.x = xb_xcc_id(); b.st = st;
    if (threadIdx.x == 0) (void)xb_add(&bar[XB_XCNT(b.x)], 1u);
    return b;
}
__device__ __forceinline__ void xcd_barrier_complete(unsigned* bar, unsigned x, unsigned& nloc, unsigned& nx) {
    const unsigned G = gridDim.x * gridDim.y * gridDim.z;
    unsigned sum, cnt, mine, sp = 0u;
    for (;;) {
        sum = 0u; cnt = 0u; mine = 0u;
#pragma unroll
        for (unsigned j = 0; j < 16; ++j) { const unsigned c = xb_ld(&bar[XB_XCNT(j)]); sum += c; cnt += (c > 0u) ? 1u : 0u; mine = (j == x) ? c : mine; }
        if (sum == G) break;
        __builtin_amdgcn_s_sleep(1);
        if ((++sp & 255u) == 0u) { if (xb_ld(&bar[XB_TMO])) break; if (sp > XB_SPIN_CAP) { atomicAdd(&bar[XB_TMO], 1u); break; } }
    }
    nloc = mine > 0u ? mine : 1u; nx = cnt > 0u ? cnt : 1u;
}
__device__ __forceinline__ void xcd_barrier(const XcdBarrier& b) {
    asm volatile("s_waitcnt vmcnt(0)" ::: "memory");
    __syncthreads();
    if (threadIdx.x == 0) {
        unsigned* bar = b.bar;
        __builtin_amdgcn_s_waitcnt(0);
        unsigned nloc = b.st[0], nx = b.st[1];
        if (nloc == 0u) { xcd_barrier_complete(bar, b.x, nloc, nx); b.st[0] = nloc; b.st[1] = nx; }
        const unsigned old = xb_add(&bar[XB_XSUB(b.x)], 1u);
        const unsigned gen = old / nloc;
        if (old + 1u == (gen + 1u) * nloc) {
            __builtin_amdgcn_fence(__ATOMIC_RELEASE, "agent");
            asm volatile("s_waitcnt vmcnt(0)" ::: "memory");
            const unsigned og = xb_add(&bar[XB_TOP], 1u);
            const unsigned tg = og / nx;
            if (og + 1u == (tg + 1u) * nx) xb_add(&bar[XB_TOPGEN], 1u);
            else XB_SPIN(xb_ld(&bar[XB_TOPGEN]) == tg, bar);
            __builtin_amdgcn_fence(__ATOMIC_ACQUIRE, "agent");
            xb_add(&bar[XB_XGEN(b.x)], 1u);
            asm volatile("s_waitcnt vmcnt(0)" ::: "memory");
        } else {
            XB_SPIN(xb_ld(&bar[XB_XGEN(b.x)]) == gen, bar);
            __builtin_amdgcn_fence(__ATOMIC_ACQUIRE, "agent");
            asm volatile("s_waitcnt vmcnt(0)" ::: "memory");
        }
    }
    __syncthreads();
}

struct Frame {
    LAS unsigned char* lds;
    volatile LAS unsigned* MISC;
    gu32* ctl;
    int tid, lane, wave, G, gw, NGW;
    const float *x, *c, *ada_w, *ada_b, *n1g, *w_in, *qng, *kng, *sgg, *sgw, *sgb, *w_a, *w_b, *w_out, *n2g, *w_up, *cvw, *cvb, *w_dn;
    float* out;
    float *MOD, *PART; bf16 *WINB; unsigned char* H8A; bf16 *WIN, *WA, *WB, *WOUT, *WUP, *WDN, *H, *PROJ, *VT, *YA, *YB, *MRG, *A, *ACT; float *X1, *TMP, *RS, *SWT; unsigned* MASK;
};
__device__ __forceinline__ float wave_sum(float v) {
#pragma unroll
    for (int o = 1; o < 64; o <<= 1) v += __shfl_xor(v, o);
    return v;
}

__device__ __forceinline__ int win_dst_row(int n) {
    if (n < SKI) return n;
    if (n < SWI) return PKI + (n - SKI);
    if (n < SGU) return PWI + (n - SWI);
    return PGU + (n - SGU);
}
__device__ __forceinline__ void gemv_item(Frame& F, int item) {
    const int nb = item % 96, ks = item / 96, n0 = nb * 256 + 4 * F.lane, k0 = ks * 64;
    float cs[4];
#pragma unroll
    for (int b = 0; b < 4; ++b) { const float cv = F.c[b * DM + k0 + F.lane]; cs[b] = cv * pg8::sigmoidf_(cv); }
    f32x4 acc[4];
#pragma unroll
    for (int b = 0; b < 4; ++b) acc[b] = (f32x4){0.f, 0.f, 0.f, 0.f};
    const float* wp = F.ada_w + (size_t)k0 * MODW + n0;
#pragma unroll 16
    for (int k = 0; k < 64; ++k) { const f32x4 w = *(const GAS f32x4*)(wp + (size_t)k * MODW);
#pragma unroll
        for (int b = 0; b < 4; ++b) { const float s = __builtin_bit_cast(float, __builtin_amdgcn_readlane(__builtin_bit_cast(int, cs[b]), k)); acc[b] += w * s; } }
#pragma unroll
    for (int b = 0; b < 4; ++b) *(GAS f32x4*)(F.PART + (size_t)(ks * 4 + b) * MODW + n0) = acc[b];
}
__device__ __forceinline__ void mod_reduce(Frame& F) {
    for (int i = F.gw * 64 + F.lane; i < 4 * (MODW / 4); i += F.NGW * 64) { const int b = i / (MODW / 4), n0 = 4 * (i % (MODW / 4));
        f32x4 a = *(const GAS f32x4*)(F.ada_b + n0);
#pragma unroll 16
        for (int ks = 0; ks < 64; ++ks) a += *(const GAS f32x4*)(F.PART + (size_t)(ks * 4 + b) * MODW + n0);
        *(GAS f32x4*)(F.MOD + b * MODW + n0) = a; }
}
struct TrItem { const float* src; unsigned char* d8; bf16* db; int Nsrc, ldk, drow0, k0; float scale; };
__device__ __forceinline__ void tr_decode(Frame& F, int r, TrItem& t) {
    constexpr int P_IN = (DM / 128) * (IN_W / 32), P_A = (ATTW / 128) * (DM / 32), P_B = (GMW / 128) * (DM / 32), P_O = (DM / 128) * (DM / 32), P_UP = (DM / 128) * (F2 / 32);
    const float* W; int Nsrc, nblk, ldk, drow; unsigned char* d8; bf16* db = nullptr; float sc; bool up = false, in = false;
    if (r < P_IN) { W = F.w_in; Nsrc = IN_W; nblk = IN_W / 32; d8 = (unsigned char*)F.WIN; ldk = DM; sc = 1024.f; in = true; }
    else if ((r -= P_IN) < P_A) { W = F.w_a; Nsrc = DM; nblk = DM / 32; d8 = (unsigned char*)F.WA; ldk = ATTW; sc = S_WA; }
    else if ((r -= P_A) < P_B) { W = F.w_b; Nsrc = DM; nblk = DM / 32; d8 = (unsigned char*)F.WB; ldk = GMW; sc = S_WB; }
    else if ((r -= P_B) < P_O) { W = F.w_out; Nsrc = DM; nblk = DM / 32; d8 = (unsigned char*)F.WOUT; ldk = DM; sc = S_WOUT; }
    else if ((r -= P_O) < P_UP) { W = F.w_up; Nsrc = F2; nblk = F2 / 32; d8 = (unsigned char*)F.WUP; ldk = DM; sc = S_WUP; up = true; }
    else { r -= P_UP; W = F.w_dn; Nsrc = DM; nblk = DM / 32; d8 = (unsigned char*)F.WDN; ldk = DFF; sc = S_WDN; }
    const int kb = r / nblk, n = 32 * (r % nblk);
    drow = n;
    if (in) { drow = win_dst_row(n); if (n >= SQI && n < SGU) db = F.WINB; }
    if (up) { const int ch = n < DFF ? n : n - DFF; drow = (ch >> 7) * 256 + (ch & 127) + (n < DFF ? 0 : 128); }
    t.src = W + (size_t)(128 * kb) * Nsrc + n; t.d8 = d8; t.db = db; t.Nsrc = Nsrc; t.ldk = ldk; t.drow0 = drow; t.k0 = 128 * kb; t.scale = sc;
}
__device__ __forceinline__ void tr_load(const TrItem& t, int half, f32x4 (&v)[8], int lane) {
    const float* p = t.src + (size_t)(64 * half + (lane >> 3)) * t.Nsrc + 4 * (lane & 7);
#pragma unroll
    for (int i = 0; i < 8; ++i) v[i] = *(const GAS f32x4*)(p + (size_t)(8 * i) * t.Nsrc);
}
__device__ __forceinline__ void tr_finish(const TrItem& t, int half, const f32x4 (&v)[8], LAS float* scr, int lane) {
#pragma unroll
    for (int i = 0; i < 8; ++i) { LAS float* s = scr + (8 * i + (lane >> 3)) * 33 + 4 * (lane & 7); s[0] = v[i].x; s[1] = v[i].y; s[2] = v[i].z; s[3] = v[i].w; }
    LDS_WAIT(); asm volatile("" ::: "memory");
    const int c = lane & 7, kcol = t.k0 + 64 * half + 8 * c; const float sc = t.scale;
#pragma unroll
    for (int j = 0; j < 4; ++j) { const int n = (lane >> 3) + 8 * j; const LAS float* s = scr + (8 * c) * 33 + n;
        const float e0 = s[0 * 33], e1 = s[1 * 33], e2 = s[2 * 33], e3 = s[3 * 33], e4 = s[4 * 33], e5 = s[5 * 33], e6 = s[6 * 33], e7 = s[7 * 33];
        v2u o; o.x = pk4_fp8(e0 * sc, e1 * sc, e2 * sc, e3 * sc); o.y = pk4_fp8(e4 * sc, e5 * sc, e6 * sc, e7 * sc);
        *(GAS v2u*)(t.d8 + (size_t)(t.drow0 + n) * t.ldk + kcol) = o;
        if (t.db) { v4u ob; ob.x = pk2(e0, e1); ob.y = pk2(e2, e3); ob.z = pk2(e4, e5); ob.w = pk2(e6, e7); *(GAS v4u*)(t.db + (size_t)(t.drow0 + n) * t.ldk + kcol) = ob; } }
    LDS_WAIT(); asm volatile("" ::: "memory");
}
__device__ __forceinline__ void p0_prologue(Frame& F, bool with_gemv = true) {
    LAS float* scr = (LAS float*)(F.lds + RING_OFF + F.wave * 16384);
    constexpr int I_GV = 96 * 64;
    constexpr int NPAIR = (DM / 128) * (IN_W / 32) + (ATTW / 128) * (DM / 32) + (GMW / 128) * (DM / 32) + (DM / 128) * (DM / 32) + (DM / 128) * (F2 / 32) + (DFF / 128) * (DM / 32);
    if (with_gemv) for (int it = F.gw; it < I_GV; it += F.NGW) gemv_item(F, it);
    {
        TrItem A, B; f32x4 a0[8], a1[8], b0[8], b1[8];
        int r = F.gw; bool hasA = r < NPAIR;
        if (hasA) { tr_decode(F, r, A); tr_load(A, 0, a0, F.lane); tr_load(A, 1, a1, F.lane); }
        while (hasA) {
            const int rb = r + F.NGW; const bool hasB = rb < NPAIR;
            if (hasB) { tr_decode(F, rb, B); tr_load(B, 0, b0, F.lane); tr_load(B, 1, b1, F.lane); }
            tr_finish(A, 0, a0, scr, F.lane); tr_finish(A, 1, a1, scr, F.lane);
            if (!hasB) break;
            r = rb + F.NGW; hasA = r < NPAIR;
            if (hasA) { tr_decode(F, r, A); tr_load(A, 0, a0, F.lane); tr_load(A, 1, a1, F.lane); }
            tr_finish(B, 0, b0, scr, F.lane); tr_finish(B, 1, b1, scr, F.lane);
        }
    }
    { const size_t n16 = (size_t)(PNP - IN_W) * DM / 16; GAS v4u* p = (GAS v4u*)((unsigned char*)F.WIN + (size_t)IN_W * DM);
      for (size_t i = (size_t)F.gw * 64 + F.lane; i < n16; i += (size_t)F.NGW * 64) p[i] = (v4u){0u, 0u, 0u, 0u};
      GAS v4u* pb = (GAS v4u*)(F.WINB + (size_t)IN_W * DM);
      for (size_t i = (size_t)F.gw * 64 + F.lane; i < 2 * n16; i += (size_t)F.NGW * 64) pb[i] = (v4u){0u, 0u, 0u, 0u}; }
}

template <int FP8 = 0>
__device__ __forceinline__ void norm_rows(Frame& F, const float* X, const float* gain, int sh_off, int sc_off, void* Ov, unsigned char* O8 = nullptr) {
    for (int m = F.gw; m < M; m += F.NGW) {
        const int b = m >> 11;
        const GAS f32x4* xr = (const GAS f32x4*)(X + (size_t)m * DM) + F.lane;
        f32x4 v[16]; float s = 0.f;
#pragma unroll
        for (int j = 0; j < 16; ++j) { v[j] = xr[64 * j]; s += (v[j].x * v[j].x + v[j].y * v[j].y) + (v[j].z * v[j].z + v[j].w * v[j].w); }
        const float rstd = 1.0f / sqrtf(wave_sum(s) * (1.f / DM) + EPS);
        const GAS f32x4* gp = (const GAS f32x4*)gain + F.lane;
        const GAS f32x4* shp = (const GAS f32x4*)(F.MOD + b * MODW + sh_off) + F.lane;
        const GAS f32x4* scp = (const GAS f32x4*)(F.MOD + b * MODW + sc_off) + F.lane;
        GAS v2u* o8 = (GAS v2u*)((bf16*)Ov + (size_t)m * DM) + F.lane; GAS unsigned* o4 = (GAS unsigned*)((FP8 == 2 ? O8 : (unsigned char*)Ov) + (size_t)m * DM) + F.lane;
#pragma unroll
        for (int j = 0; j < 16; ++j) { const f32x4 g = gp[64 * j], sh = shp[64 * j], sc = scp[64 * j];
            const f32x4 y = (v[j] * rstd) * g * (sc + 1.0f) + sh;
            if constexpr (FP8 != 0) o4[64 * j] = pk4_fp8(y.x * S_H2, y.y * S_H2, y.z * S_H2, y.w * S_H2);
            if constexpr (FP8 != 1) { v2u w; w.x = pk2(y.x, y.y); w.y = pk2(y.z, y.w); o8[64 * j] = w; } }
    }
}

__device__ __forceinline__ unsigned sortable(float f) { const unsigned u = __builtin_bit_cast(unsigned, f); return u ^ ((unsigned)((int)u >> 31) | 0x80000000u); }
__device__ __forceinline__ void select_topk(const unsigned (&sc)[32], GAS v2u* mrow, int lane) {
    unsigned thr = 0u;
    for (int bit = 31; bit >= 0; --bit) {
        const unsigned cand = thr | (1u << bit); int cnt = 0;
#pragma unroll
        for (int jp = 0; jp < 32; ++jp) cnt += __popcll(__ballot(sc[jp] >= cand));
        if (cnt >= TOPK) thr = cand;
    }
    int cgt = 0;
#pragma unroll
    for (int jp = 0; jp < 32; ++jp) cgt += __popcll(__ballot(sc[jp] > thr));
    const int need = TOPK - cgt; int seen = 0;
    unsigned mylo = 0u, myhi = 0u;
    const unsigned long long lt = (lane == 0) ? 0ull : (~0ull >> (64 - lane));
#pragma unroll
    for (int jp = 0; jp < 32; ++jp) {
        unsigned long long sel = __ballot(sc[jp] > thr);
        const unsigned long long eq = __ballot(sc[jp] == thr);
        if (eq) { const bool take = (sc[jp] == thr) && (seen + __popcll(eq & lt) < need); sel |= __ballot(take); seen += __popcll(eq); }
        if (lane == jp) { mylo = (unsigned)sel; myhi = (unsigned)(sel >> 32); }
    }
    if (lane < 32) { v2u w; w.x = mylo; w.y = myhi; mrow[lane] = w; }
}
__device__ __forceinline__ void idx_block(Frame& F, int b, int blk) {
    const int lane = F.lane, w = F.wave, hi = lane >> 5, l31 = lane & 31, tid = F.tid;
    const int t0 = blk * 8, tq = t0 + w;
    const size_t row = (size_t)b * SEQ + tq;
    GAS v2u* mrow = (GAS v2u*)(F.MASK + row * 64);
    if (t0 < TOPK) {
        if (lane < 32) { const int k0 = 64 * lane; v2u mw;
            mw.x = (tq >= k0 + 31) ? 0xffffffffu : (tq < k0 ? 0u : ((2u << (tq - k0)) - 1u));
            mw.y = (tq >= k0 + 63) ? 0xffffffffu : (tq < k0 + 32 ? 0u : ((2u << (tq - k0 - 32)) - 1u));
            mrow[lane] = mw; }
        return;
    }
    const int nt = (t0 + 7) / 64 + 1;
    const bf16* prow = F.PROJ + row * PNP;
    bf16x8 qa[4]; float wv[16];
#pragma unroll
    for (int ks = 0; ks < 4; ++ks) qa[ks] = *(const GAS bf16x8*)(prow + PQI + l31 * 64 + 16 * ks + 8 * hi);
#pragma unroll
    for (int r = 0; r < 16; ++r) wv[r] = bf2f(prow[PWI + (r & 3) + 8 * (r >> 2) + 4 * hi]);
    const bf16* ksrc = F.PROJ + ((size_t)b * SEQ + (tid >> 3)) * PNP + PKI + 8 * (tid & 7);
    const int kdst = (tid >> 3) * 128 + (((tid & 7) ^ ((tid >> 3) & 7)) << 4);
    const int krd = l31 * 128;
    unsigned sc[32];
    __syncthreads();
    v4u stg = *(const GAS v4u*)ksrc;
#pragma unroll
    for (int kt = 0; kt < 32; ++kt) {
        if (kt < nt) {
            LAS unsigned char* kb_base = F.lds + (kt & 1) * 8192;
            *(LAS v4u*)(kb_base + kdst) = stg;
            if (kt + 1 < nt) stg = *(const GAS v4u*)(ksrc + (size_t)(kt + 1) * 64 * PNP);
            LDS_WAIT(); __builtin_amdgcn_s_barrier(); asm volatile("" ::: "memory");
            float s01[2];
#pragma unroll
            for (int h = 0; h < 2; ++h) {
                f32x16 acc;
#pragma unroll
                for (int r = 0; r < 16; ++r) acc[r] = 0.f;
#pragma unroll
                for (int ks = 0; ks < 4; ++ks) { const bf16x8 kf = *(const LAS bf16x8*)(kb_base + h * 4096 + krd + (((2 * ks + hi) ^ (l31 & 7)) << 4));
                    acc = __builtin_amdgcn_mfma_f32_32x32x16_bf16(qa[ks], kf, acc, 0, 0, 0); }
                float x = 0.f;
#pragma unroll
                for (int r = 0; r < 16; ++r) x += wv[r] * fmaxf(acc[r], 0.f);
                x += __shfl_xor(x, 32);
                s01[h] = x;
            }
            const float mine = (lane < 32 ? s01[0] : s01[1]) + 0.0f;
            sc[kt] = (64 * kt + lane <= tq) ? sortable(mine) : 0u;
        } else sc[kt] = 0u;
    }
    select_topk(sc, mrow, lane);
}
constexpr float QSCALE = 0.08838834764831845f * 1.4426950408889634f;
__device__ __forceinline__ void qknorm_row(Frame& F, int row) {
    bf16* prow = F.PROJ + (size_t)row * PNP; const int lane = F.lane;
    {
        GAS v4u* p = (GAS v4u*)(prow + PQ + 32 * lane); v4u w[4]; float ss = 0.f;
#pragma unroll
        for (int i = 0; i < 4; ++i) { w[i] = p[i];
#pragma unroll
            for (int j = 0; j < 4; ++j) { const float a = bflo(w[i][j]), c = bfhi(w[i][j]); ss += a * a + c * c; } }
        ss += __shfl_xor(ss, 1); ss += __shfl_xor(ss, 2);
        const float r = QSCALE / sqrtf(ss * (1.f / HD) + EPS); const float* g = F.qng + 32 * (lane & 3);
#pragma unroll
        for (int i = 0; i < 4; ++i) { v4u o;
#pragma unroll
            for (int j = 0; j < 4; ++j) o[j] = pk2(bflo(w[i][j]) * r * g[8 * i + 2 * j], bfhi(w[i][j]) * r * g[8 * i + 2 * j + 1]);
            p[i] = o; }
    }
    {
        GAS v4u* p = (GAS v4u*)(prow + PK + 8 * lane); const v4u w = *p; float ss = 0.f;
#pragma unroll
        for (int j = 0; j < 4; ++j) { const float a = bflo(w[j]), c = bfhi(w[j]); ss += a * a + c * c; }
        ss += __shfl_xor(ss, 1); ss += __shfl_xor(ss, 2); ss += __shfl_xor(ss, 4); ss += __shfl_xor(ss, 8);
        const float r = 1.0f / sqrtf(ss * (1.f / HD) + EPS); const float* g = F.kng + 8 * (lane & 15); v4u o;
#pragma unroll
        for (int j = 0; j < 4; ++j) o[j] = pk2(bflo(w[j]) * r * g[2 * j], bfhi(w[j]) * r * g[2 * j + 1]);
        *p = o;
    }
    {
        const GAS v4u* p = (const GAS v4u*)(prow + PGV + 32 * lane); float ss = 0.f;
#pragma unroll
        for (int i = 0; i < 4; ++i) { const v4u w = p[i];
#pragma unroll
            for (int j = 0; j < 4; ++j) { const float a = bflo(w[j]), c = bfhi(w[j]); ss += a * a + c * c; } }
        ss = wave_sum(ss);
        if (lane == 0) F.RS[row] = 1.0f / sqrtf(ss * (1.f / GMW) + EPS);
    }
}
__device__ __forceinline__ void vt_item(Frame& F, int item) {
    const int s8 = item & 255, dh = (item >> 8) & 1, g = (item >> 9) & 3, b = item >> 11, d = 64 * dh + F.lane;
    const bf16* src = F.PROJ + (size_t)(b * SEQ + 8 * s8) * PNP + PV + g * HD + d;
    unsigned e[8];
#pragma unroll
    for (int j = 0; j < 8; ++j) e[j] = src[(size_t)j * PNP];
    v4u o; o.x = e[0] | (e[1] << 16); o.y = e[2] | (e[3] << 16); o.z = e[4] | (e[5] << 16); o.w = e[6] | (e[7] << 16);
    *(GAS v4u*)(F.VT + ((size_t)((b * NKV + g) * HD + d)) * SEQ + 8 * s8) = o;
}

constexpr int AT_KSTR = 272, AT_VSTR = 136, AT_TILE = 17408;
#define RAW_BARRIER() do { LDS_WAIT(); __builtin_amdgcn_s_barrier(); asm volatile("" ::: "memory"); } while (0)
__device__ __forceinline__ void attn_block(Frame& F, int b, int g, int qb, float sbound) {
    const int lane = F.lane, w = F.wave, hi = lane >> 5, l31 = lane & 31, tid = F.tid;
    const int hh = 4 * g + (w >> 1), tw0 = qb * 64 + 32 * (w & 1), t = tw0 + l31;
    const size_t row = (size_t)b * SEQ + t;
    const float slope2 = exp2f(-0.5f * (float)(hh + 1)) * 1.4426950408889634f;
    bf16x8 qf[8];
#pragma unroll
    for (int ks = 0; ks < 8; ++ks) qf[ks] = *(const GAS bf16x8*)(F.PROJ + row * PNP + PQ + hh * HD + 16 * ks + 8 * hi);
    f32x16 o[4];
#pragma unroll
    for (int db = 0; db < 4; ++db)
#pragma unroll
        for (int r = 0; r < 16; ++r) o[db][r] = 0.f;
    float m = -1e30f, lsum = 0.f;
    const bf16* ksrc = F.PROJ + ((size_t)b * SEQ + (tid >> 4)) * PNP + PK + g * HD + 8 * (tid & 15);
    const int kdst = (tid >> 4) * AT_KSTR + (tid & 15) * 16;
    const bf16* vsrc = F.VT + ((size_t)((b * NKV + g) * HD + (tid >> 3))) * SEQ + 8 * (tid & 7);
    const int vdst = 2 * AT_TILE + (tid >> 3) * AT_VSTR + (tid & 7) * 16;
    const unsigned* mbase = F.MASK + row * 64;
    LAS unsigned char* L = F.lds;
    v4u sk0, sk1, sv0, sv1; v2u mw, mwn;
#define AT_LOAD(kt_) do { sk0 = *(const GAS v4u*)(ksrc + (size_t)(64 * (kt_)) * PNP); sk1 = *(const GAS v4u*)(ksrc + (size_t)(64 * (kt_) + 32) * PNP); \
        sv0 = *(const GAS v4u*)(vsrc + 64 * (kt_)); sv1 = *(const GAS v4u*)(vsrc + (size_t)64 * SEQ + 64 * (kt_)); mwn = *(const GAS v2u*)(mbase + 2 * (kt_)); } while (0)
#define AT_STORE(bf_) do { *(LAS v4u*)(L + (bf_) * AT_TILE + kdst) = sk0; *(LAS v4u*)(L + (bf_) * AT_TILE + kdst + 32 * AT_KSTR) = sk1; \
        LAS unsigned char* _v = L + (bf_) * AT_TILE + vdst; *(LAS v2u*)_v = (v2u){sv0.x, sv0.y}; *(LAS v2u*)(_v + 8) = (v2u){sv0.z, sv0.w}; \
        *(LAS v2u*)(_v + 64 * AT_VSTR) = (v2u){sv1.x, sv1.y}; *(LAS v2u*)(_v + 64 * AT_VSTR + 8) = (v2u){sv1.z, sv1.w}; } while (0)
    RAW_BARRIER();
    AT_LOAD(qb); AT_STORE(0); mw = mwn;
    int buf = 0; bool dead = false;
    for (int kt = qb; kt >= 0; --kt) {
        if (kt > 0) AT_LOAD(kt - 1);
        RAW_BARRIER();
        if (!dead) {
            const float dmin = (float)(tw0 - (64 * kt + 63));
            dead = __all((sbound - slope2 * dmin) < (m - 40.0f));
        }
        if (!dead) {
            const LAS unsigned char* kb_ = L + buf * AT_TILE + l31 * AT_KSTR + hi * 16;
            const LAS unsigned char* vb_ = L + buf * AT_TILE + 2 * AT_TILE + l31 * AT_VSTR + hi * 8;
            f32x16 p[2];
#pragma unroll
            for (int kb = 0; kb < 2; ++kb) {
#pragma unroll
                for (int r = 0; r < 16; ++r) p[kb][r] = 0.f;
#pragma unroll
                for (int ks = 0; ks < 8; ++ks) { const bf16x8 kf = *(const LAS bf16x8*)(kb_ + kb * 32 * AT_KSTR + ks * 32); p[kb] = __builtin_amdgcn_mfma_f32_32x32x16_bf16(kf, qf[ks], p[kb], 0, 0, 0); }
            }
            const float base = -slope2 * (float)(t - 64 * kt - 4 * hi);
            float rmax = -3e30f;
#pragma unroll
            for (int kb = 0; kb < 2; ++kb) { const unsigned mword = (kb ? mw.y : mw.x) >> (4 * hi);
#pragma unroll
                for (int r = 0; r < 16; ++r) { const int ko = (r & 3) + 8 * (r >> 2);
                    float sv = p[kb][r] + (base + slope2 * (float)(32 * kb + ko));
                    sv = ((mword >> ko) & 1u) ? sv : -2e30f; p[kb][r] = sv; rmax = fmaxf(rmax, sv); } }
            rmax = fmaxf(rmax, __shfl_xor(rmax, 32));
            const float mn = fmaxf(m, rmax), alpha = exp2f(m - mn);
            const bool moved = __any(mn != m);
            m = mn;
            float ps = 0.f;
#pragma unroll
            for (int kb = 0; kb < 2; ++kb)
#pragma unroll
                for (int r = 0; r < 16; ++r) { const float e = exp2f(p[kb][r] - mn); p[kb][r] = e; ps += e; }
            lsum = lsum * alpha + ps;
            if (moved) {
#pragma unroll
                for (int db = 0; db < 4; ++db)
#pragma unroll
                    for (int r = 0; r < 16; ++r) o[db][r] *= alpha;
            }
#pragma unroll
            for (int kb = 0; kb < 2; ++kb)
#pragma unroll
                for (int s2 = 0; s2 < 2; ++s2) {
                    v4u pw; pw.x = pk2(p[kb][8 * s2 + 0], p[kb][8 * s2 + 1]); pw.y = pk2(p[kb][8 * s2 + 2], p[kb][8 * s2 + 3]); pw.z = pk2(p[kb][8 * s2 + 4], p[kb][8 * s2 + 5]); pw.w = pk2(p[kb][8 * s2 + 6], p[kb][8 * s2 + 7]);
                    const bf16x8 pb = __builtin_bit_cast(bf16x8, pw);
#pragma unroll
                    for (int db = 0; db < 4; ++db) { const LAS unsigned char* vp = vb_ + db * 32 * AT_VSTR + kb * 64 + s2 * 32;
                        const v2u v0 = *(const LAS v2u*)vp, v1 = *(const LAS v2u*)(vp + 16);
                        v4u vw; vw.x = v0.x; vw.y = v0.y; vw.z = v1.x; vw.w = v1.y;
                        o[db] = __builtin_amdgcn_mfma_f32_32x32x16_bf16(__builtin_bit_cast(bf16x8, vw), pb, o[db], 0, 0, 0); }
                }
        }
        if (kt > 0) { AT_STORE(buf ^ 1); mw = mwn; }
        buf ^= 1;
    }
#undef AT_LOAD
#undef AT_STORE
    lsum += __shfl_xor(lsum, 32);
    const float inv = S_YA / lsum;
    unsigned char* yrow = (unsigned char*)F.YA + row * ATTW + hh * HD + 4 * hi;
#pragma unroll
    for (int db = 0; db < 4; ++db)
#pragma unroll
        for (int rq = 0; rq < 4; ++rq) *(GAS unsigned*)(yrow + 32 * db + 8 * rq) = pk4_fp8(o[db][4 * rq] * inv, o[db][4 * rq + 1] * inv, o[db][4 * rq + 2] * inv, o[db][4 * rq + 3] * inv);
}
__device__ __forceinline__ float attn_score_bound(Frame& F) {
    float gq = fmaxf(fabsf(F.qng[F.lane]), fabsf(F.qng[F.lane + 64])), gk = fmaxf(fabsf(F.kng[F.lane]), fabsf(F.kng[F.lane + 64]));
#pragma unroll
    for (int o = 1; o < 64; o <<= 1) { gq = fmaxf(gq, __shfl_xor(gq, o)); gk = fmaxf(gk, __shfl_xor(gk, o)); }
    return 1.02f * 128.0f * gq * gk * QSCALE;
}

constexpr int SG_STR = 272, SG_WOFF = 65536;
__device__ __forceinline__ void sgu_unit(Frame& F, int unit) {
    const int ck = unit >> 3, g = unit & 7, r0 = ck * GMC, c0 = g * GMGW, tid = F.tid, lane = F.lane, w = F.wave, hi = lane >> 5, l31 = lane & 31;
    LAS unsigned char* L = F.lds;
    const int rs_ = tid >> 5, q_ = tid & 31;
    __syncthreads();
#pragma unroll
    for (int i = 0; i < 8; ++i) *(LAS v4u*)(L + (rs_ + 16 * i) * 512 + q_ * 16) = *(const GAS v4u*)(F.PROJ + (size_t)(r0 + rs_ + 16 * i) * PNP + PGV + c0 + 8 * q_);
    { const f32x4 q = *(const GAS f32x4*)(F.RS + r0 + 4 * q_);
#pragma unroll
      for (int i = 0; i < 8; ++i) { const int t_ = rs_ + 16 * i; const f32x4 wv = *(const GAS f32x4*)(F.sgw + ((size_t)(g * GMC + t_)) * GMC + 4 * q_);
          const int sb = 4 * q_; v2u o;
          o.x = pk2(sb + 0 <= t_ ? wv.x * q.x : 0.f, sb + 1 <= t_ ? wv.y * q.y : 0.f); o.y = pk2(sb + 2 <= t_ ? wv.z * q.z : 0.f, sb + 3 <= t_ ? wv.w * q.w : 0.f);
          *(LAS v2u*)(L + SG_WOFF + t_ * SG_STR + 8 * q_) = o; } }
    __syncthreads();
    v4u uu[8];
#pragma unroll
    for (int i = 0; i < 8; ++i) uu[i] = *(const GAS v4u*)(F.PROJ + (size_t)(r0 + rs_ + 16 * i) * PNP + PGU + c0 + 8 * q_);
    f32x16 acc[4];
#pragma unroll
    for (int tb = 0; tb < 4; ++tb)
#pragma unroll
        for (int r = 0; r < 16; ++r) acc[tb][r] = 0.f;
    const LAS unsigned char* xb = L + hi * 8 * 512 + 2 * (32 * w + l31);
    const LAS unsigned char* wa = L + SG_WOFF + l31 * SG_STR + hi * 16;
#pragma unroll
    for (int ks = 0; ks < 8; ++ks) {
        v4u xw;
#pragma unroll
        for (int j = 0; j < 4; ++j) { const unsigned lo = *(const LAS unsigned short*)(xb + (16 * ks + 2 * j) * 512), hh = *(const LAS unsigned short*)(xb + (16 * ks + 2 * j + 1) * 512); xw[j] = lo | (hh << 16); }
        const bf16x8 xf = __builtin_bit_cast(bf16x8, xw);
#pragma unroll
        for (int tb = 0; tb < 4; ++tb) if (ks < 2 * (tb + 1)) { const bf16x8 wf = *(const LAS bf16x8*)(wa + tb * 32 * SG_STR + ks * 32); acc[tb] = __builtin_amdgcn_mfma_f32_32x32x16_bf16(wf, xf, acc[tb], 0, 0, 0); } }
    LDS_WAIT(); __builtin_amdgcn_s_barrier(); asm volatile("" ::: "memory");
    { const int cl = 32 * w + l31;
#pragma unroll
      for (int tb = 0; tb < 4; ++tb)
#pragma unroll
          for (int r = 0; r < 16; ++r) { const int t = 32 * tb + (r & 3) + 8 * (r >> 2) + 4 * hi; *(LAS unsigned short*)(L + t * 512 + 2 * cl) = (unsigned short)f2bf(acc[tb][r]); } }
    const f32x4 g0 = *(const GAS f32x4*)(F.sgg + c0 + 8 * q_), g1 = *(const GAS f32x4*)(F.sgg + c0 + 8 * q_ + 4);
    LDS_WAIT(); __builtin_amdgcn_s_barrier(); asm volatile("" ::: "memory");
#pragma unroll
    for (int i = 0; i < 8; ++i) { const v4u fw = *(const LAS v4u*)(L + (rs_ + 16 * i) * 512 + q_ * 16); const float bb = F.sgb[g * GMC + rs_ + 16 * i]; v2u o;
        o.x = pk4_fp8(S_YB * bflo(uu[i].x) * (bflo(fw.x) * g0.x + bb), S_YB * bfhi(uu[i].x) * (bfhi(fw.x) * g0.y + bb), S_YB * bflo(uu[i].y) * (bflo(fw.y) * g0.z + bb), S_YB * bfhi(uu[i].y) * (bfhi(fw.y) * g0.w + bb));
        o.y = pk4_fp8(S_YB * bflo(uu[i].z) * (bflo(fw.z) * g1.x + bb), S_YB * bfhi(uu[i].z) * (bfhi(fw.z) * g1.y + bb), S_YB * bflo(uu[i].w) * (bflo(fw.w) * g1.z + bb), S_YB * bfhi(uu[i].w) * (bfhi(fw.w) * g1.w + bb));
        *(GAS v2u*)((unsigned char*)F.YB + (size_t)(r0 + rs_ + 16 * i) * GMW + c0 + 8 * q_) = o; }
}

using pg8::Unit; using pg8::cvt_pk_bf16;
struct EpiProj {
    static constexpr bool PERM = true; bf16* O; float scale;
    __device__ __forceinline__ void operator()(const f32x4 (&acc)[2][2][4][2], const Unit& u, int wr, int wc, int fr, int fq) const {
        const int act = (u.pn >= PGU / 256 && u.pn < PGA / 256) ? 1 : ((u.pn >= PGA / 256 && u.pn < PKI / 256) ? 2 : 0);
        const int row0 = u.pm * 256 + wr * 64 + fr, col0 = u.pn * 256 + wc * 32 + 8 * fq;
#pragma unroll
        for (int ai = 0; ai < 2; ++ai)
#pragma unroll
            for (int m = 0; m < 4; ++m) { bf16* rowp = O + (size_t)(row0 + ai * 128 + m * 16) * PNP + col0;
#pragma unroll
                for (int bj = 0; bj < 2; ++bj) { f32x4 v0 = acc[ai][bj][m][0] * scale, v1 = acc[ai][bj][m][1] * scale;
                    if (act == 1) { const pg8::f32x2 a = pg8::gelu_pk((pg8::f32x2){v0[0], v0[1]}), b = pg8::gelu_pk((pg8::f32x2){v0[2], v0[3]}), c = pg8::gelu_pk((pg8::f32x2){v1[0], v1[1]}), d = pg8::gelu_pk((pg8::f32x2){v1[2], v1[3]});
                        v0 = (f32x4){a.x, a.y, b.x, b.y}; v1 = (f32x4){c.x, c.y, d.x, d.y}; }
                    else if (act == 2) {
#pragma unroll
                        for (int j = 0; j < 4; ++j) { v0[j] = pg8::sigmoidf_(v0[j]); v1[j] = pg8::sigmoidf_(v1[j]); } }
                    v4u w; w.x = cvt_pk_bf16(v0[0], v0[1]); w.y = cvt_pk_bf16(v0[2], v0[3]); w.z = cvt_pk_bf16(v1[0], v1[1]); w.w = cvt_pk_bf16(v1[2], v1[3]);
                    *(GAS v4u*)(rowp + bj * 128) = w; } }
    }
};
struct EpiGateA {
    static constexpr bool PERM = true; const bf16* P; float* T; float scale;
    __device__ __forceinline__ void operator()(const f32x4 (&acc)[2][2][4][2], const Unit& u, int wr, int wc, int fr, int fq) const {
        const int row0 = u.pm * 256 + wr * 64 + fr, col0 = u.pn * 256 + wc * 32 + 8 * fq;
#pragma unroll
        for (int ai = 0; ai < 2; ++ai)
#pragma unroll
            for (int m = 0; m < 4; ++m) { const size_t r = (size_t)(row0 + ai * 128 + m * 16);
#pragma unroll
                for (int bj = 0; bj < 2; ++bj) { const v4u gw = *(const GAS v4u*)(P + r * PNP + PGA + col0 + bj * 128);
                    f32x4 v0 = acc[ai][bj][m][0], v1 = acc[ai][bj][m][1];
                    v0 = v0 * ((f32x4){bflo(gw.x), bfhi(gw.x), bflo(gw.y), bfhi(gw.y)} * scale); v1 = v1 * ((f32x4){bflo(gw.z), bfhi(gw.z), bflo(gw.w), bfhi(gw.w)} * scale);
                    GAS f32x4* tp = (GAS f32x4*)(T + r * DM + col0 + bj * 128); tp[0] = v0; tp[1] = v1; } }
    }
};
struct EpiGateB {
    static constexpr bool PERM = true; const bf16* P; const float* T; unsigned char* O; float scale;
    __device__ __forceinline__ void operator()(const f32x4 (&acc)[2][2][4][2], const Unit& u, int wr, int wc, int fr, int fq) const {
        const int row0 = u.pm * 256 + wr * 64 + fr, col0 = u.pn * 256 + wc * 32 + 8 * fq;
#pragma unroll
        for (int ai = 0; ai < 2; ++ai)
#pragma unroll
            for (int m = 0; m < 4; ++m) { const size_t r = (size_t)(row0 + ai * 128 + m * 16);
#pragma unroll
                for (int bj = 0; bj < 2; ++bj) { const v4u gw = *(const GAS v4u*)(P + r * PNP + PGB + col0 + bj * 128);
                    const GAS f32x4* tp = (const GAS f32x4*)(T + r * DM + col0 + bj * 128);
                    const f32x4 v0 = (tp[0] + acc[ai][bj][m][0] * ((f32x4){bflo(gw.x), bfhi(gw.x), bflo(gw.y), bfhi(gw.y)} * scale)) * S_MRG;
                    const f32x4 v1 = (tp[1] + acc[ai][bj][m][1] * ((f32x4){bflo(gw.z), bfhi(gw.z), bflo(gw.w), bfhi(gw.w)} * scale)) * S_MRG;
                    v2u w; w.x = pk4_fp8(v0[0], v0[1], v0[2], v0[3]); w.y = pk4_fp8(v1[0], v1[1], v1[2], v1[3]);
                    *(GAS v2u*)(O + r * DM + col0 + bj * 128) = w; } }
    }
};
struct EpiResid {
    static constexpr bool PERM = false; const float* base; const float* gate; float* C; float scale;
    __device__ __forceinline__ void operator()(const f32x4 (&acc)[2][2][4][2], const Unit& u, int wr, int wc, int fr, int fq) const {
        const int row0 = u.pm * 256 + wr * 64 + fr, col0 = u.pn * 256 + wc * 32 + 4 * fq; const float* gp = gate + (u.pm >> 3) * MODW + col0;
        f32x4 gv[2][2];
#pragma unroll
        for (int bj = 0; bj < 2; ++bj)
#pragma unroll
            for (int n = 0; n < 2; ++n) gv[bj][n] = *(const GAS f32x4*)(gp + bj * 128 + n * 16) * scale;
#pragma unroll
        for (int ai = 0; ai < 2; ++ai)
#pragma unroll
            for (int m = 0; m < 4; ++m) { const size_t off = (size_t)(row0 + ai * 128 + m * 16) * DM + col0;
#pragma unroll
                for (int bj = 0; bj < 2; ++bj)
#pragma unroll
                    for (int n = 0; n < 2; ++n) { const f32x4 bs = *(const GAS f32x4*)(base + off + bj * 128 + n * 16);
                        *(GAS f32x4*)(C + off + bj * 128 + n * 16) = bs + gv[bj][n] * acc[ai][bj][m][n]; } }
    }
};
struct EpiPlain {
    static constexpr bool PERM = true; bf16* O; int ldc; float scale;
    __device__ __forceinline__ void operator()(const f32x4 (&acc)[2][2][4][2], const Unit& u, int wr, int wc, int fr, int fq) const {
        const int row0 = u.pm * 256 + wr * 64 + fr, col0 = u.pn * 256 + wc * 32 + 8 * fq;
#pragma unroll
        for (int ai = 0; ai < 2; ++ai)
#pragma unroll
            for (int m = 0; m < 4; ++m) { bf16* rowp = O + (size_t)(row0 + ai * 128 + m * 16) * ldc + col0;
#pragma unroll
                for (int bj = 0; bj < 2; ++bj) { const f32x4 v0 = acc[ai][bj][m][0] * scale, v1 = acc[ai][bj][m][1] * scale;
                    v4u w; w.x = cvt_pk_bf16(v0[0], v0[1]); w.y = cvt_pk_bf16(v0[2], v0[3]); w.z = cvt_pk_bf16(v1[0], v1[1]); w.w = cvt_pk_bf16(v1[2], v1[3]);
                    *(GAS v4u*)(rowp + bj * 128) = w; } }
    }
};

__device__ __forceinline__ void conv_phase(Frame& F) {
    constexpr int C8 = DFF / 8, TB = 16, NTB = M / TB;
    const size_t total = (size_t)C8 * NTB;
    for (size_t idx = (size_t)F.gw * 64 + F.lane; idx < total; idx += (size_t)F.NGW * 64) {
        const int c8 = (int)(idx % C8), tb = (int)(idx / C8), ch = 8 * c8, t0 = tb * TB;
        const int acol = (ch >> 7) * 256 + (ch & 127);
        float wg[3][8], wv[3][8], bg[8], bv[8];
#pragma unroll
        for (int j = 0; j < 3; ++j) { const f32x4 a = *(const GAS f32x4*)(F.cvw + (size_t)j * F2 + ch), b = *(const GAS f32x4*)(F.cvw + (size_t)j * F2 + ch + 4);
            const f32x4 c = *(const GAS f32x4*)(F.cvw + (size_t)j * F2 + DFF + ch), d = *(const GAS f32x4*)(F.cvw + (size_t)j * F2 + DFF + ch + 4);
#pragma unroll
            for (int e = 0; e < 4; ++e) { wg[j][e] = a[e]; wg[j][4 + e] = b[e]; wv[j][e] = c[e]; wv[j][4 + e] = d[e]; } }
        { const f32x4 a = *(const GAS f32x4*)(F.cvb + ch), b = *(const GAS f32x4*)(F.cvb + ch + 4), c = *(const GAS f32x4*)(F.cvb + DFF + ch), d = *(const GAS f32x4*)(F.cvb + DFF + ch + 4);
#pragma unroll
          for (int e = 0; e < 4; ++e) { bg[e] = a[e]; bg[4 + e] = b[e]; bv[e] = c[e]; bv[4 + e] = d[e]; } }
        float g1[8], g2[8], v1[8], v2[8];
        const bool first = (t0 & (SEQ - 1)) == 0;
        const bf16* ap = F.A + (size_t)t0 * F2 + acol;
        if (first) {
#pragma unroll
            for (int e = 0; e < 8; ++e) { g1[e] = g2[e] = v1[e] = v2[e] = 0.f; }
        } else {
            const v4u ga = *(const GAS v4u*)(ap - F2), gb = *(const GAS v4u*)(ap - 2 * (size_t)F2), va = *(const GAS v4u*)(ap - F2 + 128), vb = *(const GAS v4u*)(ap - 2 * (size_t)F2 + 128);
#pragma unroll
            for (int e = 0; e < 4; ++e) { g1[2 * e] = bflo(ga[e]); g1[2 * e + 1] = bfhi(ga[e]); g2[2 * e] = bflo(gb[e]); g2[2 * e + 1] = bfhi(gb[e]);
                v1[2 * e] = bflo(va[e]); v1[2 * e + 1] = bfhi(va[e]); v2[2 * e] = bflo(vb[e]); v2[2 * e + 1] = bfhi(vb[e]); }
        }
#pragma unroll 4
        for (int i = 0; i < TB; ++i) {
            const v4u gw = *(const GAS v4u*)(ap + (size_t)i * F2), vw = *(const GAS v4u*)(ap + (size_t)i * F2 + 128);
            float g0[8], v0[8], y[8];
#pragma unroll
            for (int e = 0; e < 4; ++e) { g0[2 * e] = bflo(gw[e]); g0[2 * e + 1] = bfhi(gw[e]); v0[2 * e] = bflo(vw[e]); v0[2 * e + 1] = bfhi(vw[e]); }
#pragma unroll
            for (int e = 0; e < 8; ++e) { const float gt = bg[e] + wg[0][e] * g2[e] + wg[1][e] * g1[e] + wg[2][e] * g0[e];
                const float vl = bv[e] + wv[0][e] * v2[e] + wv[1][e] * v1[e] + wv[2][e] * v0[e];
                y[e] = gt * pg8::sigmoidf_(gt) * vl; g2[e] = g1[e]; g1[e] = g0[e]; v2[e] = v1[e]; v1[e] = v0[e]; }
            v2u o; o.x = pk4_fp8(y[0] * S_ACT, y[1] * S_ACT, y[2] * S_ACT, y[3] * S_ACT); o.y = pk4_fp8(y[4] * S_ACT, y[5] * S_ACT, y[6] * S_ACT, y[7] * S_ACT);
            *(GAS v2u*)((unsigned char*)F.ACT + (size_t)(t0 + i) * DFF + ch) = o;
        }
    }
}

constexpr int N_PHASES = 12;
struct Args { const float* in[19]; float* out; unsigned char* ws; int ph_lo, ph_hi, li, pad; };
__global__ void __launch_bounds__(NWAVES * 64, 2) mega_fwd(Args args) {
    extern __shared__ __attribute__((aligned(16))) unsigned char lds[];
    Frame F;
    F.lds = (LAS unsigned char*)lds;
    F.MISC = (volatile LAS unsigned*)(F.lds + MISC_OFF);
    F.tid = threadIdx.x; F.lane = F.tid & 63; F.wave = __builtin_amdgcn_readfirstlane(F.tid >> 6);
    F.G = gridDim.x; F.gw = blockIdx.x * NWAVES + F.wave; F.NGW = F.G * NWAVES;
    unsigned char* ws = args.ws;
    F.ctl = (gu32*)(ws + WS_CTL);
    F.x = args.in[0]; F.c = args.in[1]; F.ada_w = args.in[2]; F.ada_b = args.in[3]; F.n1g = args.in[4]; F.w_in = args.in[5]; F.qng = args.in[6]; F.kng = args.in[7];
    F.sgg = args.in[8]; F.sgw = args.in[9]; F.sgb = args.in[10]; F.w_a = args.in[11]; F.w_b = args.in[12]; F.w_out = args.in[13]; F.n2g = args.in[14]; F.w_up = args.in[15];
    F.cvw = args.in[16]; F.cvb = args.in[17]; F.w_dn = args.in[18]; F.out = args.out;
    F.MOD = (float*)(ws + WS_MOD); F.PART = (float*)(ws + WS_TMP);   F.WIN = (bf16*)(ws + WS_WIN); F.WINB = (bf16*)(ws + WS_WINB); F.H8A = ws + WS_X1;   F.WA = (bf16*)(ws + WS_WA); F.WB = (bf16*)(ws + WS_WB); F.WOUT = (bf16*)(ws + WS_WOUT); F.WUP = (bf16*)(ws + WS_WUP); F.WDN = (bf16*)(ws + WS_WDN);
    F.H = (bf16*)(ws + WS_H); F.X1 = (float*)(ws + WS_X1); F.PROJ = (bf16*)(ws + WS_PROJ); F.MASK = (unsigned*)(ws + WS_MASK); F.RS = (float*)(ws + WS_RS); F.SWT = (float*)(ws + WS_SWT);
    F.VT = (bf16*)(ws + WS_VT); F.YA = (bf16*)(ws + WS_YA); F.YB = (bf16*)(ws + WS_YB); F.MRG = (bf16*)(ws + WS_MRG); F.TMP = (float*)(ws + WS_TMP); F.A = (bf16*)(ws + WS_A); F.ACT = (bf16*)(ws + WS_ACT);
    for (int u = F.tid; u < (LDS_BYTES - LDSCTL_OFF) / 4; u += NWAVES * 64) ((LAS unsigned*)(F.lds + LDSCTL_OFF))[u] = 0u;
    __syncthreads();
    XcdBarrier bar; bar.bar = (unsigned*)(F.ctl + CW_BAR); bar.x = 0; bar.st = nullptr;
    if (MK_N_LAUNCHES == 1) bar = xcd_barrier_post((unsigned*)(F.ctl + CW_BAR), F.MISC + 8);
    const int lo = args.ph_lo, hi = args.ph_hi;
#define IN(k) (lo <= (k) && (k) < hi)
#define SEAM(k) do { if (IN(k) && IN((k) + 1)) xcd_barrier(bar); } while (0)

#define REP(k) if ((PROBE_MASK >> (k)) & 1) for (int _rep = 0; _rep < 1; ++_rep)
    if (IN(0)) { p0_prologue(F); REP(0) { xcd_barrier(bar); p0_prologue(F, false); } } SEAM(0);
    if (IN(1)) { mod_reduce(F); } SEAM(1);
    if (IN(2)) { norm_rows<2>(F, F.x, F.n1g, 0, DM, F.H, F.H8A); REP(2) { xcd_barrier(bar); norm_rows<2>(F, F.x, F.n1g, 0, DM, F.H, F.H8A); } } SEAM(2);
    if (IN(3)) {
        { pg8::Gemm g{F.H, F.WINB, M, PNP, DM, DM, DM}; pg8::MixOrder S{0, F.G, (int)blockIdx.x}; EpiProj E{F.PROJ, 1.0f};
          pg8::gemm_phase<EpiProj, pg8::MixOrder, true, 2>(F.lds + RING_OFF, g, S, E); }
        VM_WAIT(); __syncthreads();
        { pg8::Gemm g{(const bf16*)F.H8A, F.WIN, M, PNP, DM, DM, DM}; pg8::MixOrder S{1, F.G, (int)blockIdx.x}; EpiProj E{F.PROJ, 1.0f / (S_H2 * 1024.f)};
          pg8::gemm_phase<EpiProj, pg8::MixOrder, true, 1>(F.lds + RING_OFF, g, S, E); }
    } SEAM(3);
    if (IN(4)) {
        for (int it = blockIdx.x; it < 512; it += F.G) { const int b = it >> 7, j = it & 127; idx_block(F, b, j); idx_block(F, b, 255 - j); }
        for (int row = F.gw; row < M; row += F.NGW) qknorm_row(F, row);
        for (int it = F.gw; it < BATCH * NKV * 2 * 256; it += F.NGW) vt_item(F, it);
        REP(4) { xcd_barrier(bar); for (int it = blockIdx.x; it < 512; it += F.G) { const int b = it >> 7, j = it & 127; idx_block(F, b, j); idx_block(F, b, 255 - j); } }
        REP(13) { xcd_barrier(bar); for (int it = F.gw; it < BATCH * NKV * 2 * 256; it += F.NGW) vt_item(F, it); }
    } SEAM(4);
    if (IN(5)) {
        { const float sb = attn_score_bound(F); for (int p = blockIdx.x; p < 256; p += F.G) { const int bg = p >> 4, j = p & 15; attn_block(F, bg >> 2, bg & 3, j, sb); attn_block(F, bg >> 2, bg & 3, 31 - j, sb); } }
        REP(5) { xcd_barrier(bar); { const float sb = attn_score_bound(F); for (int p = blockIdx.x; p < 256; p += F.G) { const int bg = p >> 4, j = p & 15; attn_block(F, bg >> 2, bg & 3, j, sb); attn_block(F, bg >> 2, bg & 3, 31 - j, sb); } } }
        for (int u = blockIdx.x; u < 512; u += F.G) sgu_unit(F, u);
        __syncthreads();
        REP(14) { xcd_barrier(bar); for (int u = blockIdx.x; u < 512; u += F.G) sgu_unit(F, u); __syncthreads(); }
    } SEAM(5);
    if (IN(6)) {
        { pg8::Gemm g{F.YA, F.WA, M, DM, ATTW, ATTW, ATTW}; pg8::StaticOrder S; S.init(M, DM, F.G, (int)blockIdx.x); EpiGateA E{F.PROJ, F.TMP, 1.0f / (S_YA * S_WA)};
          pg8::gemm_phase<EpiGateA, pg8::StaticOrder, true, 1>(F.lds + RING_OFF, g, S, E); }
        VM_WAIT(); __syncthreads();
        { pg8::Gemm g{F.YB, F.WB, M, DM, GMW, GMW, GMW}; pg8::StaticOrder S; S.init(M, DM, F.G, (int)blockIdx.x); EpiGateB E{F.PROJ, F.TMP, (unsigned char*)F.MRG, 1.0f / (S_YB * S_WB)};
          pg8::gemm_phase<EpiGateB, pg8::StaticOrder, true, 1>(F.lds + RING_OFF, g, S, E); }
        REP(6) { xcd_barrier(bar);
          { pg8::Gemm g{F.YA, F.WA, M, DM, ATTW, ATTW, ATTW}; pg8::StaticOrder S; S.init(M, DM, F.G, (int)blockIdx.x); EpiGateA E{F.PROJ, F.TMP, 1.0f / (S_YA * S_WA)};
            pg8::gemm_phase<EpiGateA, pg8::StaticOrder, true, 1>(F.lds + RING_OFF, g, S, E); }
          VM_WAIT(); __syncthreads();
          { pg8::Gemm g{F.YB, F.WB, M, DM, GMW, GMW, GMW}; pg8::StaticOrder S; S.init(M, DM, F.G, (int)blockIdx.x); EpiGateB E{F.PROJ, F.TMP, (unsigned char*)F.MRG, 1.0f / (S_YB * S_WB)};
            pg8::gemm_phase<EpiGateB, pg8::StaticOrder, true, 1>(F.lds + RING_OFF, g, S, E); } }
    } SEAM(6);
    if (IN(7)) { pg8::Gemm g{F.MRG, F.WOUT, M, DM, DM, DM, DM}; pg8::StaticOrder S; S.init(M, DM, F.G, (int)blockIdx.x); EpiResid E{F.x, F.MOD + 2 * DM, F.X1, 1.0f / (S_MRG * S_WOUT)};
        pg8::gemm_phase<EpiResid, pg8::StaticOrder, true, 1>(F.lds + RING_OFF, g, S, E);
        REP(7) { xcd_barrier(bar); pg8::gemm_phase<EpiResid, pg8::StaticOrder, true, 1>(F.lds + RING_OFF, g, S, E); } } SEAM(7);
    if (IN(8)) { norm_rows<1>(F, F.X1, F.n2g, 3 * DM, 4 * DM, F.H); REP(8) { xcd_barrier(bar); norm_rows<1>(F, F.X1, F.n2g, 3 * DM, 4 * DM, F.H); } } SEAM(8);
    if (IN(9)) { pg8::Gemm g{F.H, F.WUP, M, F2, DM, DM, DM}; pg8::StaticOrder S; S.init(M, F2, F.G, (int)blockIdx.x); EpiPlain E{F.A, F2, 1.0f / (S_H2 * S_WUP)};
        pg8::gemm_phase<EpiPlain, pg8::StaticOrder, true, 1>(F.lds + RING_OFF, g, S, E);
        REP(9) { xcd_barrier(bar); pg8::gemm_phase<EpiPlain, pg8::StaticOrder, true, 1>(F.lds + RING_OFF, g, S, E); } } SEAM(9);
    if (IN(10)) { conv_phase(F); REP(10) { xcd_barrier(bar); conv_phase(F); } } SEAM(10);
    if (IN(11)) { pg8::Gemm g{F.ACT, F.WDN, M, DM, DFF, DFF, DFF}; pg8::StaticOrder S; S.init(M, DM, F.G, (int)blockIdx.x); EpiResid E{F.X1, F.MOD + 5 * DM, F.out, 1.0f / (S_ACT * S_WDN)};
        pg8::gemm_phase<EpiResid, pg8::StaticOrder, true, 1>(F.lds + RING_OFF, g, S, E);
        REP(11) { xcd_barrier(bar); pg8::gemm_phase<EpiResid, pg8::StaticOrder, true, 1>(F.lds + RING_OFF, g, S, E); } }
#undef REP
#undef IN
#undef SEAM
}

extern "C" void kernel_launch(void* const* d_in, const int* in_sizes, int n_in, void* d_out, int out_size, void* d_ws, size_t ws_size, hipStream_t stream) {
    static int grid = 0;
    if (grid == 0) {
        if (n_in != 19 || in_sizes[0] != M * DM || out_size != M * DM || ws_size < WS_END) { fprintf(stderr, "kernel_launch: unexpected shapes (n_in %d, in0 %d, out %d, ws %zu < %zu); nothing launched\n", n_in, n_in > 0 ? in_sizes[0] : -1, out_size, ws_size, (size_t)WS_END); grid = -1; return; }
        int dev = 0, cus = 0, per_cu = 0;
        if (hipGetDevice(&dev) != hipSuccess || hipDeviceGetAttribute(&cus, hipDeviceAttributeMultiprocessorCount, dev) != hipSuccess) { fprintf(stderr, "kernel_launch: device query failed\n"); grid = -1; return; }
        if (hipFuncSetAttribute((const void*)mega_fwd, hipFuncAttributeMaxDynamicSharedMemorySize, LDS_BYTES) != hipSuccess) { fprintf(stderr, "kernel_launch: hipFuncSetAttribute failed\n"); grid = -1; return; }
        if (hipOccupancyMaxActiveBlocksPerMultiprocessor(&per_cu, (const void*)mega_fwd, NWAVES * 64, LDS_BYTES) != hipSuccess || per_cu < 1) { fprintf(stderr, "kernel_launch: occupancy query reports %d blocks per CU\n", per_cu); }
        (void)hipGetLastError();
        grid = cus;
    }
    if (grid < 0) return;
    if (hipMemsetAsync((char*)d_ws + WS_CTL, 0, CTL_ZERO_BYTES, stream) != hipSuccess) { fprintf(stderr, "kernel_launch: memset failed\n"); return; }
    Args a{};
    for (int i = 0; i < 19; ++i) a.in[i] = (const float*)d_in[i];
    a.out = (float*)d_out; a.ws = (unsigned char*)d_ws; a.pad = 0;
    for (int li = 0; li < MK_N_LAUNCHES; ++li) {
        if (MK_N_LAUNCHES == 1) { a.ph_lo = 0; a.ph_hi = N_PHASES; } else { a.ph_lo = li; a.ph_hi = li + 1; }
        a.li = li;
        hipLaunchKernelGGL(mega_fwd, dim3(grid), dim3(NWAVES * 64), LDS_BYTES, stream, a);
        const hipError_t le = hipPeekAtLastError();
        if (le != hipSuccess) { fprintf(stderr, "kernel_launch: launch %d failed: %s\n", li, hipGetErrorName(le)); break; }
    }
}
```

```cpp
#include <hip/hip_runtime.h>
#include <cstdio>
#include <cstdint>

#ifndef MK_N_LAUNCHES
#define MK_N_LAUNCHES 1
#endif
#ifndef PROBE_MASK
#define PROBE_MASK 0x0
#endif

namespace pg8 {
#define PG8_LAS __attribute__((address_space(3)))
typedef unsigned short bf16_t;
typedef short bf16x8 __attribute__((ext_vector_type(8)));
typedef float f32x4 __attribute__((ext_vector_type(4)));
typedef float f32x2 __attribute__((ext_vector_type(2)));
typedef unsigned u32x4 __attribute__((ext_vector_type(4)));
typedef unsigned u32x2 __attribute__((ext_vector_type(2)));
constexpr int BM = 256, BK = 64, HALF = 128, HTB = HALF * BK * 2, STAGE_BYTES = 8 * HTB, NXCD = 8, WGM = 8;

__host__ __device__ __forceinline__ int lds_byte(int r, int c) { const int st = (r >> 4) * 2 + (c >> 5), rr = r & 15, cc = c & 31, ob = rr * 64 + cc * 2; return st * 1024 + (ob ^ (((ob >> 9) & 1) << 5)); }
__host__ __device__ __forceinline__ void stage_rc(int b, int& R, int& C) { const int st = b / 1024, sb = b % 1024, swz = sb ^ (((sb >> 9) & 1) << 5); R = (st >> 1) * 16 + swz / 64; C = (st & 1) * 32 + (swz % 64) / 2; }
__host__ __device__ __forceinline__ int perm32(int rho) { const int n = rho >> 4, i = rho & 15; return 8 * (i >> 2) + 4 * n + (i & 3); }

struct Unit { int pm, pn; };
struct Gemm { const bf16_t* A; const bf16_t* Bt; int M, N, K, lda, ldb; };

struct StaticOrder {
    int nM, nN, nwg, G, c;
    __host__ __device__ void init(int M, int N, int G_, int c_) { nM = M / BM; nN = N / BM; nwg = nM * nN; G = G_; c = c_; }
    __host__ __device__ bool next(int i, Unit& u) const {
        const long L = (long)i * G + c; if (L >= nwg) return false;
        int wgid = (int)L; { const int q = nwg / NXCD, r = nwg % NXCD, xcd = wgid % NXCD, off = wgid / NXCD; wgid = (xcd < r ? xcd * (q + 1) : r * (q + 1) + (xcd - r) * q) + off; }
        const int nig = WGM * nN, gid = wgid / nig, fm = gid * WGM, gsz = (nM - fm) < WGM ? (nM - fm) : WGM;
        u.pm = fm + ((wgid % nig) % gsz); u.pn = (wgid % nig) / gsz; return true;
    }
    __device__ __forceinline__ void a_ready(const Unit&) const {}
    __device__ __forceinline__ void done(const Unit&) const {}
};
struct MixOrder {
    int fp8, G, c;
    __host__ __device__ static void map(int L, int nwg, int nN, Unit& u) {
        int wgid = L; { const int q = nwg / NXCD, r = nwg % NXCD, xcd = wgid % NXCD, off = wgid / NXCD; wgid = (xcd < r ? xcd * (q + 1) : r * (q + 1) + (xcd - r) * q) + off; }
        const int nig = WGM * nN; u.pm = (wgid / nig) * WGM + ((wgid % nig) % WGM); u.pn = (wgid % nig) / WGM;
    }
    __host__ __device__ bool next(int i, Unit& u) const {
        int L;
        if (!fp8) { L = i * G + c; if (L >= 288) return false; map(L, 288, 9, u); u.pn = u.pn < 8 ? 12 + u.pn : 68; return true; }
        if (G == 256) { if (c >= 32) { if (i >= 8) return false; L = i * 224 + (c - 32); } else { if (i >= 4) return false; L = 1792 + 4 * c + i; } }
        else { L = i * G + c; if (L >= 1920) return false; }
        map(L, 1920, 60, u); u.pn = u.pn < 12 ? u.pn : u.pn + 8; return true;
    }
    __device__ __forceinline__ void a_ready(const Unit&) const {}
    __device__ __forceinline__ void done(const Unit&) const {}
};

__device__ __forceinline__ unsigned cvt_pk_bf16(float lo, float hi) { unsigned r; asm volatile("v_cvt_pk_bf16_f32 %0, %1, %2" : "=v"(r) : "v"(lo), "v"(hi)); return r; }
__device__ __forceinline__ f32x2 gelu_pk(f32x2 v) {
    const f32x2 av = __builtin_elementwise_abs(v), d = av * 0.2316418882f + 1.0f;
    f32x2 t; t.x = __builtin_amdgcn_rcpf(d.x); t.y = __builtin_amdgcn_rcpf(d.y);
    f32x2 q = t * 0.5307027145f + (-0.7265760135f); q = q * t + 0.7107068705f; q = q * t + (-0.142248368f); q = q * t + 0.127414796f; q = q * t;
    const f32x2 s = (v * v) * (-0.72134752044f);
    f32x2 e; e.x = __builtin_amdgcn_exp2f(s.x); e.y = __builtin_amdgcn_exp2f(s.y);
    const f32x2 m = v * (q * e), r = v - m;
    f32x2 o; o.x = v.x < 0.f ? m.x : r.x; o.y = v.y < 0.f ? m.y : r.y; return o;
}
__device__ __forceinline__ float sigmoidf_(float x) { return __builtin_amdgcn_rcpf(1.0f + __builtin_amdgcn_exp2f(-1.4426950408889634f * x)); }
__device__ __forceinline__ float bflo(unsigned w) { return __builtin_bit_cast(float, w << 16); }
__device__ __forceinline__ float bfhi(unsigned w) { return __builtin_bit_cast(float, w & 0xffff0000u); }

typedef int i32x8 __attribute__((ext_vector_type(8)));
typedef int i32x4 __attribute__((ext_vector_type(4)));
template <class Epi, class Sched, bool ALIGN_EPI, int ES = 2>
__device__ __forceinline__ void gemm_phase(PG8_LAS unsigned char* lds, const Gemm g, const Sched& S, const Epi& E) {
    const int tid = threadIdx.x, wid = __builtin_amdgcn_readfirstlane(tid >> 6), lane = tid & 63, wr = wid >> 2, wc = wid & 3, fr = lane & 15, fq = lane >> 4;
    const int K = g.K, nt = K * ES / (BK * 2);
    unsigned voffA[2], voffB[2];
#pragma unroll
    for (int i = 0; i < 2; ++i) { int R, C; stage_rc(tid * 16 + i * 8192, R, C); const int Rb = Epi::PERM ? ((R & ~31) + perm32(R & 31)) : R;
        voffA[i] = (unsigned)(R * g.lda) * (unsigned)ES + (unsigned)C * 2u; voffB[i] = (unsigned)(Rb * g.ldb) * (unsigned)ES + (unsigned)C * 2u; }
    const size_t kstep = (size_t)(BK * 2);
    const size_t hstepA = (size_t)HALF * g.lda * ES, hstepB = (size_t)HALF * g.ldb * ES;
    const size_t tstepA = 2 * hstepA, tstepB = 2 * hstepB;
    const unsigned ldsw = (unsigned)wid * 1024u;
    const int aoff = lds_byte(wr * 64 + fr, fq * 8), boff = lds_byte(wc * 32 + fr, fq * 8);
#define PG8_SA(b, h) (((b) * 2 + (h)) * HTB)
#define PG8_SB(b, h) ((4 + (b) * 2 + (h)) * HTB)
#define PG8_STAGE(bufoff, gbase, voff) do { _Pragma("unroll") for (int _i = 0; _i < 2; ++_i) \
        __builtin_amdgcn_global_load_lds((const unsigned*)((const char*)(gbase) + (voff)[_i]), (PG8_LAS unsigned*)(lds + (bufoff) + ldsw + _i * 8192), 16, 0, 0); } while (0)
#define PG8_CAT(x, y) __builtin_shufflevector(x, y, 0, 1, 2, 3, 4, 5, 6, 7)
#define PG8_LO(v) __builtin_bit_cast(bf16x8, __builtin_shufflevector(v, v, 0, 1, 2, 3))
#define PG8_HI(v) __builtin_bit_cast(bf16x8, __builtin_shufflevector(v, v, 4, 5, 6, 7))
#define PG8_LDA(dst, b, h) do { _Pragma("unroll") for (int m = 0; m < 4; ++m) { const i32x4 _l = *(const PG8_LAS i32x4*)(lds + PG8_SA(b, h) + aoff + m * 2048), _h = *(const PG8_LAS i32x4*)(lds + PG8_SA(b, h) + aoff + m * 2048 + 1024); dst[m] = PG8_CAT(_l, _h); } } while (0)
#define PG8_LDB(dst, b, h) do { _Pragma("unroll") for (int n = 0; n < 2; ++n) { const i32x4 _l = *(const PG8_LAS i32x4*)(lds + PG8_SB(b, h) + boff + n * 2048), _h = *(const PG8_LAS i32x4*)(lds + PG8_SB(b, h) + boff + n * 2048 + 1024); dst[n] = PG8_CAT(_l, _h); } } while (0)
#define PG8_MMA(ai, bj, At, Bt) do { __builtin_amdgcn_s_setprio(1); _Pragma("unroll") for (int m = 0; m < 4; ++m) _Pragma("unroll") for (int n = 0; n < 2; ++n) { \
        if constexpr (ES == 2) { acc[ai][bj][m][n] = __builtin_amdgcn_mfma_f32_16x16x32_bf16(PG8_LO(Bt[n]), PG8_LO(At[m]), acc[ai][bj][m][n], 0, 0, 0); \
                                 acc[ai][bj][m][n] = __builtin_amdgcn_mfma_f32_16x16x32_bf16(PG8_HI(Bt[n]), PG8_HI(At[m]), acc[ai][bj][m][n], 0, 0, 0); } \
        else asm volatile("v_mfma_f32_16x16x128_f8f6f4 %0, %1, %2, %0" : "+v"(acc[ai][bj][m][n]) : "v"(Bt[n]), "v"(At[m])); } __builtin_amdgcn_s_setprio(0); } while (0)
#define PG8_WAIT_V(n) asm volatile("s_waitcnt vmcnt(" #n ")" ::: "memory")
#define PG8_WAIT_L(n) asm volatile("s_waitcnt lgkmcnt(" #n ")" ::: "memory")
#define PG8_BAR __builtin_amdgcn_s_barrier()
#define PG8_SCHED __builtin_amdgcn_sched_barrier(0)
    Unit cur, nxt; int ui = 0;
    if (!S.next(0, cur)) return;
    f32x4 acc[2][2][4][2];
#pragma unroll
    for (int a = 0; a < 2; ++a)
#pragma unroll
        for (int b = 0; b < 2; ++b)
#pragma unroll
            for (int m = 0; m < 4; ++m)
#pragma unroll
                for (int n = 0; n < 2; ++n) acc[a][b][m][n] = (f32x4){0.f, 0.f, 0.f, 0.f};
    i32x8 At[4], B0[2], B1[2];
    const char* cA = (const char*)g.A + (size_t)cur.pm * tstepA; const char* cB = (const char*)g.Bt + (size_t)cur.pn * tstepB;
    S.a_ready(cur);
    PG8_STAGE(PG8_SB(0, 0), cB, voffB); PG8_STAGE(PG8_SB(0, 1), cB + hstepB, voffB); PG8_STAGE(PG8_SA(0, 0), cA, voffA); PG8_STAGE(PG8_SA(0, 1), cA + hstepA, voffA);
    if (wr == 1) PG8_BAR;
    PG8_WAIT_V(2); PG8_BAR;
    PG8_STAGE(PG8_SB(1, 0), cB + kstep, voffB); PG8_STAGE(PG8_SA(1, 0), cA + kstep, voffA); PG8_STAGE(PG8_SB(1, 1), cB + hstepB + kstep, voffB);
    PG8_WAIT_V(6); PG8_BAR;
    for (;;) {
        const bool has_next = S.next(ui + 1, nxt);
        const char* nA = has_next ? (const char*)g.A + (size_t)nxt.pm * tstepA : cA; const char* nB = has_next ? (const char*)g.Bt + (size_t)nxt.pn * tstepB : cB;
        for (int t = 0; t < nt; t += 2) {
            const bool last = (t == nt - 2);
            const char* a1 = cA + (size_t)(t + 1) * kstep;
            const char* a2 = last ? nA : cA + (size_t)(t + 2) * kstep; const char* b2 = last ? nB : cB + (size_t)(t + 2) * kstep;
            const char* a3 = a2 + kstep; const char* b3 = b2 + kstep;
            if (last && has_next) S.a_ready(nxt);
            if constexpr (Epi::MIDK) { if (t == nt / 2) { if constexpr (ES == 1) asm volatile("s_nop 15\n\ts_nop 15" ::: "memory"); E.mid(acc, cur, wr, wc, fr, fq); } }
            PG8_LDB(B0, 0, 0); PG8_LDB(B1, 0, 1); PG8_SCHED; PG8_LDA(At, 0, 0); PG8_STAGE(PG8_SA(1, 1), a1 + hstepA, voffA);
            PG8_WAIT_V(8); PG8_WAIT_L(0); PG8_BAR; PG8_MMA(0, 0, At, B0); PG8_MMA(0, 1, At, B1); PG8_BAR; PG8_SCHED;
            PG8_LDA(At, 0, 1); PG8_STAGE(PG8_SB(0, 0), b2, voffB); PG8_STAGE(PG8_SB(0, 1), b2 + hstepB, voffB); PG8_STAGE(PG8_SA(0, 0), a2, voffA);
            PG8_WAIT_V(8); PG8_WAIT_L(0); PG8_BAR; PG8_MMA(1, 0, At, B0); PG8_MMA(1, 1, At, B1); PG8_BAR; PG8_SCHED;
            PG8_LDB(B0, 1, 0); PG8_LDB(B1, 1, 1); PG8_SCHED; PG8_LDA(At, 1, 0); PG8_STAGE(PG8_SA(0, 1), a2 + hstepA, voffA);
            PG8_WAIT_V(8); PG8_WAIT_L(0); PG8_BAR; PG8_MMA(0, 0, At, B0); PG8_MMA(0, 1, At, B1); PG8_BAR; PG8_SCHED;
            PG8_LDA(At, 1, 1); PG8_STAGE(PG8_SB(1, 0), b3, voffB); PG8_STAGE(PG8_SB(1, 1), b3 + hstepB, voffB); PG8_STAGE(PG8_SA(1, 0), a3, voffA);
            PG8_WAIT_V(8); PG8_WAIT_L(0); PG8_BAR; PG8_MMA(1, 0, At, B0); PG8_MMA(1, 1, At, B1); PG8_BAR; PG8_SCHED;
        }
        if constexpr (ALIGN_EPI) { if (wr == 0) PG8_BAR; }
        if constexpr (ES == 1) asm volatile("s_nop 15\n\ts_nop 15" ::: "memory");
        E(acc, cur, wr, wc, fr, fq); S.done(cur);
        if (!has_next) break;
#pragma unroll
        for (int a = 0; a < 2; ++a)
#pragma unroll
            for (int b = 0; b < 2; ++b)
#pragma unroll
                for (int m = 0; m < 4; ++m)
#pragma unroll
                    for (int n = 0; n < 2; ++n) acc[a][b][m][n] = (f32x4){0.f, 0.f, 0.f, 0.f};
        cur = nxt; cA = nA; cB = nB; ++ui;
        if constexpr (ALIGN_EPI) { if (wr == 1) PG8_BAR; }
    }
    PG8_WAIT_V(0);
    if constexpr (!ALIGN_EPI) { if (wr == 0) PG8_BAR; }
    PG8_BAR;
#undef PG8_SA
#undef PG8_SB
#undef PG8_STAGE
#undef PG8_LDA
#undef PG8_CAT
#undef PG8_LO
#undef PG8_HI
#undef PG8_LDB
#undef PG8_MMA
#undef PG8_WAIT_V
#undef PG8_WAIT_L
#undef PG8_BAR
#undef PG8_SCHED
}
}

constexpr int NWAVES = 8;
constexpr int BATCH = 4, SEQ = 2048, DM = 4096, M = BATCH * SEQ;
constexpr int NH = 16, HD = 128, NKV = 4, ATTW = 2048, KVW = 512, IH = 32, IDIM = 64, TOPK = 256;
constexpr int GMW = 2048, GMG = 8, GMGW = 256, GMC = 128, DFF = 11008, F2 = 2 * DFF;
constexpr int IN_W = 17504, MODW = 6 * DM;
constexpr float EPS = 1e-6f;
constexpr int PQ = 0, PK = 2048, PV = 2560, PQI = 3072, PGU = 5120, PGV = 7168, PGA = 9216, PGB = 13312, PKI = 17408, PWI = 17472, PNP = 17664;
constexpr int SQ = 0, SK = 2048, SV = 2560, SQI = 3072, SKI = 5120, SWI = 5184, SGU = 5216, SGV = 7264, SGA = 9312, SGB = 13408;

constexpr size_t MiB = 1u << 20;
constexpr size_t WS_CTL = 0, CTL_ZERO_BYTES = 2 * MiB;
constexpr size_t WS_MOD = 1 * MiB;
constexpr size_t WS_WIN = 2 * MiB;
constexpr size_t WS_WA = 140 * MiB, WS_WB = 156 * MiB;
constexpr size_t WS_WOUT = 172 * MiB;
constexpr size_t WS_WUP = 204 * MiB;
constexpr size_t WS_WDN = 376 * MiB;
constexpr size_t WS_H = 462 * MiB;
constexpr size_t WS_X1 = 526 * MiB;
constexpr size_t WS_PROJ = 654 * MiB;
constexpr size_t WS_MASK = 930 * MiB;
constexpr size_t WS_RS = 932 * MiB;
constexpr size_t WS_SWT = 932 * MiB + 65536;
constexpr size_t WS_VT = 933 * MiB;
constexpr size_t WS_YA = 941 * MiB, WS_YB = 973 * MiB;
constexpr size_t WS_MRG = 1005 * MiB;
constexpr size_t WS_TMP = 1069 * MiB;
constexpr size_t WS_A = 654 * MiB;
constexpr size_t WS_ACT = 998 * MiB;
constexpr size_t WS_WINB = 1197 * MiB;
constexpr size_t WS_END = 1336 * MiB;
static_assert(WS_WIN + (size_t)PNP * DM * 2 <= WS_WA && WS_WUP + (size_t)F2 * DM * 2 <= WS_WDN && WS_WDN + (size_t)DM * DFF * 2 <= WS_H, "ws map 1");
static_assert(WS_PROJ + (size_t)M * PNP * 2 <= WS_MASK && WS_A + (size_t)M * F2 * 2 <= WS_ACT && WS_ACT + (size_t)M * DFF * 2 <= WS_END && WS_TMP + (size_t)M * DM * 4 <= WS_END, "ws map 2");
constexpr int CW_TMO = 0, CW_CODE = 1, CW_BAR = 4096;

constexpr int RING_OFF = 0, RING_BYTES = 131072;
constexpr int LDSCTL_OFF = RING_BYTES + 8192, MISC_OFF = LDSCTL_OFF + 320;
constexpr int LDS_BYTES = 147456;
static_assert(MISC_OFF + 128 <= LDS_BYTES, "LDS map");

#define GAS __attribute__((address_space(1)))
#define LAS __attribute__((address_space(3)))
typedef unsigned short bf16;
typedef unsigned v4u __attribute__((ext_vector_type(4)));
typedef unsigned v2u __attribute__((ext_vector_type(2)));
typedef float f32x4 __attribute__((ext_vector_type(4)));
typedef float f32x16 __attribute__((ext_vector_type(16)));
typedef short bf16x8 __attribute__((ext_vector_type(8)));
typedef short bf16x4 __attribute__((ext_vector_type(4)));
typedef GAS unsigned gu32;
#define RLX_AGENT __ATOMIC_RELAXED, __HIP_MEMORY_SCOPE_AGENT
#define LDS_WAIT() asm volatile("s_waitcnt lgkmcnt(0)" ::: "memory")
#define VM_WAIT() asm volatile("s_waitcnt vmcnt(0)" ::: "memory")
__device__ __forceinline__ unsigned f2bf(float f) { unsigned u = __builtin_bit_cast(unsigned, f); return (u + 0x7fffu + ((u >> 16) & 1u)) >> 16; }
__device__ __forceinline__ unsigned pk2(float lo, float hi) { return pg8::cvt_pk_bf16(lo, hi); }
__device__ __forceinline__ float bf2f(bf16 h) { return __builtin_bit_cast(float, (unsigned)h << 16); }
using pg8::bflo; using pg8::bfhi;
constexpr float S_H2 = 16.f, S_WUP = 1024.f, S_ACT = 4.f, S_WDN = 1024.f, S_YA = 16.f, S_YB = 8.f, S_MRG = 16.f, S_WA = 1024.f, S_WB = 1024.f, S_WOUT = 1024.f;
__device__ __forceinline__ float clamp448(float x) { return __builtin_amdgcn_fmed3f(x, -448.f, 448.f); }
__device__ __forceinline__ unsigned pk4_fp8(float a, float b, float c, float d) {
    int w = __builtin_amdgcn_cvt_pk_fp8_f32(clamp448(a), clamp448(b), 0, false);
    w = __builtin_amdgcn_cvt_pk_fp8_f32(clamp448(c), clamp448(d), w, true);
    return (unsigned)w;
}

#define XB_TMO      128
#define XB_XCNT(j)  (256  + 64 * (j))
#define XB_XSUB(j)  (1280 + 64 * (j))
#define XB_XGEN(j)  (2304 + 64 * (j))
#define XB_TOP      3328
#define XB_TOPGEN   3392
#define XCD_BAR_WORDS 3456
#define XB_SPIN_CAP (1u << 18)
__device__ __forceinline__ unsigned xb_ld(unsigned* p)              { return __hip_atomic_load(p, __ATOMIC_RELAXED, __HIP_MEMORY_SCOPE_AGENT); }
__device__ __forceinline__ unsigned xb_add(unsigned* p, unsigned v) { return __hip_atomic_fetch_add(p, v, __ATOMIC_RELAXED, __HIP_MEMORY_SCOPE_AGENT); }
__device__ __forceinline__ unsigned xb_xcc_id() { return (unsigned)__builtin_amdgcn_s_getreg((3 << 11) | 20) & 0xFu; }
#define XB_SPIN(cond, bar) do { unsigned _sp = 0; while (cond) { __builtin_amdgcn_s_sleep(1); \
    if ((++_sp & 255u) == 0u) { if (xb_ld(&(bar)[XB_TMO])) break; if (_sp > XB_SPIN_CAP) { atomicAdd(&(bar)[XB_TMO], 1u); break; } } } } while (0)
struct XcdBarrier { unsigned* bar; unsigned x; volatile LAS unsigned* st; };
__device__ __forceinline__ XcdBarrier xcd_barrier_post(unsigned* bar, volatile LAS unsigned* st) {
    XcdBarrier b; b.bar = bar; b.x = xb_xcc_id(); b.st = st;
    if (threadIdx.x == 0) (void)xb_add(&bar[XB_XCNT(b.x)], 1u);
    return b;
}
__device__ __forceinline__ void xcd_barrier_complete(unsigned* bar, unsigned x, unsigned& nloc, unsigned& nx) {
    const unsigned G = gridDim.x * gridDim.y * gridDim.z;
    unsigned sum, cnt, mine, sp = 0u;
    for (;;) {
        sum = 0u; cnt = 0u; mine = 0u;
#pragma unroll
        for (unsigned j = 0; j < 16; ++j) { const unsigned c = xb_ld(&bar[XB_XCNT(j)]); sum += c; cnt += (c > 0u) ? 1u : 0u; mine = (j == x) ? c : mine; }
        if (sum == G) break;
        __builtin_amdgcn_s_sleep(1);
        if ((++sp & 255u) == 0u) { if (xb_ld(&bar[XB_TMO])) break; if (sp > XB_SPIN_CAP) { atomicAdd(&bar[XB_TMO], 1u); break; } }
    }
    nloc = mine > 0u ? mine : 1u; nx = cnt > 0u ? cnt : 1u;
}
__device__ __forceinline__ void xcd_barrier(const XcdBarrier& b) {
    asm volatile("s_waitcnt vmcnt(0)" ::: "memory");
    __syncthreads();
    if (threadIdx.x == 0) {
        unsigned* bar = b.bar;
        __builtin_amdgcn_s_waitcnt(0);
        unsigned nloc = b.st[0], nx = b.st[1];
        if (nloc == 0u) { xcd_barrier_complete(bar, b.x, nloc, nx); b.st[0] = nloc; b.st[1] = nx; }
        const unsigned old = xb_add(&bar[XB_XSUB(b.x)], 1u);
        const unsigned gen = old / nloc;
        if (old + 1u == (gen + 1u) * nloc) {
            __builtin_amdgcn_fence(__ATOMIC_RELEASE, "agent");
            asm volatile("s_waitcnt vmcnt(0)" ::: "memory");
            const unsigned og = xb_add(&bar[XB_TOP], 1u);
            const unsigned tg = og / nx;
            if (og + 1u == (tg + 1u) * nx) xb_add(&bar[XB_TOPGEN], 1u);
            else XB_SPIN(xb_ld(&bar[XB_TOPGEN]) == tg, bar);
            __builtin_amdgcn_fence(__ATOMIC_ACQUIRE, "agent");
            xb_add(&bar[XB_XGEN(b.x)], 1u);
            asm volatile("s_waitcnt vmcnt(0)" ::: "memory");
        } else {
            XB_SPIN(xb_ld(&bar[XB_XGEN(b.x)]) == gen, bar);
            __builtin_amdgcn_fence(__ATOMIC_ACQUIRE, "agent");
            asm volatile("s_waitcnt vmcnt(0)" ::: "memory");
        }
    }
    __syncthreads();
}

struct Frame {
    LAS unsigned char* lds;
    volatile LAS unsigned* MISC;
    gu32* ctl;
    int tid, lane, wave, G, gw, NGW;
    const float *x, *c, *ada_w, *ada_b, *n1g, *w_in, *qng, *kng, *sgg, *sgw, *sgb, *w_a, *w_b, *w_out, *n2g, *w_up, *cvw, *cvb, *w_dn;
    float* out;
    float *MOD, *PART; bf16 *WINB; unsigned char* H8A; bf16 *WIN, *WA, *WB, *WOUT, *WUP, *WDN, *H, *PROJ, *VT, *YA, *YB, *MRG, *A, *ACT; float *X1, *TMP, *RS, *SWT; unsigned* MASK;
};
__device__ __forceinline__ float wave_sum(float v) {
#pragma unroll
    for (int o = 1; o < 64; o <<= 1) v += __shfl_xor(v, o);
    return v;
}

__device__ __forceinline__ int win_dst_row(int n) {
    if (n < SKI) return n;
    if (n < SWI) return PKI + (n - SKI);
    if (n < SGU) return PWI + (n - SWI);
    return PGU + (n - SGU);
}
__device__ __forceinline__ void gemv_item(Frame& F, int item) {
    const int nb = item % 96, ks = item / 96, n0 = nb * 256 + 4 * F.lane, k0 = ks * 64;
    float cs[4];
#pragma unroll
    for (int b = 0; b < 4; ++b) { const float cv = F.c[b * DM + k0 + F.lane]; cs[b] = cv * pg8::sigmoidf_(cv); }
    f32x4 acc[4];
#pragma unroll
    for (int b = 0; b < 4; ++b) acc[b] = (f32x4){0.f, 0.f, 0.f, 0.f};
    const float* wp = F.ada_w + (size_t)k0 * MODW + n0;
#pragma unroll 16
    for (int k = 0; k < 64; ++k) { const f32x4 w = *(const GAS f32x4*)(wp + (size_t)k * MODW);
#pragma unroll
        for (int b = 0; b < 4; ++b) { const float s = __builtin_bit_cast(float, __builtin_amdgcn_readlane(__builtin_bit_cast(int, cs[b]), k)); acc[b] += w * s; } }
#pragma unroll
    for (int b = 0; b < 4; ++b) *(GAS f32x4*)(F.PART + (size_t)(ks * 4 + b) * MODW + n0) = acc[b];
}
__device__ __forceinline__ void mod_reduce(Frame& F) {
    for (int i = F.gw * 64 + F.lane; i < 4 * (MODW / 4); i += F.NGW * 64) { const int b = i / (MODW / 4), n0 = 4 * (i % (MODW / 4));
        f32x4 a = *(const GAS f32x4*)(F.ada_b + n0);
#pragma unroll 16
        for (int ks = 0; ks < 64; ++ks) a += *(const GAS f32x4*)(F.PART + (size_t)(ks * 4 + b) * MODW + n0);
        *(GAS f32x4*)(F.MOD + b * MODW + n0) = a; }
}
struct TrItem { const float* src; unsigned char* d8; bf16* db; int Nsrc, ldk, drow0, k0; float scale; };
__device__ __forceinline__ void tr_decode(Frame& F, int r, TrItem& t) {
    constexpr int P_IN = (DM / 128) * (IN_W / 32), P_A = (ATTW / 128) * (DM / 32), P_B = (GMW / 128) * (DM / 32), P_O = (DM / 128) * (DM / 32), P_UP = (DM / 128) * (F2 / 32);
    const float* W; int Nsrc, nblk, ldk, drow; unsigned char* d8; bf16* db = nullptr; float sc; bool up = false, in = false;
    if (r < P_IN) { W = F.w_in; Nsrc = IN_W; nblk = IN_W / 32; d8 = (unsigned char*)F.WIN; ldk = DM; sc = 1024.f; in = true; }
    else if ((r -= P_IN) < P_A) { W = F.w_a; Nsrc = DM; nblk = DM / 32; d8 = (unsigned char*)F.WA; ldk = 2 * ATTW; sc = S_WA; }
    else if ((r -= P_A) < P_B) { W = F.w_b; Nsrc = DM; nblk = DM / 32; d8 = (unsigned char*)F.WA + ATTW; ldk = 2 * ATTW; sc = S_WB; }
    else if ((r -= P_B) < P_O) { W = F.w_out; Nsrc = DM; nblk = DM / 32; d8 = (unsigned char*)F.WOUT; ldk = DM; sc = S_WOUT; }
    else if ((r -= P_O) < P_UP) { W = F.w_up; Nsrc = F2; nblk = F2 / 32; d8 = (unsigned char*)F.WUP; ldk = DM; sc = S_WUP; up = true; }
    else { r -= P_UP; W = F.w_dn; Nsrc = DM; nblk = DM / 32; d8 = (unsigned char*)F.WDN; ldk = DFF; sc = S_WDN; }
    const int kb = r / nblk, n = 32 * (r % nblk);
    drow = n;
    if (in) { drow = win_dst_row(n); if (n >= SQI && n < SGU) db = F.WINB; }
    if (up) { const int ch = n < DFF ? n : n - DFF; drow = (ch >> 7) * 256 + (ch & 127) + (n < DFF ? 0 : 128); }
    t.src = W + (size_t)(128 * kb) * Nsrc + n; t.d8 = d8; t.db = db; t.Nsrc = Nsrc; t.ldk = ldk; t.drow0 = drow; t.k0 = 128 * kb; t.scale = sc;
}
__device__ __forceinline__ void tr_load(const TrItem& t, int half, f32x4 (&v)[8], int lane) {
    const float* p = t.src + (size_t)(64 * half + (lane >> 3)) * t.Nsrc + 4 * (lane & 7);
#pragma unroll
    for (int i = 0; i < 8; ++i) v[i] = *(const GAS f32x4*)(p + (size_t)(8 * i) * t.Nsrc);
}
__device__ __forceinline__ void tr_finish(const TrItem& t, int half, const f32x4 (&v)[8], LAS float* scr, int lane) {
#pragma unroll
    for (int i = 0; i < 8; ++i) { LAS float* s = scr + (8 * i + (lane >> 3)) * 33 + 4 * (lane & 7); s[0] = v[i].x; s[1] = v[i].y; s[2] = v[i].z; s[3] = v[i].w; }
    LDS_WAIT(); asm volatile("" ::: "memory");
    const int c = lane & 7, kcol = t.k0 + 64 * half + 8 * c; const float sc = t.scale;
#pragma unroll
    for (int j = 0; j < 4; ++j) { const int n = (lane >> 3) + 8 * j; const LAS float* s = scr + (8 * c) * 33 + n;
        const float e0 = s[0 * 33], e1 = s[1 * 33], e2 = s[2 * 33], e3 = s[3 * 33], e4 = s[4 * 33], e5 = s[5 * 33], e6 = s[6 * 33], e7 = s[7 * 33];
        v2u o; o.x = pk4_fp8(e0 * sc, e1 * sc, e2 * sc, e3 * sc); o.y = pk4_fp8(e4 * sc, e5 * sc, e6 * sc, e7 * sc);
        *(GAS v2u*)(t.d8 + (size_t)(t.drow0 + n) * t.ldk + kcol) = o;
        if (t.db) { v4u ob; ob.x = pk2(e0, e1); ob.y = pk2(e2, e3); ob.z = pk2(e4, e5); ob.w = pk2(e6, e7); *(GAS v4u*)(t.db + (size_t)(t.drow0 + n) * t.ldk + kcol) = ob; } }
    LDS_WAIT(); asm volatile("" ::: "memory");
}
__device__ __forceinline__ void p0_prologue(Frame& F, bool with_gemv = true) {
    LAS float* scr = (LAS float*)(F.lds + RING_OFF + F.wave * 16384);
    constexpr int I_GV = 96 * 64;
    constexpr int NPAIR = (DM / 128) * (IN_W / 32) + (ATTW / 128) * (DM / 32) + (GMW / 128) * (DM / 32) + (DM / 128) * (DM / 32) + (DM / 128) * (F2 / 32) + (DFF / 128) * (DM / 32);
    if (with_gemv) for (int it = F.gw; it < I_GV; it += F.NGW) gemv_item(F, it);
    {
        TrItem A, B; f32x4 a0[8], a1[8], b0[8], b1[8];
        int r = F.gw; bool hasA = r < NPAIR;
        if (hasA) { tr_decode(F, r, A); tr_load(A, 0, a0, F.lane); tr_load(A, 1, a1, F.lane); }
        while (hasA) {
            const int rb = r + F.NGW; const bool hasB = rb < NPAIR;
            if (hasB) { tr_decode(F, rb, B); tr_load(B, 0, b0, F.lane); tr_load(B, 1, b1, F.lane); }
            tr_finish(A, 0, a0, scr, F.lane); tr_finish(A, 1, a1, scr, F.lane);
            if (!hasB) break;
            r = rb + F.NGW; hasA = r < NPAIR;
            if (hasA) { tr_decode(F, r, A); tr_load(A, 0, a0, F.lane); tr_load(A, 1, a1, F.lane); }
            tr_finish(B, 0, b0, scr, F.lane); tr_finish(B, 1, b1, scr, F.lane);
        }
    }
    { const size_t n16 = (size_t)(PNP - IN_W) * DM / 16; GAS v4u* p = (GAS v4u*)((unsigned char*)F.WIN + (size_t)IN_W * DM);
      for (size_t i = (size_t)F.gw * 64 + F.lane; i < n16; i += (size_t)F.NGW * 64) p[i] = (v4u){0u, 0u, 0u, 0u};
      GAS v4u* pb = (GAS v4u*)(F.WINB + (size_t)IN_W * DM);
      for (size_t i = (size_t)F.gw * 64 + F.lane; i < 2 * n16; i += (size_t)F.NGW * 64) pb[i] = (v4u){0u, 0u, 0u, 0u}; }
}

template <int FP8 = 0>
__device__ __forceinline__ void norm_rows(Frame& F, const float* X, const float* gain, int sh_off, int sc_off, void* Ov, unsigned char* O8 = nullptr) {
    LAS f32x4* CA = (LAS f32x4*)F.lds; LAS f32x4* CB = (LAS f32x4*)(F.lds + 16384);
    for (int blk = blockIdx.x; blk < M / 32; blk += F.G) {
        const int b = (blk * 32) >> 11;
        __syncthreads();
        for (int i = F.tid; i < DM / 4; i += NWAVES * 64) { const f32x4 g = ((const GAS f32x4*)gain)[i], sh = ((const GAS f32x4*)(F.MOD + b * MODW + sh_off))[i], sc = ((const GAS f32x4*)(F.MOD + b * MODW + sc_off))[i];
            CA[i] = g * (sc + 1.0f); CB[i] = sh; }
        __syncthreads();
        const int m0 = blk * 32 + 4 * F.wave;
        f32x4 va[16], vb[16];
#define NR_LOAD(v, m_) do { const GAS f32x4* xr = (const GAS f32x4*)(X + (size_t)(m_) * DM) + F.lane; _Pragma("unroll") for (int j = 0; j < 16; ++j) v[j] = xr[64 * j]; } while (0)
#define NR_FIN(v, m_) do { float s_ = 0.f; _Pragma("unroll") for (int j = 0; j < 16; ++j) s_ += (v[j].x * v[j].x + v[j].y * v[j].y) + (v[j].z * v[j].z + v[j].w * v[j].w); \
            const float rstd = 1.0f / sqrtf(wave_sum(s_) * (1.f / DM) + EPS); \
            GAS v2u* o8 = (GAS v2u*)((bf16*)Ov + (size_t)(m_) * DM) + F.lane; GAS unsigned* o4 = (GAS unsigned*)((FP8 == 2 ? O8 : (unsigned char*)Ov) + (size_t)(m_) * DM) + F.lane; \
            _Pragma("unroll") for (int j = 0; j < 16; ++j) { const f32x4 y = (v[j] * rstd) * CA[64 * j + F.lane] + CB[64 * j + F.lane]; \
                if constexpr (FP8 != 0) o4[64 * j] = pk4_fp8(y.x * S_H2, y.y * S_H2, y.z * S_H2, y.w * S_H2); \
                if constexpr (FP8 != 1) { v2u w_; w_.x = pk2(y.x, y.y); w_.y = pk2(y.z, y.w); o8[64 * j] = w_; } \
                if ((j & 3) == 3) asm volatile("" ::: "memory"); } } while (0)
        NR_LOAD(va, m0); NR_LOAD(vb, m0 + 1); NR_FIN(va, m0); NR_LOAD(va, m0 + 2); NR_FIN(vb, m0 + 1); NR_LOAD(vb, m0 + 3); NR_FIN(va, m0 + 2); NR_FIN(vb, m0 + 3);
#undef NR_LOAD
#undef NR_FIN
    }
}

__device__ __forceinline__ unsigned sortable(float f) { const unsigned u = __builtin_bit_cast(unsigned, f); return u ^ ((unsigned)((int)u >> 31) | 0x80000000u); }
__device__ __forceinline__ void select_topk(const unsigned (&sc)[32], GAS v2u* mrow, int lane) {
    unsigned thr = 0u;
    for (int bit = 31; bit >= 0; --bit) {
        const unsigned cand = thr | (1u << bit); int cnt = 0;
#pragma unroll
        for (int jp = 0; jp < 32; ++jp) cnt += __popcll(__ballot(sc[jp] >= cand));
        if (cnt >= TOPK) thr = cand;
    }
    int cgt = 0;
#pragma unroll
    for (int jp = 0; jp < 32; ++jp) cgt += __popcll(__ballot(sc[jp] > thr));
    const int need = TOPK - cgt; int seen = 0;
    unsigned mylo = 0u, myhi = 0u;
    const unsigned long long lt = (lane == 0) ? 0ull : (~0ull >> (64 - lane));
#pragma unroll
    for (int jp = 0; jp < 32; ++jp) {
        unsigned long long sel = __ballot(sc[jp] > thr);
        const unsigned long long eq = __ballot(sc[jp] == thr);
        if (eq) { const bool take = (sc[jp] == thr) && (seen + __popcll(eq & lt) < need); sel |= __ballot(take); seen += __popcll(eq); }
        if (lane == jp) { mylo = (unsigned)sel; myhi = (unsigned)(sel >> 32); }
    }
    if (lane < 32) { v2u w; w.x = mylo; w.y = myhi; mrow[lane] = w; }
}
__device__ __forceinline__ void idx_block(Frame& F, int b, int blk) {
    const int lane = F.lane, w = F.wave, hi = lane >> 5, l31 = lane & 31, tid = F.tid;
    const int t0 = blk * 8, tq = t0 + w;
    const size_t row = (size_t)b * SEQ + tq;
    GAS v2u* mrow = (GAS v2u*)(F.MASK + row * 64);
    if (t0 < TOPK) {
        if (lane < 32) { const int k0 = 64 * lane; v2u mw;
            mw.x = (tq >= k0 + 31) ? 0xffffffffu : (tq < k0 ? 0u : ((2u << (tq - k0)) - 1u));
            mw.y = (tq >= k0 + 63) ? 0xffffffffu : (tq < k0 + 32 ? 0u : ((2u << (tq - k0 - 32)) - 1u));
            mrow[lane] = mw; }
        return;
    }
    const int nt = (t0 + 7) / 64 + 1;
    const bf16* prow = F.PROJ + row * PNP;
    bf16x8 qa[4]; float wv[16];
#pragma unroll
    for (int ks = 0; ks < 4; ++ks) qa[ks] = *(const GAS bf16x8*)(prow + PQI + l31 * 64 + 16 * ks + 8 * hi);
#pragma unroll
    for (int r = 0; r < 16; ++r) wv[r] = bf2f(prow[PWI + (r & 3) + 8 * (r >> 2) + 4 * hi]);
    const bf16* ksrc = F.PROJ + ((size_t)b * SEQ + (tid >> 3)) * PNP + PKI + 8 * (tid & 7);
    const int kdst = (tid >> 3) * 128 + (((tid & 7) ^ ((tid >> 3) & 7)) << 4);
    const int krd = l31 * 128;
    unsigned sc[32];
    __syncthreads();
    v4u stg = *(const GAS v4u*)ksrc;
#pragma unroll
    for (int kt = 0; kt < 32; ++kt) {
        if (kt < nt) {
            LAS unsigned char* kb_base = F.lds + (kt & 1) * 8192;
            *(LAS v4u*)(kb_base + kdst) = stg;
            if (kt + 1 < nt) stg = *(const GAS v4u*)(ksrc + (size_t)(kt + 1) * 64 * PNP);
            LDS_WAIT(); __builtin_amdgcn_s_barrier(); asm volatile("" ::: "memory");
            float s01[2];
#pragma unroll
            for (int h = 0; h < 2; ++h) {
                f32x16 acc;
#pragma unroll
                for (int r = 0; r < 16; ++r) acc[r] = 0.f;
#pragma unroll
                for (int ks = 0; ks < 4; ++ks) { const bf16x8 kf = *(const LAS bf16x8*)(kb_base + h * 4096 + krd + (((2 * ks + hi) ^ (l31 & 7)) << 4));
                    acc = __builtin_amdgcn_mfma_f32_32x32x16_bf16(qa[ks], kf, acc, 0, 0, 0); }
                float x = 0.f;
#pragma unroll
                for (int r = 0; r < 16; ++r) x += wv[r] * fmaxf(acc[r], 0.f);
                x += __shfl_xor(x, 32);
                s01[h] = x;
            }
            const float mine = (lane < 32 ? s01[0] : s01[1]) + 0.0f;
            sc[kt] = (64 * kt + lane <= tq) ? sortable(mine) : 0u;
        } else sc[kt] = 0u;
    }
    select_topk(sc, mrow, lane);
}
constexpr float QSCALE = 0.08838834764831845f * 1.4426950408889634f;
__device__ __forceinline__ void qknorm_row(Frame& F, int row) {
    bf16* prow = F.PROJ + (size_t)row * PNP; const int lane = F.lane;
    {
        GAS v4u* p = (GAS v4u*)(prow + PQ + 32 * lane); v4u w[4]; float ss = 0.f;
#pragma unroll
        for (int i = 0; i < 4; ++i) { w[i] = p[i];
#pragma unroll
            for (int j = 0; j < 4; ++j) { const float a = bflo(w[i][j]), c = bfhi(w[i][j]); ss += a * a + c * c; } }
        ss += __shfl_xor(ss, 1); ss += __shfl_xor(ss, 2);
        const float r = QSCALE / sqrtf(ss * (1.f / HD) + EPS); const float* g = F.qng + 32 * (lane & 3);
#pragma unroll
        for (int i = 0; i < 4; ++i) { v4u o;
#pragma unroll
            for (int j = 0; j < 4; ++j) o[j] = pk2(bflo(w[i][j]) * r * g[8 * i + 2 * j], bfhi(w[i][j]) * r * g[8 * i + 2 * j + 1]);
            p[i] = o; }
    }
    {
        GAS v4u* p = (GAS v4u*)(prow + PK + 8 * lane); const v4u w = *p; float ss = 0.f;
#pragma unroll
        for (int j = 0; j < 4; ++j) { const float a = bflo(w[j]), c = bfhi(w[j]); ss += a * a + c * c; }
        ss += __shfl_xor(ss, 1); ss += __shfl_xor(ss, 2); ss += __shfl_xor(ss, 4); ss += __shfl_xor(ss, 8);
        const float r = 1.0f / sqrtf(ss * (1.f / HD) + EPS); const float* g = F.kng + 8 * (lane & 15); v4u o;
#pragma unroll
        for (int j = 0; j < 4; ++j) o[j] = pk2(bflo(w[j]) * r * g[2 * j], bfhi(w[j]) * r * g[2 * j + 1]);
        *p = o;
    }
    {
        const GAS v4u* p = (const GAS v4u*)(prow + PGV + 32 * lane); float ss = 0.f;
#pragma unroll
        for (int i = 0; i < 4; ++i) { const v4u w = p[i];
#pragma unroll
            for (int j = 0; j < 4; ++j) { const float a = bflo(w[j]), c = bfhi(w[j]); ss += a * a + c * c; } }
        ss = wave_sum(ss);
        if (lane == 0) F.RS[row] = 1.0f / sqrtf(ss * (1.f / GMW) + EPS);
    }
}
__device__ __forceinline__ void vt_item(Frame& F, int item) {
    const int s8 = item & 255, dh = (item >> 8) & 1, g = (item >> 9) & 3, b = item >> 11, d = 64 * dh + F.lane;
    const bf16* src = F.PROJ + (size_t)(b * SEQ + 8 * s8) * PNP + PV + g * HD + d;
    unsigned e[8];
#pragma unroll
    for (int j = 0; j < 8; ++j) e[j] = src[(size_t)j * PNP];
    v4u o; o.x = e[0] | (e[1] << 16); o.y = e[2] | (e[3] << 16); o.z = e[4] | (e[5] << 16); o.w = e[6] | (e[7] << 16);
    *(GAS v4u*)(F.VT + ((size_t)((b * NKV + g) * HD + d)) * SEQ + 8 * s8) = o;
}

constexpr int AT_KSTR = 272, AT_VSTR = 136, AT_TILE = 17408;
#define RAW_BARRIER() do { LDS_WAIT(); __builtin_amdgcn_s_barrier(); asm volatile("" ::: "memory"); } while (0)
__device__ __forceinline__ void attn_block(Frame& F, int b, int g, int qb, float sbound) {
    const int lane = F.lane, w = F.wave, hi = lane >> 5, l31 = lane & 31, tid = F.tid;
    const int hh = 4 * g + (w >> 1), tw0 = qb * 64 + 32 * (w & 1), t = tw0 + l31;
    const size_t row = (size_t)b * SEQ + t;
    const float slope2 = exp2f(-0.5f * (float)(hh + 1)) * 1.4426950408889634f;
    bf16x8 qf[8];
#pragma unroll
    for (int ks = 0; ks < 8; ++ks) qf[ks] = *(const GAS bf16x8*)(F.PROJ + row * PNP + PQ + hh * HD + 16 * ks + 8 * hi);
    f32x16 o[4];
#pragma unroll
    for (int db = 0; db < 4; ++db)
#pragma unroll
        for (int r = 0; r < 16; ++r) o[db][r] = 0.f;
    float m = -1e30f, lsum = 0.f;
    const bf16* ksrc = F.PROJ + ((size_t)b * SEQ + (tid >> 4)) * PNP + PK + g * HD + 8 * (tid & 15);
    const int kdst = (tid >> 4) * AT_KSTR + (tid & 15) * 16;
    const bf16* vsrc = F.VT + ((size_t)((b * NKV + g) * HD + (tid >> 3))) * SEQ + 8 * (tid & 7);
    const int vdst = 2 * AT_TILE + (tid >> 3) * AT_VSTR + (tid & 7) * 16;
    const unsigned* mbase = F.MASK + row * 64;
    LAS unsigned char* L = F.lds;
    v4u sk0, sk1, sv0, sv1; v2u mw, mwn;
#define AT_LOAD(kt_) do { sk0 = *(const GAS v4u*)(ksrc + (size_t)(64 * (kt_)) * PNP); sk1 = *(const GAS v4u*)(ksrc + (size_t)(64 * (kt_) + 32) * PNP); \
        sv0 = *(const GAS v4u*)(vsrc + 64 * (kt_)); sv1 = *(const GAS v4u*)(vsrc + (size_t)64 * SEQ + 64 * (kt_)); mwn = *(const GAS v2u*)(mbase + 2 * (kt_)); } while (0)
#define AT_STORE(bf_) do { *(LAS v4u*)(L + (bf_) * AT_TILE + kdst) = sk0; *(LAS v4u*)(L + (bf_) * AT_TILE + kdst + 32 * AT_KSTR) = sk1; \
        LAS unsigned char* _v = L + (bf_) * AT_TILE + vdst; *(LAS v2u*)_v = (v2u){sv0.x, sv0.y}; *(LAS v2u*)(_v + 8) = (v2u){sv0.z, sv0.w}; \
        *(LAS v2u*)(_v + 64 * AT_VSTR) = (v2u){sv1.x, sv1.y}; *(LAS v2u*)(_v + 64 * AT_VSTR + 8) = (v2u){sv1.z, sv1.w}; } while (0)
    RAW_BARRIER();
    AT_LOAD(qb); AT_STORE(0); mw = mwn;
    int buf = 0; bool dead = false;
    for (int kt = qb; kt >= 0; --kt) {
        if (kt > 0) AT_LOAD(kt - 1);
        RAW_BARRIER();
        if (!dead) {
            const float dmin = (float)(tw0 - (64 * kt + 63));
            dead = __all((sbound - slope2 * dmin) < (m - 40.0f));
        }
        if (!dead) {
            const LAS unsigned char* kb_ = L + buf * AT_TILE + l31 * AT_KSTR + hi * 16;
            const LAS unsigned char* vb_ = L + buf * AT_TILE + 2 * AT_TILE + l31 * AT_VSTR + hi * 8;
            f32x16 p[2];
#pragma unroll
            for (int kb = 0; kb < 2; ++kb) {
#pragma unroll
                for (int r = 0; r < 16; ++r) p[kb][r] = 0.f;
#pragma unroll
                for (int ks = 0; ks < 8; ++ks) { const bf16x8 kf = *(const LAS bf16x8*)(kb_ + kb * 32 * AT_KSTR + ks * 32); p[kb] = __builtin_amdgcn_mfma_f32_32x32x16_bf16(kf, qf[ks], p[kb], 0, 0, 0); }
            }
            const float base = -slope2 * (float)(t - 64 * kt - 4 * hi);
            float rmax = -3e30f;
#pragma unroll
            for (int kb = 0; kb < 2; ++kb) { const unsigned mword = (kb ? mw.y : mw.x) >> (4 * hi);
#pragma unroll
                for (int r = 0; r < 16; ++r) { const int ko = (r & 3) + 8 * (r >> 2);
                    float sv = p[kb][r] + slope2 * (float)(32 * kb + ko);
                    sv = ((mword >> ko) & 1u) ? sv : -2e30f; p[kb][r] = sv; rmax = fmaxf(rmax, sv); } }
            rmax += base; rmax = fmaxf(rmax, __shfl_xor(rmax, 32));
            const float mn = fmaxf(m, rmax), alpha = __builtin_amdgcn_exp2f(m - mn), mrel = mn - base;
            const bool moved = __any(mn != m);
            m = mn;
            float ps = 0.f;
#pragma unroll
            for (int kb = 0; kb < 2; ++kb)
#pragma unroll
                for (int r = 0; r < 16; ++r) { const float e = __builtin_amdgcn_exp2f(p[kb][r] - mrel); p[kb][r] = e; ps += e; }
            lsum = lsum * alpha + ps;
            if (moved) {
#pragma unroll
                for (int db = 0; db < 4; ++db)
#pragma unroll
                    for (int r = 0; r < 16; ++r) o[db][r] *= alpha;
            }
#pragma unroll
            for (int kb = 0; kb < 2; ++kb)
#pragma unroll
                for (int s2 = 0; s2 < 2; ++s2) {
                    v4u pw; pw.x = pk2(p[kb][8 * s2 + 0], p[kb][8 * s2 + 1]); pw.y = pk2(p[kb][8 * s2 + 2], p[kb][8 * s2 + 3]); pw.z = pk2(p[kb][8 * s2 + 4], p[kb][8 * s2 + 5]); pw.w = pk2(p[kb][8 * s2 + 6], p[kb][8 * s2 + 7]);
                    const bf16x8 pb = __builtin_bit_cast(bf16x8, pw);
#pragma unroll
                    for (int db = 0; db < 4; ++db) { const LAS unsigned char* vp = vb_ + db * 32 * AT_VSTR + kb * 64 + s2 * 32;
                        const v2u v0 = *(const LAS v2u*)vp, v1 = *(const LAS v2u*)(vp + 16);
                        v4u vw; vw.x = v0.x; vw.y = v0.y; vw.z = v1.x; vw.w = v1.y;
                        o[db] = __builtin_amdgcn_mfma_f32_32x32x16_bf16(__builtin_bit_cast(bf16x8, vw), pb, o[db], 0, 0, 0); }
                }
        }
        if (kt > 0) { AT_STORE(buf ^ 1); mw = mwn; }
        buf ^= 1;
    }
#undef AT_LOAD
#undef AT_STORE
    lsum += __shfl_xor(lsum, 32);
    const float inv = S_YA / lsum;
    unsigned char* yrow = (unsigned char*)F.YA + row * (2 * ATTW) + hh * HD + 4 * hi;
#pragma unroll
    for (int db = 0; db < 4; ++db)
#pragma unroll
        for (int rq = 0; rq < 4; ++rq) *(GAS unsigned*)(yrow + 32 * db + 8 * rq) = pk4_fp8(o[db][4 * rq] * inv, o[db][4 * rq + 1] * inv, o[db][4 * rq + 2] * inv, o[db][4 * rq + 3] * inv);
}
__device__ __forceinline__ float attn_score_bound(Frame& F) {
    float gq = fmaxf(fabsf(F.qng[F.lane]), fabsf(F.qng[F.lane + 64])), gk = fmaxf(fabsf(F.kng[F.lane]), fabsf(F.kng[F.lane + 64]));
#pragma unroll
    for (int o = 1; o < 64; o <<= 1) { gq = fmaxf(gq, __shfl_xor(gq, o)); gk = fmaxf(gk, __shfl_xor(gk, o)); }
    return 1.02f * 128.0f * gq * gk * QSCALE;
}

constexpr int SG_STR = 272, SG_WOFF = 65536;
__device__ __forceinline__ void sgu_unit(Frame& F, int unit) {
    const int ck = unit >> 3, g = unit & 7, r0 = ck * GMC, c0 = g * GMGW, tid = F.tid, lane = F.lane, w = F.wave, hi = lane >> 5, l31 = lane & 31;
    LAS unsigned char* L = F.lds;
    const int rs_ = tid >> 5, q_ = tid & 31;
    __syncthreads();
#pragma unroll
    for (int i = 0; i < 8; ++i) *(LAS v4u*)(L + (rs_ + 16 * i) * 512 + q_ * 16) = *(const GAS v4u*)(F.PROJ + (size_t)(r0 + rs_ + 16 * i) * PNP + PGV + c0 + 8 * q_);
    { const f32x4 q = *(const GAS f32x4*)(F.RS + r0 + 4 * q_);
#pragma unroll
      for (int i = 0; i < 8; ++i) { const int t_ = rs_ + 16 * i; const f32x4 wv = *(const GAS f32x4*)(F.sgw + ((size_t)(g * GMC + t_)) * GMC + 4 * q_);
          const int sb = 4 * q_; v2u o;
          o.x = pk2(sb + 0 <= t_ ? wv.x * q.x : 0.f, sb + 1 <= t_ ? wv.y * q.y : 0.f); o.y = pk2(sb + 2 <= t_ ? wv.z * q.z : 0.f, sb + 3 <= t_ ? wv.w * q.w : 0.f);
          *(LAS v2u*)(L + SG_WOFF + t_ * SG_STR + 8 * q_) = o; } }
    __syncthreads();
    v4u uu[8];
#pragma unroll
    for (int i = 0; i < 8; ++i) uu[i] = *(const GAS v4u*)(F.PROJ + (size_t)(r0 + rs_ + 16 * i) * PNP + PGU + c0 + 8 * q_);
    f32x16 acc[4];
#pragma unroll
    for (int tb = 0; tb < 4; ++tb)
#pragma unroll
        for (int r = 0; r < 16; ++r) acc[tb][r] = 0.f;
    const LAS unsigned char* xb = L + hi * 8 * 512 + 2 * (32 * w + l31);
    const LAS unsigned char* wa = L + SG_WOFF + l31 * SG_STR + hi * 16;
#pragma unroll
    for (int ks = 0; ks < 8; ++ks) {
        v4u xw;
#pragma unroll
        for (int j = 0; j < 4; ++j) { const unsigned lo = *(const LAS unsigned short*)(xb + (16 * ks + 2 * j) * 512), hh = *(const LAS unsigned short*)(xb + (16 * ks + 2 * j + 1) * 512); xw[j] = lo | (hh << 16); }
        const bf16x8 xf = __builtin_bit_cast(bf16x8, xw);
#pragma unroll
        for (int tb = 0; tb < 4; ++tb) if (ks < 2 * (tb + 1)) { const bf16x8 wf = *(const LAS bf16x8*)(wa + tb * 32 * SG_STR + ks * 32); acc[tb] = __builtin_amdgcn_mfma_f32_32x32x16_bf16(wf, xf, acc[tb], 0, 0, 0); } }
    LDS_WAIT(); __builtin_amdgcn_s_barrier(); asm volatile("" ::: "memory");
    { const int cl = 32 * w + l31;
#pragma unroll
      for (int tb = 0; tb < 4; ++tb)
#pragma unroll
          for (int r = 0; r < 16; ++r) { const int t = 32 * tb + (r & 3) + 8 * (r >> 2) + 4 * hi; *(LAS unsigned short*)(L + t * 512 + 2 * cl) = (unsigned short)f2bf(acc[tb][r]); } }
    const f32x4 g0 = *(const GAS f32x4*)(F.sgg + c0 + 8 * q_), g1 = *(const GAS f32x4*)(F.sgg + c0 + 8 * q_ + 4);
    LDS_WAIT(); __builtin_amdgcn_s_barrier(); asm volatile("" ::: "memory");
#pragma unroll
    for (int i = 0; i < 8; ++i) { const v4u fw = *(const LAS v4u*)(L + (rs_ + 16 * i) * 512 + q_ * 16); const float bb = F.sgb[g * GMC + rs_ + 16 * i]; v2u o;
        o.x = pk4_fp8(S_YB * bflo(uu[i].x) * (bflo(fw.x) * g0.x + bb), S_YB * bfhi(uu[i].x) * (bfhi(fw.x) * g0.y + bb), S_YB * bflo(uu[i].y) * (bflo(fw.y) * g0.z + bb), S_YB * bfhi(uu[i].y) * (bfhi(fw.y) * g0.w + bb));
        o.y = pk4_fp8(S_YB * bflo(uu[i].z) * (bflo(fw.z) * g1.x + bb), S_YB * bfhi(uu[i].z) * (bfhi(fw.z) * g1.y + bb), S_YB * bflo(uu[i].w) * (bflo(fw.w) * g1.z + bb), S_YB * bfhi(uu[i].w) * (bfhi(fw.w) * g1.w + bb));
        *(GAS v2u*)((unsigned char*)F.YA + (size_t)(r0 + rs_ + 16 * i) * (2 * ATTW) + ATTW + c0 + 8 * q_) = o; }
}

using pg8::Unit; using pg8::cvt_pk_bf16;
struct EpiProj {
    static constexpr bool PERM = true, MIDK = false; bf16* O; float scale;
    __device__ __forceinline__ void operator()(const f32x4 (&acc)[2][2][4][2], const Unit& u, int wr, int wc, int fr, int fq) const {
        const int act = (u.pn >= PGU / 256 && u.pn < PGA / 256) ? 1 : ((u.pn >= PGA / 256 && u.pn < PKI / 256) ? 2 : 0);
        const int row0 = u.pm * 256 + wr * 64 + fr, col0 = u.pn * 256 + wc * 32 + 8 * fq;
#pragma unroll
        for (int ai = 0; ai < 2; ++ai)
#pragma unroll
            for (int m = 0; m < 4; ++m) { bf16* rowp = O + (size_t)(row0 + ai * 128 + m * 16) * PNP + col0;
#pragma unroll
                for (int bj = 0; bj < 2; ++bj) { f32x4 v0 = acc[ai][bj][m][0] * scale, v1 = acc[ai][bj][m][1] * scale;
                    if (act == 1) { const pg8::f32x2 a = pg8::gelu_pk((pg8::f32x2){v0[0], v0[1]}), b = pg8::gelu_pk((pg8::f32x2){v0[2], v0[3]}), c = pg8::gelu_pk((pg8::f32x2){v1[0], v1[1]}), d = pg8::gelu_pk((pg8::f32x2){v1[2], v1[3]});
                        v0 = (f32x4){a.x, a.y, b.x, b.y}; v1 = (f32x4){c.x, c.y, d.x, d.y}; }
                    else if (act == 2) {
#pragma unroll
                        for (int j = 0; j < 4; ++j) { v0[j] = pg8::sigmoidf_(v0[j]); v1[j] = pg8::sigmoidf_(v1[j]); } }
                    v4u w; w.x = cvt_pk_bf16(v0[0], v0[1]); w.y = cvt_pk_bf16(v0[2], v0[3]); w.z = cvt_pk_bf16(v1[0], v1[1]); w.w = cvt_pk_bf16(v1[2], v1[3]);
                    *(GAS v4u*)(rowp + bj * 128) = w; } }
    }
};
struct EpiMerge {
    static constexpr bool PERM = true, MIDK = true; const bf16* P; unsigned char* O; float cB, ratio;
    __device__ __forceinline__ void mid(f32x4 (&acc)[2][2][4][2], const Unit& u, int wr, int wc, int fr, int fq) const {
        const bf16* pb = P + (size_t)(u.pm * 256 + wr * 64 + fr) * PNP + (u.pn * 256 + wc * 32 + 8 * fq);
        asm volatile("" : "+v"(pb));
#pragma unroll
        for (int ai = 0; ai < 2; ++ai)
#pragma unroll
            for (int m = 0; m < 4; ++m) {
#pragma unroll
                for (int bj = 0; bj < 2; ++bj) { const bf16* q = pb + (size_t)(ai * 128 + m * 16) * PNP + bj * 128;
                    const v4u ga = *(const GAS v4u*)(q + PGA), gb = *(const GAS v4u*)(q + PGB);
#pragma unroll
                    for (int j = 0; j < 2; ++j) { f32x4 f;
                        f.x = ratio * bflo(ga[2 * j]) * __builtin_amdgcn_rcpf(fmaxf(bflo(gb[2 * j]), 1e-30f)); f.y = ratio * bfhi(ga[2 * j]) * __builtin_amdgcn_rcpf(fmaxf(bfhi(gb[2 * j]), 1e-30f));
                        f.z = ratio * bflo(ga[2 * j + 1]) * __builtin_amdgcn_rcpf(fmaxf(bflo(gb[2 * j + 1]), 1e-30f)); f.w = ratio * bfhi(ga[2 * j + 1]) * __builtin_amdgcn_rcpf(fmaxf(bfhi(gb[2 * j + 1]), 1e-30f));
                        acc[ai][bj][m][j] *= f; }
                    asm volatile("" ::: "memory"); } }
    }
    __device__ __forceinline__ void operator()(const f32x4 (&acc)[2][2][4][2], const Unit& u, int wr, int wc, int fr, int fq) const {
        const float sc = cB * S_MRG;
        const bf16* pb = P + (size_t)(u.pm * 256 + wr * 64 + fr) * PNP + (u.pn * 256 + wc * 32 + 8 * fq) + PGB;
        unsigned char* ob = O + (size_t)(u.pm * 256 + wr * 64 + fr) * DM + (u.pn * 256 + wc * 32 + 8 * fq);
        asm volatile("" : "+v"(pb), "+v"(ob));
#pragma unroll
        for (int ai = 0; ai < 2; ++ai)
#pragma unroll
            for (int m = 0; m < 4; ++m) {
#pragma unroll
                for (int bj = 0; bj < 2; ++bj) { const v4u gw = *(const GAS v4u*)(pb + (size_t)(ai * 128 + m * 16) * PNP + bj * 128);
                    const f32x4 v0 = acc[ai][bj][m][0] * ((f32x4){fmaxf(bflo(gw.x), 1e-30f), fmaxf(bfhi(gw.x), 1e-30f), fmaxf(bflo(gw.y), 1e-30f), fmaxf(bfhi(gw.y), 1e-30f)} * sc);
                    const f32x4 v1 = acc[ai][bj][m][1] * ((f32x4){fmaxf(bflo(gw.z), 1e-30f), fmaxf(bfhi(gw.z), 1e-30f), fmaxf(bflo(gw.w), 1e-30f), fmaxf(bfhi(gw.w), 1e-30f)} * sc);
                    v2u w; w.x = pk4_fp8(v0[0], v0[1], v0[2], v0[3]); w.y = pk4_fp8(v1[0], v1[1], v1[2], v1[3]);
                    *(GAS v2u*)(ob + (size_t)(ai * 128 + m * 16) * DM + bj * 128) = w; } }
    }
};
struct EpiResid {
    static constexpr bool PERM = false, MIDK = false; const float* base; const float* gate; float* C; float scale;
    __device__ __forceinline__ void operator()(const f32x4 (&acc)[2][2][4][2], const Unit& u, int wr, int wc, int fr, int fq) const {
        const int row0 = u.pm * 256 + wr * 64 + fr, col0 = u.pn * 256 + wc * 32 + 4 * fq; const float* gp = gate + (u.pm >> 3) * MODW + col0;
        f32x4 gv[2][2];
#pragma unroll
        for (int bj = 0; bj < 2; ++bj)
#pragma unroll
            for (int n = 0; n < 2; ++n) gv[bj][n] = *(const GAS f32x4*)(gp + bj * 128 + n * 16) * scale;
#pragma unroll
        for (int ai = 0; ai < 2; ++ai)
#pragma unroll
            for (int m = 0; m < 4; ++m) { const size_t off = (size_t)(row0 + ai * 128 + m * 16) * DM + col0;
#pragma unroll
                for (int bj = 0; bj < 2; ++bj)
#pragma unroll
                    for (int n = 0; n < 2; ++n) { const f32x4 bs = *(const GAS f32x4*)(base + off + bj * 128 + n * 16);
                        *(GAS f32x4*)(C + off + bj * 128 + n * 16) = bs + gv[bj][n] * acc[ai][bj][m][n]; } }
    }
};
struct EpiPlain {
    static constexpr bool PERM = true, MIDK = false; bf16* O; int ldc; float scale;
    __device__ __forceinline__ void operator()(const f32x4 (&acc)[2][2][4][2], const Unit& u, int wr, int wc, int fr, int fq) const {
        const int row0 = u.pm * 256 + wr * 64 + fr, col0 = u.pn * 256 + wc * 32 + 8 * fq;
#pragma unroll
        for (int ai = 0; ai < 2; ++ai)
#pragma unroll
            for (int m = 0; m < 4; ++m) { bf16* rowp = O + (size_t)(row0 + ai * 128 + m * 16) * ldc + col0;
#pragma unroll
                for (int bj = 0; bj < 2; ++bj) { const f32x4 v0 = acc[ai][bj][m][0] * scale, v1 = acc[ai][bj][m][1] * scale;
                    v4u w; w.x = cvt_pk_bf16(v0[0], v0[1]); w.y = cvt_pk_bf16(v0[2], v0[3]); w.z = cvt_pk_bf16(v1[0], v1[1]); w.w = cvt_pk_bf16(v1[2], v1[3]);
                    *(GAS v4u*)(rowp + bj * 128) = w; } }
    }
};

__device__ __forceinline__ void conv_phase(Frame& F) {
    constexpr int C8 = DFF / 8, TB = 32, NTB = M / TB;
    const size_t total = (size_t)C8 * NTB;
    for (size_t idx = (size_t)F.gw * 64 + F.lane; idx < total; idx += (size_t)F.NGW * 64) {
        const int c8 = (int)(idx % C8), tb = (int)(idx / C8), ch = 8 * c8, t0 = tb * TB;
        const int acol = (ch >> 7) * 256 + (ch & 127);
        float wg[3][8], wv[3][8], bg[8], bv[8];
#pragma unroll
        for (int j = 0; j < 3; ++j) { const f32x4 a = *(const GAS f32x4*)(F.cvw + (size_t)j * F2 + ch), b = *(const GAS f32x4*)(F.cvw + (size_t)j * F2 + ch + 4);
            const f32x4 c = *(const GAS f32x4*)(F.cvw + (size_t)j * F2 + DFF + ch), d = *(const GAS f32x4*)(F.cvw + (size_t)j * F2 + DFF + ch + 4);
#pragma unroll
            for (int e = 0; e < 4; ++e) { wg[j][e] = a[e]; wg[j][4 + e] = b[e]; wv[j][e] = c[e]; wv[j][4 + e] = d[e]; } }
        { const f32x4 a = *(const GAS f32x4*)(F.cvb + ch), b = *(const GAS f32x4*)(F.cvb + ch + 4), c = *(const GAS f32x4*)(F.cvb + DFF + ch), d = *(const GAS f32x4*)(F.cvb + DFF + ch + 4);
#pragma unroll
          for (int e = 0; e < 4; ++e) { bg[e] = a[e]; bg[4 + e] = b[e]; bv[e] = c[e]; bv[4 + e] = d[e]; } }
        float g1[8], g2[8], v1[8], v2[8];
        const bool first = (t0 & (SEQ - 1)) == 0;
        const bf16* ap = F.A + (size_t)t0 * F2 + acol;
        if (first) {
#pragma unroll
            for (int e = 0; e < 8; ++e) { g1[e] = g2[e] = v1[e] = v2[e] = 0.f; }
        } else {
            const v4u ga = *(const GAS v4u*)(ap - F2), gb = *(const GAS v4u*)(ap - 2 * (size_t)F2), va = *(const GAS v4u*)(ap - F2 + 128), vb = *(const GAS v4u*)(ap - 2 * (size_t)F2 + 128);
#pragma unroll
            for (int e = 0; e < 4; ++e) { g1[2 * e] = bflo(ga[e]); g1[2 * e + 1] = bfhi(ga[e]); g2[2 * e] = bflo(gb[e]); g2[2 * e + 1] = bfhi(gb[e]);
                v1[2 * e] = bflo(va[e]); v1[2 * e + 1] = bfhi(va[e]); v2[2 * e] = bflo(vb[e]); v2[2 * e + 1] = bfhi(vb[e]); }
        }
#pragma unroll 4
        for (int i = 0; i < TB; ++i) {
            const v4u gw = *(const GAS v4u*)(ap + (size_t)i * F2), vw = *(const GAS v4u*)(ap + (size_t)i * F2 + 128);
            float g0[8], v0[8], y[8];
#pragma unroll
            for (int e = 0; e < 4; ++e) { g0[2 * e] = bflo(gw[e]); g0[2 * e + 1] = bfhi(gw[e]); v0[2 * e] = bflo(vw[e]); v0[2 * e + 1] = bfhi(vw[e]); }
#pragma unroll
            for (int e = 0; e < 8; ++e) { const float gt = bg[e] + wg[0][e] * g2[e] + wg[1][e] * g1[e] + wg[2][e] * g0[e];
                const float vl = bv[e] + wv[0][e] * v2[e] + wv[1][e] * v1[e] + wv[2][e] * v0[e];
                y[e] = gt * pg8::sigmoidf_(gt) * vl; g2[e] = g1[e]; g1[e] = g0[e]; v2[e] = v1[e]; v1[e] = v0[e]; }
            v2u o; o.x = pk4_fp8(y[0] * S_ACT, y[1] * S_ACT, y[2] * S_ACT, y[3] * S_ACT); o.y = pk4_fp8(y[4] * S_ACT, y[5] * S_ACT, y[6] * S_ACT, y[7] * S_ACT);
            *(GAS v2u*)((unsigned char*)F.ACT + (size_t)(t0 + i) * DFF + ch) = o;
        }
    }
}

constexpr int N_PHASES = 12;
struct Args { const float* in[19]; float* out; unsigned char* ws; int ph_lo, ph_hi, li, pad; };
__global__ void __launch_bounds__(NWAVES * 64, 2) mega_fwd(Args args) {
    extern __shared__ __attribute__((aligned(16))) unsigned char lds[];
    Frame F;
    F.lds = (LAS unsigned char*)lds;
    F.MISC = (volatile LAS unsigned*)(F.lds + MISC_OFF);
    F.tid = threadIdx.x; F.lane = F.tid & 63; F.wave = __builtin_amdgcn_readfirstlane(F.tid >> 6);
    F.G = gridDim.x; F.gw = blockIdx.x * NWAVES + F.wave; F.NGW = F.G * NWAVES;
    unsigned char* ws = args.ws;
    F.ctl = (gu32*)(ws + WS_CTL);
    F.x = args.in[0]; F.c = args.in[1]; F.ada_w = args.in[2]; F.ada_b = args.in[3]; F.n1g = args.in[4]; F.w_in = args.in[5]; F.qng = args.in[6]; F.kng = args.in[7];
    F.sgg = args.in[8]; F.sgw = args.in[9]; F.sgb = args.in[10]; F.w_a = args.in[11]; F.w_b = args.in[12]; F.w_out = args.in[13]; F.n2g = args.in[14]; F.w_up = args.in[15];
    F.cvw = args.in[16]; F.cvb = args.in[17]; F.w_dn = args.in[18]; F.out = args.out;
    F.MOD = (float*)(ws + WS_MOD); F.PART = (float*)(ws + WS_TMP);   F.WIN = (bf16*)(ws + WS_WIN); F.WINB = (bf16*)(ws + WS_WINB); F.H8A = ws + WS_X1;   F.WA = (bf16*)(ws + WS_WA); F.WB = (bf16*)(ws + WS_WB); F.WOUT = (bf16*)(ws + WS_WOUT); F.WUP = (bf16*)(ws + WS_WUP); F.WDN = (bf16*)(ws + WS_WDN);
    F.H = (bf16*)(ws + WS_H); F.X1 = (float*)(ws + WS_X1); F.PROJ = (bf16*)(ws + WS_PROJ); F.MASK = (unsigned*)(ws + WS_MASK); F.RS = (float*)(ws + WS_RS); F.SWT = (float*)(ws + WS_SWT);
    F.VT = (bf16*)(ws + WS_VT); F.YA = (bf16*)(ws + WS_YA); F.YB = (bf16*)(ws + WS_YB); F.MRG = (bf16*)(ws + WS_MRG); F.TMP = (float*)(ws + WS_TMP); F.A = (bf16*)(ws + WS_A); F.ACT = (bf16*)(ws + WS_ACT);
    for (int u = F.tid; u < (LDS_BYTES - LDSCTL_OFF) / 4; u += NWAVES * 64) ((LAS unsigned*)(F.lds + LDSCTL_OFF))[u] = 0u;
    __syncthreads();
    XcdBarrier bar; bar.bar = (unsigned*)(F.ctl + CW_BAR); bar.x = 0; bar.st = nullptr;
    if (MK_N_LAUNCHES == 1) bar = xcd_barrier_post((unsigned*)(F.ctl + CW_BAR), F.MISC + 8);
    const int lo = args.ph_lo, hi = args.ph_hi;
#define IN(k) (lo <= (k) && (k) < hi)
#define SEAM(k) do { if (IN(k) && IN((k) + 1)) xcd_barrier(bar); } while (0)

#define REP(k) if ((PROBE_MASK >> (k)) & 1) for (int _rep = 0; _rep < 1; ++_rep)
    if (IN(0)) { p0_prologue(F); REP(0) { xcd_barrier(bar); p0_prologue(F, false); } } SEAM(0);
    if (IN(1)) { mod_reduce(F); } SEAM(1);
    if (IN(2)) { norm_rows<2>(F, F.x, F.n1g, 0, DM, F.H, F.H8A); REP(2) { xcd_barrier(bar); norm_rows<2>(F, F.x, F.n1g, 0, DM, F.H, F.H8A); } } SEAM(2);
    if (IN(3)) {
        { pg8::Gemm g{F.H, F.WINB, M, PNP, DM, DM, DM}; pg8::MixOrder S{0, F.G, (int)blockIdx.x}; EpiProj E{F.PROJ, 1.0f};
          pg8::gemm_phase<EpiProj, pg8::MixOrder, true, 2>(F.lds + RING_OFF, g, S, E); }
        VM_WAIT(); __syncthreads();
        { pg8::Gemm g{(const bf16*)F.H8A, F.WIN, M, PNP, DM, DM, DM}; pg8::MixOrder S{1, F.G, (int)blockIdx.x}; EpiProj E{F.PROJ, 1.0f / (S_H2 * 1024.f)};
          pg8::gemm_phase<EpiProj, pg8::MixOrder, true, 1>(F.lds + RING_OFF, g, S, E); }
    } SEAM(3);
    if (IN(4)) {
        for (int it = blockIdx.x; it < 512; it += F.G) { const int b = it >> 7, j = it & 127; idx_block(F, b, j); idx_block(F, b, 255 - j); }
        for (int row = F.gw; row < M; row += F.NGW) qknorm_row(F, row);
        for (int it = F.gw; it < BATCH * NKV * 2 * 256; it += F.NGW) vt_item(F, it);
        REP(4) { xcd_barrier(bar); for (int it = blockIdx.x; it < 512; it += F.G) { const int b = it >> 7, j = it & 127; idx_block(F, b, j); idx_block(F, b, 255 - j); } }
        REP(13) { xcd_barrier(bar); for (int it = F.gw; it < BATCH * NKV * 2 * 256; it += F.NGW) vt_item(F, it); }
    } SEAM(4);
    if (IN(5)) {
        { const float sb = attn_score_bound(F); for (int p = blockIdx.x; p < 256; p += F.G) { const int bg = p >> 4, j = p & 15; attn_block(F, bg >> 2, bg & 3, j, sb); attn_block(F, bg >> 2, bg & 3, 31 - j, sb); } }
        REP(5) { xcd_barrier(bar); { const float sb = attn_score_bound(F); for (int p = blockIdx.x; p < 256; p += F.G) { const int bg = p >> 4, j = p & 15; attn_block(F, bg >> 2, bg & 3, j, sb); attn_block(F, bg >> 2, bg & 3, 31 - j, sb); } } }
        for (int u = blockIdx.x; u < 512; u += F.G) sgu_unit(F, u);
        __syncthreads();
        REP(14) { xcd_barrier(bar); for (int u = blockIdx.x; u < 512; u += F.G) sgu_unit(F, u); __syncthreads(); }
    } SEAM(5);
    if (IN(6)) { pg8::Gemm g{F.YA, F.WA, M, DM, 2 * ATTW, 2 * ATTW, 2 * ATTW}; pg8::StaticOrder S; S.init(M, DM, F.G, (int)blockIdx.x);
        EpiMerge E{F.PROJ, (unsigned char*)F.MRG, 1.0f / (S_YB * S_WB), (S_YB * S_WB) / (S_YA * S_WA)};
        pg8::gemm_phase<EpiMerge, pg8::StaticOrder, true, 1>(F.lds + RING_OFF, g, S, E);
        REP(6) { xcd_barrier(bar); pg8::gemm_phase<EpiMerge, pg8::StaticOrder, true, 1>(F.lds + RING_OFF, g, S, E); } } SEAM(6);
    if (IN(7)) { pg8::Gemm g{F.MRG, F.WOUT, M, DM, DM, DM, DM}; pg8::StaticOrder S; S.init(M, DM, F.G, (int)blockIdx.x); EpiResid E{F.x, F.MOD + 2 * DM, F.X1, 1.0f / (S_MRG * S_WOUT)};
        pg8::gemm_phase<EpiResid, pg8::StaticOrder, true, 1>(F.lds + RING_OFF, g, S, E);
        REP(7) { xcd_barrier(bar); pg8::gemm_phase<EpiResid, pg8::StaticOrder, true, 1>(F.lds + RING_OFF, g, S, E); } } SEAM(7);
    if (IN(8)) { norm_rows<1>(F, F.X1, F.n2g, 3 * DM, 4 * DM, F.H); REP(8) { xcd_barrier(bar); norm_rows<1>(F, F.X1, F.n2g, 3 * DM, 4 * DM, F.H); } } SEAM(8);
    if (IN(9)) { pg8::Gemm g{F.H, F.WUP, M, F2, DM, DM, DM}; pg8::StaticOrder S; S.init(M, F2, F.G, (int)blockIdx.x); EpiPlain E{F.A, F2, 1.0f / (S_H2 * S_WUP)};
        pg8::gemm_phase<EpiPlain, pg8::StaticOrder, true, 1>(F.lds + RING_OFF, g, S, E);
        REP(9) { xcd_barrier(bar); pg8::gemm_phase<EpiPlain, pg8::StaticOrder, true, 1>(F.lds + RING_OFF, g, S, E); } } SEAM(9);
    if (IN(10)) { conv_phase(F); REP(10) { xcd_barrier(bar); conv_phase(F); } } SEAM(10);
    if (IN(11)) { pg8::Gemm g{F.ACT, F.WDN, M, DM, DFF, DFF, DFF}; pg8::StaticOrder S; S.init(M, DM, F.G, (int)blockIdx.x); EpiResid E{F.X1, F.MOD + 5 * DM, F.out, 1.0f / (S_ACT * S_WDN)};
        pg8::gemm_phase<EpiResid, pg8::StaticOrder, true, 1>(F.lds + RING_OFF, g, S, E);
        REP(11) { xcd_barrier(bar); pg8::gemm_phase<EpiResid, pg8::StaticOrder, true, 1>(F.lds + RING_OFF, g, S, E); } }
#undef REP
#undef IN
#undef SEAM
}

extern "C" void kernel_launch(void* const* d_in, const int* in_sizes, int n_in, void* d_out, int out_size, void* d_ws, size_t ws_size, hipStream_t stream) {
    static int grid = 0;
    if (grid == 0) {
        if (n_in != 19 || in_sizes[0] != M * DM || out_size != M * DM || ws_size < WS_END) { fprintf(stderr, "kernel_launch: unexpected shapes (n_in %d, in0 %d, out %d, ws %zu < %zu); nothing launched\n", n_in, n_in > 0 ? in_sizes[0] : -1, out_size, ws_size, (size_t)WS_END); grid = -1; return; }
        int dev = 0, cus = 0, per_cu = 0;
        if (hipGetDevice(&dev) != hipSuccess || hipDeviceGetAttribute(&cus, hipDeviceAttributeMultiprocessorCount, dev) != hipSuccess) { fprintf(stderr, "kernel_launch: device query failed\n"); grid = -1; return; }
        if (hipFuncSetAttribute((const void*)mega_fwd, hipFuncAttributeMaxDynamicSharedMemorySize, LDS_BYTES) != hipSuccess) { fprintf(stderr, "kernel_launch: hipFuncSetAttribute failed\n"); grid = -1; return; }
        if (hipOccupancyMaxActiveBlocksPerMultiprocessor(&per_cu, (const void*)mega_fwd, NWAVES * 64, LDS_BYTES) != hipSuccess || per_cu < 1) { fprintf(stderr, "kernel_launch: occupancy query reports %d blocks per CU\n", per_cu); }
        (void)hipGetLastError();
        grid = cus;
    }
    if (grid < 0) return;
    if (hipMemsetAsync((char*)d_ws + WS_CTL, 0, CTL_ZERO_BYTES, stream) != hipSuccess) { fprintf(stderr, "kernel_launch: memset failed\n"); return; }
    Args a{};
    for (int i = 0; i < 19; ++i) a.in[i] = (const float*)d_in[i];
    a.out = (float*)d_out; a.ws = (unsigned char*)d_ws; a.pad = 0;
    for (int li = 0; li < MK_N_LAUNCHES; ++li) {
        if (MK_N_LAUNCHES == 1) { a.ph_lo = 0; a.ph_hi = N_PHASES; } else { a.ph_lo = li; a.ph_hi = li + 1; }
        a.li = li;
        hipLaunchKernelGGL(mega_fwd, dim3(grid), dim3(NWAVES * 64), LDS_BYTES, stream, a);
        const hipError_t le = hipPeekAtLastError();
        if (le != hipSuccess) { fprintf(stderr, "kernel_launch: launch %d failed: %s\n", li, hipGetErrorName(le)); break; }
    }
}
```

```cpp
#include <hip/hip_runtime.h>
#include <cstdio>
#include <cstdint>

#ifndef MK_N_LAUNCHES
#define MK_N_LAUNCHES 1
#endif
#ifndef PROBE_MASK
#define PROBE_MASK 0x0
#endif

namespace pg8 {
#define PG8_LAS __attribute__((address_space(3)))
typedef unsigned short bf16_t;
typedef short bf16x8 __attribute__((ext_vector_type(8)));
typedef float f32x4 __attribute__((ext_vector_type(4)));
typedef float f32x2 __attribute__((ext_vector_type(2)));
typedef unsigned u32x4 __attribute__((ext_vector_type(4)));
typedef unsigned u32x2 __attribute__((ext_vector_type(2)));
constexpr int BM = 256, BK = 64, HALF = 128, HTB = HALF * BK * 2, STAGE_BYTES = 8 * HTB, NXCD = 8, WGM = 8;

__host__ __device__ __forceinline__ int lds_byte(int r, int c) { const int rr = r & 7, ch = c >> 3; return (r >> 3) * 1024 + (16 * ((rr >> 2) + 2 * (ch >> 2)) + 4 * (rr & 3) + ((ch ^ (2 * (rr >> 2))) & 3)) * 16; }
__host__ __device__ __forceinline__ void stage_rc(int b, int& R, int& C) { const int pc = b >> 10, p = (b & 1023) >> 4, q = p >> 4, bb = p & 15, rr = (q & 1) * 4 + (bb >> 2), ch = (q >> 1) * 4 + ((bb & 3) ^ (2 * (q & 1))); R = pc * 8 + rr; C = ch * 8; }
__host__ __device__ __forceinline__ int perm32(int rho) { const int n = rho >> 4, i = rho & 15; return 8 * (i >> 2) + 4 * n + (i & 3); }

struct Unit { int pm, pn; };
struct Gemm { const bf16_t* A; const bf16_t* Bt; int M, N, K, lda, ldb; };

struct StaticOrder {
    int nM, nN, nwg, G, c;
    __host__ __device__ void init(int M, int N, int G_, int c_) { nM = M / BM; nN = N / BM; nwg = nM * nN; G = G_; c = c_; }
    __host__ __device__ bool next(int i, Unit& u) const {
        const long L = (long)i * G + c; if (L >= nwg) return false;
        int wgid = (int)L; { const int q = nwg / NXCD, r = nwg % NXCD, xcd = wgid % NXCD, off = wgid / NXCD; wgid = (xcd < r ? xcd * (q + 1) : r * (q + 1) + (xcd - r) * q) + off; }
        const int nig = WGM * nN, gid = wgid / nig, fm = gid * WGM, gsz = (nM - fm) < WGM ? (nM - fm) : WGM;
        u.pm = fm + ((wgid % nig) % gsz); u.pn = (wgid % nig) / gsz; return true;
    }
    __device__ __forceinline__ void a_ready(const Unit&) const {}
    __device__ __forceinline__ void done(const Unit&) const {}
};
struct MixOrder {
    int fp8, G, c;
    __host__ __device__ static void map(int L, int nwg, int nN, Unit& u) {
        int wgid = L; { const int q = nwg / NXCD, r = nwg % NXCD, xcd = wgid % NXCD, off = wgid / NXCD; wgid = (xcd < r ? xcd * (q + 1) : r * (q + 1) + (xcd - r) * q) + off; }
        const int nig = WGM * nN; u.pm = (wgid / nig) * WGM + ((wgid % nig) % WGM); u.pn = (wgid % nig) / WGM;
    }
    __host__ __device__ bool next(int i, Unit& u) const {
        int L;
        if (!fp8) { L = i * G + c; if (L >= 288) return false; map(L, 288, 9, u); u.pn = u.pn < 8 ? 12 + u.pn : 68; return true; }
        if (G == 256) { if (c >= 32) { if (i >= 8) return false; L = i * 224 + (c - 32); } else { if (i >= 4) return false; L = 1792 + 4 * c + i; } }
        else { L = i * G + c; if (L >= 1920) return false; }
        map(L, 1920, 60, u); u.pn = u.pn < 12 ? u.pn : u.pn + 8; return true;
    }
    __device__ __forceinline__ void a_ready(const Unit&) const {}
    __device__ __forceinline__ void done(const Unit&) const {}
};

__device__ __forceinline__ unsigned cvt_pk_bf16(float lo, float hi) { unsigned r; asm volatile("v_cvt_pk_bf16_f32 %0, %1, %2" : "=v"(r) : "v"(lo), "v"(hi)); return r; }
__device__ __forceinline__ f32x2 gelu_pk(f32x2 v) {
    const f32x2 av = __builtin_elementwise_abs(v), d = av * 0.2316418882f + 1.0f;
    f32x2 t; t.x = __builtin_amdgcn_rcpf(d.x); t.y = __builtin_amdgcn_rcpf(d.y);
    f32x2 q = t * 0.5307027145f + (-0.7265760135f); q = q * t + 0.7107068705f; q = q * t + (-0.142248368f); q = q * t + 0.127414796f; q = q * t;
    const f32x2 s = (v * v) * (-0.72134752044f);
    f32x2 e; e.x = __builtin_amdgcn_exp2f(s.x); e.y = __builtin_amdgcn_exp2f(s.y);
    const f32x2 m = v * (q * e), r = v - m;
    f32x2 o; o.x = v.x < 0.f ? m.x : r.x; o.y = v.y < 0.f ? m.y : r.y; return o;
}
__device__ __forceinline__ float sigmoidf_(float x) { return __builtin_amdgcn_rcpf(1.0f + __builtin_amdgcn_exp2f(-1.4426950408889634f * x)); }
__device__ __forceinline__ float bflo(unsigned w) { return __builtin_bit_cast(float, w << 16); }
__device__ __forceinline__ float bfhi(unsigned w) { return __builtin_bit_cast(float, w & 0xffff0000u); }

typedef int i32x8 __attribute__((ext_vector_type(8)));
typedef int i32x4 __attribute__((ext_vector_type(4)));
template <class Epi, class Sched, bool ALIGN_EPI, int ES = 2>
__device__ __forceinline__ void gemm_phase(PG8_LAS unsigned char* lds, const Gemm g, const Sched& S, const Epi& E) {
    const int tid = threadIdx.x, wid = __builtin_amdgcn_readfirstlane(tid >> 6), lane = tid & 63, wr = wid >> 2, wc = wid & 3, fr = lane & 15, fq = lane >> 4;
    const int K = g.K, nt = K * ES / (BK * 2);
    unsigned voffA[2], voffB[2];
#pragma unroll
    for (int i = 0; i < 2; ++i) { int R, C; stage_rc(tid * 16 + i * 8192, R, C); const int Rb = Epi::PERM ? ((R & ~31) + perm32(R & 31)) : R;
        voffA[i] = (unsigned)(R * g.lda) * (unsigned)ES + (unsigned)C * 2u; voffB[i] = (unsigned)(Rb * g.ldb) * (unsigned)ES + (unsigned)C * 2u; }
    const size_t kstep = (size_t)(BK * 2);
    const size_t hstepA = (size_t)HALF * g.lda * ES, hstepB = (size_t)HALF * g.ldb * ES;
    const size_t tstepA = 2 * hstepA, tstepB = 2 * hstepB;
    const unsigned ldsw = (unsigned)wid * 1024u;
    const int aoff = lds_byte(wr * 64 + fr, fq * 8), boff = lds_byte(wc * 32 + fr, fq * 8);
#define PG8_SA(b, h) (((b) * 2 + (h)) * HTB)
#define PG8_SB(b, h) ((4 + (b) * 2 + (h)) * HTB)
#define PG8_STAGE(bufoff, gbase, voff) do { _Pragma("unroll") for (int _i = 0; _i < 2; ++_i) \
        __builtin_amdgcn_global_load_lds((const unsigned*)((const char*)(gbase) + (voff)[_i]), (PG8_LAS unsigned*)(lds + (bufoff) + ldsw + _i * 8192), 16, 0, 0); } while (0)
#define PG8_CAT(x, y) __builtin_shufflevector(x, y, 0, 1, 2, 3, 4, 5, 6, 7)
#define PG8_LO(v) __builtin_bit_cast(bf16x8, __builtin_shufflevector(v, v, 0, 1, 2, 3))
#define PG8_HI(v) __builtin_bit_cast(bf16x8, __builtin_shufflevector(v, v, 4, 5, 6, 7))
#define PG8_LDA(dst, b, h) do { _Pragma("unroll") for (int m = 0; m < 4; ++m) { const i32x4 _l = *(const PG8_LAS i32x4*)(lds + PG8_SA(b, h) + aoff + m * 2048), _h = *(const PG8_LAS i32x4*)(lds + PG8_SA(b, h) + aoff + m * 2048 + 512); dst[m] = PG8_CAT(_l, _h); } } while (0)
#define PG8_LDB(dst, b, h) do { _Pragma("unroll") for (int n = 0; n < 2; ++n) { const i32x4 _l = *(const PG8_LAS i32x4*)(lds + PG8_SB(b, h) + boff + n * 2048), _h = *(const PG8_LAS i32x4*)(lds + PG8_SB(b, h) + boff + n * 2048 + 512); dst[n] = PG8_CAT(_l, _h); } } while (0)
#define PG8_MMA(ai, bj, At, Bt) do { __builtin_amdgcn_s_setprio(1); _Pragma("unroll") for (int m = 0; m < 4; ++m) _Pragma("unroll") for (int n = 0; n < 2; ++n) { \
        if constexpr (ES == 2) { acc[ai][bj][m][n] = __builtin_amdgcn_mfma_f32_16x16x32_bf16(PG8_LO(Bt[n]), PG8_LO(At[m]), acc[ai][bj][m][n], 0, 0, 0); \
                                 acc[ai][bj][m][n] = __builtin_amdgcn_mfma_f32_16x16x32_bf16(PG8_HI(Bt[n]), PG8_HI(At[m]), acc[ai][bj][m][n], 0, 0, 0); } \
        else asm volatile("v_mfma_f32_16x16x128_f8f6f4 %0, %1, %2, %0" : "+v"(acc[ai][bj][m][n]) : "v"(Bt[n]), "v"(At[m])); } __builtin_amdgcn_s_setprio(0); } while (0)
#define PG8_WAIT_V(n) asm volatile("s_waitcnt vmcnt(" #n ")" ::: "memory")
#define PG8_WAIT_L(n) asm volatile("s_waitcnt lgkmcnt(" #n ")" ::: "memory")
#define PG8_BAR __builtin_amdgcn_s_barrier()
#define PG8_SCHED __builtin_amdgcn_sched_barrier(0)
    Unit cur, nxt; int ui = 0;
    if (!S.next(0, cur)) return;
    f32x4 acc[2][2][4][2];
#pragma unroll
    for (int a = 0; a < 2; ++a)
#pragma unroll
        for (int b = 0; b < 2; ++b)
#pragma unroll
            for (int m = 0; m < 4; ++m)
#pragma unroll
                for (int n = 0; n < 2; ++n) acc[a][b][m][n] = (f32x4){0.f, 0.f, 0.f, 0.f};
    i32x8 At[4], B0[2], B1[2];
    const char* cA = (const char*)g.A + (size_t)cur.pm * tstepA; const char* cB = (const char*)g.Bt + (size_t)cur.pn * tstepB;
    S.a_ready(cur);
    PG8_STAGE(PG8_SB(0, 0), cB, voffB); PG8_STAGE(PG8_SB(0, 1), cB + hstepB, voffB); PG8_STAGE(PG8_SA(0, 0), cA, voffA); PG8_STAGE(PG8_SA(0, 1), cA + hstepA, voffA);
    if (wr == 1) PG8_BAR;
    PG8_WAIT_V(2); PG8_BAR;
    PG8_STAGE(PG8_SB(1, 0), cB + kstep, voffB); PG8_STAGE(PG8_SA(1, 0), cA + kstep, voffA); PG8_STAGE(PG8_SB(1, 1), cB + hstepB + kstep, voffB);
    PG8_WAIT_V(6); PG8_BAR;
    for (;;) {
        const bool has_next = S.next(ui + 1, nxt);
        const char* nA = has_next ? (const char*)g.A + (size_t)nxt.pm * tstepA : cA; const char* nB = has_next ? (const char*)g.Bt + (size_t)nxt.pn * tstepB : cB;
        for (int t = 0; t < nt; t += 2) {
            const bool last = (t == nt - 2);
            const char* a1 = cA + (size_t)(t + 1) * kstep;
            const char* a2 = last ? nA : cA + (size_t)(t + 2) * kstep; const char* b2 = last ? nB : cB + (size_t)(t + 2) * kstep;
            const char* a3 = a2 + kstep; const char* b3 = b2 + kstep;
            if (last && has_next) S.a_ready(nxt);
            if constexpr (Epi::MIDK) { if (t == nt / 2) { if constexpr (ES == 1) asm volatile("s_nop 15\n\ts_nop 15" ::: "memory"); E.mid(acc, cur, wr, wc, fr, fq); } }
            PG8_LDB(B0, 0, 0); PG8_LDB(B1, 0, 1); PG8_SCHED; PG8_LDA(At, 0, 0); PG8_STAGE(PG8_SA(1, 1), a1 + hstepA, voffA);
            PG8_WAIT_V(8); PG8_WAIT_L(0); PG8_BAR; PG8_MMA(0, 0, At, B0); PG8_MMA(0, 1, At, B1); PG8_BAR; PG8_SCHED;
            PG8_LDA(At, 0, 1); PG8_STAGE(PG8_SB(0, 0), b2, voffB); PG8_STAGE(PG8_SB(0, 1), b2 + hstepB, voffB); PG8_STAGE(PG8_SA(0, 0), a2, voffA);
            PG8_WAIT_V(8); PG8_WAIT_L(0); PG8_BAR; PG8_MMA(1, 0, At, B0); PG8_MMA(1, 1, At, B1); PG8_BAR; PG8_SCHED;
            PG8_LDB(B0, 1, 0); PG8_LDB(B1, 1, 1); PG8_SCHED; PG8_LDA(At, 1, 0); PG8_STAGE(PG8_SA(0, 1), a2 + hstepA, voffA);
            PG8_WAIT_V(8); PG8_WAIT_L(0); PG8_BAR; PG8_MMA(0, 0, At, B0); PG8_MMA(0, 1, At, B1); PG8_BAR; PG8_SCHED;
            PG8_LDA(At, 1, 1); PG8_STAGE(PG8_SB(1, 0), b3, voffB); PG8_STAGE(PG8_SB(1, 1), b3 + hstepB, voffB); PG8_STAGE(PG8_SA(1, 0), a3, voffA);
            PG8_WAIT_V(8); PG8_WAIT_L(0); PG8_BAR; PG8_MMA(1, 0, At, B0); PG8_MMA(1, 1, At, B1); PG8_BAR; PG8_SCHED;
        }
        if constexpr (ALIGN_EPI) { if (wr == 0) PG8_BAR; }
        if constexpr (ES == 1) asm volatile("s_nop 15\n\ts_nop 15" ::: "memory");
        E(acc, cur, wr, wc, fr, fq); S.done(cur);
        if (!has_next) break;
#pragma unroll
        for (int a = 0; a < 2; ++a)
#pragma unroll
            for (int b = 0; b < 2; ++b)
#pragma unroll
                for (int m = 0; m < 4; ++m)
#pragma unroll
                    for (int n = 0; n < 2; ++n) acc[a][b][m][n] = (f32x4){0.f, 0.f, 0.f, 0.f};
        cur = nxt; cA = nA; cB = nB; ++ui;
        if constexpr (ALIGN_EPI) { if (wr == 1) PG8_BAR; }
    }
    PG8_WAIT_V(0);
    if constexpr (!ALIGN_EPI) { if (wr == 0) PG8_BAR; }
    PG8_BAR;
#undef PG8_SA
#undef PG8_SB
#undef PG8_STAGE
#undef PG8_LDA
#undef PG8_CAT
#undef PG8_LO
#undef PG8_HI
#undef PG8_LDB
#undef PG8_MMA
#undef PG8_WAIT_V
#undef PG8_WAIT_L
#undef PG8_BAR
#undef PG8_SCHED
}
}

constexpr int NWAVES = 8;
constexpr int BATCH = 4, SEQ = 2048, DM = 4096, M = BATCH * SEQ;
constexpr int NH = 16, HD = 128, NKV = 4, ATTW = 2048, KVW = 512, IH = 32, IDIM = 64, TOPK = 256;
constexpr int GMW = 2048, GMG = 8, GMGW = 256, GMC = 128, DFF = 11008, F2 = 2 * DFF;
constexpr int IN_W = 17504, MODW = 6 * DM;
constexpr float EPS = 1e-6f;
constexpr int PQ = 0, PK = 2048, PV = 2560, PQI = 3072, PGU = 5120, PGV = 7168, PGA = 9216, PGB = 13312, PKI = 17408, PWI = 17472, PNP = 17664;
constexpr int SQ = 0, SK = 2048, SV = 2560, SQI = 3072, SKI = 5120, SWI = 5184, SGU = 5216, SGV = 7264, SGA = 9312, SGB = 13408;

constexpr size_t MiB = 1u << 20;
constexpr size_t WS_CTL = 0, CTL_ZERO_BYTES = 2 * MiB;
constexpr size_t WS_MOD = 1 * MiB;
constexpr size_t WS_WIN = 2 * MiB;
constexpr size_t WS_WA = 140 * MiB, WS_WB = 156 * MiB;
constexpr size_t WS_WOUT = 172 * MiB;
constexpr size_t WS_WUP = 204 * MiB;
constexpr size_t WS_WDN = 376 * MiB;
constexpr size_t WS_H = 462 * MiB;
constexpr size_t WS_X1 = 526 * MiB;
constexpr size_t WS_PROJ = 654 * MiB;
constexpr size_t WS_MASK = 930 * MiB;
constexpr size_t WS_RS = 932 * MiB;
constexpr size_t WS_SWT = 932 * MiB + 65536;
constexpr size_t WS_VT = 933 * MiB;
constexpr size_t WS_YA = 941 * MiB, WS_YB = 973 * MiB;
constexpr size_t WS_MRG = 1005 * MiB;
constexpr size_t WS_TMP = 1069 * MiB;
constexpr size_t WS_A = 654 * MiB;
constexpr size_t WS_ACT = 998 * MiB;
constexpr size_t WS_WINB = 1197 * MiB;
constexpr size_t WS_END = 1336 * MiB;
static_assert(WS_WIN + (size_t)PNP * DM * 2 <= WS_WA && WS_WUP + (size_t)F2 * DM * 2 <= WS_WDN && WS_WDN + (size_t)DM * DFF * 2 <= WS_H, "ws map 1");
static_assert(WS_PROJ + (size_t)M * PNP * 2 <= WS_MASK && WS_A + (size_t)M * F2 * 2 <= WS_ACT && WS_ACT + (size_t)M * DFF * 2 <= WS_END && WS_TMP + (size_t)M * DM * 4 <= WS_END, "ws map 2");
constexpr int CW_TMO = 0, CW_CODE = 1, CW_BAR = 4096;

constexpr int RING_OFF = 0, RING_BYTES = 131072;
constexpr int LDSCTL_OFF = RING_BYTES + 8192, MISC_OFF = LDSCTL_OFF + 320;
constexpr int LDS_BYTES = 147456;
static_assert(MISC_OFF + 128 <= LDS_BYTES, "LDS map");

#define GAS __attribute__((address_space(1)))
#define LAS __attribute__((address_space(3)))
typedef unsigned short bf16;
typedef unsigned v4u __attribute__((ext_vector_type(4)));
typedef unsigned v2u __attribute__((ext_vector_type(2)));
typedef float f32x4 __attribute__((ext_vector_type(4)));
typedef float f32x16 __attribute__((ext_vector_type(16)));
typedef short bf16x8 __attribute__((ext_vector_type(8)));
typedef short bf16x4 __attribute__((ext_vector_type(4)));
typedef GAS unsigned gu32;
#define RLX_AGENT __ATOMIC_RELAXED, __HIP_MEMORY_SCOPE_AGENT
#define LDS_WAIT() asm volatile("s_waitcnt lgkmcnt(0)" ::: "memory")
#define VM_WAIT() asm volatile("s_waitcnt vmcnt(0)" ::: "memory")
__device__ __forceinline__ unsigned f2bf(float f) { unsigned u = __builtin_bit_cast(unsigned, f); return (u + 0x7fffu + ((u >> 16) & 1u)) >> 16; }
__device__ __forceinline__ unsigned pk2(float lo, float hi) { return pg8::cvt_pk_bf16(lo, hi); }
__device__ __forceinline__ float bf2f(bf16 h) { return __builtin_bit_cast(float, (unsigned)h << 16); }
using pg8::bflo; using pg8::bfhi;
constexpr float S_H2 = 16.f, S_WUP = 1024.f, S_ACT = 4.f, S_WDN = 1024.f, S_A = 16.f, S_YA = 16.f, S_YB = 8.f, S_MRG = 16.f, S_WA = 1024.f, S_WB = 1024.f, S_WOUT = 1024.f;
__device__ __forceinline__ float clamp448(float x) { return __builtin_amdgcn_fmed3f(x, -448.f, 448.f); }
__device__ __forceinline__ unsigned pk4_fp8(float a, float b, float c, float d) {
    int w = __builtin_amdgcn_cvt_pk_fp8_f32(clamp448(a), clamp448(b), 0, false);
    w = __builtin_amdgcn_cvt_pk_fp8_f32(clamp448(c), clamp448(d), w, true);
    return (unsigned)w;
}

#define XB_TMO      128
#define XB_XCNT(j)  (256  + 64 * (j))
#define XB_XSUB(j)  (1280 + 64 * (j))
#define XB_XGEN(j)  (2304 + 64 * (j))
#define XB_TOP      3328
#define XB_TOPGEN   3392
#define XCD_BAR_WORDS 3456
#define XB_SPIN_CAP (1u << 18)
__device__ __forceinline__ unsigned xb_ld(unsigned* p)              { return __hip_atomic_load(p, __ATOMIC_RELAXED, __HIP_MEMORY_SCOPE_AGENT); }
__device__ __forceinline__ unsigned xb_add(unsigned* p, unsigned v) { return __hip_atomic_fetch_add(p, v, __ATOMIC_RELAXED, __HIP_MEMORY_SCOPE_AGENT); }
__device__ __forceinline__ unsigned xb_xcc_id() { return (unsigned)__builtin_amdgcn_s_getreg((3 << 11) | 20) & 0xFu; }
#define XB_SPIN(cond, bar) do { unsigned _sp = 0; while (cond) { __builtin_amdgcn_s_sleep(1); \
    if ((++_sp & 255u) == 0u) { if (xb_ld(&(bar)[XB_TMO])) break; if (_sp > XB_SPIN_CAP) { atomicAdd(&(bar)[XB_TMO], 1u); break; } } } } while (0)
struct XcdBarrier { unsigned* bar; unsigned x; volatile LAS unsigned* st; };
__device__ __forceinline__ XcdBarrier xcd_barrier_post(unsigned* bar, volatile LAS unsigned* st) {
    XcdBarrier b; b.bar = bar; b.x = xb_xcc_id(); b.st = st;
    if (threadIdx.x == 0) (void)xb_add(&bar[XB_XCNT(b.x)], 1u);
    return b;
}
__device__ __forceinline__ void xcd_barrier_complete(unsigned* bar, unsigned x, unsigned& nloc, unsigned& nx) {
    const unsigned G = gridDim.x * gridDim.y * gridDim.z;
    unsigned sum, cnt, mine, sp = 0u;
    for (;;) {
        sum = 0u; cnt = 0u; mine = 0u;
#pragma unroll
        for (unsigned j = 0; j < 16; ++j) { const unsigned c = xb_ld(&bar[XB_XCNT(j)]); sum += c; cnt += (c > 0u) ? 1u : 0u; mine = (j == x) ? c : mine; }
        if (sum == G) break;
        __builtin_amdgcn_s_sleep(1);
        if ((++sp & 255u) == 0u) { if (xb_ld(&bar[XB_TMO])) break; if (sp > XB_SPIN_CAP) { atomicAdd(&bar[XB_TMO], 1u); break; } }
    }
    nloc = mine > 0u ? mine : 1u; nx = cnt > 0u ? cnt : 1u;
}
__device__ __forceinline__ void xcd_barrier(const XcdBarrier& b) {
    asm volatile("s_waitcnt vmcnt(0)" ::: "memory");
    __syncthreads();
    if (threadIdx.x == 0) {
        unsigned* bar = b.bar;
        __builtin_amdgcn_s_waitcnt(0);
        unsigned nloc = b.st[0], nx = b.st[1];
        if (nloc == 0u) { xcd_barrier_complete(bar, b.x, nloc, nx); b.st[0] = nloc; b.st[1] = nx; }
        const unsigned old = xb_add(&bar[XB_XSUB(b.x)], 1u);
        const unsigned gen = old / nloc;
        if (old + 1u == (gen + 1u) * nloc) {
            __builtin_amdgcn_fence(__ATOMIC_RELEASE, "agent");
            asm volatile("s_waitcnt vmcnt(0)" ::: "memory");
            const unsigned og = xb_add(&bar[XB_TOP], 1u);
            const unsigned tg = og / nx;
            if (og + 1u == (tg + 1u) * nx) xb_add(&bar[XB_TOPGEN], 1u);
            else XB_SPIN(xb_ld(&bar[XB_TOPGEN]) == tg, bar);
            __builtin_amdgcn_fence(__ATOMIC_ACQUIRE, "agent");
            xb_add(&bar[XB_XGEN(b.x)], 1u);
            asm volatile("s_waitcnt vmcnt(0)" ::: "memory");
        } else {
            XB_SPIN(xb_ld(&bar[XB_XGEN(b.x)]) == gen, bar);
            __builtin_amdgcn_fence(__ATOMIC_ACQUIRE, "agent");
            asm volatile("s_waitcnt vmcnt(0)" ::: "memory");
        }
    }
    __syncthreads();
}

struct Frame {
    LAS unsigned char* lds;
    volatile LAS unsigned* MISC;
    gu32* ctl;
    int tid, lane, wave, G, gw, NGW;
    const float *x, *c, *ada_w, *ada_b, *n1g, *w_in, *qng, *kng, *sgg, *sgw, *sgb, *w_a, *w_b, *w_out, *n2g, *w_up, *cvw, *cvb, *w_dn;
    float* out;
    float *MOD, *PART; bf16 *WINB; unsigned char* H8A; bf16 *WIN, *WA, *WB, *WOUT, *WUP, *WDN, *H, *PROJ, *VT, *YA, *YB, *MRG, *A, *ACT; float *X1, *TMP, *RS, *SWT; unsigned* MASK;
};
__device__ __forceinline__ float wave_sum(float v) {
#pragma unroll
    for (int o = 1; o < 64; o <<= 1) v += __shfl_xor(v, o);
    return v;
}

__device__ __forceinline__ int win_dst_row(int n) {
    if (n < SKI) return n;
    if (n < SWI) return PKI + (n - SKI);
    if (n < SGU) return PWI + (n - SWI);
    return PGU + (n - SGU);
}
__device__ __forceinline__ void gemv_item(Frame& F, int item) {
    const int nb = item % 96, ks = item / 96, n0 = nb * 256 + 4 * F.lane, k0 = ks * 64;
    float cs[4];
#pragma unroll
    for (int b = 0; b < 4; ++b) { const float cv = F.c[b * DM + k0 + F.lane]; cs[b] = cv * pg8::sigmoidf_(cv); }
    f32x4 acc[4];
#pragma unroll
    for (int b = 0; b < 4; ++b) acc[b] = (f32x4){0.f, 0.f, 0.f, 0.f};
    const float* wp = F.ada_w + (size_t)k0 * MODW + n0;
#pragma unroll 16
    for (int k = 0; k < 64; ++k) { const f32x4 w = *(const GAS f32x4*)(wp + (size_t)k * MODW);
#pragma unroll
        for (int b = 0; b < 4; ++b) { const float s = __builtin_bit_cast(float, __builtin_amdgcn_readlane(__builtin_bit_cast(int, cs[b]), k)); acc[b] += w * s; } }
#pragma unroll
    for (int b = 0; b < 4; ++b) *(GAS f32x4*)(F.PART + (size_t)(ks * 4 + b) * MODW + n0) = acc[b];
}
__device__ __forceinline__ void mod_reduce(Frame& F) {
    for (int i = F.gw * 64 + F.lane; i < 4 * (MODW / 4); i += F.NGW * 64) { const int b = i / (MODW / 4), n0 = 4 * (i % (MODW / 4));
        f32x4 a = *(const GAS f32x4*)(F.ada_b + n0);
#pragma unroll 16
        for (int ks = 0; ks < 64; ++ks) a += *(const GAS f32x4*)(F.PART + (size_t)(ks * 4 + b) * MODW + n0);
        *(GAS f32x4*)(F.MOD + b * MODW + n0) = a; }
}
struct TrItem { const float* src; unsigned char* d8; bf16* db; int Nsrc, ldk, drow0, k0; float scale; };
__device__ __forceinline__ void tr_decode(Frame& F, int r, TrItem& t) {
    constexpr int P_IN = (DM / 128) * (IN_W / 32), P_A = (ATTW / 128) * (DM / 32), P_B = (GMW / 128) * (DM / 32), P_O = (DM / 128) * (DM / 32), P_UP = (DM / 128) * (F2 / 32);
    const float* W; int Nsrc, nblk, ldk, drow; unsigned char* d8; bf16* db = nullptr; float sc; bool up = false, in = false;
    if (r < P_IN) { W = F.w_in; Nsrc = IN_W; nblk = IN_W / 32; d8 = (unsigned char*)F.WIN; ldk = DM; sc = 1024.f; in = true; }
    else if ((r -= P_IN) < P_A) { W = F.w_a; Nsrc = DM; nblk = DM / 32; d8 = (unsigned char*)F.WA; ldk = 2 * ATTW; sc = S_WA; }
    else if ((r -= P_A) < P_B) { W = F.w_b; Nsrc = DM; nblk = DM / 32; d8 = (unsigned char*)F.WA + ATTW; ldk = 2 * ATTW; sc = S_WB; }
    else if ((r -= P_B) < P_O) { W = F.w_out; Nsrc = DM; nblk = DM / 32; d8 = (unsigned char*)F.WOUT; ldk = DM; sc = S_WOUT; }
    else if ((r -= P_O) < P_UP) { W = F.w_up; Nsrc = F2; nblk = F2 / 32; d8 = (unsigned char*)F.WUP; ldk = DM; sc = S_WUP; up = true; }
    else { r -= P_UP; W = F.w_dn; Nsrc = DM; nblk = DM / 32; d8 = (unsigned char*)F.WDN; ldk = DFF; sc = S_WDN; }
    const int kb = r / nblk, n = 32 * (r % nblk);
    drow = n;
    if (in) { drow = win_dst_row(n); if (n >= SQI && n < SGU) db = F.WINB; }
    if (up) { const int ch = n < DFF ? n : n - DFF; drow = (ch >> 7) * 256 + (ch & 127) + (n < DFF ? 0 : 128); }
    t.src = W + (size_t)(128 * kb) * Nsrc + n; t.d8 = d8; t.db = db; t.Nsrc = Nsrc; t.ldk = ldk; t.drow0 = drow; t.k0 = 128 * kb; t.scale = sc;
}
__device__ __forceinline__ void tr_load(const TrItem& t, int half, f32x4 (&v)[8], int lane) {
    const float* p = t.src + (size_t)(64 * half + (lane >> 3)) * t.Nsrc + 4 * (lane & 7);
#pragma unroll
    for (int i = 0; i < 8; ++i) v[i] = *(const GAS f32x4*)(p + (size_t)(8 * i) * t.Nsrc);
}
__device__ __forceinline__ void tr_finish(const TrItem& t, int half, const f32x4 (&v)[8], LAS float* scr, int lane) {
#pragma unroll
    for (int i = 0; i < 8; ++i) { LAS float* s = scr + (8 * i + (lane >> 3)) * 33 + 4 * (lane & 7); s[0] = v[i].x; s[1] = v[i].y; s[2] = v[i].z; s[3] = v[i].w; }
    LDS_WAIT(); asm volatile("" ::: "memory");
    const int c = lane & 7, kcol = t.k0 + 64 * half + 8 * c; const float sc = t.scale;
#pragma unroll
    for (int j = 0; j < 4; ++j) { const int n = (lane >> 3) + 8 * j; const LAS float* s = scr + (8 * c) * 33 + n;
        const float e0 = s[0 * 33], e1 = s[1 * 33], e2 = s[2 * 33], e3 = s[3 * 33], e4 = s[4 * 33], e5 = s[5 * 33], e6 = s[6 * 33], e7 = s[7 * 33];
        v2u o; o.x = pk4_fp8(e0 * sc, e1 * sc, e2 * sc, e3 * sc); o.y = pk4_fp8(e4 * sc, e5 * sc, e6 * sc, e7 * sc);
        *(GAS v2u*)(t.d8 + (size_t)(t.drow0 + n) * t.ldk + kcol) = o;
        if (t.db) { v4u ob; ob.x = pk2(e0, e1); ob.y = pk2(e2, e3); ob.z = pk2(e4, e5); ob.w = pk2(e6, e7); *(GAS v4u*)(t.db + (size_t)(t.drow0 + n) * t.ldk + kcol) = ob; } }
    LDS_WAIT(); asm volatile("" ::: "memory");
}
__device__ __forceinline__ void p0_prologue(Frame& F, bool with_gemv = true) {
    LAS float* scr = (LAS float*)(F.lds + RING_OFF + F.wave * 16384);
    constexpr int I_GV = 96 * 64;
    constexpr int NPAIR = (DM / 128) * (IN_W / 32) + (ATTW / 128) * (DM / 32) + (GMW / 128) * (DM / 32) + (DM / 128) * (DM / 32) + (DM / 128) * (F2 / 32) + (DFF / 128) * (DM / 32);
    if (with_gemv) for (int it = F.gw; it < I_GV; it += F.NGW) gemv_item(F, it);
    {
        TrItem A, B; f32x4 a0[8], a1[8], b0[8], b1[8];
        int r = F.gw; bool hasA = r < NPAIR;
        if (hasA) { tr_decode(F, r, A); tr_load(A, 0, a0, F.lane); tr_load(A, 1, a1, F.lane); }
        while (hasA) {
            const int rb = r + F.NGW; const bool hasB = rb < NPAIR;
            if (hasB) { tr_decode(F, rb, B); tr_load(B, 0, b0, F.lane); tr_load(B, 1, b1, F.lane); }
            tr_finish(A, 0, a0, scr, F.lane); tr_finish(A, 1, a1, scr, F.lane);
            if (!hasB) break;
            r = rb + F.NGW; hasA = r < NPAIR;
            if (hasA) { tr_decode(F, r, A); tr_load(A, 0, a0, F.lane); tr_load(A, 1, a1, F.lane); }
            tr_finish(B, 0, b0, scr, F.lane); tr_finish(B, 1, b1, scr, F.lane);
        }
    }
    { const size_t n16 = (size_t)(PNP - IN_W) * DM / 16; GAS v4u* p = (GAS v4u*)((unsigned char*)F.WIN + (size_t)IN_W * DM);
      for (size_t i = (size_t)F.gw * 64 + F.lane; i < n16; i += (size_t)F.NGW * 64) p[i] = (v4u){0u, 0u, 0u, 0u};
      GAS v4u* pb = (GAS v4u*)(F.WINB + (size_t)IN_W * DM);
      for (size_t i = (size_t)F.gw * 64 + F.lane; i < 2 * n16; i += (size_t)F.NGW * 64) pb[i] = (v4u){0u, 0u, 0u, 0u}; }
}

template <int FP8 = 0>
__device__ __forceinline__ void norm_rows(Frame& F, const float* X, const float* gain, int sh_off, int sc_off, void* Ov, unsigned char* O8 = nullptr) {
    LAS f32x4* CA = (LAS f32x4*)F.lds; LAS f32x4* CB = (LAS f32x4*)(F.lds + 16384);
    for (int blk = blockIdx.x; blk < M / 32; blk += F.G) {
        const int b = (blk * 32) >> 11;
        __syncthreads();
        for (int i = F.tid; i < DM / 4; i += NWAVES * 64) { const f32x4 g = ((const GAS f32x4*)gain)[i], sh = ((const GAS f32x4*)(F.MOD + b * MODW + sh_off))[i], sc = ((const GAS f32x4*)(F.MOD + b * MODW + sc_off))[i];
            CA[i] = g * (sc + 1.0f); CB[i] = sh; }
        __syncthreads();
        const int m0 = blk * 32 + 4 * F.wave;
        f32x4 va[16], vb[16];
#define NR_LOAD(v, m_) do { const GAS f32x4* xr = (const GAS f32x4*)(X + (size_t)(m_) * DM) + F.lane; _Pragma("unroll") for (int j = 0; j < 16; ++j) v[j] = xr[64 * j]; } while (0)
#define NR_FIN(v, m_) do { float s_ = 0.f; _Pragma("unroll") for (int j = 0; j < 16; ++j) s_ += (v[j].x * v[j].x + v[j].y * v[j].y) + (v[j].z * v[j].z + v[j].w * v[j].w); \
            const float rstd = 1.0f / sqrtf(wave_sum(s_) * (1.f / DM) + EPS); \
            GAS v2u* o8 = (GAS v2u*)((bf16*)Ov + (size_t)(m_) * DM) + F.lane; GAS unsigned* o4 = (GAS unsigned*)((FP8 == 2 ? O8 : (unsigned char*)Ov) + (size_t)(m_) * DM) + F.lane; \
            _Pragma("unroll") for (int j = 0; j < 16; ++j) { const f32x4 y = (v[j] * rstd) * CA[64 * j + F.lane] + CB[64 * j + F.lane]; \
                if constexpr (FP8 != 0) o4[64 * j] = pk4_fp8(y.x * S_H2, y.y * S_H2, y.z * S_H2, y.w * S_H2); \
                if constexpr (FP8 != 1) { v2u w_; w_.x = pk2(y.x, y.y); w_.y = pk2(y.z, y.w); o8[64 * j] = w_; } \
                if ((j & 3) == 3) asm volatile("" ::: "memory"); } } while (0)
        NR_LOAD(va, m0); NR_LOAD(vb, m0 + 1); NR_FIN(va, m0); NR_LOAD(va, m0 + 2); NR_FIN(vb, m0 + 1); NR_LOAD(vb, m0 + 3); NR_FIN(va, m0 + 2); NR_FIN(vb, m0 + 3);
#undef NR_LOAD
#undef NR_FIN
    }
}

__device__ __forceinline__ unsigned sortable(float f) { const unsigned u = __builtin_bit_cast(unsigned, f); return u ^ ((unsigned)((int)u >> 31) | 0x80000000u); }
__device__ __forceinline__ void select_topk(const unsigned (&sc)[32], GAS v2u* mrow, int lane) {
    unsigned thr = 0u;
    for (int bit = 31; bit >= 0; --bit) {
        const unsigned cand = thr | (1u << bit); int cnt = 0;
#pragma unroll
        for (int jp = 0; jp < 32; ++jp) cnt += __popcll(__ballot(sc[jp] >= cand));
        if (cnt >= TOPK) thr = cand;
    }
    int cgt = 0;
#pragma unroll
    for (int jp = 0; jp < 32; ++jp) cgt += __popcll(__ballot(sc[jp] > thr));
    const int need = TOPK - cgt; int seen = 0;
    unsigned mylo = 0u, myhi = 0u;
    const unsigned long long lt = (lane == 0) ? 0ull : (~0ull >> (64 - lane));
#pragma unroll
    for (int jp = 0; jp < 32; ++jp) {
        unsigned long long sel = __ballot(sc[jp] > thr);
        const unsigned long long eq = __ballot(sc[jp] == thr);
        if (eq) { const bool take = (sc[jp] == thr) && (seen + __popcll(eq & lt) < need); sel |= __ballot(take); seen += __popcll(eq); }
        if (lane == jp) { mylo = (unsigned)sel; myhi = (unsigned)(sel >> 32); }
    }
    if (lane < 32) { v2u w; w.x = mylo; w.y = myhi; mrow[lane] = w; }
}
__device__ __forceinline__ void idx_block(Frame& F, int b, int blk) {
    const int lane = F.lane, w = F.wave, hi = lane >> 5, l31 = lane & 31, tid = F.tid;
    const int t0 = blk * 8, tq = t0 + w;
    const size_t row = (size_t)b * SEQ + tq;
    GAS v2u* mrow = (GAS v2u*)(F.MASK + row * 64);
    if (t0 < TOPK) {
        if (lane < 32) { const int k0 = 64 * lane; v2u mw;
            mw.x = (tq >= k0 + 31) ? 0xffffffffu : (tq < k0 ? 0u : ((2u << (tq - k0)) - 1u));
            mw.y = (tq >= k0 + 63) ? 0xffffffffu : (tq < k0 + 32 ? 0u : ((2u << (tq - k0 - 32)) - 1u));
            mrow[lane] = mw; }
        return;
    }
    const int nt = (t0 + 7) / 64 + 1;
    const bf16* prow = F.PROJ + row * PNP;
    bf16x8 qa[4]; float wv[16];
#pragma unroll
    for (int ks = 0; ks < 4; ++ks) qa[ks] = *(const GAS bf16x8*)(prow + PQI + l31 * 64 + 16 * ks + 8 * hi);
#pragma unroll
    for (int r = 0; r < 16; ++r) wv[r] = bf2f(prow[PWI + (r & 3) + 8 * (r >> 2) + 4 * hi]);
    const bf16* ksrc = F.PROJ + ((size_t)b * SEQ + (tid >> 3)) * PNP + PKI + 8 * (tid & 7);
    const int kdst = (tid >> 3) * 128 + (((tid & 7) ^ ((tid >> 3) & 7)) << 4);
    const int krd = l31 * 128;
    unsigned sc[32];
    __syncthreads();
    v4u stg = *(const GAS v4u*)ksrc;
#pragma unroll
    for (int kt = 0; kt < 32; ++kt) {
        if (kt < nt) {
            LAS unsigned char* kb_base = F.lds + (kt & 1) * 8192;
            *(LAS v4u*)(kb_base + kdst) = stg;
            if (kt + 1 < nt) stg = *(const GAS v4u*)(ksrc + (size_t)(kt + 1) * 64 * PNP);
            LDS_WAIT(); __builtin_amdgcn_s_barrier(); asm volatile("" ::: "memory");
            float s01[2];
#pragma unroll
            for (int h = 0; h < 2; ++h) {
                f32x16 acc;
#pragma unroll
                for (int r = 0; r < 16; ++r) acc[r] = 0.f;
#pragma unroll
                for (int ks = 0; ks < 4; ++ks) { const bf16x8 kf = *(const LAS bf16x8*)(kb_base + h * 4096 + krd + (((2 * ks + hi) ^ (l31 & 7)) << 4));
                    acc = __builtin_amdgcn_mfma_f32_32x32x16_bf16(qa[ks], kf, acc, 0, 0, 0); }
                float x = 0.f;
#pragma unroll
                for (int r = 0; r < 16; ++r) x += wv[r] * fmaxf(acc[r], 0.f);
                x += __shfl_xor(x, 32);
                s01[h] = x;
            }
            const float mine = (lane < 32 ? s01[0] : s01[1]) + 0.0f;
            sc[kt] = (64 * kt + lane <= tq) ? sortable(mine) : 0u;
        } else sc[kt] = 0u;
    }
    select_topk(sc, mrow, lane);
}
constexpr float QSCALE = 0.08838834764831845f * 1.4426950408889634f;
__device__ __forceinline__ void qknorm_row(Frame& F, int row) {
    bf16* prow = F.PROJ + (size_t)row * PNP; const int lane = F.lane;
    {
        GAS v4u* p = (GAS v4u*)(prow + PQ + 32 * lane); v4u w[4]; float ss = 0.f;
#pragma unroll
        for (int i = 0; i < 4; ++i) { w[i] = p[i];
#pragma unroll
            for (int j = 0; j < 4; ++j) { const float a = bflo(w[i][j]), c = bfhi(w[i][j]); ss += a * a + c * c; } }
        ss += __shfl_xor(ss, 1); ss += __shfl_xor(ss, 2);
        const float r = QSCALE / sqrtf(ss * (1.f / HD) + EPS); const float* g = F.qng + 32 * (lane & 3);
#pragma unroll
        for (int i = 0; i < 4; ++i) { v4u o;
#pragma unroll
            for (int j = 0; j < 4; ++j) o[j] = pk2(bflo(w[i][j]) * r * g[8 * i + 2 * j], bfhi(w[i][j]) * r * g[8 * i + 2 * j + 1]);
            p[i] = o; }
    }
    {
        GAS v4u* p = (GAS v4u*)(prow + PK + 8 * lane); const v4u w = *p; float ss = 0.f;
#pragma unroll
        for (int j = 0; j < 4; ++j) { const float a = bflo(w[j]), c = bfhi(w[j]); ss += a * a + c * c; }
        ss += __shfl_xor(ss, 1); ss += __shfl_xor(ss, 2); ss += __shfl_xor(ss, 4); ss += __shfl_xor(ss, 8);
        const float r = 1.0f / sqrtf(ss * (1.f / HD) + EPS); const float* g = F.kng + 8 * (lane & 15); v4u o;
#pragma unroll
        for (int j = 0; j < 4; ++j) o[j] = pk2(bflo(w[j]) * r * g[2 * j], bfhi(w[j]) * r * g[2 * j + 1]);
        *p = o;
    }
    {
        const GAS v4u* p = (const GAS v4u*)(prow + PGV + 32 * lane); float ss = 0.f;
#pragma unroll
        for (int i = 0; i < 4; ++i) { const v4u w = p[i];
#pragma unroll
            for (int j = 0; j < 4; ++j) { const float a = bflo(w[j]), c = bfhi(w[j]); ss += a * a + c * c; } }
        ss = wave_sum(ss);
        if (lane == 0) F.RS[row] = 1.0f / sqrtf(ss * (1.f / GMW) + EPS);
    }
}
__device__ __forceinline__ void vt_item(Frame& F, int item) {
    const int s8 = item & 255, dh = (item >> 8) & 1, g = (item >> 9) & 3, b = item >> 11, d = 64 * dh + F.lane;
    const bf16* src = F.PROJ + (size_t)(b * SEQ + 8 * s8) * PNP + PV + g * HD + d;
    unsigned e[8];
#pragma unroll
    for (int j = 0; j < 8; ++j) e[j] = src[(size_t)j * PNP];
    v4u o; o.x = e[0] | (e[1] << 16); o.y = e[2] | (e[3] << 16); o.z = e[4] | (e[5] << 16); o.w = e[6] | (e[7] << 16);
    *(GAS v4u*)(F.VT + ((size_t)((b * NKV + g) * HD + d)) * SEQ + 8 * s8) = o;
}

constexpr int AT_KSTR = 272, AT_VSTR = 136, AT_TILE = 17408;
#define RAW_BARRIER() do { LDS_WAIT(); __builtin_amdgcn_s_barrier(); asm volatile("" ::: "memory"); } while (0)
__device__ __forceinline__ void attn_block(Frame& F, int b, int g, int qb, float sbound) {
    const int lane = F.lane, w = F.wave, hi = lane >> 5, l31 = lane & 31, tid = F.tid;
    const int hh = 4 * g + (w >> 1), tw0 = qb * 64 + 32 * (w & 1), t = tw0 + l31;
    const size_t row = (size_t)b * SEQ + t;
    const float slope2 = exp2f(-0.5f * (float)(hh + 1)) * 1.4426950408889634f;
    bf16x8 qf[8];
#pragma unroll
    for (int ks = 0; ks < 8; ++ks) qf[ks] = *(const GAS bf16x8*)(F.PROJ + row * PNP + PQ + hh * HD + 16 * ks + 8 * hi);
    f32x16 o[4];
#pragma unroll
    for (int db = 0; db < 4; ++db)
#pragma unroll
        for (int r = 0; r < 16; ++r) o[db][r] = 0.f;
    float m = -1e30f, lsum = 0.f;
    const bf16* ksrc = F.PROJ + ((size_t)b * SEQ + (tid >> 4)) * PNP + PK + g * HD + 8 * (tid & 15);
    const int kdst = (tid >> 4) * AT_KSTR + (tid & 15) * 16;
    const bf16* vsrc = F.VT + ((size_t)((b * NKV + g) * HD + (tid >> 3))) * SEQ + 8 * (tid & 7);
    const int vdst = 2 * AT_TILE + (tid >> 3) * AT_VSTR + (tid & 7) * 16;
    const unsigned* mbase = F.MASK + row * 64;
    LAS unsigned char* L = F.lds;
    v4u sk0, sk1, sv0, sv1; v2u mw, mwn;
#define AT_LOAD(kt_) do { sk0 = *(const GAS v4u*)(ksrc + (size_t)(64 * (kt_)) * PNP); sk1 = *(const GAS v4u*)(ksrc + (size_t)(64 * (kt_) + 32) * PNP); \
        sv0 = *(const GAS v4u*)(vsrc + 64 * (kt_)); sv1 = *(const GAS v4u*)(vsrc + (size_t)64 * SEQ + 64 * (kt_)); mwn = *(const GAS v2u*)(mbase + 2 * (kt_)); } while (0)
#define AT_STORE(bf_) do { *(LAS v4u*)(L + (bf_) * AT_TILE + kdst) = sk0; *(LAS v4u*)(L + (bf_) * AT_TILE + kdst + 32 * AT_KSTR) = sk1; \
        LAS unsigned char* _v = L + (bf_) * AT_TILE + vdst; *(LAS v2u*)_v = (v2u){sv0.x, sv0.y}; *(LAS v2u*)(_v + 8) = (v2u){sv0.z, sv0.w}; \
        *(LAS v2u*)(_v + 64 * AT_VSTR) = (v2u){sv1.x, sv1.y}; *(LAS v2u*)(_v + 64 * AT_VSTR + 8) = (v2u){sv1.z, sv1.w}; } while (0)
    RAW_BARRIER();
    AT_LOAD(qb); AT_STORE(0); mw = mwn;
    int buf = 0; bool dead = false;
    for (int kt = qb; kt >= 0; --kt) {
        if (kt > 0) AT_LOAD(kt - 1);
        RAW_BARRIER();
        if (!dead) {
            const float dmin = (float)(tw0 - (64 * kt + 63));
            dead = __all((sbound - slope2 * dmin) < (m - 40.0f));
        }
        if (!dead) {
            const LAS unsigned char* kb_ = L + buf * AT_TILE + l31 * AT_KSTR + hi * 16;
            const LAS unsigned char* vb_ = L + buf * AT_TILE + 2 * AT_TILE + l31 * AT_VSTR + hi * 8;
            f32x16 p[2];
#pragma unroll
            for (int kb = 0; kb < 2; ++kb) {
#pragma unroll
                for (int r = 0; r < 16; ++r) p[kb][r] = 0.f;
#pragma unroll
                for (int ks = 0; ks < 8; ++ks) { const bf16x8 kf = *(const LAS bf16x8*)(kb_ + kb * 32 * AT_KSTR + ks * 32); p[kb] = __builtin_amdgcn_mfma_f32_32x32x16_bf16(kf, qf[ks], p[kb], 0, 0, 0); }
            }
            const float base = -slope2 * (float)(t - 64 * kt - 4 * hi);
            float rmax = -3e30f;
#pragma unroll
            for (int kb = 0; kb < 2; ++kb) { const unsigned mword = (kb ? mw.y : mw.x) >> (4 * hi);
#pragma unroll
                for (int r = 0; r < 16; ++r) { const int ko = (r & 3) + 8 * (r >> 2);
                    float sv = p[kb][r] + slope2 * (float)(32 * kb + ko);
                    sv = ((mword >> ko) & 1u) ? sv : -2e30f; p[kb][r] = sv; rmax = fmaxf(rmax, sv); } }
            rmax += base; rmax = fmaxf(rmax, __shfl_xor(rmax, 32));
            const float mn = fmaxf(m, rmax), alpha = __builtin_amdgcn_exp2f(m - mn), mrel = mn - base;
            const bool moved = __any(mn != m);
            m = mn;
            float ps = 0.f;
#pragma unroll
            for (int kb = 0; kb < 2; ++kb)
#pragma unroll
                for (int r = 0; r < 16; ++r) { const float e = __builtin_amdgcn_exp2f(p[kb][r] - mrel); p[kb][r] = e; ps += e; }
            lsum = lsum * alpha + ps;
            if (moved) {
#pragma unroll
                for (int db = 0; db < 4; ++db)
#pragma unroll
                    for (int r = 0; r < 16; ++r) o[db][r] *= alpha;
            }
#pragma unroll
            for (int kb = 0; kb < 2; ++kb)
#pragma unroll
                for (int s2 = 0; s2 < 2; ++s2) {
                    v4u pw; pw.x = pk2(p[kb][8 * s2 + 0], p[kb][8 * s2 + 1]); pw.y = pk2(p[kb][8 * s2 + 2], p[kb][8 * s2 + 3]); pw.z = pk2(p[kb][8 * s2 + 4], p[kb][8 * s2 + 5]); pw.w = pk2(p[kb][8 * s2 + 6], p[kb][8 * s2 + 7]);
                    const bf16x8 pb = __builtin_bit_cast(bf16x8, pw);
#pragma unroll
                    for (int db = 0; db < 4; ++db) { const LAS unsigned char* vp = vb_ + db * 32 * AT_VSTR + kb * 64 + s2 * 32;
                        const v2u v0 = *(const LAS v2u*)vp, v1 = *(const LAS v2u*)(vp + 16);
                        v4u vw; vw.x = v0.x; vw.y = v0.y; vw.z = v1.x; vw.w = v1.y;
                        o[db] = __builtin_amdgcn_mfma_f32_32x32x16_bf16(__builtin_bit_cast(bf16x8, vw), pb, o[db], 0, 0, 0); }
                }
        }
        if (kt > 0) { AT_STORE(buf ^ 1); mw = mwn; }
        buf ^= 1;
    }
#undef AT_LOAD
#undef AT_STORE
    lsum += __shfl_xor(lsum, 32);
    const float inv = S_YA / lsum;
    unsigned char* yrow = (unsigned char*)F.YA + row * (2 * ATTW) + hh * HD + 4 * hi;
#pragma unroll
    for (int db = 0; db < 4; ++db)
#pragma unroll
        for (int rq = 0; rq < 4; ++rq) *(GAS unsigned*)(yrow + 32 * db + 8 * rq) = pk4_fp8(o[db][4 * rq] * inv, o[db][4 * rq + 1] * inv, o[db][4 * rq + 2] * inv, o[db][4 * rq + 3] * inv);
}
__device__ __forceinline__ float attn_score_bound(Frame& F) {
    float gq = fmaxf(fabsf(F.qng[F.lane]), fabsf(F.qng[F.lane + 64])), gk = fmaxf(fabsf(F.kng[F.lane]), fabsf(F.kng[F.lane + 64]));
#pragma unroll
    for (int o = 1; o < 64; o <<= 1) { gq = fmaxf(gq, __shfl_xor(gq, o)); gk = fmaxf(gk, __shfl_xor(gk, o)); }
    return 1.02f * 128.0f * gq * gk * QSCALE;
}

constexpr int SG_STR = 272, SG_WOFF = 65536;
__device__ __forceinline__ void sgu_unit(Frame& F, int unit) {
    const int ck = unit >> 3, g = unit & 7, r0 = ck * GMC, c0 = g * GMGW, tid = F.tid, lane = F.lane, w = F.wave, hi = lane >> 5, l31 = lane & 31;
    LAS unsigned char* L = F.lds;
    const int rs_ = tid >> 5, q_ = tid & 31;
    __syncthreads();
#pragma unroll
    for (int i = 0; i < 8; ++i) *(LAS v4u*)(L + (rs_ + 16 * i) * 512 + q_ * 16) = *(const GAS v4u*)(F.PROJ + (size_t)(r0 + rs_ + 16 * i) * PNP + PGV + c0 + 8 * q_);
    { const f32x4 q = *(const GAS f32x4*)(F.RS + r0 + 4 * q_);
#pragma unroll
      for (int i = 0; i < 8; ++i) { const int t_ = rs_ + 16 * i; const f32x4 wv = *(const GAS f32x4*)(F.sgw + ((size_t)(g * GMC + t_)) * GMC + 4 * q_);
          const int sb = 4 * q_; v2u o;
          o.x = pk2(sb + 0 <= t_ ? wv.x * q.x : 0.f, sb + 1 <= t_ ? wv.y * q.y : 0.f); o.y = pk2(sb + 2 <= t_ ? wv.z * q.z : 0.f, sb + 3 <= t_ ? wv.w * q.w : 0.f);
          *(LAS v2u*)(L + SG_WOFF + t_ * SG_STR + 8 * q_) = o; } }
    __syncthreads();
    v4u uu[8];
#pragma unroll
    for (int i = 0; i < 8; ++i) uu[i] = *(const GAS v4u*)(F.PROJ + (size_t)(r0 + rs_ + 16 * i) * PNP + PGU + c0 + 8 * q_);
    f32x16 acc[4];
#pragma unroll
    for (int tb = 0; tb < 4; ++tb)
#pragma unroll
        for (int r = 0; r < 16; ++r) acc[tb][r] = 0.f;
    const LAS unsigned char* xb = L + hi * 8 * 512 + 2 * (32 * w + l31);
    const LAS unsigned char* wa = L + SG_WOFF + l31 * SG_STR + hi * 16;
#pragma unroll
    for (int ks = 0; ks < 8; ++ks) {
        v4u xw;
#pragma unroll
        for (int j = 0; j < 4; ++j) { const unsigned lo = *(const LAS unsigned short*)(xb + (16 * ks + 2 * j) * 512), hh = *(const LAS unsigned short*)(xb + (16 * ks + 2 * j + 1) * 512); xw[j] = lo | (hh << 16); }
        const bf16x8 xf = __builtin_bit_cast(bf16x8, xw);
#pragma unroll
        for (int tb = 0; tb < 4; ++tb) if (ks < 2 * (tb + 1)) { const bf16x8 wf = *(const LAS bf16x8*)(wa + tb * 32 * SG_STR + ks * 32); acc[tb] = __builtin_amdgcn_mfma_f32_32x32x16_bf16(wf, xf, acc[tb], 0, 0, 0); } }
    LDS_WAIT(); __builtin_amdgcn_s_barrier(); asm volatile("" ::: "memory");
    { const int cl = 32 * w + l31;
#pragma unroll
      for (int tb = 0; tb < 4; ++tb)
#pragma unroll
          for (int r = 0; r < 16; ++r) { const int t = 32 * tb + (r & 3) + 8 * (r >> 2) + 4 * hi; *(LAS unsigned short*)(L + t * 512 + 2 * cl) = (unsigned short)f2bf(acc[tb][r]); } }
    const f32x4 g0 = *(const GAS f32x4*)(F.sgg + c0 + 8 * q_), g1 = *(const GAS f32x4*)(F.sgg + c0 + 8 * q_ + 4);
    LDS_WAIT(); __builtin_amdgcn_s_barrier(); asm volatile("" ::: "memory");
#pragma unroll
    for (int i = 0; i < 8; ++i) { const v4u fw = *(const LAS v4u*)(L + (rs_ + 16 * i) * 512 + q_ * 16); const float bb = F.sgb[g * GMC + rs_ + 16 * i]; v2u o;
        o.x = pk4_fp8(S_YB * bflo(uu[i].x) * (bflo(fw.x) * g0.x + bb), S_YB * bfhi(uu[i].x) * (bfhi(fw.x) * g0.y + bb), S_YB * bflo(uu[i].y) * (bflo(fw.y) * g0.z + bb), S_YB * bfhi(uu[i].y) * (bfhi(fw.y) * g0.w + bb));
        o.y = pk4_fp8(S_YB * bflo(uu[i].z) * (bflo(fw.z) * g1.x + bb), S_YB * bfhi(uu[i].z) * (bfhi(fw.z) * g1.y + bb), S_YB * bflo(uu[i].w) * (bflo(fw.w) * g1.z + bb), S_YB * bfhi(uu[i].w) * (bfhi(fw.w) * g1.w + bb));
        *(GAS v2u*)((unsigned char*)F.YA + (size_t)(r0 + rs_ + 16 * i) * (2 * ATTW) + ATTW + c0 + 8 * q_) = o; }
}

using pg8::Unit; using pg8::cvt_pk_bf16;
struct EpiProj {
    static constexpr bool PERM = true, MIDK = false; bf16* O; float scale;
    __device__ __forceinline__ void operator()(const f32x4 (&acc)[2][2][4][2], const Unit& u, int wr, int wc, int fr, int fq) const {
        const int act = (u.pn >= PGU / 256 && u.pn < PGA / 256) ? 1 : ((u.pn >= PGA / 256 && u.pn < PKI / 256) ? 2 : 0);
        const int row0 = u.pm * 256 + wr * 64 + fr, col0 = u.pn * 256 + wc * 32 + 8 * fq;
#pragma unroll
        for (int ai = 0; ai < 2; ++ai)
#pragma unroll
            for (int m = 0; m < 4; ++m) { bf16* rowp = O + (size_t)(row0 + ai * 128 + m * 16) * PNP + col0;
#pragma unroll
                for (int bj = 0; bj < 2; ++bj) { f32x4 v0 = acc[ai][bj][m][0] * scale, v1 = acc[ai][bj][m][1] * scale;
                    if (act == 1) { const pg8::f32x2 a = pg8::gelu_pk((pg8::f32x2){v0[0], v0[1]}), b = pg8::gelu_pk((pg8::f32x2){v0[2], v0[3]}), c = pg8::gelu_pk((pg8::f32x2){v1[0], v1[1]}), d = pg8::gelu_pk((pg8::f32x2){v1[2], v1[3]});
                        v0 = (f32x4){a.x, a.y, b.x, b.y}; v1 = (f32x4){c.x, c.y, d.x, d.y}; }
                    else if (act == 2) {
#pragma unroll
                        for (int j = 0; j < 4; ++j) { v0[j] = pg8::sigmoidf_(v0[j]); v1[j] = pg8::sigmoidf_(v1[j]); } }
                    v4u w; w.x = cvt_pk_bf16(v0[0], v0[1]); w.y = cvt_pk_bf16(v0[2], v0[3]); w.z = cvt_pk_bf16(v1[0], v1[1]); w.w = cvt_pk_bf16(v1[2], v1[3]);
                    *(GAS v4u*)(rowp + bj * 128) = w; } }
    }
};
struct EpiMerge {
    static constexpr bool PERM = true, MIDK = true; const bf16* P; unsigned char* O; float cB, ratio;
    __device__ __forceinline__ void mid(f32x4 (&acc)[2][2][4][2], const Unit& u, int wr, int wc, int fr, int fq) const {
        const bf16* pb = P + (size_t)(u.pm * 256 + wr * 64 + fr) * PNP + (u.pn * 256 + wc * 32 + 8 * fq);
        asm volatile("" : "+v"(pb));
#pragma unroll
        for (int ai = 0; ai < 2; ++ai)
#pragma unroll
            for (int m = 0; m < 4; ++m) {
#pragma unroll
                for (int bj = 0; bj < 2; ++bj) { const bf16* q = pb + (size_t)(ai * 128 + m * 16) * PNP + bj * 128;
                    const v4u ga = *(const GAS v4u*)(q + PGA), gb = *(const GAS v4u*)(q + PGB);
#pragma unroll
                    for (int j = 0; j < 2; ++j) { f32x4 f;
                        f.x = ratio * bflo(ga[2 * j]) * __builtin_amdgcn_rcpf(fmaxf(bflo(gb[2 * j]), 1e-30f)); f.y = ratio * bfhi(ga[2 * j]) * __builtin_amdgcn_rcpf(fmaxf(bfhi(gb[2 * j]), 1e-30f));
                        f.z = ratio * bflo(ga[2 * j + 1]) * __builtin_amdgcn_rcpf(fmaxf(bflo(gb[2 * j + 1]), 1e-30f)); f.w = ratio * bfhi(ga[2 * j + 1]) * __builtin_amdgcn_rcpf(fmaxf(bfhi(gb[2 * j + 1]), 1e-30f));
                        acc[ai][bj][m][j] *= f; }
                    asm volatile("" ::: "memory"); } }
    }
    __device__ __forceinline__ void operator()(const f32x4 (&acc)[2][2][4][2], const Unit& u, int wr, int wc, int fr, int fq) const {
        const float sc = cB * S_MRG;
        const bf16* pb = P + (size_t)(u.pm * 256 + wr * 64 + fr) * PNP + (u.pn * 256 + wc * 32 + 8 * fq) + PGB;
        unsigned char* ob = O + (size_t)(u.pm * 256 + wr * 64 + fr) * DM + (u.pn * 256 + wc * 32 + 8 * fq);
        asm volatile("" : "+v"(pb), "+v"(ob));
#pragma unroll
        for (int ai = 0; ai < 2; ++ai)
#pragma unroll
            for (int m = 0; m < 4; ++m) {
#pragma unroll
                for (int bj = 0; bj < 2; ++bj) { const v4u gw = *(const GAS v4u*)(pb + (size_t)(ai * 128 + m * 16) * PNP + bj * 128);
                    const f32x4 v0 = acc[ai][bj][m][0] * ((f32x4){fmaxf(bflo(gw.x), 1e-30f), fmaxf(bfhi(gw.x), 1e-30f), fmaxf(bflo(gw.y), 1e-30f), fmaxf(bfhi(gw.y), 1e-30f)} * sc);
                    const f32x4 v1 = acc[ai][bj][m][1] * ((f32x4){fmaxf(bflo(gw.z), 1e-30f), fmaxf(bfhi(gw.z), 1e-30f), fmaxf(bflo(gw.w), 1e-30f), fmaxf(bfhi(gw.w), 1e-30f)} * sc);
                    v2u w; w.x = pk4_fp8(v0[0], v0[1], v0[2], v0[3]); w.y = pk4_fp8(v1[0], v1[1], v1[2], v1[3]);
                    *(GAS v2u*)(ob + (size_t)(ai * 128 + m * 16) * DM + bj * 128) = w; } }
    }
};
struct EpiResid {
    static constexpr bool PERM = false, MIDK = false; const float* base; const float* gate; float* C; float scale;
    __device__ __forceinline__ void operator()(const f32x4 (&acc)[2][2][4][2], const Unit& u, int wr, int wc, int fr, int fq) const {
        const int row0 = u.pm * 256 + wr * 64 + fr, col0 = u.pn * 256 + wc * 32 + 4 * fq; const float* gp = gate + (u.pm >> 3) * MODW + col0;
        f32x4 gv[2][2];
#pragma unroll
        for (int bj = 0; bj < 2; ++bj)
#pragma unroll
            for (int n = 0; n < 2; ++n) gv[bj][n] = *(const GAS f32x4*)(gp + bj * 128 + n * 16) * scale;
#pragma unroll
        for (int ai = 0; ai < 2; ++ai)
#pragma unroll
            for (int m = 0; m < 4; ++m) { const size_t off = (size_t)(row0 + ai * 128 + m * 16) * DM + col0;
#pragma unroll
                for (int bj = 0; bj < 2; ++bj)
#pragma unroll
                    for (int n = 0; n < 2; ++n) { const f32x4 bs = *(const GAS f32x4*)(base + off + bj * 128 + n * 16);
                        *(GAS f32x4*)(C + off + bj * 128 + n * 16) = bs + gv[bj][n] * acc[ai][bj][m][n]; } }
    }
};
struct EpiPlain {
    static constexpr bool PERM = true, MIDK = false; unsigned char* O; int ldc; float scale;
    __device__ __forceinline__ void operator()(const f32x4 (&acc)[2][2][4][2], const Unit& u, int wr, int wc, int fr, int fq) const {
        unsigned char* ob = O + (size_t)(u.pm * 256 + wr * 64 + fr) * ldc + (u.pn * 256 + wc * 32 + 8 * fq);
        asm volatile("" : "+v"(ob));
#pragma unroll
        for (int ai = 0; ai < 2; ++ai)
#pragma unroll
            for (int m = 0; m < 4; ++m)
#pragma unroll
                for (int bj = 0; bj < 2; ++bj) { const f32x4 v0 = acc[ai][bj][m][0] * scale, v1 = acc[ai][bj][m][1] * scale;
                    v2u w; w.x = pk4_fp8(v0[0], v0[1], v0[2], v0[3]); w.y = pk4_fp8(v1[0], v1[1], v1[2], v1[3]);
                    *(GAS v2u*)(ob + (size_t)(ai * 128 + m * 16) * ldc + bj * 128) = w; }
    }
};

__device__ __forceinline__ void unpack8_fp8(v2u w, float (&o)[8]) {
    typedef float f32x2_ __attribute__((ext_vector_type(2)));
    const f32x2_ a = __builtin_amdgcn_cvt_pk_f32_fp8((int)w.x, false), b = __builtin_amdgcn_cvt_pk_f32_fp8((int)w.x, true), c = __builtin_amdgcn_cvt_pk_f32_fp8((int)w.y, false), d = __builtin_amdgcn_cvt_pk_f32_fp8((int)w.y, true);
    o[0] = a.x * (1.f / S_A); o[1] = a.y * (1.f / S_A); o[2] = b.x * (1.f / S_A); o[3] = b.y * (1.f / S_A); o[4] = c.x * (1.f / S_A); o[5] = c.y * (1.f / S_A); o[6] = d.x * (1.f / S_A); o[7] = d.y * (1.f / S_A);
}
__device__ __forceinline__ void conv_phase(Frame& F) {
    constexpr int C8 = DFF / 8, TB = 32, NTB = M / TB;
    const size_t total = (size_t)C8 * NTB;
    for (size_t idx = (size_t)F.gw * 64 + F.lane; idx < total; idx += (size_t)F.NGW * 64) {
        const int c8 = (int)(idx % C8), tb = (int)(idx / C8), ch = 8 * c8, t0 = tb * TB;
        const int acol = (ch >> 7) * 256 + (ch & 127);
        float wg[3][8], wv[3][8], bg[8], bv[8];
#pragma unroll
        for (int j = 0; j < 3; ++j) { const f32x4 a = *(const GAS f32x4*)(F.cvw + (size_t)j * F2 + ch), b = *(const GAS f32x4*)(F.cvw + (size_t)j * F2 + ch + 4);
            const f32x4 c = *(const GAS f32x4*)(F.cvw + (size_t)j * F2 + DFF + ch), d = *(const GAS f32x4*)(F.cvw + (size_t)j * F2 + DFF + ch + 4);
#pragma unroll
            for (int e = 0; e < 4; ++e) { wg[j][e] = a[e]; wg[j][4 + e] = b[e]; wv[j][e] = c[e]; wv[j][4 + e] = d[e]; } }
        { const f32x4 a = *(const GAS f32x4*)(F.cvb + ch), b = *(const GAS f32x4*)(F.cvb + ch + 4), c = *(const GAS f32x4*)(F.cvb + DFF + ch), d = *(const GAS f32x4*)(F.cvb + DFF + ch + 4);
#pragma unroll
          for (int e = 0; e < 4; ++e) { bg[e] = a[e]; bg[4 + e] = b[e]; bv[e] = c[e]; bv[4 + e] = d[e]; } }
        float g1[8], g2[8], v1[8], v2[8];
        const bool first = (t0 & (SEQ - 1)) == 0;
        const unsigned char* ap = (const unsigned char*)F.A + (size_t)t0 * F2 + acol;
        if (first) {
#pragma unroll
            for (int e = 0; e < 8; ++e) { g1[e] = g2[e] = v1[e] = v2[e] = 0.f; }
        } else {
            const v2u ga = *(const GAS v2u*)(ap - F2), gb = *(const GAS v2u*)(ap - 2 * (size_t)F2), va = *(const GAS v2u*)(ap - F2 + 128), vb = *(const GAS v2u*)(ap - 2 * (size_t)F2 + 128);
            unpack8_fp8(ga, g1); unpack8_fp8(gb, g2); unpack8_fp8(va, v1); unpack8_fp8(vb, v2);
        }
#pragma unroll 4
        for (int i = 0; i < TB; ++i) {
            const v2u gw = *(const GAS v2u*)(ap + (size_t)i * F2), vw = *(const GAS v2u*)(ap + (size_t)i * F2 + 128);
            float g0[8], v0[8], y[8];
            unpack8_fp8(gw, g0); unpack8_fp8(vw, v0);
#pragma unroll
            for (int e = 0; e < 8; ++e) { const float gt = bg[e] + wg[0][e] * g2[e] + wg[1][e] * g1[e] + wg[2][e] * g0[e];
                const float vl = bv[e] + wv[0][e] * v2[e] + wv[1][e] * v1[e] + wv[2][e] * v0[e];
                y[e] = gt * pg8::sigmoidf_(gt) * vl; g2[e] = g1[e]; g1[e] = g0[e]; v2[e] = v1[e]; v1[e] = v0[e]; }
            v2u o; o.x = pk4_fp8(y[0] * S_ACT, y[1] * S_ACT, y[2] * S_ACT, y[3] * S_ACT); o.y = pk4_fp8(y[4] * S_ACT, y[5] * S_ACT, y[6] * S_ACT, y[7] * S_ACT);
            *(GAS v2u*)((unsigned char*)F.ACT + (size_t)(t0 + i) * DFF + ch) = o;
        }
    }
}

constexpr int N_PHASES = 12;
struct Args { const float* in[19]; float* out; unsigned char* ws; int ph_lo, ph_hi, li, pad; };
__global__ void __launch_bounds__(NWAVES * 64, 2) mega_fwd(Args args) {
    extern __shared__ __attribute__((aligned(16))) unsigned char lds[];
    Frame F;
    F.lds = (LAS unsigned char*)lds;
    F.MISC = (volatile LAS unsigned*)(F.lds + MISC_OFF);
    F.tid = threadIdx.x; F.lane = F.tid & 63; F.wave = __builtin_amdgcn_readfirstlane(F.tid >> 6);
    F.G = gridDim.x; F.gw = blockIdx.x * NWAVES + F.wave; F.NGW = F.G * NWAVES;
    unsigned char* ws = args.ws;
    F.ctl = (gu32*)(ws + WS_CTL);
    F.x = args.in[0]; F.c = args.in[1]; F.ada_w = args.in[2]; F.ada_b = args.in[3]; F.n1g = args.in[4]; F.w_in = args.in[5]; F.qng = args.in[6]; F.kng = args.in[7];
    F.sgg = args.in[8]; F.sgw = args.in[9]; F.sgb = args.in[10]; F.w_a = args.in[11]; F.w_b = args.in[12]; F.w_out = args.in[13]; F.n2g = args.in[14]; F.w_up = args.in[15];
    F.cvw = args.in[16]; F.cvb = args.in[17]; F.w_dn = args.in[18]; F.out = args.out;
    F.MOD = (float*)(ws + WS_MOD); F.PART = (float*)(ws + WS_TMP);   F.WIN = (bf16*)(ws + WS_WIN); F.WINB = (bf16*)(ws + WS_WINB); F.H8A = ws + WS_X1;   F.WA = (bf16*)(ws + WS_WA); F.WB = (bf16*)(ws + WS_WB); F.WOUT = (bf16*)(ws + WS_WOUT); F.WUP = (bf16*)(ws + WS_WUP); F.WDN = (bf16*)(ws + WS_WDN);
    F.H = (bf16*)(ws + WS_H); F.X1 = (float*)(ws + WS_X1); F.PROJ = (bf16*)(ws + WS_PROJ); F.MASK = (unsigned*)(ws + WS_MASK); F.RS = (float*)(ws + WS_RS); F.SWT = (float*)(ws + WS_SWT);
    F.VT = (bf16*)(ws + WS_VT); F.YA = (bf16*)(ws + WS_YA); F.YB = (bf16*)(ws + WS_YB); F.MRG = (bf16*)(ws + WS_MRG); F.TMP = (float*)(ws + WS_TMP); F.A = (bf16*)(ws + WS_A); F.ACT = (bf16*)(ws + WS_ACT);
    for (int u = F.tid; u < (LDS_BYTES - LDSCTL_OFF) / 4; u += NWAVES * 64) ((LAS unsigned*)(F.lds + LDSCTL_OFF))[u] = 0u;
    __syncthreads();
    XcdBarrier bar; bar.bar = (unsigned*)(F.ctl + CW_BAR); bar.x = 0; bar.st = nullptr;
    if (MK_N_LAUNCHES == 1) bar = xcd_barrier_post((unsigned*)(F.ctl + CW_BAR), F.MISC + 8);
    const int lo = args.ph_lo, hi = args.ph_hi;
#define IN(k) (lo <= (k) && (k) < hi)
#define SEAM(k) do { if (IN(k) && IN((k) + 1)) xcd_barrier(bar); } while (0)

#define REP(k) if ((PROBE_MASK >> (k)) & 1) for (int _rep = 0; _rep < 1; ++_rep)
    if (IN(0)) { p0_prologue(F); REP(0) { xcd_barrier(bar); p0_prologue(F, false); } } SEAM(0);
    if (IN(1)) { mod_reduce(F); } SEAM(1);
    if (IN(2)) { norm_rows<2>(F, F.x, F.n1g, 0, DM, F.H, F.H8A); REP(2) { xcd_barrier(bar); norm_rows<2>(F, F.x, F.n1g, 0, DM, F.H, F.H8A); } } SEAM(2);
    if (IN(3)) {
        { pg8::Gemm g{F.H, F.WINB, M, PNP, DM, DM, DM}; pg8::MixOrder S{0, F.G, (int)blockIdx.x}; EpiProj E{F.PROJ, 1.0f};
          pg8::gemm_phase<EpiProj, pg8::MixOrder, true, 2>(F.lds + RING_OFF, g, S, E); }
        VM_WAIT(); __syncthreads();
        { pg8::Gemm g{(const bf16*)F.H8A, F.WIN, M, PNP, DM, DM, DM}; pg8::MixOrder S{1, F.G, (int)blockIdx.x}; EpiProj E{F.PROJ, 1.0f / (S_H2 * 1024.f)};
          pg8::gemm_phase<EpiProj, pg8::MixOrder, true, 1>(F.lds + RING_OFF, g, S, E); }
    } SEAM(3);
    if (IN(4)) {
        for (int it = blockIdx.x; it < 512; it += F.G) { const int b = it >> 7, j = it & 127; idx_block(F, b, j); idx_block(F, b, 255 - j); }
        for (int row = F.gw; row < M; row += F.NGW) qknorm_row(F, row);
        for (int it = F.gw; it < BATCH * NKV * 2 * 256; it += F.NGW) vt_item(F, it);
        REP(4) { xcd_barrier(bar); for (int it = blockIdx.x; it < 512; it += F.G) { const int b = it >> 7, j = it & 127; idx_block(F, b, j); idx_block(F, b, 255 - j); } }
        REP(13) { xcd_barrier(bar); for (int it = F.gw; it < BATCH * NKV * 2 * 256; it += F.NGW) vt_item(F, it); }
    } SEAM(4);
    if (IN(5)) {
        { const float sb = attn_score_bound(F); for (int p = blockIdx.x; p < 256; p += F.G) { const int bg = p >> 4, j = p & 15; attn_block(F, bg >> 2, bg & 3, j, sb); attn_block(F, bg >> 2, bg & 3, 31 - j, sb); } }
        REP(5) { xcd_barrier(bar); { const float sb = attn_score_bound(F); for (int p = blockIdx.x; p < 256; p += F.G) { const int bg = p >> 4, j = p & 15; attn_block(F, bg >> 2, bg & 3, j, sb); attn_block(F, bg >> 2, bg & 3, 31 - j, sb); } } }
        for (int u = blockIdx.x; u < 512; u += F.G) sgu_unit(F, u);
        __syncthreads();
        REP(14) { xcd_barrier(bar); for (int u = blockIdx.x; u < 512; u += F.G) sgu_unit(F, u); __syncthreads(); }
    } SEAM(5);
    if (IN(6)) { pg8::Gemm g{F.YA, F.WA, M, DM, 2 * ATTW, 2 * ATTW, 2 * ATTW}; pg8::StaticOrder S; S.init(M, DM, F.G, (int)blockIdx.x);
        EpiMerge E{F.PROJ, (unsigned char*)F.MRG, 1.0f / (S_YB * S_WB), (S_YB * S_WB) / (S_YA * S_WA)};
        pg8::gemm_phase<EpiMerge, pg8::StaticOrder, true, 1>(F.lds + RING_OFF, g, S, E);
        REP(6) { xcd_barrier(bar); pg8::gemm_phase<EpiMerge, pg8::StaticOrder, true, 1>(F.lds + RING_OFF, g, S, E); } } SEAM(6);
    if (IN(7)) { pg8::Gemm g{F.MRG, F.WOUT, M, DM, DM, DM, DM}; pg8::StaticOrder S; S.init(M, DM, F.G, (int)blockIdx.x); EpiResid E{F.x, F.MOD + 2 * DM, F.X1, 1.0f / (S_MRG * S_WOUT)};
        pg8::gemm_phase<EpiResid, pg8::StaticOrder, true, 1>(F.lds + RING_OFF, g, S, E);
        REP(7) { xcd_barrier(bar); pg8::gemm_phase<EpiResid, pg8::StaticOrder, true, 1>(F.lds + RING_OFF, g, S, E); } } SEAM(7);
    if (IN(8)) { norm_rows<1>(F, F.X1, F.n2g, 3 * DM, 4 * DM, F.H); REP(8) { xcd_barrier(bar); norm_rows<1>(F, F.X1, F.n2g, 3 * DM, 4 * DM, F.H); } } SEAM(8);
    if (IN(9)) { pg8::Gemm g{F.H, F.WUP, M, F2, DM, DM, DM}; pg8::StaticOrder S; S.init(M, F2, F.G, (int)blockIdx.x); EpiPlain E{(unsigned char*)F.A, F2, S_A / (S_H2 * S_WUP)};
        pg8::gemm_phase<EpiPlain, pg8::StaticOrder, true, 1>(F.lds + RING_OFF, g, S, E);
        REP(9) { xcd_barrier(bar); pg8::gemm_phase<EpiPlain, pg8::StaticOrder, true, 1>(F.lds + RING_OFF, g, S, E); } } SEAM(9);
    if (IN(10)) { conv_phase(F); REP(10) { xcd_barrier(bar); conv_phase(F); } } SEAM(10);
    if (IN(11)) { pg8::Gemm g{F.ACT, F.WDN, M, DM, DFF, DFF, DFF}; pg8::StaticOrder S; S.init(M, DM, F.G, (int)blockIdx.x); EpiResid E{F.X1, F.MOD + 5 * DM, F.out, 1.0f / (S_ACT * S_WDN)};
        pg8::gemm_phase<EpiResid, pg8::StaticOrder, true, 1>(F.lds + RING_OFF, g, S, E);
        REP(11) { xcd_barrier(bar); pg8::gemm_phase<EpiResid, pg8::StaticOrder, true, 1>(F.lds + RING_OFF, g, S, E); } }
#undef REP
#undef IN
#undef SEAM
}

extern "C" void kernel_launch(void* const* d_in, const int* in_sizes, int n_in, void* d_out, int out_size, void* d_ws, size_t ws_size, hipStream_t stream) {
    static int grid = 0;
    if (grid == 0) {
        if (n_in != 19 || in_sizes[0] != M * DM || out_size != M * DM || ws_size < WS_END) { fprintf(stderr, "kernel_launch: unexpected shapes (n_in %d, in0 %d, out %d, ws %zu < %zu); nothing launched\n", n_in, n_in > 0 ? in_sizes[0] : -1, out_size, ws_size, (size_t)WS_END); grid = -1; return; }
        int dev = 0, cus = 0, per_cu = 0;
        if (hipGetDevice(&dev) != hipSuccess || hipDeviceGetAttribute(&cus, hipDeviceAttributeMultiprocessorCount, dev) != hipSuccess) { fprintf(stderr, "kernel_launch: device query failed\n"); grid = -1; return; }
        if (hipFuncSetAttribute((const void*)mega_fwd, hipFuncAttributeMaxDynamicSharedMemorySize, LDS_BYTES) != hipSuccess) { fprintf(stderr, "kernel_launch: hipFuncSetAttribute failed\n"); grid = -1; return; }
        if (hipOccupancyMaxActiveBlocksPerMultiprocessor(&per_cu, (const void*)mega_fwd, NWAVES * 64, LDS_BYTES) != hipSuccess || per_cu < 1) { fprintf(stderr, "kernel_launch: occupancy query reports %d blocks per CU\n", per_cu); }
        (void)hipGetLastError();
        grid = cus;
    }
    if (grid < 0) return;
    if (hipMemsetAsync((char*)d_ws + WS_CTL, 0, CTL_ZERO_BYTES, stream) != hipSuccess) { fprintf(stderr, "kernel_launch: memset failed\n"); return; }
    Args a{};
    for (int i = 0; i < 19; ++i) a.in[i] = (const float*)d_in[i];
    a.out = (float*)d_out; a.ws = (unsigned char*)d_ws; a.pad = 0;
    for (int li = 0; li < MK_N_LAUNCHES; ++li) {
        if (MK_N_LAUNCHES == 1) { a.ph_lo = 0; a.ph_hi = N_PHASES; } else { a.ph_lo = li; a.ph_hi = li + 1; }
        a.li = li;
        hipLaunchKernelGGL(mega_fwd, dim3(grid), dim3(NWAVES * 64), LDS_BYTES, stream, a);
        const hipError_t le = hipPeekAtLastError();
        if (le != hipSuccess) { fprintf(stderr, "kernel_launch: launch %d failed: %s\n", li, hipGetErrorName(le)); break; }
    }
}
```

```cpp
#include <hip/hip_runtime.h>
#include <cstdio>
#include <cstdint>

#ifndef MK_N_LAUNCHES
#define MK_N_LAUNCHES 1
#endif
#ifndef PROBE_MASK
#define PROBE_MASK 0x0
#endif

namespace pg8 {
#define PG8_LAS __attribute__((address_space(3)))
typedef unsigned short bf16_t;
typedef short bf16x8 __attribute__((ext_vector_type(8)));
typedef float f32x4 __attribute__((ext_vector_type(4)));
typedef float f32x2 __attribute__((ext_vector_type(2)));
typedef unsigned u32x4 __attribute__((ext_vector_type(4)));
typedef unsigned u32x2 __attribute__((ext_vector_type(2)));
constexpr int BM = 256, BK = 64, HALF = 128, HTB = HALF * BK * 2, STAGE_BYTES = 8 * HTB, NXCD = 8, WGM = 8;

__host__ __device__ __forceinline__ int lds_byte(int r, int c) { const int rr = r & 7, ch = c >> 3; return (r >> 3) * 1024 + (16 * ((rr >> 2) + 2 * (ch >> 2)) + 4 * (rr & 3) + ((ch ^ (2 * (rr >> 2))) & 3)) * 16; }
__host__ __device__ __forceinline__ void stage_rc(int b, int& R, int& C) { const int pc = b >> 10, p = (b & 1023) >> 4, q = p >> 4, bb = p & 15, rr = (q & 1) * 4 + (bb >> 2), ch = (q >> 1) * 4 + ((bb & 3) ^ (2 * (q & 1))); R = pc * 8 + rr; C = ch * 8; }
__host__ __device__ __forceinline__ int perm32(int rho) { const int n = rho >> 4, i = rho & 15; return 8 * (i >> 2) + 4 * n + (i & 3); }

struct Unit { int pm, pn; };
struct Gemm { const bf16_t* A; const bf16_t* Bt; int M, N, K, lda, ldb; };

struct StaticOrder {
    int nM, nN, nwg, G, c;
    __host__ __device__ void init(int M, int N, int G_, int c_) { nM = M / BM; nN = N / BM; nwg = nM * nN; G = G_; c = c_; }
    __host__ __device__ bool next(int i, Unit& u) const {
        const long L = (long)i * G + c; if (L >= nwg) return false;
        int wgid = (int)L; { const int q = nwg / NXCD, r = nwg % NXCD, xcd = wgid % NXCD, off = wgid / NXCD; wgid = (xcd < r ? xcd * (q + 1) : r * (q + 1) + (xcd - r) * q) + off; }
        const int nig = WGM * nN, gid = wgid / nig, fm = gid * WGM, gsz = (nM - fm) < WGM ? (nM - fm) : WGM;
        u.pm = fm + ((wgid % nig) % gsz); u.pn = (wgid % nig) / gsz; return true;
    }
    __device__ __forceinline__ void a_ready(const Unit&) const {}
    __device__ __forceinline__ void done(const Unit&) const {}
};
struct MixOrder {
    int fp8, G, c;
    __host__ __device__ static void map(int L, int nwg, int nN, Unit& u) {
        int wgid = L; { const int q = nwg / NXCD, r = nwg % NXCD, xcd = wgid % NXCD, off = wgid / NXCD; wgid = (xcd < r ? xcd * (q + 1) : r * (q + 1) + (xcd - r) * q) + off; }
        const int nig = WGM * nN; u.pm = (wgid / nig) * WGM + ((wgid % nig) % WGM); u.pn = (wgid % nig) / WGM;
    }
    __host__ __device__ bool next(int i, Unit& u) const {
        int L;
        if (!fp8) { L = i * G + c; if (L >= 288) return false; map(L, 288, 9, u); u.pn = u.pn < 8 ? 12 + u.pn : 68; return true; }
        if (G == 256) { if (c >= 32) { if (i >= 8) return false; L = i * 224 + (c - 32); } else { if (i >= 4) return false; L = 1792 + 4 * c + i; } }
        else { L = i * G + c; if (L >= 1920) return false; }
        map(L, 1920, 60, u); u.pn = u.pn < 12 ? u.pn : u.pn + 8; return true;
    }
    __device__ __forceinline__ void a_ready(const Unit&) const {}
    __device__ __forceinline__ void done(const Unit&) const {}
};

__device__ __forceinline__ unsigned cvt_pk_bf16(float lo, float hi) { unsigned r; asm volatile("v_cvt_pk_bf16_f32 %0, %1, %2" : "=v"(r) : "v"(lo), "v"(hi)); return r; }
__device__ __forceinline__ f32x2 gelu_pk(f32x2 v) {
    const f32x2 av = __builtin_elementwise_abs(v), d = av * 0.2316418882f + 1.0f;
    f32x2 t; t.x = __builtin_amdgcn_rcpf(d.x); t.y = __builtin_amdgcn_rcpf(d.y);
    f32x2 q = t * 0.5307027145f + (-0.7265760135f); q = q * t + 0.7107068705f; q = q * t + (-0.142248368f); q = q * t + 0.127414796f; q = q * t;
    const f32x2 s = (v * v) * (-0.72134752044f);
    f32x2 e; e.x = __builtin_amdgcn_exp2f(s.x); e.y = __builtin_amdgcn_exp2f(s.y);
    const f32x2 m = v * (q * e), r = v - m;
    f32x2 o; o.x = v.x < 0.f ? m.x : r.x; o.y = v.y < 0.f ? m.y : r.y; return o;
}
__device__ __forceinline__ float sigmoidf_(float x) { return __builtin_amdgcn_rcpf(1.0f + __builtin_amdgcn_exp2f(-1.4426950408889634f * x)); }
__device__ __forceinline__ float bflo(unsigned w) { return __builtin_bit_cast(float, w << 16); }
__device__ __forceinline__ float bfhi(unsigned w) { return __builtin_bit_cast(float, w & 0xffff0000u); }

typedef int i32x8 __attribute__((ext_vector_type(8)));
typedef int i32x4 __attribute__((ext_vector_type(4)));
template <class Epi, class Sched, bool ALIGN_EPI, int ES = 2>
__device__ __forceinline__ void gemm_phase(PG8_LAS unsigned char* lds, const Gemm g, const Sched& S, const Epi& E) {
    const int tid = threadIdx.x, wid = __builtin_amdgcn_readfirstlane(tid >> 6), lane = tid & 63, wr = wid >> 2, wc = wid & 3, fr = lane & 15, fq = lane >> 4;
    const int K = g.K, nt = K * ES / (BK * 2);
    unsigned voffA[2], voffB[2];
#pragma unroll
    for (int i = 0; i < 2; ++i) { int R, C; stage_rc(tid * 16 + i * 8192, R, C); const int Rb = Epi::PERM ? ((R & ~31) + perm32(R & 31)) : R;
        voffA[i] = (unsigned)(R * g.lda) * (unsigned)ES + (unsigned)C * 2u; voffB[i] = (unsigned)(Rb * g.ldb) * (unsigned)ES + (unsigned)C * 2u; }
    const size_t kstep = (size_t)(BK * 2);
    const size_t hstepA = (size_t)HALF * g.lda * ES, hstepB = (size_t)HALF * g.ldb * ES;
    const size_t tstepA = 2 * hstepA, tstepB = 2 * hstepB;
    const unsigned ldsw = (unsigned)wid * 1024u;
    const int aoff = lds_byte(wr * 64 + fr, fq * 8), boff = lds_byte(wc * 32 + fr, fq * 8);
#define PG8_SA(b, h) (((b) * 2 + (h)) * HTB)
#define PG8_SB(b, h) ((4 + (b) * 2 + (h)) * HTB)
#define PG8_STAGE(bufoff, gbase, voff) do { _Pragma("unroll") for (int _i = 0; _i < 2; ++_i) \
        __builtin_amdgcn_global_load_lds((const unsigned*)((const char*)(gbase) + (voff)[_i]), (PG8_LAS unsigned*)(lds + (bufoff) + ldsw + _i * 8192), 16, 0, 0); } while (0)
#define PG8_CAT(x, y) __builtin_shufflevector(x, y, 0, 1, 2, 3, 4, 5, 6, 7)
#define PG8_LO(v) __builtin_bit_cast(bf16x8, __builtin_shufflevector(v, v, 0, 1, 2, 3))
#define PG8_HI(v) __builtin_bit_cast(bf16x8, __builtin_shufflevector(v, v, 4, 5, 6, 7))
#define PG8_LDA(dst, b, h) do { _Pragma("unroll") for (int m = 0; m < 4; ++m) { const i32x4 _l = *(const PG8_LAS i32x4*)(lds + PG8_SA(b, h) + aoff + m * 2048), _h = *(const PG8_LAS i32x4*)(lds + PG8_SA(b, h) + aoff + m * 2048 + 512); dst[m] = PG8_CAT(_l, _h); } } while (0)
#define PG8_LDB(dst, b, h) do { _Pragma("unroll") for (int n = 0; n < 2; ++n) { const i32x4 _l = *(const PG8_LAS i32x4*)(lds + PG8_SB(b, h) + boff + n * 2048), _h = *(const PG8_LAS i32x4*)(lds + PG8_SB(b, h) + boff + n * 2048 + 512); dst[n] = PG8_CAT(_l, _h); } } while (0)
#define PG8_MMA(ai, bj, At, Bt) do { __builtin_amdgcn_s_setprio(1); _Pragma("unroll") for (int m = 0; m < 4; ++m) _Pragma("unroll") for (int n = 0; n < 2; ++n) { \
        if constexpr (ES == 2) { acc[ai][bj][m][n] = __builtin_amdgcn_mfma_f32_16x16x32_bf16(PG8_LO(Bt[n]), PG8_LO(At[m]), acc[ai][bj][m][n], 0, 0, 0); \
                                 acc[ai][bj][m][n] = __builtin_amdgcn_mfma_f32_16x16x32_bf16(PG8_HI(Bt[n]), PG8_HI(At[m]), acc[ai][bj][m][n], 0, 0, 0); } \
        else asm volatile("v_mfma_f32_16x16x128_f8f6f4 %0, %1, %2, %0" : "+v"(acc[ai][bj][m][n]) : "v"(Bt[n]), "v"(At[m])); } __builtin_amdgcn_s_setprio(0); } while (0)
#define PG8_WAIT_V(n) asm volatile("s_waitcnt vmcnt(" #n ")" ::: "memory")
#define PG8_WAIT_L(n) asm volatile("s_waitcnt lgkmcnt(" #n ")" ::: "memory")
#define PG8_BAR __builtin_amdgcn_s_barrier()
#define PG8_SCHED __builtin_amdgcn_sched_barrier(0)
    Unit cur, nxt; int ui = 0;
    if (!S.next(0, cur)) return;
    f32x4 acc[2][2][4][2];
#pragma unroll
    for (int a = 0; a < 2; ++a)
#pragma unroll
        for (int b = 0; b < 2; ++b)
#pragma unroll
            for (int m = 0; m < 4; ++m)
#pragma unroll
                for (int n = 0; n < 2; ++n) acc[a][b][m][n] = (f32x4){0.f, 0.f, 0.f, 0.f};
    i32x8 At[4], B0[2], B1[2];
    const char* cA = (const char*)g.A + (size_t)cur.pm * tstepA; const char* cB = (const char*)g.Bt + (size_t)cur.pn * tstepB;
    S.a_ready(cur);
    PG8_STAGE(PG8_SB(0, 0), cB, voffB); PG8_STAGE(PG8_SB(0, 1), cB + hstepB, voffB); PG8_STAGE(PG8_SA(0, 0), cA, voffA); PG8_STAGE(PG8_SA(0, 1), cA + hstepA, voffA);
    if (wr == 1) PG8_BAR;
    PG8_WAIT_V(2); PG8_BAR;
    PG8_STAGE(PG8_SB(1, 0), cB + kstep, voffB); PG8_STAGE(PG8_SA(1, 0), cA + kstep, voffA); PG8_STAGE(PG8_SB(1, 1), cB + hstepB + kstep, voffB);
    PG8_WAIT_V(6); PG8_BAR;
    for (;;) {
        const bool has_next = S.next(ui + 1, nxt);
        const char* nA = has_next ? (const char*)g.A + (size_t)nxt.pm * tstepA : cA; const char* nB = has_next ? (const char*)g.Bt + (size_t)nxt.pn * tstepB : cB;
        for (int t = 0; t < nt; t += 2) {
            const bool last = (t == nt - 2);
            const char* a1 = cA + (size_t)(t + 1) * kstep;
            const char* a2 = last ? nA : cA + (size_t)(t + 2) * kstep; const char* b2 = last ? nB : cB + (size_t)(t + 2) * kstep;
            const char* a3 = a2 + kstep; const char* b3 = b2 + kstep;
            if (last && has_next) S.a_ready(nxt);
            if constexpr (Epi::MIDK) { if (t == nt / 2) { if constexpr (ES == 1) asm volatile("s_nop 15\n\ts_nop 15" ::: "memory"); E.mid(acc, cur, wr, wc, fr, fq); } }
            PG8_LDB(B0, 0, 0); PG8_LDB(B1, 0, 1); PG8_SCHED; PG8_LDA(At, 0, 0); PG8_STAGE(PG8_SA(1, 1), a1 + hstepA, voffA);
            PG8_WAIT_V(8); PG8_WAIT_L(0); PG8_BAR; PG8_MMA(0, 0, At, B0); PG8_MMA(0, 1, At, B1); PG8_BAR; PG8_SCHED;
            PG8_LDA(At, 0, 1); PG8_STAGE(PG8_SB(0, 0), b2, voffB); PG8_STAGE(PG8_SB(0, 1), b2 + hstepB, voffB); PG8_STAGE(PG8_SA(0, 0), a2, voffA);
            PG8_WAIT_V(8); PG8_WAIT_L(0); PG8_BAR; PG8_MMA(1, 0, At, B0); PG8_MMA(1, 1, At, B1); PG8_BAR; PG8_SCHED;
            PG8_LDB(B0, 1, 0); PG8_LDB(B1, 1, 1); PG8_SCHED; PG8_LDA(At, 1, 0); PG8_STAGE(PG8_SA(0, 1), a2 + hstepA, voffA);
            PG8_WAIT_V(8); PG8_WAIT_L(0); PG8_BAR; PG8_MMA(0, 0, At, B0); PG8_MMA(0, 1, At, B1); PG8_BAR; PG8_SCHED;
            PG8_LDA(At, 1, 1); PG8_STAGE(PG8_SB(1, 0), b3, voffB); PG8_STAGE(PG8_SB(1, 1), b3 + hstepB, voffB); PG8_STAGE(PG8_SA(1, 0), a3, voffA);
            PG8_WAIT_V(8); PG8_WAIT_L(0); PG8_BAR; PG8_MMA(1, 0, At, B0); PG8_MMA(1, 1, At, B1); PG8_BAR; PG8_SCHED;
        }
        if constexpr (ALIGN_EPI) { if (wr == 0) PG8_BAR; }
        if constexpr (ES == 1) asm volatile("s_nop 15\n\ts_nop 15" ::: "memory");
        E(acc, cur, wr, wc, fr, fq); S.done(cur);
        if (!has_next) break;
#pragma unroll
        for (int a = 0; a < 2; ++a)
#pragma unroll
            for (int b = 0; b < 2; ++b)
#pragma unroll
                for (int m = 0; m < 4; ++m)
#pragma unroll
                    for (int n = 0; n < 2; ++n) acc[a][b][m][n] = (f32x4){0.f, 0.f, 0.f, 0.f};
        cur = nxt; cA = nA; cB = nB; ++ui;
        if constexpr (ALIGN_EPI) { if (wr == 1) PG8_BAR; }
    }
    PG8_WAIT_V(0);
    if constexpr (!ALIGN_EPI) { if (wr == 0) PG8_BAR; }
    PG8_BAR;
#undef PG8_SA
#undef PG8_SB
#undef PG8_STAGE
#undef PG8_LDA
#undef PG8_CAT
#undef PG8_LO
#undef PG8_HI
#undef PG8_LDB
#undef PG8_MMA
#undef PG8_WAIT_V
#undef PG8_WAIT_L
#undef PG8_BAR
#undef PG8_SCHED
}
}

constexpr int NWAVES = 8;
constexpr int BATCH = 4, SEQ = 2048, DM = 4096, M = BATCH * SEQ;
constexpr int NH = 16, HD = 128, NKV = 4, ATTW = 2048, KVW = 512, IH = 32, IDIM = 64, TOPK = 256;
constexpr int GMW = 2048, GMG = 8, GMGW = 256, GMC = 128, DFF = 11008, F2 = 2 * DFF;
constexpr int IN_W = 17504, MODW = 6 * DM;
constexpr float EPS = 1e-6f;
constexpr int PQ = 0, PK = 2048, PV = 2560, PQI = 3072, PGU = 5120, PGV = 7168, PGA = 9216, PGB = 13312, PKI = 17408, PWI = 17472, PNP = 17664;
constexpr int SQ = 0, SK = 2048, SV = 2560, SQI = 3072, SKI = 5120, SWI = 5184, SGU = 5216, SGV = 7264, SGA = 9312, SGB = 13408;

constexpr size_t MiB = 1u << 20;
constexpr size_t WS_CTL = 0, CTL_ZERO_BYTES = 2 * MiB;
constexpr size_t WS_MOD = 1 * MiB;
constexpr size_t WS_WIN = 2 * MiB;
constexpr size_t WS_WA = 140 * MiB, WS_WB = 156 * MiB;
constexpr size_t WS_WOUT = 172 * MiB;
constexpr size_t WS_WUP = 204 * MiB;
constexpr size_t WS_WDN = 376 * MiB;
constexpr size_t WS_H = 462 * MiB;
constexpr size_t WS_X1 = 526 * MiB;
constexpr size_t WS_PROJ = 654 * MiB;
constexpr size_t WS_MASK = 930 * MiB;
constexpr size_t WS_RS = 932 * MiB;
constexpr size_t WS_SWT = 932 * MiB + 65536;
constexpr size_t WS_VT = 933 * MiB;
constexpr size_t WS_YA = 941 * MiB, WS_YB = 973 * MiB;
constexpr size_t WS_MRG = 1005 * MiB;
constexpr size_t WS_TMP = 1069 * MiB;
constexpr size_t WS_A = 654 * MiB;
constexpr size_t WS_ACT = 998 * MiB;
constexpr size_t WS_WINB = 1197 * MiB;
constexpr size_t WS_END = 1336 * MiB;
static_assert(WS_WIN + (size_t)PNP * DM * 2 <= WS_WA && WS_WUP + (size_t)F2 * DM * 2 <= WS_WDN && WS_WDN + (size_t)DM * DFF * 2 <= WS_H, "ws map 1");
static_assert(WS_PROJ + (size_t)M * PNP * 2 <= WS_MASK && WS_A + (size_t)M * F2 * 2 <= WS_ACT && WS_ACT + (size_t)M * DFF * 2 <= WS_END && WS_TMP + (size_t)M * DM * 4 <= WS_END, "ws map 2");
constexpr int CW_TMO = 0, CW_CODE = 1, CW_BAR = 4096;

constexpr int RING_OFF = 0, RING_BYTES = 131072;
constexpr int LDSCTL_OFF = RING_BYTES + 8192, MISC_OFF = LDSCTL_OFF + 320;
constexpr int LDS_BYTES = 147456;
static_assert(MISC_OFF + 128 <= LDS_BYTES, "LDS map");

#define GAS __attribute__((address_space(1)))
#define LAS __attribute__((address_space(3)))
typedef unsigned short bf16;
typedef unsigned v4u __attribute__((ext_vector_type(4)));
typedef unsigned v2u __attribute__((ext_vector_type(2)));
typedef float f32x4 __attribute__((ext_vector_type(4)));
typedef float f32x16 __attribute__((ext_vector_type(16)));
typedef short bf16x8 __attribute__((ext_vector_type(8)));
typedef short bf16x4 __attribute__((ext_vector_type(4)));
typedef GAS unsigned gu32;
#define RLX_AGENT __ATOMIC_RELAXED, __HIP_MEMORY_SCOPE_AGENT
#define LDS_WAIT() asm volatile("s_waitcnt lgkmcnt(0)" ::: "memory")
#define VM_WAIT() asm volatile("s_waitcnt vmcnt(0)" ::: "memory")
__device__ __forceinline__ unsigned f2bf(float f) { unsigned u = __builtin_bit_cast(unsigned, f); return (u + 0x7fffu + ((u >> 16) & 1u)) >> 16; }
__device__ __forceinline__ unsigned pk2(float lo, float hi) { return pg8::cvt_pk_bf16(lo, hi); }
__device__ __forceinline__ float bf2f(bf16 h) { return __builtin_bit_cast(float, (unsigned)h << 16); }
using pg8::bflo; using pg8::bfhi;
constexpr float S_H2 = 16.f, S_WUP = 1024.f, S_ACT = 4.f, S_WDN = 1024.f, S_A = 16.f, S_YA = 16.f, S_YB = 8.f, S_MRG = 16.f, S_WA = 1024.f, S_WB = 1024.f, S_WOUT = 1024.f;
__device__ __forceinline__ float clamp448(float x) { return __builtin_amdgcn_fmed3f(x, -448.f, 448.f); }
__device__ __forceinline__ unsigned pk4_fp8(float a, float b, float c, float d) {
    int w = __builtin_amdgcn_cvt_pk_fp8_f32(clamp448(a), clamp448(b), 0, false);
    w = __builtin_amdgcn_cvt_pk_fp8_f32(clamp448(c), clamp448(d), w, true);
    return (unsigned)w;
}

#define XB_TMO      128
#define XB_XCNT(j)  (256  + 64 * (j))
#define XB_XSUB(j)  (1280 + 64 * (j))
#define XB_XGEN(j)  (2304 + 64 * (j))
#define XB_TOP      3328
#define XB_TOPGEN   3392
#define XCD_BAR_WORDS 3456
#define XB_SPIN_CAP (1u << 18)
__device__ __forceinline__ unsigned xb_ld(unsigned* p)              { return __hip_atomic_load(p, __ATOMIC_RELAXED, __HIP_MEMORY_SCOPE_AGENT); }
__device__ __forceinline__ unsigned xb_add(unsigned* p, unsigned v) { return __hip_atomic_fetch_add(p, v, __ATOMIC_RELAXED, __HIP_MEMORY_SCOPE_AGENT); }
__device__ __forceinline__ unsigned xb_xcc_id() { return (unsigned)__builtin_amdgcn_s_getreg((3 << 11) | 20) & 0xFu; }
#define XB_SPIN(cond, bar) do { unsigned _sp = 0; while (cond) { __builtin_amdgcn_s_sleep(1); \
    if ((++_sp & 255u) == 0u) { if (xb_ld(&(bar)[XB_TMO])) break; if (_sp > XB_SPIN_CAP) { atomicAdd(&(bar)[XB_TMO], 1u); break; } } } } while (0)
struct XcdBarrier { unsigned* bar; unsigned x; volatile LAS unsigned* st; };
__device__ __forceinline__ XcdBarrier xcd_barrier_post(unsigned* bar, volatile LAS unsigned* st) {
    XcdBarrier b; b.bar = bar; b.x = xb_xcc_id(); b.st = st;
    if (threadIdx.x == 0) (void)xb_add(&bar[XB_XCNT(b.x)], 1u);
    return b;
}
__device__ __forceinline__ void xcd_barrier_complete(unsigned* bar, unsigned x, unsigned& nloc, unsigned& nx) {
    const unsigned G = gridDim.x * gridDim.y * gridDim.z;
    unsigned sum, cnt, mine, sp = 0u;
    for (;;) {
        sum = 0u; cnt = 0u; mine = 0u;
#pragma unroll
        for (unsigned j = 0; j < 16; ++j) { const unsigned c = xb_ld(&bar[XB_XCNT(j)]); sum += c; cnt += (c > 0u) ? 1u : 0u; mine = (j == x) ? c : mine; }
        if (sum == G) break;
        __builtin_amdgcn_s_sleep(1);
        if ((++sp & 255u) == 0u) { if (xb_ld(&bar[XB_TMO])) break; if (sp > XB_SPIN_CAP) { atomicAdd(&bar[XB_TMO], 1u); break; } }
    }
    nloc = mine > 0u ? mine : 1u; nx = cnt > 0u ? cnt : 1u;
}
__device__ __forceinline__ void xcd_barrier(const XcdBarrier& b) {
    asm volatile("s_waitcnt vmcnt(0)" ::: "memory");
    __syncthreads();
    if (threadIdx.x == 0) {
        unsigned* bar = b.bar;
        __builtin_amdgcn_s_waitcnt(0);
        unsigned nloc = b.st[0], nx = b.st[1];
        if (nloc == 0u) { xcd_barrier_complete(bar, b.x, nloc, nx); b.st[0] = nloc; b.st[1] = nx; }
        const unsigned old = xb_add(&bar[XB_XSUB(b.x)], 1u);
        const unsigned gen = old / nloc;
        if (old + 1u == (gen + 1u) * nloc) {
            __builtin_amdgcn_fence(__ATOMIC_RELEASE, "agent");
            asm volatile("s_waitcnt vmcnt(0)" ::: "memory");
            const unsigned og = xb_add(&bar[XB_TOP], 1u);
            const unsigned tg = og / nx;
            if (og + 1u == (tg + 1u) * nx) xb_add(&bar[XB_TOPGEN], 1u);
            else XB_SPIN(xb_ld(&bar[XB_TOPGEN]) == tg, bar);
            __builtin_amdgcn_fence(__ATOMIC_ACQUIRE, "agent");
            xb_add(&bar[XB_XGEN(b.x)], 1u);
            asm volatile("s_waitcnt vmcnt(0)" ::: "memory");
        } else {
            XB_SPIN(xb_ld(&bar[XB_XGEN(b.x)]) == gen, bar);
            __builtin_amdgcn_fence(__ATOMIC_ACQUIRE, "agent");
            asm volatile("s_waitcnt vmcnt(0)" ::: "memory");
        }
    }
    __syncthreads();
}

struct Frame {
    LAS unsigned char* lds;
    volatile LAS unsigned* MISC;
    gu32* ctl;
    int tid, lane, wave, G, gw, NGW;
    const float *x, *c, *ada_w, *ada_b, *n1g, *w_in, *qng, *kng, *sgg, *sgw, *sgb, *w_a, *w_b, *w_out, *n2g, *w_up, *cvw, *cvb, *w_dn;
    float* out;
    float *MOD, *PART; bf16 *WINB; unsigned char* H8A; bf16 *WIN, *WA, *WB, *WOUT, *WUP, *WDN, *H, *PROJ, *VT, *YA, *YB, *MRG, *A, *ACT; float *X1, *TMP, *RS, *SWT; unsigned* MASK;
};
__device__ __forceinline__ void xor32_pair(float x, float& lo, float& hi) {
    float a = x, b = x; asm volatile("s_nop 1\n\tv_permlane32_swap_b32 %0, %1" : "+v"(a), "+v"(b)); lo = a; hi = b; }
__device__ __forceinline__ float xor32_sum(float x) { float lo, hi; xor32_pair(x, lo, hi); return lo + hi; }
__device__ __forceinline__ float xor32_max(float x) { float lo, hi; xor32_pair(x, lo, hi); return fmaxf(lo, hi); }
__device__ __forceinline__ float wave_sum(float v) {
#pragma unroll
    for (int o = 1; o < 32; o <<= 1) v += __shfl_xor(v, o);
    v = xor32_sum(v);
    return v;
}

__device__ __forceinline__ int win_dst_row(int n) {
    if (n < SKI) return n;
    if (n < SWI) return PKI + (n - SKI);
    if (n < SGU) return PWI + (n - SWI);
    return PGU + (n - SGU);
}
__device__ __forceinline__ void gemv_item(Frame& F, int item) {
    const int nb = item % 96, ks = item / 96, n0 = nb * 256 + 4 * F.lane, k0 = ks * 64;
    float cs[4];
#pragma unroll
    for (int b = 0; b < 4; ++b) { const float cv = F.c[b * DM + k0 + F.lane]; cs[b] = cv * pg8::sigmoidf_(cv); }
    f32x4 acc[4];
#pragma unroll
    for (int b = 0; b < 4; ++b) acc[b] = (f32x4){0.f, 0.f, 0.f, 0.f};
    const float* wp = F.ada_w + (size_t)k0 * MODW + n0;
#pragma unroll 16
    for (int k = 0; k < 64; ++k) { const f32x4 w = *(const GAS f32x4*)(wp + (size_t)k * MODW);
#pragma unroll
        for (int b = 0; b < 4; ++b) { const float s = __builtin_bit_cast(float, __builtin_amdgcn_readlane(__builtin_bit_cast(int, cs[b]), k)); acc[b] += w * s; } }
#pragma unroll
    for (int b = 0; b < 4; ++b) *(GAS f32x4*)(F.PART + (size_t)(ks * 4 + b) * MODW + n0) = acc[b];
}
__device__ __forceinline__ void mod_reduce(Frame& F) {
    for (int i = F.gw * 64 + F.lane; i < 4 * (MODW / 4); i += F.NGW * 64) { const int b = i / (MODW / 4), n0 = 4 * (i % (MODW / 4));
        f32x4 a = *(const GAS f32x4*)(F.ada_b + n0);
#pragma unroll 16
        for (int ks = 0; ks < 64; ++ks) a += *(const GAS f32x4*)(F.PART + (size_t)(ks * 4 + b) * MODW + n0);
        *(GAS f32x4*)(F.MOD + b * MODW + n0) = a; }
}
struct TrItem { const float* src; unsigned char* d8; bf16* db; int Nsrc, ldk, drow0, k0; float scale; };
__device__ __forceinline__ void tr_decode(Frame& F, int r, TrItem& t) {
    constexpr int P_IN = (DM / 128) * (IN_W / 32), P_A = (ATTW / 128) * (DM / 32), P_B = (GMW / 128) * (DM / 32), P_O = (DM / 128) * (DM / 32), P_UP = (DM / 128) * (F2 / 32);
    const float* W; int Nsrc, nblk, ldk, drow; unsigned char* d8; bf16* db = nullptr; float sc; bool up = false, in = false;
    if (r < P_IN) { W = F.w_in; Nsrc = IN_W; nblk = IN_W / 32; d8 = (unsigned char*)F.WIN; ldk = DM; sc = 1024.f; in = true; }
    else if ((r -= P_IN) < P_A) { W = F.w_a; Nsrc = DM; nblk = DM / 32; d8 = (unsigned char*)F.WA; ldk = 2 * ATTW; sc = S_WA; }
    else if ((r -= P_A) < P_B) { W = F.w_b; Nsrc = DM; nblk = DM / 32; d8 = (unsigned char*)F.WA + ATTW; ldk = 2 * ATTW; sc = S_WB; }
    else if ((r -= P_B) < P_O) { W = F.w_out; Nsrc = DM; nblk = DM / 32; d8 = (unsigned char*)F.WOUT; ldk = DM; sc = S_WOUT; }
    else if ((r -= P_O) < P_UP) { W = F.w_up; Nsrc = F2; nblk = F2 / 32; d8 = (unsigned char*)F.WUP; ldk = DM; sc = S_WUP; up = true; }
    else { r -= P_UP; W = F.w_dn; Nsrc = DM; nblk = DM / 32; d8 = (unsigned char*)F.WDN; ldk = DFF; sc = S_WDN; }
    const int kb = r / nblk, n = 32 * (r % nblk);
    drow = n;
    if (in) { drow = win_dst_row(n); if (n >= SQI && n < SGU) db = F.WINB; }
    if (up) { const int ch = n < DFF ? n : n - DFF; drow = (ch >> 7) * 256 + (ch & 127) + (n < DFF ? 0 : 128); }
    t.src = W + (size_t)(128 * kb) * Nsrc + n; t.d8 = d8; t.db = db; t.Nsrc = Nsrc; t.ldk = ldk; t.drow0 = drow; t.k0 = 128 * kb; t.scale = sc;
}
__device__ __forceinline__ void tr_load(const TrItem& t, int half, f32x4 (&v)[8], int lane) {
    const float* p = t.src + (size_t)(64 * half + (lane >> 3)) * t.Nsrc + 4 * (lane & 7);
#pragma unroll
    for (int i = 0; i < 8; ++i) v[i] = *(const GAS f32x4*)(p + (size_t)(8 * i) * t.Nsrc);
}
__device__ __forceinline__ void tr_finish(const TrItem& t, int half, const f32x4 (&v)[8], LAS float* scr, int lane) {
#pragma unroll
    for (int i = 0; i < 8; ++i) { LAS float* s = scr + (8 * i + (lane >> 3)) * 33 + 4 * (lane & 7); s[0] = v[i].x; s[1] = v[i].y; s[2] = v[i].z; s[3] = v[i].w; }
    LDS_WAIT(); asm volatile("" ::: "memory");
    const int c = lane & 7, kcol = t.k0 + 64 * half + 8 * c; const float sc = t.scale;
#pragma unroll
    for (int j = 0; j < 4; ++j) { const int n = (lane >> 3) + 8 * j; const LAS float* s = scr + (8 * c) * 33 + n;
        const float e0 = s[0 * 33], e1 = s[1 * 33], e2 = s[2 * 33], e3 = s[3 * 33], e4 = s[4 * 33], e5 = s[5 * 33], e6 = s[6 * 33], e7 = s[7 * 33];
        v2u o; o.x = pk4_fp8(e0 * sc, e1 * sc, e2 * sc, e3 * sc); o.y = pk4_fp8(e4 * sc, e5 * sc, e6 * sc, e7 * sc);
        *(GAS v2u*)(t.d8 + (size_t)(t.drow0 + n) * t.ldk + kcol) = o;
        if (t.db) { v4u ob; ob.x = pk2(e0, e1); ob.y = pk2(e2, e3); ob.z = pk2(e4, e5); ob.w = pk2(e6, e7); *(GAS v4u*)(t.db + (size_t)(t.drow0 + n) * t.ldk + kcol) = ob; } }
    LDS_WAIT(); asm volatile("" ::: "memory");
}
__device__ __forceinline__ void p0_prologue(Frame& F, bool with_gemv = true) {
    LAS float* scr = (LAS float*)(F.lds + RING_OFF + F.wave * 16384);
    constexpr int I_GV = 96 * 64;
    constexpr int NPAIR = (DM / 128) * (IN_W / 32) + (ATTW / 128) * (DM / 32) + (GMW / 128) * (DM / 32) + (DM / 128) * (DM / 32) + (DM / 128) * (F2 / 32) + (DFF / 128) * (DM / 32);
    if (with_gemv) for (int it = F.gw; it < I_GV; it += F.NGW) gemv_item(F, it);
    {
        TrItem A, B; f32x4 a0[8], a1[8], b0[8], b1[8];
        int r = F.gw; bool hasA = r < NPAIR;
        if (hasA) { tr_decode(F, r, A); tr_load(A, 0, a0, F.lane); tr_load(A, 1, a1, F.lane); }
        while (hasA) {
            const int rb = r + F.NGW; const bool hasB = rb < NPAIR;
            if (hasB) { tr_decode(F, rb, B); tr_load(B, 0, b0, F.lane); tr_load(B, 1, b1, F.lane); }
            tr_finish(A, 0, a0, scr, F.lane); tr_finish(A, 1, a1, scr, F.lane);
            if (!hasB) break;
            r = rb + F.NGW; hasA = r < NPAIR;
            if (hasA) { tr_decode(F, r, A); tr_load(A, 0, a0, F.lane); tr_load(A, 1, a1, F.lane); }
            tr_finish(B, 0, b0, scr, F.lane); tr_finish(B, 1, b1, scr, F.lane);
        }
    }
    { const size_t n16 = (size_t)(PNP - IN_W) * DM / 16; GAS v4u* p = (GAS v4u*)((unsigned char*)F.WIN + (size_t)IN_W * DM);
      for (size_t i = (size_t)F.gw * 64 + F.lane; i < n16; i += (size_t)F.NGW * 64) p[i] = (v4u){0u, 0u, 0u, 0u};
      GAS v4u* pb = (GAS v4u*)(F.WINB + (size_t)IN_W * DM);
      for (size_t i = (size_t)F.gw * 64 + F.lane; i < 2 * n16; i += (size_t)F.NGW * 64) pb[i] = (v4u){0u, 0u, 0u, 0u}; }
}

template <int FP8 = 0, bool XBF = false>
__device__ __forceinline__ void norm_rows(Frame& F, const void* X, const float* gain, int sh_off, int sc_off, void* Ov, unsigned char* O8 = nullptr) {
    LAS f32x4* CA = (LAS f32x4*)F.lds; LAS f32x4* CB = (LAS f32x4*)(F.lds + 16384);
    for (int blk = blockIdx.x; blk < M / 32; blk += F.G) {
        const int b = (blk * 32) >> 11;
        __syncthreads();
        for (int i = F.tid; i < DM / 4; i += NWAVES * 64) { const f32x4 g = ((const GAS f32x4*)gain)[i], sh = ((const GAS f32x4*)(F.MOD + b * MODW + sh_off))[i], sc = ((const GAS f32x4*)(F.MOD + b * MODW + sc_off))[i];
            CA[i] = g * (sc + 1.0f); CB[i] = sh; }
        __syncthreads();
        const int m0 = blk * 32 + 4 * F.wave;
        f32x4 va[16], vb[16];
#define NR_LOAD(v, m_) do { if constexpr (XBF) { const GAS v2u* xr = (const GAS v2u*)((const bf16*)X + (size_t)(m_) * DM) + F.lane; _Pragma("unroll") for (int j = 0; j < 16; ++j) { const v2u w_ = xr[64 * j]; v[j] = (f32x4){bflo(w_.x), bfhi(w_.x), bflo(w_.y), bfhi(w_.y)}; } } \
        else { const GAS f32x4* xr = (const GAS f32x4*)((const float*)X + (size_t)(m_) * DM) + F.lane; _Pragma("unroll") for (int j = 0; j < 16; ++j) v[j] = xr[64 * j]; } } while (0)
#define NR_FIN(v, m_) do { float s_ = 0.f; _Pragma("unroll") for (int j = 0; j < 16; ++j) s_ += (v[j].x * v[j].x + v[j].y * v[j].y) + (v[j].z * v[j].z + v[j].w * v[j].w); \
            const float rstd = 1.0f / sqrtf(wave_sum(s_) * (1.f / DM) + EPS); \
            GAS v2u* o8 = (GAS v2u*)((bf16*)Ov + (size_t)(m_) * DM) + F.lane; GAS unsigned* o4 = (GAS unsigned*)((FP8 == 2 ? O8 : (unsigned char*)Ov) + (size_t)(m_) * DM) + F.lane; \
            _Pragma("unroll") for (int j = 0; j < 16; ++j) { const f32x4 y = (v[j] * rstd) * CA[64 * j + F.lane] + CB[64 * j + F.lane]; \
                if constexpr (FP8 != 0) o4[64 * j] = pk4_fp8(y.x * S_H2, y.y * S_H2, y.z * S_H2, y.w * S_H2); \
                if constexpr (FP8 != 1) { v2u w_; w_.x = pk2(y.x, y.y); w_.y = pk2(y.z, y.w); o8[64 * j] = w_; } \
                if ((j & 3) == 3) asm volatile("" ::: "memory"); } } while (0)
        NR_LOAD(va, m0); NR_LOAD(vb, m0 + 1); NR_FIN(va, m0); NR_LOAD(va, m0 + 2); NR_FIN(vb, m0 + 1); NR_LOAD(vb, m0 + 3); NR_FIN(va, m0 + 2); NR_FIN(vb, m0 + 3);
#undef NR_LOAD
#undef NR_FIN
    }
}

__device__ __forceinline__ unsigned sortable(float f) { const unsigned u = __builtin_bit_cast(unsigned, f); return u ^ ((unsigned)((int)u >> 31) | 0x80000000u); }
__device__ __forceinline__ void select_topk(const unsigned (&sc)[32], GAS v2u* mrow, int lane) {
    unsigned thr = 0u;
    for (int bit = 31; bit >= 0; --bit) {
        const unsigned cand = thr | (1u << bit); int cnt = 0;
#pragma unroll
        for (int jp = 0; jp < 32; ++jp) cnt += __popcll(__ballot(sc[jp] >= cand));
        if (cnt >= TOPK) thr = cand;
    }
    int cgt = 0;
#pragma unroll
    for (int jp = 0; jp < 32; ++jp) cgt += __popcll(__ballot(sc[jp] > thr));
    const int need = TOPK - cgt; int seen = 0;
    unsigned mylo = 0u, myhi = 0u;
    const unsigned long long lt = (lane == 0) ? 0ull : (~0ull >> (64 - lane));
#pragma unroll
    for (int jp = 0; jp < 32; ++jp) {
        unsigned long long sel = __ballot(sc[jp] > thr);
        const unsigned long long eq = __ballot(sc[jp] == thr);
        if (eq) { const bool take = (sc[jp] == thr) && (seen + __popcll(eq & lt) < need); sel |= __ballot(take); seen += __popcll(eq); }
        if (lane == jp) { mylo = (unsigned)sel; myhi = (unsigned)(sel >> 32); }
    }
    if (lane < 32) { v2u w; w.x = mylo; w.y = myhi; mrow[lane] = w; }
}
__device__ __forceinline__ void idx_block(Frame& F, int b, int blk) {
    const int lane = F.lane, w = F.wave, hi = lane >> 5, l31 = lane & 31, tid = F.tid;
    const int t0 = blk * 8, tq = t0 + w;
    const size_t row = (size_t)b * SEQ + tq;
    GAS v2u* mrow = (GAS v2u*)(F.MASK + row * 64);
    if (t0 < TOPK) {
        if (lane < 32) { const int k0 = 64 * lane; v2u mw;
            mw.x = (tq >= k0 + 31) ? 0xffffffffu : (tq < k0 ? 0u : ((2u << (tq - k0)) - 1u));
            mw.y = (tq >= k0 + 63) ? 0xffffffffu : (tq < k0 + 32 ? 0u : ((2u << (tq - k0 - 32)) - 1u));
            mrow[lane] = mw; }
        return;
    }
    const int nt = (t0 + 7) / 128 + 1;
    const bf16* prow = F.PROJ + row * PNP;
    bf16x8 qa[4]; float wv[16];
#pragma unroll
    for (int ks = 0; ks < 4; ++ks) qa[ks] = *(const GAS bf16x8*)(prow + PQI + l31 * 64 + 16 * ks + 8 * hi);
#pragma unroll
    for (int r = 0; r < 16; ++r) wv[r] = bf2f(prow[PWI + (r & 3) + 8 * (r >> 2) + 4 * hi]);
    const bf16* ksrc = F.PROJ + ((size_t)b * SEQ + (tid >> 3)) * PNP + PKI + 8 * (tid & 7);
    const int kdst = (tid >> 3) * 128 + (((tid & 7) ^ ((tid >> 3) & 7)) << 4);
    const int krd = l31 * 128;
    unsigned sc[32];
    __syncthreads();
    v4u stg0 = *(const GAS v4u*)ksrc, stg1 = *(const GAS v4u*)(ksrc + (size_t)64 * PNP);
#pragma unroll
    for (int kt = 0; kt < 16; ++kt) {
        if (kt < nt) {
            LAS unsigned char* kb_base = F.lds + (kt & 1) * 16384;
            *(LAS v4u*)(kb_base + kdst) = stg0; *(LAS v4u*)(kb_base + 8192 + kdst) = stg1;
            if (kt + 1 < nt) { stg0 = *(const GAS v4u*)(ksrc + (size_t)(kt + 1) * 128 * PNP); stg1 = *(const GAS v4u*)(ksrc + (size_t)((kt + 1) * 128 + 64) * PNP); }
            LDS_WAIT(); __builtin_amdgcn_s_barrier(); asm volatile("" ::: "memory");
            float s4[4];
#pragma unroll
            for (int h = 0; h < 4; ++h) {
                f32x16 acc;
#pragma unroll
                for (int r = 0; r < 16; ++r) acc[r] = 0.f;
#pragma unroll
                for (int ks = 0; ks < 4; ++ks) { const bf16x8 kf = *(const LAS bf16x8*)(kb_base + h * 4096 + krd + (((2 * ks + hi) ^ (l31 & 7)) << 4));
                    acc = __builtin_amdgcn_mfma_f32_32x32x16_bf16(qa[ks], kf, acc, 0, 0, 0); }
                float x0 = 0.f, x1 = 0.f;
#pragma unroll
                for (int r = 0; r < 16; r += 2) { x0 += wv[r] * fmaxf(acc[r], 0.f); x1 += wv[r + 1] * fmaxf(acc[r + 1], 0.f); }
                s4[h] = xor32_sum(x0 + x1);
            }
            const float ma = (lane < 32 ? s4[0] : s4[1]) + 0.0f, mb = (lane < 32 ? s4[2] : s4[3]) + 0.0f;
            sc[2 * kt] = (128 * kt + lane <= tq) ? sortable(ma) : 0u;
            sc[2 * kt + 1] = (128 * kt + 64 + lane <= tq) ? sortable(mb) : 0u;
        } else { sc[2 * kt] = 0u; sc[2 * kt + 1] = 0u; }
    }
    select_topk(sc, mrow, lane);
}
constexpr float QSCALE = 0.08838834764831845f * 1.4426950408889634f;
__device__ __forceinline__ void qknorm_row(Frame& F, int row) {
    bf16* prow = F.PROJ + (size_t)row * PNP; const int lane = F.lane;
    {
        GAS v4u* p = (GAS v4u*)(prow + PQ + 32 * lane); v4u w[4]; float ss = 0.f;
#pragma unroll
        for (int i = 0; i < 4; ++i) { w[i] = p[i];
#pragma unroll
            for (int j = 0; j < 4; ++j) { const float a = bflo(w[i][j]), c = bfhi(w[i][j]); ss += a * a + c * c; } }
        ss += __shfl_xor(ss, 1); ss += __shfl_xor(ss, 2);
        const float r = QSCALE / sqrtf(ss * (1.f / HD) + EPS); const float* g = F.qng + 32 * (lane & 3);
#pragma unroll
        for (int i = 0; i < 4; ++i) { v4u o;
#pragma unroll
            for (int j = 0; j < 4; ++j) o[j] = pk2(bflo(w[i][j]) * r * g[8 * i + 2 * j], bfhi(w[i][j]) * r * g[8 * i + 2 * j + 1]);
            p[i] = o; }
    }
    {
        GAS v4u* p = (GAS v4u*)(prow + PK + 8 * lane); const v4u w = *p; float ss = 0.f;
#pragma unroll
        for (int j = 0; j < 4; ++j) { const float a = bflo(w[j]), c = bfhi(w[j]); ss += a * a + c * c; }
        ss += __shfl_xor(ss, 1); ss += __shfl_xor(ss, 2); ss += __shfl_xor(ss, 4); ss += __shfl_xor(ss, 8);
        const float r = 1.0f / sqrtf(ss * (1.f / HD) + EPS); const float* g = F.kng + 8 * (lane & 15); v4u o;
#pragma unroll
        for (int j = 0; j < 4; ++j) o[j] = pk2(bflo(w[j]) * r * g[2 * j], bfhi(w[j]) * r * g[2 * j + 1]);
        *p = o;
    }
    {
        const GAS v4u* p = (const GAS v4u*)(prow + PGV + 32 * lane); float ss = 0.f;
#pragma unroll
        for (int i = 0; i < 4; ++i) { const v4u w = p[i];
#pragma unroll
            for (int j = 0; j < 4; ++j) { const float a = bflo(w[j]), c = bfhi(w[j]); ss += a * a + c * c; } }
        ss = wave_sum(ss);
        if (lane == 0) F.RS[row] = 1.0f / sqrtf(ss * (1.f / GMW) + EPS);
    }
}
__device__ __forceinline__ void vt_item(Frame& F, int item) {
    const int s8 = item & 255, dh = (item >> 8) & 1, g = (item >> 9) & 3, b = item >> 11, d = 64 * dh + F.lane;
    const bf16* src = F.PROJ + (size_t)(b * SEQ + 8 * s8) * PNP + PV + g * HD + d;
    unsigned e[8];
#pragma unroll
    for (int j = 0; j < 8; ++j) e[j] = src[(size_t)j * PNP];
    v4u o; o.x = e[0] | (e[1] << 16); o.y = e[2] | (e[3] << 16); o.z = e[4] | (e[5] << 16); o.w = e[6] | (e[7] << 16);
    *(GAS v4u*)(F.VT + ((size_t)((b * NKV + g) * HD + d)) * SEQ + 8 * s8) = o;
}

constexpr int AT_KSTR = 272, AT_VSTR = 136, AT_TILE = 17408;
#define RAW_BARRIER() do { LDS_WAIT(); __builtin_amdgcn_s_barrier(); asm volatile("" ::: "memory"); } while (0)
__device__ __forceinline__ void attn_block(Frame& F, int b, int g, int qb, float sbound) {
    const int lane = F.lane, w = F.wave, hi = lane >> 5, l31 = lane & 31, tid = F.tid;
    const int hh = 4 * g + (w >> 1), tw0 = qb * 64 + 32 * (w & 1), t = tw0 + l31;
    const size_t row = (size_t)b * SEQ + t;
    const float slope2 = exp2f(-0.5f * (float)(hh + 1)) * 1.4426950408889634f;
    bf16x8 qf[8];
#pragma unroll
    for (int ks = 0; ks < 8; ++ks) qf[ks] = *(const GAS bf16x8*)(F.PROJ + row * PNP + PQ + hh * HD + 16 * ks + 8 * hi);
    f32x16 o[4];
#pragma unroll
    for (int db = 0; db < 4; ++db)
#pragma unroll
        for (int r = 0; r < 16; ++r) o[db][r] = 0.f;
    float m = -1e30f, lsum = 0.f;
    const bf16* ksrc = F.PROJ + ((size_t)b * SEQ + (tid >> 4)) * PNP + PK + g * HD + 8 * (tid & 15);
    const int kdst = (tid >> 4) * AT_KSTR + (tid & 15) * 16;
    const bf16* vsrc = F.VT + ((size_t)((b * NKV + g) * HD + (tid >> 3))) * SEQ + 8 * (tid & 7);
    const int vdst = 2 * AT_TILE + (tid >> 3) * AT_VSTR + (tid & 7) * 16;
    const unsigned* mbase = F.MASK + row * 64;
    LAS unsigned char* L = F.lds;
    v4u sk0, sk1, sv0, sv1; v2u mw, mwn;
#define AT_LOAD(kt_) do { sk0 = *(const GAS v4u*)(ksrc + (size_t)(64 * (kt_)) * PNP); sk1 = *(const GAS v4u*)(ksrc + (size_t)(64 * (kt_) + 32) * PNP); \
        sv0 = *(const GAS v4u*)(vsrc + 64 * (kt_)); sv1 = *(const GAS v4u*)(vsrc + (size_t)64 * SEQ + 64 * (kt_)); mwn = *(const GAS v2u*)(mbase + 2 * (kt_)); } while (0)
#define AT_STORE(bf_) do { *(LAS v4u*)(L + (bf_) * AT_TILE + kdst) = sk0; *(LAS v4u*)(L + (bf_) * AT_TILE + kdst + 32 * AT_KSTR) = sk1; \
        LAS unsigned char* _v = L + (bf_) * AT_TILE + vdst; *(LAS v2u*)_v = (v2u){sv0.x, sv0.y}; *(LAS v2u*)(_v + 8) = (v2u){sv0.z, sv0.w}; \
        *(LAS v2u*)(_v + 64 * AT_VSTR) = (v2u){sv1.x, sv1.y}; *(LAS v2u*)(_v + 64 * AT_VSTR + 8) = (v2u){sv1.z, sv1.w}; } while (0)
    RAW_BARRIER();
    AT_LOAD(qb); AT_STORE(0); mw = mwn;
    int buf = 0; bool dead = false;
    for (int kt = qb; kt >= 0; --kt) {
        if (kt > 0) AT_LOAD(kt - 1);
        RAW_BARRIER();
        if (!dead) {
            const float dmin = (float)(tw0 - (64 * kt + 63));
            dead = __all((sbound - slope2 * dmin) < (m - 40.0f));
        }
        if (!dead) {
            const LAS unsigned char* kb_ = L + buf * AT_TILE + l31 * AT_KSTR + hi * 16;
            const LAS unsigned char* vb_ = L + buf * AT_TILE + 2 * AT_TILE + l31 * AT_VSTR + hi * 8;
            f32x16 p[2];
#pragma unroll
            for (int kb = 0; kb < 2; ++kb) {
#pragma unroll
                for (int r = 0; r < 16; ++r) p[kb][r] = 0.f;
#pragma unroll
                for (int ks = 0; ks < 8; ++ks) { const bf16x8 kf = *(const LAS bf16x8*)(kb_ + kb * 32 * AT_KSTR + ks * 32); p[kb] = __builtin_amdgcn_mfma_f32_32x32x16_bf16(kf, qf[ks], p[kb], 0, 0, 0); }
            }
            const float base = -slope2 * (float)(t - 64 * kt - 4 * hi);
            float rmax = -3e30f;
#pragma unroll
            for (int kb = 0; kb < 2; ++kb) { const unsigned mword = (kb ? mw.y : mw.x) >> (4 * hi);
#pragma unroll
                for (int r = 0; r < 16; ++r) { const int ko = (r & 3) + 8 * (r >> 2);
                    float sv = p[kb][r] + slope2 * (float)(32 * kb + ko);
                    sv = ((mword >> ko) & 1u) ? sv : -2e30f; p[kb][r] = sv; rmax = fmaxf(rmax, sv); } }
            rmax += base; rmax = xor32_max(rmax);
            const float mn = fmaxf(m, rmax), alpha = __builtin_amdgcn_exp2f(m - mn), mrel = mn - base;
            const bool moved = __any(mn != m);
            m = mn;
            float ps = 0.f;
#pragma unroll
            for (int kb = 0; kb < 2; ++kb)
#pragma unroll
                for (int r = 0; r < 16; ++r) { const float e = __builtin_amdgcn_exp2f(p[kb][r] - mrel); p[kb][r] = e; ps += e; }
            lsum = lsum * alpha + ps;
            if (moved) {
#pragma unroll
                for (int db = 0; db < 4; ++db)
#pragma unroll
                    for (int r = 0; r < 16; ++r) o[db][r] *= alpha;
            }
#pragma unroll
            for (int kb = 0; kb < 2; ++kb)
#pragma unroll
                for (int s2 = 0; s2 < 2; ++s2) {
                    v4u pw; pw.x = pk2(p[kb][8 * s2 + 0], p[kb][8 * s2 + 1]); pw.y = pk2(p[kb][8 * s2 + 2], p[kb][8 * s2 + 3]); pw.z = pk2(p[kb][8 * s2 + 4], p[kb][8 * s2 + 5]); pw.w = pk2(p[kb][8 * s2 + 6], p[kb][8 * s2 + 7]);
                    const bf16x8 pb = __builtin_bit_cast(bf16x8, pw);
#pragma unroll
                    for (int db = 0; db < 4; ++db) { const LAS unsigned char* vp = vb_ + db * 32 * AT_VSTR + kb * 64 + s2 * 32;
                        const v2u v0 = *(const LAS v2u*)vp, v1 = *(const LAS v2u*)(vp + 16);
                        v4u vw; vw.x = v0.x; vw.y = v0.y; vw.z = v1.x; vw.w = v1.y;
                        o[db] = __builtin_amdgcn_mfma_f32_32x32x16_bf16(__builtin_bit_cast(bf16x8, vw), pb, o[db], 0, 0, 0); }
                }
        }
        if (kt > 0) { AT_STORE(buf ^ 1); mw = mwn; }
        buf ^= 1;
    }
#undef AT_LOAD
#undef AT_STORE
    lsum = xor32_sum(lsum);
    const float inv = S_YA / lsum;
    unsigned char* yrow = (unsigned char*)F.YA + row * (2 * ATTW) + hh * HD + 4 * hi;
#pragma unroll
    for (int db = 0; db < 4; ++db)
#pragma unroll
        for (int rq = 0; rq < 4; ++rq) *(GAS unsigned*)(yrow + 32 * db + 8 * rq) = pk4_fp8(o[db][4 * rq] * inv, o[db][4 * rq + 1] * inv, o[db][4 * rq + 2] * inv, o[db][4 * rq + 3] * inv);
}
__device__ __forceinline__ float attn_score_bound(Frame& F) {
    float gq = fmaxf(fabsf(F.qng[F.lane]), fabsf(F.qng[F.lane + 64])), gk = fmaxf(fabsf(F.kng[F.lane]), fabsf(F.kng[F.lane + 64]));
#pragma unroll
    for (int o = 1; o < 64; o <<= 1) { gq = fmaxf(gq, __shfl_xor(gq, o)); gk = fmaxf(gk, __shfl_xor(gk, o)); }
    return 1.02f * 128.0f * gq * gk * QSCALE;
}

constexpr int SG_STR = 272, SG_WOFF = 65536;
__device__ __forceinline__ void sgu_unit(Frame& F, int unit) {
    const int ck = unit >> 3, g = unit & 7, r0 = ck * GMC, c0 = g * GMGW, tid = F.tid, lane = F.lane, w = F.wave, hi = lane >> 5, l31 = lane & 31;
    LAS unsigned char* L = F.lds;
    const int rs_ = tid >> 5, q_ = tid & 31;
    __syncthreads();
#pragma unroll
    for (int i = 0; i < 8; ++i) *(LAS v4u*)(L + (rs_ + 16 * i) * 512 + q_ * 16) = *(const GAS v4u*)(F.PROJ + (size_t)(r0 + rs_ + 16 * i) * PNP + PGV + c0 + 8 * q_);
    { const f32x4 q = *(const GAS f32x4*)(F.RS + r0 + 4 * q_);
#pragma unroll
      for (int i = 0; i < 8; ++i) { const int t_ = rs_ + 16 * i; const f32x4 wv = *(const GAS f32x4*)(F.sgw + ((size_t)(g * GMC + t_)) * GMC + 4 * q_);
          const int sb = 4 * q_; v2u o;
          o.x = pk2(sb + 0 <= t_ ? wv.x * q.x : 0.f, sb + 1 <= t_ ? wv.y * q.y : 0.f); o.y = pk2(sb + 2 <= t_ ? wv.z * q.z : 0.f, sb + 3 <= t_ ? wv.w * q.w : 0.f);
          *(LAS v2u*)(L + SG_WOFF + t_ * SG_STR + 8 * q_) = o; } }
    __syncthreads();
    v4u uu[8];
#pragma unroll
    for (int i = 0; i < 8; ++i) uu[i] = *(const GAS v4u*)(F.PROJ + (size_t)(r0 + rs_ + 16 * i) * PNP + PGU + c0 + 8 * q_);
    f32x16 acc[4];
#pragma unroll
    for (int tb = 0; tb < 4; ++tb)
#pragma unroll
        for (int r = 0; r < 16; ++r) acc[tb][r] = 0.f;
    const LAS unsigned char* xb = L + hi * 8 * 512 + 2 * (32 * w + l31);
    const LAS unsigned char* wa = L + SG_WOFF + l31 * SG_STR + hi * 16;
#pragma unroll
    for (int ks = 0; ks < 8; ++ks) {
        v4u xw;
#pragma unroll
        for (int j = 0; j < 4; ++j) { const unsigned lo = *(const LAS unsigned short*)(xb + (16 * ks + 2 * j) * 512), hh = *(const LAS unsigned short*)(xb + (16 * ks + 2 * j + 1) * 512); xw[j] = lo | (hh << 16); }
        const bf16x8 xf = __builtin_bit_cast(bf16x8, xw);
#pragma unroll
        for (int tb = 0; tb < 4; ++tb) if (ks < 2 * (tb + 1)) { const bf16x8 wf = *(const LAS bf16x8*)(wa + tb * 32 * SG_STR + ks * 32); acc[tb] = __builtin_amdgcn_mfma_f32_32x32x16_bf16(wf, xf, acc[tb], 0, 0, 0); } }
    LDS_WAIT(); __builtin_amdgcn_s_barrier(); asm volatile("" ::: "memory");
    { const int cl = 32 * w + l31;
#pragma unroll
      for (int tb = 0; tb < 4; ++tb)
#pragma unroll
          for (int r = 0; r < 16; ++r) { const int t = 32 * tb + (r & 3) + 8 * (r >> 2) + 4 * hi; *(LAS unsigned short*)(L + t * 512 + 2 * cl) = (unsigned short)f2bf(acc[tb][r]); } }
    const f32x4 g0 = *(const GAS f32x4*)(F.sgg + c0 + 8 * q_), g1 = *(const GAS f32x4*)(F.sgg + c0 + 8 * q_ + 4);
    LDS_WAIT(); __builtin_amdgcn_s_barrier(); asm volatile("" ::: "memory");
#pragma unroll
    for (int i = 0; i < 8; ++i) { const v4u fw = *(const LAS v4u*)(L + (rs_ + 16 * i) * 512 + q_ * 16); const float bb = F.sgb[g * GMC + rs_ + 16 * i]; v2u o;
        o.x = pk4_fp8(S_YB * bflo(uu[i].x) * (bflo(fw.x) * g0.x + bb), S_YB * bfhi(uu[i].x) * (bfhi(fw.x) * g0.y + bb), S_YB * bflo(uu[i].y) * (bflo(fw.y) * g0.z + bb), S_YB * bfhi(uu[i].y) * (bfhi(fw.y) * g0.w + bb));
        o.y = pk4_fp8(S_YB * bflo(uu[i].z) * (bflo(fw.z) * g1.x + bb), S_YB * bfhi(uu[i].z) * (bfhi(fw.z) * g1.y + bb), S_YB * bflo(uu[i].w) * (bflo(fw.w) * g1.z + bb), S_YB * bfhi(uu[i].w) * (bfhi(fw.w) * g1.w + bb));
        *(GAS v2u*)((unsigned char*)F.YA + (size_t)(r0 + rs_ + 16 * i) * (2 * ATTW) + ATTW + c0 + 8 * q_) = o; }
}

using pg8::Unit; using pg8::cvt_pk_bf16;
struct EpiProj {
    static constexpr bool PERM = true, MIDK = false; bf16* O; float scale;
    __device__ __forceinline__ void operator()(const f32x4 (&acc)[2][2][4][2], const Unit& u, int wr, int wc, int fr, int fq) const {
        const int act = (u.pn >= PGU / 256 && u.pn < PGA / 256) ? 1 : ((u.pn >= PGA / 256 && u.pn < PKI / 256) ? 2 : 0);
        const int row0 = u.pm * 256 + wr * 64 + fr, col0 = u.pn * 256 + wc * 32 + 8 * fq;
#pragma unroll
        for (int ai = 0; ai < 2; ++ai)
#pragma unroll
            for (int m = 0; m < 4; ++m) { bf16* rowp = O + (size_t)(row0 + ai * 128 + m * 16) * PNP + col0;
#pragma unroll
                for (int bj = 0; bj < 2; ++bj) { f32x4 v0 = acc[ai][bj][m][0] * scale, v1 = acc[ai][bj][m][1] * scale;
                    if (act == 1) { const pg8::f32x2 a = pg8::gelu_pk((pg8::f32x2){v0[0], v0[1]}), b = pg8::gelu_pk((pg8::f32x2){v0[2], v0[3]}), c = pg8::gelu_pk((pg8::f32x2){v1[0], v1[1]}), d = pg8::gelu_pk((pg8::f32x2){v1[2], v1[3]});
                        v0 = (f32x4){a.x, a.y, b.x, b.y}; v1 = (f32x4){c.x, c.y, d.x, d.y}; }
                    else if (act == 2) {
#pragma unroll
                        for (int j = 0; j < 4; ++j) { v0[j] = pg8::sigmoidf_(v0[j]); v1[j] = pg8::sigmoidf_(v1[j]); } }
                    v4u w; w.x = cvt_pk_bf16(v0[0], v0[1]); w.y = cvt_pk_bf16(v0[2], v0[3]); w.z = cvt_pk_bf16(v1[0], v1[1]); w.w = cvt_pk_bf16(v1[2], v1[3]);
                    *(GAS v4u*)(rowp + bj * 128) = w; } }
    }
};
struct EpiMerge {
    static constexpr bool PERM = true, MIDK = true; const bf16* P; unsigned char* O; float cB, ratio;
    __device__ __forceinline__ void mid(f32x4 (&acc)[2][2][4][2], const Unit& u, int wr, int wc, int fr, int fq) const {
        const bf16* pb = P + (size_t)(u.pm * 256 + wr * 64 + fr) * PNP + (u.pn * 256 + wc * 32 + 8 * fq);
        asm volatile("" : "+v"(pb));
#pragma unroll
        for (int ai = 0; ai < 2; ++ai)
#pragma unroll
            for (int m = 0; m < 4; ++m) {
#pragma unroll
                for (int bj = 0; bj < 2; ++bj) { const bf16* q = pb + (size_t)(ai * 128 + m * 16) * PNP + bj * 128;
                    const v4u ga = *(const GAS v4u*)(q + PGA), gb = *(const GAS v4u*)(q + PGB);
#pragma unroll
                    for (int j = 0; j < 2; ++j) { f32x4 f;
                        f.x = ratio * bflo(ga[2 * j]) * __builtin_amdgcn_rcpf(fmaxf(bflo(gb[2 * j]), 1e-30f)); f.y = ratio * bfhi(ga[2 * j]) * __builtin_amdgcn_rcpf(fmaxf(bfhi(gb[2 * j]), 1e-30f));
                        f.z = ratio * bflo(ga[2 * j + 1]) * __builtin_amdgcn_rcpf(fmaxf(bflo(gb[2 * j + 1]), 1e-30f)); f.w = ratio * bfhi(ga[2 * j + 1]) * __builtin_amdgcn_rcpf(fmaxf(bfhi(gb[2 * j + 1]), 1e-30f));
                        acc[ai][bj][m][j] *= f; }
                    asm volatile("" ::: "memory"); } }
    }
    __device__ __forceinline__ void operator()(const f32x4 (&acc)[2][2][4][2], const Unit& u, int wr, int wc, int fr, int fq) const {
        const float sc = cB * S_MRG;
        const bf16* pb = P + (size_t)(u.pm * 256 + wr * 64 + fr) * PNP + (u.pn * 256 + wc * 32 + 8 * fq) + PGB;
        unsigned char* ob = O + (size_t)(u.pm * 256 + wr * 64 + fr) * DM + (u.pn * 256 + wc * 32 + 8 * fq);
        asm volatile("" : "+v"(pb), "+v"(ob));
#pragma unroll
        for (int ai = 0; ai < 2; ++ai)
#pragma unroll
            for (int m = 0; m < 4; ++m) {
#pragma unroll
                for (int bj = 0; bj < 2; ++bj) { const v4u gw = *(const GAS v4u*)(pb + (size_t)(ai * 128 + m * 16) * PNP + bj * 128);
                    const f32x4 v0 = acc[ai][bj][m][0] * ((f32x4){fmaxf(bflo(gw.x), 1e-30f), fmaxf(bfhi(gw.x), 1e-30f), fmaxf(bflo(gw.y), 1e-30f), fmaxf(bfhi(gw.y), 1e-30f)} * sc);
                    const f32x4 v1 = acc[ai][bj][m][1] * ((f32x4){fmaxf(bflo(gw.z), 1e-30f), fmaxf(bfhi(gw.z), 1e-30f), fmaxf(bflo(gw.w), 1e-30f), fmaxf(bfhi(gw.w), 1e-30f)} * sc);
                    v2u w; w.x = pk4_fp8(v0[0], v0[1], v0[2], v0[3]); w.y = pk4_fp8(v1[0], v1[1], v1[2], v1[3]);
                    *(GAS v2u*)(ob + (size_t)(ai * 128 + m * 16) * DM + bj * 128) = w; } }
    }
};
template <bool BIN, bool BOUT>
struct EpiResid {
    static constexpr bool PERM = false, MIDK = false; const void* base; const float* gate; void* C; float scale;
    __device__ __forceinline__ void operator()(const f32x4 (&acc)[2][2][4][2], const Unit& u, int wr, int wc, int fr, int fq) const {
        const int row0 = u.pm * 256 + wr * 64 + fr, col0 = u.pn * 256 + wc * 32 + 4 * fq; const float* gp = gate + (u.pm >> 3) * MODW + col0;
        f32x4 gv[2][2];
#pragma unroll
        for (int bj = 0; bj < 2; ++bj)
#pragma unroll
            for (int n = 0; n < 2; ++n) gv[bj][n] = *(const GAS f32x4*)(gp + bj * 128 + n * 16) * scale;
#pragma unroll
        for (int ai = 0; ai < 2; ++ai)
#pragma unroll
            for (int m = 0; m < 4; ++m) { const size_t off = (size_t)(row0 + ai * 128 + m * 16) * DM + col0;
#pragma unroll
                for (int bj = 0; bj < 2; ++bj)
#pragma unroll
                    for (int n = 0; n < 2; ++n) { const size_t o = off + bj * 128 + n * 16; f32x4 bs;
                        if constexpr (BIN) { const v2u w = *(const GAS v2u*)((const bf16*)base + o); bs = (f32x4){bflo(w.x), bfhi(w.x), bflo(w.y), bfhi(w.y)}; }
                        else bs = *(const GAS f32x4*)((const float*)base + o);
                        const f32x4 r = bs + gv[bj][n] * acc[ai][bj][m][n];
                        if constexpr (BOUT) { v2u w; w.x = cvt_pk_bf16(r.x, r.y); w.y = cvt_pk_bf16(r.z, r.w); *(GAS v2u*)((bf16*)C + o) = w; }
                        else *(GAS f32x4*)((float*)C + o) = r; } }
    }
};
struct EpiPlain {
    static constexpr bool PERM = true, MIDK = false; unsigned char* O; int ldc; float scale;
    __device__ __forceinline__ void operator()(const f32x4 (&acc)[2][2][4][2], const Unit& u, int wr, int wc, int fr, int fq) const {
        unsigned char* ob = O + (size_t)(u.pm * 256 + wr * 64 + fr) * ldc + (u.pn * 256 + wc * 32 + 8 * fq);
        asm volatile("" : "+v"(ob));
#pragma unroll
        for (int ai = 0; ai < 2; ++ai)
#pragma unroll
            for (int m = 0; m < 4; ++m)
#pragma unroll
                for (int bj = 0; bj < 2; ++bj) { const f32x4 v0 = acc[ai][bj][m][0] * scale, v1 = acc[ai][bj][m][1] * scale;
                    v2u w; w.x = pk4_fp8(v0[0], v0[1], v0[2], v0[3]); w.y = pk4_fp8(v1[0], v1[1], v1[2], v1[3]);
                    *(GAS v2u*)(ob + (size_t)(ai * 128 + m * 16) * ldc + bj * 128) = w; }
    }
};

__device__ __forceinline__ void unpack8_fp8(v2u w, float (&o)[8]) {
    typedef float f32x2_ __attribute__((ext_vector_type(2)));
    const f32x2_ a = __builtin_amdgcn_cvt_pk_f32_fp8((int)w.x, false), b = __builtin_amdgcn_cvt_pk_f32_fp8((int)w.x, true), c = __builtin_amdgcn_cvt_pk_f32_fp8((int)w.y, false), d = __builtin_amdgcn_cvt_pk_f32_fp8((int)w.y, true);
    o[0] = a.x * (1.f / S_A); o[1] = a.y * (1.f / S_A); o[2] = b.x * (1.f / S_A); o[3] = b.y * (1.f / S_A); o[4] = c.x * (1.f / S_A); o[5] = c.y * (1.f / S_A); o[6] = d.x * (1.f / S_A); o[7] = d.y * (1.f / S_A);
}
__device__ __forceinline__ void conv_phase(Frame& F) {
    constexpr int C8 = DFF / 8, TB = 32, NTB = M / TB;
    const size_t total = (size_t)C8 * NTB;
    for (size_t idx = (size_t)F.gw * 64 + F.lane; idx < total; idx += (size_t)F.NGW * 64) {
        const int c8 = (int)(idx % C8), tb = (int)(idx / C8), ch = 8 * c8, t0 = tb * TB;
        const int acol = (ch >> 7) * 256 + (ch & 127);
        float wg[3][8], wv[3][8], bg[8], bv[8];
#pragma unroll
        for (int j = 0; j < 3; ++j) { const f32x4 a = *(const GAS f32x4*)(F.cvw + (size_t)j * F2 + ch), b = *(const GAS f32x4*)(F.cvw + (size_t)j * F2 + ch + 4);
            const f32x4 c = *(const GAS f32x4*)(F.cvw + (size_t)j * F2 + DFF + ch), d = *(const GAS f32x4*)(F.cvw + (size_t)j * F2 + DFF + ch + 4);
#pragma unroll
            for (int e = 0; e < 4; ++e) { wg[j][e] = a[e]; wg[j][4 + e] = b[e]; wv[j][e] = c[e]; wv[j][4 + e] = d[e]; } }
        { const f32x4 a = *(const GAS f32x4*)(F.cvb + ch), b = *(const GAS f32x4*)(F.cvb + ch + 4), c = *(const GAS f32x4*)(F.cvb + DFF + ch), d = *(const GAS f32x4*)(F.cvb + DFF + ch + 4);
#pragma unroll
          for (int e = 0; e < 4; ++e) { bg[e] = a[e]; bg[4 + e] = b[e]; bv[e] = c[e]; bv[4 + e] = d[e]; } }
        float g1[8], g2[8], v1[8], v2[8];
        const bool first = (t0 & (SEQ - 1)) == 0;
        const unsigned char* ap = (const unsigned char*)F.A + (size_t)t0 * F2 + acol;
        if (first) {
#pragma unroll
            for (int e = 0; e < 8; ++e) { g1[e] = g2[e] = v1[e] = v2[e] = 0.f; }
        } else {
            const v2u ga = *(const GAS v2u*)(ap - F2), gb = *(const GAS v2u*)(ap - 2 * (size_t)F2), va = *(const GAS v2u*)(ap - F2 + 128), vb = *(const GAS v2u*)(ap - 2 * (size_t)F2 + 128);
            unpack8_fp8(ga, g1); unpack8_fp8(gb, g2); unpack8_fp8(va, v1); unpack8_fp8(vb, v2);
        }
#pragma unroll 4
        for (int i = 0; i < TB; ++i) {
            const v2u gw = *(const GAS v2u*)(ap + (size_t)i * F2), vw = *(const GAS v2u*)(ap + (size_t)i * F2 + 128);
            float g0[8], v0[8], y[8];
            unpack8_fp8(gw, g0); unpack8_fp8(vw, v0);
#pragma unroll
            for (int e = 0; e < 8; ++e) { const float gt = bg[e] + wg[0][e] * g2[e] + wg[1][e] * g1[e] + wg[2][e] * g0[e];
                const float vl = bv[e] + wv[0][e] * v2[e] + wv[1][e] * v1[e] + wv[2][e] * v0[e];
                y[e] = gt * pg8::sigmoidf_(gt) * vl; g2[e] = g1[e]; g1[e] = g0[e]; v2[e] = v1[e]; v1[e] = v0[e]; }
            v2u o; o.x = pk4_fp8(y[0] * S_ACT, y[1] * S_ACT, y[2] * S_ACT, y[3] * S_ACT); o.y = pk4_fp8(y[4] * S_ACT, y[5] * S_ACT, y[6] * S_ACT, y[7] * S_ACT);
            *(GAS v2u*)((unsigned char*)F.ACT + (size_t)(t0 + i) * DFF + ch) = o;
        }
    }
}

constexpr int N_PHASES = 12;
struct Args { const float* in[19]; float* out; unsigned char* ws; int ph_lo, ph_hi, li, pad; };
__global__ void __launch_bounds__(NWAVES * 64, 2) mega_fwd(Args args) {
    extern __shared__ __attribute__((aligned(16))) unsigned char lds[];
    Frame F;
    F.lds = (LAS unsigned char*)lds;
    F.MISC = (volatile LAS unsigned*)(F.lds + MISC_OFF);
    F.tid = threadIdx.x; F.lane = F.tid & 63; F.wave = __builtin_amdgcn_readfirstlane(F.tid >> 6);
    F.G = gridDim.x; F.gw = blockIdx.x * NWAVES + F.wave; F.NGW = F.G * NWAVES;
    unsigned char* ws = args.ws;
    F.ctl = (gu32*)(ws + WS_CTL);
    F.x = args.in[0]; F.c = args.in[1]; F.ada_w = args.in[2]; F.ada_b = args.in[3]; F.n1g = args.in[4]; F.w_in = args.in[5]; F.qng = args.in[6]; F.kng = args.in[7];
    F.sgg = args.in[8]; F.sgw = args.in[9]; F.sgb = args.in[10]; F.w_a = args.in[11]; F.w_b = args.in[12]; F.w_out = args.in[13]; F.n2g = args.in[14]; F.w_up = args.in[15];
    F.cvw = args.in[16]; F.cvb = args.in[17]; F.w_dn = args.in[18]; F.out = args.out;
    F.MOD = (float*)(ws + WS_MOD); F.PART = (float*)(ws + WS_TMP);   F.WIN = (bf16*)(ws + WS_WIN); F.WINB = (bf16*)(ws + WS_WINB); F.H8A = ws + WS_X1;   F.WA = (bf16*)(ws + WS_WA); F.WB = (bf16*)(ws + WS_WB); F.WOUT = (bf16*)(ws + WS_WOUT); F.WUP = (bf16*)(ws + WS_WUP); F.WDN = (bf16*)(ws + WS_WDN);
    F.H = (bf16*)(ws + WS_H); F.X1 = (float*)(ws + WS_X1); F.PROJ = (bf16*)(ws + WS_PROJ); F.MASK = (unsigned*)(ws + WS_MASK); F.RS = (float*)(ws + WS_RS); F.SWT = (float*)(ws + WS_SWT);
    F.VT = (bf16*)(ws + WS_VT); F.YA = (bf16*)(ws + WS_YA); F.YB = (bf16*)(ws + WS_YB); F.MRG = (bf16*)(ws + WS_MRG); F.TMP = (float*)(ws + WS_TMP); F.A = (bf16*)(ws + WS_A); F.ACT = (bf16*)(ws + WS_ACT);
    for (int u = F.tid; u < (LDS_BYTES - LDSCTL_OFF) / 4; u += NWAVES * 64) ((LAS unsigned*)(F.lds + LDSCTL_OFF))[u] = 0u;
    __syncthreads();
    XcdBarrier bar; bar.bar = (unsigned*)(F.ctl + CW_BAR); bar.x = 0; bar.st = nullptr;
    if (MK_N_LAUNCHES == 1) bar = xcd_barrier_post((unsigned*)(F.ctl + CW_BAR), F.MISC + 8);
    const int lo = args.ph_lo, hi = args.ph_hi;
#define IN(k) (lo <= (k) && (k) < hi)
#define SEAM(k) do { if (IN(k) && IN((k) + 1)) xcd_barrier(bar); } while (0)

#define REP(k) if ((PROBE_MASK >> (k)) & 1) for (int _rep = 0; _rep < 1; ++_rep)
    if (IN(0)) { p0_prologue(F); REP(0) { xcd_barrier(bar); p0_prologue(F, false); } } SEAM(0);
    if (IN(1)) { mod_reduce(F); } SEAM(1);
    if (IN(2)) { norm_rows<2>(F, F.x, F.n1g, 0, DM, F.H, F.H8A); REP(2) { xcd_barrier(bar); norm_rows<2>(F, F.x, F.n1g, 0, DM, F.H, F.H8A); } } SEAM(2);
    if (IN(3)) {
        { pg8::Gemm g{F.H, F.WINB, M, PNP, DM, DM, DM}; pg8::MixOrder S{0, F.G, (int)blockIdx.x}; EpiProj E{F.PROJ, 1.0f};
          pg8::gemm_phase<EpiProj, pg8::MixOrder, true, 2>(F.lds + RING_OFF, g, S, E); }
        VM_WAIT(); __syncthreads();
        { pg8::Gemm g{(const bf16*)F.H8A, F.WIN, M, PNP, DM, DM, DM}; pg8::MixOrder S{1, F.G, (int)blockIdx.x}; EpiProj E{F.PROJ, 1.0f / (S_H2 * 1024.f)};
          pg8::gemm_phase<EpiProj, pg8::MixOrder, true, 1>(F.lds + RING_OFF, g, S, E); }
    } SEAM(3);
    if (IN(4)) {
        for (int it = blockIdx.x; it < 512; it += F.G) { const int b = it >> 7, j = it & 127; idx_block(F, b, j); idx_block(F, b, 255 - j); }
        for (int row = F.gw; row < M; row += F.NGW) qknorm_row(F, row);
        for (int it = F.gw; it < BATCH * NKV * 2 * 256; it += F.NGW) vt_item(F, it);
        REP(4) { xcd_barrier(bar); for (int it = blockIdx.x; it < 512; it += F.G) { const int b = it >> 7, j = it & 127; idx_block(F, b, j); idx_block(F, b, 255 - j); } }
        REP(13) { xcd_barrier(bar); for (int it = F.gw; it < BATCH * NKV * 2 * 256; it += F.NGW) vt_item(F, it); }
    } SEAM(4);
    if (IN(5)) {
        { const float sb = attn_score_bound(F); for (int p = blockIdx.x; p < 256; p += F.G) { const int bg = p >> 4, j = p & 15; attn_block(F, bg >> 2, bg & 3, j, sb); attn_block(F, bg >> 2, bg & 3, 31 - j, sb); } }
        REP(5) { xcd_barrier(bar); { const float sb = attn_score_bound(F); for (int p = blockIdx.x; p < 256; p += F.G) { const int bg = p >> 4, j = p & 15; attn_block(F, bg >> 2, bg & 3, j, sb); attn_block(F, bg >> 2, bg & 3, 31 - j, sb); } } }
        for (int u = blockIdx.x; u < 512; u += F.G) sgu_unit(F, u);
        __syncthreads();
        REP(14) { xcd_barrier(bar); for (int u = blockIdx.x; u < 512; u += F.G) sgu_unit(F, u); __syncthreads(); }
    } SEAM(5);
    if (IN(6)) { pg8::Gemm g{F.YA, F.WA, M, DM, 2 * ATTW, 2 * ATTW, 2 * ATTW}; pg8::StaticOrder S; S.init(M, DM, F.G, (int)blockIdx.x);
        EpiMerge E{F.PROJ, (unsigned char*)F.MRG, 1.0f / (S_YB * S_WB), (S_YB * S_WB) / (S_YA * S_WA)};
        pg8::gemm_phase<EpiMerge, pg8::StaticOrder, true, 1>(F.lds + RING_OFF, g, S, E);
        REP(6) { xcd_barrier(bar); pg8::gemm_phase<EpiMerge, pg8::StaticOrder, true, 1>(F.lds + RING_OFF, g, S, E); } } SEAM(6);
    if (IN(7)) { pg8::Gemm g{F.MRG, F.WOUT, M, DM, DM, DM, DM}; pg8::StaticOrder S; S.init(M, DM, F.G, (int)blockIdx.x); EpiResid<false, true> E{F.x, F.MOD + 2 * DM, F.X1, 1.0f / (S_MRG * S_WOUT)};
        pg8::gemm_phase<EpiResid<false, true>, pg8::StaticOrder, true, 1>(F.lds + RING_OFF, g, S, E);
        REP(7) { xcd_barrier(bar); pg8::gemm_phase<EpiResid<false, true>, pg8::StaticOrder, true, 1>(F.lds + RING_OFF, g, S, E); } } SEAM(7);
    if (IN(8)) { norm_rows<1, true>(F, F.X1, F.n2g, 3 * DM, 4 * DM, F.H); REP(8) { xcd_barrier(bar); norm_rows<1, true>(F, F.X1, F.n2g, 3 * DM, 4 * DM, F.H); } } SEAM(8);
    if (IN(9)) { pg8::Gemm g{F.H, F.WUP, M, F2, DM, DM, DM}; pg8::StaticOrder S; S.init(M, F2, F.G, (int)blockIdx.x); EpiPlain E{(unsigned char*)F.A, F2, S_A / (S_H2 * S_WUP)};
        pg8::gemm_phase<EpiPlain, pg8::StaticOrder, true, 1>(F.lds + RING_OFF, g, S, E);
        REP(9) { xcd_barrier(bar); pg8::gemm_phase<EpiPlain, pg8::StaticOrder, true, 1>(F.lds + RING_OFF, g, S, E); } } SEAM(9);
    if (IN(10)) { conv_phase(F); REP(10) { xcd_barrier(bar); conv_phase(F); } } SEAM(10);
    if (IN(11)) { pg8::Gemm g{F.ACT, F.WDN, M, DM, DFF, DFF, DFF}; pg8::StaticOrder S; S.init(M, DM, F.G, (int)blockIdx.x); EpiResid<true, false> E{F.X1, F.MOD + 5 * DM, F.out, 1.0f / (S_ACT * S_WDN)};
        pg8::gemm_phase<EpiResid<true, false>, pg8::StaticOrder, true, 1>(F.lds + RING_OFF, g, S, E);
        REP(11) { xcd_barrier(bar); pg8::gemm_phase<EpiResid<true, false>, pg8::StaticOrder, true, 1>(F.lds + RING_OFF, g, S, E); } }
#undef REP
#undef IN
#undef SEAM
}

extern "C" void kernel_launch(void* const* d_in, const int* in_sizes, int n_in, void* d_out, int out_size, void* d_ws, size_t ws_size, hipStream_t stream) {
    static int grid = 0;
    if (grid == 0) {
        if (n_in != 19 || in_sizes[0] != M * DM || out_size != M * DM || ws_size < WS_END) { fprintf(stderr, "kernel_launch: unexpected shapes (n_in %d, in0 %d, out %d, ws %zu < %zu); nothing launched\n", n_in, n_in > 0 ? in_sizes[0] : -1, out_size, ws_size, (size_t)WS_END); grid = -1; return; }
        int dev = 0, cus = 0, per_cu = 0;
        if (hipGetDevice(&dev) != hipSuccess || hipDeviceGetAttribute(&cus, hipDeviceAttributeMultiprocessorCount, dev) != hipSuccess) { fprintf(stderr, "kernel_launch: device query failed\n"); grid = -1; return; }
        if (hipFuncSetAttribute((const void*)mega_fwd, hipFuncAttributeMaxDynamicSharedMemorySize, LDS_BYTES) != hipSuccess) { fprintf(stderr, "kernel_launch: hipFuncSetAttribute failed\n"); grid = -1; return; }
        if (hipOccupancyMaxActiveBlocksPerMultiprocessor(&per_cu, (const void*)mega_fwd, NWAVES * 64, LDS_BYTES) != hipSuccess || per_cu < 1) { fprintf(stderr, "kernel_launch: occupancy query reports %d blocks per CU\n", per_cu); }
        (void)hipGetLastError();
        grid = cus;
    }
    if (grid < 0) return;
    if (hipMemsetAsync((char*)d_ws + WS_CTL, 0, CTL_ZERO_BYTES, stream) != hipSuccess) { fprintf(stderr, "kernel_launch: memset failed\n"); return; }
    Args a{};
    for (int i = 0; i < 19; ++i) a.in[i] = (const float*)d_in[i];
    a.out = (float*)d_out; a.ws = (unsigned char*)d_ws; a.pad = 0;
    for (int li = 0; li < MK_N_LAUNCHES; ++li) {
        if (MK_N_LAUNCHES == 1) { a.ph_lo = 0; a.ph_hi = N_PHASES; } else { a.ph_lo = li; a.ph_hi = li + 1; }
        a.li = li;
        hipLaunchKernelGGL(mega_fwd, dim3(grid), dim3(NWAVES * 64), LDS_BYTES, stream, a);
        const hipError_t le = hipPeekAtLastError();
        if (le != hipSuccess) { fprintf(stderr, "kernel_launch: launch %d failed: %s\n", li, hipGetErrorName(le)); break; }
    }
}
```

```cpp
#include <hip/hip_runtime.h>
#include <cstdio>
#include <cstdint>

#ifndef MK_N_LAUNCHES
#define MK_N_LAUNCHES 1
#endif
#ifndef PROBE_MASK
#define PROBE_MASK 0x0
#endif

namespace pg8 {
#define PG8_LAS __attribute__((address_space(3)))
typedef unsigned short bf16_t;
typedef short bf16x8 __attribute__((ext_vector_type(8)));
typedef float f32x4 __attribute__((ext_vector_type(4)));
typedef float f32x2 __attribute__((ext_vector_type(2)));
typedef unsigned u32x4 __attribute__((ext_vector_type(4)));
typedef unsigned u32x2 __attribute__((ext_vector_type(2)));
constexpr int BM = 256, BK = 64, HALF = 128, HTB = HALF * BK * 2, STAGE_BYTES = 8 * HTB, NXCD = 8, WGM = 8;

__host__ __device__ __forceinline__ int lds_byte(int r, int c) { const int rr = r & 7, ch = c >> 3; return (r >> 3) * 1024 + (16 * ((rr >> 2) + 2 * (ch >> 2)) + 4 * (rr & 3) + ((ch ^ (2 * (rr >> 2))) & 3)) * 16; }
__host__ __device__ __forceinline__ void stage_rc(int b, int& R, int& C) { const int pc = b >> 10, p = (b & 1023) >> 4, q = p >> 4, bb = p & 15, rr = (q & 1) * 4 + (bb >> 2), ch = (q >> 1) * 4 + ((bb & 3) ^ (2 * (q & 1))); R = pc * 8 + rr; C = ch * 8; }
__host__ __device__ __forceinline__ int perm32(int rho) { const int n = rho >> 4, i = rho & 15; return 8 * (i >> 2) + 4 * n + (i & 3); }

struct Unit { int pm, pn; };
struct Gemm { const bf16_t* A; const bf16_t* Bt; int M, N, K, lda, ldb; };

struct StaticOrder {
    int nM, nN, nwg, G, c;
    __host__ __device__ void init(int M, int N, int G_, int c_) { nM = M / BM; nN = N / BM; nwg = nM * nN; G = G_; c = c_; }
    __host__ __device__ bool next(int i, Unit& u) const {
        const long L = (long)i * G + c; if (L >= nwg) return false;
        int wgid = (int)L; { const int q = nwg / NXCD, r = nwg % NXCD, xcd = wgid % NXCD, off = wgid / NXCD; wgid = (xcd < r ? xcd * (q + 1) : r * (q + 1) + (xcd - r) * q) + off; }
        const int nig = WGM * nN, gid = wgid / nig, fm = gid * WGM, gsz = (nM - fm) < WGM ? (nM - fm) : WGM;
        u.pm = fm + ((wgid % nig) % gsz); u.pn = (wgid % nig) / gsz; return true;
    }
    __device__ __forceinline__ void a_ready(const Unit&) const {}
    __device__ __forceinline__ void done(const Unit&) const {}
};
struct MixOrder {
    int fp8, G, c;
    __host__ __device__ static void map(int L, int nwg, int nN, Unit& u) {
        int wgid = L; { const int q = nwg / NXCD, r = nwg % NXCD, xcd = wgid % NXCD, off = wgid / NXCD; wgid = (xcd < r ? xcd * (q + 1) : r * (q + 1) + (xcd - r) * q) + off; }
        const int nig = WGM * nN; u.pm = (wgid / nig) * WGM + ((wgid % nig) % WGM); u.pn = (wgid % nig) / WGM;
    }
    __host__ __device__ bool next(int i, Unit& u) const {
        int L;
        if (!fp8) { L = i * G + c; if (L >= 288) return false; map(L, 288, 9, u); u.pn = u.pn < 8 ? 12 + u.pn : 68; return true; }
        if (G == 256) { if (c >= 32) { if (i >= 8) return false; L = i * 224 + (c - 32); } else { if (i >= 4) return false; L = 1792 + 4 * c + i; } }
        else { L = i * G + c; if (L >= 1920) return false; }
        map(L, 1920, 60, u); u.pn = u.pn < 12 ? u.pn : u.pn + 8; return true;
    }
    __device__ __forceinline__ void a_ready(const Unit&) const {}
    __device__ __forceinline__ void done(const Unit&) const {}
};

__device__ __forceinline__ unsigned cvt_pk_bf16(float lo, float hi) { unsigned r; asm volatile("v_cvt_pk_bf16_f32 %0, %1, %2" : "=v"(r) : "v"(lo), "v"(hi)); return r; }
__device__ __forceinline__ f32x2 gelu_pk(f32x2 v) {
    const f32x2 av = __builtin_elementwise_abs(v), d = av * 0.2316418882f + 1.0f;
    f32x2 t; t.x = __builtin_amdgcn_rcpf(d.x); t.y = __builtin_amdgcn_rcpf(d.y);
    f32x2 q = t * 0.5307027145f + (-0.7265760135f); q = q * t + 0.7107068705f; q = q * t + (-0.142248368f); q = q * t + 0.127414796f; q = q * t;
    const f32x2 s = (v * v) * (-0.72134752044f);
    f32x2 e; e.x = __builtin_amdgcn_exp2f(s.x); e.y = __builtin_amdgcn_exp2f(s.y);
    const f32x2 m = v * (q * e), r = v - m;
    f32x2 o; o.x = v.x < 0.f ? m.x : r.x; o.y = v.y < 0.f ? m.y : r.y; return o;
}
__device__ __forceinline__ float sigmoidf_(float x) { return __builtin_amdgcn_rcpf(1.0f + __builtin_amdgcn_exp2f(-1.4426950408889634f * x)); }
__device__ __forceinline__ float bflo(unsigned w) { return __builtin_bit_cast(float, w << 16); }
__device__ __forceinline__ float bfhi(unsigned w) { return __builtin_bit_cast(float, w & 0xffff0000u); }

typedef int i32x8 __attribute__((ext_vector_type(8)));
typedef int i32x4 __attribute__((ext_vector_type(4)));
template <class Epi, class Sched, bool ALIGN_EPI, int ES = 2>
__device__ __forceinline__ void gemm_phase(PG8_LAS unsigned char* lds, const Gemm g, const Sched& S, const Epi& E) {
    const int tid = threadIdx.x, wid = __builtin_amdgcn_readfirstlane(tid >> 6), lane = tid & 63, wr = wid >> 2, wc = wid & 3, fr = lane & 15, fq = lane >> 4;
    const int K = g.K, nt = K * ES / (BK * 2);
    unsigned voffA[2], voffB[2];
#pragma unroll
    for (int i = 0; i < 2; ++i) { int R, C; stage_rc(tid * 16 + i * 8192, R, C); const int Rb = Epi::PERM ? ((R & ~31) + perm32(R & 31)) : R;
        voffA[i] = (unsigned)(R * g.lda) * (unsigned)ES + (unsigned)C * 2u; voffB[i] = (unsigned)(Rb * g.ldb) * (unsigned)ES + (unsigned)C * 2u; }
    const size_t kstep = (size_t)(BK * 2);
    const size_t hstepA = (size_t)HALF * g.lda * ES, hstepB = (size_t)HALF * g.ldb * ES;
    const size_t tstepA = 2 * hstepA, tstepB = 2 * hstepB;
    const unsigned ldsw = (unsigned)wid * 1024u;
    const int aoff = lds_byte(wr * 64 + fr, fq * 8), boff = lds_byte(wc * 32 + fr, fq * 8);
#define PG8_SA(b, h) (((b) * 2 + (h)) * HTB)
#define PG8_SB(b, h) ((4 + (b) * 2 + (h)) * HTB)
#define PG8_STAGE(bufoff, gbase, voff) do { _Pragma("unroll") for (int _i = 0; _i < 2; ++_i) \
        __builtin_amdgcn_global_load_lds((const unsigned*)((const char*)(gbase) + (voff)[_i]), (PG8_LAS unsigned*)(lds + (bufoff) + ldsw + _i * 8192), 16, 0, 0); } while (0)
#define PG8_CAT(x, y) __builtin_shufflevector(x, y, 0, 1, 2, 3, 4, 5, 6, 7)
#define PG8_LO(v) __builtin_bit_cast(bf16x8, __builtin_shufflevector(v, v, 0, 1, 2, 3))
#define PG8_HI(v) __builtin_bit_cast(bf16x8, __builtin_shufflevector(v, v, 4, 5, 6, 7))
#define PG8_LDA(dst, b, h) do { _Pragma("unroll") for (int m = 0; m < 4; ++m) { const i32x4 _l = *(const PG8_LAS i32x4*)(lds + PG8_SA(b, h) + aoff + m * 2048), _h = *(const PG8_LAS i32x4*)(lds + PG8_SA(b, h) + aoff + m * 2048 + 512); dst[m] = PG8_CAT(_l, _h); } } while (0)
#define PG8_LDB(dst, b, h) do { _Pragma("unroll") for (int n = 0; n < 2; ++n) { const i32x4 _l = *(const PG8_LAS i32x4*)(lds + PG8_SB(b, h) + boff + n * 2048), _h = *(const PG8_LAS i32x4*)(lds + PG8_SB(b, h) + boff + n * 2048 + 512); dst[n] = PG8_CAT(_l, _h); } } while (0)
#define PG8_MMA(ai, bj, At, Bt) do { __builtin_amdgcn_s_setprio(1); _Pragma("unroll") for (int m = 0; m < 4; ++m) _Pragma("unroll") for (int n = 0; n < 2; ++n) { \
        if constexpr (ES == 2) { acc[ai][bj][m][n] = __builtin_amdgcn_mfma_f32_16x16x32_bf16(PG8_LO(Bt[n]), PG8_LO(At[m]), acc[ai][bj][m][n], 0, 0, 0); \
                                 acc[ai][bj][m][n] = __builtin_amdgcn_mfma_f32_16x16x32_bf16(PG8_HI(Bt[n]), PG8_HI(At[m]), acc[ai][bj][m][n], 0, 0, 0); } \
        else asm volatile("v_mfma_f32_16x16x128_f8f6f4 %0, %1, %2, %0" : "+v"(acc[ai][bj][m][n]) : "v"(Bt[n]), "v"(At[m])); } __builtin_amdgcn_s_setprio(0); } while (0)
#define PG8_WAIT_V(n) asm volatile("s_waitcnt vmcnt(" #n ")" ::: "memory")
#define PG8_WAIT_L(n) asm volatile("s_waitcnt lgkmcnt(" #n ")" ::: "memory")
#define PG8_BAR __builtin_amdgcn_s_barrier()
#define PG8_SCHED __builtin_amdgcn_sched_barrier(0)
    Unit cur, nxt; int ui = 0;
    if (!S.next(0, cur)) return;
    f32x4 acc[2][2][4][2];
#pragma unroll
    for (int a = 0; a < 2; ++a)
#pragma unroll
        for (int b = 0; b < 2; ++b)
#pragma unroll
            for (int m = 0; m < 4; ++m)
#pragma unroll
                for (int n = 0; n < 2; ++n) acc[a][b][m][n] = (f32x4){0.f, 0.f, 0.f, 0.f};
    i32x8 At[4], B0[2], B1[2];
    const char* cA = (const char*)g.A + (size_t)cur.pm * tstepA; const char* cB = (const char*)g.Bt + (size_t)cur.pn * tstepB;
    S.a_ready(cur);
    PG8_STAGE(PG8_SB(0, 0), cB, voffB); PG8_STAGE(PG8_SB(0, 1), cB + hstepB, voffB); PG8_STAGE(PG8_SA(0, 0), cA, voffA); PG8_STAGE(PG8_SA(0, 1), cA + hstepA, voffA);
    if (wr == 1) PG8_BAR;
    PG8_WAIT_V(2); PG8_BAR;
    PG8_STAGE(PG8_SB(1, 0), cB + kstep, voffB); PG8_STAGE(PG8_SA(1, 0), cA + kstep, voffA); PG8_STAGE(PG8_SB(1, 1), cB + hstepB + kstep, voffB);
    PG8_WAIT_V(6); PG8_BAR;
    for (;;) {
        const bool has_next = S.next(ui + 1, nxt);
        const char* nA = has_next ? (const char*)g.A + (size_t)nxt.pm * tstepA : cA; const char* nB = has_next ? (const char*)g.Bt + (size_t)nxt.pn * tstepB : cB;
        for (int t = 0; t < nt; t += 2) {
            const bool last = (t == nt - 2);
            const char* a1 = cA + (size_t)(t + 1) * kstep;
            const char* a2 = last ? nA : cA + (size_t)(t + 2) * kstep; const char* b2 = last ? nB : cB + (size_t)(t + 2) * kstep;
            const char* a3 = a2 + kstep; const char* b3 = b2 + kstep;
            if (last && has_next) S.a_ready(nxt);
            if constexpr (Epi::MIDK) { if (t == nt / 2) { if constexpr (ES == 1) asm volatile("s_nop 15\n\ts_nop 15" ::: "memory"); E.mid(acc, cur, wr, wc, fr, fq); } }
            PG8_LDB(B0, 0, 0); PG8_LDB(B1, 0, 1); PG8_SCHED; PG8_LDA(At, 0, 0); PG8_STAGE(PG8_SA(1, 1), a1 + hstepA, voffA);
            PG8_WAIT_V(8); PG8_WAIT_L(0); PG8_BAR; PG8_MMA(0, 0, At, B0); PG8_MMA(0, 1, At, B1); PG8_BAR; PG8_SCHED;
            PG8_LDA(At, 0, 1); PG8_STAGE(PG8_SB(0, 0), b2, voffB); PG8_STAGE(PG8_SB(0, 1), b2 + hstepB, voffB); PG8_STAGE(PG8_SA(0, 0), a2, voffA);
            PG8_WAIT_V(8); PG8_WAIT_L(0); PG8_BAR; PG8_MMA(1, 0, At, B0); PG8_MMA(1, 1, At, B1); PG8_BAR; PG8_SCHED;
            PG8_LDB(B0, 1, 0); PG8_LDB(B1, 1, 1); PG8_SCHED; PG8_LDA(At, 1, 0); PG8_STAGE(PG8_SA(0, 1), a2 + hstepA, voffA);
            PG8_WAIT_V(8); PG8_WAIT_L(0); PG8_BAR; PG8_MMA(0, 0, At, B0); PG8_MMA(0, 1, At, B1); PG8_BAR; PG8_SCHED;
            PG8_LDA(At, 1, 1); PG8_STAGE(PG8_SB(1, 0), b3, voffB); PG8_STAGE(PG8_SB(1, 1), b3 + hstepB, voffB); PG8_STAGE(PG8_SA(1, 0), a3, voffA);
            PG8_WAIT_V(8); PG8_WAIT_L(0); PG8_BAR; PG8_MMA(1, 0, At, B0); PG8_MMA(1, 1, At, B1); PG8_BAR; PG8_SCHED;
        }
        if constexpr (ALIGN_EPI) { if (wr == 0) PG8_BAR; }
        if constexpr (ES == 1) asm volatile("s_nop 15\n\ts_nop 15" ::: "memory");
        E(acc, cur, wr, wc, fr, fq); S.done(cur);
        if (!has_next) break;
#pragma unroll
        for (int a = 0; a < 2; ++a)
#pragma unroll
            for (int b = 0; b < 2; ++b)
#pragma unroll
                for (int m = 0; m < 4; ++m)
#pragma unroll
                    for (int n = 0; n < 2; ++n) acc[a][b][m][n] = (f32x4){0.f, 0.f, 0.f, 0.f};
        cur = nxt; cA = nA; cB = nB; ++ui;
        if constexpr (ALIGN_EPI) { if (wr == 1) PG8_BAR; }
    }
    PG8_WAIT_V(0);
    if constexpr (!ALIGN_EPI) { if (wr == 0) PG8_BAR; }
    PG8_BAR;
#undef PG8_SA
#undef PG8_SB
#undef PG8_STAGE
#undef PG8_LDA
#undef PG8_CAT
#undef PG8_LO
#undef PG8_HI
#undef PG8_LDB
#undef PG8_MMA
#undef PG8_WAIT_V
#undef PG8_WAIT_L
#undef PG8_BAR
#undef PG8_SCHED
}
}

constexpr int NWAVES = 8;
constexpr int BATCH = 4, SEQ = 2048, DM = 4096, M = BATCH * SEQ;
constexpr int NH = 16, HD = 128, NKV = 4, ATTW = 2048, KVW = 512, IH = 32, IDIM = 64, TOPK = 256;
constexpr int GMW = 2048, GMG = 8, GMGW = 256, GMC = 128, DFF = 11008, F2 = 2 * DFF;
constexpr int IN_W = 17504, MODW = 6 * DM;
constexpr float EPS = 1e-6f;
constexpr int PQ = 0, PK = 2048, PV = 2560, PQI = 3072, PGU = 5120, PGV = 7168, PGA = 9216, PGB = 13312, PKI = 17408, PWI = 17472, PNP = 17664;
constexpr int SQ = 0, SK = 2048, SV = 2560, SQI = 3072, SKI = 5120, SWI = 5184, SGU = 5216, SGV = 7264, SGA = 9312, SGB = 13408;

constexpr size_t MiB = 1u << 20;
constexpr size_t WS_CTL = 0, CTL_ZERO_BYTES = 2 * MiB;
constexpr size_t WS_MOD = 1 * MiB;
constexpr size_t WS_WIN = 2 * MiB;
constexpr size_t WS_WA = 140 * MiB, WS_WB = 156 * MiB;
constexpr size_t WS_WOUT = 172 * MiB;
constexpr size_t WS_WUP = 204 * MiB;
constexpr size_t WS_WDN = 376 * MiB;
constexpr size_t WS_H = 462 * MiB;
constexpr size_t WS_X1 = 526 * MiB;
constexpr size_t WS_PROJ = 654 * MiB;
constexpr size_t WS_MASK = 930 * MiB;
constexpr size_t WS_RS = 932 * MiB;
constexpr size_t WS_SWT = 932 * MiB + 65536;
constexpr size_t WS_VT = 933 * MiB;
constexpr size_t WS_YA = 941 * MiB, WS_YB = 973 * MiB;
constexpr size_t WS_MRG = 1005 * MiB;
constexpr size_t WS_TMP = 1069 * MiB;
constexpr size_t WS_A = 654 * MiB;
constexpr size_t WS_ACT = 998 * MiB;
constexpr size_t WS_WINB = 1197 * MiB;
constexpr size_t WS_END = 1336 * MiB;
static_assert(WS_WIN + (size_t)PNP * DM * 2 <= WS_WA && WS_WUP + (size_t)F2 * DM * 2 <= WS_WDN && WS_WDN + (size_t)DM * DFF * 2 <= WS_H, "ws map 1");
static_assert(WS_PROJ + (size_t)M * PNP * 2 <= WS_MASK && WS_A + (size_t)M * F2 * 2 <= WS_ACT && WS_ACT + (size_t)M * DFF * 2 <= WS_END && WS_TMP + (size_t)M * DM * 4 <= WS_END, "ws map 2");
constexpr int CW_TMO = 0, CW_CODE = 1, CW_BAR = 4096;

constexpr int RING_OFF = 0, RING_BYTES = 131072;
constexpr int LDSCTL_OFF = RING_BYTES + 8192, MISC_OFF = LDSCTL_OFF + 320;
constexpr int LDS_BYTES = 147456;
static_assert(MISC_OFF + 128 <= LDS_BYTES, "LDS map");

#define GAS __attribute__((address_space(1)))
#define LAS __attribute__((address_space(3)))
typedef unsigned short bf16;
typedef unsigned v4u __attribute__((ext_vector_type(4)));
typedef unsigned v2u __attribute__((ext_vector_type(2)));
typedef float f32x4 __attribute__((ext_vector_type(4)));
typedef float f32x16 __attribute__((ext_vector_type(16)));
typedef short bf16x8 __attribute__((ext_vector_type(8)));
typedef short bf16x4 __attribute__((ext_vector_type(4)));
typedef GAS unsigned gu32;
#define RLX_AGENT __ATOMIC_RELAXED, __HIP_MEMORY_SCOPE_AGENT
#define LDS_WAIT() asm volatile("s_waitcnt lgkmcnt(0)" ::: "memory")
#define VM_WAIT() asm volatile("s_waitcnt vmcnt(0)" ::: "memory")
__device__ __forceinline__ unsigned f2bf(float f) { unsigned u = __builtin_bit_cast(unsigned, f); return (u + 0x7fffu + ((u >> 16) & 1u)) >> 16; }
__device__ __forceinline__ unsigned pk2(float lo, float hi) { return pg8::cvt_pk_bf16(lo, hi); }
__device__ __forceinline__ float bf2f(bf16 h) { return __builtin_bit_cast(float, (unsigned)h << 16); }
using pg8::bflo; using pg8::bfhi;
constexpr float S_H2 = 16.f, S_WUP = 1024.f, S_ACT = 4.f, S_WDN = 1024.f, S_A = 16.f, S_YA = 16.f, S_YB = 8.f, S_MRG = 16.f, S_WA = 1024.f, S_WB = 1024.f, S_WOUT = 1024.f;
__device__ __forceinline__ float clamp448(float x) { return __builtin_amdgcn_fmed3f(x, -448.f, 448.f); }
__device__ __forceinline__ unsigned pk4_fp8(float a, float b, float c, float d) {
    int w = __builtin_amdgcn_cvt_pk_fp8_f32(clamp448(a), clamp448(b), 0, false);
    w = __builtin_amdgcn_cvt_pk_fp8_f32(clamp448(c), clamp448(d), w, true);
    return (unsigned)w;
}

#define XB_TMO      128
#define XB_XCNT(j)  (256  + 64 * (j))
#define XB_XSUB(j)  (1280 + 64 * (j))
#define XB_XGEN(j)  (2304 + 64 * (j))
#define XB_TOP      3328
#define XB_TOPGEN   3392
#define XCD_BAR_WORDS 3456
#define XB_SPIN_CAP (1u << 18)
__device__ __forceinline__ unsigned xb_ld(unsigned* p)              { return __hip_atomic_load(p, __ATOMIC_RELAXED, __HIP_MEMORY_SCOPE_AGENT); }
__device__ __forceinline__ unsigned xb_add(unsigned* p, unsigned v) { return __hip_atomic_fetch_add(p, v, __ATOMIC_RELAXED, __HIP_MEMORY_SCOPE_AGENT); }
__device__ __forceinline__ unsigned xb_xcc_id() { return (unsigned)__builtin_amdgcn_s_getreg((3 << 11) | 20) & 0xFu; }
#define XB_SPIN(cond, bar) do { unsigned _sp = 0; while (cond) { __builtin_amdgcn_s_sleep(1); \
    if ((++_sp & 255u) == 0u) { if (xb_ld(&(bar)[XB_TMO])) break; if (_sp > XB_SPIN_CAP) { atomicAdd(&(bar)[XB_TMO], 1u); break; } } } } while (0)
struct XcdBarrier { unsigned* bar; unsigned x; volatile LAS unsigned* st; };
__device__ __forceinline__ XcdBarrier xcd_barrier_post(unsigned* bar, volatile LAS unsigned* st) {
    XcdBarrier b; b.bar = bar; b.x = xb_xcc_id(); b.st = st;
    if (threadIdx.x == 0) (void)xb_add(&bar[XB_XCNT(b.x)], 1u);
    return b;
}
__device__ __forceinline__ void xcd_barrier_complete(unsigned* bar, unsigned x, unsigned& nloc, unsigned& nx) {
    const unsigned G = gridDim.x * gridDim.y * gridDim.z;
    unsigned sum, cnt, mine, sp = 0u;
    for (;;) {
        sum = 0u; cnt = 0u; mine = 0u;
#pragma unroll
        for (unsigned j = 0; j < 16; ++j) { const unsigned c = xb_ld(&bar[XB_XCNT(j)]); sum += c; cnt += (c > 0u) ? 1u : 0u; mine = (j == x) ? c : mine; }
        if (sum == G) break;
        __builtin_amdgcn_s_sleep(1);
        if ((++sp & 255u) == 0u) { if (xb_ld(&bar[XB_TMO])) break; if (sp > XB_SPIN_CAP) { atomicAdd(&bar[XB_TMO], 1u); break; } }
    }
    nloc = mine > 0u ? mine : 1u; nx = cnt > 0u ? cnt : 1u;
}
__device__ __forceinline__ void xcd_barrier(const XcdBarrier& b) {
    asm volatile("s_waitcnt vmcnt(0)" ::: "memory");
    __syncthreads();
    if (threadIdx.x == 0) {
        unsigned* bar = b.bar;
        __builtin_amdgcn_s_waitcnt(0);
        unsigned nloc = b.st[0], nx = b.st[1];
        if (nloc == 0u) { xcd_barrier_complete(bar, b.x, nloc, nx); b.st[0] = nloc; b.st[1] = nx; }
        const unsigned old = xb_add(&bar[XB_XSUB(b.x)], 1u);
        const unsigned gen = old / nloc;
        if (old + 1u == (gen + 1u) * nloc) {
            __builtin_amdgcn_fence(__ATOMIC_RELEASE, "agent");
            asm volatile("s_waitcnt vmcnt(0)" ::: "memory");
            const unsigned og = xb_add(&bar[XB_TOP], 1u);
            const unsigned tg = og / nx;
            if (og + 1u == (tg + 1u) * nx) xb_add(&bar[XB_TOPGEN], 1u);
            else XB_SPIN(xb_ld(&bar[XB_TOPGEN]) == tg, bar);
            __builtin_amdgcn_fence(__ATOMIC_ACQUIRE, "agent");
            xb_add(&bar[XB_XGEN(b.x)], 1u);
            asm volatile("s_waitcnt vmcnt(0)" ::: "memory");
        } else {
            XB_SPIN(xb_ld(&bar[XB_XGEN(b.x)]) == gen, bar);
            __builtin_amdgcn_fence(__ATOMIC_ACQUIRE, "agent");
            asm volatile("s_waitcnt vmcnt(0)" ::: "memory");
        }
    }
    __syncthreads();
}

struct Frame {
    LAS unsigned char* lds;
    volatile LAS unsigned* MISC;
    gu32* ctl;
    int tid, lane, wave, G, gw, NGW;
    const float *x, *c, *ada_w, *ada_b, *n1g, *w_in, *qng, *kng, *sgg, *sgw, *sgb, *w_a, *w_b, *w_out, *n2g, *w_up, *cvw, *cvb, *w_dn;
    float* out;
    float *MOD, *PART; bf16 *WINB; unsigned char* H8A; bf16 *WIN, *WA, *WB, *WOUT, *WUP, *WDN, *H, *PROJ, *VT, *YA, *YB, *MRG, *A, *ACT; float *X1, *TMP, *RS, *SWT; unsigned* MASK;
};
__device__ __forceinline__ void xor32_pair(float x, float& lo, float& hi) {
    float a = x, b = x; asm volatile("s_nop 1\n\tv_permlane32_swap_b32 %0, %1" : "+v"(a), "+v"(b)); lo = a; hi = b; }
__device__ __forceinline__ float xor32_sum(float x) { float lo, hi; xor32_pair(x, lo, hi); return lo + hi; }
__device__ __forceinline__ float xor32_max(float x) { float lo, hi; xor32_pair(x, lo, hi); return fmaxf(lo, hi); }
__device__ __forceinline__ float wave_sum(float v) {
#pragma unroll
    for (int o = 1; o < 32; o <<= 1) v += __shfl_xor(v, o);
    v = xor32_sum(v);
    return v;
}

__device__ __forceinline__ int win_dst_row(int n) {
    if (n < SKI) return n;
    if (n < SWI) return PKI + (n - SKI);
    if (n < SGU) return PWI + (n - SWI);
    return PGU + (n - SGU);
}
__device__ __forceinline__ void gemv_item(Frame& F, int item) {
    const int nb = item % 96, ks = item / 96, n0 = nb * 256 + 4 * F.lane, k0 = ks * 64;
    float cs[4];
#pragma unroll
    for (int b = 0; b < 4; ++b) { const float cv = F.c[b * DM + k0 + F.lane]; cs[b] = cv * pg8::sigmoidf_(cv); }
    f32x4 acc[4];
#pragma unroll
    for (int b = 0; b < 4; ++b) acc[b] = (f32x4){0.f, 0.f, 0.f, 0.f};
    const float* wp = F.ada_w + (size_t)k0 * MODW + n0;
#pragma unroll 16
    for (int k = 0; k < 64; ++k) { const f32x4 w = *(const GAS f32x4*)(wp + (size_t)k * MODW);
#pragma unroll
        for (int b = 0; b < 4; ++b) { const float s = __builtin_bit_cast(float, __builtin_amdgcn_readlane(__builtin_bit_cast(int, cs[b]), k)); acc[b] += w * s; } }
#pragma unroll
    for (int b = 0; b < 4; ++b) *(GAS f32x4*)(F.PART + (size_t)(ks * 4 + b) * MODW + n0) = acc[b];
}
__device__ __forceinline__ void mod_reduce(Frame& F) {
    for (int i = F.gw * 64 + F.lane; i < 4 * (MODW / 4); i += F.NGW * 64) { const int b = i / (MODW / 4), n0 = 4 * (i % (MODW / 4));
        f32x4 a = *(const GAS f32x4*)(F.ada_b + n0);
#pragma unroll 16
        for (int ks = 0; ks < 64; ++ks) a += *(const GAS f32x4*)(F.PART + (size_t)(ks * 4 + b) * MODW + n0);
        *(GAS f32x4*)(F.MOD + b * MODW + n0) = a; }
}
struct TrItem { const float* src; unsigned char* d8; bf16* db; int Nsrc, ldk, drow0, k0; float scale; };
__device__ __forceinline__ void tr_decode(Frame& F, int r, TrItem& t) {
    constexpr int P_IN = (DM / 128) * (IN_W / 32), P_A = (ATTW / 128) * (DM / 32), P_B = (GMW / 128) * (DM / 32), P_O = (DM / 128) * (DM / 32), P_UP = (DM / 128) * (F2 / 32);
    const float* W; int Nsrc, nblk, ldk, drow; unsigned char* d8; bf16* db = nullptr; float sc; bool up = false, in = false;
    if (r < P_IN) { W = F.w_in; Nsrc = IN_W; nblk = IN_W / 32; d8 = (unsigned char*)F.WIN; ldk = DM; sc = 1024.f; in = true; }
    else if ((r -= P_IN) < P_A) { W = F.w_a; Nsrc = DM; nblk = DM / 32; d8 = (unsigned char*)F.WA; ldk = 2 * ATTW; sc = S_WA; }
    else if ((r -= P_A) < P_B) { W = F.w_b; Nsrc = DM; nblk = DM / 32; d8 = (unsigned char*)F.WA + ATTW; ldk = 2 * ATTW; sc = S_WB; }
    else if ((r -= P_B) < P_O) { W = F.w_out; Nsrc = DM; nblk = DM / 32; d8 = (unsigned char*)F.WOUT; ldk = DM; sc = S_WOUT; }
    else if ((r -= P_O) < P_UP) { W = F.w_up; Nsrc = F2; nblk = F2 / 32; d8 = (unsigned char*)F.WUP; ldk = DM; sc = S_WUP; up = true; }
    else { r -= P_UP; W = F.w_dn; Nsrc = DM; nblk = DM / 32; d8 = (unsigned char*)F.WDN; ldk = DFF; sc = S_WDN; }
    const int kb = r / nblk, n = 32 * (r % nblk);
    drow = n;
    if (in) { drow = win_dst_row(n); if (n >= SQI && n < SGU) db = F.WINB; }
    if (up) { const int ch = n < DFF ? n : n - DFF; drow = (ch >> 7) * 256 + (ch & 127) + (n < DFF ? 0 : 128); }
    t.src = W + (size_t)(128 * kb) * Nsrc + n; t.d8 = d8; t.db = db; t.Nsrc = Nsrc; t.ldk = ldk; t.drow0 = drow; t.k0 = 128 * kb; t.scale = sc;
}
__device__ __forceinline__ void tr_load(const TrItem& t, int half, f32x4 (&v)[8], int lane) {
    const float* p = t.src + (size_t)(64 * half + (lane >> 3)) * t.Nsrc + 4 * (lane & 7);
#pragma unroll
    for (int i = 0; i < 8; ++i) v[i] = *(const GAS f32x4*)(p + (size_t)(8 * i) * t.Nsrc);
}
__device__ __forceinline__ void tr_finish(const TrItem& t, int half, const f32x4 (&v)[8], LAS float* scr, int lane) {
#pragma unroll
    for (int i = 0; i < 8; ++i) { LAS float* s = scr + (8 * i + (lane >> 3)) * 33 + 4 * (lane & 7); s[0] = v[i].x; s[1] = v[i].y; s[2] = v[i].z; s[3] = v[i].w; }
    LDS_WAIT(); asm volatile("" ::: "memory");
    const int c = lane & 7, kcol = t.k0 + 64 * half + 8 * c; const float sc = t.scale;
#pragma unroll
    for (int j = 0; j < 4; ++j) { const int n = (lane >> 3) + 8 * j; const LAS float* s = scr + (8 * c) * 33 + n;
        const float e0 = s[0 * 33], e1 = s[1 * 33], e2 = s[2 * 33], e3 = s[3 * 33], e4 = s[4 * 33], e5 = s[5 * 33], e6 = s[6 * 33], e7 = s[7 * 33];
        v2u o; o.x = pk4_fp8(e0 * sc, e1 * sc, e2 * sc, e3 * sc); o.y = pk4_fp8(e4 * sc, e5 * sc, e6 * sc, e7 * sc);
        *(GAS v2u*)(t.d8 + (size_t)(t.drow0 + n) * t.ldk + kcol) = o;
        if (t.db) { v4u ob; ob.x = pk2(e0, e1); ob.y = pk2(e2, e3); ob.z = pk2(e4, e5); ob.w = pk2(e6, e7); *(GAS v4u*)(t.db + (size_t)(t.drow0 + n) * t.ldk + kcol) = ob; } }
    LDS_WAIT(); asm volatile("" ::: "memory");
}
constexpr int TR_P_IN = (DM / 128) * (IN_W / 32), TR_P_A = (ATTW / 128) * (DM / 32), TR_P_B = (GMW / 128) * (DM / 32), TR_P_O = (DM / 128) * (DM / 32), TR_P_UP = (DM / 128) * (F2 / 32), TR_P_DN = (DFF / 128) * (DM / 32);
constexpr int TR_OUT0 = TR_P_IN + TR_P_A + TR_P_B, TR_UP0 = TR_OUT0 + TR_P_O, TR_DN0 = TR_UP0 + TR_P_UP, TR_ALL = TR_DN0 + TR_P_DN;
constexpr int TR_DN_LATE = 3584;
template <int LIST> __device__ __forceinline__ int tr_map(int v) {
    if (LIST == 1) return v < TR_OUT0 ? v : v + TR_P_O;
    if (LIST == 2) return v < TR_P_O ? TR_OUT0 + v : TR_DN0 + (v - TR_P_O);
    if (LIST == 3) return TR_ALL - TR_DN_LATE + v;
    return v;
}
template <int LIST> __device__ __forceinline__ void tr_run(Frame& F, int r0, int rend, int stride, LAS float* scr) {
    TrItem A, B; f32x4 a0[8], a1[8], b0[8], b1[8];
    int r = r0; bool hasA = r < rend;
    if (hasA) { tr_decode(F, tr_map<LIST>(r), A); tr_load(A, 0, a0, F.lane); tr_load(A, 1, a1, F.lane); }
    while (hasA) {
        const int rb = r + stride; const bool hasB = rb < rend;
        if (hasB) { tr_decode(F, tr_map<LIST>(rb), B); tr_load(B, 0, b0, F.lane); tr_load(B, 1, b1, F.lane); }
        tr_finish(A, 0, a0, scr, F.lane); tr_finish(A, 1, a1, scr, F.lane);
        if (!hasB) break;
        r = rb + stride; hasA = r < rend;
        if (hasA) { tr_decode(F, tr_map<LIST>(r), A); tr_load(A, 0, a0, F.lane); tr_load(A, 1, a1, F.lane); }
        tr_finish(B, 0, b0, scr, F.lane); tr_finish(B, 1, b1, scr, F.lane);
    }
}
__device__ __forceinline__ void p0_prologue(Frame& F, bool with_gemv = true) {
    LAS float* scr = (LAS float*)(F.lds + RING_OFF + F.wave * 16384);
    constexpr int I_GV = 96 * 64;
    if (with_gemv) for (int it = F.gw; it < I_GV; it += F.NGW) gemv_item(F, it);
    if (F.G == 256) tr_run<1>(F, F.gw, TR_ALL - TR_P_O - TR_P_DN, F.NGW, scr); else tr_run<0>(F, F.gw, TR_ALL, F.NGW, scr);
    { const size_t n16 = (size_t)(PNP - IN_W) * DM / 16; GAS v4u* p = (GAS v4u*)((unsigned char*)F.WIN + (size_t)IN_W * DM);
      for (size_t i = (size_t)F.gw * 64 + F.lane; i < n16; i += (size_t)F.NGW * 64) p[i] = (v4u){0u, 0u, 0u, 0u};
      GAS v4u* pb = (GAS v4u*)(F.WINB + (size_t)IN_W * DM);
      for (size_t i = (size_t)F.gw * 64 + F.lane; i < 2 * n16; i += (size_t)F.NGW * 64) pb[i] = (v4u){0u, 0u, 0u, 0u}; }
}

template <int FP8 = 0, bool XBF = false>
__device__ __forceinline__ void norm_rows(Frame& F, const void* X, const float* gain, int sh_off, int sc_off, void* Ov, unsigned char* O8 = nullptr) {
    LAS f32x4* CA = (LAS f32x4*)F.lds; LAS f32x4* CB = (LAS f32x4*)(F.lds + 16384);
    for (int blk = blockIdx.x; blk < M / 32; blk += F.G) {
        const int b = (blk * 32) >> 11;
        __syncthreads();
        for (int i = F.tid; i < DM / 4; i += NWAVES * 64) { const f32x4 g = ((const GAS f32x4*)gain)[i], sh = ((const GAS f32x4*)(F.MOD + b * MODW + sh_off))[i], sc = ((const GAS f32x4*)(F.MOD + b * MODW + sc_off))[i];
            CA[i] = g * (sc + 1.0f); CB[i] = sh; }
        __syncthreads();
        const int m0 = blk * 32 + 4 * F.wave;
        f32x4 va[16], vb[16];
#define NR_LOAD(v, m_) do { if constexpr (XBF) { const GAS v2u* xr = (const GAS v2u*)((const bf16*)X + (size_t)(m_) * DM) + F.lane; _Pragma("unroll") for (int j = 0; j < 16; ++j) { const v2u w_ = xr[64 * j]; v[j] = (f32x4){bflo(w_.x), bfhi(w_.x), bflo(w_.y), bfhi(w_.y)}; } } \
        else { const GAS f32x4* xr = (const GAS f32x4*)((const float*)X + (size_t)(m_) * DM) + F.lane; _Pragma("unroll") for (int j = 0; j < 16; ++j) v[j] = xr[64 * j]; } } while (0)
#define NR_FIN(v, m_) do { float s_ = 0.f; _Pragma("unroll") for (int j = 0; j < 16; ++j) s_ += (v[j].x * v[j].x + v[j].y * v[j].y) + (v[j].z * v[j].z + v[j].w * v[j].w); \
            const float rstd = 1.0f / sqrtf(wave_sum(s_) * (1.f / DM) + EPS); \
            GAS v2u* o8 = (GAS v2u*)((bf16*)Ov + (size_t)(m_) * DM) + F.lane; GAS unsigned* o4 = (GAS unsigned*)((FP8 == 2 ? O8 : (unsigned char*)Ov) + (size_t)(m_) * DM) + F.lane; \
            _Pragma("unroll") for (int j = 0; j < 16; ++j) { const f32x4 y = (v[j] * rstd) * CA[64 * j + F.lane] + CB[64 * j + F.lane]; \
                if constexpr (FP8 != 0) o4[64 * j] = pk4_fp8(y.x * S_H2, y.y * S_H2, y.z * S_H2, y.w * S_H2); \
                if constexpr (FP8 != 1) { v2u w_; w_.x = pk2(y.x, y.y); w_.y = pk2(y.z, y.w); o8[64 * j] = w_; } \
                if ((j & 3) == 3) asm volatile("" ::: "memory"); } } while (0)
        NR_LOAD(va, m0); NR_LOAD(vb, m0 + 1); NR_FIN(va, m0); NR_LOAD(va, m0 + 2); NR_FIN(vb, m0 + 1); NR_LOAD(vb, m0 + 3); NR_FIN(va, m0 + 2); NR_FIN(vb, m0 + 3);
#undef NR_LOAD
#undef NR_FIN
    }
}

__device__ __forceinline__ unsigned sortable(float f) { const unsigned u = __builtin_bit_cast(unsigned, f); return u ^ ((unsigned)((int)u >> 31) | 0x80000000u); }
__device__ __forceinline__ void select_topk(const unsigned (&sc)[32], GAS v2u* mrow, int lane) {
    unsigned thr = 0u;
    for (int bit = 31; bit >= 0; --bit) {
        const unsigned cand = thr | (1u << bit); int cnt = 0;
#pragma unroll
        for (int jp = 0; jp < 32; ++jp) cnt += __popcll(__ballot(sc[jp] >= cand));
        if (cnt >= TOPK) thr = cand;
    }
    int cgt = 0;
#pragma unroll
    for (int jp = 0; jp < 32; ++jp) cgt += __popcll(__ballot(sc[jp] > thr));
    const int need = TOPK - cgt; int seen = 0;
    unsigned mylo = 0u, myhi = 0u;
    const unsigned long long lt = (lane == 0) ? 0ull : (~0ull >> (64 - lane));
#pragma unroll
    for (int jp = 0; jp < 32; ++jp) {
        unsigned long long sel = __ballot(sc[jp] > thr);
        const unsigned long long eq = __ballot(sc[jp] == thr);
        if (eq) { const bool take = (sc[jp] == thr) && (seen + __popcll(eq & lt) < need); sel |= __ballot(take); seen += __popcll(eq); }
        if (lane == jp) { mylo = (unsigned)sel; myhi = (unsigned)(sel >> 32); }
    }
    if (lane < 32) { v2u w; w.x = mylo; w.y = myhi; mrow[lane] = w; }
}
__device__ __forceinline__ void idx_block(Frame& F, int b, int blk) {
    const int lane = F.lane, w = F.wave, hi = lane >> 5, l31 = lane & 31, tid = F.tid;
    const int t0 = blk * 8, tq = t0 + w;
    const size_t row = (size_t)b * SEQ + tq;
    GAS v2u* mrow = (GAS v2u*)(F.MASK + row * 64);
    if (t0 < TOPK) {
        if (lane < 32) { const int k0 = 64 * lane; v2u mw;
            mw.x = (tq >= k0 + 31) ? 0xffffffffu : (tq < k0 ? 0u : ((2u << (tq - k0)) - 1u));
            mw.y = (tq >= k0 + 63) ? 0xffffffffu : (tq < k0 + 32 ? 0u : ((2u << (tq - k0 - 32)) - 1u));
            mrow[lane] = mw; }
        return;
    }
    const int nt = (t0 + 7) / 128 + 1;
    const bf16* prow = F.PROJ + row * PNP;
    bf16x8 qa[4]; float wv[16];
#pragma unroll
    for (int ks = 0; ks < 4; ++ks) qa[ks] = *(const GAS bf16x8*)(prow + PQI + l31 * 64 + 16 * ks + 8 * hi);
#pragma unroll
    for (int r = 0; r < 16; ++r) wv[r] = bf2f(prow[PWI + (r & 3) + 8 * (r >> 2) + 4 * hi]);
    const bf16* ksrc = F.PROJ + ((size_t)b * SEQ + (tid >> 3)) * PNP + PKI + 8 * (tid & 7);
    const int kdst = (tid >> 3) * 128 + (((tid & 7) ^ ((tid >> 3) & 7)) << 4);
    const int krd = l31 * 128;
    unsigned sc[32];
    __syncthreads();
    v4u stg0 = *(const GAS v4u*)ksrc, stg1 = *(const GAS v4u*)(ksrc + (size_t)64 * PNP);
#pragma unroll
    for (int kt = 0; kt < 16; ++kt) {
        if (kt < nt) {
            LAS unsigned char* kb_base = F.lds + (kt & 1) * 16384;
            *(LAS v4u*)(kb_base + kdst) = stg0; *(LAS v4u*)(kb_base + 8192 + kdst) = stg1;
            if (kt + 1 < nt) { stg0 = *(const GAS v4u*)(ksrc + (size_t)(kt + 1) * 128 * PNP); stg1 = *(const GAS v4u*)(ksrc + (size_t)((kt + 1) * 128 + 64) * PNP); }
            LDS_WAIT(); __builtin_amdgcn_s_barrier(); asm volatile("" ::: "memory");
            float s4[4];
#pragma unroll
            for (int h = 0; h < 4; ++h) {
                f32x16 acc;
#pragma unroll
                for (int r = 0; r < 16; ++r) acc[r] = 0.f;
#pragma unroll
                for (int ks = 0; ks < 4; ++ks) { const bf16x8 kf = *(const LAS bf16x8*)(kb_base + h * 4096 + krd + (((2 * ks + hi) ^ (l31 & 7)) << 4));
                    acc = __builtin_amdgcn_mfma_f32_32x32x16_bf16(qa[ks], kf, acc, 0, 0, 0); }
                float x0 = 0.f, x1 = 0.f;
#pragma unroll
                for (int r = 0; r < 16; r += 2) { x0 += wv[r] * fmaxf(acc[r], 0.f); x1 += wv[r + 1] * fmaxf(acc[r + 1], 0.f); }
                s4[h] = xor32_sum(x0 + x1);
            }
            const float ma = (lane < 32 ? s4[0] : s4[1]) + 0.0f, mb = (lane < 32 ? s4[2] : s4[3]) + 0.0f;
            sc[2 * kt] = (128 * kt + lane <= tq) ? sortable(ma) : 0u;
            sc[2 * kt + 1] = (128 * kt + 64 + lane <= tq) ? sortable(mb) : 0u;
        } else { sc[2 * kt] = 0u; sc[2 * kt + 1] = 0u; }
    }
    select_topk(sc, mrow, lane);
}
constexpr float QSCALE = 0.08838834764831845f * 1.4426950408889634f;
__device__ __forceinline__ void qknorm_row(Frame& F, int row) {
    bf16* prow = F.PROJ + (size_t)row * PNP; const int lane = F.lane;
    {
        GAS v4u* p = (GAS v4u*)(prow + PQ + 32 * lane); v4u w[4]; float ss = 0.f;
#pragma unroll
        for (int i = 0; i < 4; ++i) { w[i] = p[i];
#pragma unroll
            for (int j = 0; j < 4; ++j) { const float a = bflo(w[i][j]), c = bfhi(w[i][j]); ss += a * a + c * c; } }
        ss += __shfl_xor(ss, 1); ss += __shfl_xor(ss, 2);
        const float r = QSCALE / sqrtf(ss * (1.f / HD) + EPS); const float* g = F.qng + 32 * (lane & 3);
#pragma unroll
        for (int i = 0; i < 4; ++i) { v4u o;
#pragma unroll
            for (int j = 0; j < 4; ++j) o[j] = pk2(bflo(w[i][j]) * r * g[8 * i + 2 * j], bfhi(w[i][j]) * r * g[8 * i + 2 * j + 1]);
            p[i] = o; }
    }
    {
        GAS v4u* p = (GAS v4u*)(prow + PK + 8 * lane); const v4u w = *p; float ss = 0.f;
#pragma unroll
        for (int j = 0; j < 4; ++j) { const float a = bflo(w[j]), c = bfhi(w[j]); ss += a * a + c * c; }
        ss += __shfl_xor(ss, 1); ss += __shfl_xor(ss, 2); ss += __shfl_xor(ss, 4); ss += __shfl_xor(ss, 8);
        const float r = 1.0f / sqrtf(ss * (1.f / HD) + EPS); const float* g = F.kng + 8 * (lane & 15); v4u o;
#pragma unroll
        for (int j = 0; j < 4; ++j) o[j] = pk2(bflo(w[j]) * r * g[2 * j], bfhi(w[j]) * r * g[2 * j + 1]);
        *p = o;
    }
    {
        const GAS v4u* p = (const GAS v4u*)(prow + PGV + 32 * lane); float ss = 0.f;
#pragma unroll
        for (int i = 0; i < 4; ++i) { const v4u w = p[i];
#pragma unroll
            for (int j = 0; j < 4; ++j) { const float a = bflo(w[j]), c = bfhi(w[j]); ss += a * a + c * c; } }
        ss = wave_sum(ss);
        if (lane == 0) F.RS[row] = 1.0f / sqrtf(ss * (1.f / GMW) + EPS);
    }
}
__device__ __forceinline__ void vt_item(Frame& F, int item) {
    const int s8 = item & 255, dh = (item >> 8) & 1, g = (item >> 9) & 3, b = item >> 11, d = 64 * dh + F.lane;
    const bf16* src = F.PROJ + (size_t)(b * SEQ + 8 * s8) * PNP + PV + g * HD + d;
    unsigned e[8];
#pragma unroll
    for (int j = 0; j < 8; ++j) e[j] = src[(size_t)j * PNP];
    v4u o; o.x = e[0] | (e[1] << 16); o.y = e[2] | (e[3] << 16); o.z = e[4] | (e[5] << 16); o.w = e[6] | (e[7] << 16);
    *(GAS v4u*)(F.VT + ((size_t)((b * NKV + g) * HD + d)) * SEQ + 8 * s8) = o;
}

constexpr int AT_KSTR = 272, AT_VSTR = 136, AT_TILE = 17408;
#define RAW_BARRIER() do { LDS_WAIT(); __builtin_amdgcn_s_barrier(); asm volatile("" ::: "memory"); } while (0)
__device__ __forceinline__ void attn_block(Frame& F, int b, int g, int qb, float sbound) {
    const int lane = F.lane, w = F.wave, hi = lane >> 5, l31 = lane & 31, tid = F.tid;
    const int hh = 4 * g + (w >> 1), tw0 = qb * 64 + 32 * (w & 1), t = tw0 + l31;
    const size_t row = (size_t)b * SEQ + t;
    const float slope2 = exp2f(-0.5f * (float)(hh + 1)) * 1.4426950408889634f;
    bf16x8 qf[8];
#pragma unroll
    for (int ks = 0; ks < 8; ++ks) qf[ks] = *(const GAS bf16x8*)(F.PROJ + row * PNP + PQ + hh * HD + 16 * ks + 8 * hi);
    f32x16 o[4];
#pragma unroll
    for (int db = 0; db < 4; ++db)
#pragma unroll
        for (int r = 0; r < 16; ++r) o[db][r] = 0.f;
    float m = -1e30f, lsum = 0.f;
    const bf16* ksrc = F.PROJ + ((size_t)b * SEQ + (tid >> 4)) * PNP + PK + g * HD + 8 * (tid & 15);
    const int kdst = (tid >> 4) * AT_KSTR + (tid & 15) * 16;
    const bf16* vsrc = F.VT + ((size_t)((b * NKV + g) * HD + (tid >> 3))) * SEQ + 8 * (tid & 7);
    const int vdst = 2 * AT_TILE + (tid >> 3) * AT_VSTR + (tid & 7) * 16;
    const unsigned* mbase = F.MASK + row * 64;
    LAS unsigned char* L = F.lds;
    v4u sk0, sk1, sv0, sv1; v2u mw, mwn;
#define AT_LOAD(kt_) do { sk0 = *(const GAS v4u*)(ksrc + (size_t)(64 * (kt_)) * PNP); sk1 = *(const GAS v4u*)(ksrc + (size_t)(64 * (kt_) + 32) * PNP); \
        sv0 = *(const GAS v4u*)(vsrc + 64 * (kt_)); sv1 = *(const GAS v4u*)(vsrc + (size_t)64 * SEQ + 64 * (kt_)); mwn = *(const GAS v2u*)(mbase + 2 * (kt_)); } while (0)
#define AT_STORE(bf_) do { *(LAS v4u*)(L + (bf_) * AT_TILE + kdst) = sk0; *(LAS v4u*)(L + (bf_) * AT_TILE + kdst + 32 * AT_KSTR) = sk1; \
        LAS unsigned char* _v = L + (bf_) * AT_TILE + vdst; *(LAS v2u*)_v = (v2u){sv0.x, sv0.y}; *(LAS v2u*)(_v + 8) = (v2u){sv0.z, sv0.w}; \
        *(LAS v2u*)(_v + 64 * AT_VSTR) = (v2u){sv1.x, sv1.y}; *(LAS v2u*)(_v + 64 * AT_VSTR + 8) = (v2u){sv1.z, sv1.w}; } while (0)
    RAW_BARRIER();
    AT_LOAD(qb); AT_STORE(0); mw = mwn;
    int buf = 0; bool dead = false;
    for (int kt = qb; kt >= 0; --kt) {
        if (kt > 0) AT_LOAD(kt - 1);
        RAW_BARRIER();
        if (!dead) {
            const float dmin = (float)(tw0 - (64 * kt + 63));
            dead = __all((sbound - slope2 * dmin) < (m - 40.0f));
        }
        if (!dead) {
            const LAS unsigned char* kb_ = L + buf * AT_TILE + l31 * AT_KSTR + hi * 16;
            const LAS unsigned char* vb_ = L + buf * AT_TILE + 2 * AT_TILE + l31 * AT_VSTR + hi * 8;
            f32x16 p[2];
#pragma unroll
            for (int kb = 0; kb < 2; ++kb) { const unsigned mword = (kb ? mw.y : mw.x) >> (4 * hi);
#pragma unroll
                for (int r = 0; r < 16; ++r) { const int ko = (r & 3) + 8 * (r >> 2);
                    p[kb][r] = ((mword >> ko) & 1u) ? slope2 * (float)(32 * kb + ko) : -2e30f; }
#pragma unroll
                for (int ks = 0; ks < 8; ++ks) { const bf16x8 kf = *(const LAS bf16x8*)(kb_ + kb * 32 * AT_KSTR + ks * 32); p[kb] = __builtin_amdgcn_mfma_f32_32x32x16_bf16(kf, qf[ks], p[kb], 0, 0, 0); }
            }
            const float base = -slope2 * (float)(t - 64 * kt - 4 * hi);
            float rmax = -3e30f;
#pragma unroll
            for (int kb = 0; kb < 2; ++kb)
#pragma unroll
                for (int r = 0; r < 16; ++r) rmax = fmaxf(rmax, p[kb][r]);
            rmax += base; rmax = xor32_max(rmax);
            const float mn = fmaxf(m, rmax), alpha = __builtin_amdgcn_exp2f(m - mn), mrel = mn - base;
            const bool moved = __any(mn != m);
            m = mn;
            float ps = 0.f;
#pragma unroll
            for (int kb = 0; kb < 2; ++kb)
#pragma unroll
                for (int r = 0; r < 16; ++r) { const float e = __builtin_amdgcn_exp2f(p[kb][r] - mrel); p[kb][r] = e; ps += e; }
            lsum = lsum * alpha + ps;
            if (moved) {
#pragma unroll
                for (int db = 0; db < 4; ++db)
#pragma unroll
                    for (int r = 0; r < 16; ++r) o[db][r] *= alpha;
            }
#pragma unroll
            for (int kb = 0; kb < 2; ++kb)
#pragma unroll
                for (int s2 = 0; s2 < 2; ++s2) {
                    v4u pw; pw.x = pk2(p[kb][8 * s2 + 0], p[kb][8 * s2 + 1]); pw.y = pk2(p[kb][8 * s2 + 2], p[kb][8 * s2 + 3]); pw.z = pk2(p[kb][8 * s2 + 4], p[kb][8 * s2 + 5]); pw.w = pk2(p[kb][8 * s2 + 6], p[kb][8 * s2 + 7]);
                    const bf16x8 pb = __builtin_bit_cast(bf16x8, pw);
#pragma unroll
                    for (int db = 0; db < 4; ++db) { const LAS unsigned char* vp = vb_ + db * 32 * AT_VSTR + kb * 64 + s2 * 32;
                        const v2u v0 = *(const LAS v2u*)vp, v1 = *(const LAS v2u*)(vp + 16);
                        v4u vw; vw.x = v0.x; vw.y = v0.y; vw.z = v1.x; vw.w = v1.y;
                        o[db] = __builtin_amdgcn_mfma_f32_32x32x16_bf16(__builtin_bit_cast(bf16x8, vw), pb, o[db], 0, 0, 0); }
                }
        }
        if (kt > 0) { AT_STORE(buf ^ 1); mw = mwn; }
        buf ^= 1;
    }
#undef AT_LOAD
#undef AT_STORE
    lsum = xor32_sum(lsum);
    const float inv = S_YA / lsum;
    unsigned char* yrow = (unsigned char*)F.YA + row * (2 * ATTW) + hh * HD + 4 * hi;
#pragma unroll
    for (int db = 0; db < 4; ++db)
#pragma unroll
        for (int rq = 0; rq < 4; ++rq) *(GAS unsigned*)(yrow + 32 * db + 8 * rq) = pk4_fp8(o[db][4 * rq] * inv, o[db][4 * rq + 1] * inv, o[db][4 * rq + 2] * inv, o[db][4 * rq + 3] * inv);
}
__device__ __forceinline__ float attn_score_bound(Frame& F) {
    float gq = fmaxf(fabsf(F.qng[F.lane]), fabsf(F.qng[F.lane + 64])), gk = fmaxf(fabsf(F.kng[F.lane]), fabsf(F.kng[F.lane + 64]));
#pragma unroll
    for (int o = 1; o < 64; o <<= 1) { gq = fmaxf(gq, __shfl_xor(gq, o)); gk = fmaxf(gk, __shfl_xor(gk, o)); }
    return 1.02f * 128.0f * gq * gk * QSCALE;
}

constexpr int SG_STR = 272, SG_WOFF = 65536;
__device__ __forceinline__ void sgu_unit(Frame& F, int unit) {
    const int ck = unit >> 3, g = unit & 7, r0 = ck * GMC, c0 = g * GMGW, tid = F.tid, lane = F.lane, w = F.wave, hi = lane >> 5, l31 = lane & 31;
    LAS unsigned char* L = F.lds;
    const int rs_ = tid >> 5, q_ = tid & 31;
    __syncthreads();
#pragma unroll
    for (int i = 0; i < 8; ++i) *(LAS v4u*)(L + (rs_ + 16 * i) * 512 + q_ * 16) = *(const GAS v4u*)(F.PROJ + (size_t)(r0 + rs_ + 16 * i) * PNP + PGV + c0 + 8 * q_);
    { const f32x4 q = *(const GAS f32x4*)(F.RS + r0 + 4 * q_);
#pragma unroll
      for (int i = 0; i < 8; ++i) { const int t_ = rs_ + 16 * i; const f32x4 wv = *(const GAS f32x4*)(F.sgw + ((size_t)(g * GMC + t_)) * GMC + 4 * q_);
          const int sb = 4 * q_; v2u o;
          o.x = pk2(sb + 0 <= t_ ? wv.x * q.x : 0.f, sb + 1 <= t_ ? wv.y * q.y : 0.f); o.y = pk2(sb + 2 <= t_ ? wv.z * q.z : 0.f, sb + 3 <= t_ ? wv.w * q.w : 0.f);
          *(LAS v2u*)(L + SG_WOFF + t_ * SG_STR + 8 * q_) = o; } }
    __syncthreads();
    v4u uu[8];
#pragma unroll
    for (int i = 0; i < 8; ++i) uu[i] = *(const GAS v4u*)(F.PROJ + (size_t)(r0 + rs_ + 16 * i) * PNP + PGU + c0 + 8 * q_);
    f32x16 acc[4];
#pragma unroll
    for (int tb = 0; tb < 4; ++tb)
#pragma unroll
        for (int r = 0; r < 16; ++r) acc[tb][r] = 0.f;
    const LAS unsigned char* xb = L + hi * 8 * 512 + 2 * (32 * w + l31);
    const LAS unsigned char* wa = L + SG_WOFF + l31 * SG_STR + hi * 16;
#pragma unroll
    for (int ks = 0; ks < 8; ++ks) {
        v4u xw;
#pragma unroll
        for (int j = 0; j < 4; ++j) { const unsigned lo = *(const LAS unsigned short*)(xb + (16 * ks + 2 * j) * 512), hh = *(const LAS unsigned short*)(xb + (16 * ks + 2 * j + 1) * 512); xw[j] = lo | (hh << 16); }
        const bf16x8 xf = __builtin_bit_cast(bf16x8, xw);
#pragma unroll
        for (int tb = 0; tb < 4; ++tb) if (ks < 2 * (tb + 1)) { const bf16x8 wf = *(const LAS bf16x8*)(wa + tb * 32 * SG_STR + ks * 32); acc[tb] = __builtin_amdgcn_mfma_f32_32x32x16_bf16(wf, xf, acc[tb], 0, 0, 0); } }
    LDS_WAIT(); __builtin_amdgcn_s_barrier(); asm volatile("" ::: "memory");
    { const int cl = 32 * w + l31;
#pragma unroll
      for (int tb = 0; tb < 4; ++tb)
#pragma unroll
          for (int r = 0; r < 16; ++r) { const int t = 32 * tb + (r & 3) + 8 * (r >> 2) + 4 * hi; *(LAS unsigned short*)(L + t * 512 + 2 * cl) = (unsigned short)f2bf(acc[tb][r]); } }
    const f32x4 g0 = *(const GAS f32x4*)(F.sgg + c0 + 8 * q_), g1 = *(const GAS f32x4*)(F.sgg + c0 + 8 * q_ + 4);
    LDS_WAIT(); __builtin_amdgcn_s_barrier(); asm volatile("" ::: "memory");
#pragma unroll
    for (int i = 0; i < 8; ++i) { const v4u fw = *(const LAS v4u*)(L + (rs_ + 16 * i) * 512 + q_ * 16); const float bb = F.sgb[g * GMC + rs_ + 16 * i]; v2u o;
        o.x = pk4_fp8(S_YB * bflo(uu[i].x) * (bflo(fw.x) * g0.x + bb), S_YB * bfhi(uu[i].x) * (bfhi(fw.x) * g0.y + bb), S_YB * bflo(uu[i].y) * (bflo(fw.y) * g0.z + bb), S_YB * bfhi(uu[i].y) * (bfhi(fw.y) * g0.w + bb));
        o.y = pk4_fp8(S_YB * bflo(uu[i].z) * (bflo(fw.z) * g1.x + bb), S_YB * bfhi(uu[i].z) * (bfhi(fw.z) * g1.y + bb), S_YB * bflo(uu[i].w) * (bflo(fw.w) * g1.z + bb), S_YB * bfhi(uu[i].w) * (bfhi(fw.w) * g1.w + bb));
        *(GAS v2u*)((unsigned char*)F.YA + (size_t)(r0 + rs_ + 16 * i) * (2 * ATTW) + ATTW + c0 + 8 * q_) = o; }
}

using pg8::Unit; using pg8::cvt_pk_bf16;
struct EpiProj {
    static constexpr bool PERM = true, MIDK = false; bf16* O; float scale;
    __device__ __forceinline__ void operator()(const f32x4 (&acc)[2][2][4][2], const Unit& u, int wr, int wc, int fr, int fq) const {
        const int act = (u.pn >= PGU / 256 && u.pn < PGA / 256) ? 1 : ((u.pn >= PGA / 256 && u.pn < PKI / 256) ? 2 : 0);
        const int row0 = u.pm * 256 + wr * 64 + fr, col0 = u.pn * 256 + wc * 32 + 8 * fq;
#pragma unroll
        for (int ai = 0; ai < 2; ++ai)
#pragma unroll
            for (int m = 0; m < 4; ++m) { bf16* rowp = O + (size_t)(row0 + ai * 128 + m * 16) * PNP + col0;
#pragma unroll
                for (int bj = 0; bj < 2; ++bj) { f32x4 v0 = acc[ai][bj][m][0] * scale, v1 = acc[ai][bj][m][1] * scale;
                    if (act == 1) { const pg8::f32x2 a = pg8::gelu_pk((pg8::f32x2){v0[0], v0[1]}), b = pg8::gelu_pk((pg8::f32x2){v0[2], v0[3]}), c = pg8::gelu_pk((pg8::f32x2){v1[0], v1[1]}), d = pg8::gelu_pk((pg8::f32x2){v1[2], v1[3]});
                        v0 = (f32x4){a.x, a.y, b.x, b.y}; v1 = (f32x4){c.x, c.y, d.x, d.y}; }
                    else if (act == 2) {
#pragma unroll
                        for (int j = 0; j < 4; ++j) { v0[j] = pg8::sigmoidf_(v0[j]); v1[j] = pg8::sigmoidf_(v1[j]); } }
                    v4u w; w.x = cvt_pk_bf16(v0[0], v0[1]); w.y = cvt_pk_bf16(v0[2], v0[3]); w.z = cvt_pk_bf16(v1[0], v1[1]); w.w = cvt_pk_bf16(v1[2], v1[3]);
                    *(GAS v4u*)(rowp + bj * 128) = w; } }
    }
};
struct EpiMerge {
    static constexpr bool PERM = true, MIDK = true; const bf16* P; unsigned char* O; float cB, ratio;
    __device__ __forceinline__ void mid(f32x4 (&acc)[2][2][4][2], const Unit& u, int wr, int wc, int fr, int fq) const {
        const bf16* pb = P + (size_t)(u.pm * 256 + wr * 64 + fr) * PNP + (u.pn * 256 + wc * 32 + 8 * fq);
        asm volatile("" : "+v"(pb));
#pragma unroll
        for (int ai = 0; ai < 2; ++ai)
#pragma unroll
            for (int m = 0; m < 4; ++m) {
#pragma unroll
                for (int bj = 0; bj < 2; ++bj) { const bf16* q = pb + (size_t)(ai * 128 + m * 16) * PNP + bj * 128;
                    const v4u ga = *(const GAS v4u*)(q + PGA), gb = *(const GAS v4u*)(q + PGB);
#pragma unroll
                    for (int j = 0; j < 2; ++j) { f32x4 f;
                        f.x = ratio * bflo(ga[2 * j]) * __builtin_amdgcn_rcpf(fmaxf(bflo(gb[2 * j]), 1e-30f)); f.y = ratio * bfhi(ga[2 * j]) * __builtin_amdgcn_rcpf(fmaxf(bfhi(gb[2 * j]), 1e-30f));
                        f.z = ratio * bflo(ga[2 * j + 1]) * __builtin_amdgcn_rcpf(fmaxf(bflo(gb[2 * j + 1]), 1e-30f)); f.w = ratio * bfhi(ga[2 * j + 1]) * __builtin_amdgcn_rcpf(fmaxf(bfhi(gb[2 * j + 1]), 1e-30f));
                        acc[ai][bj][m][j] *= f; }
                    asm volatile("" ::: "memory"); } }
    }
    __device__ __forceinline__ void operator()(const f32x4 (&acc)[2][2][4][2], const Unit& u, int wr, int wc, int fr, int fq) const {
        const float sc = cB * S_MRG;
        const bf16* pb = P + (size_t)(u.pm * 256 + wr * 64 + fr) * PNP + (u.pn * 256 + wc * 32 + 8 * fq) + PGB;
        unsigned char* ob = O + (size_t)(u.pm * 256 + wr * 64 + fr) * DM + (u.pn * 256 + wc * 32 + 8 * fq);
        asm volatile("" : "+v"(pb), "+v"(ob));
#pragma unroll
        for (int ai = 0; ai < 2; ++ai)
#pragma unroll
            for (int m = 0; m < 4; ++m) {
#pragma unroll
                for (int bj = 0; bj < 2; ++bj) { const v4u gw = *(const GAS v4u*)(pb + (size_t)(ai * 128 + m * 16) * PNP + bj * 128);
                    const f32x4 v0 = acc[ai][bj][m][0] * ((f32x4){fmaxf(bflo(gw.x), 1e-30f), fmaxf(bfhi(gw.x), 1e-30f), fmaxf(bflo(gw.y), 1e-30f), fmaxf(bfhi(gw.y), 1e-30f)} * sc);
                    const f32x4 v1 = acc[ai][bj][m][1] * ((f32x4){fmaxf(bflo(gw.z), 1e-30f), fmaxf(bfhi(gw.z), 1e-30f), fmaxf(bflo(gw.w), 1e-30f), fmaxf(bfhi(gw.w), 1e-30f)} * sc);
                    v2u w; w.x = pk4_fp8(v0[0], v0[1], v0[2], v0[3]); w.y = pk4_fp8(v1[0], v1[1], v1[2], v1[3]);
                    *(GAS v2u*)(ob + (size_t)(ai * 128 + m * 16) * DM + bj * 128) = w; } }
    }
};
template <bool BIN, bool BOUT>
struct EpiResid {
    static constexpr bool PERM = false, MIDK = false; const void* base; const float* gate; void* C; float scale;
    __device__ __forceinline__ void operator()(const f32x4 (&acc)[2][2][4][2], const Unit& u, int wr, int wc, int fr, int fq) const {
        const int row0 = u.pm * 256 + wr * 64 + fr, col0 = u.pn * 256 + wc * 32 + 4 * fq; const float* gp = gate + (u.pm >> 3) * MODW + col0;
        f32x4 gv[2][2];
#pragma unroll
        for (int bj = 0; bj < 2; ++bj)
#pragma unroll
            for (int n = 0; n < 2; ++n) gv[bj][n] = *(const GAS f32x4*)(gp + bj * 128 + n * 16) * scale;
#pragma unroll
        for (int ai = 0; ai < 2; ++ai)
#pragma unroll
            for (int m = 0; m < 4; ++m) { const size_t off = (size_t)(row0 + ai * 128 + m * 16) * DM + col0;
#pragma unroll
                for (int bj = 0; bj < 2; ++bj)
#pragma unroll
                    for (int n = 0; n < 2; ++n) { const size_t o = off + bj * 128 + n * 16; f32x4 bs;
                        if constexpr (BIN) { const v2u w = *(const GAS v2u*)((const bf16*)base + o); bs = (f32x4){bflo(w.x), bfhi(w.x), bflo(w.y), bfhi(w.y)}; }
                        else bs = *(const GAS f32x4*)((const float*)base + o);
                        const f32x4 r = bs + gv[bj][n] * acc[ai][bj][m][n];
                        if constexpr (BOUT) { v2u w; w.x = cvt_pk_bf16(r.x, r.y); w.y = cvt_pk_bf16(r.z, r.w); *(GAS v2u*)((bf16*)C + o) = w; }
                        else *(GAS f32x4*)((float*)C + o) = r; } }
    }
};
struct EpiPlain {
    static constexpr bool PERM = true, MIDK = false; unsigned char* O; int ldc; float scale;
    __device__ __forceinline__ void operator()(const f32x4 (&acc)[2][2][4][2], const Unit& u, int wr, int wc, int fr, int fq) const {
        unsigned char* ob = O + (size_t)(u.pm * 256 + wr * 64 + fr) * ldc + (u.pn * 256 + wc * 32 + 8 * fq);
        asm volatile("" : "+v"(ob));
#pragma unroll
        for (int ai = 0; ai < 2; ++ai)
#pragma unroll
            for (int m = 0; m < 4; ++m)
#pragma unroll
                for (int bj = 0; bj < 2; ++bj) { const f32x4 v0 = acc[ai][bj][m][0] * scale, v1 = acc[ai][bj][m][1] * scale;
                    v2u w; w.x = pk4_fp8(v0[0], v0[1], v0[2], v0[3]); w.y = pk4_fp8(v1[0], v1[1], v1[2], v1[3]);
                    *(GAS v2u*)(ob + (size_t)(ai * 128 + m * 16) * ldc + bj * 128) = w; }
    }
};

__device__ __forceinline__ void unpack8_fp8(v2u w, float (&o)[8]) {
    typedef float f32x2_ __attribute__((ext_vector_type(2)));
    const f32x2_ a = __builtin_amdgcn_cvt_pk_f32_fp8((int)w.x, false), b = __builtin_amdgcn_cvt_pk_f32_fp8((int)w.x, true), c = __builtin_amdgcn_cvt_pk_f32_fp8((int)w.y, false), d = __builtin_amdgcn_cvt_pk_f32_fp8((int)w.y, true);
    o[0] = a.x * (1.f / S_A); o[1] = a.y * (1.f / S_A); o[2] = b.x * (1.f / S_A); o[3] = b.y * (1.f / S_A); o[4] = c.x * (1.f / S_A); o[5] = c.y * (1.f / S_A); o[6] = d.x * (1.f / S_A); o[7] = d.y * (1.f / S_A);
}
__device__ __forceinline__ void conv_phase(Frame& F) {
    constexpr int C8 = DFF / 8, TB = 32, NTB = M / TB;
    const size_t total = (size_t)C8 * NTB;
    for (size_t idx = (size_t)F.gw * 64 + F.lane; idx < total; idx += (size_t)F.NGW * 64) {
        const int c8 = (int)(idx % C8), tb = (int)(idx / C8), ch = 8 * c8, t0 = tb * TB;
        const int acol = (ch >> 7) * 256 + (ch & 127);
        float wg[3][8], wv[3][8], bg[8], bv[8];
#pragma unroll
        for (int j = 0; j < 3; ++j) { const f32x4 a = *(const GAS f32x4*)(F.cvw + (size_t)j * F2 + ch), b = *(const GAS f32x4*)(F.cvw + (size_t)j * F2 + ch + 4);
            const f32x4 c = *(const GAS f32x4*)(F.cvw + (size_t)j * F2 + DFF + ch), d = *(const GAS f32x4*)(F.cvw + (size_t)j * F2 + DFF + ch + 4);
#pragma unroll
            for (int e = 0; e < 4; ++e) { wg[j][e] = a[e]; wg[j][4 + e] = b[e]; wv[j][e] = c[e]; wv[j][4 + e] = d[e]; } }
        { const f32x4 a = *(const GAS f32x4*)(F.cvb + ch), b = *(const GAS f32x4*)(F.cvb + ch + 4), c = *(const GAS f32x4*)(F.cvb + DFF + ch), d = *(const GAS f32x4*)(F.cvb + DFF + ch + 4);
#pragma unroll
          for (int e = 0; e < 4; ++e) { bg[e] = a[e]; bg[4 + e] = b[e]; bv[e] = c[e]; bv[4 + e] = d[e]; } }
        float g1[8], g2[8], v1[8], v2[8];
        const bool first = (t0 & (SEQ - 1)) == 0;
        const unsigned char* ap = (const unsigned char*)F.A + (size_t)t0 * F2 + acol;
        if (first) {
#pragma unroll
            for (int e = 0; e < 8; ++e) { g1[e] = g2[e] = v1[e] = v2[e] = 0.f; }
        } else {
            const v2u ga = *(const GAS v2u*)(ap - F2), gb = *(const GAS v2u*)(ap - 2 * (size_t)F2), va = *(const GAS v2u*)(ap - F2 + 128), vb = *(const GAS v2u*)(ap - 2 * (size_t)F2 + 128);
            unpack8_fp8(ga, g1); unpack8_fp8(gb, g2); unpack8_fp8(va, v1); unpack8_fp8(vb, v2);
        }
#pragma unroll 4
        for (int i = 0; i < TB; ++i) {
            const v2u gw = *(const GAS v2u*)(ap + (size_t)i * F2), vw = *(const GAS v2u*)(ap + (size_t)i * F2 + 128);
            float g0[8], v0[8], y[8];
            unpack8_fp8(gw, g0); unpack8_fp8(vw, v0);
#pragma unroll
            for (int e = 0; e < 8; ++e) { const float gt = bg[e] + wg[0][e] * g2[e] + wg[1][e] * g1[e] + wg[2][e] * g0[e];
                const float vl = bv[e] + wv[0][e] * v2[e] + wv[1][e] * v1[e] + wv[2][e] * v0[e];
                y[e] = gt * pg8::sigmoidf_(gt) * vl; g2[e] = g1[e]; g1[e] = g0[e]; v2[e] = v1[e]; v1[e] = v0[e]; }
            v2u o; o.x = pk4_fp8(y[0] * S_ACT, y[1] * S_ACT, y[2] * S_ACT, y[3] * S_ACT); o.y = pk4_fp8(y[4] * S_ACT, y[5] * S_ACT, y[6] * S_ACT, y[7] * S_ACT);
            *(GAS v2u*)((unsigned char*)F.ACT + (size_t)(t0 + i) * DFF + ch) = o;
        }
    }
}

constexpr int N_PHASES = 12;
struct Args { const float* in[19]; float* out; unsigned char* ws; int ph_lo, ph_hi, li, pad; };
__global__ void __launch_bounds__(NWAVES * 64, 2) mega_fwd(Args args) {
    extern __shared__ __attribute__((aligned(16))) unsigned char lds[];
    Frame F;
    F.lds = (LAS unsigned char*)lds;
    F.MISC = (volatile LAS unsigned*)(F.lds + MISC_OFF);
    F.tid = threadIdx.x; F.lane = F.tid & 63; F.wave = __builtin_amdgcn_readfirstlane(F.tid >> 6);
    F.G = gridDim.x; F.gw = blockIdx.x * NWAVES + F.wave; F.NGW = F.G * NWAVES;
    unsigned char* ws = args.ws;
    F.ctl = (gu32*)(ws + WS_CTL);
    F.x = args.in[0]; F.c = args.in[1]; F.ada_w = args.in[2]; F.ada_b = args.in[3]; F.n1g = args.in[4]; F.w_in = args.in[5]; F.qng = args.in[6]; F.kng = args.in[7];
    F.sgg = args.in[8]; F.sgw = args.in[9]; F.sgb = args.in[10]; F.w_a = args.in[11]; F.w_b = args.in[12]; F.w_out = args.in[13]; F.n2g = args.in[14]; F.w_up = args.in[15];
    F.cvw = args.in[16]; F.cvb = args.in[17]; F.w_dn = args.in[18]; F.out = args.out;
    F.MOD = (float*)(ws + WS_MOD); F.PART = (float*)(ws + WS_TMP);   F.WIN = (bf16*)(ws + WS_WIN); F.WINB = (bf16*)(ws + WS_WINB); F.H8A = ws + WS_X1;   F.WA = (bf16*)(ws + WS_WA); F.WB = (bf16*)(ws + WS_WB); F.WOUT = (bf16*)(ws + WS_WOUT); F.WUP = (bf16*)(ws + WS_WUP); F.WDN = (bf16*)(ws + WS_WDN);
    F.H = (bf16*)(ws + WS_H); F.X1 = (float*)(ws + WS_X1); F.PROJ = (bf16*)(ws + WS_PROJ); F.MASK = (unsigned*)(ws + WS_MASK); F.RS = (float*)(ws + WS_RS); F.SWT = (float*)(ws + WS_SWT);
    F.VT = (bf16*)(ws + WS_VT); F.YA = (bf16*)(ws + WS_YA); F.YB = (bf16*)(ws + WS_YB); F.MRG = (bf16*)(ws + WS_MRG); F.TMP = (float*)(ws + WS_TMP); F.A = (bf16*)(ws + WS_A); F.ACT = (bf16*)(ws + WS_ACT);
    for (int u = F.tid; u < (LDS_BYTES - LDSCTL_OFF) / 4; u += NWAVES * 64) ((LAS unsigned*)(F.lds + LDSCTL_OFF))[u] = 0u;
    __syncthreads();
    XcdBarrier bar; bar.bar = (unsigned*)(F.ctl + CW_BAR); bar.x = 0; bar.st = nullptr;
    if (MK_N_LAUNCHES == 1) bar = xcd_barrier_post((unsigned*)(F.ctl + CW_BAR), F.MISC + 8);
    const int lo = args.ph_lo, hi = args.ph_hi;
#define IN(k) (lo <= (k) && (k) < hi)
#define SEAM(k) do { if (IN(k) && IN((k) + 1)) xcd_barrier(bar); } while (0)

#define REP(k) if ((PROBE_MASK >> (k)) & 1) for (int _rep = 0; _rep < 1; ++_rep)
    if (IN(0)) { p0_prologue(F); REP(0) { xcd_barrier(bar); p0_prologue(F, false); } } SEAM(0);
    if (IN(1)) { mod_reduce(F); } SEAM(1);
    if (IN(2)) { norm_rows<2>(F, F.x, F.n1g, 0, DM, F.H, F.H8A); REP(2) { xcd_barrier(bar); norm_rows<2>(F, F.x, F.n1g, 0, DM, F.H, F.H8A); } } SEAM(2);
    if (IN(3)) {
        { pg8::Gemm g{F.H, F.WINB, M, PNP, DM, DM, DM}; pg8::MixOrder S{0, F.G, (int)blockIdx.x}; EpiProj E{F.PROJ, 1.0f};
          pg8::gemm_phase<EpiProj, pg8::MixOrder, true, 2>(F.lds + RING_OFF, g, S, E); }
        VM_WAIT(); __syncthreads();
        { pg8::Gemm g{(const bf16*)F.H8A, F.WIN, M, PNP, DM, DM, DM}; pg8::MixOrder S{1, F.G, (int)blockIdx.x}; EpiProj E{F.PROJ, 1.0f / (S_H2 * 1024.f)};
          pg8::gemm_phase<EpiProj, pg8::MixOrder, true, 1>(F.lds + RING_OFF, g, S, E); }
    } SEAM(3);
    if (IN(4)) {
        for (int it = blockIdx.x; it < 512; it += F.G) { const int b = it >> 7, j = it & 127; idx_block(F, b, j); idx_block(F, b, 255 - j); }
        for (int row = F.gw; row < M; row += F.NGW) qknorm_row(F, row);
        for (int it = F.gw; it < BATCH * NKV * 2 * 256; it += F.NGW) vt_item(F, it);
        REP(4) { xcd_barrier(bar); for (int it = blockIdx.x; it < 512; it += F.G) { const int b = it >> 7, j = it & 127; idx_block(F, b, j); idx_block(F, b, 255 - j); } }
        REP(13) { xcd_barrier(bar); for (int it = F.gw; it < BATCH * NKV * 2 * 256; it += F.NGW) vt_item(F, it); }
    } SEAM(4);
    if (IN(5)) {
        { const float sb = attn_score_bound(F); for (int p = blockIdx.x; p < 256; p += F.G) { const int bg = p >> 4, j = p & 15; attn_block(F, bg >> 2, bg & 3, j, sb); attn_block(F, bg >> 2, bg & 3, 31 - j, sb); } }
        REP(5) { xcd_barrier(bar); { const float sb = attn_score_bound(F); for (int p = blockIdx.x; p < 256; p += F.G) { const int bg = p >> 4, j = p & 15; attn_block(F, bg >> 2, bg & 3, j, sb); attn_block(F, bg >> 2, bg & 3, 31 - j, sb); } } }
        for (int u = blockIdx.x; u < 512; u += F.G) sgu_unit(F, u);
        __syncthreads();
        if (F.G == 256) { const int pq = blockIdx.x, g_ = (pq >> 4) & 3, li = (pq >> 6) * 16 + (pq & 15);
            if (g_ < 2) { const int cnt = g_ == 0 ? 100 : 80, first = g_ == 0 ? li * 100 : 64 * 100 + li * 80;
                tr_run<2>(F, first + F.wave, first + cnt, NWAVES, (LAS float*)(F.lds + RING_OFF + F.wave * 16384)); }
            __syncthreads(); }
        REP(14) { xcd_barrier(bar); for (int u = blockIdx.x; u < 512; u += F.G) sgu_unit(F, u); __syncthreads(); }
    } SEAM(5);
    if (IN(6)) { pg8::Gemm g{F.YA, F.WA, M, DM, 2 * ATTW, 2 * ATTW, 2 * ATTW}; pg8::StaticOrder S; S.init(M, DM, F.G, (int)blockIdx.x);
        EpiMerge E{F.PROJ, (unsigned char*)F.MRG, 1.0f / (S_YB * S_WB), (S_YB * S_WB) / (S_YA * S_WA)};
        pg8::gemm_phase<EpiMerge, pg8::StaticOrder, true, 1>(F.lds + RING_OFF, g, S, E);
        REP(6) { xcd_barrier(bar); pg8::gemm_phase<EpiMerge, pg8::StaticOrder, true, 1>(F.lds + RING_OFF, g, S, E); } } SEAM(6);
    if (IN(7)) { pg8::Gemm g{F.MRG, F.WOUT, M, DM, DM, DM, DM}; pg8::StaticOrder S; S.init(M, DM, F.G, (int)blockIdx.x); EpiResid<false, true> E{F.x, F.MOD + 2 * DM, F.X1, 1.0f / (S_MRG * S_WOUT)};
        pg8::gemm_phase<EpiResid<false, true>, pg8::StaticOrder, true, 1>(F.lds + RING_OFF, g, S, E);
        REP(7) { xcd_barrier(bar); pg8::gemm_phase<EpiResid<false, true>, pg8::StaticOrder, true, 1>(F.lds + RING_OFF, g, S, E); } } SEAM(7);
    if (IN(8)) { norm_rows<1, true>(F, F.X1, F.n2g, 3 * DM, 4 * DM, F.H); REP(8) { xcd_barrier(bar); norm_rows<1, true>(F, F.X1, F.n2g, 3 * DM, 4 * DM, F.H); } } SEAM(8);
    if (IN(9)) { pg8::Gemm g{F.H, F.WUP, M, F2, DM, DM, DM}; pg8::StaticOrder S; S.init(M, F2, F.G, (int)blockIdx.x); EpiPlain E{(unsigned char*)F.A, F2, S_A / (S_H2 * S_WUP)};
        pg8::gemm_phase<EpiPlain, pg8::StaticOrder, true, 1>(F.lds + RING_OFF, g, S, E);
        if (F.G == 256 && blockIdx.x >= 192) { const int first = ((int)blockIdx.x - 192) * 56;
            tr_run<3>(F, first + F.wave, first + 56, NWAVES, (LAS float*)(F.lds + RING_OFF + F.wave * 16384)); }
        REP(9) { xcd_barrier(bar); pg8::gemm_phase<EpiPlain, pg8::StaticOrder, true, 1>(F.lds + RING_OFF, g, S, E); } } SEAM(9);
    if (IN(10)) { conv_phase(F); REP(10) { xcd_barrier(bar); conv_phase(F); } } SEAM(10);
    if (IN(11)) { pg8::Gemm g{F.ACT, F.WDN, M, DM, DFF, DFF, DFF}; pg8::StaticOrder S; S.init(M, DM, F.G, (int)blockIdx.x); EpiResid<true, false> E{F.X1, F.MOD + 5 * DM, F.out, 1.0f / (S_ACT * S_WDN)};
        pg8::gemm_phase<EpiResid<true, false>, pg8::StaticOrder, true, 1>(F.lds + RING_OFF, g, S, E);
        REP(11) { xcd_barrier(bar); pg8::gemm_phase<EpiResid<true, false>, pg8::StaticOrder, true, 1>(F.lds + RING_OFF, g, S, E); } }
#undef REP
#undef IN
#undef SEAM
}

extern "C" void kernel_launch(void* const* d_in, const int* in_sizes, int n_in, void* d_out, int out_size, void* d_ws, size_t ws_size, hipStream_t stream) {
    static int grid = 0;
    if (grid == 0) {
        if (n_in != 19 || in_sizes[0] != M * DM || out_size != M * DM || ws_size < WS_END) { fprintf(stderr, "kernel_launch: unexpected shapes (n_in %d, in0 %d, out %d, ws %zu < %zu); nothing launched\n", n_in, n_in > 0 ? in_sizes[0] : -1, out_size, ws_size, (size_t)WS_END); grid = -1; return; }
        int dev = 0, cus = 0, per_cu = 0;
        if (hipGetDevice(&dev) != hipSuccess || hipDeviceGetAttribute(&cus, hipDeviceAttributeMultiprocessorCount, dev) != hipSuccess) { fprintf(stderr, "kernel_launch: device query failed\n"); grid = -1; return; }
        if (hipFuncSetAttribute((const void*)mega_fwd, hipFuncAttributeMaxDynamicSharedMemorySize, LDS_BYTES) != hipSuccess) { fprintf(stderr, "kernel_launch: hipFuncSetAttribute failed\n"); grid = -1; return; }
        if (hipOccupancyMaxActiveBlocksPerMultiprocessor(&per_cu, (const void*)mega_fwd, NWAVES * 64, LDS_BYTES) != hipSuccess || per_cu < 1) { fprintf(stderr, "kernel_launch: occupancy query reports %d blocks per CU\n", per_cu); }
        (void)hipGetLastError();
        grid = cus;
    }
    if (grid < 0) return;
    if (hipMemsetAsync((char*)d_ws + WS_CTL, 0, CTL_ZERO_BYTES, stream) != hipSuccess) { fprintf(stderr, "kernel_launch: memset failed\n"); return; }
    Args a{};
    for (int i = 0; i < 19; ++i) a.in[i] = (const float*)d_in[i];
    a.out = (float*)d_out; a.ws = (unsigned char*)d_ws; a.pad = 0;
    for (int li = 0; li < MK_N_LAUNCHES; ++li) {
        if (MK_N_LAUNCHES == 1) { a.ph_lo = 0; a.ph_hi = N_PHASES; } else { a.ph_lo = li; a.ph_hi = li + 1; }
        a.li = li;
        hipLaunchKernelGGL(mega_fwd, dim3(grid), dim3(NWAVES * 64), LDS_BYTES, stream, a);
        const hipError_t le = hipPeekAtLastError();
        if (le != hipSuccess) { fprintf(stderr, "kernel_launch: launch %d failed: %s\n", li, hipGetErrorName(le)); break; }
    }
}
```

```cpp
#include <hip/hip_runtime.h>
#include <cstdio>
#include <cstdint>

#ifndef MK_N_LAUNCHES
#define MK_N_LAUNCHES 1
#endif
#ifndef PROBE_MASK
#define PROBE_MASK 0x0
#endif

namespace pg8 {
#define PG8_LAS __attribute__((address_space(3)))
typedef unsigned short bf16_t;
typedef short bf16x8 __attribute__((ext_vector_type(8)));
typedef float f32x4 __attribute__((ext_vector_type(4)));
typedef float f32x2 __attribute__((ext_vector_type(2)));
typedef unsigned u32x4 __attribute__((ext_vector_type(4)));
typedef unsigned u32x2 __attribute__((ext_vector_type(2)));
constexpr int BM = 256, BK = 64, HALF = 128, HTB = HALF * BK * 2, STAGE_BYTES = 8 * HTB, NXCD = 8, WGM = 8;

__host__ __device__ __forceinline__ int lds_byte(int r, int c) { const int rr = r & 7, ch = c >> 3; return (r >> 3) * 1024 + (16 * ((rr >> 2) + 2 * (ch >> 2)) + 4 * (rr & 3) + ((ch ^ (2 * (rr >> 2))) & 3)) * 16; }
__host__ __device__ __forceinline__ void stage_rc(int b, int& R, int& C) { const int pc = b >> 10, p = (b & 1023) >> 4, q = p >> 4, bb = p & 15, rr = (q & 1) * 4 + (bb >> 2), ch = (q >> 1) * 4 + ((bb & 3) ^ (2 * (q & 1))); R = pc * 8 + rr; C = ch * 8; }
__host__ __device__ __forceinline__ int perm32(int rho) { const int n = rho >> 4, i = rho & 15; return 8 * (i >> 2) + 4 * n + (i & 3); }

struct Unit { int pm, pn; };
struct Gemm { const bf16_t* A; const bf16_t* Bt; int M, N, K, lda, ldb; };

struct StaticOrder {
    int nM, nN, nwg, G, c;
    __host__ __device__ void init(int M, int N, int G_, int c_) { nM = M / BM; nN = N / BM; nwg = nM * nN; G = G_; c = c_; }
    __host__ __device__ bool next(int i, Unit& u) const {
        const long L = (long)i * G + c; if (L >= nwg) return false;
        int wgid = (int)L; { const int q = nwg / NXCD, r = nwg % NXCD, xcd = wgid % NXCD, off = wgid / NXCD; wgid = (xcd < r ? xcd * (q + 1) : r * (q + 1) + (xcd - r) * q) + off; }
        const int nig = WGM * nN, gid = wgid / nig, fm = gid * WGM, gsz = (nM - fm) < WGM ? (nM - fm) : WGM;
        u.pm = fm + ((wgid % nig) % gsz); u.pn = (wgid % nig) / gsz; return true;
    }
    __device__ __forceinline__ void a_ready(const Unit&) const {}
    __device__ __forceinline__ void done(const Unit&) const {}
};
struct MixOrder {
    int fp8, G, c;
    __host__ __device__ static void map(int L, int nwg, int nN, Unit& u) {
        int wgid = L; { const int q = nwg / NXCD, r = nwg % NXCD, xcd = wgid % NXCD, off = wgid / NXCD; wgid = (xcd < r ? xcd * (q + 1) : r * (q + 1) + (xcd - r) * q) + off; }
        const int nig = WGM * nN; u.pm = (wgid / nig) * WGM + ((wgid % nig) % WGM); u.pn = (wgid % nig) / WGM;
    }
    __host__ __device__ bool next(int i, Unit& u) const {
        int L;
        if (!fp8) { L = i * G + c; if (L >= 288) return false; map(L, 288, 9, u); u.pn = u.pn < 8 ? 12 + u.pn : 68; return true; }
        if (G == 256) { if (c >= 32) { if (i >= 8) return false; L = i * 224 + (c - 32); } else { if (i >= 4) return false; L = 1792 + 4 * c + i; } }
        else { L = i * G + c; if (L >= 1920) return false; }
        map(L, 1920, 60, u); u.pn = u.pn < 12 ? u.pn : u.pn + 8; return true;
    }
    __device__ __forceinline__ void a_ready(const Unit&) const {}
    __device__ __forceinline__ void done(const Unit&) const {}
};

__device__ __forceinline__ unsigned cvt_pk_bf16(float lo, float hi) { unsigned r; asm volatile("v_cvt_pk_bf16_f32 %0, %1, %2" : "=v"(r) : "v"(lo), "v"(hi)); return r; }
__device__ __forceinline__ f32x2 gelu_pk(f32x2 v) {
    const f32x2 av = __builtin_elementwise_abs(v), d = av * 0.2316418882f + 1.0f;
    f32x2 t; t.x = __builtin_amdgcn_rcpf(d.x); t.y = __builtin_amdgcn_rcpf(d.y);
    f32x2 q = t * 0.5307027145f + (-0.7265760135f); q = q * t + 0.7107068705f; q = q * t + (-0.142248368f); q = q * t + 0.127414796f; q = q * t;
    const f32x2 s = (v * v) * (-0.72134752044f);
    f32x2 e; e.x = __builtin_amdgcn_exp2f(s.x); e.y = __builtin_amdgcn_exp2f(s.y);
    const f32x2 m = v * (q * e), r = v - m;
    f32x2 o; o.x = v.x < 0.f ? m.x : r.x; o.y = v.y < 0.f ? m.y : r.y; return o;
}
__device__ __forceinline__ float sigmoidf_(float x) { return __builtin_amdgcn_rcpf(1.0f + __builtin_amdgcn_exp2f(-1.4426950408889634f * x)); }
__device__ __forceinline__ float bflo(unsigned w) { return __builtin_bit_cast(float, w << 16); }
__device__ __forceinline__ float bfhi(unsigned w) { return __builtin_bit_cast(float, w & 0xffff0000u); }

typedef int i32x8 __attribute__((ext_vector_type(8)));
typedef int i32x4 __attribute__((ext_vector_type(4)));
template <class Epi, class Sched, bool ALIGN_EPI, int ES = 2>
__device__ __forceinline__ void gemm_phase(PG8_LAS unsigned char* lds, const Gemm g, const Sched& S, const Epi& E) {
    const int tid = threadIdx.x, wid = __builtin_amdgcn_readfirstlane(tid >> 6), lane = tid & 63, wr = wid >> 2, wc = wid & 3, fr = lane & 15, fq = lane >> 4;
    const int K = g.K, nt = K * ES / (BK * 2);
    unsigned voffA[2], voffB[2];
#pragma unroll
    for (int i = 0; i < 2; ++i) { int R, C; stage_rc(tid * 16 + i * 8192, R, C); const int Rb = Epi::PERM ? ((R & ~31) + perm32(R & 31)) : R;
        voffA[i] = (unsigned)(R * g.lda) * (unsigned)ES + (unsigned)C * 2u; voffB[i] = (unsigned)(Rb * g.ldb) * (unsigned)ES + (unsigned)C * 2u; }
    const size_t kstep = (size_t)(BK * 2);
    const size_t hstepA = (size_t)HALF * g.lda * ES, hstepB = (size_t)HALF * g.ldb * ES;
    const size_t tstepA = 2 * hstepA, tstepB = 2 * hstepB;
    const unsigned ldsw = (unsigned)wid * 1024u;
    const int aoff = lds_byte(wr * 64 + fr, fq * 8), boff = lds_byte(wc * 32 + fr, fq * 8);
#define PG8_SA(b, h) (((b) * 2 + (h)) * HTB)
#define PG8_SB(b, h) ((4 + (b) * 2 + (h)) * HTB)
#define PG8_STAGE(bufoff, gbase, voff) do { _Pragma("unroll") for (int _i = 0; _i < 2; ++_i) \
        __builtin_amdgcn_global_load_lds((const unsigned*)((const char*)(gbase) + (voff)[_i]), (PG8_LAS unsigned*)(lds + (bufoff) + ldsw + _i * 8192), 16, 0, 0); } while (0)
#define PG8_CAT(x, y) __builtin_shufflevector(x, y, 0, 1, 2, 3, 4, 5, 6, 7)
#define PG8_LO(v) __builtin_bit_cast(bf16x8, __builtin_shufflevector(v, v, 0, 1, 2, 3))
#define PG8_HI(v) __builtin_bit_cast(bf16x8, __builtin_shufflevector(v, v, 4, 5, 6, 7))
#define PG8_LDA(dst, b, h) do { _Pragma("unroll") for (int m = 0; m < 4; ++m) { const i32x4 _l = *(const PG8_LAS i32x4*)(lds + PG8_SA(b, h) + aoff + m * 2048), _h = *(const PG8_LAS i32x4*)(lds + PG8_SA(b, h) + aoff + m * 2048 + 512); dst[m] = PG8_CAT(_l, _h); } } while (0)
#define PG8_LDB(dst, b, h) do { _Pragma("unroll") for (int n = 0; n < 2; ++n) { const i32x4 _l = *(const PG8_LAS i32x4*)(lds + PG8_SB(b, h) + boff + n * 2048), _h = *(const PG8_LAS i32x4*)(lds + PG8_SB(b, h) + boff + n * 2048 + 512); dst[n] = PG8_CAT(_l, _h); } } while (0)
#define PG8_MMA(ai, bj, At, Bt) do { __builtin_amdgcn_s_setprio(1); _Pragma("unroll") for (int m = 0; m < 4; ++m) _Pragma("unroll") for (int n = 0; n < 2; ++n) { \
        if constexpr (ES == 2) { acc[ai][bj][m][n] = __builtin_amdgcn_mfma_f32_16x16x32_bf16(PG8_LO(Bt[n]), PG8_LO(At[m]), acc[ai][bj][m][n], 0, 0, 0); \
                                 acc[ai][bj][m][n] = __builtin_amdgcn_mfma_f32_16x16x32_bf16(PG8_HI(Bt[n]), PG8_HI(At[m]), acc[ai][bj][m][n], 0, 0, 0); } \
        else asm volatile("v_mfma_f32_16x16x128_f8f6f4 %0, %1, %2, %0" : "+v"(acc[ai][bj][m][n]) : "v"(Bt[n]), "v"(At[m])); } __builtin_amdgcn_s_setprio(0); } while (0)
#define PG8_WAIT_V(n) asm volatile("s_waitcnt vmcnt(" #n ")" ::: "memory")
#define PG8_WAIT_L(n) asm volatile("s_waitcnt lgkmcnt(" #n ")" ::: "memory")
#define PG8_BAR __builtin_amdgcn_s_barrier()
#define PG8_SCHED __builtin_amdgcn_sched_barrier(0)
    Unit cur, nxt; int ui = 0;
    if (!S.next(0, cur)) return;
    f32x4 acc[2][2][4][2];
#pragma unroll
    for (int a = 0; a < 2; ++a)
#pragma unroll
        for (int b = 0; b < 2; ++b)
#pragma unroll
            for (int m = 0; m < 4; ++m)
#pragma unroll
                for (int n = 0; n < 2; ++n) acc[a][b][m][n] = (f32x4){0.f, 0.f, 0.f, 0.f};
    i32x8 At[4], B0[2], B1[2];
    const char* cA = (const char*)g.A + (size_t)cur.pm * tstepA; const char* cB = (const char*)g.Bt + (size_t)cur.pn * tstepB;
    S.a_ready(cur);
    PG8_STAGE(PG8_SB(0, 0), cB, voffB); PG8_STAGE(PG8_SB(0, 1), cB + hstepB, voffB); PG8_STAGE(PG8_SA(0, 0), cA, voffA); PG8_STAGE(PG8_SA(0, 1), cA + hstepA, voffA);
    if (wr == 1) PG8_BAR;
    PG8_WAIT_V(2); PG8_BAR;
    PG8_STAGE(PG8_SB(1, 0), cB + kstep, voffB); PG8_STAGE(PG8_SA(1, 0), cA + kstep, voffA); PG8_STAGE(PG8_SB(1, 1), cB + hstepB + kstep, voffB);
    PG8_WAIT_V(6); PG8_BAR;
    for (;;) {
        const bool has_next = S.next(ui + 1, nxt);
        const char* nA = has_next ? (const char*)g.A + (size_t)nxt.pm * tstepA : cA; const char* nB = has_next ? (const char*)g.Bt + (size_t)nxt.pn * tstepB : cB;
        for (int t = 0; t < nt; t += 2) {
            const bool last = (t == nt - 2);
            const char* a1 = cA + (size_t)(t + 1) * kstep;
            const char* a2 = last ? nA : cA + (size_t)(t + 2) * kstep; const char* b2 = last ? nB : cB + (size_t)(t + 2) * kstep;
            const char* a3 = a2 + kstep; const char* b3 = b2 + kstep;
            if (last && has_next) S.a_ready(nxt);
            if constexpr (Epi::MIDK) { if (t == nt / 2) { if constexpr (ES == 1) asm volatile("s_nop 15\n\ts_nop 15" ::: "memory"); E.mid(acc, cur, wr, wc, fr, fq); } }
            PG8_LDB(B0, 0, 0); PG8_LDB(B1, 0, 1); PG8_SCHED; PG8_LDA(At, 0, 0); PG8_STAGE(PG8_SA(1, 1), a1 + hstepA, voffA);
            PG8_WAIT_V(8); PG8_WAIT_L(0); PG8_BAR; PG8_MMA(0, 0, At, B0); PG8_MMA(0, 1, At, B1); PG8_BAR; PG8_SCHED;
            PG8_LDA(At, 0, 1); PG8_STAGE(PG8_SB(0, 0), b2, voffB); PG8_STAGE(PG8_SB(0, 1), b2 + hstepB, voffB); PG8_STAGE(PG8_SA(0, 0), a2, voffA);
            PG8_WAIT_V(8); PG8_WAIT_L(0); PG8_BAR; PG8_MMA(1, 0, At, B0); PG8_MMA(1, 1, At, B1); PG8_BAR; PG8_SCHED;
            PG8_LDB(B0, 1, 0); PG8_LDB(B1, 1, 1); PG8_SCHED; PG8_LDA(At, 1, 0); PG8_STAGE(PG8_SA(0, 1), a2 + hstepA, voffA);
            PG8_WAIT_V(8); PG8_WAIT_L(0); PG8_BAR; PG8_MMA(0, 0, At, B0); PG8_MMA(0, 1, At, B1); PG8_BAR; PG8_SCHED;
            PG8_LDA(At, 1, 1); PG8_STAGE(PG8_SB(1, 0), b3, voffB); PG8_STAGE(PG8_SB(1, 1), b3 + hstepB, voffB); PG8_STAGE(PG8_SA(1, 0), a3, voffA);
            PG8_WAIT_V(8); PG8_WAIT_L(0); PG8_BAR; PG8_MMA(1, 0, At, B0); PG8_MMA(1, 1, At, B1); PG8_BAR; PG8_SCHED;
        }
        if constexpr (ALIGN_EPI) { if (wr == 0) PG8_BAR; }
        if constexpr (ES == 1) asm volatile("s_nop 15\n\ts_nop 15" ::: "memory");
        E(acc, cur, wr, wc, fr, fq); S.done(cur);
        if (!has_next) break;
#pragma unroll
        for (int a = 0; a < 2; ++a)
#pragma unroll
            for (int b = 0; b < 2; ++b)
#pragma unroll
                for (int m = 0; m < 4; ++m)
#pragma unroll
                    for (int n = 0; n < 2; ++n) acc[a][b][m][n] = (f32x4){0.f, 0.f, 0.f, 0.f};
        cur = nxt; cA = nA; cB = nB; ++ui;
        if constexpr (ALIGN_EPI) { if (wr == 1) PG8_BAR; }
    }
    PG8_WAIT_V(0);
    if constexpr (!ALIGN_EPI) { if (wr == 0) PG8_BAR; }
    PG8_BAR;
#undef PG8_SA
#undef PG8_SB
#undef PG8_STAGE
#undef PG8_LDA
#undef PG8_CAT
#undef PG8_LO
#undef PG8_HI
#undef PG8_LDB
#undef PG8_MMA
#undef PG8_WAIT_V
#undef PG8_WAIT_L
#undef PG8_BAR
#undef PG8_SCHED
}
}

constexpr int NWAVES = 8;
constexpr int BATCH = 4, SEQ = 2048, DM = 4096, M = BATCH * SEQ;
constexpr int NH = 16, HD = 128, NKV = 4, ATTW = 2048, KVW = 512, IH = 32, IDIM = 64, TOPK = 256;
constexpr int GMW = 2048, GMG = 8, GMGW = 256, GMC = 128, DFF = 11008, F2 = 2 * DFF;
constexpr int IN_W = 17504, MODW = 6 * DM;
constexpr float EPS = 1e-6f;
constexpr int PQ = 0, PK = 2048, PV = 2560, PQI = 3072, PGU = 5120, PGV = 7168, PGA = 9216, PGB = 13312, PKI = 17408, PWI = 17472, PNP = 17664;
constexpr int SQ = 0, SK = 2048, SV = 2560, SQI = 3072, SKI = 5120, SWI = 5184, SGU = 5216, SGV = 7264, SGA = 9312, SGB = 13408;

constexpr size_t MiB = 1u << 20;
constexpr size_t WS_CTL = 0, CTL_ZERO_BYTES = 2 * MiB;
constexpr size_t WS_MOD = 1 * MiB;
constexpr size_t WS_WIN = 2 * MiB;
constexpr size_t WS_WA = 140 * MiB, WS_WB = 156 * MiB;
constexpr size_t WS_WOUT = 172 * MiB;
constexpr size_t WS_WUP = 204 * MiB;
constexpr size_t WS_WDN = 376 * MiB;
constexpr size_t WS_H = 462 * MiB;
constexpr size_t WS_X1 = 526 * MiB;
constexpr size_t WS_PROJ = 654 * MiB;
constexpr size_t WS_MASK = 930 * MiB;
constexpr size_t WS_RS = 932 * MiB;
constexpr size_t WS_SWT = 932 * MiB + 65536;
constexpr size_t WS_VT = 933 * MiB;
constexpr size_t WS_YA = 941 * MiB, WS_YB = 973 * MiB;
constexpr size_t WS_MRG = 1005 * MiB;
constexpr size_t WS_TMP = 1069 * MiB;
constexpr size_t WS_A = 654 * MiB;
constexpr size_t WS_ACT = 998 * MiB;
constexpr size_t WS_WINB = 1197 * MiB;
constexpr size_t WS_END = 1336 * MiB;
static_assert(WS_WIN + (size_t)PNP * DM * 2 <= WS_WA && WS_WUP + (size_t)F2 * DM * 2 <= WS_WDN && WS_WDN + (size_t)DM * DFF * 2 <= WS_H, "ws map 1");
static_assert(WS_PROJ + (size_t)M * PNP * 2 <= WS_MASK && WS_A + (size_t)M * F2 * 2 <= WS_ACT && WS_ACT + (size_t)M * DFF * 2 <= WS_END && WS_TMP + (size_t)M * DM * 4 <= WS_END, "ws map 2");
constexpr int CW_TMO = 0, CW_CODE = 1, CW_BAR = 4096;

constexpr int RING_OFF = 0, RING_BYTES = 131072;
constexpr int LDSCTL_OFF = RING_BYTES + 8192, MISC_OFF = LDSCTL_OFF + 320;
constexpr int LDS_BYTES = 147456;
static_assert(MISC_OFF + 128 <= LDS_BYTES, "LDS map");

#define GAS __attribute__((address_space(1)))
#define LAS __attribute__((address_space(3)))
typedef unsigned short bf16;
typedef unsigned v4u __attribute__((ext_vector_type(4)));
typedef unsigned v2u __attribute__((ext_vector_type(2)));
typedef float f32x4 __attribute__((ext_vector_type(4)));
typedef float f32x16 __attribute__((ext_vector_type(16)));
typedef short bf16x8 __attribute__((ext_vector_type(8)));
typedef short bf16x4 __attribute__((ext_vector_type(4)));
typedef GAS unsigned gu32;
#define RLX_AGENT __ATOMIC_RELAXED, __HIP_MEMORY_SCOPE_AGENT
#define LDS_WAIT() asm volatile("s_waitcnt lgkmcnt(0)" ::: "memory")
#define VM_WAIT() asm volatile("s_waitcnt vmcnt(0)" ::: "memory")
__device__ __forceinline__ unsigned f2bf(float f) { unsigned u = __builtin_bit_cast(unsigned, f); return (u + 0x7fffu + ((u >> 16) & 1u)) >> 16; }
__device__ __forceinline__ unsigned pk2(float lo, float hi) { return pg8::cvt_pk_bf16(lo, hi); }
__device__ __forceinline__ float bf2f(bf16 h) { return __builtin_bit_cast(float, (unsigned)h << 16); }
using pg8::bflo; using pg8::bfhi;
constexpr float S_H2 = 16.f, S_WUP = 1024.f, S_ACT = 4.f, S_WDN = 1024.f, S_A = 16.f, S_YA = 16.f, S_YB = 8.f, S_MRG = 16.f, S_WA = 1024.f, S_WB = 1024.f, S_WOUT = 1024.f;
__device__ __forceinline__ float clamp448(float x) { return __builtin_amdgcn_fmed3f(x, -448.f, 448.f); }
__device__ __forceinline__ unsigned pk4_fp8(float a, float b, float c, float d) {
    int w = __builtin_amdgcn_cvt_pk_fp8_f32(clamp448(a), clamp448(b), 0, false);
    w = __builtin_amdgcn_cvt_pk_fp8_f32(clamp448(c), clamp448(d), w, true);
    return (unsigned)w;
}

#define XB_TMO      128
#define XB_XCNT(j)  (256  + 64 * (j))
#define XB_XSUB(j)  (1280 + 64 * (j))
#define XB_XGEN(j)  (2304 + 64 * (j))
#define XB_TOP      3328
#define XB_TOPGEN   3392
#define XCD_BAR_WORDS 3456
#define XB_SPIN_CAP (1u << 18)
__device__ __forceinline__ unsigned xb_ld(unsigned* p)              { return __hip_atomic_load(p, __ATOMIC_RELAXED, __HIP_MEMORY_SCOPE_AGENT); }
__device__ __forceinline__ unsigned xb_add(unsigned* p, unsigned v) { return __hip_atomic_fetch_add(p, v, __ATOMIC_RELAXED, __HIP_MEMORY_SCOPE_AGENT); }
__device__ __forceinline__ unsigned xb_xcc_id() { return (unsigned)__builtin_amdgcn_s_getreg((3 << 11) | 20) & 0xFu; }
#define XB_SPIN(cond, bar) do { unsigned _sp = 0; while (cond) { __builtin_amdgcn_s_sleep(1); \
    if ((++_sp & 255u) == 0u) { if (xb_ld(&(bar)[XB_TMO])) break; if (_sp > XB_SPIN_CAP) { atomicAdd(&(bar)[XB_TMO], 1u); break; } } } } while (0)
struct XcdBarrier { unsigned* bar; unsigned x; volatile LAS unsigned* st; };
__device__ __forceinline__ XcdBarrier xcd_barrier_post(unsigned* bar, volatile LAS unsigned* st) {
    XcdBarrier b; b.bar = bar; b.x = xb_xcc_id(); b.st = st;
    if (threadIdx.x == 0) (void)xb_add(&bar[XB_XCNT(b.x)], 1u);
    return b;
}
__device__ __forceinline__ void xcd_barrier_complete(unsigned* bar, unsigned x, unsigned& nloc, unsigned& nx) {
    const unsigned G = gridDim.x * gridDim.y * gridDim.z;
    unsigned sum, cnt, mine, sp = 0u;
    for (;;) {
        sum = 0u; cnt = 0u; mine = 0u;
#pragma unroll
        for (unsigned j = 0; j < 16; ++j) { const unsigned c = xb_ld(&bar[XB_XCNT(j)]); sum += c; cnt += (c > 0u) ? 1u : 0u; mine = (j == x) ? c : mine; }
        if (sum == G) break;
        __builtin_amdgcn_s_sleep(1);
        if ((++sp & 255u) == 0u) { if (xb_ld(&bar[XB_TMO])) break; if (sp > XB_SPIN_CAP) { atomicAdd(&bar[XB_TMO], 1u); break; } }
    }
    nloc = mine > 0u ? mine : 1u; nx = cnt > 0u ? cnt : 1u;
}
__device__ __forceinline__ void xcd_barrier(const XcdBarrier& b) {
    asm volatile("s_waitcnt vmcnt(0)" ::: "memory");
    __syncthreads();
    if (threadIdx.x == 0) {
        unsigned* bar = b.bar;
        __builtin_amdgcn_s_waitcnt(0);
        unsigned nloc = b.st[0], nx = b.st[1];
        if (nloc == 0u) { xcd_barrier_complete(bar, b.x, nloc, nx); b.st[0] = nloc; b.st[1] = nx; }
        const unsigned old = xb_add(&bar[XB_XSUB(b.x)], 1u);
        const unsigned gen = old / nloc;
        if (old + 1u == (gen + 1u) * nloc) {
            __builtin_amdgcn_fence(__ATOMIC_RELEASE, "agent");
            asm volatile("s_waitcnt vmcnt(0)" ::: "memory");
            const unsigned og = xb_add(&bar[XB_TOP], 1u);
            const unsigned tg = og / nx;
            if (og + 1u == (tg + 1u) * nx) xb_add(&bar[XB_TOPGEN], 1u);
            else XB_SPIN(xb_ld(&bar[XB_TOPGEN]) == tg, bar);
            __builtin_amdgcn_fence(__ATOMIC_ACQUIRE, "agent");
            xb_add(&bar[XB_XGEN(b.x)], 1u);
            asm volatile("s_waitcnt vmcnt(0)" ::: "memory");
        } else {
            XB_SPIN(xb_ld(&bar[XB_XGEN(b.x)]) == gen, bar);
            __builtin_amdgcn_fence(__ATOMIC_ACQUIRE, "agent");
            asm volatile("s_waitcnt vmcnt(0)" ::: "memory");
        }
    }
    __syncthreads();
}

struct Frame {
    LAS unsigned char* lds;
    volatile LAS unsigned* MISC;
    gu32* ctl;
    int tid, lane, wave, G, gw, NGW;
    const float *x, *c, *ada_w, *ada_b, *n1g, *w_in, *qng, *kng, *sgg, *sgw, *sgb, *w_a, *w_b, *w_out, *n2g, *w_up, *cvw, *cvb, *w_dn;
    float* out;
    float *MOD, *PART; bf16 *WINB; unsigned char* H8A; bf16 *WIN, *WA, *WB, *WOUT, *WUP, *WDN, *H, *PROJ, *VT, *YA, *YB, *MRG, *A, *ACT; float *X1, *TMP, *RS, *SWT; unsigned* MASK;
};
__device__ __forceinline__ void xor32_pair(float x, float& lo, float& hi) {
    float a = x, b = x; asm volatile("s_nop 1\n\tv_permlane32_swap_b32 %0, %1" : "+v"(a), "+v"(b)); lo = a; hi = b; }
__device__ __forceinline__ float xor32_sum(float x) { float lo, hi; xor32_pair(x, lo, hi); return lo + hi; }
__device__ __forceinline__ float xor32_max(float x) { float lo, hi; xor32_pair(x, lo, hi); return fmaxf(lo, hi); }
__device__ __forceinline__ float wave_sum(float v) {
#pragma unroll
    for (int o = 1; o < 32; o <<= 1) v += __shfl_xor(v, o);
    v = xor32_sum(v);
    return v;
}

__device__ __forceinline__ int win_dst_row(int n) {
    if (n < SKI) return n;
    if (n < SWI) return PKI + (n - SKI);
    if (n < SGU) return PWI + (n - SWI);
    return PGU + (n - SGU);
}
__device__ __forceinline__ void gemv_item(Frame& F, int item) {
    const int nb = item % 96, ks = item / 96, n0 = nb * 256 + 4 * F.lane, k0 = ks * 64;
    float cs[4];
#pragma unroll
    for (int b = 0; b < 4; ++b) { const float cv = F.c[b * DM + k0 + F.lane]; cs[b] = cv * pg8::sigmoidf_(cv); }
    f32x4 acc[4];
#pragma unroll
    for (int b = 0; b < 4; ++b) acc[b] = (f32x4){0.f, 0.f, 0.f, 0.f};
    const float* wp = F.ada_w + (size_t)k0 * MODW + n0;
#pragma unroll 16
    for (int k = 0; k < 64; ++k) { const f32x4 w = *(const GAS f32x4*)(wp + (size_t)k * MODW);
#pragma unroll
        for (int b = 0; b < 4; ++b) { const float s = __builtin_bit_cast(float, __builtin_amdgcn_readlane(__builtin_bit_cast(int, cs[b]), k)); acc[b] += w * s; } }
#pragma unroll
    for (int b = 0; b < 4; ++b) *(GAS f32x4*)(F.PART + (size_t)(ks * 4 + b) * MODW + n0) = acc[b];
}
__device__ __forceinline__ void mod_reduce(Frame& F) {
    for (int i = F.gw * 64 + F.lane; i < 4 * (MODW / 4); i += F.NGW * 64) { const int b = i / (MODW / 4), n0 = 4 * (i % (MODW / 4));
        f32x4 a = *(const GAS f32x4*)(F.ada_b + n0);
#pragma unroll 16
        for (int ks = 0; ks < 64; ++ks) a += *(const GAS f32x4*)(F.PART + (size_t)(ks * 4 + b) * MODW + n0);
        *(GAS f32x4*)(F.MOD + b * MODW + n0) = a; }
}
struct TrItem { const float* src; unsigned char* d8; bf16* db; int Nsrc, ldk, drow0, k0; float scale; };
__device__ __forceinline__ void tr_decode(Frame& F, int r, TrItem& t) {
    constexpr int P_IN = (DM / 128) * (IN_W / 32), P_A = (ATTW / 128) * (DM / 32), P_B = (GMW / 128) * (DM / 32), P_O = (DM / 128) * (DM / 32), P_UP = (DM / 128) * (F2 / 32);
    const float* W; int Nsrc, nblk, ldk, drow; unsigned char* d8; bf16* db = nullptr; float sc; bool up = false, in = false;
    if (r < P_IN) { W = F.w_in; Nsrc = IN_W; nblk = IN_W / 32; d8 = (unsigned char*)F.WIN; ldk = DM; sc = 1024.f; in = true; }
    else if ((r -= P_IN) < P_A) { W = F.w_a; Nsrc = DM; nblk = DM / 32; d8 = (unsigned char*)F.WA; ldk = 2 * ATTW; sc = S_WA; }
    else if ((r -= P_A) < P_B) { W = F.w_b; Nsrc = DM; nblk = DM / 32; d8 = (unsigned char*)F.WA + ATTW; ldk = 2 * ATTW; sc = S_WB; }
    else if ((r -= P_B) < P_O) { W = F.w_out; Nsrc = DM; nblk = DM / 32; d8 = (unsigned char*)F.WOUT; ldk = DM; sc = S_WOUT; }
    else if ((r -= P_O) < P_UP) { W = F.w_up; Nsrc = F2; nblk = F2 / 32; d8 = (unsigned char*)F.WUP; ldk = DM; sc = S_WUP; up = true; }
    else { r -= P_UP; W = F.w_dn; Nsrc = DM; nblk = DM / 32; d8 = (unsigned char*)F.WDN; ldk = DFF; sc = S_WDN; }
    const int kb = r / nblk, n = 32 * (r % nblk);
    drow = n;
    if (in) { drow = win_dst_row(n); if (n >= SQI && n < SGU) db = F.WINB; }
    if (up) { const int ch = n < DFF ? n : n - DFF; drow = (ch >> 7) * 256 + (ch & 127) + (n < DFF ? 0 : 128); }
    t.src = W + (size_t)(128 * kb) * Nsrc + n; t.d8 = d8; t.db = db; t.Nsrc = Nsrc; t.ldk = ldk; t.drow0 = drow; t.k0 = 128 * kb; t.scale = sc;
}
__device__ __forceinline__ void tr_load(const TrItem& t, int half, f32x4 (&v)[8], int lane) {
    const float* p = t.src + (size_t)(64 * half + (lane >> 3)) * t.Nsrc + 4 * (lane & 7);
#pragma unroll
    for (int i = 0; i < 8; ++i) v[i] = *(const GAS f32x4*)(p + (size_t)(8 * i) * t.Nsrc);
}
__device__ __forceinline__ void tr_finish(const TrItem& t, int half, const f32x4 (&v)[8], LAS float* scr, int lane) {
#pragma unroll
    for (int i = 0; i < 8; ++i) { LAS float* s = scr + (8 * i + (lane >> 3)) * 33 + 4 * (lane & 7); s[0] = v[i].x; s[1] = v[i].y; s[2] = v[i].z; s[3] = v[i].w; }
    LDS_WAIT(); asm volatile("" ::: "memory");
    const int c = lane & 7, kcol = t.k0 + 64 * half + 8 * c; const float sc = t.scale;
#pragma unroll
    for (int j = 0; j < 4; ++j) { const int n = (lane >> 3) + 8 * j; const LAS float* s = scr + (8 * c) * 33 + n;
        const float e0 = s[0 * 33], e1 = s[1 * 33], e2 = s[2 * 33], e3 = s[3 * 33], e4 = s[4 * 33], e5 = s[5 * 33], e6 = s[6 * 33], e7 = s[7 * 33];
        v2u o; o.x = pk4_fp8(e0 * sc, e1 * sc, e2 * sc, e3 * sc); o.y = pk4_fp8(e4 * sc, e5 * sc, e6 * sc, e7 * sc);
        *(GAS v2u*)(t.d8 + (size_t)(t.drow0 + n) * t.ldk + kcol) = o;
        if (t.db) { v4u ob; ob.x = pk2(e0, e1); ob.y = pk2(e2, e3); ob.z = pk2(e4, e5); ob.w = pk2(e6, e7); *(GAS v4u*)(t.db + (size_t)(t.drow0 + n) * t.ldk + kcol) = ob; } }
    LDS_WAIT(); asm volatile("" ::: "memory");
}
constexpr int TR_P_IN = (DM / 128) * (IN_W / 32), TR_P_A = (ATTW / 128) * (DM / 32), TR_P_B = (GMW / 128) * (DM / 32), TR_P_O = (DM / 128) * (DM / 32), TR_P_UP = (DM / 128) * (F2 / 32), TR_P_DN = (DFF / 128) * (DM / 32);
constexpr int TR_OUT0 = TR_P_IN + TR_P_A + TR_P_B, TR_UP0 = TR_OUT0 + TR_P_O, TR_DN0 = TR_UP0 + TR_P_UP, TR_ALL = TR_DN0 + TR_P_DN;
constexpr int TR_AB_EARLY = 3072, TR_B_LATE = TR_P_A + TR_P_B - TR_AB_EARLY;
constexpr int TR_DN_LATE = 3584;
template <int LIST> __device__ __forceinline__ int tr_map(int v) {
    if (LIST == 1) return v < TR_P_IN ? v : (v < TR_P_IN + TR_B_LATE ? v + TR_AB_EARLY : TR_UP0 + (v - TR_P_IN - TR_B_LATE));
    if (LIST == 4) return TR_P_IN + v;
    if (LIST == 2) return v < TR_P_O ? TR_OUT0 + v : TR_DN0 + (v - TR_P_O);
    if (LIST == 3) return TR_ALL - TR_DN_LATE + v;
    return v;
}
template <int LIST> __device__ __forceinline__ void tr_run(Frame& F, int r0, int rend, int stride, LAS float* scr) {
    TrItem A, B; f32x4 a0[8], a1[8], b0[8], b1[8];
    int r = r0; bool hasA = r < rend;
    if (hasA) { tr_decode(F, tr_map<LIST>(r), A); tr_load(A, 0, a0, F.lane); tr_load(A, 1, a1, F.lane); }
    while (hasA) {
        const int rb = r + stride; const bool hasB = rb < rend;
        if (hasB) { tr_decode(F, tr_map<LIST>(rb), B); tr_load(B, 0, b0, F.lane); tr_load(B, 1, b1, F.lane); }
        tr_finish(A, 0, a0, scr, F.lane); tr_finish(A, 1, a1, scr, F.lane);
        if (!hasB) break;
        r = rb + stride; hasA = r < rend;
        if (hasA) { tr_decode(F, tr_map<LIST>(r), A); tr_load(A, 0, a0, F.lane); tr_load(A, 1, a1, F.lane); }
        tr_finish(B, 0, b0, scr, F.lane); tr_finish(B, 1, b1, scr, F.lane);
    }
}
__device__ __forceinline__ void p0_prologue(Frame& F, bool with_gemv = true) {
    LAS float* scr = (LAS float*)(F.lds + RING_OFF + F.wave * 16384);
    constexpr int I_GV = 96 * 64;
    if (with_gemv) for (int it = F.gw; it < I_GV; it += F.NGW) gemv_item(F, it);
    if (F.G == 256) tr_run<1>(F, F.gw, TR_P_IN + TR_B_LATE + TR_P_UP, F.NGW, scr); else tr_run<0>(F, F.gw, TR_ALL, F.NGW, scr);
    { const size_t n16 = (size_t)(PNP - IN_W) * DM / 16; GAS v4u* p = (GAS v4u*)((unsigned char*)F.WIN + (size_t)IN_W * DM);
      for (size_t i = (size_t)F.gw * 64 + F.lane; i < n16; i += (size_t)F.NGW * 64) p[i] = (v4u){0u, 0u, 0u, 0u};
      GAS v4u* pb = (GAS v4u*)(F.WINB + (size_t)IN_W * DM);
      for (size_t i = (size_t)F.gw * 64 + F.lane; i < 2 * n16; i += (size_t)F.NGW * 64) pb[i] = (v4u){0u, 0u, 0u, 0u}; }
}

template <int FP8 = 0, bool XBF = false>
__device__ __forceinline__ void norm_rows(Frame& F, const void* X, const float* gain, int sh_off, int sc_off, void* Ov, unsigned char* O8 = nullptr) {
    LAS f32x4* CA = (LAS f32x4*)F.lds; LAS f32x4* CB = (LAS f32x4*)(F.lds + 16384);
    for (int blk = blockIdx.x; blk < M / 32; blk += F.G) {
        const int b = (blk * 32) >> 11;
        __syncthreads();
        for (int i = F.tid; i < DM / 4; i += NWAVES * 64) { const f32x4 g = ((const GAS f32x4*)gain)[i], sh = ((const GAS f32x4*)(F.MOD + b * MODW + sh_off))[i], sc = ((const GAS f32x4*)(F.MOD + b * MODW + sc_off))[i];
            CA[i] = g * (sc + 1.0f); CB[i] = sh; }
        __syncthreads();
        const int m0 = blk * 32 + 4 * F.wave;
        f32x4 va[16], vb[16];
#define NR_LOAD(v, m_) do { if constexpr (XBF) { const GAS v2u* xr = (const GAS v2u*)((const bf16*)X + (size_t)(m_) * DM) + F.lane; _Pragma("unroll") for (int j = 0; j < 16; ++j) { const v2u w_ = xr[64 * j]; v[j] = (f32x4){bflo(w_.x), bfhi(w_.x), bflo(w_.y), bfhi(w_.y)}; } } \
        else { const GAS f32x4* xr = (const GAS f32x4*)((const float*)X + (size_t)(m_) * DM) + F.lane; _Pragma("unroll") for (int j = 0; j < 16; ++j) v[j] = xr[64 * j]; } } while (0)
#define NR_FIN(v, m_) do { float s_ = 0.f; _Pragma("unroll") for (int j = 0; j < 16; ++j) s_ += (v[j].x * v[j].x + v[j].y * v[j].y) + (v[j].z * v[j].z + v[j].w * v[j].w); \
            const float rstd = 1.0f / sqrtf(wave_sum(s_) * (1.f / DM) + EPS); \
            GAS v2u* o8 = (GAS v2u*)((bf16*)Ov + (size_t)(m_) * DM) + F.lane; GAS unsigned* o4 = (GAS unsigned*)((FP8 == 2 ? O8 : (unsigned char*)Ov) + (size_t)(m_) * DM) + F.lane; \
            _Pragma("unroll") for (int j = 0; j < 16; ++j) { const f32x4 y = (v[j] * rstd) * CA[64 * j + F.lane] + CB[64 * j + F.lane]; \
                if constexpr (FP8 != 0) o4[64 * j] = pk4_fp8(y.x * S_H2, y.y * S_H2, y.z * S_H2, y.w * S_H2); \
                if constexpr (FP8 != 1) { v2u w_; w_.x = pk2(y.x, y.y); w_.y = pk2(y.z, y.w); o8[64 * j] = w_; } \
                if ((j & 3) == 3) asm volatile("" ::: "memory"); } } while (0)
        NR_LOAD(va, m0); NR_LOAD(vb, m0 + 1); NR_FIN(va, m0); NR_LOAD(va, m0 + 2); NR_FIN(vb, m0 + 1); NR_LOAD(vb, m0 + 3); NR_FIN(va, m0 + 2); NR_FIN(vb, m0 + 3);
#undef NR_LOAD
#undef NR_FIN
    }
}

__device__ __forceinline__ unsigned sortable(float f) { const unsigned u = __builtin_bit_cast(unsigned, f); return u ^ ((unsigned)((int)u >> 31) | 0x80000000u); }
__device__ __forceinline__ void select_topk(const unsigned (&sc)[32], GAS v2u* mrow, int lane) {
    unsigned thr = 0u;
    for (int bit = 31; bit >= 0; --bit) {
        const unsigned cand = thr | (1u << bit); int cnt = 0;
#pragma unroll
        for (int jp = 0; jp < 32; ++jp) cnt += __popcll(__ballot(sc[jp] >= cand));
        if (cnt >= TOPK) thr = cand;
    }
    int cgt = 0;
#pragma unroll
    for (int jp = 0; jp < 32; ++jp) cgt += __popcll(__ballot(sc[jp] > thr));
    const int need = TOPK - cgt; int seen = 0;
    unsigned mylo = 0u, myhi = 0u;
    const unsigned long long lt = (lane == 0) ? 0ull : (~0ull >> (64 - lane));
#pragma unroll
    for (int jp = 0; jp < 32; ++jp) {
        unsigned long long sel = __ballot(sc[jp] > thr);
        const unsigned long long eq = __ballot(sc[jp] == thr);
        if (eq) { const bool take = (sc[jp] == thr) && (seen + __popcll(eq & lt) < need); sel |= __ballot(take); seen += __popcll(eq); }
        if (lane == jp) { mylo = (unsigned)sel; myhi = (unsigned)(sel >> 32); }
    }
    if (lane < 32) { v2u w; w.x = mylo; w.y = myhi; mrow[lane] = w; }
}
__device__ __forceinline__ void idx_block(Frame& F, int b, int blk) {
    const int lane = F.lane, w = F.wave, hi = lane >> 5, l31 = lane & 31, tid = F.tid;
    const int t0 = blk * 8, tq = t0 + w;
    const size_t row = (size_t)b * SEQ + tq;
    GAS v2u* mrow = (GAS v2u*)(F.MASK + row * 64);
    if (t0 < TOPK) {
        if (lane < 32) { const int k0 = 64 * lane; v2u mw;
            mw.x = (tq >= k0 + 31) ? 0xffffffffu : (tq < k0 ? 0u : ((2u << (tq - k0)) - 1u));
            mw.y = (tq >= k0 + 63) ? 0xffffffffu : (tq < k0 + 32 ? 0u : ((2u << (tq - k0 - 32)) - 1u));
            mrow[lane] = mw; }
        return;
    }
    const int nt = (t0 + 7) / 128 + 1;
    const bf16* prow = F.PROJ + row * PNP;
    bf16x8 qa[4]; float wv[16];
#pragma unroll
    for (int ks = 0; ks < 4; ++ks) qa[ks] = *(const GAS bf16x8*)(prow + PQI + l31 * 64 + 16 * ks + 8 * hi);
#pragma unroll
    for (int r = 0; r < 16; ++r) wv[r] = bf2f(prow[PWI + (r & 3) + 8 * (r >> 2) + 4 * hi]);
    const bf16* ksrc = F.PROJ + ((size_t)b * SEQ + (tid >> 3)) * PNP + PKI + 8 * (tid & 7);
    const int kdst = (tid >> 3) * 128 + (((tid & 7) ^ ((tid >> 3) & 7)) << 4);
    const int krd = l31 * 128;
    unsigned sc[32];
    __syncthreads();
    v4u stg0 = *(const GAS v4u*)ksrc, stg1 = *(const GAS v4u*)(ksrc + (size_t)64 * PNP);
#pragma unroll
    for (int kt = 0; kt < 16; ++kt) {
        if (kt < nt) {
            LAS unsigned char* kb_base = F.lds + (kt & 1) * 16384;
            *(LAS v4u*)(kb_base + kdst) = stg0; *(LAS v4u*)(kb_base + 8192 + kdst) = stg1;
            if (kt + 1 < nt) { stg0 = *(const GAS v4u*)(ksrc + (size_t)(kt + 1) * 128 * PNP); stg1 = *(const GAS v4u*)(ksrc + (size_t)((kt + 1) * 128 + 64) * PNP); }
            LDS_WAIT(); __builtin_amdgcn_s_barrier(); asm volatile("" ::: "memory");
            float s4[4];
#pragma unroll
            for (int h = 0; h < 4; ++h) {
                f32x16 acc;
#pragma unroll
                for (int r = 0; r < 16; ++r) acc[r] = 0.f;
#pragma unroll
                for (int ks = 0; ks < 4; ++ks) { const bf16x8 kf = *(const LAS bf16x8*)(kb_base + h * 4096 + krd + (((2 * ks + hi) ^ (l31 & 7)) << 4));
                    acc = __builtin_amdgcn_mfma_f32_32x32x16_bf16(qa[ks], kf, acc, 0, 0, 0); }
                float x0 = 0.f, x1 = 0.f;
#pragma unroll
                for (int r = 0; r < 16; r += 2) { x0 += wv[r] * fmaxf(acc[r], 0.f); x1 += wv[r + 1] * fmaxf(acc[r + 1], 0.f); }
                s4[h] = xor32_sum(x0 + x1);
            }
            const float ma = (lane < 32 ? s4[0] : s4[1]) + 0.0f, mb = (lane < 32 ? s4[2] : s4[3]) + 0.0f;
            sc[2 * kt] = (128 * kt + lane <= tq) ? sortable(ma) : 0u;
            sc[2 * kt + 1] = (128 * kt + 64 + lane <= tq) ? sortable(mb) : 0u;
        } else { sc[2 * kt] = 0u; sc[2 * kt + 1] = 0u; }
    }
    select_topk(sc, mrow, lane);
}
constexpr float QSCALE = 0.08838834764831845f * 1.4426950408889634f;
__device__ __forceinline__ void qknorm_row(Frame& F, int row) {
    bf16* prow = F.PROJ + (size_t)row * PNP; const int lane = F.lane;
    {
        GAS v4u* p = (GAS v4u*)(prow + PQ + 32 * lane); v4u w[4]; float ss = 0.f;
#pragma unroll
        for (int i = 0; i < 4; ++i) { w[i] = p[i];
#pragma unroll
            for (int j = 0; j < 4; ++j) { const float a = bflo(w[i][j]), c = bfhi(w[i][j]); ss += a * a + c * c; } }
        ss += __shfl_xor(ss, 1); ss += __shfl_xor(ss, 2);
        const float r = QSCALE / sqrtf(ss * (1.f / HD) + EPS); const float* g = F.qng + 32 * (lane & 3);
#pragma unroll
        for (int i = 0; i < 4; ++i) { v4u o;
#pragma unroll
            for (int j = 0; j < 4; ++j) o[j] = pk2(bflo(w[i][j]) * r * g[8 * i + 2 * j], bfhi(w[i][j]) * r * g[8 * i + 2 * j + 1]);
            p[i] = o; }
    }
    {
        GAS v4u* p = (GAS v4u*)(prow + PK + 8 * lane); const v4u w = *p; float ss = 0.f;
#pragma unroll
        for (int j = 0; j < 4; ++j) { const float a = bflo(w[j]), c = bfhi(w[j]); ss += a * a + c * c; }
        ss += __shfl_xor(ss, 1); ss += __shfl_xor(ss, 2); ss += __shfl_xor(ss, 4); ss += __shfl_xor(ss, 8);
        const float r = 1.0f / sqrtf(ss * (1.f / HD) + EPS); const float* g = F.kng + 8 * (lane & 15); v4u o;
#pragma unroll
        for (int j = 0; j < 4; ++j) o[j] = pk2(bflo(w[j]) * r * g[2 * j], bfhi(w[j]) * r * g[2 * j + 1]);
        *p = o;
    }
    {
        const GAS v4u* p = (const GAS v4u*)(prow + PGV + 32 * lane); float ss = 0.f;
#pragma unroll
        for (int i = 0; i < 4; ++i) { const v4u w = p[i];
#pragma unroll
            for (int j = 0; j < 4; ++j) { const float a = bflo(w[j]), c = bfhi(w[j]); ss += a * a + c * c; } }
        ss = wave_sum(ss);
        if (lane == 0) F.RS[row] = 1.0f / sqrtf(ss * (1.f / GMW) + EPS);
    }
}
__device__ __forceinline__ void vt_item(Frame& F, int item) {
    const int s8 = item & 255, dh = (item >> 8) & 1, g = (item >> 9) & 3, b = item >> 11, d = 64 * dh + F.lane;
    const bf16* src = F.PROJ + (size_t)(b * SEQ + 8 * s8) * PNP + PV + g * HD + d;
    unsigned e[8];
#pragma unroll
    for (int j = 0; j < 8; ++j) e[j] = src[(size_t)j * PNP];
    v4u o; o.x = e[0] | (e[1] << 16); o.y = e[2] | (e[3] << 16); o.z = e[4] | (e[5] << 16); o.w = e[6] | (e[7] << 16);
    *(GAS v4u*)(F.VT + ((size_t)((b * NKV + g) * HD + d)) * SEQ + 8 * s8) = o;
}

constexpr int AT_KSTR = 272, AT_VSTR = 136, AT_TILE = 17408;
#define RAW_BARRIER() do { LDS_WAIT(); __builtin_amdgcn_s_barrier(); asm volatile("" ::: "memory"); } while (0)
__device__ __forceinline__ void attn_block(Frame& F, int b, int g, int qb, float sbound) {
    const int lane = F.lane, w = F.wave, hi = lane >> 5, l31 = lane & 31, tid = F.tid;
    const int hh = 4 * g + (w >> 1), tw0 = qb * 64 + 32 * (w & 1), t = tw0 + l31;
    const size_t row = (size_t)b * SEQ + t;
    const float slope2 = exp2f(-0.5f * (float)(hh + 1)) * 1.4426950408889634f;
    bf16x8 qf[8];
#pragma unroll
    for (int ks = 0; ks < 8; ++ks) qf[ks] = *(const GAS bf16x8*)(F.PROJ + row * PNP + PQ + hh * HD + 16 * ks + 8 * hi);
    f32x16 o[4];
#pragma unroll
    for (int db = 0; db < 4; ++db)
#pragma unroll
        for (int r = 0; r < 16; ++r) o[db][r] = 0.f;
    float m = -1e30f, lsum = 0.f;
    const bf16* ksrc = F.PROJ + ((size_t)b * SEQ + (tid >> 4)) * PNP + PK + g * HD + 8 * (tid & 15);
    const int kdst = (tid >> 4) * AT_KSTR + (tid & 15) * 16;
    const bf16* vsrc = F.VT + ((size_t)((b * NKV + g) * HD + (tid >> 3))) * SEQ + 8 * (tid & 7);
    const int vdst = 2 * AT_TILE + (tid >> 3) * AT_VSTR + (tid & 7) * 16;
    const unsigned* mbase = F.MASK + row * 64;
    LAS unsigned char* L = F.lds;
    v4u sk0, sk1, sv0, sv1; v2u mw, mwn;
#define AT_LOAD(kt_) do { sk0 = *(const GAS v4u*)(ksrc + (size_t)(64 * (kt_)) * PNP); sk1 = *(const GAS v4u*)(ksrc + (size_t)(64 * (kt_) + 32) * PNP); \
        sv0 = *(const GAS v4u*)(vsrc + 64 * (kt_)); sv1 = *(const GAS v4u*)(vsrc + (size_t)64 * SEQ + 64 * (kt_)); mwn = *(const GAS v2u*)(mbase + 2 * (kt_)); } while (0)
#define AT_STORE(bf_) do { *(LAS v4u*)(L + (bf_) * AT_TILE + kdst) = sk0; *(LAS v4u*)(L + (bf_) * AT_TILE + kdst + 32 * AT_KSTR) = sk1; \
        LAS unsigned char* _v = L + (bf_) * AT_TILE + vdst; *(LAS v2u*)_v = (v2u){sv0.x, sv0.y}; *(LAS v2u*)(_v + 8) = (v2u){sv0.z, sv0.w}; \
        *(LAS v2u*)(_v + 64 * AT_VSTR) = (v2u){sv1.x, sv1.y}; *(LAS v2u*)(_v + 64 * AT_VSTR + 8) = (v2u){sv1.z, sv1.w}; } while (0)
    RAW_BARRIER();
    AT_LOAD(qb); AT_STORE(0); mw = mwn;
    int buf = 0; bool dead = false;
    for (int kt = qb; kt >= 0; --kt) {
        if (kt > 0) AT_LOAD(kt - 1);
        RAW_BARRIER();
        if (!dead) {
            const float dmin = (float)(tw0 - (64 * kt + 63));
            dead = __all((sbound - slope2 * dmin) < (m - 40.0f));
        }
        if (!dead) {
            const LAS unsigned char* kb_ = L + buf * AT_TILE + l31 * AT_KSTR + hi * 16;
            const LAS unsigned char* vb_ = L + buf * AT_TILE + 2 * AT_TILE + l31 * AT_VSTR + hi * 8;
            f32x16 p[2];
#pragma unroll
            for (int kb = 0; kb < 2; ++kb) { const unsigned mword = (kb ? mw.y : mw.x) >> (4 * hi);
#pragma unroll
                for (int r = 0; r < 16; ++r) { const int ko = (r & 3) + 8 * (r >> 2);
                    p[kb][r] = ((mword >> ko) & 1u) ? slope2 * (float)(32 * kb + ko) : -2e30f; }
#pragma unroll
                for (int ks = 0; ks < 8; ++ks) { const bf16x8 kf = *(const LAS bf16x8*)(kb_ + kb * 32 * AT_KSTR + ks * 32); p[kb] = __builtin_amdgcn_mfma_f32_32x32x16_bf16(kf, qf[ks], p[kb], 0, 0, 0); }
            }
            const float base = -slope2 * (float)(t - 64 * kt - 4 * hi);
            float rmax = -3e30f;
#pragma unroll
            for (int kb = 0; kb < 2; ++kb)
#pragma unroll
                for (int r = 0; r < 16; ++r) rmax = fmaxf(rmax, p[kb][r]);
            rmax += base; rmax = xor32_max(rmax);
            const float mn = fmaxf(m, rmax), alpha = __builtin_amdgcn_exp2f(m - mn), mrel = mn - base;
            const bool moved = __any(mn != m);
            m = mn;
            float ps = 0.f;
#pragma unroll
            for (int kb = 0; kb < 2; ++kb)
#pragma unroll
                for (int r = 0; r < 16; ++r) { const float e = __builtin_amdgcn_exp2f(p[kb][r] - mrel); p[kb][r] = e; ps += e; }
            lsum = lsum * alpha + ps;
            if (moved) {
#pragma unroll
                for (int db = 0; db < 4; ++db)
#pragma unroll
                    for (int r = 0; r < 16; ++r) o[db][r] *= alpha;
            }
#pragma unroll
            for (int kb = 0; kb < 2; ++kb)
#pragma unroll
                for (int s2 = 0; s2 < 2; ++s2) {
                    v4u pw; pw.x = pk2(p[kb][8 * s2 + 0], p[kb][8 * s2 + 1]); pw.y = pk2(p[kb][8 * s2 + 2], p[kb][8 * s2 + 3]); pw.z = pk2(p[kb][8 * s2 + 4], p[kb][8 * s2 + 5]); pw.w = pk2(p[kb][8 * s2 + 6], p[kb][8 * s2 + 7]);
                    const bf16x8 pb = __builtin_bit_cast(bf16x8, pw);
#pragma unroll
                    for (int db = 0; db < 4; ++db) { const LAS unsigned char* vp = vb_ + db * 32 * AT_VSTR + kb * 64 + s2 * 32;
                        const v2u v0 = *(const LAS v2u*)vp, v1 = *(const LAS v2u*)(vp + 16);
                        v4u vw; vw.x = v0.x; vw.y = v0.y; vw.z = v1.x; vw.w = v1.y;
                        o[db] = __builtin_amdgcn_mfma_f32_32x32x16_bf16(__builtin_bit_cast(bf16x8, vw), pb, o[db], 0, 0, 0); }
                }
        }
        if (kt > 0) { AT_STORE(buf ^ 1); mw = mwn; }
        buf ^= 1;
    }
#undef AT_LOAD
#undef AT_STORE
    lsum = xor32_sum(lsum);
    const float inv = S_YA / lsum;
    unsigned char* yrow = (unsigned char*)F.YA + row * (2 * ATTW) + hh * HD + 4 * hi;
#pragma unroll
    for (int db = 0; db < 4; ++db)
#pragma unroll
        for (int rq = 0; rq < 4; ++rq) *(GAS unsigned*)(yrow + 32 * db + 8 * rq) = pk4_fp8(o[db][4 * rq] * inv, o[db][4 * rq + 1] * inv, o[db][4 * rq + 2] * inv, o[db][4 * rq + 3] * inv);
}
__device__ __forceinline__ float attn_score_bound(Frame& F) {
    float gq = fmaxf(fabsf(F.qng[F.lane]), fabsf(F.qng[F.lane + 64])), gk = fmaxf(fabsf(F.kng[F.lane]), fabsf(F.kng[F.lane + 64]));
#pragma unroll
    for (int o = 1; o < 64; o <<= 1) { gq = fmaxf(gq, __shfl_xor(gq, o)); gk = fmaxf(gk, __shfl_xor(gk, o)); }
    return 1.02f * 128.0f * gq * gk * QSCALE;
}

constexpr int SG_STR = 272, SG_WOFF = 65536;
__device__ __forceinline__ void sgu_unit(Frame& F, int unit) {
    const int ck = unit >> 3, g = unit & 7, r0 = ck * GMC, c0 = g * GMGW, tid = F.tid, lane = F.lane, w = F.wave, hi = lane >> 5, l31 = lane & 31;
    LAS unsigned char* L = F.lds;
    const int rs_ = tid >> 5, q_ = tid & 31;
    __syncthreads();
#pragma unroll
    for (int i = 0; i < 8; ++i) *(LAS v4u*)(L + (rs_ + 16 * i) * 512 + q_ * 16) = *(const GAS v4u*)(F.PROJ + (size_t)(r0 + rs_ + 16 * i) * PNP + PGV + c0 + 8 * q_);
    { const f32x4 q = *(const GAS f32x4*)(F.RS + r0 + 4 * q_);
#pragma unroll
      for (int i = 0; i < 8; ++i) { const int t_ = rs_ + 16 * i; const f32x4 wv = *(const GAS f32x4*)(F.sgw + ((size_t)(g * GMC + t_)) * GMC + 4 * q_);
          const int sb = 4 * q_; v2u o;
          o.x = pk2(sb + 0 <= t_ ? wv.x * q.x : 0.f, sb + 1 <= t_ ? wv.y * q.y : 0.f); o.y = pk2(sb + 2 <= t_ ? wv.z * q.z : 0.f, sb + 3 <= t_ ? wv.w * q.w : 0.f);
          *(LAS v2u*)(L + SG_WOFF + t_ * SG_STR + 8 * q_) = o; } }
    __syncthreads();
    v4u uu[8];
#pragma unroll
    for (int i = 0; i < 8; ++i) uu[i] = *(const GAS v4u*)(F.PROJ + (size_t)(r0 + rs_ + 16 * i) * PNP + PGU + c0 + 8 * q_);
    f32x16 acc[4];
#pragma unroll
    for (int tb = 0; tb < 4; ++tb)
#pragma unroll
        for (int r = 0; r < 16; ++r) acc[tb][r] = 0.f;
    const LAS unsigned char* xb = L + hi * 8 * 512 + 2 * (32 * w + l31);
    const LAS unsigned char* wa = L + SG_WOFF + l31 * SG_STR + hi * 16;
#pragma unroll
    for (int ks = 0; ks < 8; ++ks) {
        v4u xw;
#pragma unroll
        for (int j = 0; j < 4; ++j) { const unsigned lo = *(const LAS unsigned short*)(xb + (16 * ks + 2 * j) * 512), hh = *(const LAS unsigned short*)(xb + (16 * ks + 2 * j + 1) * 512); xw[j] = lo | (hh << 16); }
        const bf16x8 xf = __builtin_bit_cast(bf16x8, xw);
#pragma unroll
        for (int tb = 0; tb < 4; ++tb) if (ks < 2 * (tb + 1)) { const bf16x8 wf = *(const LAS bf16x8*)(wa + tb * 32 * SG_STR + ks * 32); acc[tb] = __builtin_amdgcn_mfma_f32_32x32x16_bf16(wf, xf, acc[tb], 0, 0, 0); } }
    LDS_WAIT(); __builtin_amdgcn_s_barrier(); asm volatile("" ::: "memory");
    { const int cl = 32 * w + l31;
#pragma unroll
      for (int tb = 0; tb < 4; ++tb)
#pragma unroll
          for (int r = 0; r < 16; ++r) { const int t = 32 * tb + (r & 3) + 8 * (r >> 2) + 4 * hi; *(LAS unsigned short*)(L + t * 512 + 2 * cl) = (unsigned short)f2bf(acc[tb][r]); } }
    const f32x4 g0 = *(const GAS f32x4*)(F.sgg + c0 + 8 * q_), g1 = *(const GAS f32x4*)(F.sgg + c0 + 8 * q_ + 4);
    LDS_WAIT(); __builtin_amdgcn_s_barrier(); asm volatile("" ::: "memory");
#pragma unroll
    for (int i = 0; i < 8; ++i) { const v4u fw = *(const LAS v4u*)(L + (rs_ + 16 * i) * 512 + q_ * 16); const float bb = F.sgb[g * GMC + rs_ + 16 * i]; v2u o;
        o.x = pk4_fp8(S_YB * bflo(uu[i].x) * (bflo(fw.x) * g0.x + bb), S_YB * bfhi(uu[i].x) * (bfhi(fw.x) * g0.y + bb), S_YB * bflo(uu[i].y) * (bflo(fw.y) * g0.z + bb), S_YB * bfhi(uu[i].y) * (bfhi(fw.y) * g0.w + bb));
        o.y = pk4_fp8(S_YB * bflo(uu[i].z) * (bflo(fw.z) * g1.x + bb), S_YB * bfhi(uu[i].z) * (bfhi(fw.z) * g1.y + bb), S_YB * bflo(uu[i].w) * (bflo(fw.w) * g1.z + bb), S_YB * bfhi(uu[i].w) * (bfhi(fw.w) * g1.w + bb));
        *(GAS v2u*)((unsigned char*)F.YA + (size_t)(r0 + rs_ + 16 * i) * (2 * ATTW) + ATTW + c0 + 8 * q_) = o; }
}

using pg8::Unit; using pg8::cvt_pk_bf16;
struct EpiProj {
    static constexpr bool PERM = true, MIDK = false; bf16* O; float scale;
    __device__ __forceinline__ void operator()(const f32x4 (&acc)[2][2][4][2], const Unit& u, int wr, int wc, int fr, int fq) const {
        const int act = (u.pn >= PGU / 256 && u.pn < PGA / 256) ? 1 : ((u.pn >= PGA / 256 && u.pn < PKI / 256) ? 2 : 0);
        const int row0 = u.pm * 256 + wr * 64 + fr, col0 = u.pn * 256 + wc * 32 + 8 * fq;
#pragma unroll
        for (int ai = 0; ai < 2; ++ai)
#pragma unroll
            for (int m = 0; m < 4; ++m) { bf16* rowp = O + (size_t)(row0 + ai * 128 + m * 16) * PNP + col0;
#pragma unroll
                for (int bj = 0; bj < 2; ++bj) { f32x4 v0 = acc[ai][bj][m][0] * scale, v1 = acc[ai][bj][m][1] * scale;
                    if (act == 1) { const pg8::f32x2 a = pg8::gelu_pk((pg8::f32x2){v0[0], v0[1]}), b = pg8::gelu_pk((pg8::f32x2){v0[2], v0[3]}), c = pg8::gelu_pk((pg8::f32x2){v1[0], v1[1]}), d = pg8::gelu_pk((pg8::f32x2){v1[2], v1[3]});
                        v0 = (f32x4){a.x, a.y, b.x, b.y}; v1 = (f32x4){c.x, c.y, d.x, d.y}; }
                    else if (act == 2) {
#pragma unroll
                        for (int j = 0; j < 4; ++j) { v0[j] = pg8::sigmoidf_(v0[j]); v1[j] = pg8::sigmoidf_(v1[j]); } }
                    v4u w; w.x = cvt_pk_bf16(v0[0], v0[1]); w.y = cvt_pk_bf16(v0[2], v0[3]); w.z = cvt_pk_bf16(v1[0], v1[1]); w.w = cvt_pk_bf16(v1[2], v1[3]);
                    *(GAS v4u*)(rowp + bj * 128) = w; } }
    }
};
struct EpiMerge {
    static constexpr bool PERM = true, MIDK = true; const bf16* P; unsigned char* O; float cB, ratio;
    __device__ __forceinline__ void mid(f32x4 (&acc)[2][2][4][2], const Unit& u, int wr, int wc, int fr, int fq) const {
        const bf16* pb = P + (size_t)(u.pm * 256 + wr * 64 + fr) * PNP + (u.pn * 256 + wc * 32 + 8 * fq);
        asm volatile("" : "+v"(pb));
#pragma unroll
        for (int ai = 0; ai < 2; ++ai)
#pragma unroll
            for (int m = 0; m < 4; ++m) {
#pragma unroll
                for (int bj = 0; bj < 2; ++bj) { const bf16* q = pb + (size_t)(ai * 128 + m * 16) * PNP + bj * 128;
                    const v4u ga = *(const GAS v4u*)(q + PGA), gb = *(const GAS v4u*)(q + PGB);
#pragma unroll
                    for (int j = 0; j < 2; ++j) { f32x4 f;
                        f.x = ratio * bflo(ga[2 * j]) * __builtin_amdgcn_rcpf(fmaxf(bflo(gb[2 * j]), 1e-30f)); f.y = ratio * bfhi(ga[2 * j]) * __builtin_amdgcn_rcpf(fmaxf(bfhi(gb[2 * j]), 1e-30f));
                        f.z = ratio * bflo(ga[2 * j + 1]) * __builtin_amdgcn_rcpf(fmaxf(bflo(gb[2 * j + 1]), 1e-30f)); f.w = ratio * bfhi(ga[2 * j + 1]) * __builtin_amdgcn_rcpf(fmaxf(bfhi(gb[2 * j + 1]), 1e-30f));
                        acc[ai][bj][m][j] *= f; }
                    asm volatile("" ::: "memory"); } }
    }
    __device__ __forceinline__ void operator()(const f32x4 (&acc)[2][2][4][2], const Unit& u, int wr, int wc, int fr, int fq) const {
        const float sc = cB * S_MRG;
        const bf16* pb = P + (size_t)(u.pm * 256 + wr * 64 + fr) * PNP + (u.pn * 256 + wc * 32 + 8 * fq) + PGB;
        unsigned char* ob = O + (size_t)(u.pm * 256 + wr * 64 + fr) * DM + (u.pn * 256 + wc * 32 + 8 * fq);
        asm volatile("" : "+v"(pb), "+v"(ob));
#pragma unroll
        for (int ai = 0; ai < 2; ++ai)
#pragma unroll
            for (int m = 0; m < 4; ++m) {
#pragma unroll
                for (int bj = 0; bj < 2; ++bj) { const v4u gw = *(const GAS v4u*)(pb + (size_t)(ai * 128 + m * 16) * PNP + bj * 128);
                    const f32x4 v0 = acc[ai][bj][m][0] * ((f32x4){fmaxf(bflo(gw.x), 1e-30f), fmaxf(bfhi(gw.x), 1e-30f), fmaxf(bflo(gw.y), 1e-30f), fmaxf(bfhi(gw.y), 1e-30f)} * sc);
                    const f32x4 v1 = acc[ai][bj][m][1] * ((f32x4){fmaxf(bflo(gw.z), 1e-30f), fmaxf(bfhi(gw.z), 1e-30f), fmaxf(bflo(gw.w), 1e-30f), fmaxf(bfhi(gw.w), 1e-30f)} * sc);
                    v2u w; w.x = pk4_fp8(v0[0], v0[1], v0[2], v0[3]); w.y = pk4_fp8(v1[0], v1[1], v1[2], v1[3]);
                    *(GAS v2u*)(ob + (size_t)(ai * 128 + m * 16) * DM + bj * 128) = w; } }
    }
};
template <bool BIN, bool BOUT>
struct EpiResid {
    static constexpr bool PERM = false, MIDK = false; const void* base; const float* gate; void* C; float scale;
    __device__ __forceinline__ void operator()(const f32x4 (&acc)[2][2][4][2], const Unit& u, int wr, int wc, int fr, int fq) const {
        const int row0 = u.pm * 256 + wr * 64 + fr, col0 = u.pn * 256 + wc * 32 + 4 * fq; const float* gp = gate + (u.pm >> 3) * MODW + col0;
        f32x4 gv[2][2];
#pragma unroll
        for (int bj = 0; bj < 2; ++bj)
#pragma unroll
            for (int n = 0; n < 2; ++n) gv[bj][n] = *(const GAS f32x4*)(gp + bj * 128 + n * 16) * scale;
#pragma unroll
        for (int ai = 0; ai < 2; ++ai)
#pragma unroll
            for (int m = 0; m < 4; ++m) { const size_t off = (size_t)(row0 + ai * 128 + m * 16) * DM + col0;
#pragma unroll
                for (int bj = 0; bj < 2; ++bj)
#pragma unroll
                    for (int n = 0; n < 2; ++n) { const size_t o = off + bj * 128 + n * 16; f32x4 bs;
                        if constexpr (BIN) { const v2u w = *(const GAS v2u*)((const bf16*)base + o); bs = (f32x4){bflo(w.x), bfhi(w.x), bflo(w.y), bfhi(w.y)}; }
                        else bs = *(const GAS f32x4*)((const float*)base + o);
                        const f32x4 r = bs + gv[bj][n] * acc[ai][bj][m][n];
                        if constexpr (BOUT) { v2u w; w.x = cvt_pk_bf16(r.x, r.y); w.y = cvt_pk_bf16(r.z, r.w); *(GAS v2u*)((bf16*)C + o) = w; }
                        else *(GAS f32x4*)((float*)C + o) = r; } }
    }
};
struct EpiPlain {
    static constexpr bool PERM = true, MIDK = false; unsigned char* O; int ldc; float scale;
    __device__ __forceinline__ void operator()(const f32x4 (&acc)[2][2][4][2], const Unit& u, int wr, int wc, int fr, int fq) const {
        unsigned char* ob = O + (size_t)(u.pm * 256 + wr * 64 + fr) * ldc + (u.pn * 256 + wc * 32 + 8 * fq);
        asm volatile("" : "+v"(ob));
#pragma unroll
        for (int ai = 0; ai < 2; ++ai)
#pragma unroll
            for (int m = 0; m < 4; ++m)
#pragma unroll
                for (int bj = 0; bj < 2; ++bj) { const f32x4 v0 = acc[ai][bj][m][0] * scale, v1 = acc[ai][bj][m][1] * scale;
                    v2u w; w.x = pk4_fp8(v0[0], v0[1], v0[2], v0[3]); w.y = pk4_fp8(v1[0], v1[1], v1[2], v1[3]);
                    *(GAS v2u*)(ob + (size_t)(ai * 128 + m * 16) * ldc + bj * 128) = w; }
    }
};

typedef float f32x2 __attribute__((ext_vector_type(2)));
__device__ __forceinline__ void unpack8_fp8(v2u w, f32x2 (&o)[4]) {
    o[0] = __builtin_amdgcn_cvt_pk_f32_fp8((int)w.x, false); o[1] = __builtin_amdgcn_cvt_pk_f32_fp8((int)w.x, true); o[2] = __builtin_amdgcn_cvt_pk_f32_fp8((int)w.y, false); o[3] = __builtin_amdgcn_cvt_pk_f32_fp8((int)w.y, true);
}
__device__ __forceinline__ void conv_phase(Frame& F) {
    constexpr int C8 = DFF / 8, TB = 32, NTB = M / TB;
    const size_t total = (size_t)C8 * NTB;
    for (size_t idx = (size_t)F.gw * 64 + F.lane; idx < total; idx += (size_t)F.NGW * 64) {
        const int c8 = (int)(idx % C8), tb = (int)(idx / C8), ch = 8 * c8, t0 = tb * TB;
        const int acol = (ch >> 7) * 256 + (ch & 127);
        f32x2 wg[3][4], wv[3][4], bg[4], bv[4];
#pragma unroll
        for (int j = 0; j < 3; ++j) { const f32x4 a = *(const GAS f32x4*)(F.cvw + (size_t)j * F2 + ch) * (1.f / S_A), b = *(const GAS f32x4*)(F.cvw + (size_t)j * F2 + ch + 4) * (1.f / S_A);
            const f32x4 c = *(const GAS f32x4*)(F.cvw + (size_t)j * F2 + DFF + ch) * (1.f / S_A), d = *(const GAS f32x4*)(F.cvw + (size_t)j * F2 + DFF + ch + 4) * (1.f / S_A);
            wg[j][0] = (f32x2){a.x, a.y}; wg[j][1] = (f32x2){a.z, a.w}; wg[j][2] = (f32x2){b.x, b.y}; wg[j][3] = (f32x2){b.z, b.w};
            wv[j][0] = (f32x2){c.x, c.y}; wv[j][1] = (f32x2){c.z, c.w}; wv[j][2] = (f32x2){d.x, d.y}; wv[j][3] = (f32x2){d.z, d.w}; }
        { const f32x4 a = *(const GAS f32x4*)(F.cvb + ch), b = *(const GAS f32x4*)(F.cvb + ch + 4), c = *(const GAS f32x4*)(F.cvb + DFF + ch), d = *(const GAS f32x4*)(F.cvb + DFF + ch + 4);
          bg[0] = (f32x2){a.x, a.y}; bg[1] = (f32x2){a.z, a.w}; bg[2] = (f32x2){b.x, b.y}; bg[3] = (f32x2){b.z, b.w}; bv[0] = (f32x2){c.x, c.y}; bv[1] = (f32x2){c.z, c.w}; bv[2] = (f32x2){d.x, d.y}; bv[3] = (f32x2){d.z, d.w}; }
        f32x2 g1[4], g2[4], v1[4], v2[4];
        const bool first = (t0 & (SEQ - 1)) == 0;
        const unsigned char* ap = (const unsigned char*)F.A + (size_t)t0 * F2 + acol;
        if (first) {
#pragma unroll
            for (int e = 0; e < 4; ++e) { g1[e] = g2[e] = v1[e] = v2[e] = (f32x2){0.f, 0.f}; }
        } else {
            const v2u ga = *(const GAS v2u*)(ap - F2), gb = *(const GAS v2u*)(ap - 2 * (size_t)F2), va = *(const GAS v2u*)(ap - F2 + 128), vb = *(const GAS v2u*)(ap - 2 * (size_t)F2 + 128);
            unpack8_fp8(ga, g1); unpack8_fp8(gb, g2); unpack8_fp8(va, v1); unpack8_fp8(vb, v2);
        }
        v2u GA[8], VA[8], GB[8], VB[8];
#define CV_LOAD(G_, V_, r0_) do { _Pragma("unroll") for (int i_ = 0; i_ < 8; ++i_) { G_[i_] = *(const GAS v2u*)(ap + (size_t)((r0_) + i_) * F2); V_[i_] = *(const GAS v2u*)(ap + (size_t)((r0_) + i_) * F2 + 128); } } while (0)
#define CV_COMP(G_, V_, r0_) do { _Pragma("unroll") for (int i_ = 0; i_ < 8; ++i_) { f32x2 g0[4], v0[4], y[4]; unpack8_fp8(G_[i_], g0); unpack8_fp8(V_[i_], v0); \
            _Pragma("unroll") for (int e = 0; e < 4; ++e) { const f32x2 gt = bg[e] + wg[0][e] * g2[e] + wg[1][e] * g1[e] + wg[2][e] * g0[e]; \
                const f32x2 vl = bv[e] + wv[0][e] * v2[e] + wv[1][e] * v1[e] + wv[2][e] * v0[e]; \
                f32x2 sg; sg.x = pg8::sigmoidf_(gt.x); sg.y = pg8::sigmoidf_(gt.y); \
                y[e] = (gt * sg) * (vl * S_ACT); g2[e] = g1[e]; g1[e] = g0[e]; v2[e] = v1[e]; v1[e] = v0[e]; } \
            v2u o; o.x = pk4_fp8(y[0].x, y[0].y, y[1].x, y[1].y); o.y = pk4_fp8(y[2].x, y[2].y, y[3].x, y[3].y); \
            *(GAS v2u*)((unsigned char*)F.ACT + (size_t)(t0 + (r0_) + i_) * DFF + ch) = o; } asm volatile("" ::: "memory"); } while (0)
        CV_LOAD(GA, VA, 0); CV_LOAD(GB, VB, 8); CV_COMP(GA, VA, 0); CV_LOAD(GA, VA, 16); CV_COMP(GB, VB, 8); CV_LOAD(GB, VB, 24); CV_COMP(GA, VA, 16); CV_COMP(GB, VB, 24);
#undef CV_LOAD
#undef CV_COMP
    }
}

constexpr int N_PHASES = 12;
struct Args { const float* in[19]; float* out; unsigned char* ws; int ph_lo, ph_hi, li, pad; };
__global__ void __launch_bounds__(NWAVES * 64, 2) mega_fwd(Args args) {
    extern __shared__ __attribute__((aligned(16))) unsigned char lds[];
    Frame F;
    F.lds = (LAS unsigned char*)lds;
    F.MISC = (volatile LAS unsigned*)(F.lds + MISC_OFF);
    F.tid = threadIdx.x; F.lane = F.tid & 63; F.wave = __builtin_amdgcn_readfirstlane(F.tid >> 6);
    F.G = gridDim.x; F.gw = blockIdx.x * NWAVES + F.wave; F.NGW = F.G * NWAVES;
    unsigned char* ws = args.ws;
    F.ctl = (gu32*)(ws + WS_CTL);
    F.x = args.in[0]; F.c = args.in[1]; F.ada_w = args.in[2]; F.ada_b = args.in[3]; F.n1g = args.in[4]; F.w_in = args.in[5]; F.qng = args.in[6]; F.kng = args.in[7];
    F.sgg = args.in[8]; F.sgw = args.in[9]; F.sgb = args.in[10]; F.w_a = args.in[11]; F.w_b = args.in[12]; F.w_out = args.in[13]; F.n2g = args.in[14]; F.w_up = args.in[15];
    F.cvw = args.in[16]; F.cvb = args.in[17]; F.w_dn = args.in[18]; F.out = args.out;
    F.MOD = (float*)(ws + WS_MOD); F.PART = (float*)(ws + WS_TMP);   F.WIN = (bf16*)(ws + WS_WIN); F.WINB = (bf16*)(ws + WS_WINB); F.H8A = ws + WS_X1;   F.WA = (bf16*)(ws + WS_WA); F.WB = (bf16*)(ws + WS_WB); F.WOUT = (bf16*)(ws + WS_WOUT); F.WUP = (bf16*)(ws + WS_WUP); F.WDN = (bf16*)(ws + WS_WDN);
    F.H = (bf16*)(ws + WS_H); F.X1 = (float*)(ws + WS_X1); F.PROJ = (bf16*)(ws + WS_PROJ); F.MASK = (unsigned*)(ws + WS_MASK); F.RS = (float*)(ws + WS_RS); F.SWT = (float*)(ws + WS_SWT);
    F.VT = (bf16*)(ws + WS_VT); F.YA = (bf16*)(ws + WS_YA); F.YB = (bf16*)(ws + WS_YB); F.MRG = (bf16*)(ws + WS_MRG); F.TMP = (float*)(ws + WS_TMP); F.A = (bf16*)(ws + WS_A); F.ACT = (bf16*)(ws + WS_ACT);
    for (int u = F.tid; u < (LDS_BYTES - LDSCTL_OFF) / 4; u += NWAVES * 64) ((LAS unsigned*)(F.lds + LDSCTL_OFF))[u] = 0u;
    __syncthreads();
    XcdBarrier bar; bar.bar = (unsigned*)(F.ctl + CW_BAR); bar.x = 0; bar.st = nullptr;
    if (MK_N_LAUNCHES == 1) bar = xcd_barrier_post((unsigned*)(F.ctl + CW_BAR), F.MISC + 8);
    const int lo = args.ph_lo, hi = args.ph_hi;
#define IN(k) (lo <= (k) && (k) < hi)
#define SEAM(k) do { if (IN(k) && IN((k) + 1)) xcd_barrier(bar); } while (0)

#define REP(k) if ((PROBE_MASK >> (k)) & 1) for (int _rep = 0; _rep < 1; ++_rep)
    if (IN(0)) { p0_prologue(F); REP(0) { xcd_barrier(bar); p0_prologue(F, false); } } SEAM(0);
    if (IN(1)) { mod_reduce(F); } SEAM(1);
    if (IN(2)) { norm_rows<2>(F, F.x, F.n1g, 0, DM, F.H, F.H8A); REP(2) { xcd_barrier(bar); norm_rows<2>(F, F.x, F.n1g, 0, DM, F.H, F.H8A); } } SEAM(2);
    if (IN(3)) {
        { pg8::Gemm g{F.H, F.WINB, M, PNP, DM, DM, DM}; pg8::MixOrder S{0, F.G, (int)blockIdx.x}; EpiProj E{F.PROJ, 1.0f};
          pg8::gemm_phase<EpiProj, pg8::MixOrder, true, 2>(F.lds + RING_OFF, g, S, E); }
        VM_WAIT(); __syncthreads();
        { pg8::Gemm g{(const bf16*)F.H8A, F.WIN, M, PNP, DM, DM, DM}; pg8::MixOrder S{1, F.G, (int)blockIdx.x}; EpiProj E{F.PROJ, 1.0f / (S_H2 * 1024.f)};
          pg8::gemm_phase<EpiProj, pg8::MixOrder, true, 1>(F.lds + RING_OFF, g, S, E); }
        if (F.G == 256 && blockIdx.x < 32) { const int first = (int)blockIdx.x * 96;
            tr_run<4>(F, first + F.wave, first + 96, NWAVES, (LAS float*)(F.lds + RING_OFF + F.wave * 16384)); }
    } SEAM(3);
    if (IN(4)) {
        for (int it = blockIdx.x; it < 512; it += F.G) { const int b = it >> 7, j = it & 127; idx_block(F, b, j); idx_block(F, b, 255 - j); }
        for (int row = F.gw; row < M; row += F.NGW) qknorm_row(F, row);
        for (int it = F.gw; it < BATCH * NKV * 2 * 256; it += F.NGW) vt_item(F, it);
        REP(4) { xcd_barrier(bar); for (int it = blockIdx.x; it < 512; it += F.G) { const int b = it >> 7, j = it & 127; idx_block(F, b, j); idx_block(F, b, 255 - j); } }
        REP(13) { xcd_barrier(bar); for (int it = F.gw; it < BATCH * NKV * 2 * 256; it += F.NGW) vt_item(F, it); }
    } SEAM(4);
    if (IN(5)) {
        { const float sb = attn_score_bound(F); for (int p = blockIdx.x; p < 256; p += F.G) { const int bg = p >> 4, j = p & 15; attn_block(F, bg >> 2, bg & 3, j, sb); attn_block(F, bg >> 2, bg & 3, 31 - j, sb); } }
        REP(5) { xcd_barrier(bar); { const float sb = attn_score_bound(F); for (int p = blockIdx.x; p < 256; p += F.G) { const int bg = p >> 4, j = p & 15; attn_block(F, bg >> 2, bg & 3, j, sb); attn_block(F, bg >> 2, bg & 3, 31 - j, sb); } } }
        for (int u = blockIdx.x; u < 512; u += F.G) sgu_unit(F, u);
        __syncthreads();
        if (F.G == 256) { const int pq = blockIdx.x, g_ = (pq >> 4) & 3, li = (pq >> 6) * 16 + (pq & 15);
            if (g_ < 2) { const int cnt = g_ == 0 ? 100 : 80, first = g_ == 0 ? li * 100 : 64 * 100 + li * 80;
                tr_run<2>(F, first + F.wave, first + cnt, NWAVES, (LAS float*)(F.lds + RING_OFF + F.wave * 16384)); }
            __syncthreads(); }
        REP(14) { xcd_barrier(bar); for (int u = blockIdx.x; u < 512; u += F.G) sgu_unit(F, u); __syncthreads(); }
    } SEAM(5);
    if (IN(6)) { pg8::Gemm g{F.YA, F.WA, M, DM, 2 * ATTW, 2 * ATTW, 2 * ATTW}; pg8::StaticOrder S; S.init(M, DM, F.G, (int)blockIdx.x);
        EpiMerge E{F.PROJ, (unsigned char*)F.MRG, 1.0f / (S_YB * S_WB), (S_YB * S_WB) / (S_YA * S_WA)};
        pg8::gemm_phase<EpiMerge, pg8::StaticOrder, true, 1>(F.lds + RING_OFF, g, S, E);
        REP(6) { xcd_barrier(bar); pg8::gemm_phase<EpiMerge, pg8::StaticOrder, true, 1>(F.lds + RING_OFF, g, S, E); } } SEAM(6);
    if (IN(7)) { pg8::Gemm g{F.MRG, F.WOUT, M, DM, DM, DM, DM}; pg8::StaticOrder S; S.init(M, DM, F.G, (int)blockIdx.x); EpiResid<false, true> E{F.x, F.MOD + 2 * DM, F.X1, 1.0f / (S_MRG * S_WOUT)};
        pg8::gemm_phase<EpiResid<false, true>, pg8::StaticOrder, true, 1>(F.lds + RING_OFF, g, S, E);
        REP(7) { xcd_barrier(bar); pg8::gemm_phase<EpiResid<false, true>, pg8::StaticOrder, true, 1>(F.lds + RING_OFF, g, S, E); } } SEAM(7);
    if (IN(8)) { norm_rows<1, true>(F, F.X1, F.n2g, 3 * DM, 4 * DM, F.H); REP(8) { xcd_barrier(bar); norm_rows<1, true>(F, F.X1, F.n2g, 3 * DM, 4 * DM, F.H); } } SEAM(8);
    if (IN(9)) { pg8::Gemm g{F.H, F.WUP, M, F2, DM, DM, DM}; pg8::StaticOrder S; S.init(M, F2, F.G, (int)blockIdx.x); EpiPlain E{(unsigned char*)F.A, F2, S_A / (S_H2 * S_WUP)};
        pg8::gemm_phase<EpiPlain, pg8::StaticOrder, true, 1>(F.lds + RING_OFF, g, S, E);
        if (F.G == 256 && blockIdx.x >= 192) { const int first = ((int)blockIdx.x - 192) * 56;
            tr_run<3>(F, first + F.wave, first + 56, NWAVES, (LAS float*)(F.lds + RING_OFF + F.wave * 16384)); }
        REP(9) { xcd_barrier(bar); pg8::gemm_phase<EpiPlain, pg8::StaticOrder, true, 1>(F.lds + RING_OFF, g, S, E); } } SEAM(9);
    if (IN(10)) { conv_phase(F); REP(10) { xcd_barrier(bar); conv_phase(F); } } SEAM(10);
    if (IN(11)) { pg8::Gemm g{F.ACT, F.WDN, M, DM, DFF, DFF, DFF}; pg8::StaticOrder S; S.init(M, DM, F.G, (int)blockIdx.x); EpiResid<true, false> E{F.X1, F.MOD + 5 * DM, F.out, 1.0f / (S_ACT * S_WDN)};
        pg8::gemm_phase<EpiResid<true, false>, pg8::StaticOrder, true, 1>(F.lds + RING_OFF, g, S, E);
        REP(11) { xcd_barrier(bar); pg8::gemm_phase<EpiResid<true, false>, pg8::StaticOrder, true, 1>(F.lds + RING_OFF, g, S, E); } }
#undef REP
#undef IN
#undef SEAM
}

extern "C" void kernel_launch(void* const* d_in, const int* in_sizes, int n_in, void* d_out, int out_size, void* d_ws, size_t ws_size, hipStream_t stream) {
    static int grid = 0;
    if (grid == 0) {
        if (n_in != 19 || in_sizes[0] != M * DM || out_size != M * DM || ws_size < WS_END) { fprintf(stderr, "kernel_launch: unexpected shapes (n_in %d, in0 %d, out %d, ws %zu < %zu); nothing launched\n", n_in, n_in > 0 ? in_sizes[0] : -1, out_size, ws_size, (size_t)WS_END); grid = -1; return; }
        int dev = 0, cus = 0, per_cu = 0;
        if (hipGetDevice(&dev) != hipSuccess || hipDeviceGetAttribute(&cus, hipDeviceAttributeMultiprocessorCount, dev) != hipSuccess) { fprintf(stderr, "kernel_launch: device query failed\n"); grid = -1; return; }
        if (hipFuncSetAttribute((const void*)mega_fwd, hipFuncAttributeMaxDynamicSharedMemorySize, LDS_BYTES) != hipSuccess) { fprintf(stderr, "kernel_launch: hipFuncSetAttribute failed\n"); grid = -1; return; }
        if (hipOccupancyMaxActiveBlocksPerMultiprocessor(&per_cu, (const void*)mega_fwd, NWAVES * 64, LDS_BYTES) != hipSuccess || per_cu < 1) { fprintf(stderr, "kernel_launch: occupancy query reports %d blocks per CU\n", per_cu); }
        (void)hipGetLastError();
        grid = cus;
    }
    if (grid < 0) return;
    if (hipMemsetAsync((char*)d_ws + WS_CTL, 0, CTL_ZERO_BYTES, stream) != hipSuccess) { fprintf(stderr, "kernel_launch: memset failed\n"); return; }
    Args a{};
    for (int i = 0; i < 19; ++i) a.in[i] = (const float*)d_in[i];
    a.out = (float*)d_out; a.ws = (unsigned char*)d_ws; a.pad = 0;
    for (int li = 0; li < MK_N_LAUNCHES; ++li) {
        if (MK_N_LAUNCHES == 1) { a.ph_lo = 0; a.ph_hi = N_PHASES; } else { a.ph_lo = li; a.ph_hi = li + 1; }
        a.li = li;
        hipLaunchKernelGGL(mega_fwd, dim3(grid), dim3(NWAVES * 64), LDS_BYTES, stream, a);
        const hipError_t le = hipPeekAtLastError();
        if (le != hipSuccess) { fprintf(stderr, "kernel_launch: launch %d failed: %s\n", li, hipGetErrorName(le)); break; }
    }
}
```

```cpp
#include <hip/hip_runtime.h>
#include <cstdio>
#include <cstdint>

#ifndef MK_N_LAUNCHES
#define MK_N_LAUNCHES 1
#endif
#ifndef PROBE_MASK
#define PROBE_MASK 0x0
#endif

namespace pg8 {
#define PG8_LAS __attribute__((address_space(3)))
typedef unsigned short bf16_t;
typedef short bf16x8 __attribute__((ext_vector_type(8)));
typedef float f32x4 __attribute__((ext_vector_type(4)));
typedef float f32x2 __attribute__((ext_vector_type(2)));
typedef unsigned u32x4 __attribute__((ext_vector_type(4)));
typedef unsigned u32x2 __attribute__((ext_vector_type(2)));
constexpr int BM = 256, BK = 64, HALF = 128, HTB = HALF * BK * 2, STAGE_BYTES = 8 * HTB, NXCD = 8, WGM = 8;

__host__ __device__ __forceinline__ int lds_byte(int r, int c) { const int rr = r & 7, ch = c >> 3; return (r >> 3) * 1024 + (16 * ((rr >> 2) + 2 * (ch >> 2)) + 4 * (rr & 3) + ((ch ^ (2 * (rr >> 2))) & 3)) * 16; }
__host__ __device__ __forceinline__ void stage_rc(int b, int& R, int& C) { const int pc = b >> 10, p = (b & 1023) >> 4, q = p >> 4, bb = p & 15, rr = (q & 1) * 4 + (bb >> 2), ch = (q >> 1) * 4 + ((bb & 3) ^ (2 * (q & 1))); R = pc * 8 + rr; C = ch * 8; }
__host__ __device__ __forceinline__ int perm32(int rho) { const int n = rho >> 4, i = rho & 15; return 8 * (i >> 2) + 4 * n + (i & 3); }

struct Unit { int pm, pn; };
struct Gemm { const bf16_t* A; const bf16_t* Bt; int M, N, K, lda, ldb; };

struct StaticOrder {
    int nM, nN, nwg, G, c;
    __host__ __device__ void init(int M, int N, int G_, int c_) { nM = M / BM; nN = N / BM; nwg = nM * nN; G = G_; c = c_; }
    __host__ __device__ bool next(int i, Unit& u) const {
        const long L = (long)i * G + c; if (L >= nwg) return false;
        int wgid = (int)L; { const int q = nwg / NXCD, r = nwg % NXCD, xcd = wgid % NXCD, off = wgid / NXCD; wgid = (xcd < r ? xcd * (q + 1) : r * (q + 1) + (xcd - r) * q) + off; }
        const int nig = WGM * nN, gid = wgid / nig, fm = gid * WGM, gsz = (nM - fm) < WGM ? (nM - fm) : WGM;
        u.pm = fm + ((wgid % nig) % gsz); u.pn = (wgid % nig) / gsz; return true;
    }
    __device__ __forceinline__ void a_ready(const Unit&) const {}
    __device__ __forceinline__ void done(const Unit&) const {}
};
struct MixOrder {
    int fp8, G, c;
    __host__ __device__ static void map(int L, int nwg, int nN, Unit& u) {
        int wgid = L; { const int q = nwg / NXCD, r = nwg % NXCD, xcd = wgid % NXCD, off = wgid / NXCD; wgid = (xcd < r ? xcd * (q + 1) : r * (q + 1) + (xcd - r) * q) + off; }
        const int nig = WGM * nN; u.pm = (wgid / nig) * WGM + ((wgid % nig) % WGM); u.pn = (wgid % nig) / WGM;
    }
    __host__ __device__ bool next(int i, Unit& u) const {
        int L;
        if (!fp8) { L = i * G + c; if (L >= 288) return false; map(L, 288, 9, u); u.pn = u.pn < 8 ? 12 + u.pn : 68; return true; }
        if (G == 256) { if (c >= 32) { if (i >= 8) return false; L = i * 224 + (c - 32); } else { if (i >= 4) return false; L = 1792 + 4 * c + i; } }
        else { L = i * G + c; if (L >= 1920) return false; }
        map(L, 1920, 60, u); u.pn = u.pn < 12 ? u.pn : u.pn + 8; return true;
    }
    __device__ __forceinline__ void a_ready(const Unit&) const {}
    __device__ __forceinline__ void done(const Unit&) const {}
};

__device__ __forceinline__ unsigned cvt_pk_bf16(float lo, float hi) { unsigned r; asm volatile("v_cvt_pk_bf16_f32 %0, %1, %2" : "=v"(r) : "v"(lo), "v"(hi)); return r; }
__device__ __forceinline__ f32x2 gelu_pk(f32x2 v) {
    const f32x2 av = __builtin_elementwise_abs(v), d = av * 0.2316418882f + 1.0f;
    f32x2 t; t.x = __builtin_amdgcn_rcpf(d.x); t.y = __builtin_amdgcn_rcpf(d.y);
    f32x2 q = t * 0.5307027145f + (-0.7265760135f); q = q * t + 0.7107068705f; q = q * t + (-0.142248368f); q = q * t + 0.127414796f; q = q * t;
    const f32x2 s = (v * v) * (-0.72134752044f);
    f32x2 e; e.x = __builtin_amdgcn_exp2f(s.x); e.y = __builtin_amdgcn_exp2f(s.y);
    const f32x2 m = v * (q * e), r = v - m;
    f32x2 o; o.x = v.x < 0.f ? m.x : r.x; o.y = v.y < 0.f ? m.y : r.y; return o;
}
__device__ __forceinline__ float sigmoidf_(float x) { return __builtin_amdgcn_rcpf(1.0f + __builtin_amdgcn_exp2f(-1.4426950408889634f * x)); }
__device__ __forceinline__ float bflo(unsigned w) { return __builtin_bit_cast(float, w << 16); }
__device__ __forceinline__ float bfhi(unsigned w) { return __builtin_bit_cast(float, w & 0xffff0000u); }

typedef int i32x8 __attribute__((ext_vector_type(8)));
typedef int i32x4 __attribute__((ext_vector_type(4)));
template <class Epi, class Sched, bool ALIGN_EPI, int ES = 2>
__device__ __forceinline__ void gemm_phase(PG8_LAS unsigned char* lds, const Gemm g, const Sched& S, const Epi& E) {
    const int tid = threadIdx.x, wid = __builtin_amdgcn_readfirstlane(tid >> 6), lane = tid & 63, wr = wid >> 2, wc = wid & 3, fr = lane & 15, fq = lane >> 4;
    const int K = g.K, nt = K * ES / (BK * 2);
    unsigned voffA[2], voffB[2];
#pragma unroll
    for (int i = 0; i < 2; ++i) { int R, C; stage_rc(tid * 16 + i * 8192, R, C); const int Rb = Epi::PERM ? ((R & ~31) + perm32(R & 31)) : R;
        voffA[i] = (unsigned)(R * g.lda) * (unsigned)ES + (unsigned)C * 2u; voffB[i] = (unsigned)(Rb * g.ldb) * (unsigned)ES + (unsigned)C * 2u; }
    const size_t kstep = (size_t)(BK * 2);
    const size_t hstepA = (size_t)HALF * g.lda * ES, hstepB = (size_t)HALF * g.ldb * ES;
    const size_t tstepA = 2 * hstepA, tstepB = 2 * hstepB;
    const unsigned ldsw = (unsigned)wid * 1024u;
    const int aoff = lds_byte(wr * 64 + fr, fq * 8), boff = lds_byte(wc * 32 + fr, fq * 8);
#define PG8_SA(b, h) (((b) * 2 + (h)) * HTB)
#define PG8_SB(b, h) ((4 + (b) * 2 + (h)) * HTB)
#define PG8_STAGE(bufoff, gbase, voff) do { _Pragma("unroll") for (int _i = 0; _i < 2; ++_i) \
        __builtin_amdgcn_global_load_lds((const unsigned*)((const char*)(gbase) + (voff)[_i]), (PG8_LAS unsigned*)(lds + (bufoff) + ldsw + _i * 8192), 16, 0, 0); } while (0)
#define PG8_CAT(x, y) __builtin_shufflevector(x, y, 0, 1, 2, 3, 4, 5, 6, 7)
#define PG8_LO(v) __builtin_bit_cast(bf16x8, __builtin_shufflevector(v, v, 0, 1, 2, 3))
#define PG8_HI(v) __builtin_bit_cast(bf16x8, __builtin_shufflevector(v, v, 4, 5, 6, 7))
#define PG8_LDA(dst, b, h) do { _Pragma("unroll") for (int m = 0; m < 4; ++m) { const i32x4 _l = *(const PG8_LAS i32x4*)(lds + PG8_SA(b, h) + aoff + m * 2048), _h = *(const PG8_LAS i32x4*)(lds + PG8_SA(b, h) + aoff + m * 2048 + 512); dst[m] = PG8_CAT(_l, _h); } } while (0)
#define PG8_LDB(dst, b, h) do { _Pragma("unroll") for (int n = 0; n < 2; ++n) { const i32x4 _l = *(const PG8_LAS i32x4*)(lds + PG8_SB(b, h) + boff + n * 2048), _h = *(const PG8_LAS i32x4*)(lds + PG8_SB(b, h) + boff + n * 2048 + 512); dst[n] = PG8_CAT(_l, _h); } } while (0)
#define PG8_MMA(ai, bj, At, Bt) do { __builtin_amdgcn_s_setprio(1); _Pragma("unroll") for (int m = 0; m < 4; ++m) _Pragma("unroll") for (int n = 0; n < 2; ++n) { \
        if constexpr (ES == 2) { acc[ai][bj][m][n] = __builtin_amdgcn_mfma_f32_16x16x32_bf16(PG8_LO(Bt[n]), PG8_LO(At[m]), acc[ai][bj][m][n], 0, 0, 0); \
                                 acc[ai][bj][m][n] = __builtin_amdgcn_mfma_f32_16x16x32_bf16(PG8_HI(Bt[n]), PG8_HI(At[m]), acc[ai][bj][m][n], 0, 0, 0); } \
        else asm volatile("v_mfma_f32_16x16x128_f8f6f4 %0, %1, %2, %0" : "+v"(acc[ai][bj][m][n]) : "v"(Bt[n]), "v"(At[m])); } __builtin_amdgcn_s_setprio(0); } while (0)
#define PG8_WAIT_V(n) asm volatile("s_waitcnt vmcnt(" #n ")" ::: "memory")
#define PG8_WAIT_L(n) asm volatile("s_waitcnt lgkmcnt(" #n ")" ::: "memory")
#define PG8_BAR __builtin_amdgcn_s_barrier()
#define PG8_SCHED __builtin_amdgcn_sched_barrier(0)
    Unit cur, nxt; int ui = 0;
    if (!S.next(0, cur)) return;
    f32x4 acc[2][2][4][2];
#pragma unroll
    for (int a = 0; a < 2; ++a)
#pragma unroll
        for (int b = 0; b < 2; ++b)
#pragma unroll
            for (int m = 0; m < 4; ++m)
#pragma unroll
                for (int n = 0; n < 2; ++n) acc[a][b][m][n] = (f32x4){0.f, 0.f, 0.f, 0.f};
    i32x8 At[4], B0[2], B1[2];
    const char* cA = (const char*)g.A + (size_t)cur.pm * tstepA; const char* cB = (const char*)g.Bt + (size_t)cur.pn * tstepB;
    S.a_ready(cur);
    PG8_STAGE(PG8_SB(0, 0), cB, voffB); PG8_STAGE(PG8_SB(0, 1), cB + hstepB, voffB); PG8_STAGE(PG8_SA(0, 0), cA, voffA); PG8_STAGE(PG8_SA(0, 1), cA + hstepA, voffA);
    if (wr == 1) PG8_BAR;
    PG8_WAIT_V(2); PG8_BAR;
    PG8_STAGE(PG8_SB(1, 0), cB + kstep, voffB); PG8_STAGE(PG8_SA(1, 0), cA + kstep, voffA); PG8_STAGE(PG8_SB(1, 1), cB + hstepB + kstep, voffB);
    PG8_WAIT_V(6); PG8_BAR;
    for (;;) {
        const bool has_next = S.next(ui + 1, nxt);
        const char* nA = has_next ? (const char*)g.A + (size_t)nxt.pm * tstepA : cA; const char* nB = has_next ? (const char*)g.Bt + (size_t)nxt.pn * tstepB : cB;
        for (int t = 0; t < nt; t += 2) {
            const bool last = (t == nt - 2);
            const char* a1 = cA + (size_t)(t + 1) * kstep;
            const char* a2 = last ? nA : cA + (size_t)(t + 2) * kstep; const char* b2 = last ? nB : cB + (size_t)(t + 2) * kstep;
            const char* a3 = a2 + kstep; const char* b3 = b2 + kstep;
            if (last && has_next) S.a_ready(nxt);
            if constexpr (Epi::MIDK) { if (t == nt / 2) { if constexpr (ES == 1) asm volatile("s_nop 15\n\ts_nop 15" ::: "memory"); E.mid(acc, cur, wr, wc, fr, fq); } }
            PG8_LDB(B0, 0, 0); PG8_LDB(B1, 0, 1); PG8_SCHED; PG8_LDA(At, 0, 0); PG8_STAGE(PG8_SA(1, 1), a1 + hstepA, voffA);
            PG8_WAIT_V(8); PG8_WAIT_L(0); PG8_BAR; PG8_MMA(0, 0, At, B0); PG8_MMA(0, 1, At, B1); PG8_BAR; PG8_SCHED;
            PG8_LDA(At, 0, 1); PG8_STAGE(PG8_SB(0, 0), b2, voffB); PG8_STAGE(PG8_SB(0, 1), b2 + hstepB, voffB); PG8_STAGE(PG8_SA(0, 0), a2, voffA);
            PG8_WAIT_V(8); PG8_WAIT_L(0); PG8_BAR; PG8_MMA(1, 0, At, B0); PG8_MMA(1, 1, At, B1); PG8_BAR; PG8_SCHED;
            PG8_LDB(B0, 1, 0); PG8_LDB(B1, 1, 1); PG8_SCHED; PG8_LDA(At, 1, 0); PG8_STAGE(PG8_SA(0, 1), a2 + hstepA, voffA);
            PG8_WAIT_V(8); PG8_WAIT_L(0); PG8_BAR; PG8_MMA(0, 0, At, B0); PG8_MMA(0, 1, At, B1); PG8_BAR; PG8_SCHED;
            PG8_LDA(At, 1, 1); PG8_STAGE(PG8_SB(1, 0), b3, voffB); PG8_STAGE(PG8_SB(1, 1), b3 + hstepB, voffB); PG8_STAGE(PG8_SA(1, 0), a3, voffA);
            PG8_WAIT_V(8); PG8_WAIT_L(0); PG8_BAR; PG8_MMA(1, 0, At, B0); PG8_MMA(1, 1, At, B1); PG8_BAR; PG8_SCHED;
        }
        if constexpr (ALIGN_EPI) { if (wr == 0) PG8_BAR; }
        if constexpr (ES == 1) asm volatile("s_nop 15\n\ts_nop 15" ::: "memory");
        E(acc, cur, wr, wc, fr, fq); S.done(cur);
        if (!has_next) break;
#pragma unroll
        for (int a = 0; a < 2; ++a)
#pragma unroll
            for (int b = 0; b < 2; ++b)
#pragma unroll
                for (int m = 0; m < 4; ++m)
#pragma unroll
                    for (int n = 0; n < 2; ++n) acc[a][b][m][n] = (f32x4){0.f, 0.f, 0.f, 0.f};
        cur = nxt; cA = nA; cB = nB; ++ui;
        if constexpr (ALIGN_EPI) { if (wr == 1) PG8_BAR; }
    }
    PG8_WAIT_V(0);
    if constexpr (!ALIGN_EPI) { if (wr == 0) PG8_BAR; }
    PG8_BAR;
#undef PG8_SA
#undef PG8_SB
#undef PG8_STAGE
#undef PG8_LDA
#undef PG8_CAT
#undef PG8_LO
#undef PG8_HI
#undef PG8_LDB
#undef PG8_MMA
#undef PG8_WAIT_V
#undef PG8_WAIT_L
#undef PG8_BAR
#undef PG8_SCHED
}
}

constexpr int NWAVES = 8;
constexpr int BATCH = 4, SEQ = 2048, DM = 4096, M = BATCH * SEQ;
constexpr int NH = 16, HD = 128, NKV = 4, ATTW = 2048, KVW = 512, IH = 32, IDIM = 64, TOPK = 256;
constexpr int GMW = 2048, GMG = 8, GMGW = 256, GMC = 128, DFF = 11008, F2 = 2 * DFF;
constexpr int IN_W = 17504, MODW = 6 * DM;
constexpr float EPS = 1e-6f;
constexpr int PQ = 0, PK = 2048, PV = 2560, PQI = 3072, PGU = 5120, PGV = 7168, PGA = 9216, PGB = 13312, PKI = 17408, PWI = 17472, PNP = 17664;
constexpr int SQ = 0, SK = 2048, SV = 2560, SQI = 3072, SKI = 5120, SWI = 5184, SGU = 5216, SGV = 7264, SGA = 9312, SGB = 13408;

constexpr size_t MiB = 1u << 20;
constexpr size_t WS_CTL = 0, CTL_ZERO_BYTES = 2 * MiB;
constexpr size_t WS_MOD = 1 * MiB;
constexpr size_t WS_WIN = 2 * MiB;
constexpr size_t WS_WA = 140 * MiB, WS_WB = 156 * MiB;
constexpr size_t WS_WOUT = 172 * MiB;
constexpr size_t WS_WUP = 204 * MiB;
constexpr size_t WS_WDN = 376 * MiB;
constexpr size_t WS_H = 462 * MiB;
constexpr size_t WS_X1 = 526 * MiB;
constexpr size_t WS_PROJ = 654 * MiB;
constexpr size_t WS_MASK = 930 * MiB;
constexpr size_t WS_RS = 932 * MiB;
constexpr size_t WS_SWT = 932 * MiB + 65536;
constexpr size_t WS_VT = 933 * MiB;
constexpr size_t WS_YA = 941 * MiB, WS_YB = 973 * MiB;
constexpr size_t WS_MRG = 1005 * MiB;
constexpr size_t WS_TMP = 1069 * MiB;
constexpr size_t WS_A = 654 * MiB;
constexpr size_t WS_ACT = 998 * MiB;
constexpr size_t WS_WINB = 1197 * MiB;
constexpr size_t WS_END = 1336 * MiB;
static_assert(WS_WIN + (size_t)PNP * DM * 2 <= WS_WA && WS_WUP + (size_t)F2 * DM * 2 <= WS_WDN && WS_WDN + (size_t)DM * DFF * 2 <= WS_H, "ws map 1");
static_assert(WS_PROJ + (size_t)M * PNP * 2 <= WS_MASK && WS_A + (size_t)M * F2 * 2 <= WS_ACT && WS_ACT + (size_t)M * DFF * 2 <= WS_END && WS_TMP + (size_t)M * DM * 4 <= WS_END, "ws map 2");
constexpr int CW_TMO = 0, CW_CODE = 1, CW_BAR = 4096;

constexpr int RING_OFF = 0, RING_BYTES = 131072;
constexpr int LDSCTL_OFF = RING_BYTES + 8192, MISC_OFF = LDSCTL_OFF + 320;
constexpr int LDS_BYTES = 147456;
static_assert(MISC_OFF + 128 <= LDS_BYTES, "LDS map");

#define GAS __attribute__((address_space(1)))
#define LAS __attribute__((address_space(3)))
typedef unsigned short bf16;
typedef unsigned v4u __attribute__((ext_vector_type(4)));
typedef unsigned v2u __attribute__((ext_vector_type(2)));
typedef float f32x4 __attribute__((ext_vector_type(4)));
typedef float f32x16 __attribute__((ext_vector_type(16)));
typedef short bf16x8 __attribute__((ext_vector_type(8)));
typedef short bf16x4 __attribute__((ext_vector_type(4)));
typedef GAS unsigned gu32;
#define RLX_AGENT __ATOMIC_RELAXED, __HIP_MEMORY_SCOPE_AGENT
#define LDS_WAIT() asm volatile("s_waitcnt lgkmcnt(0)" ::: "memory")
#define VM_WAIT() asm volatile("s_waitcnt vmcnt(0)" ::: "memory")
__device__ __forceinline__ unsigned f2bf(float f) { unsigned u = __builtin_bit_cast(unsigned, f); return (u + 0x7fffu + ((u >> 16) & 1u)) >> 16; }
__device__ __forceinline__ unsigned pk2(float lo, float hi) { return pg8::cvt_pk_bf16(lo, hi); }
__device__ __forceinline__ float bf2f(bf16 h) { return __builtin_bit_cast(float, (unsigned)h << 16); }
using pg8::bflo; using pg8::bfhi;
constexpr float S_H2 = 16.f, S_WUP = 1024.f, S_ACT = 4.f, S_WDN = 1024.f, S_A = 16.f, S_YA = 16.f, S_YB = 8.f, S_MRG = 16.f, S_WA = 1024.f, S_WB = 1024.f, S_WOUT = 1024.f;
__device__ __forceinline__ float clamp448(float x) { return __builtin_amdgcn_fmed3f(x, -448.f, 448.f); }
__device__ __forceinline__ unsigned pk4_fp8(float a, float b, float c, float d) {
    int w = __builtin_amdgcn_cvt_pk_fp8_f32(clamp448(a), clamp448(b), 0, false);
    w = __builtin_amdgcn_cvt_pk_fp8_f32(clamp448(c), clamp448(d), w, true);
    return (unsigned)w;
}

#define XB_TMO      128
#define XB_XCNT(j)  (256  + 64 * (j))
#define XB_XSUB(j)  (1280 + 64 * (j))
#define XB_XGEN(j)  (2304 + 64 * (j))
#define XB_TOP      3328
#define XB_TOPGEN   3392
#define XCD_BAR_WORDS 3456
#define XB_SPIN_CAP (1u << 18)
__device__ __forceinline__ unsigned xb_ld(unsigned* p)              { return __hip_atomic_load(p, __ATOMIC_RELAXED, __HIP_MEMORY_SCOPE_AGENT); }
__device__ __forceinline__ unsigned xb_add(unsigned* p, unsigned v) { return __hip_atomic_fetch_add(p, v, __ATOMIC_RELAXED, __HIP_MEMORY_SCOPE_AGENT); }
__device__ __forceinline__ unsigned xb_xcc_id() { return (unsigned)__builtin_amdgcn_s_getreg((3 << 11) | 20) & 0xFu; }
#define XB_SPIN(cond, bar) do { unsigned _sp = 0; while (cond) { __builtin_amdgcn_s_sleep(1); \
    if ((++_sp & 255u) == 0u) { if (xb_ld(&(bar)[XB_TMO])) break; if (_sp > XB_SPIN_CAP) { atomicAdd(&(bar)[XB_TMO], 1u); break; } } } } while (0)
struct XcdBarrier { unsigned* bar; unsigned x; volatile LAS unsigned* st; };
__device__ __forceinline__ XcdBarrier xcd_barrier_post(unsigned* bar, volatile LAS unsigned* st) {
    XcdBarrier b; b.bar = bar; b.x = xb_xcc_id(); b.st = st;
    if (threadIdx.x == 0) (void)xb_add(&bar[XB_XCNT(b.x)], 1u);
    return b;
}
__device__ __forceinline__ void xcd_barrier_complete(unsigned* bar, unsigned x, unsigned& nloc, unsigned& nx) {
    const unsigned G = gridDim.x * gridDim.y * gridDim.z;
    unsigned sum, cnt, mine, sp = 0u;
    for (;;) {
        sum = 0u; cnt = 0u; mine = 0u;
#pragma unroll
        for (unsigned j = 0; j < 16; ++j) { const unsigned c = xb_ld(&bar[XB_XCNT(j)]); sum += c; cnt += (c > 0u) ? 1u : 0u; mine = (j == x) ? c : mine; }
        if (sum == G) break;
        __builtin_amdgcn_s_sleep(1);
        if ((++sp & 255u) == 0u) { if (xb_ld(&bar[XB_TMO])) break; if (sp > XB_SPIN_CAP) { atomicAdd(&bar[XB_TMO], 1u); break; } }
    }
    nloc = mine > 0u ? mine : 1u; nx = cnt > 0u ? cnt : 1u;
}
__device__ __forceinline__ void xcd_barrier(const XcdBarrier& b) {
    asm volatile("s_waitcnt vmcnt(0)" ::: "memory");
    __syncthreads();
    if (threadIdx.x == 0) {
        unsigned* bar = b.bar;
        __builtin_amdgcn_s_waitcnt(0);
        unsigned nloc = b.st[0], nx = b.st[1];
        if (nloc == 0u) { xcd_barrier_complete(bar, b.x, nloc, nx); b.st[0] = nloc; b.st[1] = nx; }
        const unsigned old = xb_add(&bar[XB_XSUB(b.x)], 1u);
        const unsigned gen = old / nloc;
        if (old + 1u == (gen + 1u) * nloc) {
            __builtin_amdgcn_fence(__ATOMIC_RELEASE, "agent");
            asm volatile("s_waitcnt vmcnt(0)" ::: "memory");
            const unsigned og = xb_add(&bar[XB_TOP], 1u);
            const unsigned tg = og / nx;
            if (og + 1u == (tg + 1u) * nx) xb_add(&bar[XB_TOPGEN], 1u);
            else XB_SPIN(xb_ld(&bar[XB_TOPGEN]) == tg, bar);
            __builtin_amdgcn_fence(__ATOMIC_ACQUIRE, "agent");
            xb_add(&bar[XB_XGEN(b.x)], 1u);
            asm volatile("s_waitcnt vmcnt(0)" ::: "memory");
        } else {
            XB_SPIN(xb_ld(&bar[XB_XGEN(b.x)]) == gen, bar);
            __builtin_amdgcn_fence(__ATOMIC_ACQUIRE, "agent");
            asm volatile("s_waitcnt vmcnt(0)" ::: "memory");
        }
    }
    __syncthreads();
}

struct Frame {
    LAS unsigned char* lds;
    volatile LAS unsigned* MISC;
    gu32* ctl;
    int tid, lane, wave, G, gw, NGW;
    const float *x, *c, *ada_w, *ada_b, *n1g, *w_in, *qng, *kng, *sgg, *sgw, *sgb, *w_a, *w_b, *w_out, *n2g, *w_up, *cvw, *cvb, *w_dn;
    float* out;
    float *MOD, *PART; bf16 *WINB; unsigned char* H8A; bf16 *WIN, *WA, *WB, *WOUT, *WUP, *WDN, *H, *PROJ, *VT, *YA, *YB, *MRG, *A, *ACT; float *X1, *TMP, *RS, *SWT; unsigned* MASK;
};
__device__ __forceinline__ void xor32_pair(float x, float& lo, float& hi) {
    float a = x, b = x; asm volatile("s_nop 1\n\tv_permlane32_swap_b32 %0, %1" : "+v"(a), "+v"(b)); lo = a; hi = b; }
__device__ __forceinline__ float xor32_sum(float x) { float lo, hi; xor32_pair(x, lo, hi); return lo + hi; }
__device__ __forceinline__ float xor32_max(float x) { float lo, hi; xor32_pair(x, lo, hi); return fmaxf(lo, hi); }
__device__ __forceinline__ float wave_sum(float v) {
#pragma unroll
    for (int o = 1; o < 32; o <<= 1) v += __shfl_xor(v, o);
    v = xor32_sum(v);
    return v;
}

__device__ __forceinline__ int win_dst_row(int n) {
    if (n < SKI) return n;
    if (n < SWI) return PKI + (n - SKI);
    if (n < SGU) return PWI + (n - SWI);
    return PGU + (n - SGU);
}
__device__ __forceinline__ void gemv_item(Frame& F, int item) {
    const int nb = item % 96, ks = item / 96, n0 = nb * 256 + 4 * F.lane, k0 = ks * 64;
    float cs[4];
#pragma unroll
    for (int b = 0; b < 4; ++b) { const float cv = F.c[b * DM + k0 + F.lane]; cs[b] = cv * pg8::sigmoidf_(cv); }
    f32x4 acc[4];
#pragma unroll
    for (int b = 0; b < 4; ++b) acc[b] = (f32x4){0.f, 0.f, 0.f, 0.f};
    const float* wp = F.ada_w + (size_t)k0 * MODW + n0;
#pragma unroll 16
    for (int k = 0; k < 64; ++k) { const f32x4 w = *(const GAS f32x4*)(wp + (size_t)k * MODW);
#pragma unroll
        for (int b = 0; b < 4; ++b) { const float s = __builtin_bit_cast(float, __builtin_amdgcn_readlane(__builtin_bit_cast(int, cs[b]), k)); acc[b] += w * s; } }
#pragma unroll
    for (int b = 0; b < 4; ++b) *(GAS f32x4*)(F.PART + (size_t)(ks * 4 + b) * MODW + n0) = acc[b];
}
__device__ __forceinline__ void mod_reduce(Frame& F) {
    for (int i = F.gw * 64 + F.lane; i < 4 * (MODW / 4); i += F.NGW * 64) { const int b = i / (MODW / 4), n0 = 4 * (i % (MODW / 4));
        f32x4 a = *(const GAS f32x4*)(F.ada_b + n0);
#pragma unroll 16
        for (int ks = 0; ks < 64; ++ks) a += *(const GAS f32x4*)(F.PART + (size_t)(ks * 4 + b) * MODW + n0);
        *(GAS f32x4*)(F.MOD + b * MODW + n0) = a; }
}
struct TrItem { const float* src; unsigned char* d8; bf16* db; int Nsrc, ldk, drow0, k0; float scale; };
__device__ __forceinline__ void tr_decode(Frame& F, int r, TrItem& t) {
    constexpr int P_IN = (DM / 128) * (IN_W / 32), P_A = (ATTW / 128) * (DM / 32), P_B = (GMW / 128) * (DM / 32), P_O = (DM / 128) * (DM / 32), P_UP = (DM / 128) * (F2 / 32);
    const float* W; int Nsrc, nblk, ldk, drow; unsigned char* d8; bf16* db = nullptr; float sc; bool up = false, in = false;
    if (r < P_IN) { W = F.w_in; Nsrc = IN_W; nblk = IN_W / 32; d8 = (unsigned char*)F.WIN; ldk = DM; sc = 1024.f; in = true; }
    else if ((r -= P_IN) < P_A) { W = F.w_a; Nsrc = DM; nblk = DM / 32; d8 = (unsigned char*)F.WA; ldk = 2 * ATTW; sc = S_WA; }
    else if ((r -= P_A) < P_B) { W = F.w_b; Nsrc = DM; nblk = DM / 32; d8 = (unsigned char*)F.WA + ATTW; ldk = 2 * ATTW; sc = S_WB; }
    else if ((r -= P_B) < P_O) { W = F.w_out; Nsrc = DM; nblk = DM / 32; d8 = (unsigned char*)F.WOUT; ldk = DM; sc = S_WOUT; }
    else if ((r -= P_O) < P_UP) { W = F.w_up; Nsrc = F2; nblk = F2 / 32; d8 = (unsigned char*)F.WUP; ldk = DM; sc = S_WUP; up = true; }
    else { r -= P_UP; W = F.w_dn; Nsrc = DM; nblk = DM / 32; d8 = (unsigned char*)F.WDN; ldk = DFF; sc = S_WDN; }
    const int kb = r / nblk, n = 32 * (r % nblk);
    drow = n;
    if (in) { drow = win_dst_row(n); if (n >= SQI && n < SGU) db = F.WINB; }
    if (up) { const int ch = n < DFF ? n : n - DFF; drow = (ch >> 7) * 256 + (ch & 127) + (n < DFF ? 0 : 128); }
    t.src = W + (size_t)(128 * kb) * Nsrc + n; t.d8 = d8; t.db = db; t.Nsrc = Nsrc; t.ldk = ldk; t.drow0 = drow; t.k0 = 128 * kb; t.scale = sc;
}
__device__ __forceinline__ void tr_load(const TrItem& t, int half, f32x4 (&v)[8], int lane) {
    const float* p = t.src + (size_t)(64 * half + (lane >> 3)) * t.Nsrc + 4 * (lane & 7);
#pragma unroll
    for (int i = 0; i < 8; ++i) v[i] = *(const GAS f32x4*)(p + (size_t)(8 * i) * t.Nsrc);
}
__device__ __forceinline__ void tr_finish(const TrItem& t, int half, const f32x4 (&v)[8], LAS float* scr, int lane) {
#pragma unroll
    for (int i = 0; i < 8; ++i) { LAS float* s = scr + (8 * i + (lane >> 3)) * 33 + 4 * (lane & 7); s[0] = v[i].x; s[1] = v[i].y; s[2] = v[i].z; s[3] = v[i].w; }
    LDS_WAIT(); asm volatile("" ::: "memory");
    const int c = lane & 7, kcol = t.k0 + 64 * half + 8 * c; const float sc = t.scale;
#pragma unroll
    for (int j = 0; j < 4; ++j) { const int n = (lane >> 3) + 8 * j; const LAS float* s = scr + (8 * c) * 33 + n;
        const float e0 = s[0 * 33], e1 = s[1 * 33], e2 = s[2 * 33], e3 = s[3 * 33], e4 = s[4 * 33], e5 = s[5 * 33], e6 = s[6 * 33], e7 = s[7 * 33];
        v2u o; o.x = pk4_fp8(e0 * sc, e1 * sc, e2 * sc, e3 * sc); o.y = pk4_fp8(e4 * sc, e5 * sc, e6 * sc, e7 * sc);
        *(GAS v2u*)(t.d8 + (size_t)(t.drow0 + n) * t.ldk + kcol) = o;
        if (t.db) { v4u ob; ob.x = pk2(e0, e1); ob.y = pk2(e2, e3); ob.z = pk2(e4, e5); ob.w = pk2(e6, e7); *(GAS v4u*)(t.db + (size_t)(t.drow0 + n) * t.ldk + kcol) = ob; } }
    LDS_WAIT(); asm volatile("" ::: "memory");
}
constexpr int TR_P_IN = (DM / 128) * (IN_W / 32), TR_P_A = (ATTW / 128) * (DM / 32), TR_P_B = (GMW / 128) * (DM / 32), TR_P_O = (DM / 128) * (DM / 32), TR_P_UP = (DM / 128) * (F2 / 32), TR_P_DN = (DFF / 128) * (DM / 32);
constexpr int TR_OUT0 = TR_P_IN + TR_P_A + TR_P_B, TR_UP0 = TR_OUT0 + TR_P_O, TR_DN0 = TR_UP0 + TR_P_UP, TR_ALL = TR_DN0 + TR_P_DN;
constexpr int TR_AB_EARLY = 3072, TR_B_LATE = TR_P_A + TR_P_B - TR_AB_EARLY;
constexpr int TR_DN_LATE = 3584;
template <int LIST> __device__ __forceinline__ int tr_map(int v) {
    if (LIST == 1) return v < TR_P_IN ? v : (v < TR_P_IN + TR_B_LATE ? v + TR_AB_EARLY : TR_UP0 + (v - TR_P_IN - TR_B_LATE));
    if (LIST == 4) return TR_P_IN + v;
    if (LIST == 2) return v < TR_P_O ? TR_OUT0 + v : TR_DN0 + (v - TR_P_O);
    if (LIST == 3) return TR_ALL - TR_DN_LATE + v;
    return v;
}
template <int LIST> __device__ __forceinline__ void tr_run(Frame& F, int r0, int rend, int stride, LAS float* scr) {
    TrItem A, B; f32x4 a0[8], a1[8], b0[8], b1[8];
    int r = r0; bool hasA = r < rend;
    if (hasA) { tr_decode(F, tr_map<LIST>(r), A); tr_load(A, 0, a0, F.lane); tr_load(A, 1, a1, F.lane); }
    while (hasA) {
        const int rb = r + stride; const bool hasB = rb < rend;
        if (hasB) { tr_decode(F, tr_map<LIST>(rb), B); tr_load(B, 0, b0, F.lane); tr_load(B, 1, b1, F.lane); }
        tr_finish(A, 0, a0, scr, F.lane); tr_finish(A, 1, a1, scr, F.lane);
        if (!hasB) break;
        r = rb + stride; hasA = r < rend;
        if (hasA) { tr_decode(F, tr_map<LIST>(r), A); tr_load(A, 0, a0, F.lane); tr_load(A, 1, a1, F.lane); }
        tr_finish(B, 0, b0, scr, F.lane); tr_finish(B, 1, b1, scr, F.lane);
    }
}
__device__ __forceinline__ void p0_prologue(Frame& F, bool with_gemv = true) {
    LAS float* scr = (LAS float*)(F.lds + RING_OFF + F.wave * 16384);
    constexpr int I_GV = 96 * 64;
    if (with_gemv) for (int it = F.gw; it < I_GV; it += F.NGW) gemv_item(F, it);
    if (F.G == 256) tr_run<1>(F, F.gw, TR_P_IN + TR_B_LATE + TR_P_UP, F.NGW, scr); else tr_run<0>(F, F.gw, TR_ALL, F.NGW, scr);
    { const size_t n16 = (size_t)(PNP - IN_W) * DM / 16; GAS v4u* p = (GAS v4u*)((unsigned char*)F.WIN + (size_t)IN_W * DM);
      for (size_t i = (size_t)F.gw * 64 + F.lane; i < n16; i += (size_t)F.NGW * 64) p[i] = (v4u){0u, 0u, 0u, 0u};
      GAS v4u* pb = (GAS v4u*)(F.WINB + (size_t)IN_W * DM);
      for (size_t i = (size_t)F.gw * 64 + F.lane; i < 2 * n16; i += (size_t)F.NGW * 64) pb[i] = (v4u){0u, 0u, 0u, 0u}; }
}

template <int FP8 = 0, bool XBF = false>
__device__ __forceinline__ void norm_rows(Frame& F, const void* X, const float* gain, int sh_off, int sc_off, void* Ov, unsigned char* O8 = nullptr) {
    LAS f32x4* CA = (LAS f32x4*)F.lds; LAS f32x4* CB = (LAS f32x4*)(F.lds + 16384);
    for (int blk = blockIdx.x; blk < M / 32; blk += F.G) {
        const int b = (blk * 32) >> 11;
        __syncthreads();
        for (int i = F.tid; i < DM / 4; i += NWAVES * 64) { const f32x4 g = ((const GAS f32x4*)gain)[i], sh = ((const GAS f32x4*)(F.MOD + b * MODW + sh_off))[i], sc = ((const GAS f32x4*)(F.MOD + b * MODW + sc_off))[i];
            CA[i] = g * (sc + 1.0f); CB[i] = sh; }
        __syncthreads();
        const int m0 = blk * 32 + 4 * F.wave;
        f32x4 va[16], vb[16];
#define NR_LOAD(v, m_) do { if constexpr (XBF) { const GAS v2u* xr = (const GAS v2u*)((const bf16*)X + (size_t)(m_) * DM) + F.lane; _Pragma("unroll") for (int j = 0; j < 16; ++j) { const v2u w_ = xr[64 * j]; v[j] = (f32x4){bflo(w_.x), bfhi(w_.x), bflo(w_.y), bfhi(w_.y)}; } } \
        else { const GAS f32x4* xr = (const GAS f32x4*)((const float*)X + (size_t)(m_) * DM) + F.lane; _Pragma("unroll") for (int j = 0; j < 16; ++j) v[j] = xr[64 * j]; } } while (0)
#define NR_FIN(v, m_) do { float s_ = 0.f; _Pragma("unroll") for (int j = 0; j < 16; ++j) s_ += (v[j].x * v[j].x + v[j].y * v[j].y) + (v[j].z * v[j].z + v[j].w * v[j].w); \
            const float rstd = 1.0f / sqrtf(wave_sum(s_) * (1.f / DM) + EPS); \
            GAS v2u* o8 = (GAS v2u*)((bf16*)Ov + (size_t)(m_) * DM) + F.lane; GAS unsigned* o4 = (GAS unsigned*)((FP8 == 2 ? O8 : (unsigned char*)Ov) + (size_t)(m_) * DM) + F.lane; \
            _Pragma("unroll") for (int j = 0; j < 16; ++j) { const f32x4 y = (v[j] * rstd) * CA[64 * j + F.lane] + CB[64 * j + F.lane]; \
                if constexpr (FP8 != 0) o4[64 * j] = pk4_fp8(y.x * S_H2, y.y * S_H2, y.z * S_H2, y.w * S_H2); \
                if constexpr (FP8 != 1) { v2u w_; w_.x = pk2(y.x, y.y); w_.y = pk2(y.z, y.w); o8[64 * j] = w_; } \
                if ((j & 3) == 3) asm volatile("" ::: "memory"); } } while (0)
        NR_LOAD(va, m0); NR_LOAD(vb, m0 + 1); NR_FIN(va, m0); NR_LOAD(va, m0 + 2); NR_FIN(vb, m0 + 1); NR_LOAD(vb, m0 + 3); NR_FIN(va, m0 + 2); NR_FIN(vb, m0 + 3);
#undef NR_LOAD
#undef NR_FIN
    }
}

__device__ __forceinline__ unsigned sortable(float f) { const unsigned u = __builtin_bit_cast(unsigned, f); return u ^ ((unsigned)((int)u >> 31) | 0x80000000u); }
__device__ __forceinline__ void select_topk(const unsigned (&sc)[32], GAS v2u* mrow, int lane) {
    unsigned thr = 0u;
    for (int bit = 31; bit >= 0; --bit) {
        const unsigned cand = thr | (1u << bit); unsigned c = 0u;
#pragma unroll
        for (int jp = 0; jp < 32; ++jp) c += (sc[jp] >= cand) ? 1u : 0u;
#pragma unroll
        for (int o = 1; o < 32; o <<= 1) c += __shfl_xor(c, o);
        { float lo, hi2; xor32_pair(__builtin_bit_cast(float, c), lo, hi2); c = __builtin_bit_cast(unsigned, lo) + __builtin_bit_cast(unsigned, hi2); }
        if (c >= (unsigned)TOPK) thr = cand;
    }
    thr = (unsigned)__builtin_amdgcn_readfirstlane((int)thr);
    int cgt = 0;
#pragma unroll
    for (int jp = 0; jp < 32; ++jp) cgt += __popcll(__ballot(sc[jp] > thr));
    const int need = TOPK - cgt; int seen = 0;
    unsigned mylo = 0u, myhi = 0u;
    const unsigned long long lt = (lane == 0) ? 0ull : (~0ull >> (64 - lane));
#pragma unroll
    for (int jp = 0; jp < 32; ++jp) {
        unsigned long long sel = __ballot(sc[jp] > thr);
        const unsigned long long eq = __ballot(sc[jp] == thr);
        if (eq) { const bool take = (sc[jp] == thr) && (seen + __popcll(eq & lt) < need); sel |= __ballot(take); seen += __popcll(eq); }
        if (lane == jp) { mylo = (unsigned)sel; myhi = (unsigned)(sel >> 32); }
    }
    if (lane < 32) { v2u w; w.x = mylo; w.y = myhi; mrow[lane] = w; }
}
__device__ __forceinline__ void idx_block(Frame& F, int b, int blk) {
    const int lane = F.lane, w = F.wave, hi = lane >> 5, l31 = lane & 31, tid = F.tid;
    const int t0 = blk * 8, tq = t0 + w;
    const size_t row = (size_t)b * SEQ + tq;
    GAS v2u* mrow = (GAS v2u*)(F.MASK + row * 64);
    if (t0 < TOPK) {
        if (lane < 32) { const int k0 = 64 * lane; v2u mw;
            mw.x = (tq >= k0 + 31) ? 0xffffffffu : (tq < k0 ? 0u : ((2u << (tq - k0)) - 1u));
            mw.y = (tq >= k0 + 63) ? 0xffffffffu : (tq < k0 + 32 ? 0u : ((2u << (tq - k0 - 32)) - 1u));
            mrow[lane] = mw; }
        return;
    }
    const int nt = (t0 + 7) / 128 + 1;
    const bf16* prow = F.PROJ + row * PNP;
    bf16x8 qa[4]; float wv[16];
#pragma unroll
    for (int ks = 0; ks < 4; ++ks) qa[ks] = *(const GAS bf16x8*)(prow + PQI + l31 * 64 + 16 * ks + 8 * hi);
#pragma unroll
    for (int r = 0; r < 16; ++r) wv[r] = bf2f(prow[PWI + (r & 3) + 8 * (r >> 2) + 4 * hi]);
    const bf16* ksrc = F.PROJ + ((size_t)b * SEQ + (tid >> 3)) * PNP + PKI + 8 * (tid & 7);
    const int kdst = (tid >> 3) * 128 + (((tid & 7) ^ ((tid >> 3) & 7)) << 4);
    const int krd = l31 * 128;
    unsigned sc[32];
    __syncthreads();
    v4u stg[3][2];
#pragma unroll
    for (int i = 0; i < 3; ++i) if (i < nt) { stg[i][0] = *(const GAS v4u*)(ksrc + (size_t)(i * 128) * PNP); stg[i][1] = *(const GAS v4u*)(ksrc + (size_t)(i * 128 + 64) * PNP); }
#pragma unroll
    for (int kt = 0; kt < 16; ++kt) {
        if (kt < nt) {
            LAS unsigned char* kb_base = F.lds + (kt & 1) * 16384;
            *(LAS v4u*)(kb_base + kdst) = stg[kt % 3][0]; *(LAS v4u*)(kb_base + 8192 + kdst) = stg[kt % 3][1];
            if (kt + 3 < nt) { stg[kt % 3][0] = *(const GAS v4u*)(ksrc + (size_t)(kt + 3) * 128 * PNP); stg[kt % 3][1] = *(const GAS v4u*)(ksrc + (size_t)((kt + 3) * 128 + 64) * PNP); }
            LDS_WAIT(); __builtin_amdgcn_s_barrier(); asm volatile("" ::: "memory");
            float s4[4];
            f32x16 accp, accc;
#define IDX_MM(dst, h_) do { const f32x16 z_ = {0.f,0.f,0.f,0.f,0.f,0.f,0.f,0.f,0.f,0.f,0.f,0.f,0.f,0.f,0.f,0.f}; \
                const bf16x8 k0_ = *(const LAS bf16x8*)(kb_base + (h_) * 4096 + krd + (((0 + hi) ^ (l31 & 7)) << 4)), k1_ = *(const LAS bf16x8*)(kb_base + (h_) * 4096 + krd + (((2 + hi) ^ (l31 & 7)) << 4)); \
                const bf16x8 k2_ = *(const LAS bf16x8*)(kb_base + (h_) * 4096 + krd + (((4 + hi) ^ (l31 & 7)) << 4)), k3_ = *(const LAS bf16x8*)(kb_base + (h_) * 4096 + krd + (((6 + hi) ^ (l31 & 7)) << 4)); \
                dst = __builtin_amdgcn_mfma_f32_32x32x16_bf16(qa[0], k0_, z_, 0, 0, 0); dst = __builtin_amdgcn_mfma_f32_32x32x16_bf16(qa[1], k1_, dst, 0, 0, 0); \
                dst = __builtin_amdgcn_mfma_f32_32x32x16_bf16(qa[2], k2_, dst, 0, 0, 0); dst = __builtin_amdgcn_mfma_f32_32x32x16_bf16(qa[3], k3_, dst, 0, 0, 0); } while (0)
#define IDX_RED(src, h_) do { float x0 = 0.f, x1 = 0.f; _Pragma("unroll") for (int r = 0; r < 16; r += 2) { float m0_, m1_; \
                    asm("v_max_f32 %0, 0, %1" : "=v"(m0_) : "v"(src[r])); asm("v_max_f32 %0, 0, %1" : "=v"(m1_) : "v"(src[r + 1]));     \
                    x0 += wv[r] * m0_; x1 += wv[r + 1] * m1_; } s4[h_] = xor32_sum(x0 + x1); } while (0)
            IDX_MM(accp, 0); __builtin_amdgcn_sched_barrier(0);
            IDX_MM(accc, 1); __builtin_amdgcn_sched_barrier(0); IDX_RED(accp, 0); __builtin_amdgcn_sched_barrier(0);
            IDX_MM(accp, 2); __builtin_amdgcn_sched_barrier(0); IDX_RED(accc, 1); __builtin_amdgcn_sched_barrier(0);
            IDX_MM(accc, 3); __builtin_amdgcn_sched_barrier(0); IDX_RED(accp, 2); __builtin_amdgcn_sched_barrier(0);
            IDX_RED(accc, 3);
#undef IDX_MM
#undef IDX_RED
            const float ma = (lane < 32 ? s4[0] : s4[1]) + 0.0f, mb = (lane < 32 ? s4[2] : s4[3]) + 0.0f;
            sc[2 * kt] = (128 * kt + lane <= tq) ? sortable(ma) : 0u;
            sc[2 * kt + 1] = (128 * kt + 64 + lane <= tq) ? sortable(mb) : 0u;
        } else { sc[2 * kt] = 0u; sc[2 * kt + 1] = 0u; }
    }
    select_topk(sc, mrow, lane);
}
constexpr float QSCALE = 0.08838834764831845f * 1.4426950408889634f;
__device__ __forceinline__ void qknorm_row(Frame& F, int row) {
    bf16* prow = F.PROJ + (size_t)row * PNP; const int lane = F.lane;
    {
        GAS v4u* p = (GAS v4u*)(prow + PQ + 32 * lane); v4u w[4]; float ss = 0.f;
#pragma unroll
        for (int i = 0; i < 4; ++i) { w[i] = p[i];
#pragma unroll
            for (int j = 0; j < 4; ++j) { const float a = bflo(w[i][j]), c = bfhi(w[i][j]); ss += a * a + c * c; } }
        ss += __shfl_xor(ss, 1); ss += __shfl_xor(ss, 2);
        const float r = QSCALE / sqrtf(ss * (1.f / HD) + EPS); const float* g = F.qng + 32 * (lane & 3);
#pragma unroll
        for (int i = 0; i < 4; ++i) { v4u o;
#pragma unroll
            for (int j = 0; j < 4; ++j) o[j] = pk2(bflo(w[i][j]) * r * g[8 * i + 2 * j], bfhi(w[i][j]) * r * g[8 * i + 2 * j + 1]);
            p[i] = o; }
    }
    {
        GAS v4u* p = (GAS v4u*)(prow + PK + 8 * lane); const v4u w = *p; float ss = 0.f;
#pragma unroll
        for (int j = 0; j < 4; ++j) { const float a = bflo(w[j]), c = bfhi(w[j]); ss += a * a + c * c; }
        ss += __shfl_xor(ss, 1); ss += __shfl_xor(ss, 2); ss += __shfl_xor(ss, 4); ss += __shfl_xor(ss, 8);
        const float r = 1.0f / sqrtf(ss * (1.f / HD) + EPS); const float* g = F.kng + 8 * (lane & 15); v4u o;
#pragma unroll
        for (int j = 0; j < 4; ++j) o[j] = pk2(bflo(w[j]) * r * g[2 * j], bfhi(w[j]) * r * g[2 * j + 1]);
        *p = o;
    }
    {
        const GAS v4u* p = (const GAS v4u*)(prow + PGV + 32 * lane); float ss = 0.f;
#pragma unroll
        for (int i = 0; i < 4; ++i) { const v4u w = p[i];
#pragma unroll
            for (int j = 0; j < 4; ++j) { const float a = bflo(w[j]), c = bfhi(w[j]); ss += a * a + c * c; } }
        ss = wave_sum(ss);
        if (lane == 0) F.RS[row] = 1.0f / sqrtf(ss * (1.f / GMW) + EPS);
    }
}
__device__ __forceinline__ void vt_item(Frame& F, int item) {
    const int s8 = item & 255, dh = (item >> 8) & 1, g = (item >> 9) & 3, b = item >> 11, d = 64 * dh + F.lane;
    const bf16* src = F.PROJ + (size_t)(b * SEQ + 8 * s8) * PNP + PV + g * HD + d;
    unsigned e[8];
#pragma unroll
    for (int j = 0; j < 8; ++j) e[j] = src[(size_t)j * PNP];
    v4u o; o.x = e[0] | (e[1] << 16); o.y = e[2] | (e[3] << 16); o.z = e[4] | (e[5] << 16); o.w = e[6] | (e[7] << 16);
    *(GAS v4u*)(F.VT + ((size_t)((b * NKV + g) * HD + d)) * SEQ + 8 * s8) = o;
}

constexpr int AT_KSTR = 272, AT_VSTR = 136, AT_TILE = 17408;
#define RAW_BARRIER() do { LDS_WAIT(); __builtin_amdgcn_s_barrier(); asm volatile("" ::: "memory"); } while (0)
__device__ __forceinline__ void attn_block(Frame& F, int b, int g, int qb, float sbound) {
    const int lane = F.lane, w = F.wave, hi = lane >> 5, l31 = lane & 31, tid = F.tid;
    const int hh = 4 * g + (w >> 1), tw0 = qb * 64 + 32 * (w & 1), t = tw0 + l31;
    const size_t row = (size_t)b * SEQ + t;
    const float slope2 = exp2f(-0.5f * (float)(hh + 1)) * 1.4426950408889634f;
    bf16x8 qf[8];
#pragma unroll
    for (int ks = 0; ks < 8; ++ks) qf[ks] = *(const GAS bf16x8*)(F.PROJ + row * PNP + PQ + hh * HD + 16 * ks + 8 * hi);
    f32x16 o[4];
#pragma unroll
    for (int db = 0; db < 4; ++db)
#pragma unroll
        for (int r = 0; r < 16; ++r) o[db][r] = 0.f;
    float m = -1e30f, lsum = 0.f;
    const bf16* ksrc = F.PROJ + ((size_t)b * SEQ + (tid >> 4)) * PNP + PK + g * HD + 8 * (tid & 15);
    const int kdst = (tid >> 4) * AT_KSTR + (tid & 15) * 16;
    const bf16* vsrc = F.VT + ((size_t)((b * NKV + g) * HD + (tid >> 3))) * SEQ + 8 * (tid & 7);
    const int vdst = 2 * AT_TILE + (tid >> 3) * AT_VSTR + (tid & 7) * 16;
    const unsigned* mbase = F.MASK + row * 64;
    LAS unsigned char* L = F.lds;
    v4u sk0, sk1, sv0, sv1; v2u mw, mwn;
#define AT_LOAD(kt_) do { sk0 = *(const GAS v4u*)(ksrc + (size_t)(64 * (kt_)) * PNP); sk1 = *(const GAS v4u*)(ksrc + (size_t)(64 * (kt_) + 32) * PNP); \
        sv0 = *(const GAS v4u*)(vsrc + 64 * (kt_)); sv1 = *(const GAS v4u*)(vsrc + (size_t)64 * SEQ + 64 * (kt_)); mwn = *(const GAS v2u*)(mbase + 2 * (kt_)); } while (0)
#define AT_STORE(bf_) do { *(LAS v4u*)(L + (bf_) * AT_TILE + kdst) = sk0; *(LAS v4u*)(L + (bf_) * AT_TILE + kdst + 32 * AT_KSTR) = sk1; \
        LAS unsigned char* _v = L + (bf_) * AT_TILE + vdst; *(LAS v2u*)_v = (v2u){sv0.x, sv0.y}; *(LAS v2u*)(_v + 8) = (v2u){sv0.z, sv0.w}; \
        *(LAS v2u*)(_v + 64 * AT_VSTR) = (v2u){sv1.x, sv1.y}; *(LAS v2u*)(_v + 64 * AT_VSTR + 8) = (v2u){sv1.z, sv1.w}; } while (0)
    RAW_BARRIER();
    AT_LOAD(qb); AT_STORE(0); mw = mwn;
    int buf = 0; bool dead = false;
    for (int kt = qb; kt >= 0; --kt) {
        if (kt > 0) AT_LOAD(kt - 1);
        RAW_BARRIER();
        if (!dead) {
            const float dmin = (float)(tw0 - (64 * kt + 63));
            dead = __all((sbound - slope2 * dmin) < (m - 40.0f));
        }
        if (!dead) {
            const LAS unsigned char* kb_ = L + buf * AT_TILE + l31 * AT_KSTR + hi * 16;
            const LAS unsigned char* vb_ = L + buf * AT_TILE + 2 * AT_TILE + l31 * AT_VSTR + hi * 8;
            f32x16 p[2];
#pragma unroll
            for (int kb = 0; kb < 2; ++kb) { const unsigned mword = (kb ? mw.y : mw.x) >> (4 * hi);
#pragma unroll
                for (int r = 0; r < 16; ++r) { const int ko = (r & 3) + 8 * (r >> 2);
                    p[kb][r] = ((mword >> ko) & 1u) ? slope2 * (float)(32 * kb + ko) : -2e30f; }
#pragma unroll
                for (int ks = 0; ks < 8; ++ks) { const bf16x8 kf = *(const LAS bf16x8*)(kb_ + kb * 32 * AT_KSTR + ks * 32); p[kb] = __builtin_amdgcn_mfma_f32_32x32x16_bf16(kf, qf[ks], p[kb], 0, 0, 0); }
            }
            const float base = -slope2 * (float)(t - 64 * kt - 4 * hi);
            float rmax = -3e30f;
#pragma unroll
            for (int kb = 0; kb < 2; ++kb)
#pragma unroll
                for (int r = 0; r < 16; ++r) rmax = fmaxf(rmax, p[kb][r]);
            rmax += base; rmax = xor32_max(rmax);
            const float mn = fmaxf(m, rmax), alpha = __builtin_amdgcn_exp2f(m - mn), mrel = mn - base;
            const bool moved = __any(mn != m);
            m = mn;
            float ps = 0.f;
#pragma unroll
            for (int kb = 0; kb < 2; ++kb)
#pragma unroll
                for (int r = 0; r < 16; ++r) { const float e = __builtin_amdgcn_exp2f(p[kb][r] - mrel); p[kb][r] = e; ps += e; }
            lsum = lsum * alpha + ps;
            if (moved) {
#pragma unroll
                for (int db = 0; db < 4; ++db)
#pragma unroll
                    for (int r = 0; r < 16; ++r) o[db][r] *= alpha;
            }
#pragma unroll
            for (int kb = 0; kb < 2; ++kb)
#pragma unroll
                for (int s2 = 0; s2 < 2; ++s2) {
                    v4u pw; pw.x = pk2(p[kb][8 * s2 + 0], p[kb][8 * s2 + 1]); pw.y = pk2(p[kb][8 * s2 + 2], p[kb][8 * s2 + 3]); pw.z = pk2(p[kb][8 * s2 + 4], p[kb][8 * s2 + 5]); pw.w = pk2(p[kb][8 * s2 + 6], p[kb][8 * s2 + 7]);
                    const bf16x8 pb = __builtin_bit_cast(bf16x8, pw);
#pragma unroll
                    for (int db = 0; db < 4; ++db) { const LAS unsigned char* vp = vb_ + db * 32 * AT_VSTR + kb * 64 + s2 * 32;
                        const v2u v0 = *(const LAS v2u*)vp, v1 = *(const LAS v2u*)(vp + 16);
                        v4u vw; vw.x = v0.x; vw.y = v0.y; vw.z = v1.x; vw.w = v1.y;
                        o[db] = __builtin_amdgcn_mfma_f32_32x32x16_bf16(__builtin_bit_cast(bf16x8, vw), pb, o[db], 0, 0, 0); }
                }
        }
        if (kt > 0) { AT_STORE(buf ^ 1); mw = mwn; }
        buf ^= 1;
    }
#undef AT_LOAD
#undef AT_STORE
    lsum = xor32_sum(lsum);
    const float inv = S_YA / lsum;
    unsigned char* yrow = (unsigned char*)F.YA + row * (2 * ATTW) + hh * HD + 4 * hi;
#pragma unroll
    for (int db = 0; db < 4; ++db)
#pragma unroll
        for (int rq = 0; rq < 4; ++rq) *(GAS unsigned*)(yrow + 32 * db + 8 * rq) = pk4_fp8(o[db][4 * rq] * inv, o[db][4 * rq + 1] * inv, o[db][4 * rq + 2] * inv, o[db][4 * rq + 3] * inv);
}
__device__ __forceinline__ float attn_score_bound(Frame& F) {
    float gq = fmaxf(fabsf(F.qng[F.lane]), fabsf(F.qng[F.lane + 64])), gk = fmaxf(fabsf(F.kng[F.lane]), fabsf(F.kng[F.lane + 64]));
#pragma unroll
    for (int o = 1; o < 64; o <<= 1) { gq = fmaxf(gq, __shfl_xor(gq, o)); gk = fmaxf(gk, __shfl_xor(gk, o)); }
    return 1.02f * 128.0f * gq * gk * QSCALE;
}

constexpr int SG_STR = 272, SG_WOFF = 65536;
__device__ __forceinline__ void sgu_unit(Frame& F, int unit) {
    const int ck = unit >> 3, g = unit & 7, r0 = ck * GMC, c0 = g * GMGW, tid = F.tid, lane = F.lane, w = F.wave, hi = lane >> 5, l31 = lane & 31;
    LAS unsigned char* L = F.lds;
    const int rs_ = tid >> 5, q_ = tid & 31;
    __syncthreads();
#pragma unroll
    for (int i = 0; i < 8; ++i) *(LAS v4u*)(L + (rs_ + 16 * i) * 512 + q_ * 16) = *(const GAS v4u*)(F.PROJ + (size_t)(r0 + rs_ + 16 * i) * PNP + PGV + c0 + 8 * q_);
    { const f32x4 q = *(const GAS f32x4*)(F.RS + r0 + 4 * q_);
#pragma unroll
      for (int i = 0; i < 8; ++i) { const int t_ = rs_ + 16 * i; const f32x4 wv = *(const GAS f32x4*)(F.sgw + ((size_t)(g * GMC + t_)) * GMC + 4 * q_);
          const int sb = 4 * q_; v2u o;
          o.x = pk2(sb + 0 <= t_ ? wv.x * q.x : 0.f, sb + 1 <= t_ ? wv.y * q.y : 0.f); o.y = pk2(sb + 2 <= t_ ? wv.z * q.z : 0.f, sb + 3 <= t_ ? wv.w * q.w : 0.f);
          *(LAS v2u*)(L + SG_WOFF + t_ * SG_STR + 8 * q_) = o; } }
    __syncthreads();
    v4u uu[8];
#pragma unroll
    for (int i = 0; i < 8; ++i) uu[i] = *(const GAS v4u*)(F.PROJ + (size_t)(r0 + rs_ + 16 * i) * PNP + PGU + c0 + 8 * q_);
    f32x16 acc[4];
#pragma unroll
    for (int tb = 0; tb < 4; ++tb)
#pragma unroll
        for (int r = 0; r < 16; ++r) acc[tb][r] = 0.f;
    const LAS unsigned char* xb = L + hi * 8 * 512 + 2 * (32 * w + l31);
    const LAS unsigned char* wa = L + SG_WOFF + l31 * SG_STR + hi * 16;
#pragma unroll
    for (int ks = 0; ks < 8; ++ks) {
        v4u xw;
#pragma unroll
        for (int j = 0; j < 4; ++j) { const unsigned lo = *(const LAS unsigned short*)(xb + (16 * ks + 2 * j) * 512), hh = *(const LAS unsigned short*)(xb + (16 * ks + 2 * j + 1) * 512); xw[j] = lo | (hh << 16); }
        const bf16x8 xf = __builtin_bit_cast(bf16x8, xw);
#pragma unroll
        for (int tb = 0; tb < 4; ++tb) if (ks < 2 * (tb + 1)) { const bf16x8 wf = *(const LAS bf16x8*)(wa + tb * 32 * SG_STR + ks * 32); acc[tb] = __builtin_amdgcn_mfma_f32_32x32x16_bf16(wf, xf, acc[tb], 0, 0, 0); } }
    LDS_WAIT(); __builtin_amdgcn_s_barrier(); asm volatile("" ::: "memory");
    { const int cl = 32 * w + l31;
#pragma unroll
      for (int tb = 0; tb < 4; ++tb)
#pragma unroll
          for (int r = 0; r < 16; ++r) { const int t = 32 * tb + (r & 3) + 8 * (r >> 2) + 4 * hi; *(LAS unsigned short*)(L + t * 512 + 2 * cl) = (unsigned short)f2bf(acc[tb][r]); } }
    const f32x4 g0 = *(const GAS f32x4*)(F.sgg + c0 + 8 * q_), g1 = *(const GAS f32x4*)(F.sgg + c0 + 8 * q_ + 4);
    LDS_WAIT(); __builtin_amdgcn_s_barrier(); asm volatile("" ::: "memory");
#pragma unroll
    for (int i = 0; i < 8; ++i) { const v4u fw = *(const LAS v4u*)(L + (rs_ + 16 * i) * 512 + q_ * 16); const float bb = F.sgb[g * GMC + rs_ + 16 * i]; v2u o;
        o.x = pk4_fp8(S_YB * bflo(uu[i].x) * (bflo(fw.x) * g0.x + bb), S_YB * bfhi(uu[i].x) * (bfhi(fw.x) * g0.y + bb), S_YB * bflo(uu[i].y) * (bflo(fw.y) * g0.z + bb), S_YB * bfhi(uu[i].y) * (bfhi(fw.y) * g0.w + bb));
        o.y = pk4_fp8(S_YB * bflo(uu[i].z) * (bflo(fw.z) * g1.x + bb), S_YB * bfhi(uu[i].z) * (bfhi(fw.z) * g1.y + bb), S_YB * bflo(uu[i].w) * (bflo(fw.w) * g1.z + bb), S_YB * bfhi(uu[i].w) * (bfhi(fw.w) * g1.w + bb));
        *(GAS v2u*)((unsigned char*)F.YA + (size_t)(r0 + rs_ + 16 * i) * (2 * ATTW) + ATTW + c0 + 8 * q_) = o; }
}

using pg8::Unit; using pg8::cvt_pk_bf16;
struct EpiProj {
    static constexpr bool PERM = true, MIDK = false; bf16* O; float scale;
    __device__ __forceinline__ void operator()(const f32x4 (&acc)[2][2][4][2], const Unit& u, int wr, int wc, int fr, int fq) const {
        const int act = (u.pn >= PGU / 256 && u.pn < PGA / 256) ? 1 : ((u.pn >= PGA / 256 && u.pn < PKI / 256) ? 2 : 0);
        const int row0 = u.pm * 256 + wr * 64 + fr, col0 = u.pn * 256 + wc * 32 + 8 * fq;
#pragma unroll
        for (int ai = 0; ai < 2; ++ai)
#pragma unroll
            for (int m = 0; m < 4; ++m) { bf16* rowp = O + (size_t)(row0 + ai * 128 + m * 16) * PNP + col0;
#pragma unroll
                for (int bj = 0; bj < 2; ++bj) { f32x4 v0 = acc[ai][bj][m][0] * scale, v1 = acc[ai][bj][m][1] * scale;
                    if (act == 1) { const pg8::f32x2 a = pg8::gelu_pk((pg8::f32x2){v0[0], v0[1]}), b = pg8::gelu_pk((pg8::f32x2){v0[2], v0[3]}), c = pg8::gelu_pk((pg8::f32x2){v1[0], v1[1]}), d = pg8::gelu_pk((pg8::f32x2){v1[2], v1[3]});
                        v0 = (f32x4){a.x, a.y, b.x, b.y}; v1 = (f32x4){c.x, c.y, d.x, d.y}; }
                    else if (act == 2) {
#pragma unroll
                        for (int j = 0; j < 4; ++j) { v0[j] = pg8::sigmoidf_(v0[j]); v1[j] = pg8::sigmoidf_(v1[j]); } }
                    v4u w; w.x = cvt_pk_bf16(v0[0], v0[1]); w.y = cvt_pk_bf16(v0[2], v0[3]); w.z = cvt_pk_bf16(v1[0], v1[1]); w.w = cvt_pk_bf16(v1[2], v1[3]);
                    *(GAS v4u*)(rowp + bj * 128) = w; } }
    }
};
struct EpiMerge {
    static constexpr bool PERM = true, MIDK = true; const bf16* P; unsigned char* O; float cB, ratio;
    __device__ __forceinline__ void mid(f32x4 (&acc)[2][2][4][2], const Unit& u, int wr, int wc, int fr, int fq) const {
        const bf16* pb = P + (size_t)(u.pm * 256 + wr * 64 + fr) * PNP + (u.pn * 256 + wc * 32 + 8 * fq);
        asm volatile("" : "+v"(pb));
#pragma unroll
        for (int ai = 0; ai < 2; ++ai)
#pragma unroll
            for (int m = 0; m < 4; ++m) {
#pragma unroll
                for (int bj = 0; bj < 2; ++bj) { const bf16* q = pb + (size_t)(ai * 128 + m * 16) * PNP + bj * 128;
                    const v4u ga = *(const GAS v4u*)(q + PGA), gb = *(const GAS v4u*)(q + PGB);
#pragma unroll
                    for (int j = 0; j < 2; ++j) { f32x4 f;
                        f.x = ratio * bflo(ga[2 * j]) * __builtin_amdgcn_rcpf(fmaxf(bflo(gb[2 * j]), 1e-30f)); f.y = ratio * bfhi(ga[2 * j]) * __builtin_amdgcn_rcpf(fmaxf(bfhi(gb[2 * j]), 1e-30f));
                        f.z = ratio * bflo(ga[2 * j + 1]) * __builtin_amdgcn_rcpf(fmaxf(bflo(gb[2 * j + 1]), 1e-30f)); f.w = ratio * bfhi(ga[2 * j + 1]) * __builtin_amdgcn_rcpf(fmaxf(bfhi(gb[2 * j + 1]), 1e-30f));
                        acc[ai][bj][m][j] *= f; }
                    asm volatile("" ::: "memory"); } }
    }
    __device__ __forceinline__ void operator()(const f32x4 (&acc)[2][2][4][2], const Unit& u, int wr, int wc, int fr, int fq) const {
        const float sc = cB * S_MRG;
        const bf16* pb = P + (size_t)(u.pm * 256 + wr * 64 + fr) * PNP + (u.pn * 256 + wc * 32 + 8 * fq) + PGB;
        unsigned char* ob = O + (size_t)(u.pm * 256 + wr * 64 + fr) * DM + (u.pn * 256 + wc * 32 + 8 * fq);
        asm volatile("" : "+v"(pb), "+v"(ob));
#pragma unroll
        for (int ai = 0; ai < 2; ++ai)
#pragma unroll
            for (int m = 0; m < 4; ++m) {
#pragma unroll
                for (int bj = 0; bj < 2; ++bj) { const v4u gw = *(const GAS v4u*)(pb + (size_t)(ai * 128 + m * 16) * PNP + bj * 128);
                    const f32x4 v0 = acc[ai][bj][m][0] * ((f32x4){fmaxf(bflo(gw.x), 1e-30f), fmaxf(bfhi(gw.x), 1e-30f), fmaxf(bflo(gw.y), 1e-30f), fmaxf(bfhi(gw.y), 1e-30f)} * sc);
                    const f32x4 v1 = acc[ai][bj][m][1] * ((f32x4){fmaxf(bflo(gw.z), 1e-30f), fmaxf(bfhi(gw.z), 1e-30f), fmaxf(bflo(gw.w), 1e-30f), fmaxf(bfhi(gw.w), 1e-30f)} * sc);
                    v2u w; w.x = pk4_fp8(v0[0], v0[1], v0[2], v0[3]); w.y = pk4_fp8(v1[0], v1[1], v1[2], v1[3]);
                    *(GAS v2u*)(ob + (size_t)(ai * 128 + m * 16) * DM + bj * 128) = w; } }
    }
};
template <bool BIN, bool BOUT>
struct EpiResid {
    static constexpr bool PERM = false, MIDK = false; const void* base; const float* gate; void* C; float scale;
    __device__ __forceinline__ void operator()(const f32x4 (&acc)[2][2][4][2], const Unit& u, int wr, int wc, int fr, int fq) const {
        const int row0 = u.pm * 256 + wr * 64 + fr, col0 = u.pn * 256 + wc * 32 + 4 * fq; const float* gp = gate + (u.pm >> 3) * MODW + col0;
        f32x4 gv[2][2];
#pragma unroll
        for (int bj = 0; bj < 2; ++bj)
#pragma unroll
            for (int n = 0; n < 2; ++n) gv[bj][n] = *(const GAS f32x4*)(gp + bj * 128 + n * 16) * scale;
#pragma unroll
        for (int ai = 0; ai < 2; ++ai)
#pragma unroll
            for (int m = 0; m < 4; ++m) { const size_t off = (size_t)(row0 + ai * 128 + m * 16) * DM + col0;
#pragma unroll
                for (int bj = 0; bj < 2; ++bj)
#pragma unroll
                    for (int n = 0; n < 2; ++n) { const size_t o = off + bj * 128 + n * 16; f32x4 bs;
                        if constexpr (BIN) { const v2u w = *(const GAS v2u*)((const bf16*)base + o); bs = (f32x4){bflo(w.x), bfhi(w.x), bflo(w.y), bfhi(w.y)}; }
                        else bs = *(const GAS f32x4*)((const float*)base + o);
                        const f32x4 r = bs + gv[bj][n] * acc[ai][bj][m][n];
                        if constexpr (BOUT) { v2u w; w.x = cvt_pk_bf16(r.x, r.y); w.y = cvt_pk_bf16(r.z, r.w); *(GAS v2u*)((bf16*)C + o) = w; }
                        else *(GAS f32x4*)((float*)C + o) = r; } }
    }
};
struct EpiPlain {
    static constexpr bool PERM = true, MIDK = false; unsigned char* O; int ldc; float scale;
    __device__ __forceinline__ void operator()(const f32x4 (&acc)[2][2][4][2], const Unit& u, int wr, int wc, int fr, int fq) const {
        unsigned char* ob = O + (size_t)(u.pm * 256 + wr * 64 + fr) * ldc + (u.pn * 256 + wc * 32 + 8 * fq);
        asm volatile("" : "+v"(ob));
#pragma unroll
        for (int ai = 0; ai < 2; ++ai)
#pragma unroll
            for (int m = 0; m < 4; ++m)
#pragma unroll
                for (int bj = 0; bj < 2; ++bj) { const f32x4 v0 = acc[ai][bj][m][0] * scale, v1 = acc[ai][bj][m][1] * scale;
                    v2u w; w.x = pk4_fp8(v0[0], v0[1], v0[2], v0[3]); w.y = pk4_fp8(v1[0], v1[1], v1[2], v1[3]);
                    *(GAS v2u*)(ob + (size_t)(ai * 128 + m * 16) * ldc + bj * 128) = w; }
    }
};

typedef float f32x2 __attribute__((ext_vector_type(2)));
__device__ __forceinline__ void unpack8_fp8(v2u w, f32x2 (&o)[4]) {
    o[0] = __builtin_amdgcn_cvt_pk_f32_fp8((int)w.x, false); o[1] = __builtin_amdgcn_cvt_pk_f32_fp8((int)w.x, true); o[2] = __builtin_amdgcn_cvt_pk_f32_fp8((int)w.y, false); o[3] = __builtin_amdgcn_cvt_pk_f32_fp8((int)w.y, true);
}
__device__ __forceinline__ void conv_phase(Frame& F) {
    constexpr int C8 = DFF / 8, TB = 32, NTB = M / TB;
    const size_t total = (size_t)C8 * NTB;
    for (size_t idx = (size_t)F.gw * 64 + F.lane; idx < total; idx += (size_t)F.NGW * 64) {
        const int c8 = (int)(idx % C8), tb = (int)(idx / C8), ch = 8 * c8, t0 = tb * TB;
        const int acol = (ch >> 7) * 256 + (ch & 127);
        f32x2 wg[3][4], wv[3][4], bg[4], bv[4];
#pragma unroll
        for (int j = 0; j < 3; ++j) { const f32x4 a = *(const GAS f32x4*)(F.cvw + (size_t)j * F2 + ch) * (1.f / S_A), b = *(const GAS f32x4*)(F.cvw + (size_t)j * F2 + ch + 4) * (1.f / S_A);
            const f32x4 c = *(const GAS f32x4*)(F.cvw + (size_t)j * F2 + DFF + ch) * (1.f / S_A), d = *(const GAS f32x4*)(F.cvw + (size_t)j * F2 + DFF + ch + 4) * (1.f / S_A);
            wg[j][0] = (f32x2){a.x, a.y}; wg[j][1] = (f32x2){a.z, a.w}; wg[j][2] = (f32x2){b.x, b.y}; wg[j][3] = (f32x2){b.z, b.w};
            wv[j][0] = (f32x2){c.x, c.y}; wv[j][1] = (f32x2){c.z, c.w}; wv[j][2] = (f32x2){d.x, d.y}; wv[j][3] = (f32x2){d.z, d.w}; }
        { const f32x4 a = *(const GAS f32x4*)(F.cvb + ch), b = *(const GAS f32x4*)(F.cvb + ch + 4), c = *(const GAS f32x4*)(F.cvb + DFF + ch), d = *(const GAS f32x4*)(F.cvb + DFF + ch + 4);
          bg[0] = (f32x2){a.x, a.y}; bg[1] = (f32x2){a.z, a.w}; bg[2] = (f32x2){b.x, b.y}; bg[3] = (f32x2){b.z, b.w}; bv[0] = (f32x2){c.x, c.y}; bv[1] = (f32x2){c.z, c.w}; bv[2] = (f32x2){d.x, d.y}; bv[3] = (f32x2){d.z, d.w}; }
        f32x2 g1[4], g2[4], v1[4], v2[4];
        const bool first = (t0 & (SEQ - 1)) == 0;
        const unsigned char* ap = (const unsigned char*)F.A + (size_t)t0 * F2 + acol;
        if (first) {
#pragma unroll
            for (int e = 0; e < 4; ++e) { g1[e] = g2[e] = v1[e] = v2[e] = (f32x2){0.f, 0.f}; }
        } else {
            const v2u ga = *(const GAS v2u*)(ap - F2), gb = *(const GAS v2u*)(ap - 2 * (size_t)F2), va = *(const GAS v2u*)(ap - F2 + 128), vb = *(const GAS v2u*)(ap - 2 * (size_t)F2 + 128);
            unpack8_fp8(ga, g1); unpack8_fp8(gb, g2); unpack8_fp8(va, v1); unpack8_fp8(vb, v2);
        }
        v2u GA[8], VA[8], GB[8], VB[8];
#define CV_LOAD(G_, V_, r0_) do { _Pragma("unroll") for (int i_ = 0; i_ < 8; ++i_) { G_[i_] = *(const GAS v2u*)(ap + (size_t)((r0_) + i_) * F2); V_[i_] = *(const GAS v2u*)(ap + (size_t)((r0_) + i_) * F2 + 128); } } while (0)
#define CV_COMP(G_, V_, r0_) do { _Pragma("unroll") for (int i_ = 0; i_ < 8; ++i_) { f32x2 g0[4], v0[4], y[4]; unpack8_fp8(G_[i_], g0); unpack8_fp8(V_[i_], v0); \
            _Pragma("unroll") for (int e = 0; e < 4; ++e) { const f32x2 gt = bg[e] + wg[0][e] * g2[e] + wg[1][e] * g1[e] + wg[2][e] * g0[e]; \
                const f32x2 vl = bv[e] + wv[0][e] * v2[e] + wv[1][e] * v1[e] + wv[2][e] * v0[e]; \
                f32x2 sg; sg.x = pg8::sigmoidf_(gt.x); sg.y = pg8::sigmoidf_(gt.y); \
                y[e] = (gt * sg) * (vl * S_ACT); g2[e] = g1[e]; g1[e] = g0[e]; v2[e] = v1[e]; v1[e] = v0[e]; } \
            v2u o; o.x = pk4_fp8(y[0].x, y[0].y, y[1].x, y[1].y); o.y = pk4_fp8(y[2].x, y[2].y, y[3].x, y[3].y); \
            *(GAS v2u*)((unsigned char*)F.ACT + (size_t)(t0 + (r0_) + i_) * DFF + ch) = o; } asm volatile("" ::: "memory"); } while (0)
        CV_LOAD(GA, VA, 0); CV_LOAD(GB, VB, 8); CV_COMP(GA, VA, 0); CV_LOAD(GA, VA, 16); CV_COMP(GB, VB, 8); CV_LOAD(GB, VB, 24); CV_COMP(GA, VA, 16); CV_COMP(GB, VB, 24);
#undef CV_LOAD
#undef CV_COMP
    }
}

constexpr int N_PHASES = 12;
struct Args { const float* in[19]; float* out; unsigned char* ws; int ph_lo, ph_hi, li, pad; };
__global__ void __launch_bounds__(NWAVES * 64, 2) mega_fwd(Args args) {
    extern __shared__ __attribute__((aligned(16))) unsigned char lds[];
    Frame F;
    F.lds = (LAS unsigned char*)lds;
    F.MISC = (volatile LAS unsigned*)(F.lds + MISC_OFF);
    F.tid = threadIdx.x; F.lane = F.tid & 63; F.wave = __builtin_amdgcn_readfirstlane(F.tid >> 6);
    F.G = gridDim.x; F.gw = blockIdx.x * NWAVES + F.wave; F.NGW = F.G * NWAVES;
    unsigned char* ws = args.ws;
    F.ctl = (gu32*)(ws + WS_CTL);
    F.x = args.in[0]; F.c = args.in[1]; F.ada_w = args.in[2]; F.ada_b = args.in[3]; F.n1g = args.in[4]; F.w_in = args.in[5]; F.qng = args.in[6]; F.kng = args.in[7];
    F.sgg = args.in[8]; F.sgw = args.in[9]; F.sgb = args.in[10]; F.w_a = args.in[11]; F.w_b = args.in[12]; F.w_out = args.in[13]; F.n2g = args.in[14]; F.w_up = args.in[15];
    F.cvw = args.in[16]; F.cvb = args.in[17]; F.w_dn = args.in[18]; F.out = args.out;
    F.MOD = (float*)(ws + WS_MOD); F.PART = (float*)(ws + WS_TMP);   F.WIN = (bf16*)(ws + WS_WIN); F.WINB = (bf16*)(ws + WS_WINB); F.H8A = ws + WS_X1;   F.WA = (bf16*)(ws + WS_WA); F.WB = (bf16*)(ws + WS_WB); F.WOUT = (bf16*)(ws + WS_WOUT); F.WUP = (bf16*)(ws + WS_WUP); F.WDN = (bf16*)(ws + WS_WDN);
    F.H = (bf16*)(ws + WS_H); F.X1 = (float*)(ws + WS_X1); F.PROJ = (bf16*)(ws + WS_PROJ); F.MASK = (unsigned*)(ws + WS_MASK); F.RS = (float*)(ws + WS_RS); F.SWT = (float*)(ws + WS_SWT);
    F.VT = (bf16*)(ws + WS_VT); F.YA = (bf16*)(ws + WS_YA); F.YB = (bf16*)(ws + WS_YB); F.MRG = (bf16*)(ws + WS_MRG); F.TMP = (float*)(ws + WS_TMP); F.A = (bf16*)(ws + WS_A); F.ACT = (bf16*)(ws + WS_ACT);
    for (int u = F.tid; u < (LDS_BYTES - LDSCTL_OFF) / 4; u += NWAVES * 64) ((LAS unsigned*)(F.lds + LDSCTL_OFF))[u] = 0u;
    __syncthreads();
    XcdBarrier bar; bar.bar = (unsigned*)(F.ctl + CW_BAR); bar.x = 0; bar.st = nullptr;
    if (MK_N_LAUNCHES == 1) bar = xcd_barrier_post((unsigned*)(F.ctl + CW_BAR), F.MISC + 8);
    const int lo = args.ph_lo, hi = args.ph_hi;
#define IN(k) (lo <= (k) && (k) < hi)
#define SEAM(k) do { if (IN(k) && IN((k) + 1)) xcd_barrier(bar); } while (0)

#define REP(k) if ((PROBE_MASK >> (k)) & 1) for (int _rep = 0; _rep < 1; ++_rep)
    if (IN(0)) { p0_prologue(F); REP(0) { xcd_barrier(bar); p0_prologue(F, false); } } SEAM(0);
    if (IN(1)) { mod_reduce(F); } SEAM(1);
    if (IN(2)) { norm_rows<2>(F, F.x, F.n1g, 0, DM, F.H, F.H8A); REP(2) { xcd_barrier(bar); norm_rows<2>(F, F.x, F.n1g, 0, DM, F.H, F.H8A); } } SEAM(2);
    if (IN(3)) {
        { pg8::Gemm g{F.H, F.WINB, M, PNP, DM, DM, DM}; pg8::MixOrder S{0, F.G, (int)blockIdx.x}; EpiProj E{F.PROJ, 1.0f};
          pg8::gemm_phase<EpiProj, pg8::MixOrder, true, 2>(F.lds + RING_OFF, g, S, E); }
        VM_WAIT(); __syncthreads();
        { pg8::Gemm g{(const bf16*)F.H8A, F.WIN, M, PNP, DM, DM, DM}; pg8::MixOrder S{1, F.G, (int)blockIdx.x}; EpiProj E{F.PROJ, 1.0f / (S_H2 * 1024.f)};
          pg8::gemm_phase<EpiProj, pg8::MixOrder, true, 1>(F.lds + RING_OFF, g, S, E); }
        if (F.G == 256 && blockIdx.x < 32) { const int first = (int)blockIdx.x * 96;
            tr_run<4>(F, first + F.wave, first + 96, NWAVES, (LAS float*)(F.lds + RING_OFF + F.wave * 16384)); }
    } SEAM(3);
    if (IN(4)) {
        for (int it = blockIdx.x; it < 512; it += F.G) { const int b = it >> 7, j = it & 127; idx_block(F, b, j); idx_block(F, b, 255 - j); }
        for (int row = F.gw; row < M; row += F.NGW) qknorm_row(F, row);
        for (int it = F.gw; it < BATCH * NKV * 2 * 256; it += F.NGW) vt_item(F, it);
        REP(4) { xcd_barrier(bar); for (int it = blockIdx.x; it < 512; it += F.G) { const int b = it >> 7, j = it & 127; idx_block(F, b, j); idx_block(F, b, 255 - j); } }
        REP(13) { xcd_barrier(bar); for (int it = F.gw; it < BATCH * NKV * 2 * 256; it += F.NGW) vt_item(F, it); }
    } SEAM(4);
    if (IN(5)) {
        { const float sb = attn_score_bound(F); for (int p = blockIdx.x; p < 256; p += F.G) { const int bg = p >> 4, j = p & 15; attn_block(F, bg >> 2, bg & 3, j, sb); attn_block(F, bg >> 2, bg & 3, 31 - j, sb); } }
        REP(5) { xcd_barrier(bar); { const float sb = attn_score_bound(F); for (int p = blockIdx.x; p < 256; p += F.G) { const int bg = p >> 4, j = p & 15; attn_block(F, bg >> 2, bg & 3, j, sb); attn_block(F, bg >> 2, bg & 3, 31 - j, sb); } } }
        for (int u = blockIdx.x; u < 512; u += F.G) sgu_unit(F, u);
        __syncthreads();
        if (F.G == 256) { const int pq = blockIdx.x, g_ = (pq >> 4) & 3, li = (pq >> 6) * 16 + (pq & 15);
            if (g_ < 2) { const int cnt = g_ == 0 ? 100 : 80, first = g_ == 0 ? li * 100 : 64 * 100 + li * 80;
                tr_run<2>(F, first + F.wave, first + cnt, NWAVES, (LAS float*)(F.lds + RING_OFF + F.wave * 16384)); }
            __syncthreads(); }
        REP(14) { xcd_barrier(bar); for (int u = blockIdx.x; u < 512; u += F.G) sgu_unit(F, u); __syncthreads(); }
    } SEAM(5);
    if (IN(6)) { pg8::Gemm g{F.YA, F.WA, M, DM, 2 * ATTW, 2 * ATTW, 2 * ATTW}; pg8::StaticOrder S; S.init(M, DM, F.G, (int)blockIdx.x);
        EpiMerge E{F.PROJ, (unsigned char*)F.MRG, 1.0f / (S_YB * S_WB), (S_YB * S_WB) / (S_YA * S_WA)};
        pg8::gemm_phase<EpiMerge, pg8::StaticOrder, true, 1>(F.lds + RING_OFF, g, S, E);
        REP(6) { xcd_barrier(bar); pg8::gemm_phase<EpiMerge, pg8::StaticOrder, true, 1>(F.lds + RING_OFF, g, S, E); } } SEAM(6);
    if (IN(7)) { pg8::Gemm g{F.MRG, F.WOUT, M, DM, DM, DM, DM}; pg8::StaticOrder S; S.init(M, DM, F.G, (int)blockIdx.x); EpiResid<false, true> E{F.x, F.MOD + 2 * DM, F.X1, 1.0f / (S_MRG * S_WOUT)};
        pg8::gemm_phase<EpiResid<false, true>, pg8::StaticOrder, true, 1>(F.lds + RING_OFF, g, S, E);
        REP(7) { xcd_barrier(bar); pg8::gemm_phase<EpiResid<false, true>, pg8::StaticOrder, true, 1>(F.lds + RING_OFF, g, S, E); } } SEAM(7);
    if (IN(8)) { norm_rows<1, true>(F, F.X1, F.n2g, 3 * DM, 4 * DM, F.H); REP(8) { xcd_barrier(bar); norm_rows<1, true>(F, F.X1, F.n2g, 3 * DM, 4 * DM, F.H); } } SEAM(8);
    if (IN(9)) { pg8::Gemm g{F.H, F.WUP, M, F2, DM, DM, DM}; pg8::StaticOrder S; S.init(M, F2, F.G, (int)blockIdx.x); EpiPlain E{(unsigned char*)F.A, F2, S_A / (S_H2 * S_WUP)};
        pg8::gemm_phase<EpiPlain, pg8::StaticOrder, true, 1>(F.lds + RING_OFF, g, S, E);
        if (F.G == 256 && blockIdx.x >= 192) { const int first = ((int)blockIdx.x - 192) * 56;
            tr_run<3>(F, first + F.wave, first + 56, NWAVES, (LAS float*)(F.lds + RING_OFF + F.wave * 16384)); }
        REP(9) { xcd_barrier(bar); pg8::gemm_phase<EpiPlain, pg8::StaticOrder, true, 1>(F.lds + RING_OFF, g, S, E); } } SEAM(9);
    if (IN(10)) { conv_phase(F); REP(10) { xcd_barrier(bar); conv_phase(F); } } SEAM(10);
    if (IN(11)) { pg8::Gemm g{F.ACT, F.WDN, M, DM, DFF, DFF, DFF}; pg8::StaticOrder S; S.init(M, DM, F.G, (int)blockIdx.x); EpiResid<true, false> E{F.X1, F.MOD + 5 * DM, F.out, 1.0f / (S_ACT * S_WDN)};
        pg8::gemm_phase<EpiResid<true, false>, pg8::StaticOrder, true, 1>(F.lds + RING_OFF, g, S, E);
        REP(11) { xcd_barrier(bar); pg8::gemm_phase<EpiResid<true, false>, pg8::StaticOrder, true, 1>(F.lds + RING_OFF, g, S, E); } }
#undef REP
#undef IN
#undef SEAM
}

extern "C" void kernel_launch(void* const* d_in, const int* in_sizes, int n_in, void* d_out, int out_size, void* d_ws, size_t ws_size, hipStream_t stream) {
    static int grid = 0;
    if (grid == 0) {
        if (n_in != 19 || in_sizes[0] != M * DM || out_size != M * DM || ws_size < WS_END) { fprintf(stderr, "kernel_launch: unexpected shapes (n_in %d, in0 %d, out %d, ws %zu < %zu); nothing launched\n", n_in, n_in > 0 ? in_sizes[0] : -1, out_size, ws_size, (size_t)WS_END); grid = -1; return; }
        int dev = 0, cus = 0, per_cu = 0;
        if (hipGetDevice(&dev) != hipSuccess || hipDeviceGetAttribute(&cus, hipDeviceAttributeMultiprocessorCount, dev) != hipSuccess) { fprintf(stderr, "kernel_launch: device query failed\n"); grid = -1; return; }
        if (hipFuncSetAttribute((const void*)mega_fwd, hipFuncAttributeMaxDynamicSharedMemorySize, LDS_BYTES) != hipSuccess) { fprintf(stderr, "kernel_launch: hipFuncSetAttribute failed\n"); grid = -1; return; }
        if (hipOccupancyMaxActiveBlocksPerMultiprocessor(&per_cu, (const void*)mega_fwd, NWAVES * 64, LDS_BYTES) != hipSuccess || per_cu < 1) { fprintf(stderr, "kernel_launch: occupancy query reports %d blocks per CU\n", per_cu); }
        (void)hipGetLastError();
        grid = cus;
    }
    if (grid < 0) return;
    if (hipMemsetAsync((char*)d_ws + WS_CTL, 0, CTL_ZERO_BYTES, stream) != hipSuccess) { fprintf(stderr, "kernel_launch: memset failed\n"); return; }
    Args a{};
    for (int i = 0; i < 19; ++i) a.in[i] = (const float*)d_in[i];
    a.out = (float*)d_out; a.ws = (unsigned char*)d_ws; a.pad = 0;
    for (int li = 0; li < MK_N_LAUNCHES; ++li) {
        if (MK_N_LAUNCHES == 1) { a.ph_lo = 0; a.ph_hi = N_PHASES; } else { a.ph_lo = li; a.ph_hi = li + 1; }
        a.li = li;
        hipLaunchKernelGGL(mega_fwd, dim3(grid), dim3(NWAVES * 64), LDS_BYTES, stream, a);
        const hipError_t le = hipPeekAtLastError();
        if (le != hipSuccess) { fprintf(stderr, "kernel_launch: launch %d failed: %s\n", li, hipGetErrorName(le)); break; }
    }
}
```

```cpp
#include <hip/hip_runtime.h>
#include <cstdio>
#include <cstdint>

#ifndef MK_N_LAUNCHES
#define MK_N_LAUNCHES 1
#endif
#ifndef PROBE_MASK
#define PROBE_MASK 0x0
#endif

namespace pg8 {
#define PG8_LAS __attribute__((address_space(3)))
typedef unsigned short bf16_t;
typedef short bf16x8 __attribute__((ext_vector_type(8)));
typedef float f32x4 __attribute__((ext_vector_type(4)));
typedef float f32x2 __attribute__((ext_vector_type(2)));
typedef unsigned u32x4 __attribute__((ext_vector_type(4)));
typedef unsigned u32x2 __attribute__((ext_vector_type(2)));
constexpr int BM = 256, BK = 64, HALF = 128, HTB = HALF * BK * 2, STAGE_BYTES = 8 * HTB, NXCD = 8, WGM = 8;

__host__ __device__ __forceinline__ int lds_byte(int r, int c) { const int rr = r & 7, ch = c >> 3; return (r >> 3) * 1024 + (16 * ((rr >> 2) + 2 * (ch >> 2)) + 4 * (rr & 3) + ((ch ^ (2 * (rr >> 2))) & 3)) * 16; }
__host__ __device__ __forceinline__ void stage_rc(int b, int& R, int& C) { const int pc = b >> 10, p = (b & 1023) >> 4, q = p >> 4, bb = p & 15, rr = (q & 1) * 4 + (bb >> 2), ch = (q >> 1) * 4 + ((bb & 3) ^ (2 * (q & 1))); R = pc * 8 + rr; C = ch * 8; }
__host__ __device__ __forceinline__ int perm32(int rho) { const int n = rho >> 4, i = rho & 15; return 8 * (i >> 2) + 4 * n + (i & 3); }

struct Unit { int pm, pn; };
struct Gemm { const bf16_t* A; const bf16_t* Bt; int M, N, K, lda, ldb; };

struct StaticOrder {
    int nM, nN, nwg, G, c;
    __host__ __device__ void init(int M, int N, int G_, int c_) { nM = M / BM; nN = N / BM; nwg = nM * nN; G = G_; c = c_; }
    __host__ __device__ bool next(int i, Unit& u) const {
        const long L = (long)i * G + c; if (L >= nwg) return false;
        int wgid = (int)L; { const int q = nwg / NXCD, r = nwg % NXCD, xcd = wgid % NXCD, off = wgid / NXCD; wgid = (xcd < r ? xcd * (q + 1) : r * (q + 1) + (xcd - r) * q) + off; }
        const int nig = WGM * nN, gid = wgid / nig, fm = gid * WGM, gsz = (nM - fm) < WGM ? (nM - fm) : WGM;
        u.pm = fm + ((wgid % nig) % gsz); u.pn = (wgid % nig) / gsz; return true;
    }
    __device__ __forceinline__ void a_ready(const Unit&) const {}
    __device__ __forceinline__ void done(const Unit&) const {}
};
struct MixOrder {
    int fp8, G, c, i0 = 0, i1 = 1 << 30;
    __host__ __device__ static void map(int L, int nwg, int nN, Unit& u) {
        int wgid = L; { const int q = nwg / NXCD, r = nwg % NXCD, xcd = wgid % NXCD, off = wgid / NXCD; wgid = (xcd < r ? xcd * (q + 1) : r * (q + 1) + (xcd - r) * q) + off; }
        const int nig = WGM * nN; u.pm = (wgid / nig) * WGM + ((wgid % nig) % WGM); u.pn = (wgid % nig) / WGM;
    }
    __host__ __device__ bool next(int i, Unit& u) const {
        int L;
        if (!fp8) { L = i * G + c; if (L >= 288) return false; map(L, 288, 9, u); u.pn = u.pn < 8 ? 12 + u.pn : 68; return true; }
        i += i0; if (i >= i1) return false;
        if (G == 256) { if (c >= 32) { if (i >= 8) return false; L = i * 224 + (c - 32); } else { if (i >= 4) return false; L = 1792 + 4 * c + i; } }
        else { L = i * G + c; if (L >= 1920) return false; }
        map(L, 1920, 60, u); u.pn = u.pn < 12 ? u.pn : u.pn + 8; return true;
    }
    __device__ __forceinline__ void a_ready(const Unit&) const {}
    __device__ __forceinline__ void done(const Unit&) const {}
};

__device__ __forceinline__ unsigned cvt_pk_bf16(float lo, float hi) { unsigned r; asm volatile("v_cvt_pk_bf16_f32 %0, %1, %2" : "=v"(r) : "v"(lo), "v"(hi)); return r; }
__device__ __forceinline__ f32x2 gelu_pk(f32x2 v) {
    const f32x2 av = __builtin_elementwise_abs(v), d = av * 0.2316418882f + 1.0f;
    f32x2 t; t.x = __builtin_amdgcn_rcpf(d.x); t.y = __builtin_amdgcn_rcpf(d.y);
    f32x2 q = t * 0.5307027145f + (-0.7265760135f); q = q * t + 0.7107068705f; q = q * t + (-0.142248368f); q = q * t + 0.127414796f; q = q * t;
    const f32x2 s = (v * v) * (-0.72134752044f);
    f32x2 e; e.x = __builtin_amdgcn_exp2f(s.x); e.y = __builtin_amdgcn_exp2f(s.y);
    const f32x2 m = v * (q * e), r = v - m;
    f32x2 o; o.x = v.x < 0.f ? m.x : r.x; o.y = v.y < 0.f ? m.y : r.y; return o;
}
__device__ __forceinline__ float sigmoidf_(float x) { return __builtin_amdgcn_rcpf(1.0f + __builtin_amdgcn_exp2f(-1.4426950408889634f * x)); }
__device__ __forceinline__ float bflo(unsigned w) { return __builtin_bit_cast(float, w << 16); }
__device__ __forceinline__ float bfhi(unsigned w) { return __builtin_bit_cast(float, w & 0xffff0000u); }

typedef int i32x8 __attribute__((ext_vector_type(8)));
typedef int i32x4 __attribute__((ext_vector_type(4)));
template <class Epi, class Sched, bool ALIGN_EPI, int ES = 2>
__device__ __forceinline__ void gemm_phase(PG8_LAS unsigned char* lds, const Gemm g, const Sched& S, const Epi& E) {
    const int tid = threadIdx.x, wid = __builtin_amdgcn_readfirstlane(tid >> 6), lane = tid & 63, wr = wid >> 2, wc = wid & 3, fr = lane & 15, fq = lane >> 4;
    const int K = g.K, nt = K * ES / (BK * 2);
    unsigned voffA[2], voffB[2];
#pragma unroll
    for (int i = 0; i < 2; ++i) { int R, C; stage_rc(tid * 16 + i * 8192, R, C); const int Rb = Epi::PERM ? ((R & ~31) + perm32(R & 31)) : R;
        voffA[i] = (unsigned)(R * g.lda) * (unsigned)ES + (unsigned)C * 2u; voffB[i] = (unsigned)(Rb * g.ldb) * (unsigned)ES + (unsigned)C * 2u; }
    const size_t kstep = (size_t)(BK * 2);
    const size_t hstepA = (size_t)HALF * g.lda * ES, hstepB = (size_t)HALF * g.ldb * ES;
    const size_t tstepA = 2 * hstepA, tstepB = 2 * hstepB;
    const unsigned ldsw = (unsigned)wid * 1024u;
    const int aoff = lds_byte(wr * 64 + fr, fq * 8), boff = lds_byte(wc * 32 + fr, fq * 8);
#define PG8_SA(b, h) (((b) * 2 + (h)) * HTB)
#define PG8_SB(b, h) ((4 + (b) * 2 + (h)) * HTB)
#define PG8_STAGE(bufoff, gbase, voff) do { _Pragma("unroll") for (int _i = 0; _i < 2; ++_i) \
        __builtin_amdgcn_global_load_lds((const unsigned*)((const char*)(gbase) + (voff)[_i]), (PG8_LAS unsigned*)(lds + (bufoff) + ldsw + _i * 8192), 16, 0, 0); } while (0)
#define PG8_CAT(x, y) __builtin_shufflevector(x, y, 0, 1, 2, 3, 4, 5, 6, 7)
#define PG8_LO(v) __builtin_bit_cast(bf16x8, __builtin_shufflevector(v, v, 0, 1, 2, 3))
#define PG8_HI(v) __builtin_bit_cast(bf16x8, __builtin_shufflevector(v, v, 4, 5, 6, 7))
#define PG8_LDA(dst, b, h) do { _Pragma("unroll") for (int m = 0; m < 4; ++m) { const i32x4 _l = *(const PG8_LAS i32x4*)(lds + PG8_SA(b, h) + aoff + m * 2048), _h = *(const PG8_LAS i32x4*)(lds + PG8_SA(b, h) + aoff + m * 2048 + 512); dst[m] = PG8_CAT(_l, _h); } } while (0)
#define PG8_LDB(dst, b, h) do { _Pragma("unroll") for (int n = 0; n < 2; ++n) { const i32x4 _l = *(const PG8_LAS i32x4*)(lds + PG8_SB(b, h) + boff + n * 2048), _h = *(const PG8_LAS i32x4*)(lds + PG8_SB(b, h) + boff + n * 2048 + 512); dst[n] = PG8_CAT(_l, _h); } } while (0)
#define PG8_MMA(ai, bj, At, Bt) do { __builtin_amdgcn_s_setprio(1); _Pragma("unroll") for (int m = 0; m < 4; ++m) _Pragma("unroll") for (int n = 0; n < 2; ++n) { \
        if constexpr (ES == 2) { acc[ai][bj][m][n] = __builtin_amdgcn_mfma_f32_16x16x32_bf16(PG8_LO(Bt[n]), PG8_LO(At[m]), acc[ai][bj][m][n], 0, 0, 0); \
                                 acc[ai][bj][m][n] = __builtin_amdgcn_mfma_f32_16x16x32_bf16(PG8_HI(Bt[n]), PG8_HI(At[m]), acc[ai][bj][m][n], 0, 0, 0); } \
        else asm volatile("v_mfma_f32_16x16x128_f8f6f4 %0, %1, %2, %0" : "+v"(acc[ai][bj][m][n]) : "v"(Bt[n]), "v"(At[m])); } __builtin_amdgcn_s_setprio(0); } while (0)
#define PG8_WAIT_V(n) asm volatile("s_waitcnt vmcnt(" #n ")" ::: "memory")
#define PG8_WAIT_L(n) asm volatile("s_waitcnt lgkmcnt(" #n ")" ::: "memory")
#define PG8_BAR __builtin_amdgcn_s_barrier()
#define PG8_SCHED __builtin_amdgcn_sched_barrier(0)
    Unit cur, nxt; int ui = 0;
    if (!S.next(0, cur)) return;
    f32x4 acc[2][2][4][2];
#pragma unroll
    for (int a = 0; a < 2; ++a)
#pragma unroll
        for (int b = 0; b < 2; ++b)
#pragma unroll
            for (int m = 0; m < 4; ++m)
#pragma unroll
                for (int n = 0; n < 2; ++n) acc[a][b][m][n] = (f32x4){0.f, 0.f, 0.f, 0.f};
    i32x8 At[4], B0[2], B1[2];
    const char* cA = (const char*)g.A + (size_t)cur.pm * tstepA; const char* cB = (const char*)g.Bt + (size_t)cur.pn * tstepB;
    S.a_ready(cur);
    PG8_STAGE(PG8_SB(0, 0), cB, voffB); PG8_STAGE(PG8_SB(0, 1), cB + hstepB, voffB); PG8_STAGE(PG8_SA(0, 0), cA, voffA); PG8_STAGE(PG8_SA(0, 1), cA + hstepA, voffA);
    if (wr == 1) PG8_BAR;
    PG8_WAIT_V(2); PG8_BAR;
    PG8_STAGE(PG8_SB(1, 0), cB + kstep, voffB); PG8_STAGE(PG8_SA(1, 0), cA + kstep, voffA); PG8_STAGE(PG8_SB(1, 1), cB + hstepB + kstep, voffB);
    PG8_WAIT_V(6); PG8_BAR;
    for (;;) {
        const bool has_next = S.next(ui + 1, nxt);
        const char* nA = has_next ? (const char*)g.A + (size_t)nxt.pm * tstepA : cA; const char* nB = has_next ? (const char*)g.Bt + (size_t)nxt.pn * tstepB : cB;
        for (int t = 0; t < nt; t += 2) {
            const bool last = (t == nt - 2);
            const char* a1 = cA + (size_t)(t + 1) * kstep;
            const char* a2 = last ? nA : cA + (size_t)(t + 2) * kstep; const char* b2 = last ? nB : cB + (size_t)(t + 2) * kstep;
            const char* a3 = a2 + kstep; const char* b3 = b2 + kstep;
            if (last && has_next) S.a_ready(nxt);
            if constexpr (Epi::MIDK) { if (t == nt / 2) { if constexpr (ES == 1) asm volatile("s_nop 15\n\ts_nop 15" ::: "memory"); E.mid(acc, cur, wr, wc, fr, fq); } }
            PG8_LDB(B0, 0, 0); PG8_LDB(B1, 0, 1); PG8_SCHED; PG8_LDA(At, 0, 0); PG8_STAGE(PG8_SA(1, 1), a1 + hstepA, voffA);
            PG8_WAIT_V(8); PG8_WAIT_L(0); PG8_BAR; PG8_MMA(0, 0, At, B0); PG8_MMA(0, 1, At, B1); PG8_BAR; PG8_SCHED;
            PG8_LDA(At, 0, 1); PG8_STAGE(PG8_SB(0, 0), b2, voffB); PG8_STAGE(PG8_SB(0, 1), b2 + hstepB, voffB); PG8_STAGE(PG8_SA(0, 0), a2, voffA);
            PG8_WAIT_V(8); PG8_WAIT_L(0); PG8_BAR; PG8_MMA(1, 0, At, B0); PG8_MMA(1, 1, At, B1); PG8_BAR; PG8_SCHED;
            PG8_LDB(B0, 1, 0); PG8_LDB(B1, 1, 1); PG8_SCHED; PG8_LDA(At, 1, 0); PG8_STAGE(PG8_SA(0, 1), a2 + hstepA, voffA);
            PG8_WAIT_V(8); PG8_WAIT_L(0); PG8_BAR; PG8_MMA(0, 0, At, B0); PG8_MMA(0, 1, At, B1); PG8_BAR; PG8_SCHED;
            PG8_LDA(At, 1, 1); PG8_STAGE(PG8_SB(1, 0), b3, voffB); PG8_STAGE(PG8_SB(1, 1), b3 + hstepB, voffB); PG8_STAGE(PG8_SA(1, 0), a3, voffA);
            PG8_WAIT_V(8); PG8_WAIT_L(0); PG8_BAR; PG8_MMA(1, 0, At, B0); PG8_MMA(1, 1, At, B1); PG8_BAR; PG8_SCHED;
        }
        if constexpr (ALIGN_EPI) { if (wr == 0) PG8_BAR; }
        if constexpr (ES == 1) asm volatile("s_nop 15\n\ts_nop 15" ::: "memory");
        E(acc, cur, wr, wc, fr, fq); S.done(cur);
        if (!has_next) break;
#pragma unroll
        for (int a = 0; a < 2; ++a)
#pragma unroll
            for (int b = 0; b < 2; ++b)
#pragma unroll
                for (int m = 0; m < 4; ++m)
#pragma unroll
                    for (int n = 0; n < 2; ++n) acc[a][b][m][n] = (f32x4){0.f, 0.f, 0.f, 0.f};
        cur = nxt; cA = nA; cB = nB; ++ui;
        if constexpr (ALIGN_EPI) { if (wr == 1) PG8_BAR; }
    }
    PG8_WAIT_V(0);
    if constexpr (!ALIGN_EPI) { if (wr == 0) PG8_BAR; }
    PG8_BAR;
#undef PG8_SA
#undef PG8_SB
#undef PG8_STAGE
#undef PG8_LDA
#undef PG8_CAT
#undef PG8_LO
#undef PG8_HI
#undef PG8_LDB
#undef PG8_MMA
#undef PG8_WAIT_V
#undef PG8_WAIT_L
#undef PG8_BAR
#undef PG8_SCHED
}
}

constexpr int NWAVES = 8;
constexpr int BATCH = 4, SEQ = 2048, DM = 4096, M = BATCH * SEQ;
constexpr int NH = 16, HD = 128, NKV = 4, ATTW = 2048, KVW = 512, IH = 32, IDIM = 64, TOPK = 256;
constexpr int GMW = 2048, GMG = 8, GMGW = 256, GMC = 128, DFF = 11008, F2 = 2 * DFF;
constexpr int IN_W = 17504, MODW = 6 * DM;
constexpr float EPS = 1e-6f;
constexpr int PQ = 0, PK = 2048, PV = 2560, PQI = 3072, PGU = 5120, PGV = 7168, PGA = 9216, PGB = 13312, PKI = 17408, PWI = 17472, PNP = 17664;
constexpr int SQ = 0, SK = 2048, SV = 2560, SQI = 3072, SKI = 5120, SWI = 5184, SGU = 5216, SGV = 7264, SGA = 9312, SGB = 13408;

constexpr size_t MiB = 1u << 20;
constexpr size_t WS_CTL = 0, CTL_ZERO_BYTES = 65536;
constexpr size_t WS_MOD = 1 * MiB;
constexpr size_t WS_WIN = 2 * MiB;
constexpr size_t WS_WA = 140 * MiB, WS_WB = 156 * MiB;
constexpr size_t WS_WOUT = 172 * MiB;
constexpr size_t WS_WUP = 204 * MiB;
constexpr size_t WS_WDN = 376 * MiB;
constexpr size_t WS_H = 462 * MiB;
constexpr size_t WS_X1 = 526 * MiB;
constexpr size_t WS_PROJ = 654 * MiB;
constexpr size_t WS_MASK = 930 * MiB;
constexpr size_t WS_RS = 932 * MiB;
constexpr size_t WS_SWT = 932 * MiB + 65536;
constexpr size_t WS_VT = 933 * MiB;
constexpr size_t WS_YA = 941 * MiB, WS_YB = 973 * MiB;
constexpr size_t WS_MRG = 1005 * MiB;
constexpr size_t WS_TMP = 1069 * MiB;
constexpr size_t WS_A = 654 * MiB;
constexpr size_t WS_ACT = 998 * MiB;
constexpr size_t WS_WINB = 1197 * MiB;
constexpr size_t WS_END = 1336 * MiB;
static_assert(WS_WIN + (size_t)PNP * DM * 2 <= WS_WA && WS_WUP + (size_t)F2 * DM * 2 <= WS_WDN && WS_WDN + (size_t)DM * DFF * 2 <= WS_H, "ws map 1");
static_assert(WS_PROJ + (size_t)M * PNP * 2 <= WS_MASK && WS_A + (size_t)M * F2 * 2 <= WS_ACT && WS_ACT + (size_t)M * DFF * 2 <= WS_END && WS_TMP + (size_t)M * DM * 4 <= WS_END, "ws map 2");
constexpr int CW_TMO = 0, CW_CODE = 1, CW_BAR = 4096;

constexpr int RING_OFF = 0, RING_BYTES = 131072;
constexpr int LDSCTL_OFF = RING_BYTES + 8192, MISC_OFF = LDSCTL_OFF + 320;
constexpr int LDS_BYTES = 147456;
static_assert(MISC_OFF + 128 <= LDS_BYTES, "LDS map");

#define GAS __attribute__((address_space(1)))
#define LAS __attribute__((address_space(3)))
typedef unsigned short bf16;
typedef unsigned v4u __attribute__((ext_vector_type(4)));
typedef unsigned v2u __attribute__((ext_vector_type(2)));
typedef float f32x4 __attribute__((ext_vector_type(4)));
typedef float f32x16 __attribute__((ext_vector_type(16)));
typedef short bf16x8 __attribute__((ext_vector_type(8)));
typedef short bf16x4 __attribute__((ext_vector_type(4)));
typedef GAS unsigned gu32;
#define RLX_AGENT __ATOMIC_RELAXED, __HIP_MEMORY_SCOPE_AGENT
#define LDS_WAIT() asm volatile("s_waitcnt lgkmcnt(0)" ::: "memory")
#define VM_WAIT() asm volatile("s_waitcnt vmcnt(0)" ::: "memory")
__device__ __forceinline__ unsigned f2bf(float f) { unsigned u = __builtin_bit_cast(unsigned, f); return (u + 0x7fffu + ((u >> 16) & 1u)) >> 16; }
__device__ __forceinline__ unsigned pk2(float lo, float hi) { return pg8::cvt_pk_bf16(lo, hi); }
__device__ __forceinline__ float bf2f(bf16 h) { return __builtin_bit_cast(float, (unsigned)h << 16); }
using pg8::bflo; using pg8::bfhi;
constexpr float S_H2 = 16.f, S_WUP = 1024.f, S_ACT = 4.f, S_WDN = 1024.f, S_A = 16.f, S_YA = 16.f, S_YB = 8.f, S_MRG = 16.f, S_WA = 1024.f, S_WB = 1024.f, S_WOUT = 1024.f;
__device__ __forceinline__ float clamp448(float x) { return __builtin_amdgcn_fmed3f(x, -448.f, 448.f); }
__device__ __forceinline__ unsigned pk4_fp8(float a, float b, float c, float d) {
    int w = __builtin_amdgcn_cvt_pk_fp8_f32(clamp448(a), clamp448(b), 0, false);
    w = __builtin_amdgcn_cvt_pk_fp8_f32(clamp448(c), clamp448(d), w, true);
    return (unsigned)w;
}

#define XB_TMO      128
#define XB_XCNT(j)  (256  + 64 * (j))
#define XB_XSUB(j)  (1280 + 64 * (j))
#define XB_XGEN(j)  (2304 + 64 * (j))
#define XB_TOP      3328
#define XB_TOPGEN   3392
#define XCD_BAR_WORDS 3456
#define XB_SPIN_CAP (1u << 18)
__device__ __forceinline__ unsigned xb_ld(unsigned* p)              { return __hip_atomic_load(p, __ATOMIC_RELAXED, __HIP_MEMORY_SCOPE_AGENT); }
__device__ __forceinline__ unsigned xb_add(unsigned* p, unsigned v) { return __hip_atomic_fetch_add(p, v, __ATOMIC_RELAXED, __HIP_MEMORY_SCOPE_AGENT); }
__device__ __forceinline__ unsigned xb_xcc_id() { return (unsigned)__builtin_amdgcn_s_getreg((3 << 11) | 20) & 0xFu; }
#define XB_SPIN(cond, bar) do { unsigned _sp = 0; while (cond) { __builtin_amdgcn_s_sleep(1); \
    if ((++_sp & 255u) == 0u) { if (xb_ld(&(bar)[XB_TMO])) break; if (_sp > XB_SPIN_CAP) { atomicAdd(&(bar)[XB_TMO], 1u); break; } } } } while (0)
struct XcdBarrier { unsigned* bar; unsigned x; volatile LAS unsigned* st; };
__device__ __forceinline__ XcdBarrier xcd_barrier_post(unsigned* bar, volatile LAS unsigned* st) {
    XcdBarrier b; b.bar = bar; b.x = xb_xcc_id(); b.st = st;
    if (threadIdx.x == 0) (void)xb_add(&bar[XB_XCNT(b.x)], 1u);
    return b;
}
__device__ __forceinline__ void xcd_barrier_complete(unsigned* bar, unsigned x, unsigned& nloc, unsigned& nx) {
    const unsigned G = gridDim.x * gridDim.y * gridDim.z;
    unsigned sum, cnt, mine, sp = 0u;
    for (;;) {
        sum = 0u; cnt = 0u; mine = 0u;
#pragma unroll
        for (unsigned j = 0; j < 16; ++j) { const unsigned c = xb_ld(&bar[XB_XCNT(j)]); sum += c; cnt += (c > 0u) ? 1u : 0u; mine = (j == x) ? c : mine; }
        if (sum == G) break;
        __builtin_amdgcn_s_sleep(1);
        if ((++sp & 255u) == 0u) { if (xb_ld(&bar[XB_TMO])) break; if (sp > XB_SPIN_CAP) { atomicAdd(&bar[XB_TMO], 1u); break; } }
    }
    nloc = mine > 0u ? mine : 1u; nx = cnt > 0u ? cnt : 1u;
}
__device__ __forceinline__ void xcd_barrier(const XcdBarrier& b) {
    asm volatile("s_waitcnt vmcnt(0)" ::: "memory");
    __syncthreads();
    if (threadIdx.x == 0) {
        unsigned* bar = b.bar;
        __builtin_amdgcn_s_waitcnt(0);
        unsigned nloc = b.st[0], nx = b.st[1];
        if (nloc == 0u) { xcd_barrier_complete(bar, b.x, nloc, nx); b.st[0] = nloc; b.st[1] = nx; }
        const unsigned old = xb_add(&bar[XB_XSUB(b.x)], 1u);
        const unsigned gen = old / nloc;
        if (old + 1u == (gen + 1u) * nloc) {
            __builtin_amdgcn_fence(__ATOMIC_RELEASE, "agent");
            asm volatile("s_waitcnt vmcnt(0)" ::: "memory");
            const unsigned og = xb_add(&bar[XB_TOP], 1u);
            const unsigned tg = og / nx;
            if (og + 1u == (tg + 1u) * nx) xb_add(&bar[XB_TOPGEN], 1u);
            else XB_SPIN(xb_ld(&bar[XB_TOPGEN]) == tg, bar);
            __builtin_amdgcn_fence(__ATOMIC_ACQUIRE, "agent");
            xb_add(&bar[XB_XGEN(b.x)], 1u);
            asm volatile("s_waitcnt vmcnt(0)" ::: "memory");
        } else {
            XB_SPIN(xb_ld(&bar[XB_XGEN(b.x)]) == gen, bar);
            __builtin_amdgcn_fence(__ATOMIC_ACQUIRE, "agent");
            asm volatile("s_waitcnt vmcnt(0)" ::: "memory");
        }
    }
    __syncthreads();
}

struct Frame {
    LAS unsigned char* lds;
    volatile LAS unsigned* MISC;
    gu32* ctl;
    int tid, lane, wave, G, gw, NGW;
    const float *x, *c, *ada_w, *ada_b, *n1g, *w_in, *qng, *kng, *sgg, *sgw, *sgb, *w_a, *w_b, *w_out, *n2g, *w_up, *cvw, *cvb, *w_dn;
    float* out;
    float *MOD, *PART; bf16 *WINB; unsigned char* H8A; bf16 *WIN, *WA, *WB, *WOUT, *WUP, *WDN, *H, *PROJ, *VT, *YA, *YB, *MRG, *A, *ACT; float *X1, *TMP, *RS, *SWT; unsigned* MASK;
};
__device__ __forceinline__ void xor32_pair(float x, float& lo, float& hi) {
    float a = x, b = x; asm volatile("s_nop 1\n\tv_permlane32_swap_b32 %0, %1" : "+v"(a), "+v"(b)); lo = a; hi = b; }
__device__ __forceinline__ float xor32_sum(float x) { float lo, hi; xor32_pair(x, lo, hi); return lo + hi; }
__device__ __forceinline__ float xor32_max(float x) { float lo, hi; xor32_pair(x, lo, hi); return fmaxf(lo, hi); }
__device__ __forceinline__ unsigned wave_sum_u32(unsigned c) {
    c += (unsigned)__builtin_amdgcn_update_dpp(0, (int)c, 0xB1, 0xf, 0xf, true);
    c += (unsigned)__builtin_amdgcn_update_dpp(0, (int)c, 0x4E, 0xf, 0xf, true);
    c += (unsigned)__builtin_amdgcn_update_dpp(0, (int)c, 0x141, 0xf, 0xf, true);
    c += (unsigned)__builtin_amdgcn_update_dpp(0, (int)c, 0x140, 0xf, 0xf, true);
    { unsigned a = c, b = c; asm volatile("s_nop 1\n\tv_permlane16_swap_b32 %0, %1" : "+v"(a), "+v"(b)); c = a + b; }
    { unsigned a = c, b = c; asm volatile("s_nop 1\n\tv_permlane32_swap_b32 %0, %1" : "+v"(a), "+v"(b)); c = a + b; }
    return c;
}
template <int CTRL> __device__ __forceinline__ float dpp_f(float x) { return __builtin_bit_cast(float, __builtin_amdgcn_update_dpp(0, __builtin_bit_cast(int, x), CTRL, 0xf, 0xf, true)); }
__device__ __forceinline__ float sum4(float v) { v += dpp_f<0xB1>(v); v += dpp_f<0x4E>(v); return v; }
__device__ __forceinline__ float sum16(float v) { v = sum4(v); v += dpp_f<0x141>(v); v += dpp_f<0x140>(v); return v; }
__device__ __forceinline__ float wave_sum(float v) {
    v = sum16(v);
    { float a = v, b = v; asm volatile("s_nop 1\n\tv_permlane16_swap_b32 %0, %1" : "+v"(a), "+v"(b)); v = a + b; }
    return xor32_sum(v);
}

__device__ __forceinline__ int win_dst_row(int n) {
    if (n < SKI) return n;
    if (n < SWI) return PKI + (n - SKI);
    if (n < SGU) return PWI + (n - SWI);
    return PGU + (n - SGU);
}
__device__ __forceinline__ void gemv_item(Frame& F, int item) {
    const int nb = item % 96, ks = item / 96, n0 = nb * 256 + 4 * F.lane, k0 = ks * 64;
    float cs[4];
#pragma unroll
    for (int b = 0; b < 4; ++b) { const float cv = F.c[b * DM + k0 + F.lane]; cs[b] = cv * pg8::sigmoidf_(cv); }
    f32x4 acc[4];
#pragma unroll
    for (int b = 0; b < 4; ++b) acc[b] = (f32x4){0.f, 0.f, 0.f, 0.f};
    const float* wp = F.ada_w + (size_t)k0 * MODW + n0;
#pragma unroll 16
    for (int k = 0; k < 64; ++k) { const f32x4 w = __builtin_nontemporal_load((const GAS f32x4*)(wp + (size_t)k * MODW));
#pragma unroll
        for (int b = 0; b < 4; ++b) { const float s = __builtin_bit_cast(float, __builtin_amdgcn_readlane(__builtin_bit_cast(int, cs[b]), k)); acc[b] += w * s; } }
#pragma unroll
    for (int b = 0; b < 4; ++b) *(GAS f32x4*)(F.PART + (size_t)(ks * 4 + b) * MODW + n0) = acc[b];
}
__device__ __forceinline__ void mod_reduce(Frame& F) {
    for (int i = F.gw * 64 + F.lane; i < 4 * (MODW / 4); i += F.NGW * 64) { const int b = i / (MODW / 4), n0 = 4 * (i % (MODW / 4));
        f32x4 a = *(const GAS f32x4*)(F.ada_b + n0);
#pragma unroll 16
        for (int ks = 0; ks < 64; ++ks) a += *(const GAS f32x4*)(F.PART + (size_t)(ks * 4 + b) * MODW + n0);
        *(GAS f32x4*)(F.MOD + b * MODW + n0) = a; }
}
struct TrItem { const float* src; unsigned char* d8; bf16* db; int Nsrc, ldk, drow0, k0; float scale; };
__device__ __forceinline__ void tr_decode(Frame& F, int r, TrItem& t) {
    constexpr int P_IN = (DM / 128) * (IN_W / 32), P_A = (ATTW / 128) * (DM / 32), P_B = (GMW / 128) * (DM / 32), P_O = (DM / 128) * (DM / 32), P_UP = (DM / 128) * (F2 / 32);
    const float* W; int Nsrc, nblk, ldk, drow; unsigned char* d8; bf16* db = nullptr; float sc; bool up = false, in = false;
    if (r < P_IN) { W = F.w_in; Nsrc = IN_W; nblk = IN_W / 32; d8 = (unsigned char*)F.WIN; ldk = DM; sc = 1024.f; in = true; }
    else if ((r -= P_IN) < P_A) { W = F.w_a; Nsrc = DM; nblk = DM / 32; d8 = (unsigned char*)F.WA; ldk = 2 * ATTW; sc = S_WA; }
    else if ((r -= P_A) < P_B) { W = F.w_b; Nsrc = DM; nblk = DM / 32; d8 = (unsigned char*)F.WA + ATTW; ldk = 2 * ATTW; sc = S_WB; }
    else if ((r -= P_B) < P_O) { W = F.w_out; Nsrc = DM; nblk = DM / 32; d8 = (unsigned char*)F.WOUT; ldk = DM; sc = S_WOUT; }
    else if ((r -= P_O) < P_UP) { W = F.w_up; Nsrc = F2; nblk = F2 / 32; d8 = (unsigned char*)F.WUP; ldk = DM; sc = S_WUP; up = true; }
    else { r -= P_UP; W = F.w_dn; Nsrc = DM; nblk = DM / 32; d8 = (unsigned char*)F.WDN; ldk = DFF; sc = S_WDN; }
    const int kb = r / nblk, n = 32 * (r % nblk);
    drow = n;
    if (in) { drow = win_dst_row(n); if (n >= SQI && n < SGU) db = F.WINB; }
    if (up) { const int ch = n < DFF ? n : n - DFF; drow = (ch >> 7) * 256 + (ch & 127) + (n < DFF ? 0 : 128); }
    t.src = W + (size_t)(128 * kb) * Nsrc + n; t.d8 = d8; t.db = db; t.Nsrc = Nsrc; t.ldk = ldk; t.drow0 = drow; t.k0 = 128 * kb; t.scale = sc;
}
__device__ __forceinline__ void tr_load(const TrItem& t, int half, f32x4 (&v)[8], int lane) {
    const float* p = t.src + (size_t)(64 * half + (lane >> 3)) * t.Nsrc + 4 * (lane & 7);
#pragma unroll
    for (int i = 0; i < 8; ++i) v[i] = __builtin_nontemporal_load((const GAS f32x4*)(p + (size_t)(8 * i) * t.Nsrc));
}
__device__ __forceinline__ void tr_finish(const TrItem& t, int half, const f32x4 (&v)[8], LAS float* scr, int lane) {
#pragma unroll
    for (int i = 0; i < 8; ++i) { LAS float* s = scr + (8 * i + (lane >> 3)) * 33 + 4 * (lane & 7); s[0] = v[i].x; s[1] = v[i].y; s[2] = v[i].z; s[3] = v[i].w; }
    LDS_WAIT(); asm volatile("" ::: "memory");
    const int c = lane & 7, kcol = t.k0 + 64 * half + 8 * c; const float sc = t.scale;
#pragma unroll
    for (int j = 0; j < 4; ++j) { const int n = (lane >> 3) + 8 * j; const LAS float* s = scr + (8 * c) * 33 + n;
        const float e0 = s[0 * 33], e1 = s[1 * 33], e2 = s[2 * 33], e3 = s[3 * 33], e4 = s[4 * 33], e5 = s[5 * 33], e6 = s[6 * 33], e7 = s[7 * 33];
        v2u o; o.x = pk4_fp8(e0 * sc, e1 * sc, e2 * sc, e3 * sc); o.y = pk4_fp8(e4 * sc, e5 * sc, e6 * sc, e7 * sc);
        *(GAS v2u*)(t.d8 + (size_t)(t.drow0 + n) * t.ldk + kcol) = o;
        if (t.db) { v4u ob; ob.x = pk2(e0, e1); ob.y = pk2(e2, e3); ob.z = pk2(e4, e5); ob.w = pk2(e6, e7); *(GAS v4u*)(t.db + (size_t)(t.drow0 + n) * t.ldk + kcol) = ob; } }
    LDS_WAIT(); asm volatile("" ::: "memory");
}
constexpr int TR_P_IN = (DM / 128) * (IN_W / 32), TR_P_A = (ATTW / 128) * (DM / 32), TR_P_B = (GMW / 128) * (DM / 32), TR_P_O = (DM / 128) * (DM / 32), TR_P_UP = (DM / 128) * (F2 / 32), TR_P_DN = (DFF / 128) * (DM / 32);
constexpr int TR_OUT0 = TR_P_IN + TR_P_A + TR_P_B, TR_UP0 = TR_OUT0 + TR_P_O, TR_DN0 = TR_UP0 + TR_P_UP, TR_ALL = TR_DN0 + TR_P_DN;
constexpr int TR_AB_EARLY = 4096, TR_B_LATE = TR_P_A + TR_P_B - TR_AB_EARLY;
constexpr int TR_DN_LATE = 5120;
constexpr int TR_UP_TAIL = 32 * 32;
constexpr int TR_UP_67 = 28;
constexpr int TR_UP_SLOT = (TR_P_UP - TR_UP_TAIL - 2 * 256 * TR_UP_67 + 223) / 224;
constexpr int TR_AT0 = 84, TR_AT1 = 62, TR_N5 = 64 * (TR_AT0 + TR_AT1), TR_DN_MID = TR_P_DN - TR_DN_LATE - (TR_N5 - TR_P_O);
static_assert(TR_N5 >= TR_P_O && TR_DN_MID >= 0 && TR_AB_EARLY == 32 * 128, "conversion split");
template <int LIST> __device__ __forceinline__ int tr_map(int v) {
    if (LIST == 1) return v < TR_P_IN ? v : (v < TR_P_IN + TR_B_LATE ? v + TR_AB_EARLY : TR_DN0 + (TR_N5 - TR_P_O) + (v - TR_P_IN - TR_B_LATE));
    if (LIST == 5) return TR_UP0 + TR_UP_TAIL + 2 * 256 * TR_UP_67 + v;
    if (LIST == 6) return TR_UP0 + TR_UP_TAIL + v;
    if (LIST == 4) return v < TR_AB_EARLY ? TR_P_IN + v : TR_UP0 + (v - TR_AB_EARLY);
    if (LIST == 2) return v < TR_P_O ? TR_OUT0 + v : TR_DN0 + (v - TR_P_O);
    if (LIST == 3) return TR_ALL - TR_DN_LATE + v;
    return v;
}
template <int LIST> __device__ __forceinline__ void tr_run(Frame& F, int r0, int rend, int stride, LAS float* scr) {
    TrItem A, B; f32x4 a0[8], a1[8], b0[8], b1[8];
    int r = r0; bool hasA = r < rend;
    if (hasA) { tr_decode(F, tr_map<LIST>(r), A); tr_load(A, 0, a0, F.lane); tr_load(A, 1, a1, F.lane); }
    while (hasA) {
        const int rb = r + stride; const bool hasB = rb < rend;
        if (hasB) { tr_decode(F, tr_map<LIST>(rb), B); tr_load(B, 0, b0, F.lane); tr_load(B, 1, b1, F.lane); }
        tr_finish(A, 0, a0, scr, F.lane); tr_finish(A, 1, a1, scr, F.lane);
        if (!hasB) break;
        r = rb + stride; hasA = r < rend;
        if (hasA) { tr_decode(F, tr_map<LIST>(r), A); tr_load(A, 0, a0, F.lane); tr_load(A, 1, a1, F.lane); }
        tr_finish(B, 0, b0, scr, F.lane); tr_finish(B, 1, b1, scr, F.lane);
    }
}
__device__ __forceinline__ void p0_prologue(Frame& F, bool with_gemv = true) {
    LAS float* scr = (LAS float*)(F.lds + RING_OFF + F.wave * 16384);
    constexpr int I_GV = 96 * 64;
    if (with_gemv) for (int it = F.gw; it < I_GV; it += F.NGW) gemv_item(F, it);
    if (F.G == 256) tr_run<1>(F, F.gw, TR_P_IN + TR_B_LATE + TR_DN_MID, F.NGW, scr); else tr_run<0>(F, F.gw, TR_ALL, F.NGW, scr);
    { const size_t n16 = (size_t)(PNP - IN_W) * DM / 16; GAS v4u* p = (GAS v4u*)((unsigned char*)F.WIN + (size_t)IN_W * DM);
      for (size_t i = (size_t)F.gw * 64 + F.lane; i < n16; i += (size_t)F.NGW * 64) p[i] = (v4u){0u, 0u, 0u, 0u};
      GAS v4u* pb = (GAS v4u*)(F.WINB + (size_t)IN_W * DM);
      for (size_t i = (size_t)F.gw * 64 + F.lane; i < 2 * n16; i += (size_t)F.NGW * 64) pb[i] = (v4u){0u, 0u, 0u, 0u}; }
}

template <int FP8 = 0, bool XBF = false>
__device__ __forceinline__ void norm_rows(Frame& F, const void* X, const float* gain, int sh_off, int sc_off, void* Ov, unsigned char* O8 = nullptr) {
    LAS f32x4* CA = (LAS f32x4*)F.lds; LAS f32x4* CB = (LAS f32x4*)(F.lds + 16384);
    for (int blk = blockIdx.x; blk < M / 32; blk += F.G) {
        const int b = (blk * 32) >> 11;
        __syncthreads();
        for (int i = F.tid; i < DM / 4; i += NWAVES * 64) { const f32x4 g = ((const GAS f32x4*)gain)[i], sh = ((const GAS f32x4*)(F.MOD + b * MODW + sh_off))[i], sc = ((const GAS f32x4*)(F.MOD + b * MODW + sc_off))[i];
            CA[i] = g * (sc + 1.0f); CB[i] = sh; }
        __syncthreads();
        const int m0 = blk * 32 + 4 * F.wave;
        f32x4 va[16], vb[16];
#define NR_LOAD(v, m_) do { if constexpr (XBF) { const GAS v2u* xr = (const GAS v2u*)((const bf16*)X + (size_t)(m_) * DM) + F.lane; _Pragma("unroll") for (int j = 0; j < 16; ++j) { const v2u w_ = xr[64 * j]; v[j] = (f32x4){bflo(w_.x), bfhi(w_.x), bflo(w_.y), bfhi(w_.y)}; } } \
        else { const GAS f32x4* xr = (const GAS f32x4*)((const float*)X + (size_t)(m_) * DM) + F.lane; _Pragma("unroll") for (int j = 0; j < 16; ++j) v[j] = __builtin_nontemporal_load(xr + 64 * j); } } while (0)
#define NR_FIN(v, m_) do { float s_ = 0.f; _Pragma("unroll") for (int j = 0; j < 16; ++j) s_ += (v[j].x * v[j].x + v[j].y * v[j].y) + (v[j].z * v[j].z + v[j].w * v[j].w); \
            const float rstd = 1.0f / sqrtf(wave_sum(s_) * (1.f / DM) + EPS); \
            GAS v2u* o8 = (GAS v2u*)((bf16*)Ov + (size_t)(m_) * DM) + F.lane; GAS unsigned* o4 = (GAS unsigned*)((FP8 == 2 ? O8 : (unsigned char*)Ov) + (size_t)(m_) * DM) + F.lane; \
            _Pragma("unroll") for (int j = 0; j < 16; ++j) { const f32x4 y = (v[j] * rstd) * CA[64 * j + F.lane] + CB[64 * j + F.lane]; \
                if constexpr (FP8 != 0) o4[64 * j] = pk4_fp8(y.x * S_H2, y.y * S_H2, y.z * S_H2, y.w * S_H2); \
                if constexpr (FP8 != 1) { v2u w_; w_.x = pk2(y.x, y.y); w_.y = pk2(y.z, y.w); o8[64 * j] = w_; } \
                if ((j & 3) == 3) asm volatile("" ::: "memory"); } } while (0)
        NR_LOAD(va, m0); NR_LOAD(vb, m0 + 1); NR_FIN(va, m0); NR_LOAD(va, m0 + 2); NR_FIN(vb, m0 + 1); NR_LOAD(vb, m0 + 3); NR_FIN(va, m0 + 2); NR_FIN(vb, m0 + 3);
#undef NR_LOAD
#undef NR_FIN
    }
}

__device__ __forceinline__ unsigned sortable(float f) { const unsigned u = __builtin_bit_cast(unsigned, f); return u ^ ((unsigned)((int)u >> 31) | 0x80000000u); }
__device__ __forceinline__ void select_topk(const unsigned (&sc)[32], GAS v2u* mrow, int lane) {
    unsigned thr = 0u;
    for (int bit = 31; bit >= 0; --bit) {
        const unsigned cand = thr | (1u << bit); unsigned c = 0u;
#pragma unroll
        for (int jp = 0; jp < 32; ++jp) c += (sc[jp] >= cand) ? 1u : 0u;
        c = (unsigned)__builtin_amdgcn_readfirstlane((int)wave_sum_u32(c));
        if (c == (unsigned)TOPK) {
            unsigned mylo = 0u, myhi = 0u;
#pragma unroll
            for (int jp = 0; jp < 32; ++jp) { const unsigned long long sel = __ballot(sc[jp] >= cand); if (lane == jp) { mylo = (unsigned)sel; myhi = (unsigned)(sel >> 32); } }
            if (lane < 32) { v2u w; w.x = mylo; w.y = myhi; mrow[lane] = w; }
            return;
        }
        if (c > (unsigned)TOPK) thr = cand;
    }
    thr = (unsigned)__builtin_amdgcn_readfirstlane((int)thr);
    int cgt = 0;
#pragma unroll
    for (int jp = 0; jp < 32; ++jp) cgt += __popcll(__ballot(sc[jp] > thr));
    const int need = TOPK - cgt; int seen = 0;
    unsigned mylo = 0u, myhi = 0u;
    const unsigned long long lt = (lane == 0) ? 0ull : (~0ull >> (64 - lane));
#pragma unroll
    for (int jp = 0; jp < 32; ++jp) {
        unsigned long long sel = __ballot(sc[jp] > thr);
        const unsigned long long eq = __ballot(sc[jp] == thr);
        if (eq) { const bool take = (sc[jp] == thr) && (seen + __popcll(eq & lt) < need); sel |= __ballot(take); seen += __popcll(eq); }
        if (lane == jp) { mylo = (unsigned)sel; myhi = (unsigned)(sel >> 32); }
    }
    if (lane < 32) { v2u w; w.x = mylo; w.y = myhi; mrow[lane] = w; }
}
__device__ __forceinline__ void idx_block(Frame& F, int b, int blk) {
    const int lane = F.lane, w = F.wave, hi = lane >> 5, l31 = lane & 31, tid = F.tid;
    const int t0 = blk * 8, tq = t0 + w;
    const size_t row = (size_t)b * SEQ + tq;
    GAS v2u* mrow = (GAS v2u*)(F.MASK + row * 64);
    if (t0 < TOPK) {
        if (lane < 32) { const int k0 = 64 * lane; v2u mw;
            mw.x = (tq >= k0 + 31) ? 0xffffffffu : (tq < k0 ? 0u : ((2u << (tq - k0)) - 1u));
            mw.y = (tq >= k0 + 63) ? 0xffffffffu : (tq < k0 + 32 ? 0u : ((2u << (tq - k0 - 32)) - 1u));
            mrow[lane] = mw; }
        return;
    }
    const int nt = (t0 + 7) / 128 + 1;
    const bf16* prow = F.PROJ + row * PNP;
    bf16x8 qa[4]; float wv[16];
#pragma unroll
    for (int ks = 0; ks < 4; ++ks) qa[ks] = *(const GAS bf16x8*)(prow + PQI + l31 * 64 + 16 * ks + 8 * hi);
#pragma unroll
    for (int r = 0; r < 16; ++r) wv[r] = bf2f(prow[PWI + (r & 3) + 8 * (r >> 2) + 4 * hi]);
    const bf16* ksrc = F.PROJ + ((size_t)b * SEQ + (tid >> 3)) * PNP + PKI + 8 * (tid & 7);
    const int kdst = (tid >> 3) * 128 + (((tid & 7) ^ ((tid >> 3) & 7)) << 4);
    const int krd = l31 * 128;
    unsigned sc[32];
    __syncthreads();
    v4u stg[3][2];
#pragma unroll
    for (int i = 0; i < 3; ++i) if (i < nt) { stg[i][0] = *(const GAS v4u*)(ksrc + (size_t)(i * 128) * PNP); stg[i][1] = *(const GAS v4u*)(ksrc + (size_t)(i * 128 + 64) * PNP); }
#pragma unroll
    for (int kt = 0; kt < 16; ++kt) {
        if (kt < nt) {
            LAS unsigned char* kb_base = F.lds + (kt & 1) * 16384;
            *(LAS v4u*)(kb_base + kdst) = stg[kt % 3][0]; *(LAS v4u*)(kb_base + 8192 + kdst) = stg[kt % 3][1];
            if (kt + 3 < nt) { stg[kt % 3][0] = *(const GAS v4u*)(ksrc + (size_t)(kt + 3) * 128 * PNP); stg[kt % 3][1] = *(const GAS v4u*)(ksrc + (size_t)((kt + 3) * 128 + 64) * PNP); }
            LDS_WAIT(); __builtin_amdgcn_s_barrier(); asm volatile("" ::: "memory");
            float s4[4];
            f32x16 accp, accc;
#define IDX_MM(dst, h_) do { const f32x16 z_ = {0.f,0.f,0.f,0.f,0.f,0.f,0.f,0.f,0.f,0.f,0.f,0.f,0.f,0.f,0.f,0.f}; \
                const bf16x8 k0_ = *(const LAS bf16x8*)(kb_base + (h_) * 4096 + krd + (((0 + hi) ^ (l31 & 7)) << 4)), k1_ = *(const LAS bf16x8*)(kb_base + (h_) * 4096 + krd + (((2 + hi) ^ (l31 & 7)) << 4)); \
                const bf16x8 k2_ = *(const LAS bf16x8*)(kb_base + (h_) * 4096 + krd + (((4 + hi) ^ (l31 & 7)) << 4)), k3_ = *(const LAS bf16x8*)(kb_base + (h_) * 4096 + krd + (((6 + hi) ^ (l31 & 7)) << 4)); \
                dst = __builtin_amdgcn_mfma_f32_32x32x16_bf16(qa[0], k0_, z_, 0, 0, 0); dst = __builtin_amdgcn_mfma_f32_32x32x16_bf16(qa[1], k1_, dst, 0, 0, 0); \
                dst = __builtin_amdgcn_mfma_f32_32x32x16_bf16(qa[2], k2_, dst, 0, 0, 0); dst = __builtin_amdgcn_mfma_f32_32x32x16_bf16(qa[3], k3_, dst, 0, 0, 0); } while (0)
#define IDX_RED(src, h_) do { float x0 = 0.f, x1 = 0.f; _Pragma("unroll") for (int r = 0; r < 16; r += 2) { float m0_, m1_; \
                    asm("v_max_f32 %0, 0, %1" : "=v"(m0_) : "v"(src[r])); asm("v_max_f32 %0, 0, %1" : "=v"(m1_) : "v"(src[r + 1]));     \
                    x0 += wv[r] * m0_; x1 += wv[r + 1] * m1_; } s4[h_] = xor32_sum(x0 + x1); } while (0)
            IDX_MM(accp, 0); __builtin_amdgcn_sched_barrier(0);
            IDX_MM(accc, 1); __builtin_amdgcn_sched_barrier(0); IDX_RED(accp, 0); __builtin_amdgcn_sched_barrier(0);
            IDX_MM(accp, 2); __builtin_amdgcn_sched_barrier(0); IDX_RED(accc, 1); __builtin_amdgcn_sched_barrier(0);
            IDX_MM(accc, 3); __builtin_amdgcn_sched_barrier(0); IDX_RED(accp, 2); __builtin_amdgcn_sched_barrier(0);
            IDX_RED(accc, 3);
#undef IDX_MM
#undef IDX_RED
            const float ma = (lane < 32 ? s4[0] : s4[1]) + 0.0f, mb = (lane < 32 ? s4[2] : s4[3]) + 0.0f;
            sc[2 * kt] = (128 * kt + lane <= tq) ? sortable(ma) : 0u;
            sc[2 * kt + 1] = (128 * kt + 64 + lane <= tq) ? sortable(mb) : 0u;
        } else { sc[2 * kt] = 0u; sc[2 * kt + 1] = 0u; }
    }
    select_topk(sc, mrow, lane);
}
constexpr float QSCALE = 0.08838834764831845f * 1.4426950408889634f;
struct QkRow { v4u q[4], k, g[4]; };
__device__ __forceinline__ void qk_load(Frame& F, int row, QkRow& R) {
    const bf16* prow = F.PROJ + (size_t)row * PNP; const int lane = F.lane;
#pragma unroll
    for (int i = 0; i < 4; ++i) { R.q[i] = ((const GAS v4u*)(prow + PQ + 32 * lane))[i]; R.g[i] = ((const GAS v4u*)(prow + PGV + 32 * lane))[i]; }
    R.k = *(const GAS v4u*)(prow + PK + 8 * lane);
}
__device__ __forceinline__ void qk_finish(Frame& F, int row, const QkRow& R) {
    bf16* prow = F.PROJ + (size_t)row * PNP; const int lane = F.lane;
    {
        float ss = 0.f;
#pragma unroll
        for (int i = 0; i < 4; ++i)
#pragma unroll
            for (int j = 0; j < 4; ++j) { const float a = bflo(R.q[i][j]), c = bfhi(R.q[i][j]); ss += a * a + c * c; }
        ss = sum4(ss);
        const float r = QSCALE / sqrtf(ss * (1.f / HD) + EPS); const float* g = F.qng + 32 * (lane & 3);
#pragma unroll
        for (int i = 0; i < 4; ++i) { v4u o;
#pragma unroll
            for (int j = 0; j < 4; ++j) o[j] = pk2(bflo(R.q[i][j]) * r * g[8 * i + 2 * j], bfhi(R.q[i][j]) * r * g[8 * i + 2 * j + 1]);
            ((GAS v4u*)(prow + PQ + 32 * lane))[i] = o; }
    }
    {
        float ss = 0.f;
#pragma unroll
        for (int j = 0; j < 4; ++j) { const float a = bflo(R.k[j]), c = bfhi(R.k[j]); ss += a * a + c * c; }
        ss = sum16(ss);
        const float r = 1.0f / sqrtf(ss * (1.f / HD) + EPS); const float* g = F.kng + 8 * (lane & 15); v4u o;
#pragma unroll
        for (int j = 0; j < 4; ++j) o[j] = pk2(bflo(R.k[j]) * r * g[2 * j], bfhi(R.k[j]) * r * g[2 * j + 1]);
        *(GAS v4u*)(prow + PK + 8 * lane) = o;
    }
    {
        float ss = 0.f;
#pragma unroll
        for (int i = 0; i < 4; ++i)
#pragma unroll
            for (int j = 0; j < 4; ++j) { const float a = bflo(R.g[i][j]), c = bfhi(R.g[i][j]); ss += a * a + c * c; }
        ss = wave_sum(ss);
        if (lane == 0) F.RS[row] = 1.0f / sqrtf(ss * (1.f / GMW) + EPS);
    }
}
__device__ __forceinline__ void qknorm_rows(Frame& F) {
    QkRow A, B; int row = F.gw; bool hasA = row < M;
    if (hasA) qk_load(F, row, A);
    while (hasA) {
        const int rb = row + F.NGW; const bool hasB = rb < M;
        if (hasB) qk_load(F, rb, B);
        qk_finish(F, row, A);
        if (!hasB) break;
        row = rb + F.NGW; hasA = row < M;
        if (hasA) qk_load(F, row, A);
        qk_finish(F, rb, B);
    }
}
__device__ __forceinline__ void vt_items(Frame& F) {
    constexpr int NI = BATCH * NKV * 2 * 256;
    for (int it0 = F.gw; it0 < NI; it0 += 4 * F.NGW) {
        unsigned e[4][8];
#pragma unroll
        for (int q = 0; q < 4; ++q) { const int item = it0 + q * F.NGW;
            if (item < NI) { const int s8 = item & 255, dh = (item >> 8) & 1, g = (item >> 9) & 3, b = item >> 11, d = 64 * dh + F.lane;
                const bf16* src = F.PROJ + (size_t)(b * SEQ + 8 * s8) * PNP + PV + g * HD + d;
#pragma unroll
                for (int j = 0; j < 8; ++j) e[q][j] = src[(size_t)j * PNP]; } }
#pragma unroll
        for (int q = 0; q < 4; ++q) { const int item = it0 + q * F.NGW;
            if (item < NI) { const int s8 = item & 255, dh = (item >> 8) & 1, g = (item >> 9) & 3, b = item >> 11, d = 64 * dh + F.lane;
                v4u o; o.x = e[q][0] | (e[q][1] << 16); o.y = e[q][2] | (e[q][3] << 16); o.z = e[q][4] | (e[q][5] << 16); o.w = e[q][6] | (e[q][7] << 16);
                *(GAS v4u*)(F.VT + ((size_t)((b * NKV + g) * HD + d)) * SEQ + 8 * s8) = o; } }
    }
}

constexpr int AT_KSTR = 272, AT_VSTR = 136, AT_TILE = 17408;
#define RAW_BARRIER() do { LDS_WAIT(); __builtin_amdgcn_s_barrier(); asm volatile("" ::: "memory"); } while (0)
__device__ __forceinline__ void attn_block(Frame& F, int b, int g, int qb, float sbound) {
    const int lane = F.lane, w = F.wave, hi = lane >> 5, l31 = lane & 31, tid = F.tid;
    const int hh = 4 * g + (w >> 1), tw0 = qb * 64 + 32 * (w & 1), t = tw0 + l31;
    const size_t row = (size_t)b * SEQ + t;
    const float slope2 = exp2f(-0.5f * (float)(hh + 1)) * 1.4426950408889634f;
    bf16x8 qf[8];
#pragma unroll
    for (int ks = 0; ks < 8; ++ks) qf[ks] = *(const GAS bf16x8*)(F.PROJ + row * PNP + PQ + hh * HD + 16 * ks + 8 * hi);
    f32x16 o[4];
#pragma unroll
    for (int db = 0; db < 4; ++db)
#pragma unroll
        for (int r = 0; r < 16; ++r) o[db][r] = 0.f;
    float m = -1e30f, lsum = 0.f;
    const bf16* ksrc = F.PROJ + ((size_t)b * SEQ + (tid >> 4)) * PNP + PK + g * HD + 8 * (tid & 15);
    const int kdst = (tid >> 4) * AT_KSTR + (tid & 15) * 16;
    const bf16* vsrc = F.VT + ((size_t)((b * NKV + g) * HD + (tid >> 3))) * SEQ + 8 * (tid & 7);
    const int vdst = 2 * AT_TILE + (tid >> 3) * AT_VSTR + (tid & 7) * 16;
    const unsigned* mbase = F.MASK + row * 64;
    LAS unsigned char* L = F.lds;
    v4u sk0, sk1, sv0, sv1; v2u mw, mwn;
#define AT_LOAD(kt_) do { sk0 = *(const GAS v4u*)(ksrc + (size_t)(64 * (kt_)) * PNP); sk1 = *(const GAS v4u*)(ksrc + (size_t)(64 * (kt_) + 32) * PNP); \
        sv0 = *(const GAS v4u*)(vsrc + 64 * (kt_)); sv1 = *(const GAS v4u*)(vsrc + (size_t)64 * SEQ + 64 * (kt_)); mwn = *(const GAS v2u*)(mbase + 2 * (kt_)); } while (0)
#define AT_STORE(bf_) do { *(LAS v4u*)(L + (bf_) * AT_TILE + kdst) = sk0; *(LAS v4u*)(L + (bf_) * AT_TILE + kdst + 32 * AT_KSTR) = sk1; \
        LAS unsigned char* _v = L + (bf_) * AT_TILE + vdst; *(LAS v2u*)_v = (v2u){sv0.x, sv0.y}; *(LAS v2u*)(_v + 8) = (v2u){sv0.z, sv0.w}; \
        *(LAS v2u*)(_v + 64 * AT_VSTR) = (v2u){sv1.x, sv1.y}; *(LAS v2u*)(_v + 64 * AT_VSTR + 8) = (v2u){sv1.z, sv1.w}; } while (0)
    RAW_BARRIER();
    AT_LOAD(qb); AT_STORE(0); mw = mwn;
    int buf = 0; bool dead = false;
    for (int kt = qb; kt >= 0; --kt) {
        if (kt > 0) AT_LOAD(kt - 1);
        RAW_BARRIER();
        if (!dead) {
            const float dmin = (float)(tw0 - (64 * kt + 63));
            dead = __all((sbound - slope2 * dmin) < (m - 40.0f));
        }
        if (!dead) {
            const LAS unsigned char* kb_ = L + buf * AT_TILE + l31 * AT_KSTR + hi * 16;
            const LAS unsigned char* vb_ = L + buf * AT_TILE + 2 * AT_TILE + l31 * AT_VSTR + hi * 8;
            f32x16 p[2];
#pragma unroll
            for (int kb = 0; kb < 2; ++kb) { const unsigned mword = (kb ? mw.y : mw.x) >> (4 * hi);
#pragma unroll
                for (int r = 0; r < 16; ++r) { const int ko = (r & 3) + 8 * (r >> 2);
                    const unsigned tm = (unsigned)__builtin_amdgcn_sbfe((int)mword, ko, 1);
                    p[kb][r] = __builtin_bit_cast(float, (__builtin_bit_cast(unsigned, slope2 * (float)(32 * kb + ko)) & tm) | (__builtin_bit_cast(unsigned, -2e30f) & ~tm)); } }
            {
                bf16x8 ka[4], kc[4];
#define AT_LDK(dst, kb_i, g_) do { _Pragma("unroll") for (int q_ = 0; q_ < 4; ++q_) dst[q_] = *(const LAS bf16x8*)(kb_ + (kb_i) * 32 * AT_KSTR + (4 * (g_) + q_) * 32); } while (0)
#define AT_MMK(kb_i, src, g_) do { _Pragma("unroll") for (int q_ = 0; q_ < 4; ++q_) p[kb_i] = __builtin_amdgcn_mfma_f32_32x32x16_bf16(src[q_], qf[4 * (g_) + q_], p[kb_i], 0, 0, 0); } while (0)
                AT_LDK(ka, 0, 0); __builtin_amdgcn_sched_barrier(0); AT_MMK(0, ka, 0); __builtin_amdgcn_sched_barrier(0);
                AT_LDK(kc, 0, 1); __builtin_amdgcn_sched_barrier(0); AT_MMK(0, kc, 1); __builtin_amdgcn_sched_barrier(0);
                AT_LDK(ka, 1, 0); __builtin_amdgcn_sched_barrier(0); AT_MMK(1, ka, 0); __builtin_amdgcn_sched_barrier(0);
                AT_LDK(kc, 1, 1); __builtin_amdgcn_sched_barrier(0); AT_MMK(1, kc, 1); __builtin_amdgcn_sched_barrier(0);
#undef AT_LDK
#undef AT_MMK
            }
            const float base = -slope2 * (float)(t - 64 * kt - 4 * hi);
            float rmax = -3e30f;
#pragma unroll
            for (int kb = 0; kb < 2; ++kb)
#pragma unroll
                for (int r = 0; r < 16; ++r) rmax = fmaxf(rmax, p[kb][r]);
            rmax += base; rmax = xor32_max(rmax);
            const float mn = fmaxf(m, rmax), alpha = __builtin_amdgcn_exp2f(m - mn), mrel = mn - base;
            const bool moved = __any(mn != m);
            m = mn;
            float ps = 0.f;
#pragma unroll
            for (int kb = 0; kb < 2; ++kb)
#pragma unroll
                for (int r = 0; r < 16; ++r) { const float e = __builtin_amdgcn_exp2f(p[kb][r] - mrel); p[kb][r] = e; ps += e; }
            lsum = lsum * alpha + ps;
            if (moved) {
#pragma unroll
                for (int db = 0; db < 4; ++db)
#pragma unroll
                    for (int r = 0; r < 16; ++r) o[db][r] *= alpha;
            }
            {
                v4u va[4], vc[4];
#define AT_LDV(dst, st_) do { _Pragma("unroll") for (int db = 0; db < 4; ++db) { const LAS unsigned char* vp = vb_ + db * 32 * AT_VSTR + (st_) * 32; const v2u v0 = *(const LAS v2u*)vp, v1 = *(const LAS v2u*)(vp + 16); \
                    dst[db] = (v4u){v0.x, v0.y, v1.x, v1.y}; } } while (0)
#define AT_MMV(src, st_) do { const int kb_i = (st_) >> 1, s2 = (st_) & 1; v4u pw; pw.x = pk2(p[kb_i][8 * s2 + 0], p[kb_i][8 * s2 + 1]); pw.y = pk2(p[kb_i][8 * s2 + 2], p[kb_i][8 * s2 + 3]); \
                    pw.z = pk2(p[kb_i][8 * s2 + 4], p[kb_i][8 * s2 + 5]); pw.w = pk2(p[kb_i][8 * s2 + 6], p[kb_i][8 * s2 + 7]); const bf16x8 pb = __builtin_bit_cast(bf16x8, pw); \
                    _Pragma("unroll") for (int db = 0; db < 4; ++db) o[db] = __builtin_amdgcn_mfma_f32_32x32x16_bf16(__builtin_bit_cast(bf16x8, src[db]), pb, o[db], 0, 0, 0); } while (0)
                AT_LDV(va, 0); __builtin_amdgcn_sched_barrier(0); AT_MMV(va, 0); __builtin_amdgcn_sched_barrier(0);
                AT_LDV(vc, 1); __builtin_amdgcn_sched_barrier(0); AT_MMV(vc, 1); __builtin_amdgcn_sched_barrier(0);
                AT_LDV(va, 2); __builtin_amdgcn_sched_barrier(0); AT_MMV(va, 2); __builtin_amdgcn_sched_barrier(0);
                AT_LDV(vc, 3); __builtin_amdgcn_sched_barrier(0); AT_MMV(vc, 3); __builtin_amdgcn_sched_barrier(0);
#undef AT_LDV
#undef AT_MMV
            }
        }
        if (kt > 0) { AT_STORE(buf ^ 1); mw = mwn; }
        buf ^= 1;
    }
#undef AT_LOAD
#undef AT_STORE
    lsum = xor32_sum(lsum);
    const float inv = S_YA / lsum;
    unsigned char* yrow = (unsigned char*)F.YA + row * (2 * ATTW) + hh * HD + 4 * hi;
#pragma unroll
    for (int db = 0; db < 4; ++db)
#pragma unroll
        for (int rq = 0; rq < 4; ++rq) *(GAS unsigned*)(yrow + 32 * db + 8 * rq) = pk4_fp8(o[db][4 * rq] * inv, o[db][4 * rq + 1] * inv, o[db][4 * rq + 2] * inv, o[db][4 * rq + 3] * inv);
}
__device__ __forceinline__ float attn_score_bound(Frame& F) {
    float gq = fmaxf(fabsf(F.qng[F.lane]), fabsf(F.qng[F.lane + 64])), gk = fmaxf(fabsf(F.kng[F.lane]), fabsf(F.kng[F.lane + 64]));
#pragma unroll
    for (int o = 1; o < 64; o <<= 1) { gq = fmaxf(gq, __shfl_xor(gq, o)); gk = fmaxf(gk, __shfl_xor(gk, o)); }
    return 1.02f * 128.0f * gq * gk * QSCALE;
}

constexpr int SG_STR = 272, SG_WOFF = 65536;
__device__ __forceinline__ void sgu_unit(Frame& F, int unit) {
    const int ck = unit >> 3, g = unit & 7, r0 = ck * GMC, c0 = g * GMGW, tid = F.tid, lane = F.lane, w = F.wave, hi = lane >> 5, l31 = lane & 31;
    LAS unsigned char* L = F.lds;
    const int rs_ = tid >> 5, q_ = tid & 31;
    __syncthreads();
#pragma unroll
    for (int i = 0; i < 8; ++i) *(LAS v4u*)(L + (rs_ + 16 * i) * 512 + q_ * 16) = *(const GAS v4u*)(F.PROJ + (size_t)(r0 + rs_ + 16 * i) * PNP + PGV + c0 + 8 * q_);
    { const f32x4 q = *(const GAS f32x4*)(F.RS + r0 + 4 * q_);
#pragma unroll
      for (int i = 0; i < 8; ++i) { const int t_ = rs_ + 16 * i; const f32x4 wv = *(const GAS f32x4*)(F.sgw + ((size_t)(g * GMC + t_)) * GMC + 4 * q_);
          const int sb = 4 * q_; v2u o;
          o.x = pk2(sb + 0 <= t_ ? wv.x * q.x : 0.f, sb + 1 <= t_ ? wv.y * q.y : 0.f); o.y = pk2(sb + 2 <= t_ ? wv.z * q.z : 0.f, sb + 3 <= t_ ? wv.w * q.w : 0.f);
          *(LAS v2u*)(L + SG_WOFF + t_ * SG_STR + 8 * q_) = o; } }
    __syncthreads();
    v4u uu[8];
#pragma unroll
    for (int i = 0; i < 8; ++i) uu[i] = *(const GAS v4u*)(F.PROJ + (size_t)(r0 + rs_ + 16 * i) * PNP + PGU + c0 + 8 * q_);
    f32x16 acc[4];
#pragma unroll
    for (int tb = 0; tb < 4; ++tb)
#pragma unroll
        for (int r = 0; r < 16; ++r) acc[tb][r] = 0.f;
    const LAS unsigned char* xb = L + hi * 8 * 512 + 2 * (32 * w + l31);
    const LAS unsigned char* wa = L + SG_WOFF + l31 * SG_STR + hi * 16;
#pragma unroll
    for (int ks = 0; ks < 8; ++ks) {
        v4u xw;
#pragma unroll
        for (int j = 0; j < 4; ++j) { const unsigned lo = *(const LAS unsigned short*)(xb + (16 * ks + 2 * j) * 512), hh = *(const LAS unsigned short*)(xb + (16 * ks + 2 * j + 1) * 512); xw[j] = lo | (hh << 16); }
        const bf16x8 xf = __builtin_bit_cast(bf16x8, xw);
#pragma unroll
        for (int tb = 0; tb < 4; ++tb) if (ks < 2 * (tb + 1)) { const bf16x8 wf = *(const LAS bf16x8*)(wa + tb * 32 * SG_STR + ks * 32); acc[tb] = __builtin_amdgcn_mfma_f32_32x32x16_bf16(wf, xf, acc[tb], 0, 0, 0); } }
    LDS_WAIT(); __builtin_amdgcn_s_barrier(); asm volatile("" ::: "memory");
    { const int cl = 32 * w + l31;
#pragma unroll
      for (int tb = 0; tb < 4; ++tb)
#pragma unroll
          for (int r = 0; r < 16; ++r) { const int t = 32 * tb + (r & 3) + 8 * (r >> 2) + 4 * hi; *(LAS unsigned short*)(L + t * 512 + 2 * cl) = (unsigned short)f2bf(acc[tb][r]); } }
    const f32x4 g0 = *(const GAS f32x4*)(F.sgg + c0 + 8 * q_), g1 = *(const GAS f32x4*)(F.sgg + c0 + 8 * q_ + 4);
    LDS_WAIT(); __builtin_amdgcn_s_barrier(); asm volatile("" ::: "memory");
#pragma unroll
    for (int i = 0; i < 8; ++i) { const v4u fw = *(const LAS v4u*)(L + (rs_ + 16 * i) * 512 + q_ * 16); const float bb = F.sgb[g * GMC + rs_ + 16 * i]; v2u o;
        o.x = pk4_fp8(S_YB * bflo(uu[i].x) * (bflo(fw.x) * g0.x + bb), S_YB * bfhi(uu[i].x) * (bfhi(fw.x) * g0.y + bb), S_YB * bflo(uu[i].y) * (bflo(fw.y) * g0.z + bb), S_YB * bfhi(uu[i].y) * (bfhi(fw.y) * g0.w + bb));
        o.y = pk4_fp8(S_YB * bflo(uu[i].z) * (bflo(fw.z) * g1.x + bb), S_YB * bfhi(uu[i].z) * (bfhi(fw.z) * g1.y + bb), S_YB * bflo(uu[i].w) * (bflo(fw.w) * g1.z + bb), S_YB * bfhi(uu[i].w) * (bfhi(fw.w) * g1.w + bb));
        *(GAS v2u*)((unsigned char*)F.YA + (size_t)(r0 + rs_ + 16 * i) * (2 * ATTW) + ATTW + c0 + 8 * q_) = o; }
}

using pg8::Unit; using pg8::cvt_pk_bf16;
struct EpiProj {
    static constexpr bool PERM = true, MIDK = false; bf16* O; float scale;
    __device__ __forceinline__ void operator()(const f32x4 (&acc)[2][2][4][2], const Unit& u, int wr, int wc, int fr, int fq) const {
        const int act = (u.pn >= PGU / 256 && u.pn < PGA / 256) ? 1 : ((u.pn >= PGA / 256 && u.pn < PKI / 256) ? 2 : 0);
        const int row0 = u.pm * 256 + wr * 64 + fr, col0 = u.pn * 256 + wc * 32 + 8 * fq;
#pragma unroll
        for (int ai = 0; ai < 2; ++ai)
#pragma unroll
            for (int m = 0; m < 4; ++m) { bf16* rowp = O + (size_t)(row0 + ai * 128 + m * 16) * PNP + col0;
#pragma unroll
                for (int bj = 0; bj < 2; ++bj) { f32x4 v0 = acc[ai][bj][m][0] * scale, v1 = acc[ai][bj][m][1] * scale;
                    if (act == 1) { const pg8::f32x2 a = pg8::gelu_pk((pg8::f32x2){v0[0], v0[1]}), b = pg8::gelu_pk((pg8::f32x2){v0[2], v0[3]}), c = pg8::gelu_pk((pg8::f32x2){v1[0], v1[1]}), d = pg8::gelu_pk((pg8::f32x2){v1[2], v1[3]});
                        v0 = (f32x4){a.x, a.y, b.x, b.y}; v1 = (f32x4){c.x, c.y, d.x, d.y}; }
                    else if (act == 2) {
#pragma unroll
                        for (int j = 0; j < 4; ++j) { v0[j] = pg8::sigmoidf_(v0[j]); v1[j] = pg8::sigmoidf_(v1[j]); } }
                    v4u w; w.x = cvt_pk_bf16(v0[0], v0[1]); w.y = cvt_pk_bf16(v0[2], v0[3]); w.z = cvt_pk_bf16(v1[0], v1[1]); w.w = cvt_pk_bf16(v1[2], v1[3]);
                    *(GAS v4u*)(rowp + bj * 128) = w; } }
    }
};
struct EpiMerge {
    static constexpr bool PERM = true, MIDK = true; const bf16* P; unsigned char* O; float cB, ratio;
    __device__ __forceinline__ void mid(f32x4 (&acc)[2][2][4][2], const Unit& u, int wr, int wc, int fr, int fq) const {
        const bf16* pb = P + (size_t)(u.pm * 256 + wr * 64 + fr) * PNP + (u.pn * 256 + wc * 32 + 8 * fq);
        asm volatile("" : "+v"(pb));
        v4u A0[4], A1[4];
#define MG_LOAD(G_, s_) do { const bf16* q_ = pb + (size_t)(((s_) >> 2) * 128 + ((s_) & 3) * 16) * PNP; G_[0] = *(const GAS v4u*)(q_ + PGA); G_[1] = *(const GAS v4u*)(q_ + PGB); G_[2] = *(const GAS v4u*)(q_ + PGA + 128); G_[3] = *(const GAS v4u*)(q_ + PGB + 128); } while (0)
#define MG_APPLY(G_, s_) do { _Pragma("unroll") for (int bj = 0; bj < 2; ++bj) { const v4u ga = G_[2 * bj], gb = G_[2 * bj + 1]; _Pragma("unroll") for (int j = 0; j < 2; ++j) { f32x4 f; \
                f.x = ratio * bflo(ga[2 * j]) * __builtin_amdgcn_rcpf(fmaxf(bflo(gb[2 * j]), 1e-30f)); f.y = ratio * bfhi(ga[2 * j]) * __builtin_amdgcn_rcpf(fmaxf(bfhi(gb[2 * j]), 1e-30f)); \
                f.z = ratio * bflo(ga[2 * j + 1]) * __builtin_amdgcn_rcpf(fmaxf(bflo(gb[2 * j + 1]), 1e-30f)); f.w = ratio * bfhi(ga[2 * j + 1]) * __builtin_amdgcn_rcpf(fmaxf(bfhi(gb[2 * j + 1]), 1e-30f)); \
                acc[(s_) >> 2][bj][(s_) & 3][j] *= f; } } asm volatile("" ::: "memory"); } while (0)
        MG_LOAD(A0, 0); MG_LOAD(A1, 1); MG_APPLY(A0, 0); MG_LOAD(A0, 2); MG_APPLY(A1, 1); MG_LOAD(A1, 3); MG_APPLY(A0, 2); MG_LOAD(A0, 4); MG_APPLY(A1, 3); MG_LOAD(A1, 5);
        MG_APPLY(A0, 4); MG_LOAD(A0, 6); MG_APPLY(A1, 5); MG_LOAD(A1, 7); MG_APPLY(A0, 6); MG_APPLY(A1, 7);
#undef MG_LOAD
#undef MG_APPLY
    }
    __device__ __forceinline__ void operator()(const f32x4 (&acc)[2][2][4][2], const Unit& u, int wr, int wc, int fr, int fq) const {
        const float sc = cB * S_MRG;
        const bf16* pb = P + (size_t)(u.pm * 256 + wr * 64 + fr) * PNP + (u.pn * 256 + wc * 32 + 8 * fq) + PGB;
        unsigned char* ob = O + (size_t)(u.pm * 256 + wr * 64 + fr) * DM + (u.pn * 256 + wc * 32 + 8 * fq);
        asm volatile("" : "+v"(pb), "+v"(ob));
        v4u G0[2], G1[2];
#define ME_LOAD(G_, s_) do { const bf16* q_ = pb + (size_t)(((s_) >> 2) * 128 + ((s_) & 3) * 16) * PNP; G_[0] = *(const GAS v4u*)q_; G_[1] = *(const GAS v4u*)(q_ + 128); } while (0)
#define ME_STORE(G_, s_) do { _Pragma("unroll") for (int bj = 0; bj < 2; ++bj) { const v4u gw = G_[bj]; \
            const f32x4 v0 = acc[(s_) >> 2][bj][(s_) & 3][0] * ((f32x4){fmaxf(bflo(gw.x), 1e-30f), fmaxf(bfhi(gw.x), 1e-30f), fmaxf(bflo(gw.y), 1e-30f), fmaxf(bfhi(gw.y), 1e-30f)} * sc); \
            const f32x4 v1 = acc[(s_) >> 2][bj][(s_) & 3][1] * ((f32x4){fmaxf(bflo(gw.z), 1e-30f), fmaxf(bfhi(gw.z), 1e-30f), fmaxf(bflo(gw.w), 1e-30f), fmaxf(bfhi(gw.w), 1e-30f)} * sc); \
            v2u w; w.x = pk4_fp8(v0[0], v0[1], v0[2], v0[3]); w.y = pk4_fp8(v1[0], v1[1], v1[2], v1[3]); \
            *(GAS v2u*)(ob + (size_t)(((s_) >> 2) * 128 + ((s_) & 3) * 16) * DM + bj * 128) = w; } } while (0)
        ME_LOAD(G0, 0); ME_LOAD(G1, 1); ME_STORE(G0, 0); ME_LOAD(G0, 2); ME_STORE(G1, 1); ME_LOAD(G1, 3); ME_STORE(G0, 2); ME_LOAD(G0, 4); ME_STORE(G1, 3); ME_LOAD(G1, 5);
        ME_STORE(G0, 4); ME_LOAD(G0, 6); ME_STORE(G1, 5); ME_LOAD(G1, 7); ME_STORE(G0, 6); ME_STORE(G1, 7);
#undef ME_LOAD
#undef ME_STORE
    }
};
template <bool BIN, bool BOUT>
struct EpiResid {
    static constexpr bool PERM = false, MIDK = false; const void* base; const float* gate; void* C; float scale;
    __device__ __forceinline__ void operator()(const f32x4 (&acc)[2][2][4][2], const Unit& u, int wr, int wc, int fr, int fq) const {
        const int row0 = u.pm * 256 + wr * 64 + fr, col0 = u.pn * 256 + wc * 32 + 4 * fq; const float* gp = gate + (u.pm >> 3) * MODW + col0;
        f32x4 gv[2][2];
#pragma unroll
        for (int bj = 0; bj < 2; ++bj)
#pragma unroll
            for (int n = 0; n < 2; ++n) gv[bj][n] = *(const GAS f32x4*)(gp + bj * 128 + n * 16) * scale;
        size_t off0 = (size_t)row0 * DM + col0; asm volatile("" : "+v"(off0));
        f32x4 B0[4], B1[4];
#define ER_LOAD(B_, s_) do { const size_t o_ = off0 + (size_t)(((s_) >> 2) * 128 + ((s_) & 3) * 16) * DM; _Pragma("unroll") for (int q_ = 0; q_ < 4; ++q_) { const size_t oo_ = o_ + (q_ >> 1) * 128 + (q_ & 1) * 16; \
            if constexpr (BIN) { const v2u w_ = *(const GAS v2u*)((const bf16*)base + oo_); B_[q_] = (f32x4){bflo(w_.x), bfhi(w_.x), bflo(w_.y), bfhi(w_.y)}; } else B_[q_] = *(const GAS f32x4*)((const float*)base + oo_); } } while (0)
#define ER_STORE(B_, s_) do { const size_t o_ = off0 + (size_t)(((s_) >> 2) * 128 + ((s_) & 3) * 16) * DM; _Pragma("unroll") for (int q_ = 0; q_ < 4; ++q_) { const size_t oo_ = o_ + (q_ >> 1) * 128 + (q_ & 1) * 16; \
            const f32x4 r_ = B_[q_] + gv[q_ >> 1][q_ & 1] * acc[(s_) >> 2][q_ >> 1][(s_) & 3][q_ & 1]; \
            if constexpr (BOUT) { v2u w_; w_.x = cvt_pk_bf16(r_.x, r_.y); w_.y = cvt_pk_bf16(r_.z, r_.w); *(GAS v2u*)((bf16*)C + oo_) = w_; } else __builtin_nontemporal_store(r_, (GAS f32x4*)((float*)C + oo_)); } } while (0)
        ER_LOAD(B0, 0); ER_LOAD(B1, 1); ER_STORE(B0, 0); ER_LOAD(B0, 2); ER_STORE(B1, 1); ER_LOAD(B1, 3); ER_STORE(B0, 2); ER_LOAD(B0, 4); ER_STORE(B1, 3); ER_LOAD(B1, 5);
        ER_STORE(B0, 4); ER_LOAD(B0, 6); ER_STORE(B1, 5); ER_LOAD(B1, 7); ER_STORE(B0, 6); ER_STORE(B1, 7);
#undef ER_LOAD
#undef ER_STORE
    }
};
struct EpiPlain {
    static constexpr bool PERM = true, MIDK = false; unsigned char* O; int ldc; float scale;
    __device__ __forceinline__ void operator()(const f32x4 (&acc)[2][2][4][2], const Unit& u, int wr, int wc, int fr, int fq) const {
        unsigned char* ob = O + (size_t)(u.pm * 256 + wr * 64 + fr) * ldc + (u.pn * 256 + wc * 32 + 8 * fq);
        asm volatile("" : "+v"(ob));
#pragma unroll
        for (int ai = 0; ai < 2; ++ai)
#pragma unroll
            for (int m = 0; m < 4; ++m)
#pragma unroll
                for (int bj = 0; bj < 2; ++bj) { const f32x4 v0 = acc[ai][bj][m][0] * scale, v1 = acc[ai][bj][m][1] * scale;
                    v2u w; w.x = pk4_fp8(v0[0], v0[1], v0[2], v0[3]); w.y = pk4_fp8(v1[0], v1[1], v1[2], v1[3]);
                    *(GAS v2u*)(ob + (size_t)(ai * 128 + m * 16) * ldc + bj * 128) = w; }
    }
};

typedef float f32x2 __attribute__((ext_vector_type(2)));
__device__ __forceinline__ void unpack8_fp8(v2u w, f32x2 (&o)[4]) {
    o[0] = __builtin_amdgcn_cvt_pk_f32_fp8((int)w.x, false); o[1] = __builtin_amdgcn_cvt_pk_f32_fp8((int)w.x, true); o[2] = __builtin_amdgcn_cvt_pk_f32_fp8((int)w.y, false); o[3] = __builtin_amdgcn_cvt_pk_f32_fp8((int)w.y, true);
}
__device__ __forceinline__ void conv_phase(Frame& F) {
    constexpr int C8 = DFF / 8, TB = 32, NTB = M / TB;
    const size_t total = (size_t)C8 * NTB;
    for (size_t idx = (size_t)F.gw * 64 + F.lane; idx < total; idx += (size_t)F.NGW * 64) {
        const int c8 = (int)(idx % C8), tb = (int)(idx / C8), ch = 8 * c8, t0 = tb * TB;
        const int acol = (ch >> 7) * 256 + (ch & 127);
        f32x2 wg[3][4], wv[3][4], bg[4], bv[4];
#pragma unroll
        for (int j = 0; j < 3; ++j) { const f32x4 a = *(const GAS f32x4*)(F.cvw + (size_t)j * F2 + ch) * (1.f / S_A), b = *(const GAS f32x4*)(F.cvw + (size_t)j * F2 + ch + 4) * (1.f / S_A);
            const f32x4 c = *(const GAS f32x4*)(F.cvw + (size_t)j * F2 + DFF + ch) * (1.f / S_A), d = *(const GAS f32x4*)(F.cvw + (size_t)j * F2 + DFF + ch + 4) * (1.f / S_A);
            wg[j][0] = (f32x2){a.x, a.y}; wg[j][1] = (f32x2){a.z, a.w}; wg[j][2] = (f32x2){b.x, b.y}; wg[j][3] = (f32x2){b.z, b.w};
            wv[j][0] = (f32x2){c.x, c.y}; wv[j][1] = (f32x2){c.z, c.w}; wv[j][2] = (f32x2){d.x, d.y}; wv[j][3] = (f32x2){d.z, d.w}; }
        { const f32x4 a = *(const GAS f32x4*)(F.cvb + ch), b = *(const GAS f32x4*)(F.cvb + ch + 4), c = *(const GAS f32x4*)(F.cvb + DFF + ch), d = *(const GAS f32x4*)(F.cvb + DFF + ch + 4);
          bg[0] = (f32x2){a.x, a.y}; bg[1] = (f32x2){a.z, a.w}; bg[2] = (f32x2){b.x, b.y}; bg[3] = (f32x2){b.z, b.w}; bv[0] = (f32x2){c.x, c.y}; bv[1] = (f32x2){c.z, c.w}; bv[2] = (f32x2){d.x, d.y}; bv[3] = (f32x2){d.z, d.w}; }
        f32x2 g1[4], g2[4], v1[4], v2[4];
        const bool first = (t0 & (SEQ - 1)) == 0;
        const unsigned char* ap = (const unsigned char*)F.A + (size_t)t0 * F2 + acol;
        if (first) {
#pragma unroll
            for (int e = 0; e < 4; ++e) { g1[e] = g2[e] = v1[e] = v2[e] = (f32x2){0.f, 0.f}; }
        } else {
            const v2u ga = *(const GAS v2u*)(ap - F2), gb = *(const GAS v2u*)(ap - 2 * (size_t)F2), va = *(const GAS v2u*)(ap - F2 + 128), vb = *(const GAS v2u*)(ap - 2 * (size_t)F2 + 128);
            unpack8_fp8(ga, g1); unpack8_fp8(gb, g2); unpack8_fp8(va, v1); unpack8_fp8(vb, v2);
        }
        v2u GA[8], VA[8], GB[8], VB[8];
#define CV_LOAD(G_, V_, r0_) do { _Pragma("unroll") for (int i_ = 0; i_ < 8; ++i_) { G_[i_] = *(const GAS v2u*)(ap + (size_t)((r0_) + i_) * F2); V_[i_] = *(const GAS v2u*)(ap + (size_t)((r0_) + i_) * F2 + 128); } } while (0)
#define CV_COMP(G_, V_, r0_) do { _Pragma("unroll") for (int i_ = 0; i_ < 8; ++i_) { f32x2 g0[4], v0[4], y[4]; unpack8_fp8(G_[i_], g0); unpack8_fp8(V_[i_], v0); \
            _Pragma("unroll") for (int e = 0; e < 4; ++e) { const f32x2 gt = bg[e] + wg[0][e] * g2[e] + wg[1][e] * g1[e] + wg[2][e] * g0[e]; \
                const f32x2 vl = bv[e] + wv[0][e] * v2[e] + wv[1][e] * v1[e] + wv[2][e] * v0[e]; \
                f32x2 sg; sg.x = pg8::sigmoidf_(gt.x); sg.y = pg8::sigmoidf_(gt.y); \
                y[e] = (gt * sg) * (vl * S_ACT); g2[e] = g1[e]; g1[e] = g0[e]; v2[e] = v1[e]; v1[e] = v0[e]; } \
            v2u o; o.x = pk4_fp8(y[0].x, y[0].y, y[1].x, y[1].y); o.y = pk4_fp8(y[2].x, y[2].y, y[3].x, y[3].y); \
            *(GAS v2u*)((unsigned char*)F.ACT + (size_t)(t0 + (r0_) + i_) * DFF + ch) = o; } asm volatile("" ::: "memory"); } while (0)
        CV_LOAD(GA, VA, 0); CV_LOAD(GB, VB, 8); CV_COMP(GA, VA, 0); CV_LOAD(GA, VA, 16); CV_COMP(GB, VB, 8); CV_LOAD(GB, VB, 24); CV_COMP(GA, VA, 16); CV_COMP(GB, VB, 24);
#undef CV_LOAD
#undef CV_COMP
    }
}

constexpr int N_PHASES = 12;
struct Args { const float* in[19]; float* out; unsigned char* ws; int ph_lo, ph_hi, li, pad; };
__global__ void __launch_bounds__(NWAVES * 64, 2) mega_fwd(Args args) {
    extern __shared__ __attribute__((aligned(16))) unsigned char lds[];
    Frame F;
    F.lds = (LAS unsigned char*)lds;
    F.MISC = (volatile LAS unsigned*)(F.lds + MISC_OFF);
    F.tid = threadIdx.x; F.lane = F.tid & 63; F.wave = __builtin_amdgcn_readfirstlane(F.tid >> 6);
    F.G = gridDim.x; F.gw = blockIdx.x * NWAVES + F.wave; F.NGW = F.G * NWAVES;
    unsigned char* ws = args.ws;
    F.ctl = (gu32*)(ws + WS_CTL);
    F.x = args.in[0]; F.c = args.in[1]; F.ada_w = args.in[2]; F.ada_b = args.in[3]; F.n1g = args.in[4]; F.w_in = args.in[5]; F.qng = args.in[6]; F.kng = args.in[7];
    F.sgg = args.in[8]; F.sgw = args.in[9]; F.sgb = args.in[10]; F.w_a = args.in[11]; F.w_b = args.in[12]; F.w_out = args.in[13]; F.n2g = args.in[14]; F.w_up = args.in[15];
    F.cvw = args.in[16]; F.cvb = args.in[17]; F.w_dn = args.in[18]; F.out = args.out;
    F.MOD = (float*)(ws + WS_MOD); F.PART = (float*)(ws + WS_TMP);   F.WIN = (bf16*)(ws + WS_WIN); F.WINB = (bf16*)(ws + WS_WINB); F.H8A = ws + WS_X1;   F.WA = (bf16*)(ws + WS_WA); F.WB = (bf16*)(ws + WS_WB); F.WOUT = (bf16*)(ws + WS_WOUT); F.WUP = (bf16*)(ws + WS_WUP); F.WDN = (bf16*)(ws + WS_WDN);
    F.H = (bf16*)(ws + WS_H); F.X1 = (float*)(ws + WS_X1); F.PROJ = (bf16*)(ws + WS_PROJ); F.MASK = (unsigned*)(ws + WS_MASK); F.RS = (float*)(ws + WS_RS); F.SWT = (float*)(ws + WS_SWT);
    F.VT = (bf16*)(ws + WS_VT); F.YA = (bf16*)(ws + WS_YA); F.YB = (bf16*)(ws + WS_YB); F.MRG = (bf16*)(ws + WS_MRG); F.TMP = (float*)(ws + WS_TMP); F.A = (bf16*)(ws + WS_A); F.ACT = (bf16*)(ws + WS_ACT);
    for (int u = F.tid; u < (LDS_BYTES - LDSCTL_OFF) / 4; u += NWAVES * 64) ((LAS unsigned*)(F.lds + LDSCTL_OFF))[u] = 0u;
    __syncthreads();
    XcdBarrier bar; bar.bar = (unsigned*)(F.ctl + CW_BAR); bar.x = 0; bar.st = nullptr;
    if (MK_N_LAUNCHES == 1) bar = xcd_barrier_post((unsigned*)(F.ctl + CW_BAR), F.MISC + 8);
    const int lo = args.ph_lo, hi = args.ph_hi;
#define IN(k) (lo <= (k) && (k) < hi)
#define SEAM(k) do { if (IN(k) && IN((k) + 1)) xcd_barrier(bar); } while (0)

#define REP(k) if ((PROBE_MASK >> (k)) & 1) for (int _rep = 0; _rep < 1; ++_rep)
    if (IN(0)) { p0_prologue(F); REP(0) { xcd_barrier(bar); p0_prologue(F, false); } } SEAM(0);
    if (IN(1)) { mod_reduce(F); } SEAM(1);
    if (IN(2)) { norm_rows<2>(F, F.x, F.n1g, 0, DM, F.H, F.H8A); REP(2) { xcd_barrier(bar); norm_rows<2>(F, F.x, F.n1g, 0, DM, F.H, F.H8A); } } SEAM(2);
    if (IN(3)) {
        { pg8::Gemm g{F.H, F.WINB, M, PNP, DM, DM, DM}; pg8::MixOrder S{0, F.G, (int)blockIdx.x}; EpiProj E{F.PROJ, 1.0f};
          pg8::gemm_phase<EpiProj, pg8::MixOrder, true, 2>(F.lds + RING_OFF, g, S, E); }
        VM_WAIT(); __syncthreads();
        { pg8::Gemm g{(const bf16*)F.H8A, F.WIN, M, PNP, DM, DM, DM}; EpiProj E{F.PROJ, 1.0f / (S_H2 * 1024.f)};
          const bool slotted = F.G == 256 && blockIdx.x >= 32; const int cut = slotted ? ((int)blockIdx.x - 32) % 9 : (1 << 30);
          for (int part = 0; part < 2; ++part) {
              pg8::MixOrder S{1, F.G, (int)blockIdx.x}; S.i0 = part ? cut : 0; S.i1 = part ? (1 << 30) : cut;
              pg8::gemm_phase<EpiProj, pg8::MixOrder, true, 1>(F.lds + RING_OFF, g, S, E);
              if (part == 0 && slotted) { const int first = ((int)blockIdx.x - 32) * TR_UP_SLOT, last = first + TR_UP_SLOT < TR_P_UP - TR_UP_TAIL - 2 * 256 * TR_UP_67 ? first + TR_UP_SLOT : TR_P_UP - TR_UP_TAIL - 2 * 256 * TR_UP_67;
                  tr_run<5>(F, first + F.wave, last, NWAVES, (LAS float*)(F.lds + RING_OFF + F.wave * 16384)); VM_WAIT(); __syncthreads(); }
          } }
        if (F.G == 256 && blockIdx.x < 32) { const int first = (int)blockIdx.x * (128 + 32);
            tr_run<4>(F, first + F.wave, first + 128 + 32, NWAVES, (LAS float*)(F.lds + RING_OFF + F.wave * 16384)); }
    } SEAM(3);
    if (IN(4)) {
        for (int it = blockIdx.x; it < 512; it += F.G) { const int b = it >> 7, j = it & 127; idx_block(F, b, j); idx_block(F, b, 255 - j); }
        qknorm_rows(F);
        vt_items(F);
        REP(4) { xcd_barrier(bar); for (int it = blockIdx.x; it < 512; it += F.G) { const int b = it >> 7, j = it & 127; idx_block(F, b, j); idx_block(F, b, 255 - j); } }
        REP(13) { xcd_barrier(bar); vt_items(F); }
    } SEAM(4);
    if (IN(5)) {
        { const float sb = attn_score_bound(F); for (int p = blockIdx.x; p < 256; p += F.G) { const int bg = (p & 7) * 2 + ((p >> 3) & 1), j = p >> 4;     attn_block(F, bg >> 2, bg & 3, j, sb); attn_block(F, bg >> 2, bg & 3, 31 - j, sb); } }
        REP(5) { xcd_barrier(bar); { const float sb = attn_score_bound(F); for (int p = blockIdx.x; p < 256; p += F.G) { const int bg = (p & 7) * 2 + ((p >> 3) & 1), j = p >> 4;     attn_block(F, bg >> 2, bg & 3, j, sb); attn_block(F, bg >> 2, bg & 3, 31 - j, sb); } } }
        for (int u = blockIdx.x; u < 512; u += F.G) sgu_unit(F, u);
        __syncthreads();
        if (F.G == 256) { const int pq = blockIdx.x, bg_ = (pq & 7) * 2 + ((pq >> 3) & 1), g_ = bg_ & 3, li = (bg_ >> 2) * 16 + (pq >> 4);
            if (g_ < 2) { const int cnt = g_ == 0 ? TR_AT0 : TR_AT1, first = g_ == 0 ? li * TR_AT0 : 64 * TR_AT0 + li * TR_AT1;
                tr_run<2>(F, first + F.wave, first + cnt, NWAVES, (LAS float*)(F.lds + RING_OFF + F.wave * 16384)); }
            __syncthreads(); }
        REP(14) { xcd_barrier(bar); for (int u = blockIdx.x; u < 512; u += F.G) sgu_unit(F, u); __syncthreads(); }
    } SEAM(5);
    if (IN(6) && F.G == 256 && ((blockIdx.x >> 3) & 1)) { const int first = (int)blockIdx.x * TR_UP_67; tr_run<6>(F, first + F.wave, first + TR_UP_67, NWAVES, (LAS float*)(F.lds + RING_OFF + F.wave * 16384)); VM_WAIT(); __syncthreads(); }
    if (IN(6)) { pg8::Gemm g{F.YA, F.WA, M, DM, 2 * ATTW, 2 * ATTW, 2 * ATTW}; pg8::StaticOrder S; S.init(M, DM, F.G, (int)blockIdx.x);
        EpiMerge E{F.PROJ, (unsigned char*)F.MRG, 1.0f / (S_YB * S_WB), (S_YB * S_WB) / (S_YA * S_WA)};
        pg8::gemm_phase<EpiMerge, pg8::StaticOrder, true, 1>(F.lds + RING_OFF, g, S, E);
        REP(6) { xcd_barrier(bar); pg8::gemm_phase<EpiMerge, pg8::StaticOrder, true, 1>(F.lds + RING_OFF, g, S, E); } }
    if (IN(6) && F.G == 256 && !((blockIdx.x >> 3) & 1)) { const int first = (int)blockIdx.x * TR_UP_67; tr_run<6>(F, first + F.wave, first + TR_UP_67, NWAVES, (LAS float*)(F.lds + RING_OFF + F.wave * 16384)); VM_WAIT(); __syncthreads(); }
    SEAM(6);
    if (IN(7) && F.G == 256 && ((blockIdx.x >> 3) & 1)) { const int first = 256 * TR_UP_67 + (int)blockIdx.x * TR_UP_67; tr_run<6>(F, first + F.wave, first + TR_UP_67, NWAVES, (LAS float*)(F.lds + RING_OFF + F.wave * 16384)); VM_WAIT(); __syncthreads(); }
    if (IN(7)) { pg8::Gemm g{F.MRG, F.WOUT, M, DM, DM, DM, DM}; pg8::StaticOrder S; S.init(M, DM, F.G, (int)blockIdx.x); EpiResid<false, true> E{F.x, F.MOD + 2 * DM, F.X1, 1.0f / (S_MRG * S_WOUT)};
        pg8::gemm_phase<EpiResid<false, true>, pg8::StaticOrder, true, 1>(F.lds + RING_OFF, g, S, E);
        REP(7) { xcd_barrier(bar); pg8::gemm_phase<EpiResid<false, true>, pg8::StaticOrder, true, 1>(F.lds + RING_OFF, g, S, E); } }
    if (IN(7) && F.G == 256 && !((blockIdx.x >> 3) & 1)) { const int first = 256 * TR_UP_67 + (int)blockIdx.x * TR_UP_67; tr_run<6>(F, first + F.wave, first + TR_UP_67, NWAVES, (LAS float*)(F.lds + RING_OFF + F.wave * 16384)); VM_WAIT(); __syncthreads(); }
    SEAM(7);
    if (IN(8)) { norm_rows<1, true>(F, F.X1, F.n2g, 3 * DM, 4 * DM, F.H); REP(8) { xcd_barrier(bar); norm_rows<1, true>(F, F.X1, F.n2g, 3 * DM, 4 * DM, F.H); } } SEAM(8);
    if (IN(9)) { pg8::Gemm g{F.H, F.WUP, M, F2, DM, DM, DM}; pg8::StaticOrder S; S.init(M, F2, F.G, (int)blockIdx.x); EpiPlain E{(unsigned char*)F.A, F2, S_A / (S_H2 * S_WUP)};
        pg8::gemm_phase<EpiPlain, pg8::StaticOrder, true, 1>(F.lds + RING_OFF, g, S, E);
        if (F.G == 256 && blockIdx.x >= 192) { const int first = ((int)blockIdx.x - 192) * 80;
            tr_run<3>(F, first + F.wave, first + 80, NWAVES, (LAS float*)(F.lds + RING_OFF + F.wave * 16384)); }
        REP(9) { xcd_barrier(bar); pg8::gemm_phase<EpiPlain, pg8::StaticOrder, true, 1>(F.lds + RING_OFF, g, S, E); } } SEAM(9);
    if (IN(10)) { conv_phase(F); REP(10) { xcd_barrier(bar); conv_phase(F); } } SEAM(10);
    if (IN(11)) { pg8::Gemm g{F.ACT, F.WDN, M, DM, DFF, DFF, DFF}; pg8::StaticOrder S; S.init(M, DM, F.G, (int)blockIdx.x); EpiResid<true, false> E{F.X1, F.MOD + 5 * DM, F.out, 1.0f / (S_ACT * S_WDN)};
        pg8::gemm_phase<EpiResid<true, false>, pg8::StaticOrder, true, 1>(F.lds + RING_OFF, g, S, E);
        REP(11) { xcd_barrier(bar); pg8::gemm_phase<EpiResid<true, false>, pg8::StaticOrder, true, 1>(F.lds + RING_OFF, g, S, E); } }
#undef REP
#undef IN
#undef SEAM
}

extern "C" void kernel_launch(void* const* d_in, const int* in_sizes, int n_in, void* d_out, int out_size, void* d_ws, size_t ws_size, hipStream_t stream) {
    static int grid = 0;
    if (grid == 0) {
        if (n_in != 19 || in_sizes[0] != M * DM || out_size != M * DM || ws_size < WS_END) { fprintf(stderr, "kernel_launch: unexpected shapes (n_in %d, in0 %d, out %d, ws %zu < %zu); nothing launched\n", n_in, n_in > 0 ? in_sizes[0] : -1, out_size, ws_size, (size_t)WS_END); grid = -1; return; }
        int dev = 0, cus = 0, per_cu = 0;
        if (hipGetDevice(&dev) != hipSuccess || hipDeviceGetAttribute(&cus, hipDeviceAttributeMultiprocessorCount, dev) != hipSuccess) { fprintf(stderr, "kernel_launch: device query failed\n"); grid = -1; return; }
        if (hipFuncSetAttribute((const void*)mega_fwd, hipFuncAttributeMaxDynamicSharedMemorySize, LDS_BYTES) != hipSuccess) { fprintf(stderr, "kernel_launch: hipFuncSetAttribute failed\n"); grid = -1; return; }
        if (hipOccupancyMaxActiveBlocksPerMultiprocessor(&per_cu, (const void*)mega_fwd, NWAVES * 64, LDS_BYTES) != hipSuccess || per_cu < 1) { fprintf(stderr, "kernel_launch: occupancy query reports %d blocks per CU\n", per_cu); }
        (void)hipGetLastError();
        grid = cus;
    }
    if (grid < 0) return;
    if (hipMemsetAsync((char*)d_ws + WS_CTL, 0, CTL_ZERO_BYTES, stream) != hipSuccess) { fprintf(stderr, "kernel_launch: memset failed\n"); return; }
    Args a{};
    for (int i = 0; i < 19; ++i) a.in[i] = (const float*)d_in[i];
    a.out = (float*)d_out; a.ws = (unsigned char*)d_ws; a.pad = 0;
    for (int li = 0; li < MK_N_LAUNCHES; ++li) {
        if (MK_N_LAUNCHES == 1) { a.ph_lo = 0; a.ph_hi = N_PHASES; } else { a.ph_lo = li; a.ph_hi = li + 1; }
        a.li = li;
        hipLaunchKernelGGL(mega_fwd, dim3(grid), dim3(NWAVES * 64), LDS_BYTES, stream, a);
        const hipError_t le = hipPeekAtLastError();
        if (le != hipSuccess) { fprintf(stderr, "kernel_launch: launch %d failed: %s\n", li, hipGetErrorName(le)); break; }
    }
}
```

```cpp
#include <hip/hip_runtime.h>
#include <cstdio>
#include <cstdint>

#ifndef MK_N_LAUNCHES
#define MK_N_LAUNCHES 1
#endif
#ifndef PROBE_MASK
#define PROBE_MASK 0x0
#endif

namespace pg8 {
#define PG8_LAS __attribute__((address_space(3)))
typedef unsigned short bf16_t;
typedef short bf16x8 __attribute__((ext_vector_type(8)));
typedef float f32x4 __attribute__((ext_vector_type(4)));
typedef float f32x2 __attribute__((ext_vector_type(2)));
typedef unsigned u32x4 __attribute__((ext_vector_type(4)));
typedef unsigned u32x2 __attribute__((ext_vector_type(2)));
constexpr int BM = 256, BK = 64, HALF = 128, HTB = HALF * BK * 2, STAGE_BYTES = 8 * HTB, NXCD = 8, WGM = 8;

__host__ __device__ __forceinline__ int lds_byte(int r, int c) { const int rr = r & 7, ch = c >> 3; return (r >> 3) * 1024 + (16 * ((rr >> 2) + 2 * (ch >> 2)) + 4 * (rr & 3) + ((ch ^ (2 * (rr >> 2))) & 3)) * 16; }
__host__ __device__ __forceinline__ void stage_rc(int b, int& R, int& C) { const int pc = b >> 10, p = (b & 1023) >> 4, q = p >> 4, bb = p & 15, rr = (q & 1) * 4 + (bb >> 2), ch = (q >> 1) * 4 + ((bb & 3) ^ (2 * (q & 1))); R = pc * 8 + rr; C = ch * 8; }
__host__ __device__ __forceinline__ int perm32(int rho) { const int n = rho >> 4, i = rho & 15; return 8 * (i >> 2) + 4 * n + (i & 3); }

struct Unit { int pm, pn; };
struct Gemm { const bf16_t* A; const bf16_t* Bt; int M, N, K, lda, ldb; };

struct StaticOrder {
    int nM, nN, nwg, G, c;
    __host__ __device__ void init(int M, int N, int G_, int c_) { nM = M / BM; nN = N / BM; nwg = nM * nN; G = G_; c = c_; }
    __host__ __device__ bool next(int i, Unit& u) const {
        const long L = (long)i * G + c; if (L >= nwg) return false;
        int wgid = (int)L; { const int q = nwg / NXCD, r = nwg % NXCD, xcd = wgid % NXCD, off = wgid / NXCD; wgid = (xcd < r ? xcd * (q + 1) : r * (q + 1) + (xcd - r) * q) + off; }
        const int nig = WGM * nN, gid = wgid / nig, fm = gid * WGM, gsz = (nM - fm) < WGM ? (nM - fm) : WGM;
        u.pm = fm + ((wgid % nig) % gsz); u.pn = (wgid % nig) / gsz; return true;
    }
    __device__ __forceinline__ void a_ready(const Unit&) const {}
    __device__ __forceinline__ void done(const Unit&) const {}
};
struct MixOrder {
    int fp8, G, c, i0 = 0, i1 = 1 << 30;
    __host__ __device__ static void map(int L, int nwg, int nN, Unit& u) {
        int wgid = L; { const int q = nwg / NXCD, r = nwg % NXCD, xcd = wgid % NXCD, off = wgid / NXCD; wgid = (xcd < r ? xcd * (q + 1) : r * (q + 1) + (xcd - r) * q) + off; }
        const int nig = WGM * nN; u.pm = (wgid / nig) * WGM + ((wgid % nig) % WGM); u.pn = (wgid % nig) / WGM;
    }
    __host__ __device__ bool next(int i, Unit& u) const {
        int L;
        if (!fp8) { L = i * G + c; if (L >= 288) return false; map(L, 288, 9, u); u.pn = u.pn < 8 ? 12 + u.pn : 68; return true; }
        i += i0; if (i >= i1) return false;
        if (G == 256) { if (c >= 32) { if (i >= 8) return false; L = i * 224 + (c - 32); } else { if (i >= 4) return false; L = 1792 + 4 * c + i; } }
        else { L = i * G + c; if (L >= 1920) return false; }
        map(L, 1920, 60, u); u.pn = u.pn < 12 ? u.pn : u.pn + 8; return true;
    }
    __device__ __forceinline__ void a_ready(const Unit&) const {}
    __device__ __forceinline__ void done(const Unit&) const {}
};

__device__ __forceinline__ unsigned cvt_pk_bf16(float lo, float hi) { unsigned r; asm volatile("v_cvt_pk_bf16_f32 %0, %1, %2" : "=v"(r) : "v"(lo), "v"(hi)); return r; }
__device__ __forceinline__ f32x2 gelu_pk(f32x2 v) {
    const f32x2 av = __builtin_elementwise_abs(v), d = av * 0.2316418882f + 1.0f;
    f32x2 t; t.x = __builtin_amdgcn_rcpf(d.x); t.y = __builtin_amdgcn_rcpf(d.y);
    f32x2 q = t * 0.5307027145f + (-0.7265760135f); q = q * t + 0.7107068705f; q = q * t + (-0.142248368f); q = q * t + 0.127414796f; q = q * t;
    const f32x2 s = (v * v) * (-0.72134752044f);
    f32x2 e; e.x = __builtin_amdgcn_exp2f(s.x); e.y = __builtin_amdgcn_exp2f(s.y);
    const f32x2 m = v * (q * e), r = v - m;
    f32x2 o; o.x = v.x < 0.f ? m.x : r.x; o.y = v.y < 0.f ? m.y : r.y; return o;
}
__device__ __forceinline__ float sigmoidf_(float x) { return __builtin_amdgcn_rcpf(1.0f + __builtin_amdgcn_exp2f(-1.4426950408889634f * x)); }
__device__ __forceinline__ float bflo(unsigned w) { return __builtin_bit_cast(float, w << 16); }
__device__ __forceinline__ float bfhi(unsigned w) { return __builtin_bit_cast(float, w & 0xffff0000u); }

typedef int i32x8 __attribute__((ext_vector_type(8)));
typedef int i32x4 __attribute__((ext_vector_type(4)));
template <class Epi, class Sched, bool ALIGN_EPI, int ES = 2>
__device__ __forceinline__ void gemm_phase(PG8_LAS unsigned char* lds, const Gemm g, const Sched& S, const Epi& E) {
    const int tid = threadIdx.x, wid = __builtin_amdgcn_readfirstlane(tid >> 6), lane = tid & 63, wr = wid >> 2, wc = wid & 3, fr = lane & 15, fq = lane >> 4;
    const int K = g.K, nt = K * ES / (BK * 2);
    unsigned voffA[2], voffB[2];
#pragma unroll
    for (int i = 0; i < 2; ++i) { int R, C; stage_rc(tid * 16 + i * 8192, R, C); const int Rb = Epi::PERM ? ((R & ~31) + perm32(R & 31)) : R;
        voffA[i] = (unsigned)(R * g.lda) * (unsigned)ES + (unsigned)C * 2u; voffB[i] = (unsigned)(Rb * g.ldb) * (unsigned)ES + (unsigned)C * 2u; }
    const size_t kstep = (size_t)(BK * 2);
    const size_t hstepA = (size_t)HALF * g.lda * ES, hstepB = (size_t)HALF * g.ldb * ES;
    const size_t tstepA = 2 * hstepA, tstepB = 2 * hstepB;
    const unsigned ldsw = (unsigned)wid * 1024u;
    const int aoff = lds_byte(wr * 64 + fr, fq * 8), boff = lds_byte(wc * 32 + fr, fq * 8);
#define PG8_SA(b, h) (((b) * 2 + (h)) * HTB)
#define PG8_SB(b, h) ((4 + (b) * 2 + (h)) * HTB)
#define PG8_STAGE(bufoff, gbase, voff) do { _Pragma("unroll") for (int _i = 0; _i < 2; ++_i) \
        __builtin_amdgcn_global_load_lds((const unsigned*)((const char*)(gbase) + (voff)[_i]), (PG8_LAS unsigned*)(lds + (bufoff) + ldsw + _i * 8192), 16, 0, 0); } while (0)
#define PG8_CAT(x, y) __builtin_shufflevector(x, y, 0, 1, 2, 3, 4, 5, 6, 7)
#define PG8_LO(v) __builtin_bit_cast(bf16x8, __builtin_shufflevector(v, v, 0, 1, 2, 3))
#define PG8_HI(v) __builtin_bit_cast(bf16x8, __builtin_shufflevector(v, v, 4, 5, 6, 7))
#define PG8_LDA(dst, b, h) do { _Pragma("unroll") for (int m = 0; m < 4; ++m) { const i32x4 _l = *(const PG8_LAS i32x4*)(lds + PG8_SA(b, h) + aoff + m * 2048), _h = *(const PG8_LAS i32x4*)(lds + PG8_SA(b, h) + aoff + m * 2048 + 512); dst[m] = PG8_CAT(_l, _h); } } while (0)
#define PG8_LDB(dst, b, h) do { _Pragma("unroll") for (int n = 0; n < 2; ++n) { const i32x4 _l = *(const PG8_LAS i32x4*)(lds + PG8_SB(b, h) + boff + n * 2048), _h = *(const PG8_LAS i32x4*)(lds + PG8_SB(b, h) + boff + n * 2048 + 512); dst[n] = PG8_CAT(_l, _h); } } while (0)
#define PG8_MMA(ai, bj, At, Bt) do { __builtin_amdgcn_s_setprio(1); _Pragma("unroll") for (int m = 0; m < 4; ++m) _Pragma("unroll") for (int n = 0; n < 2; ++n) { \
        if constexpr (ES == 2) { acc[ai][bj][m][n] = __builtin_amdgcn_mfma_f32_16x16x32_bf16(PG8_LO(Bt[n]), PG8_LO(At[m]), acc[ai][bj][m][n], 0, 0, 0); \
                                 acc[ai][bj][m][n] = __builtin_amdgcn_mfma_f32_16x16x32_bf16(PG8_HI(Bt[n]), PG8_HI(At[m]), acc[ai][bj][m][n], 0, 0, 0); } \
        else asm volatile("v_mfma_f32_16x16x128_f8f6f4 %0, %1, %2, %0" : "+v"(acc[ai][bj][m][n]) : "v"(Bt[n]), "v"(At[m])); } __builtin_amdgcn_s_setprio(0); } while (0)
#define PG8_WAIT_V(n) asm volatile("s_waitcnt vmcnt(" #n ")" ::: "memory")
#define PG8_WAIT_L(n) asm volatile("s_waitcnt lgkmcnt(" #n ")" ::: "memory")
#define PG8_BAR __builtin_amdgcn_s_barrier()
#define PG8_SCHED __builtin_amdgcn_sched_barrier(0)
    Unit cur, nxt; int ui = 0;
    if (!S.next(0, cur)) return;
    f32x4 acc[2][2][4][2];
#pragma unroll
    for (int a = 0; a < 2; ++a)
#pragma unroll
        for (int b = 0; b < 2; ++b)
#pragma unroll
            for (int m = 0; m < 4; ++m)
#pragma unroll
                for (int n = 0; n < 2; ++n) acc[a][b][m][n] = (f32x4){0.f, 0.f, 0.f, 0.f};
    i32x8 At[4], B0[2], B1[2];
    const char* cA = (const char*)g.A + (size_t)cur.pm * tstepA; const char* cB = (const char*)g.Bt + (size_t)cur.pn * tstepB;
    S.a_ready(cur);
    PG8_STAGE(PG8_SB(0, 0), cB, voffB); PG8_STAGE(PG8_SB(0, 1), cB + hstepB, voffB); PG8_STAGE(PG8_SA(0, 0), cA, voffA); PG8_STAGE(PG8_SA(0, 1), cA + hstepA, voffA);
    if (wr == 1) PG8_BAR;
    PG8_WAIT_V(2); PG8_BAR;
    PG8_STAGE(PG8_SB(1, 0), cB + kstep, voffB); PG8_STAGE(PG8_SA(1, 0), cA + kstep, voffA); PG8_STAGE(PG8_SB(1, 1), cB + hstepB + kstep, voffB);
    PG8_WAIT_V(6); PG8_BAR;
    for (;;) {
        const bool has_next = S.next(ui + 1, nxt);
        const char* nA = has_next ? (const char*)g.A + (size_t)nxt.pm * tstepA : cA; const char* nB = has_next ? (const char*)g.Bt + (size_t)nxt.pn * tstepB : cB;
        for (int t = 0; t < nt; t += 2) {
            const bool last = (t == nt - 2);
            const char* a1 = cA + (size_t)(t + 1) * kstep;
            const char* a2 = last ? nA : cA + (size_t)(t + 2) * kstep; const char* b2 = last ? nB : cB + (size_t)(t + 2) * kstep;
            const char* a3 = a2 + kstep; const char* b3 = b2 + kstep;
            if (last && has_next) S.a_ready(nxt);
            if constexpr (Epi::MIDK) { if (t == nt / 2) { if constexpr (ES == 1) asm volatile("s_nop 15\n\ts_nop 15" ::: "memory"); E.mid(acc, cur, wr, wc, fr, fq); } }
            PG8_LDB(B0, 0, 0); PG8_LDB(B1, 0, 1); PG8_SCHED; PG8_LDA(At, 0, 0); PG8_STAGE(PG8_SA(1, 1), a1 + hstepA, voffA);
            PG8_WAIT_V(8); PG8_WAIT_L(0); PG8_BAR; PG8_MMA(0, 0, At, B0); PG8_MMA(0, 1, At, B1); PG8_BAR; PG8_SCHED;
            PG8_LDA(At, 0, 1); PG8_STAGE(PG8_SB(0, 0), b2, voffB); PG8_STAGE(PG8_SB(0, 1), b2 + hstepB, voffB); PG8_STAGE(PG8_SA(0, 0), a2, voffA);
            PG8_WAIT_V(8); PG8_WAIT_L(0); PG8_BAR; PG8_MMA(1, 0, At, B0); PG8_MMA(1, 1, At, B1); PG8_BAR; PG8_SCHED;
            PG8_LDB(B0, 1, 0); PG8_LDB(B1, 1, 1); PG8_SCHED; PG8_LDA(At, 1, 0); PG8_STAGE(PG8_SA(0, 1), a2 + hstepA, voffA);
            PG8_WAIT_V(8); PG8_WAIT_L(0); PG8_BAR; PG8_MMA(0, 0, At, B0); PG8_MMA(0, 1, At, B1); PG8_BAR; PG8_SCHED;
            PG8_LDA(At, 1, 1); PG8_STAGE(PG8_SB(1, 0), b3, voffB); PG8_STAGE(PG8_SB(1, 1), b3 + hstepB, voffB); PG8_STAGE(PG8_SA(1, 0), a3, voffA);
            PG8_WAIT_V(8); PG8_WAIT_L(0); PG8_BAR; PG8_MMA(1, 0, At, B0); PG8_MMA(1, 1, At, B1); PG8_BAR; PG8_SCHED;
        }
        if constexpr (ALIGN_EPI) { if (wr == 0) PG8_BAR; }
        if constexpr (ES == 1) asm volatile("s_nop 15\n\ts_nop 15" ::: "memory");
        E(acc, cur, wr, wc, fr, fq); S.done(cur);
        if (!has_next) break;
#pragma unroll
        for (int a = 0; a < 2; ++a)
#pragma unroll
            for (int b = 0; b < 2; ++b)
#pragma unroll
                for (int m = 0; m < 4; ++m)
#pragma unroll
                    for (int n = 0; n < 2; ++n) acc[a][b][m][n] = (f32x4){0.f, 0.f, 0.f, 0.f};
        cur = nxt; cA = nA; cB = nB; ++ui;
        if constexpr (ALIGN_EPI) { if (wr == 1) PG8_BAR; }
    }
    PG8_WAIT_V(0);
    if constexpr (!ALIGN_EPI) { if (wr == 0) PG8_BAR; }
    PG8_BAR;
#undef PG8_SA
#undef PG8_SB
#undef PG8_STAGE
#undef PG8_LDA
#undef PG8_CAT
#undef PG8_LO
#undef PG8_HI
#undef PG8_LDB
#undef PG8_MMA
#undef PG8_WAIT_V
#undef PG8_WAIT_L
#undef PG8_BAR
#undef PG8_SCHED
}
}

constexpr int NWAVES = 8;
constexpr int BATCH = 4, SEQ = 2048, DM = 4096, M = BATCH * SEQ;
constexpr int NH = 16, HD = 128, NKV = 4, ATTW = 2048, KVW = 512, IH = 32, IDIM = 64, TOPK = 256;
constexpr int GMW = 2048, GMG = 8, GMGW = 256, GMC = 128, DFF = 11008, F2 = 2 * DFF;
constexpr int IN_W = 17504, MODW = 6 * DM;
constexpr float EPS = 1e-6f;
constexpr int PQ = 0, PK = 2048, PV = 2560, PQI = 3072, PGU = 5120, PGV = 7168, PGA = 9216, PGB = 13312, PKI = 17408, PWI = 17472, PNP = 17664;
constexpr int SQ = 0, SK = 2048, SV = 2560, SQI = 3072, SKI = 5120, SWI = 5184, SGU = 5216, SGV = 7264, SGA = 9312, SGB = 13408;

constexpr size_t MiB = 1u << 20;
constexpr size_t WS_CTL = 0, CTL_ZERO_BYTES = 65536;
constexpr size_t WS_MOD = 1 * MiB;
constexpr size_t WS_WIN = 2 * MiB;
constexpr size_t WS_WA = 140 * MiB, WS_WB = 156 * MiB;
constexpr size_t WS_WOUT = 172 * MiB;
constexpr size_t WS_WUP = 204 * MiB;
constexpr size_t WS_WDN = 376 * MiB;
constexpr size_t WS_H = 462 * MiB;
constexpr size_t WS_X1 = 526 * MiB;
constexpr size_t WS_PROJ = 654 * MiB;
constexpr size_t WS_MASK = 930 * MiB;
constexpr size_t WS_RS = 932 * MiB;
constexpr size_t WS_SWT = 932 * MiB + 65536;
constexpr size_t WS_VT = 933 * MiB;
constexpr size_t WS_YA = 941 * MiB, WS_YB = 973 * MiB;
constexpr size_t WS_MRG = 1005 * MiB;
constexpr size_t WS_TMP = 1069 * MiB;
constexpr size_t WS_A = 654 * MiB;
constexpr size_t WS_ACT = 998 * MiB;
constexpr size_t WS_WINB = 1197 * MiB;
constexpr size_t WS_END = 1336 * MiB;
static_assert(WS_WIN + (size_t)PNP * DM * 2 <= WS_WA && WS_WUP + (size_t)F2 * DM * 2 <= WS_WDN && WS_WDN + (size_t)DM * DFF * 2 <= WS_H, "ws map 1");
static_assert(WS_PROJ + (size_t)M * PNP * 2 <= WS_MASK && WS_A + (size_t)M * F2 * 2 <= WS_ACT && WS_ACT + (size_t)M * DFF * 2 <= WS_END && WS_TMP + (size_t)M * DM * 4 <= WS_END, "ws map 2");
constexpr int CW_TMO = 0, CW_CODE = 1, CW_BAR = 4096;

constexpr int RING_OFF = 0, RING_BYTES = 131072;
constexpr int LDSCTL_OFF = RING_BYTES + 8192, MISC_OFF = LDSCTL_OFF + 320;
constexpr int LDS_BYTES = 147456;
static_assert(MISC_OFF + 128 <= LDS_BYTES, "LDS map");

#define GAS __attribute__((address_space(1)))
#define LAS __attribute__((address_space(3)))
typedef unsigned short bf16;
typedef unsigned v4u __attribute__((ext_vector_type(4)));
typedef unsigned v2u __attribute__((ext_vector_type(2)));
typedef float f32x4 __attribute__((ext_vector_type(4)));
typedef float f32x16 __attribute__((ext_vector_type(16)));
typedef short bf16x8 __attribute__((ext_vector_type(8)));
typedef short bf16x4 __attribute__((ext_vector_type(4)));
typedef GAS unsigned gu32;
#define RLX_AGENT __ATOMIC_RELAXED, __HIP_MEMORY_SCOPE_AGENT
#define LDS_WAIT() asm volatile("s_waitcnt lgkmcnt(0)" ::: "memory")
#define VM_WAIT() asm volatile("s_waitcnt vmcnt(0)" ::: "memory")
__device__ __forceinline__ unsigned f2bf(float f) { unsigned u = __builtin_bit_cast(unsigned, f); return (u + 0x7fffu + ((u >> 16) & 1u)) >> 16; }
__device__ __forceinline__ unsigned pk2(float lo, float hi) { return pg8::cvt_pk_bf16(lo, hi); }
__device__ __forceinline__ float bf2f(bf16 h) { return __builtin_bit_cast(float, (unsigned)h << 16); }
using pg8::bflo; using pg8::bfhi;
constexpr float S_H2 = 16.f, S_WUP = 1024.f, S_ACT = 4.f, S_WDN = 1024.f, S_A = 16.f, S_YA = 16.f, S_YB = 8.f, S_MRG = 16.f, S_WA = 1024.f, S_WB = 1024.f, S_WOUT = 1024.f;
__device__ __forceinline__ float clamp448(float x) { return __builtin_amdgcn_fmed3f(x, -448.f, 448.f); }
__device__ __forceinline__ unsigned pk4_fp8(float a, float b, float c, float d) {
    int w = __builtin_amdgcn_cvt_pk_fp8_f32(clamp448(a), clamp448(b), 0, false);
    w = __builtin_amdgcn_cvt_pk_fp8_f32(clamp448(c), clamp448(d), w, true);
    return (unsigned)w;
}

#define XB_TMO      128
#define XB_XCNT(j)  (256  + 64 * (j))
#define XB_XSUB(j)  (1280 + 64 * (j))
#define XB_XGEN(j)  (2304 + 64 * (j))
#define XB_TOP      3328
#define XB_TOPGEN   3392
#define XCD_BAR_WORDS 3456
#define XB_SPIN_CAP (1u << 18)
__device__ __forceinline__ unsigned xb_ld(unsigned* p)              { return __hip_atomic_load(p, __ATOMIC_RELAXED, __HIP_MEMORY_SCOPE_AGENT); }
__device__ __forceinline__ unsigned xb_add(unsigned* p, unsigned v) { return __hip_atomic_fetch_add(p, v, __ATOMIC_RELAXED, __HIP_MEMORY_SCOPE_AGENT); }
__device__ __forceinline__ unsigned xb_xcc_id() { return (unsigned)__builtin_amdgcn_s_getreg((3 << 11) | 20) & 0xFu; }
#define XB_SPIN(cond, bar) do { unsigned _sp = 0; while (cond) { __builtin_amdgcn_s_sleep(1); \
    if ((++_sp & 255u) == 0u) { if (xb_ld(&(bar)[XB_TMO])) break; if (_sp > XB_SPIN_CAP) { atomicAdd(&(bar)[XB_TMO], 1u); break; } } } } while (0)
struct XcdBarrier { unsigned* bar; unsigned x; volatile LAS unsigned* st; };
__device__ __forceinline__ XcdBarrier xcd_barrier_post(unsigned* bar, volatile LAS unsigned* st) {
    XcdBarrier b; b.bar = bar; b.x = xb_xcc_id(); b.st = st;
    if (threadIdx.x == 0) (void)xb_add(&bar[XB_XCNT(b.x)], 1u);
    return b;
}
__device__ __forceinline__ void xcd_barrier_complete(unsigned* bar, unsigned x, unsigned& nloc, unsigned& nx) {
    const unsigned G = gridDim.x * gridDim.y * gridDim.z;
    unsigned sum, cnt, mine, sp = 0u;
    for (;;) {
        sum = 0u; cnt = 0u; mine = 0u;
#pragma unroll
        for (unsigned j = 0; j < 16; ++j) { const unsigned c = xb_ld(&bar[XB_XCNT(j)]); sum += c; cnt += (c > 0u) ? 1u : 0u; mine = (j == x) ? c : mine; }
        if (sum == G) break;
        __builtin_amdgcn_s_sleep(1);
        if ((++sp & 255u) == 0u) { if (xb_ld(&bar[XB_TMO])) break; if (sp > XB_SPIN_CAP) { atomicAdd(&bar[XB_TMO], 1u); break; } }
    }
    nloc = mine > 0u ? mine : 1u; nx = cnt > 0u ? cnt : 1u;
}
__device__ __forceinline__ void xcd_barrier(const XcdBarrier& b) {
    asm volatile("s_waitcnt vmcnt(0)" ::: "memory");
    __syncthreads();
    if (threadIdx.x == 0) {
        unsigned* bar = b.bar;
        __builtin_amdgcn_s_waitcnt(0);
        unsigned nloc = b.st[0], nx = b.st[1];
        if (nloc == 0u) { xcd_barrier_complete(bar, b.x, nloc, nx); b.st[0] = nloc; b.st[1] = nx; }
        const unsigned old = xb_add(&bar[XB_XSUB(b.x)], 1u);
        const unsigned gen = old / nloc;
        if (old + 1u == (gen + 1u) * nloc) {
            __builtin_amdgcn_fence(__ATOMIC_RELEASE, "agent");
            asm volatile("s_waitcnt vmcnt(0)" ::: "memory");
            const unsigned og = xb_add(&bar[XB_TOP], 1u);
            const unsigned tg = og / nx;
            if (og + 1u == (tg + 1u) * nx) xb_add(&bar[XB_TOPGEN], 1u);
            else XB_SPIN(xb_ld(&bar[XB_TOPGEN]) == tg, bar);
            __builtin_amdgcn_fence(__ATOMIC_ACQUIRE, "agent");
            xb_add(&bar[XB_XGEN(b.x)], 1u);
            asm volatile("s_waitcnt vmcnt(0)" ::: "memory");
        } else {
            XB_SPIN(xb_ld(&bar[XB_XGEN(b.x)]) == gen, bar);
            __builtin_amdgcn_fence(__ATOMIC_ACQUIRE, "agent");
            asm volatile("s_waitcnt vmcnt(0)" ::: "memory");
        }
    }
    __syncthreads();
}

struct Frame {
    LAS unsigned char* lds;
    volatile LAS unsigned* MISC;
    gu32* ctl;
    int tid, lane, wave, G, gw, NGW;
    const float *x, *c, *ada_w, *ada_b, *n1g, *w_in, *qng, *kng, *sgg, *sgw, *sgb, *w_a, *w_b, *w_out, *n2g, *w_up, *cvw, *cvb, *w_dn;
    float* out;
    float *MOD, *PART; bf16 *WINB; unsigned char* H8A; bf16 *WIN, *WA, *WB, *WOUT, *WUP, *WDN, *H, *PROJ, *VT, *YA, *YB, *MRG, *A, *ACT; float *X1, *TMP, *RS, *SWT; unsigned* MASK;
};
__device__ __forceinline__ void xor32_pair(float x, float& lo, float& hi) {
    float a = x, b = x; asm volatile("s_nop 1\n\tv_permlane32_swap_b32 %0, %1" : "+v"(a), "+v"(b)); lo = a; hi = b; }
__device__ __forceinline__ float xor32_sum(float x) { float lo, hi; xor32_pair(x, lo, hi); return lo + hi; }
__device__ __forceinline__ float xor32_max(float x) { float lo, hi; xor32_pair(x, lo, hi); return fmaxf(lo, hi); }
__device__ __forceinline__ unsigned wave_sum_u32(unsigned c) {
    c += (unsigned)__builtin_amdgcn_update_dpp(0, (int)c, 0xB1, 0xf, 0xf, true);
    c += (unsigned)__builtin_amdgcn_update_dpp(0, (int)c, 0x4E, 0xf, 0xf, true);
    c += (unsigned)__builtin_amdgcn_update_dpp(0, (int)c, 0x141, 0xf, 0xf, true);
    c += (unsigned)__builtin_amdgcn_update_dpp(0, (int)c, 0x140, 0xf, 0xf, true);
    { unsigned a = c, b = c; asm volatile("s_nop 1\n\tv_permlane16_swap_b32 %0, %1" : "+v"(a), "+v"(b)); c = a + b; }
    { unsigned a = c, b = c; asm volatile("s_nop 1\n\tv_permlane32_swap_b32 %0, %1" : "+v"(a), "+v"(b)); c = a + b; }
    return c;
}
template <int CTRL> __device__ __forceinline__ float dpp_f(float x) { return __builtin_bit_cast(float, __builtin_amdgcn_update_dpp(0, __builtin_bit_cast(int, x), CTRL, 0xf, 0xf, true)); }
__device__ __forceinline__ float sum4(float v) { v += dpp_f<0xB1>(v); v += dpp_f<0x4E>(v); return v; }
__device__ __forceinline__ float sum16(float v) { v = sum4(v); v += dpp_f<0x141>(v); v += dpp_f<0x140>(v); return v; }
__device__ __forceinline__ float wave_sum(float v) {
    v = sum16(v);
    { float a = v, b = v; asm volatile("s_nop 1\n\tv_permlane16_swap_b32 %0, %1" : "+v"(a), "+v"(b)); v = a + b; }
    return xor32_sum(v);
}

__device__ __forceinline__ int win_dst_row(int n) {
    if (n < SKI) return n;
    if (n < SWI) return PKI + (n - SKI);
    if (n < SGU) return PWI + (n - SWI);
    return PGU + (n - SGU);
}
__device__ __forceinline__ void gemv_item(Frame& F, int item) {
    const int nb = item % 96, ks = item / 96, n0 = nb * 256 + 4 * F.lane, k0 = ks * 64;
    float cs[4];
#pragma unroll
    for (int b = 0; b < 4; ++b) { const float cv = F.c[b * DM + k0 + F.lane]; cs[b] = cv * pg8::sigmoidf_(cv); }
    f32x4 acc[4];
#pragma unroll
    for (int b = 0; b < 4; ++b) acc[b] = (f32x4){0.f, 0.f, 0.f, 0.f};
    const float* wp = F.ada_w + (size_t)k0 * MODW + n0;
#pragma unroll 16
    for (int k = 0; k < 64; ++k) { const f32x4 w = __builtin_nontemporal_load((const GAS f32x4*)(wp + (size_t)k * MODW));
#pragma unroll
        for (int b = 0; b < 4; ++b) { const float s = __builtin_bit_cast(float, __builtin_amdgcn_readlane(__builtin_bit_cast(int, cs[b]), k)); acc[b] += w * s; } }
#pragma unroll
    for (int b = 0; b < 4; ++b) *(GAS f32x4*)(F.PART + (size_t)(ks * 4 + b) * MODW + n0) = acc[b];
}
__device__ __forceinline__ void mod_reduce(Frame& F) {
    for (int i = F.gw * 64 + F.lane; i < 4 * (MODW / 4); i += F.NGW * 64) { const int b = i / (MODW / 4), n0 = 4 * (i % (MODW / 4));
        f32x4 a = *(const GAS f32x4*)(F.ada_b + n0);
#pragma unroll 16
        for (int ks = 0; ks < 64; ++ks) a += *(const GAS f32x4*)(F.PART + (size_t)(ks * 4 + b) * MODW + n0);
        *(GAS f32x4*)(F.MOD + b * MODW + n0) = a; }
}
struct TrItem { const float* src; unsigned char* d8; bf16* db; int Nsrc, ldk, drow0, k0; float scale; };
__device__ __forceinline__ void tr_decode(Frame& F, int r, TrItem& t) {
    constexpr int P_IN = (DM / 128) * (IN_W / 32), P_A = (ATTW / 128) * (DM / 32), P_B = (GMW / 128) * (DM / 32), P_O = (DM / 128) * (DM / 32), P_UP = (DM / 128) * (F2 / 32);
    const float* W; int Nsrc, nblk, ldk, drow; unsigned char* d8; bf16* db = nullptr; float sc; bool up = false, in = false;
    if (r < P_IN) { W = F.w_in; Nsrc = IN_W; nblk = IN_W / 32; d8 = (unsigned char*)F.WIN; ldk = DM; sc = 1024.f; in = true; }
    else if ((r -= P_IN) < P_A) { W = F.w_a; Nsrc = DM; nblk = DM / 32; d8 = (unsigned char*)F.WA; ldk = 2 * ATTW; sc = S_WA; }
    else if ((r -= P_A) < P_B) { W = F.w_b; Nsrc = DM; nblk = DM / 32; d8 = (unsigned char*)F.WA + ATTW; ldk = 2 * ATTW; sc = S_WB; }
    else if ((r -= P_B) < P_O) { W = F.w_out; Nsrc = DM; nblk = DM / 32; d8 = (unsigned char*)F.WOUT; ldk = DM; sc = S_WOUT; }
    else if ((r -= P_O) < P_UP) { W = F.w_up; Nsrc = F2; nblk = F2 / 32; d8 = (unsigned char*)F.WUP; ldk = DM; sc = S_WUP; up = true; }
    else { r -= P_UP; W = F.w_dn; Nsrc = DM; nblk = DM / 32; d8 = (unsigned char*)F.WDN; ldk = DFF; sc = S_WDN; }
    const int kb = r / nblk, n = 32 * (r % nblk);
    drow = n;
    if (in) { drow = win_dst_row(n); if (n >= SQI && n < SGU) db = F.WINB; }
    if (up) { const int ch = n < DFF ? n : n - DFF; drow = (ch >> 7) * 256 + (ch & 127) + (n < DFF ? 0 : 128); }
    t.src = W + (size_t)(128 * kb) * Nsrc + n; t.d8 = d8; t.db = db; t.Nsrc = Nsrc; t.ldk = ldk; t.drow0 = drow; t.k0 = 128 * kb; t.scale = sc;
}
__device__ __forceinline__ void tr_load(const TrItem& t, int half, f32x4 (&v)[8], int lane) {
    const float* p = t.src + (size_t)(64 * half + (lane >> 3)) * t.Nsrc + 4 * (lane & 7);
#pragma unroll
    for (int i = 0; i < 8; ++i) v[i] = __builtin_nontemporal_load((const GAS f32x4*)(p + (size_t)(8 * i) * t.Nsrc));
}
__device__ __forceinline__ void tr_finish(const TrItem& t, int half, const f32x4 (&v)[8], LAS float* scr, int lane) {
#pragma unroll
    for (int i = 0; i < 8; ++i) { LAS float* s = scr + (8 * i + (lane >> 3)) * 33 + 4 * (lane & 7); s[0] = v[i].x; s[1] = v[i].y; s[2] = v[i].z; s[3] = v[i].w; }
    LDS_WAIT(); asm volatile("" ::: "memory");
    const int c = lane & 7, kcol = t.k0 + 64 * half + 8 * c; const float sc = t.scale;
#pragma unroll
    for (int j = 0; j < 4; ++j) { const int n = (lane >> 3) + 8 * j; const LAS float* s = scr + (8 * c) * 33 + n;
        const float e0 = s[0 * 33], e1 = s[1 * 33], e2 = s[2 * 33], e3 = s[3 * 33], e4 = s[4 * 33], e5 = s[5 * 33], e6 = s[6 * 33], e7 = s[7 * 33];
        v2u o; o.x = pk4_fp8(e0 * sc, e1 * sc, e2 * sc, e3 * sc); o.y = pk4_fp8(e4 * sc, e5 * sc, e6 * sc, e7 * sc);
        *(GAS v2u*)(t.d8 + (size_t)(t.drow0 + n) * t.ldk + kcol) = o;
        if (t.db) { v4u ob; ob.x = pk2(e0, e1); ob.y = pk2(e2, e3); ob.z = pk2(e4, e5); ob.w = pk2(e6, e7); *(GAS v4u*)(t.db + (size_t)(t.drow0 + n) * t.ldk + kcol) = ob; } }
    LDS_WAIT(); asm volatile("" ::: "memory");
}
constexpr int TR_P_IN = (DM / 128) * (IN_W / 32), TR_P_A = (ATTW / 128) * (DM / 32), TR_P_B = (GMW / 128) * (DM / 32), TR_P_O = (DM / 128) * (DM / 32), TR_P_UP = (DM / 128) * (F2 / 32), TR_P_DN = (DFF / 128) * (DM / 32);
constexpr int TR_OUT0 = TR_P_IN + TR_P_A + TR_P_B, TR_UP0 = TR_OUT0 + TR_P_O, TR_DN0 = TR_UP0 + TR_P_UP, TR_ALL = TR_DN0 + TR_P_DN;
constexpr int TR_AB_EARLY = 4096, TR_B_LATE = TR_P_A + TR_P_B - TR_AB_EARLY;
constexpr int TR_DN_LATE = 5120;
constexpr int TR_UP_TAIL = 32 * 16;
constexpr int TR_UP_67 = 40;
constexpr int TR_UP_SLOT = (TR_P_UP - TR_UP_TAIL - 2 * 256 * TR_UP_67 + 223) / 224;
constexpr int TR_AT0 = 84, TR_AT1 = 62, TR_N5 = 64 * (TR_AT0 + TR_AT1), TR_DN_MID = TR_P_DN - TR_DN_LATE - (TR_N5 - TR_P_O);
static_assert(TR_N5 >= TR_P_O && TR_DN_MID >= 0 && TR_AB_EARLY == 32 * 128, "conversion split");
template <int LIST> __device__ __forceinline__ int tr_map(int v) {
    if (LIST == 1) return v < TR_P_IN ? v : (v < TR_P_IN + TR_B_LATE ? v + TR_AB_EARLY : TR_DN0 + (TR_N5 - TR_P_O) + (v - TR_P_IN - TR_B_LATE));
    if (LIST == 5) return TR_UP0 + TR_UP_TAIL + 2 * 256 * TR_UP_67 + v;
    if (LIST == 6) return TR_UP0 + TR_UP_TAIL + v;
    if (LIST == 4) return v < TR_AB_EARLY ? TR_P_IN + v : TR_UP0 + (v - TR_AB_EARLY);
    if (LIST == 2) return v < TR_P_O ? TR_OUT0 + v : TR_DN0 + (v - TR_P_O);
    if (LIST == 3) return TR_ALL - TR_DN_LATE + v;
    return v;
}
template <int LIST> __device__ __forceinline__ void tr_run(Frame& F, int r0, int rend, int stride, LAS float* scr) {
    TrItem A, B; f32x4 a0[8], a1[8], b0[8], b1[8];
    int r = r0; bool hasA = r < rend;
    if (hasA) { tr_decode(F, tr_map<LIST>(r), A); tr_load(A, 0, a0, F.lane); tr_load(A, 1, a1, F.lane); }
    while (hasA) {
        const int rb = r + stride; const bool hasB = rb < rend;
        if (hasB) { tr_decode(F, tr_map<LIST>(rb), B); tr_load(B, 0, b0, F.lane); tr_load(B, 1, b1, F.lane); }
        tr_finish(A, 0, a0, scr, F.lane); tr_finish(A, 1, a1, scr, F.lane);
        if (!hasB) break;
        r = rb + stride; hasA = r < rend;
        if (hasA) { tr_decode(F, tr_map<LIST>(r), A); tr_load(A, 0, a0, F.lane); tr_load(A, 1, a1, F.lane); }
        tr_finish(B, 0, b0, scr, F.lane); tr_finish(B, 1, b1, scr, F.lane);
    }
}
__device__ __forceinline__ void p0_prologue(Frame& F, bool with_gemv = true) {
    LAS float* scr = (LAS float*)(F.lds + RING_OFF + F.wave * 16384);
    constexpr int I_GV = 96 * 64;
    if (with_gemv) for (int it = F.gw; it < I_GV; it += F.NGW) gemv_item(F, it);
    if (F.G == 256) tr_run<1>(F, F.gw, TR_P_IN + TR_B_LATE + TR_DN_MID, F.NGW, scr); else tr_run<0>(F, F.gw, TR_ALL, F.NGW, scr);
    { const size_t n16 = (size_t)(PNP - IN_W) * DM / 16; GAS v4u* p = (GAS v4u*)((unsigned char*)F.WIN + (size_t)IN_W * DM);
      for (size_t i = (size_t)F.gw * 64 + F.lane; i < n16; i += (size_t)F.NGW * 64) p[i] = (v4u){0u, 0u, 0u, 0u};
      GAS v4u* pb = (GAS v4u*)(F.WINB + (size_t)IN_W * DM);
      for (size_t i = (size_t)F.gw * 64 + F.lane; i < 2 * n16; i += (size_t)F.NGW * 64) pb[i] = (v4u){0u, 0u, 0u, 0u}; }
}

template <int FP8 = 0, bool XBF = false>
__device__ __forceinline__ void norm_rows(Frame& F, const void* X, const float* gain, int sh_off, int sc_off, void* Ov, unsigned char* O8 = nullptr) {
    LAS f32x4* CA = (LAS f32x4*)F.lds; LAS f32x4* CB = (LAS f32x4*)(F.lds + 16384);
    for (int blk = blockIdx.x; blk < M / 32; blk += F.G) {
        const int b = (blk * 32) >> 11;
        __syncthreads();
        for (int i = F.tid; i < DM / 4; i += NWAVES * 64) { const f32x4 g = ((const GAS f32x4*)gain)[i], sh = ((const GAS f32x4*)(F.MOD + b * MODW + sh_off))[i], sc = ((const GAS f32x4*)(F.MOD + b * MODW + sc_off))[i];
            CA[i] = g * (sc + 1.0f); CB[i] = sh; }
        __syncthreads();
        const int m0 = blk * 32 + 4 * F.wave;
        f32x4 va[16], vb[16];
#define NR_LOAD(v, m_) do { if constexpr (XBF) { const GAS v2u* xr = (const GAS v2u*)((const bf16*)X + (size_t)(m_) * DM) + F.lane; _Pragma("unroll") for (int j = 0; j < 16; ++j) { const v2u w_ = xr[64 * j]; v[j] = (f32x4){bflo(w_.x), bfhi(w_.x), bflo(w_.y), bfhi(w_.y)}; } } \
        else { const GAS f32x4* xr = (const GAS f32x4*)((const float*)X + (size_t)(m_) * DM) + F.lane; _Pragma("unroll") for (int j = 0; j < 16; ++j) v[j] = __builtin_nontemporal_load(xr + 64 * j); } } while (0)
#define NR_FIN(v, m_) do { float s_ = 0.f; _Pragma("unroll") for (int j = 0; j < 16; ++j) s_ += (v[j].x * v[j].x + v[j].y * v[j].y) + (v[j].z * v[j].z + v[j].w * v[j].w); \
            const float rstd = 1.0f / sqrtf(wave_sum(s_) * (1.f / DM) + EPS); \
            GAS v2u* o8 = (GAS v2u*)((bf16*)Ov + (size_t)(m_) * DM) + F.lane; GAS unsigned* o4 = (GAS unsigned*)((FP8 == 2 ? O8 : (unsigned char*)Ov) + (size_t)(m_) * DM) + F.lane; \
            _Pragma("unroll") for (int j = 0; j < 16; ++j) { const f32x4 y = (v[j] * rstd) * CA[64 * j + F.lane] + CB[64 * j + F.lane]; \
                if constexpr (FP8 != 0) o4[64 * j] = pk4_fp8(y.x * S_H2, y.y * S_H2, y.z * S_H2, y.w * S_H2); \
                if constexpr (FP8 != 1) { v2u w_; w_.x = pk2(y.x, y.y); w_.y = pk2(y.z, y.w); o8[64 * j] = w_; } \
                if ((j & 3) == 3) asm volatile("" ::: "memory"); } } while (0)
        NR_LOAD(va, m0); NR_LOAD(vb, m0 + 1); NR_FIN(va, m0); NR_LOAD(va, m0 + 2); NR_FIN(vb, m0 + 1); NR_LOAD(vb, m0 + 3); NR_FIN(va, m0 + 2); NR_FIN(vb, m0 + 3);
#undef NR_LOAD
#undef NR_FIN
    }
}

__device__ __forceinline__ unsigned sortable(float f) { const unsigned u = __builtin_bit_cast(unsigned, f); return u ^ ((unsigned)((int)u >> 31) | 0x80000000u); }
__device__ __forceinline__ void select_topk(const unsigned (&sc)[32], GAS v2u* mrow, int lane) {
    unsigned thr = 0u;
    for (int bit = 31; bit >= 0; --bit) {
        const unsigned cand = thr | (1u << bit); unsigned c = 0u;
#pragma unroll
        for (int jp = 0; jp < 32; ++jp) c += (sc[jp] >= cand) ? 1u : 0u;
        c = (unsigned)__builtin_amdgcn_readfirstlane((int)wave_sum_u32(c));
        if (c == (unsigned)TOPK) {
            unsigned mylo = 0u, myhi = 0u;
#pragma unroll
            for (int jp = 0; jp < 32; ++jp) { const unsigned long long sel = __ballot(sc[jp] >= cand); if (lane == jp) { mylo = (unsigned)sel; myhi = (unsigned)(sel >> 32); } }
            if (lane < 32) { v2u w; w.x = mylo; w.y = myhi; mrow[lane] = w; }
            return;
        }
        if (c > (unsigned)TOPK) thr = cand;
    }
    thr = (unsigned)__builtin_amdgcn_readfirstlane((int)thr);
    int cgt = 0;
#pragma unroll
    for (int jp = 0; jp < 32; ++jp) cgt += __popcll(__ballot(sc[jp] > thr));
    const int need = TOPK - cgt; int seen = 0;
    unsigned mylo = 0u, myhi = 0u;
    const unsigned long long lt = (lane == 0) ? 0ull : (~0ull >> (64 - lane));
#pragma unroll
    for (int jp = 0; jp < 32; ++jp) {
        unsigned long long sel = __ballot(sc[jp] > thr);
        const unsigned long long eq = __ballot(sc[jp] == thr);
        if (eq) { const bool take = (sc[jp] == thr) && (seen + __popcll(eq & lt) < need); sel |= __ballot(take); seen += __popcll(eq); }
        if (lane == jp) { mylo = (unsigned)sel; myhi = (unsigned)(sel >> 32); }
    }
    if (lane < 32) { v2u w; w.x = mylo; w.y = myhi; mrow[lane] = w; }
}
__device__ __forceinline__ void idx_block(Frame& F, int b, int blk) {
    const int lane = F.lane, w = F.wave, hi = lane >> 5, l31 = lane & 31, tid = F.tid;
    const int t0 = blk * 8, tq = t0 + w;
    const size_t row = (size_t)b * SEQ + tq;
    GAS v2u* mrow = (GAS v2u*)(F.MASK + row * 64);
    if (t0 < TOPK) {
        if (lane < 32) { const int k0 = 64 * lane; v2u mw;
            mw.x = (tq >= k0 + 31) ? 0xffffffffu : (tq < k0 ? 0u : ((2u << (tq - k0)) - 1u));
            mw.y = (tq >= k0 + 63) ? 0xffffffffu : (tq < k0 + 32 ? 0u : ((2u << (tq - k0 - 32)) - 1u));
            mrow[lane] = mw; }
        return;
    }
    const int nt = (t0 + 7) / 128 + 1;
    const bf16* prow = F.PROJ + row * PNP;
    bf16x8 qa[4]; float wv[16];
#pragma unroll
    for (int ks = 0; ks < 4; ++ks) qa[ks] = *(const GAS bf16x8*)(prow + PQI + l31 * 64 + 16 * ks + 8 * hi);
#pragma unroll
    for (int r = 0; r < 16; ++r) wv[r] = bf2f(prow[PWI + (r & 3) + 8 * (r >> 2) + 4 * hi]);
    const bf16* ksrc = F.PROJ + ((size_t)b * SEQ + (tid >> 3)) * PNP + PKI + 8 * (tid & 7);
    const int kdst = (tid >> 3) * 128 + (((tid & 7) ^ ((tid >> 3) & 7)) << 4);
    const int krd = l31 * 128;
    unsigned sc[32];
    __syncthreads();
    v4u stg[3][2];
#pragma unroll
    for (int i = 0; i < 3; ++i) if (i < nt) { stg[i][0] = *(const GAS v4u*)(ksrc + (size_t)(i * 128) * PNP); stg[i][1] = *(const GAS v4u*)(ksrc + (size_t)(i * 128 + 64) * PNP); }
#pragma unroll
    for (int kt = 0; kt < 16; ++kt) {
        if (kt < nt) {
            LAS unsigned char* kb_base = F.lds + (kt & 1) * 16384;
            *(LAS v4u*)(kb_base + kdst) = stg[kt % 3][0]; *(LAS v4u*)(kb_base + 8192 + kdst) = stg[kt % 3][1];
            if (kt + 3 < nt) { stg[kt % 3][0] = *(const GAS v4u*)(ksrc + (size_t)(kt + 3) * 128 * PNP); stg[kt % 3][1] = *(const GAS v4u*)(ksrc + (size_t)((kt + 3) * 128 + 64) * PNP); }
            LDS_WAIT(); __builtin_amdgcn_s_barrier(); asm volatile("" ::: "memory");
            float s4[4];
            f32x16 accp, accc;
#define IDX_MM(dst, h_) do { const f32x16 z_ = {0.f,0.f,0.f,0.f,0.f,0.f,0.f,0.f,0.f,0.f,0.f,0.f,0.f,0.f,0.f,0.f}; \
                const bf16x8 k0_ = *(const LAS bf16x8*)(kb_base + (h_) * 4096 + krd + (((0 + hi) ^ (l31 & 7)) << 4)), k1_ = *(const LAS bf16x8*)(kb_base + (h_) * 4096 + krd + (((2 + hi) ^ (l31 & 7)) << 4)); \
                const bf16x8 k2_ = *(const LAS bf16x8*)(kb_base + (h_) * 4096 + krd + (((4 + hi) ^ (l31 & 7)) << 4)), k3_ = *(const LAS bf16x8*)(kb_base + (h_) * 4096 + krd + (((6 + hi) ^ (l31 & 7)) << 4)); \
                dst = __builtin_amdgcn_mfma_f32_32x32x16_bf16(qa[0], k0_, z_, 0, 0, 0); dst = __builtin_amdgcn_mfma_f32_32x32x16_bf16(qa[1], k1_, dst, 0, 0, 0); \
                dst = __builtin_amdgcn_mfma_f32_32x32x16_bf16(qa[2], k2_, dst, 0, 0, 0); dst = __builtin_amdgcn_mfma_f32_32x32x16_bf16(qa[3], k3_, dst, 0, 0, 0); } while (0)
#define IDX_RED(src, h_) do { float x0 = 0.f, x1 = 0.f; _Pragma("unroll") for (int r = 0; r < 16; r += 2) { float m0_, m1_; \
                    asm("v_max_f32 %0, 0, %1" : "=v"(m0_) : "v"(src[r])); asm("v_max_f32 %0, 0, %1" : "=v"(m1_) : "v"(src[r + 1]));     \
                    x0 += wv[r] * m0_; x1 += wv[r + 1] * m1_; } s4[h_] = xor32_sum(x0 + x1); } while (0)
            IDX_MM(accp, 0); __builtin_amdgcn_sched_barrier(0);
            IDX_MM(accc, 1); __builtin_amdgcn_sched_barrier(0); IDX_RED(accp, 0); __builtin_amdgcn_sched_barrier(0);
            IDX_MM(accp, 2); __builtin_amdgcn_sched_barrier(0); IDX_RED(accc, 1); __builtin_amdgcn_sched_barrier(0);
            IDX_MM(accc, 3); __builtin_amdgcn_sched_barrier(0); IDX_RED(accp, 2); __builtin_amdgcn_sched_barrier(0);
            IDX_RED(accc, 3);
#undef IDX_MM
#undef IDX_RED
            const float ma = (lane < 32 ? s4[0] : s4[1]) + 0.0f, mb = (lane < 32 ? s4[2] : s4[3]) + 0.0f;
            sc[2 * kt] = (128 * kt + lane <= tq) ? sortable(ma) : 0u;
            sc[2 * kt + 1] = (128 * kt + 64 + lane <= tq) ? sortable(mb) : 0u;
        } else { sc[2 * kt] = 0u; sc[2 * kt + 1] = 0u; }
    }
    select_topk(sc, mrow, lane);
}
constexpr float QSCALE = 0.08838834764831845f * 1.4426950408889634f;
struct QkRow { v4u q[4], k, g[4]; };
__device__ __forceinline__ void qk_load(Frame& F, int row, QkRow& R) {
    const bf16* prow = F.PROJ + (size_t)row * PNP; const int lane = F.lane;
#pragma unroll
    for (int i = 0; i < 4; ++i) { R.q[i] = ((const GAS v4u*)(prow + PQ + 32 * lane))[i]; R.g[i] = ((const GAS v4u*)(prow + PGV + 32 * lane))[i]; }
    R.k = *(const GAS v4u*)(prow + PK + 8 * lane);
}
__device__ __forceinline__ void qk_finish(Frame& F, int row, const QkRow& R) {
    bf16* prow = F.PROJ + (size_t)row * PNP; const int lane = F.lane;
    {
        float ss = 0.f;
#pragma unroll
        for (int i = 0; i < 4; ++i)
#pragma unroll
            for (int j = 0; j < 4; ++j) { const float a = bflo(R.q[i][j]), c = bfhi(R.q[i][j]); ss += a * a + c * c; }
        ss = sum4(ss);
        const float r = QSCALE / sqrtf(ss * (1.f / HD) + EPS); const float* g = F.qng + 32 * (lane & 3);
#pragma unroll
        for (int i = 0; i < 4; ++i) { v4u o;
#pragma unroll
            for (int j = 0; j < 4; ++j) o[j] = pk2(bflo(R.q[i][j]) * r * g[8 * i + 2 * j], bfhi(R.q[i][j]) * r * g[8 * i + 2 * j + 1]);
            ((GAS v4u*)(prow + PQ + 32 * lane))[i] = o; }
    }
    {
        float ss = 0.f;
#pragma unroll
        for (int j = 0; j < 4; ++j) { const float a = bflo(R.k[j]), c = bfhi(R.k[j]); ss += a * a + c * c; }
        ss = sum16(ss);
        const float r = 1.0f / sqrtf(ss * (1.f / HD) + EPS); const float* g = F.kng + 8 * (lane & 15); v4u o;
#pragma unroll
        for (int j = 0; j < 4; ++j) o[j] = pk2(bflo(R.k[j]) * r * g[2 * j], bfhi(R.k[j]) * r * g[2 * j + 1]);
        *(GAS v4u*)(prow + PK + 8 * lane) = o;
    }
    {
        float ss = 0.f;
#pragma unroll
        for (int i = 0; i < 4; ++i)
#pragma unroll
            for (int j = 0; j < 4; ++j) { const float a = bflo(R.g[i][j]), c = bfhi(R.g[i][j]); ss += a * a + c * c; }
        ss = wave_sum(ss);
        if (lane == 0) F.RS[row] = 1.0f / sqrtf(ss * (1.f / GMW) + EPS);
    }
}
__device__ __forceinline__ void qknorm_rows(Frame& F) {
    QkRow A, B; int row = F.gw; bool hasA = row < M;
    if (hasA) qk_load(F, row, A);
    while (hasA) {
        const int rb = row + F.NGW; const bool hasB = rb < M;
        if (hasB) qk_load(F, rb, B);
        qk_finish(F, row, A);
        if (!hasB) break;
        row = rb + F.NGW; hasA = row < M;
        if (hasA) qk_load(F, row, A);
        qk_finish(F, rb, B);
    }
}
__device__ __forceinline__ void vt_items(Frame& F) {
    constexpr int NI = BATCH * NKV * 2 * 256;
    for (int it0 = F.gw; it0 < NI; it0 += 4 * F.NGW) {
        unsigned e[4][8];
#pragma unroll
        for (int q = 0; q < 4; ++q) { const int item = it0 + q * F.NGW;
            if (item < NI) { const int s8 = item & 255, dh = (item >> 8) & 1, g = (item >> 9) & 3, b = item >> 11, d = 64 * dh + F.lane;
                const bf16* src = F.PROJ + (size_t)(b * SEQ + 8 * s8) * PNP + PV + g * HD + d;
#pragma unroll
                for (int j = 0; j < 8; ++j) e[q][j] = src[(size_t)j * PNP]; } }
#pragma unroll
        for (int q = 0; q < 4; ++q) { const int item = it0 + q * F.NGW;
            if (item < NI) { const int s8 = item & 255, dh = (item >> 8) & 1, g = (item >> 9) & 3, b = item >> 11, d = 64 * dh + F.lane;
                v4u o; o.x = e[q][0] | (e[q][1] << 16); o.y = e[q][2] | (e[q][3] << 16); o.z = e[q][4] | (e[q][5] << 16); o.w = e[q][6] | (e[q][7] << 16);
                *(GAS v4u*)(F.VT + ((size_t)((b * NKV + g) * HD + d)) * SEQ + 8 * s8) = o; } }
    }
}

constexpr int AT_KSTR = 272, AT_VSTR = 136, AT_TILE = 17408;
#define RAW_BARRIER() do { LDS_WAIT(); __builtin_amdgcn_s_barrier(); asm volatile("" ::: "memory"); } while (0)
__device__ __forceinline__ void attn_block(Frame& F, int b, int g, int qb, float sbound) {
    const int lane = F.lane, w = F.wave, hi = lane >> 5, l31 = lane & 31, tid = F.tid;
    const int hh = 4 * g + (w >> 1), tw0 = qb * 64 + 32 * (w & 1), t = tw0 + l31;
    const size_t row = (size_t)b * SEQ + t;
    const float slope2 = exp2f(-0.5f * (float)(hh + 1)) * 1.4426950408889634f;
    bf16x8 qf[8];
#pragma unroll
    for (int ks = 0; ks < 8; ++ks) qf[ks] = *(const GAS bf16x8*)(F.PROJ + row * PNP + PQ + hh * HD + 16 * ks + 8 * hi);
    f32x16 o[4];
#pragma unroll
    for (int db = 0; db < 4; ++db)
#pragma unroll
        for (int r = 0; r < 16; ++r) o[db][r] = 0.f;
    float m = -1e30f, lsum = 0.f;
    const bf16* ksrc = F.PROJ + ((size_t)b * SEQ + (tid >> 4)) * PNP + PK + g * HD + 8 * (tid & 15);
    const int kdst = (tid >> 4) * AT_KSTR + (tid & 15) * 16;
    const bf16* vsrc = F.VT + ((size_t)((b * NKV + g) * HD + (tid >> 3))) * SEQ + 8 * (tid & 7);
    const int vdst = 2 * AT_TILE + (tid >> 3) * AT_VSTR + (tid & 7) * 16;
    const unsigned* mbase = F.MASK + row * 64;
    LAS unsigned char* L = F.lds;
    v4u sk0, sk1, sv0, sv1; v2u mw, mwn;
#define AT_LOAD(kt_) do { sk0 = *(const GAS v4u*)(ksrc + (size_t)(64 * (kt_)) * PNP); sk1 = *(const GAS v4u*)(ksrc + (size_t)(64 * (kt_) + 32) * PNP); \
        sv0 = *(const GAS v4u*)(vsrc + 64 * (kt_)); sv1 = *(const GAS v4u*)(vsrc + (size_t)64 * SEQ + 64 * (kt_)); mwn = *(const GAS v2u*)(mbase + 2 * (kt_)); } while (0)
#define AT_STORE(bf_) do { *(LAS v4u*)(L + (bf_) * AT_TILE + kdst) = sk0; *(LAS v4u*)(L + (bf_) * AT_TILE + kdst + 32 * AT_KSTR) = sk1; \
        LAS unsigned char* _v = L + (bf_) * AT_TILE + vdst; *(LAS v2u*)_v = (v2u){sv0.x, sv0.y}; *(LAS v2u*)(_v + 8) = (v2u){sv0.z, sv0.w}; \
        *(LAS v2u*)(_v + 64 * AT_VSTR) = (v2u){sv1.x, sv1.y}; *(LAS v2u*)(_v + 64 * AT_VSTR + 8) = (v2u){sv1.z, sv1.w}; } while (0)
    RAW_BARRIER();
    AT_LOAD(qb); AT_STORE(0); mw = mwn;
    int buf = 0; bool dead = false;
    for (int kt = qb; kt >= 0; --kt) {
        if (kt > 0) AT_LOAD(kt - 1);
        RAW_BARRIER();
        if (!dead) {
            const float dmin = (float)(tw0 - (64 * kt + 63));
            dead = __all((sbound - slope2 * dmin) < (m - 40.0f));
        }
        if (!dead) {
            const LAS unsigned char* kb_ = L + buf * AT_TILE + l31 * AT_KSTR + hi * 16;
            const LAS unsigned char* vb_ = L + buf * AT_TILE + 2 * AT_TILE + l31 * AT_VSTR + hi * 8;
            f32x16 p[2];
#pragma unroll
            for (int kb = 0; kb < 2; ++kb) { const unsigned mword = (kb ? mw.y : mw.x) >> (4 * hi);
#pragma unroll
                for (int r = 0; r < 16; ++r) { const int ko = (r & 3) + 8 * (r >> 2);
                    const unsigned tm = (unsigned)__builtin_amdgcn_sbfe((int)mword, ko, 1);
                    p[kb][r] = __builtin_bit_cast(float, (__builtin_bit_cast(unsigned, slope2 * (float)(32 * kb + ko)) & tm) | (__builtin_bit_cast(unsigned, -2e30f) & ~tm)); } }
            {
                bf16x8 ka[4], kc[4];
#define AT_LDK(dst, kb_i, g_) do { _Pragma("unroll") for (int q_ = 0; q_ < 4; ++q_) dst[q_] = *(const LAS bf16x8*)(kb_ + (kb_i) * 32 * AT_KSTR + (4 * (g_) + q_) * 32); } while (0)
#define AT_MMK(kb_i, src, g_) do { _Pragma("unroll") for (int q_ = 0; q_ < 4; ++q_) p[kb_i] = __builtin_amdgcn_mfma_f32_32x32x16_bf16(src[q_], qf[4 * (g_) + q_], p[kb_i], 0, 0, 0); } while (0)
                AT_LDK(ka, 0, 0); __builtin_amdgcn_sched_barrier(0); AT_MMK(0, ka, 0); __builtin_amdgcn_sched_barrier(0);
                AT_LDK(kc, 0, 1); __builtin_amdgcn_sched_barrier(0); AT_MMK(0, kc, 1); __builtin_amdgcn_sched_barrier(0);
                AT_LDK(ka, 1, 0); __builtin_amdgcn_sched_barrier(0); AT_MMK(1, ka, 0); __builtin_amdgcn_sched_barrier(0);
                AT_LDK(kc, 1, 1); __builtin_amdgcn_sched_barrier(0); AT_MMK(1, kc, 1); __builtin_amdgcn_sched_barrier(0);
#undef AT_LDK
#undef AT_MMK
            }
            const float base = -slope2 * (float)(t - 64 * kt - 4 * hi);
            float rmax = -3e30f;
#pragma unroll
            for (int kb = 0; kb < 2; ++kb)
#pragma unroll
                for (int r = 0; r < 16; ++r) rmax = fmaxf(rmax, p[kb][r]);
            rmax += base; rmax = xor32_max(rmax);
            const float mn = fmaxf(m, rmax), alpha = __builtin_amdgcn_exp2f(m - mn), mrel = mn - base;
            const bool moved = __any(mn != m);
            m = mn;
            float ps = 0.f;
#pragma unroll
            for (int kb = 0; kb < 2; ++kb)
#pragma unroll
                for (int r = 0; r < 16; ++r) { const float e = __builtin_amdgcn_exp2f(p[kb][r] - mrel); p[kb][r] = e; ps += e; }
            lsum = lsum * alpha + ps;
            if (moved) {
#pragma unroll
                for (int db = 0; db < 4; ++db)
#pragma unroll
                    for (int r = 0; r < 16; ++r) o[db][r] *= alpha;
            }
            {
                v4u va[4], vc[4];
#define AT_LDV(dst, st_) do { _Pragma("unroll") for (int db = 0; db < 4; ++db) { const LAS unsigned char* vp = vb_ + db * 32 * AT_VSTR + (st_) * 32; const v2u v0 = *(const LAS v2u*)vp, v1 = *(const LAS v2u*)(vp + 16); \
                    dst[db] = (v4u){v0.x, v0.y, v1.x, v1.y}; } } while (0)
#define AT_MMV(src, st_) do { const int kb_i = (st_) >> 1, s2 = (st_) & 1; v4u pw; pw.x = pk2(p[kb_i][8 * s2 + 0], p[kb_i][8 * s2 + 1]); pw.y = pk2(p[kb_i][8 * s2 + 2], p[kb_i][8 * s2 + 3]); \
                    pw.z = pk2(p[kb_i][8 * s2 + 4], p[kb_i][8 * s2 + 5]); pw.w = pk2(p[kb_i][8 * s2 + 6], p[kb_i][8 * s2 + 7]); const bf16x8 pb = __builtin_bit_cast(bf16x8, pw); \
                    _Pragma("unroll") for (int db = 0; db < 4; ++db) o[db] = __builtin_amdgcn_mfma_f32_32x32x16_bf16(__builtin_bit_cast(bf16x8, src[db]), pb, o[db], 0, 0, 0); } while (0)
                AT_LDV(va, 0); __builtin_amdgcn_sched_barrier(0); AT_MMV(va, 0); __builtin_amdgcn_sched_barrier(0);
                AT_LDV(vc, 1); __builtin_amdgcn_sched_barrier(0); AT_MMV(vc, 1); __builtin_amdgcn_sched_barrier(0);
                AT_LDV(va, 2); __builtin_amdgcn_sched_barrier(0); AT_MMV(va, 2); __builtin_amdgcn_sched_barrier(0);
                AT_LDV(vc, 3); __builtin_amdgcn_sched_barrier(0); AT_MMV(vc, 3); __builtin_amdgcn_sched_barrier(0);
#undef AT_LDV
#undef AT_MMV
            }
        }
        if (kt > 0) { AT_STORE(buf ^ 1); mw = mwn; }
        buf ^= 1;
    }
#undef AT_LOAD
#undef AT_STORE
    lsum = xor32_sum(lsum);
    const float inv = S_YA / lsum;
    unsigned char* yrow = (unsigned char*)F.YA + row * (2 * ATTW) + hh * HD + 4 * hi;
#pragma unroll
    for (int db = 0; db < 4; ++db)
#pragma unroll
        for (int rq = 0; rq < 4; ++rq) *(GAS unsigned*)(yrow + 32 * db + 8 * rq) = pk4_fp8(o[db][4 * rq] * inv, o[db][4 * rq + 1] * inv, o[db][4 * rq + 2] * inv, o[db][4 * rq + 3] * inv);
}
__device__ __forceinline__ float attn_score_bound(Frame& F) {
    float gq = fmaxf(fabsf(F.qng[F.lane]), fabsf(F.qng[F.lane + 64])), gk = fmaxf(fabsf(F.kng[F.lane]), fabsf(F.kng[F.lane + 64]));
#pragma unroll
    for (int o = 1; o < 64; o <<= 1) { gq = fmaxf(gq, __shfl_xor(gq, o)); gk = fmaxf(gk, __shfl_xor(gk, o)); }
    return 1.02f * 128.0f * gq * gk * QSCALE;
}

constexpr int SG_STR = 272, SG_WOFF = 65536;
__device__ __forceinline__ void sgu_unit(Frame& F, int unit) {
    const int ck = unit >> 3, g = unit & 7, r0 = ck * GMC, c0 = g * GMGW, tid = F.tid, lane = F.lane, w = F.wave, hi = lane >> 5, l31 = lane & 31;
    LAS unsigned char* L = F.lds;
    const int rs_ = tid >> 5, q_ = tid & 31;
    __syncthreads();
#pragma unroll
    for (int i = 0; i < 8; ++i) *(LAS v4u*)(L + (rs_ + 16 * i) * 512 + q_ * 16) = *(const GAS v4u*)(F.PROJ + (size_t)(r0 + rs_ + 16 * i) * PNP + PGV + c0 + 8 * q_);
    { const f32x4 q = *(const GAS f32x4*)(F.RS + r0 + 4 * q_);
#pragma unroll
      for (int i = 0; i < 8; ++i) { const int t_ = rs_ + 16 * i; const f32x4 wv = *(const GAS f32x4*)(F.sgw + ((size_t)(g * GMC + t_)) * GMC + 4 * q_);
          const int sb = 4 * q_; v2u o;
          o.x = pk2(sb + 0 <= t_ ? wv.x * q.x : 0.f, sb + 1 <= t_ ? wv.y * q.y : 0.f); o.y = pk2(sb + 2 <= t_ ? wv.z * q.z : 0.f, sb + 3 <= t_ ? wv.w * q.w : 0.f);
          *(LAS v2u*)(L + SG_WOFF + t_ * SG_STR + 8 * q_) = o; } }
    __syncthreads();
    v4u uu[8];
#pragma unroll
    for (int i = 0; i < 8; ++i) uu[i] = *(const GAS v4u*)(F.PROJ + (size_t)(r0 + rs_ + 16 * i) * PNP + PGU + c0 + 8 * q_);
    f32x16 acc[4];
#pragma unroll
    for (int tb = 0; tb < 4; ++tb)
#pragma unroll
        for (int r = 0; r < 16; ++r) acc[tb][r] = 0.f;
    const LAS unsigned char* xb = L + hi * 8 * 512 + 2 * (32 * w + l31);
    const LAS unsigned char* wa = L + SG_WOFF + l31 * SG_STR + hi * 16;
#pragma unroll
    for (int ks = 0; ks < 8; ++ks) {
        v4u xw;
#pragma unroll
        for (int j = 0; j < 4; ++j) { const unsigned lo = *(const LAS unsigned short*)(xb + (16 * ks + 2 * j) * 512), hh = *(const LAS unsigned short*)(xb + (16 * ks + 2 * j + 1) * 512); xw[j] = lo | (hh << 16); }
        const bf16x8 xf = __builtin_bit_cast(bf16x8, xw);
#pragma unroll
        for (int tb = 0; tb < 4; ++tb) if (ks < 2 * (tb + 1)) { const bf16x8 wf = *(const LAS bf16x8*)(wa + tb * 32 * SG_STR + ks * 32); acc[tb] = __builtin_amdgcn_mfma_f32_32x32x16_bf16(wf, xf, acc[tb], 0, 0, 0); } }
    LDS_WAIT(); __builtin_amdgcn_s_barrier(); asm volatile("" ::: "memory");
    { const int cl = 32 * w + l31;
#pragma unroll
      for (int tb = 0; tb < 4; ++tb)
#pragma unroll
          for (int r = 0; r < 16; ++r) { const int t = 32 * tb + (r & 3) + 8 * (r >> 2) + 4 * hi; *(LAS unsigned short*)(L + t * 512 + 2 * cl) = (unsigned short)f2bf(acc[tb][r]); } }
    const f32x4 g0 = *(const GAS f32x4*)(F.sgg + c0 + 8 * q_), g1 = *(const GAS f32x4*)(F.sgg + c0 + 8 * q_ + 4);
    LDS_WAIT(); __builtin_amdgcn_s_barrier(); asm volatile("" ::: "memory");
#pragma unroll
    for (int i = 0; i < 8; ++i) { const v4u fw = *(const LAS v4u*)(L + (rs_ + 16 * i) * 512 + q_ * 16); const float bb = F.sgb[g * GMC + rs_ + 16 * i]; v2u o;
        o.x = pk4_fp8(S_YB * bflo(uu[i].x) * (bflo(fw.x) * g0.x + bb), S_YB * bfhi(uu[i].x) * (bfhi(fw.x) * g0.y + bb), S_YB * bflo(uu[i].y) * (bflo(fw.y) * g0.z + bb), S_YB * bfhi(uu[i].y) * (bfhi(fw.y) * g0.w + bb));
        o.y = pk4_fp8(S_YB * bflo(uu[i].z) * (bflo(fw.z) * g1.x + bb), S_YB * bfhi(uu[i].z) * (bfhi(fw.z) * g1.y + bb), S_YB * bflo(uu[i].w) * (bflo(fw.w) * g1.z + bb), S_YB * bfhi(uu[i].w) * (bfhi(fw.w) * g1.w + bb));
        *(GAS v2u*)((unsigned char*)F.YA + (size_t)(r0 + rs_ + 16 * i) * (2 * ATTW) + ATTW + c0 + 8 * q_) = o; }
}

using pg8::Unit; using pg8::cvt_pk_bf16;
struct EpiProj {
    static constexpr bool PERM = true, MIDK = false; bf16* O; float scale;
    __device__ __forceinline__ void operator()(const f32x4 (&acc)[2][2][4][2], const Unit& u, int wr, int wc, int fr, int fq) const {
        const int act = (u.pn >= PGU / 256 && u.pn < PGA / 256) ? 1 : ((u.pn >= PGA / 256 && u.pn < PKI / 256) ? 2 : 0);
        const int row0 = u.pm * 256 + wr * 64 + fr, col0 = u.pn * 256 + wc * 32 + 8 * fq;
#pragma unroll
        for (int ai = 0; ai < 2; ++ai)
#pragma unroll
            for (int m = 0; m < 4; ++m) { bf16* rowp = O + (size_t)(row0 + ai * 128 + m * 16) * PNP + col0;
#pragma unroll
                for (int bj = 0; bj < 2; ++bj) { f32x4 v0 = acc[ai][bj][m][0] * scale, v1 = acc[ai][bj][m][1] * scale;
                    if (act == 1) { const pg8::f32x2 a = pg8::gelu_pk((pg8::f32x2){v0[0], v0[1]}), b = pg8::gelu_pk((pg8::f32x2){v0[2], v0[3]}), c = pg8::gelu_pk((pg8::f32x2){v1[0], v1[1]}), d = pg8::gelu_pk((pg8::f32x2){v1[2], v1[3]});
                        v0 = (f32x4){a.x, a.y, b.x, b.y}; v1 = (f32x4){c.x, c.y, d.x, d.y}; }
                    else if (act == 2) {
#pragma unroll
                        for (int j = 0; j < 4; ++j) { v0[j] = pg8::sigmoidf_(v0[j]); v1[j] = pg8::sigmoidf_(v1[j]); } }
                    v4u w; w.x = cvt_pk_bf16(v0[0], v0[1]); w.y = cvt_pk_bf16(v0[2], v0[3]); w.z = cvt_pk_bf16(v1[0], v1[1]); w.w = cvt_pk_bf16(v1[2], v1[3]);
                    *(GAS v4u*)(rowp + bj * 128) = w; } }
    }
};
struct EpiMerge {
    static constexpr bool PERM = true, MIDK = true; const bf16* P; unsigned char* O; float cB, ratio;
    __device__ __forceinline__ void mid(f32x4 (&acc)[2][2][4][2], const Unit& u, int wr, int wc, int fr, int fq) const {
        const bf16* pb = P + (size_t)(u.pm * 256 + wr * 64 + fr) * PNP + (u.pn * 256 + wc * 32 + 8 * fq);
        asm volatile("" : "+v"(pb));
        v4u A0[4], A1[4];
#define MG_LOAD(G_, s_) do { const bf16* q_ = pb + (size_t)(((s_) >> 2) * 128 + ((s_) & 3) * 16) * PNP; G_[0] = *(const GAS v4u*)(q_ + PGA); G_[1] = *(const GAS v4u*)(q_ + PGB); G_[2] = *(const GAS v4u*)(q_ + PGA + 128); G_[3] = *(const GAS v4u*)(q_ + PGB + 128); } while (0)
#define MG_APPLY(G_, s_) do { _Pragma("unroll") for (int bj = 0; bj < 2; ++bj) { const v4u ga = G_[2 * bj], gb = G_[2 * bj + 1]; _Pragma("unroll") for (int j = 0; j < 2; ++j) { f32x4 f; \
                f.x = ratio * bflo(ga[2 * j]) * __builtin_amdgcn_rcpf(fmaxf(bflo(gb[2 * j]), 1e-30f)); f.y = ratio * bfhi(ga[2 * j]) * __builtin_amdgcn_rcpf(fmaxf(bfhi(gb[2 * j]), 1e-30f)); \
                f.z = ratio * bflo(ga[2 * j + 1]) * __builtin_amdgcn_rcpf(fmaxf(bflo(gb[2 * j + 1]), 1e-30f)); f.w = ratio * bfhi(ga[2 * j + 1]) * __builtin_amdgcn_rcpf(fmaxf(bfhi(gb[2 * j + 1]), 1e-30f)); \
                acc[(s_) >> 2][bj][(s_) & 3][j] *= f; } } asm volatile("" ::: "memory"); } while (0)
        MG_LOAD(A0, 0); MG_LOAD(A1, 1); MG_APPLY(A0, 0); MG_LOAD(A0, 2); MG_APPLY(A1, 1); MG_LOAD(A1, 3); MG_APPLY(A0, 2); MG_LOAD(A0, 4); MG_APPLY(A1, 3); MG_LOAD(A1, 5);
        MG_APPLY(A0, 4); MG_LOAD(A0, 6); MG_APPLY(A1, 5); MG_LOAD(A1, 7); MG_APPLY(A0, 6); MG_APPLY(A1, 7);
#undef MG_LOAD
#undef MG_APPLY
    }
    __device__ __forceinline__ void operator()(const f32x4 (&acc)[2][2][4][2], const Unit& u, int wr, int wc, int fr, int fq) const {
        const float sc = cB * S_MRG;
        const bf16* pb = P + (size_t)(u.pm * 256 + wr * 64 + fr) * PNP + (u.pn * 256 + wc * 32 + 8 * fq) + PGB;
        unsigned char* ob = O + (size_t)(u.pm * 256 + wr * 64 + fr) * DM + (u.pn * 256 + wc * 32 + 8 * fq);
        asm volatile("" : "+v"(pb), "+v"(ob));
        v4u G0[2], G1[2];
#define ME_LOAD(G_, s_) do { const bf16* q_ = pb + (size_t)(((s_) >> 2) * 128 + ((s_) & 3) * 16) * PNP; G_[0] = *(const GAS v4u*)q_; G_[1] = *(const GAS v4u*)(q_ + 128); } while (0)
#define ME_STORE(G_, s_) do { _Pragma("unroll") for (int bj = 0; bj < 2; ++bj) { const v4u gw = G_[bj]; \
            const f32x4 v0 = acc[(s_) >> 2][bj][(s_) & 3][0] * ((f32x4){fmaxf(bflo(gw.x), 1e-30f), fmaxf(bfhi(gw.x), 1e-30f), fmaxf(bflo(gw.y), 1e-30f), fmaxf(bfhi(gw.y), 1e-30f)} * sc); \
            const f32x4 v1 = acc[(s_) >> 2][bj][(s_) & 3][1] * ((f32x4){fmaxf(bflo(gw.z), 1e-30f), fmaxf(bfhi(gw.z), 1e-30f), fmaxf(bflo(gw.w), 1e-30f), fmaxf(bfhi(gw.w), 1e-30f)} * sc); \
            v2u w; w.x = pk4_fp8(v0[0], v0[1], v0[2], v0[3]); w.y = pk4_fp8(v1[0], v1[1], v1[2], v1[3]); \
            *(GAS v2u*)(ob + (size_t)(((s_) >> 2) * 128 + ((s_) & 3) * 16) * DM + bj * 128) = w; } } while (0)
        ME_LOAD(G0, 0); ME_LOAD(G1, 1); ME_STORE(G0, 0); ME_LOAD(G0, 2); ME_STORE(G1, 1); ME_LOAD(G1, 3); ME_STORE(G0, 2); ME_LOAD(G0, 4); ME_STORE(G1, 3); ME_LOAD(G1, 5);
        ME_STORE(G0, 4); ME_LOAD(G0, 6); ME_STORE(G1, 5); ME_LOAD(G1, 7); ME_STORE(G0, 6); ME_STORE(G1, 7);
#undef ME_LOAD
#undef ME_STORE
    }
};
template <bool BIN, bool BOUT>
struct EpiResid {
    static constexpr bool PERM = false, MIDK = false; const void* base; const float* gate; void* C; float scale;
    __device__ __forceinline__ void operator()(const f32x4 (&acc)[2][2][4][2], const Unit& u, int wr, int wc, int fr, int fq) const {
        const int row0 = u.pm * 256 + wr * 64 + fr, col0 = u.pn * 256 + wc * 32 + 4 * fq; const float* gp = gate + (u.pm >> 3) * MODW + col0;
        f32x4 gv[2][2];
#pragma unroll
        for (int bj = 0; bj < 2; ++bj)
#pragma unroll
            for (int n = 0; n < 2; ++n) gv[bj][n] = *(const GAS f32x4*)(gp + bj * 128 + n * 16) * scale;
        size_t off0 = (size_t)row0 * DM + col0; asm volatile("" : "+v"(off0));
        f32x4 B0[4], B1[4];
#define ER_LOAD(B_, s_) do { const size_t o_ = off0 + (size_t)(((s_) >> 2) * 128 + ((s_) & 3) * 16) * DM; _Pragma("unroll") for (int q_ = 0; q_ < 4; ++q_) { const size_t oo_ = o_ + (q_ >> 1) * 128 + (q_ & 1) * 16; \
            if constexpr (BIN) { const v2u w_ = *(const GAS v2u*)((const bf16*)base + oo_); B_[q_] = (f32x4){bflo(w_.x), bfhi(w_.x), bflo(w_.y), bfhi(w_.y)}; } else B_[q_] = *(const GAS f32x4*)((const float*)base + oo_); } } while (0)
#define ER_STORE(B_, s_) do { const size_t o_ = off0 + (size_t)(((s_) >> 2) * 128 + ((s_) & 3) * 16) * DM; _Pragma("unroll") for (int q_ = 0; q_ < 4; ++q_) { const size_t oo_ = o_ + (q_ >> 1) * 128 + (q_ & 1) * 16; \
            const f32x4 r_ = B_[q_] + gv[q_ >> 1][q_ & 1] * acc[(s_) >> 2][q_ >> 1][(s_) & 3][q_ & 1]; \
            if constexpr (BOUT) { v2u w_; w_.x = cvt_pk_bf16(r_.x, r_.y); w_.y = cvt_pk_bf16(r_.z, r_.w); *(GAS v2u*)((bf16*)C + oo_) = w_; } else __builtin_nontemporal_store(r_, (GAS f32x4*)((float*)C + oo_)); } } while (0)
        ER_LOAD(B0, 0); ER_LOAD(B1, 1); ER_STORE(B0, 0); ER_LOAD(B0, 2); ER_STORE(B1, 1); ER_LOAD(B1, 3); ER_STORE(B0, 2); ER_LOAD(B0, 4); ER_STORE(B1, 3); ER_LOAD(B1, 5);
        ER_STORE(B0, 4); ER_LOAD(B0, 6); ER_STORE(B1, 5); ER_LOAD(B1, 7); ER_STORE(B0, 6); ER_STORE(B1, 7);
#undef ER_LOAD
#undef ER_STORE
    }
};
struct EpiPlain {
    static constexpr bool PERM = true, MIDK = false; unsigned char* O; int ldc; float scale;
    __device__ __forceinline__ void operator()(const f32x4 (&acc)[2][2][4][2], const Unit& u, int wr, int wc, int fr, int fq) const {
        unsigned char* ob = O + (size_t)(u.pm * 256 + wr * 64 + fr) * ldc + (u.pn * 256 + wc * 32 + 8 * fq);
        asm volatile("" : "+v"(ob));
#pragma unroll
        for (int ai = 0; ai < 2; ++ai)
#pragma unroll
            for (int m = 0; m < 4; ++m)
#pragma unroll
                for (int bj = 0; bj < 2; ++bj) { const f32x4 v0 = acc[ai][bj][m][0] * scale, v1 = acc[ai][bj][m][1] * scale;
                    v2u w; w.x = pk4_fp8(v0[0], v0[1], v0[2], v0[3]); w.y = pk4_fp8(v1[0], v1[1], v1[2], v1[3]);
                    *(GAS v2u*)(ob + (size_t)(ai * 128 + m * 16) * ldc + bj * 128) = w; }
    }
};

typedef float f32x2 __attribute__((ext_vector_type(2)));
__device__ __forceinline__ void unpack8_fp8(v2u w, f32x2 (&o)[4]) {
    o[0] = __builtin_amdgcn_cvt_pk_f32_fp8((int)w.x, false); o[1] = __builtin_amdgcn_cvt_pk_f32_fp8((int)w.x, true); o[2] = __builtin_amdgcn_cvt_pk_f32_fp8((int)w.y, false); o[3] = __builtin_amdgcn_cvt_pk_f32_fp8((int)w.y, true);
}
__device__ __forceinline__ void conv_phase(Frame& F) {
    constexpr int C8 = DFF / 8, TB = 32, NTB = M / TB;
    const size_t total = (size_t)C8 * NTB;
    for (size_t idx = (size_t)F.gw * 64 + F.lane; idx < total; idx += (size_t)F.NGW * 64) {
        const int c8 = (int)(idx % C8), tb = (int)(idx / C8), ch = 8 * c8, t0 = tb * TB;
        const int acol = (ch >> 7) * 256 + (ch & 127);
        f32x2 wg[3][4], wv[3][4], bg[4], bv[4];
#pragma unroll
        for (int j = 0; j < 3; ++j) { const f32x4 a = *(const GAS f32x4*)(F.cvw + (size_t)j * F2 + ch) * (1.f / S_A), b = *(const GAS f32x4*)(F.cvw + (size_t)j * F2 + ch + 4) * (1.f / S_A);
            const f32x4 c = *(const GAS f32x4*)(F.cvw + (size_t)j * F2 + DFF + ch) * (1.f / S_A), d = *(const GAS f32x4*)(F.cvw + (size_t)j * F2 + DFF + ch + 4) * (1.f / S_A);
            wg[j][0] = (f32x2){a.x, a.y}; wg[j][1] = (f32x2){a.z, a.w}; wg[j][2] = (f32x2){b.x, b.y}; wg[j][3] = (f32x2){b.z, b.w};
            wv[j][0] = (f32x2){c.x, c.y}; wv[j][1] = (f32x2){c.z, c.w}; wv[j][2] = (f32x2){d.x, d.y}; wv[j][3] = (f32x2){d.z, d.w}; }
        { const f32x4 a = *(const GAS f32x4*)(F.cvb + ch), b = *(const GAS f32x4*)(F.cvb + ch + 4), c = *(const GAS f32x4*)(F.cvb + DFF + ch), d = *(const GAS f32x4*)(F.cvb + DFF + ch + 4);
          bg[0] = (f32x2){a.x, a.y}; bg[1] = (f32x2){a.z, a.w}; bg[2] = (f32x2){b.x, b.y}; bg[3] = (f32x2){b.z, b.w}; bv[0] = (f32x2){c.x, c.y}; bv[1] = (f32x2){c.z, c.w}; bv[2] = (f32x2){d.x, d.y}; bv[3] = (f32x2){d.z, d.w}; }
        f32x2 g1[4], g2[4], v1[4], v2[4];
        const bool first = (t0 & (SEQ - 1)) == 0;
        const unsigned char* ap = (const unsigned char*)F.A + (size_t)t0 * F2 + acol;
        if (first) {
#pragma unroll
            for (int e = 0; e < 4; ++e) { g1[e] = g2[e] = v1[e] = v2[e] = (f32x2){0.f, 0.f}; }
        } else {
            const v2u ga = *(const GAS v2u*)(ap - F2), gb = *(const GAS v2u*)(ap - 2 * (size_t)F2), va = *(const GAS v2u*)(ap - F2 + 128), vb = *(const GAS v2u*)(ap - 2 * (size_t)F2 + 128);
            unpack8_fp8(ga, g1); unpack8_fp8(gb, g2); unpack8_fp8(va, v1); unpack8_fp8(vb, v2);
        }
        v2u GA[8], VA[8], GB[8], VB[8];
#define CV_LOAD(G_, V_, r0_) do { _Pragma("unroll") for (int i_ = 0; i_ < 8; ++i_) { G_[i_] = *(const GAS v2u*)(ap + (size_t)((r0_) + i_) * F2); V_[i_] = *(const GAS v2u*)(ap + (size_t)((r0_) + i_) * F2 + 128); } } while (0)
#define CV_COMP(G_, V_, r0_) do { _Pragma("unroll") for (int i_ = 0; i_ < 8; ++i_) { f32x2 g0[4], v0[4], y[4]; unpack8_fp8(G_[i_], g0); unpack8_fp8(V_[i_], v0); \
            _Pragma("unroll") for (int e = 0; e < 4; ++e) { const f32x2 gt = bg[e] + wg[0][e] * g2[e] + wg[1][e] * g1[e] + wg[2][e] * g0[e]; \
                const f32x2 vl = bv[e] + wv[0][e] * v2[e] + wv[1][e] * v1[e] + wv[2][e] * v0[e]; \
                f32x2 sg; sg.x = pg8::sigmoidf_(gt.x); sg.y = pg8::sigmoidf_(gt.y); \
                y[e] = (gt * sg) * (vl * S_ACT); g2[e] = g1[e]; g1[e] = g0[e]; v2[e] = v1[e]; v1[e] = v0[e]; } \
            v2u o; o.x = pk4_fp8(y[0].x, y[0].y, y[1].x, y[1].y); o.y = pk4_fp8(y[2].x, y[2].y, y[3].x, y[3].y); \
            *(GAS v2u*)((unsigned char*)F.ACT + (size_t)(t0 + (r0_) + i_) * DFF + ch) = o; } asm volatile("" ::: "memory"); } while (0)
        CV_LOAD(GA, VA, 0); CV_LOAD(GB, VB, 8); CV_COMP(GA, VA, 0); CV_LOAD(GA, VA, 16); CV_COMP(GB, VB, 8); CV_LOAD(GB, VB, 24); CV_COMP(GA, VA, 16); CV_COMP(GB, VB, 24);
#undef CV_LOAD
#undef CV_COMP
    }
}

constexpr int N_PHASES = 12;
struct Args { const float* in[19]; float* out; unsigned char* ws; int ph_lo, ph_hi, li, pad; };
__global__ void __launch_bounds__(NWAVES * 64, 2) mega_fwd(Args args) {
    extern __shared__ __attribute__((aligned(16))) unsigned char lds[];
    Frame F;
    F.lds = (LAS unsigned char*)lds;
    F.MISC = (volatile LAS unsigned*)(F.lds + MISC_OFF);
    F.tid = threadIdx.x; F.lane = F.tid & 63; F.wave = __builtin_amdgcn_readfirstlane(F.tid >> 6);
    F.G = gridDim.x; F.gw = blockIdx.x * NWAVES + F.wave; F.NGW = F.G * NWAVES;
    unsigned char* ws = args.ws;
    F.ctl = (gu32*)(ws + WS_CTL);
    F.x = args.in[0]; F.c = args.in[1]; F.ada_w = args.in[2]; F.ada_b = args.in[3]; F.n1g = args.in[4]; F.w_in = args.in[5]; F.qng = args.in[6]; F.kng = args.in[7];
    F.sgg = args.in[8]; F.sgw = args.in[9]; F.sgb = args.in[10]; F.w_a = args.in[11]; F.w_b = args.in[12]; F.w_out = args.in[13]; F.n2g = args.in[14]; F.w_up = args.in[15];
    F.cvw = args.in[16]; F.cvb = args.in[17]; F.w_dn = args.in[18]; F.out = args.out;
    F.MOD = (float*)(ws + WS_MOD); F.PART = (float*)(ws + WS_TMP);   F.WIN = (bf16*)(ws + WS_WIN); F.WINB = (bf16*)(ws + WS_WINB); F.H8A = ws + WS_X1;   F.WA = (bf16*)(ws + WS_WA); F.WB = (bf16*)(ws + WS_WB); F.WOUT = (bf16*)(ws + WS_WOUT); F.WUP = (bf16*)(ws + WS_WUP); F.WDN = (bf16*)(ws + WS_WDN);
    F.H = (bf16*)(ws + WS_H); F.X1 = (float*)(ws + WS_X1); F.PROJ = (bf16*)(ws + WS_PROJ); F.MASK = (unsigned*)(ws + WS_MASK); F.RS = (float*)(ws + WS_RS); F.SWT = (float*)(ws + WS_SWT);
    F.VT = (bf16*)(ws + WS_VT); F.YA = (bf16*)(ws + WS_YA); F.YB = (bf16*)(ws + WS_YB); F.MRG = (bf16*)(ws + WS_MRG); F.TMP = (float*)(ws + WS_TMP); F.A = (bf16*)(ws + WS_A); F.ACT = (bf16*)(ws + WS_ACT);
    for (int u = F.tid; u < (LDS_BYTES - LDSCTL_OFF) / 4; u += NWAVES * 64) ((LAS unsigned*)(F.lds + LDSCTL_OFF))[u] = 0u;
    __syncthreads();
    XcdBarrier bar; bar.bar = (unsigned*)(F.ctl + CW_BAR); bar.x = 0; bar.st = nullptr;
    if (MK_N_LAUNCHES == 1) bar = xcd_barrier_post((unsigned*)(F.ctl + CW_BAR), F.MISC + 8);
    const int lo = args.ph_lo, hi = args.ph_hi;
#define IN(k) (lo <= (k) && (k) < hi)
#define SEAM(k) do { if (IN(k) && IN((k) + 1)) xcd_barrier(bar); } while (0)

#define REP(k) if ((PROBE_MASK >> (k)) & 1) for (int _rep = 0; _rep < 1; ++_rep)
    if (IN(0)) { p0_prologue(F); REP(0) { xcd_barrier(bar); p0_prologue(F, false); } } SEAM(0);
    if (IN(1)) { mod_reduce(F); } SEAM(1);
    if (IN(2)) { norm_rows<2>(F, F.x, F.n1g, 0, DM, F.H, F.H8A); REP(2) { xcd_barrier(bar); norm_rows<2>(F, F.x, F.n1g, 0, DM, F.H, F.H8A); } } SEAM(2);
    if (IN(3)) {
        { pg8::Gemm g{F.H, F.WINB, M, PNP, DM, DM, DM}; pg8::MixOrder S{0, F.G, (int)blockIdx.x}; EpiProj E{F.PROJ, 1.0f};
          pg8::gemm_phase<EpiProj, pg8::MixOrder, true, 2>(F.lds + RING_OFF, g, S, E); }
        VM_WAIT(); __syncthreads();
        { pg8::Gemm g{(const bf16*)F.H8A, F.WIN, M, PNP, DM, DM, DM}; EpiProj E{F.PROJ, 1.0f / (S_H2 * 1024.f)};
          const bool slotted = F.G == 256 && blockIdx.x >= 32; const int cut = slotted ? ((int)blockIdx.x - 32) % 9 : (1 << 30);
          for (int part = 0; part < 2; ++part) {
              pg8::MixOrder S{1, F.G, (int)blockIdx.x}; S.i0 = part ? cut : 0; S.i1 = part ? (1 << 30) : cut;
              pg8::gemm_phase<EpiProj, pg8::MixOrder, true, 1>(F.lds + RING_OFF, g, S, E);
              if (part == 0 && slotted) { const int first = ((int)blockIdx.x - 32) * TR_UP_SLOT, last = first + TR_UP_SLOT < TR_P_UP - TR_UP_TAIL - 2 * 256 * TR_UP_67 ? first + TR_UP_SLOT : TR_P_UP - TR_UP_TAIL - 2 * 256 * TR_UP_67;
                  tr_run<5>(F, first + F.wave, last, NWAVES, (LAS float*)(F.lds + RING_OFF + F.wave * 16384)); VM_WAIT(); __syncthreads(); }
          } }
        if (F.G == 256 && blockIdx.x < 32) { const int first = (int)blockIdx.x * (128 + 16);
            tr_run<4>(F, first + F.wave, first + 128 + 16, NWAVES, (LAS float*)(F.lds + RING_OFF + F.wave * 16384)); }
    } SEAM(3);
    if (IN(4)) {
        for (int it = blockIdx.x; it < 512; it += F.G) { const int b = it >> 7, j = it & 127; idx_block(F, b, j); idx_block(F, b, 255 - j); }
        qknorm_rows(F);
        vt_items(F);
        REP(4) { xcd_barrier(bar); for (int it = blockIdx.x; it < 512; it += F.G) { const int b = it >> 7, j = it & 127; idx_block(F, b, j); idx_block(F, b, 255 - j); } }
        REP(13) { xcd_barrier(bar); vt_items(F); }
    } SEAM(4);
    if (IN(5)) {
        { const float sb = attn_score_bound(F); for (int p = blockIdx.x; p < 256; p += F.G) { const int bg = (p & 7) * 2 + ((p >> 3) & 1), j = p >> 4;     attn_block(F, bg >> 2, bg & 3, j, sb); attn_block(F, bg >> 2, bg & 3, 31 - j, sb); } }
        REP(5) { xcd_barrier(bar); { const float sb = attn_score_bound(F); for (int p = blockIdx.x; p < 256; p += F.G) { const int bg = (p & 7) * 2 + ((p >> 3) & 1), j = p >> 4;     attn_block(F, bg >> 2, bg & 3, j, sb); attn_block(F, bg >> 2, bg & 3, 31 - j, sb); } } }
        for (int u = blockIdx.x; u < 512; u += F.G) sgu_unit(F, u);
        __syncthreads();
        if (F.G == 256) { const int pq = blockIdx.x, bg_ = (pq & 7) * 2 + ((pq >> 3) & 1), g_ = bg_ & 3, li = (bg_ >> 2) * 16 + (pq >> 4);
            if (g_ < 2) { const int cnt = g_ == 0 ? TR_AT0 : TR_AT1, first = g_ == 0 ? li * TR_AT0 : 64 * TR_AT0 + li * TR_AT1;
                tr_run<2>(F, first + F.wave, first + cnt, NWAVES, (LAS float*)(F.lds + RING_OFF + F.wave * 16384)); }
            __syncthreads(); }
        REP(14) { xcd_barrier(bar); for (int u = blockIdx.x; u < 512; u += F.G) sgu_unit(F, u); __syncthreads(); }
    } SEAM(5);
    if (IN(6) && F.G == 256 && ((blockIdx.x >> 3) & 1)) { const int first = (int)blockIdx.x * TR_UP_67; tr_run<6>(F, first + F.wave, first + TR_UP_67, NWAVES, (LAS float*)(F.lds + RING_OFF + F.wave * 16384)); VM_WAIT(); __syncthreads(); }
    if (IN(6)) { pg8::Gemm g{F.YA, F.WA, M, DM, 2 * ATTW, 2 * ATTW, 2 * ATTW}; pg8::StaticOrder S; S.init(M, DM, F.G, (int)blockIdx.x);
        EpiMerge E{F.PROJ, (unsigned char*)F.MRG, 1.0f / (S_YB * S_WB), (S_YB * S_WB) / (S_YA * S_WA)};
        pg8::gemm_phase<EpiMerge, pg8::StaticOrder, true, 1>(F.lds + RING_OFF, g, S, E);
        REP(6) { xcd_barrier(bar); pg8::gemm_phase<EpiMerge, pg8::StaticOrder, true, 1>(F.lds + RING_OFF, g, S, E); } }
    if (IN(6) && F.G == 256 && !((blockIdx.x >> 3) & 1)) { const int first = (int)blockIdx.x * TR_UP_67; tr_run<6>(F, first + F.wave, first + TR_UP_67, NWAVES, (LAS float*)(F.lds + RING_OFF + F.wave * 16384)); VM_WAIT(); __syncthreads(); }
    SEAM(6);
    if (IN(7) && F.G == 256 && ((blockIdx.x >> 3) & 1)) { const int first = 256 * TR_UP_67 + (int)blockIdx.x * TR_UP_67; tr_run<6>(F, first + F.wave, first + TR_UP_67, NWAVES, (LAS float*)(F.lds + RING_OFF + F.wave * 16384)); VM_WAIT(); __syncthreads(); }
    if (IN(7)) { pg8::Gemm g{F.MRG, F.WOUT, M, DM, DM, DM, DM}; pg8::StaticOrder S; S.init(M, DM, F.G, (int)blockIdx.x); EpiResid<false, true> E{F.x, F.MOD + 2 * DM, F.X1, 1.0f / (S_MRG * S_WOUT)};
        pg8::gemm_phase<EpiResid<false, true>, pg8::StaticOrder, true, 1>(F.lds + RING_OFF, g, S, E);
        REP(7) { xcd_barrier(bar); pg8::gemm_phase<EpiResid<false, true>, pg8::StaticOrder, true, 1>(F.lds + RING_OFF, g, S, E); } }
    if (IN(7) && F.G == 256 && !((blockIdx.x >> 3) & 1)) { const int first = 256 * TR_UP_67 + (int)blockIdx.x * TR_UP_67; tr_run<6>(F, first + F.wave, first + TR_UP_67, NWAVES, (LAS float*)(F.lds + RING_OFF + F.wave * 16384)); VM_WAIT(); __syncthreads(); }
    SEAM(7);
    if (IN(8)) { norm_rows<1, true>(F, F.X1, F.n2g, 3 * DM, 4 * DM, F.H); REP(8) { xcd_barrier(bar); norm_rows<1, true>(F, F.X1, F.n2g, 3 * DM, 4 * DM, F.H); } } SEAM(8);
    if (IN(9)) { pg8::Gemm g{F.H, F.WUP, M, F2, DM, DM, DM}; pg8::StaticOrder S; S.init(M, F2, F.G, (int)blockIdx.x); EpiPlain E{(unsigned char*)F.A, F2, S_A / (S_H2 * S_WUP)};
        pg8::gemm_phase<EpiPlain, pg8::StaticOrder, true, 1>(F.lds + RING_OFF, g, S, E);
        if (F.G == 256 && blockIdx.x >= 192) { const int first = ((int)blockIdx.x - 192) * 80;
            tr_run<3>(F, first + F.wave, first + 80, NWAVES, (LAS float*)(F.lds + RING_OFF + F.wave * 16384)); }
        REP(9) { xcd_barrier(bar); pg8::gemm_phase<EpiPlain, pg8::StaticOrder, true, 1>(F.lds + RING_OFF, g, S, E); } } SEAM(9);
    if (IN(10)) { conv_phase(F); REP(10) { xcd_barrier(bar); conv_phase(F); } } SEAM(10);
    if (IN(11)) { pg8::Gemm g{F.ACT, F.WDN, M, DM, DFF, DFF, DFF}; pg8::StaticOrder S; S.init(M, DM, F.G, (int)blockIdx.x); EpiResid<true, false> E{F.X1, F.MOD + 5 * DM, F.out, 1.0f / (S_ACT * S_WDN)};
        pg8::gemm_phase<EpiResid<true, false>, pg8::StaticOrder, true, 1>(F.lds + RING_OFF, g, S, E);
        REP(11) { xcd_barrier(bar); pg8::gemm_phase<EpiResid<true, false>, pg8::StaticOrder, true, 1>(F.lds + RING_OFF, g, S, E); } }
#undef REP
#undef IN
#undef SEAM
}

extern "C" void kernel_launch(void* const* d_in, const int* in_sizes, int n_in, void* d_out, int out_size, void* d_ws, size_t ws_size, hipStream_t stream) {
    static int grid = 0;
    if (grid == 0) {
        if (n_in != 19 || in_sizes[0] != M * DM || out_size != M * DM || ws_size < WS_END) { fprintf(stderr, "kernel_launch: unexpected shapes (n_in %d, in0 %d, out %d, ws %zu < %zu); nothing launched\n", n_in, n_in > 0 ? in_sizes[0] : -1, out_size, ws_size, (size_t)WS_END); grid = -1; return; }
        int dev = 0, cus = 0, per_cu = 0;
        if (hipGetDevice(&dev) != hipSuccess || hipDeviceGetAttribute(&cus, hipDeviceAttributeMultiprocessorCount, dev) != hipSuccess) { fprintf(stderr, "kernel_launch: device query failed\n"); grid = -1; return; }
        if (hipFuncSetAttribute((const void*)mega_fwd, hipFuncAttributeMaxDynamicSharedMemorySize, LDS_BYTES) != hipSuccess) { fprintf(stderr, "kernel_launch: hipFuncSetAttribute failed\n"); grid = -1; return; }
        if (hipOccupancyMaxActiveBlocksPerMultiprocessor(&per_cu, (const void*)mega_fwd, NWAVES * 64, LDS_BYTES) != hipSuccess || per_cu < 1) { fprintf(stderr, "kernel_launch: occupancy query reports %d blocks per CU\n", per_cu); }
        (void)hipGetLastError();
        grid = cus;
    }
    if (grid < 0) return;
    if (hipMemsetAsync((char*)d_ws + WS_CTL, 0, CTL_ZERO_BYTES, stream) != hipSuccess) { fprintf(stderr, "kernel_launch: memset failed\n"); return; }
    Args a{};
    for (int i = 0; i < 19; ++i) a.in[i] = (const float*)d_in[i];
    a.out = (float*)d_out; a.ws = (unsigned char*)d_ws; a.pad = 0;
    for (int li = 0; li < MK_N_LAUNCHES; ++li) {
        if (MK_N_LAUNCHES == 1) { a.ph_lo = 0; a.ph_hi = N_PHASES; } else { a.ph_lo = li; a.ph_hi = li + 1; }
        a.li = li;
        hipLaunchKernelGGL(mega_fwd, dim3(grid), dim3(NWAVES * 64), LDS_BYTES, stream, a);
        const hipError_t le = hipPeekAtLastError();
        if (le != hipSuccess) { fprintf(stderr, "kernel_launch: launch %d failed: %s\n", li, hipGetErrorName(le)); break; }
    }
}
```
